# Optimizing an MI355X kernel written in HIP

```python
import math
import jax, jax.numpy as jnp
from jax import lax
import numpy as np

D_MODEL = 1024
BATCH = 4
SEQ = 8192
DEPTH = 2

HEAD_DIM = 64
A_HEADS = 6
A_PATTERNS = ((128, 1), (512, 4), (2048, 16))
B_HEADS = 6
C_Q_HEADS = 6
C_KV_HEADS = 2
C_GROUP = C_Q_HEADS // C_KV_HEADS
C_WINDOW = 128
N_BRANCHES = 3
A_WIDTH = A_HEADS * HEAD_DIM
B_WIDTH = B_HEADS * HEAD_DIM
C_Q_WIDTH = C_Q_HEADS * HEAD_DIM
C_KV_WIDTH = C_KV_HEADS * HEAD_DIM
IN_SIZES = (A_WIDTH, A_WIDTH, A_WIDTH, B_WIDTH, B_WIDTH, B_WIDTH, B_HEADS,
            C_Q_WIDTH, C_KV_WIDTH, C_KV_WIDTH, N_BRANCHES * D_MODEL)
IN_COLS = sum(IN_SIZES)
BLOCK = 128
ROPE_THETA = 10000.0
RMS_EPS = 1e-6
NEG_INF = -1e30
PEER_HEADS = 8
PEER_DK = 256
PEER_DK_HALF = PEER_DK // 2
N_KEYS = 128
N_EXPERTS = N_KEYS * N_KEYS
PEER_TOPK = 16
PEER_CHUNK = 128

kernel_name = "hybrid_dilated_fox_swasink_peer"


def rms_norm(x, g):
    x32 = x.astype(jnp.float32)
    y = x32 * lax.rsqrt(jnp.mean(x32 * x32, axis=-1, keepdims=True) + RMS_EPS)
    return (y * g.astype(jnp.float32)).astype(x.dtype)


def rope_tables(positions):
    inv_freq = ROPE_THETA ** (-jnp.arange(0, HEAD_DIM, 2, dtype=jnp.float32) / HEAD_DIM)
    ang = positions.astype(jnp.float32)[..., None] * inv_freq
    return jnp.cos(ang), jnp.sin(ang)


def apply_rope(t, cos, sin):
    t32 = t.astype(jnp.float32)
    t1, t2 = jnp.split(t32, 2, axis=-1)
    c = cos[:, :, None, :]
    s = sin[:, :, None, :]
    return jnp.concatenate([t1 * c - t2 * s, t2 * c + t1 * s], axis=-1).astype(t.dtype)


def split_columns(t):
    parts, start = [], 0
    for size in IN_SIZES:
        parts.append(t[..., start:start + size])
        start += size
    return parts


def banded_attention(q, k, v, max_dist, sink=None):
    n, length, hk, g, dh = q.shape
    nb = -(-length // BLOCK)
    pad = nb * BLOCK - length
    q = jnp.pad(q, ((0, 0), (0, pad), (0, 0), (0, 0), (0, 0)))
    kv_pad = ((0, 0), (BLOCK, pad), (0, 0), (0, 0))

    def windows(t):
        tb = jnp.pad(t, kv_pad).reshape(n, nb + 1, BLOCK, hk, dh)
        return jnp.concatenate([tb[:, :-1], tb[:, 1:]], axis=2)

    kw, vw = windows(k), windows(v)
    qb = q.reshape(n, nb, BLOCK, hk, g, dh)
    logits = jnp.einsum('nbqhgd,nbkhd->nbhgqk', qb, kw,
                        preferred_element_type=jnp.float32) * (dh ** -0.5)
    dist = jnp.arange(BLOCK)[:, None] + BLOCK - jnp.arange(2 * BLOCK)[None, :]
    band = (dist >= 0) & (dist <= max_dist)
    key_pos = jnp.arange(nb)[:, None] * BLOCK - BLOCK + jnp.arange(2 * BLOCK)[None, :]
    valid = band[None, :, :] & (key_pos >= 0)[:, None, :]
    logits = jnp.where(valid[None, :, None, None], logits, NEG_INF)
    m = jnp.max(logits, axis=-1, keepdims=True)
    if sink is not None:
        s = sink.astype(jnp.float32)[None, None, :, :, None, None]
        m = jnp.maximum(m, s)
    p = jnp.exp(logits - m)
    denom = jnp.sum(p, axis=-1, keepdims=True)
    if sink is not None:
        denom = denom + jnp.exp(s - m)
    out = jnp.einsum('nbhgqk,nbkhd->nbqhgd', p.astype(v.dtype), vw,
                     preferred_element_type=jnp.float32)
    out = out / jnp.transpose(denom, (0, 1, 4, 2, 3, 5))
    out = out.reshape(n, nb * BLOCK, hk, g, dh)[:, :length].astype(q.dtype)
    lse = jnp.transpose((m + jnp.log(denom))[..., 0], (0, 1, 4, 2, 3))
    lse = lse.reshape(n, nb * BLOCK, hk, g)[:, :length]
    return out, lse


def dilated_mixture_attention(q, k, v):
    b, s, h, dh = q.shape
    outs, lses = [], []
    for window, dil in A_PATTERNS:
        length = s // dil

        def to_res(t):
            return t.reshape(b, length, dil, h, dh).transpose(0, 2, 1, 3, 4).reshape(b * dil, length, h, dh)

        o, lse = banded_attention(to_res(q)[:, :, :, None, :], to_res(k), to_res(v), window // dil)
        outs.append(o[:, :, :, 0].reshape(b, dil, length, h, dh).transpose(0, 2, 1, 3, 4).reshape(b, s, h, dh))
        lses.append(lse[..., 0].reshape(b, dil, length, h).transpose(0, 2, 1, 3).reshape(b, s, h))
    wts = jax.nn.softmax(jnp.stack(lses, axis=0), axis=0)
    out = jnp.einsum('pbsh,pbshd->bshd', wts, jnp.stack(outs, axis=0).astype(jnp.float32))
    return out.astype(q.dtype)


def forgetting_attention(q, k, v, f_logit, b_f):
    b, s, h, dh = q.shape
    nq = s // BLOCK
    log_f = jax.nn.log_sigmoid(f_logit.astype(jnp.float32) + b_f.astype(jnp.float32))
    cum = jnp.cumsum(log_f, axis=1)
    cum_t = cum.transpose(0, 2, 1)
    key_pos = jnp.arange(s)
    qb = q.reshape(b, nq, BLOCK, h, dh).transpose(1, 0, 2, 3, 4)
    cb = cum_t.reshape(b, h, nq, BLOCK).transpose(2, 0, 1, 3)

    def block(args):
        q_blk, c_blk, i = args
        logits = jnp.einsum('bqhd,bkhd->bhqk', q_blk, k,
                            preferred_element_type=jnp.float32) * (dh ** -0.5)
        decay = c_blk[..., None] - cum_t[:, :, None, :]
        q_pos = i * BLOCK + jnp.arange(BLOCK)
        causal = key_pos[None, :] <= q_pos[:, None]
        p = jax.nn.softmax(jnp.where(causal, logits + decay, NEG_INF), axis=-1)
        return jnp.einsum('bhqk,bkhd->bqhd', p.astype(v.dtype), v,
                          preferred_element_type=jnp.float32).astype(q.dtype)

    out = lax.map(block, (qb, cb, jnp.arange(nq)))
    return out.transpose(1, 0, 2, 3, 4).reshape(b, s, h, dh)


def hybrid_mixer(xn, cos, sin, w_in, b_forget, sinks, b_gate, w_br_a, w_br_b, w_br_c, w_out):
    b, s, _ = xn.shape
    proj = jnp.einsum('bsd,dc->bsc', xn, w_in)
    qa, ka, va, qb, kb, vb, fb, qc, kc, vc, gate_logits = split_columns(proj)

    def heads(t, n):
        return t.reshape(b, s, n, HEAD_DIM)

    oa = dilated_mixture_attention(apply_rope(heads(qa, A_HEADS), cos, sin),
                                   apply_rope(heads(ka, A_HEADS), cos, sin),
                                   heads(va, A_HEADS)).reshape(b, s, A_WIDTH)
    ob = forgetting_attention(heads(qb, B_HEADS), heads(kb, B_HEADS), heads(vb, B_HEADS),
                              fb, b_forget).reshape(b, s, B_WIDTH)
    qc_r = apply_rope(heads(qc, C_Q_HEADS), cos, sin).reshape(b, s, C_KV_HEADS, C_GROUP, HEAD_DIM)
    kc_r = apply_rope(heads(kc, C_KV_HEADS), cos, sin)
    oc, _ = banded_attention(qc_r, kc_r, heads(vc, C_KV_HEADS), C_WINDOW - 1,
                             sink=sinks.reshape(C_KV_HEADS, C_GROUP))
    oc = oc.reshape(b, s, C_Q_WIDTH)
    gates = jax.nn.sigmoid(gate_logits.reshape(b, s, N_BRANCHES, D_MODEL) + b_gate)
    merged = (gates[:, :, 0] * (oa @ w_br_a)
              + gates[:, :, 1] * (ob @ w_br_b)
              + gates[:, :, 2] * (oc @ w_br_c))
    return merged @ w_out


def peer_ffn(xn, w_q, k1, k2, u, v):
    b, s, d = xn.shape
    xt = xn.reshape(-1, PEER_CHUNK, d)
    k1f = k1.astype(jnp.float32)
    k2f = k2.astype(jnp.float32)

    def chunk(xc):
        q = (xc @ w_q).reshape(PEER_CHUNK, PEER_HEADS, 2, PEER_DK_HALF).astype(jnp.float32)
        s1 = jnp.einsum('thd,nd->thn', q[:, :, 0], k1f)
        s2 = jnp.einsum('thd,nd->thn', q[:, :, 1], k2f)
        v1, i1 = lax.top_k(s1, PEER_TOPK)
        v2, i2 = lax.top_k(s2, PEER_TOPK)
        cand = (v1[..., :, None] + v2[..., None, :]).reshape(PEER_CHUNK, PEER_HEADS, PEER_TOPK * PEER_TOPK)
        cand_id = (i1[..., :, None] * N_KEYS + i2[..., None, :]).reshape(PEER_CHUNK, PEER_HEADS, PEER_TOPK * PEER_TOPK)
        top_s, top_pos = lax.top_k(cand, PEER_TOPK)
        ids = jnp.take_along_axis(cand_id, top_pos, axis=-1)
        g = jax.nn.softmax(top_s, axis=-1)
        act = jnp.einsum('thkd,td->thk', u[ids], xc, preferred_element_type=jnp.float32)
        w = (g * jax.nn.gelu(act, approximate=False)).astype(v.dtype)
        return jnp.einsum('thk,thkd->td', w, v[ids], preferred_element_type=jnp.float32).astype(xn.dtype)

    return lax.map(chunk, xt).reshape(b, s, d)


def setup_inputs(seed: int = 0) -> dict:
    key = jax.random.key(seed)
    ks = jax.random.split(key, 18)
    f32 = jnp.float32

    def nrm(k, shape, scale):
        return jax.random.normal(k, shape, f32) * scale

    return {
        "x": nrm(ks[0], (BATCH, SEQ, D_MODEL), 1.0),
        "positions": jnp.broadcast_to(jnp.arange(SEQ, dtype=jnp.int32), (BATCH, SEQ)),
        "norm1_g": 1.0 + nrm(ks[1], (DEPTH, D_MODEL), 0.05),
        "w_in": nrm(ks[2], (DEPTH, D_MODEL, IN_COLS), D_MODEL ** -0.5),
        "b_forget": 2.0 + nrm(ks[3], (DEPTH, B_HEADS), 0.5),
        "sinks": nrm(ks[4], (DEPTH, C_Q_HEADS), 0.5),
        "b_gate": nrm(ks[5], (DEPTH, N_BRANCHES, D_MODEL), 0.1),
        "w_br_a": nrm(ks[6], (DEPTH, A_WIDTH, D_MODEL), A_WIDTH ** -0.5),
        "w_br_b": nrm(ks[7], (DEPTH, B_WIDTH, D_MODEL), B_WIDTH ** -0.5),
        "w_br_c": nrm(ks[8], (DEPTH, C_Q_WIDTH, D_MODEL), C_Q_WIDTH ** -0.5),
        "w_out": nrm(ks[9], (DEPTH, D_MODEL, D_MODEL), D_MODEL ** -0.5),
        "norm2_g": 1.0 + nrm(ks[10], (DEPTH, D_MODEL), 0.05),
        "peer_wq": nrm(ks[11], (DEPTH, D_MODEL, PEER_HEADS * PEER_DK), D_MODEL ** -0.5),
        "peer_k1": nrm(ks[12], (DEPTH, N_KEYS, PEER_DK_HALF), PEER_DK_HALF ** -0.5),
        "peer_k2": nrm(ks[13], (DEPTH, N_KEYS, PEER_DK_HALF), PEER_DK_HALF ** -0.5),
        "peer_u": nrm(ks[14], (DEPTH, N_EXPERTS, D_MODEL), D_MODEL ** -0.5),
        "peer_v": nrm(ks[15], (DEPTH, N_EXPERTS, D_MODEL), PEER_HEADS ** -0.5),
        "final_g": 1.0 + nrm(ks[16], (D_MODEL,), 0.05),
    }


def reference(x, positions, norm1_g, w_in, b_forget, sinks, b_gate, w_br_a, w_br_b, w_br_c,
              w_out, norm2_g, peer_wq, peer_k1, peer_k2, peer_u, peer_v, final_g):
    cos, sin = rope_tables(positions)
    h = x
    for l in range(DEPTH):
        h = h + hybrid_mixer(rms_norm(h, norm1_g[l]), cos, sin, w_in[l], b_forget[l], sinks[l],
                             b_gate[l], w_br_a[l], w_br_b[l], w_br_c[l], w_out[l])
        h = h + peer_ffn(rms_norm(h, norm2_g[l]), peer_wq[l], peer_k1[l], peer_k2[l],
                         peer_u[l], peer_v[l])
    return rms_norm(h, final_g)
```

```cpp
#include <hip/hip_runtime.h>
#include <hip/hip_cooperative_groups.h>
#include <cstdio>
#include <cstdint>
#include <cmath>
namespace cg = cooperative_groups;
namespace pg8 {
#define PG8_LAS __attribute__((address_space(3)))
typedef unsigned short bf16_t;
typedef short bf16x8 __attribute__((ext_vector_type(8)));
typedef float f32x4 __attribute__((ext_vector_type(4)));
typedef unsigned u32x4 __attribute__((ext_vector_type(4)));
constexpr int BM = 256, BK = 64, HALF = 128, HTB = HALF * BK * 2  , STAGE_BYTES = 8 * HTB, NXCD = 8, WGM = 8;

__host__ __device__ __forceinline__ int lds_byte(int r, int c) { const int st = (r >> 4) * 2 + (c >> 5), rr = r & 15, cc = c & 31, ob = rr * 64 + cc * 2; return st * 1024 + (ob ^ (((ob >> 9) & 1) << 5)); }
__host__ __device__ __forceinline__ void stage_rc(int b, int& R, int& C) { const int st = b / 1024, sb = b % 1024, swz = sb ^ (((sb >> 9) & 1) << 5); R = (st >> 1) * 16 + swz / 64; C = (st & 1) * 32 + (swz % 64) / 2; }
__host__ __device__ __forceinline__ int perm32(int rho) { const int n = rho >> 4, i = rho & 15; return 8 * (i >> 2) + 4 * n + (i & 3); }

struct Unit { int pm, pn, br; };
struct Gemm { const bf16_t* A; const bf16_t* Bt; int M, N, K, lda; };

struct StaticOrder {
    int nM, nN, nwg, G, c;
    __host__ __device__ void init(int M, int N, int G_, int c_) { nM = M / BM; nN = N / BM; nwg = nM * nN; G = G_; c = c_; }
    __host__ __device__ bool next(int i, Unit& u) const {
        const long L = (long)i * G + c; if (L >= nwg) return false;
        int wgid = (int)L; { const int q = nwg / NXCD, r = nwg % NXCD, xcd = wgid % NXCD, off = wgid / NXCD; wgid = (xcd < r ? xcd * (q + 1) : r * (q + 1) + (xcd - r) * q) + off; }
        const int nig = WGM * nN, gid = wgid / nig, fm = gid * WGM, gsz = (nM - fm) < WGM ? (nM - fm) : WGM;
        u.pm = fm + ((wgid % nig) % gsz); u.pn = (wgid % nig) / gsz; u.br = 0; return true;
    }
    __device__ __forceinline__ size_t a_off(const Unit&) const { return 0; }
    __device__ __forceinline__ size_t b_off(const Unit&) const { return 0; }
    __device__ __forceinline__ void a_ready(const Unit&) const {}
    __device__ __forceinline__ void done(const Unit&) const {}
};

__device__ __forceinline__ unsigned cvt_pk_bf16(float lo, float hi) { unsigned r; asm volatile("v_cvt_pk_bf16_f32 %0, %1, %2" : "=v"(r) : "v"(lo), "v"(hi)); return r; }
typedef float f32x2 __attribute__((ext_vector_type(2)));
__device__ __forceinline__ f32x2 gelu_pk(f32x2 v) {
    const f32x2 av = __builtin_elementwise_abs(v), d = av * 0.2316418882f + 1.0f;
    f32x2 t; t.x = __builtin_amdgcn_rcpf(d.x); t.y = __builtin_amdgcn_rcpf(d.y);
    f32x2 q = t * 0.5307027145f + (-0.7265760135f); q = q * t + 0.7107068705f; q = q * t + (-0.142248368f); q = q * t + 0.127414796f; q = q * t;
    const f32x2 s = (v * v) * (-0.72134752044f);
    f32x2 e; e.x = __builtin_amdgcn_exp2f(s.x); e.y = __builtin_amdgcn_exp2f(s.y);
    const f32x2 m = v * (q * e), r = v - m;
    f32x2 o; o.x = v.x < 0.f ? m.x : r.x; o.y = v.y < 0.f ? m.y : r.y; return o;
}

template <int ACT  > struct EpiBf16 {
    static constexpr bool PERM = true, AFTER_DRAIN = false; static_assert(ACT == 0 || ACT == 1, "EpiBf16: ACT is 0 (none) or 1 (gelu_pk)");
    bf16_t* O; int ldc; const float* bias; int split_cols; size_t split_stride; float scale0;
    __device__ __forceinline__ void operator()(const f32x4 (&acc)[2][2][4][2], const Unit& u, int wr, int wc, int fr, int fq) const {
        const int row0 = u.pm * BM + wr * 64 + fr; int colt = u.pn * BM; bf16_t* base = O;
        float sc = 1.f; if (split_cols) { const int t = colt / split_cols; base += (size_t)t * split_stride; colt -= t * split_cols; if (t == 0) sc = scale0; }
        const int col0 = colt + wc * 32 + 8 * fq, bcol0 = u.pn * BM + wc * 32 + 8 * fq;
        f32x4 bv[2][2];
#pragma unroll
        for (int bj = 0; bj < 2; ++bj)
#pragma unroll
            for (int n = 0; n < 2; ++n) bv[bj][n] = bias ? *(const f32x4*)(bias + bcol0 + bj * HALF + 4 * n) : (f32x4){0.f, 0.f, 0.f, 0.f};
#pragma unroll
        for (int ai = 0; ai < 2; ++ai)
#pragma unroll
            for (int m = 0; m < 4; ++m) { bf16_t* rowp = base + (size_t)(row0 + ai * HALF + m * 16) * ldc + col0;
#pragma unroll
                for (int bj = 0; bj < 2; ++bj) { f32x4 v0 = acc[ai][bj][m][0] + bv[bj][0], v1 = acc[ai][bj][m][1] + bv[bj][1];
                    if (ACT == 1) { f32x2 a = gelu_pk((f32x2){v0[0], v0[1]}), b = gelu_pk((f32x2){v0[2], v0[3]}), c = gelu_pk((f32x2){v1[0], v1[1]}), d = gelu_pk((f32x2){v1[2], v1[3]});
                        v0 = (f32x4){a.x, a.y, b.x, b.y}; v1 = (f32x4){c.x, c.y, d.x, d.y}; }
                    v0 = v0 * sc; v1 = v1 * sc; u32x4 w; w.x = cvt_pk_bf16(v0[0], v0[1]); w.y = cvt_pk_bf16(v0[2], v0[3]); w.z = cvt_pk_bf16(v1[0], v1[1]); w.w = cvt_pk_bf16(v1[2], v1[3]);
                    *(u32x4*)(rowp + bj * HALF) = w; } }
    }
};
template <class Epi, class Sched, bool ALIGN_EPI = false, bool SP2 = false>
__device__ __forceinline__ void gemm_phase(PG8_LAS unsigned char* lds, const Gemm g, const Sched& S, const Epi& E, const int tid) {
    const int wid = __builtin_amdgcn_readfirstlane(tid >> 6), lane = tid & 63, wr = wid >> 2, wc = wid & 3, fr = lane & 15, fq = lane >> 4;
    const int K = g.K, nt = K / BK;
    unsigned voffA[2], voffB[2];
#pragma unroll
    for (int i = 0; i < 2; ++i) { int R, C; stage_rc(tid * 16 + i * 8192, R, C); const int Rb = Epi::PERM ? ((R & ~31) + perm32(R & 31)) : R;
        voffA[i] = (unsigned)(R * g.lda + C) * 2u; voffB[i] = (unsigned)(Rb * K + C) * 2u; }
    const size_t kstep = (size_t)(BK * 2);
    const size_t hstep = (size_t)HALF * K * 2;
    const size_t tstep = 2 * hstep; const size_t hstepA = (size_t)HALF * g.lda * 2, tstepA = 2 * hstepA;
    const unsigned ldsw = (unsigned)wid * 1024u;
    const int aoff = lds_byte(wr * 64 + fr, fq * 8), boff = lds_byte(wc * 32 + fr, fq * 8);
#define PG8_SA(b, h) (((b) * 2 + (h)) * HTB)
#define PG8_SB(b, h) ((4 + (b) * 2 + (h)) * HTB)
#define PG8_STAGE(bufoff, gbase, voff) do { _Pragma("unroll") for (int _i = 0; _i < 2; ++_i) \
        __builtin_amdgcn_global_load_lds((const unsigned*)((const char*)(gbase) + (voff)[_i]), (PG8_LAS unsigned*)(lds + (bufoff) + ldsw + _i * 8192), 16, 0, 0); } while (0)
#define PG8_LDA(dst, b, h) do { _Pragma("unroll") for (int m = 0; m < 4; ++m) _Pragma("unroll") for (int k = 0; k < 2; ++k) dst[m][k] = *(const PG8_LAS bf16x8*)(lds + PG8_SA(b, h) + aoff + m * 2048 + k * 1024); } while (0)
#define PG8_LDB(dst, b, h) do { _Pragma("unroll") for (int n = 0; n < 2; ++n) _Pragma("unroll") for (int k = 0; k < 2; ++k) dst[n][k] = *(const PG8_LAS bf16x8*)(lds + PG8_SB(b, h) + boff + n * 2048 + k * 1024); } while (0)
#define PG8_MMA(ai, bj, At, Bt) do { __builtin_amdgcn_s_setprio(1); _Pragma("unroll") for (int m = 0; m < 4; ++m) _Pragma("unroll") for (int n = 0; n < 2; ++n) _Pragma("unroll") for (int k = 0; k < 2; ++k) \
        acc[ai][bj][m][n] = __builtin_amdgcn_mfma_f32_16x16x32_bf16(Bt[n][k], At[m][k], acc[ai][bj][m][n], 0, 0, 0); __builtin_amdgcn_s_setprio(0); } while (0)
#define PG8_WAIT_V(n) asm volatile("s_waitcnt vmcnt(" #n ")" ::: "memory")
#define PG8_WAIT_L(n) asm volatile("s_waitcnt lgkmcnt(" #n ")" ::: "memory")
#define PG8_BAR __builtin_amdgcn_s_barrier()
#define PG8_SCHED __builtin_amdgcn_sched_barrier(0)
    Unit cur, nxt; int ui = 0;
    if (!S.next(0, cur)) return;
    f32x4 acc[2][2][4][2];
#pragma unroll
    for (int a = 0; a < 2; ++a)
#pragma unroll
        for (int b = 0; b < 2; ++b)
#pragma unroll
            for (int m = 0; m < 4; ++m)
#pragma unroll
                for (int n = 0; n < 2; ++n) acc[a][b][m][n] = (f32x4){0.f, 0.f, 0.f, 0.f};
    bf16x8 At[4][2], B0[2][2], B1[2][2];
    const char* cA = (const char*)g.A + S.a_off(cur) + (size_t)cur.pm * tstepA; const char* cB = (const char*)g.Bt + S.b_off(cur) + (size_t)cur.pn * tstep;
    S.a_ready(cur);
    if constexpr (SP2) {
        PG8_STAGE(PG8_SB(0, 0), cB, voffB); PG8_STAGE(PG8_SB(0, 1), cB + hstep, voffB); PG8_STAGE(PG8_SA(0, 0), cA, voffA); PG8_STAGE(PG8_SA(0, 1), cA + hstepA, voffA);
        if (wr == 1) PG8_BAR;
        PG8_WAIT_V(2); PG8_BAR;
        PG8_STAGE(PG8_SB(1, 0), cB + kstep, voffB); PG8_STAGE(PG8_SA(1, 0), cA + kstep, voffA); PG8_STAGE(PG8_SB(1, 1), cB + hstep + kstep, voffB);
        PG8_WAIT_V(6); PG8_BAR;
    } else {
        PG8_STAGE(PG8_SB(0, 0), cB, voffB); PG8_STAGE(PG8_SA(0, 0), cA, voffA); PG8_STAGE(PG8_SB(0, 1), cB + hstep, voffB); PG8_STAGE(PG8_SA(0, 1), cA + hstepA, voffA);
        if (wr == 1) PG8_BAR;
        PG8_WAIT_V(4); PG8_BAR;
        PG8_STAGE(PG8_SB(1, 0), cB + kstep, voffB); PG8_STAGE(PG8_SA(1, 0), cA + kstep, voffA); PG8_STAGE(PG8_SB(1, 1), cB + hstep + kstep, voffB);
        PG8_WAIT_V(6); PG8_BAR;
    }
    for (;;) {
        const bool has_next = S.next(ui + 1, nxt);
        const char* nA = has_next ? (const char*)g.A + S.a_off(nxt) + (size_t)nxt.pm * tstepA : cA; const char* nB = has_next ? (const char*)g.Bt + S.b_off(nxt) + (size_t)nxt.pn * tstep : cB;
        for (int t = 0; t < nt; t += 2) {
            const bool last = (t == nt - 2);
            const char* a1 = cA + (size_t)(t + 1) * kstep;
            const char* a2 = last ? nA : cA + (size_t)(t + 2) * kstep; const char* b2 = last ? nB : cB + (size_t)(t + 2) * kstep;
            const char* a3 = a2 + kstep; const char* b3 = b2 + kstep;
            if (last && has_next) S.a_ready(nxt);
            if constexpr (SP2) {
            PG8_LDB(B0, 0, 0); PG8_LDB(B1, 0, 1); PG8_SCHED; PG8_LDA(At, 0, 0); PG8_STAGE(PG8_SA(1, 1), a1 + hstepA, voffA);
            PG8_WAIT_V(8); PG8_WAIT_L(0); PG8_BAR; PG8_MMA(0, 0, At, B0); PG8_MMA(0, 1, At, B1); PG8_BAR; PG8_SCHED;
            PG8_LDA(At, 0, 1); PG8_STAGE(PG8_SB(0, 0), b2, voffB); PG8_STAGE(PG8_SB(0, 1), b2 + hstep, voffB); PG8_STAGE(PG8_SA(0, 0), a2, voffA);
            PG8_WAIT_V(8); PG8_WAIT_L(0); PG8_BAR; PG8_MMA(1, 0, At, B0); PG8_MMA(1, 1, At, B1); PG8_BAR; PG8_SCHED;
            PG8_LDB(B0, 1, 0); PG8_LDB(B1, 1, 1); PG8_SCHED; PG8_LDA(At, 1, 0); PG8_STAGE(PG8_SA(0, 1), a2 + hstepA, voffA);
            PG8_WAIT_V(8); PG8_WAIT_L(0); PG8_BAR; PG8_MMA(0, 0, At, B0); PG8_MMA(0, 1, At, B1); PG8_BAR; PG8_SCHED;
            PG8_LDA(At, 1, 1); PG8_STAGE(PG8_SB(1, 0), b3, voffB); PG8_STAGE(PG8_SB(1, 1), b3 + hstep, voffB); PG8_STAGE(PG8_SA(1, 0), a3, voffA);
            PG8_WAIT_V(8); PG8_WAIT_L(0); PG8_BAR; PG8_MMA(1, 0, At, B0); PG8_MMA(1, 1, At, B1); PG8_BAR; PG8_SCHED;
            } else {
            PG8_LDB(B0, 0, 0); PG8_SCHED; PG8_LDA(At, 0, 0); PG8_STAGE(PG8_SA(1, 1), a1 + hstepA, voffA);
            PG8_WAIT_L(8); PG8_BAR; PG8_WAIT_L(0); PG8_MMA(0, 0, At, B0); PG8_BAR; PG8_SCHED;
            PG8_LDB(B1, 0, 1); PG8_STAGE(PG8_SB(0, 0), b2, voffB);
            PG8_BAR; PG8_WAIT_L(0); PG8_MMA(0, 1, At, B1); PG8_BAR;
            PG8_LDA(At, 0, 1); PG8_STAGE(PG8_SA(0, 0), a2, voffA);
            PG8_BAR; PG8_WAIT_L(0); PG8_MMA(1, 0, At, B0); PG8_BAR; PG8_SCHED;
            PG8_STAGE(PG8_SB(0, 1), b2 + hstep, voffB);
            PG8_WAIT_V(6); PG8_BAR; PG8_MMA(1, 1, At, B1); PG8_BAR;
            PG8_LDB(B0, 1, 0); PG8_SCHED; PG8_LDA(At, 1, 0); PG8_STAGE(PG8_SA(0, 1), a2 + hstepA, voffA);
            PG8_WAIT_L(8); PG8_BAR; PG8_WAIT_L(0); PG8_MMA(0, 0, At, B0); PG8_BAR; PG8_SCHED;
            PG8_LDB(B1, 1, 1); PG8_STAGE(PG8_SB(1, 0), b3, voffB);
            PG8_BAR; PG8_WAIT_L(0); PG8_MMA(0, 1, At, B1); PG8_BAR;
            PG8_LDA(At, 1, 1); PG8_STAGE(PG8_SA(1, 0), a3, voffA);
            PG8_BAR; PG8_WAIT_L(0); PG8_MMA(1, 0, At, B0); PG8_BAR; PG8_SCHED;
            PG8_STAGE(PG8_SB(1, 1), b3 + hstep, voffB);
            PG8_WAIT_V(6); PG8_BAR; PG8_MMA(1, 1, At, B1); PG8_BAR;
            }
        }
        if constexpr (ALIGN_EPI) { if (wr == 0) PG8_BAR; }
        if constexpr (!Epi::AFTER_DRAIN) { E(acc, cur, wr, wc, fr, fq); S.done(cur); }
        if (!has_next) break;
        if (!E.keep(cur)) {
#pragma unroll
        for (int a = 0; a < 2; ++a)
#pragma unroll
            for (int b = 0; b < 2; ++b)
#pragma unroll
                for (int m = 0; m < 4; ++m)
#pragma unroll
                    for (int n = 0; n < 2; ++n) acc[a][b][m][n] = (f32x4){0.f, 0.f, 0.f, 0.f};
        }
        cur = nxt; cA = nA; cB = nB; ++ui;
        if constexpr (ALIGN_EPI) { if (wr == 1) PG8_BAR; }
    }
    PG8_WAIT_V(0);
    if constexpr (!ALIGN_EPI) { if (wr == 0) PG8_BAR; }
    PG8_BAR;
    if constexpr (Epi::AFTER_DRAIN) { E.fused(acc, cur, wr, wc, fr, fq, lds, wid, lane); S.done(cur); }
#undef PG8_SA
#undef PG8_SB
#undef PG8_STAGE
#undef PG8_LDA
#undef PG8_LDB
#undef PG8_MMA
#undef PG8_WAIT_V
#undef PG8_WAIT_L
#undef PG8_BAR
#undef PG8_SCHED
}
}

constexpr int BATCH = 4, SEQ = 8192, T = BATCH * SEQ, DM = 1024, DEPTH = 2;
constexpr int IN_COLS = 6022, NP = 3072, N_IN = 6144;
constexpr int N_EXP = 16384;
constexpr int PC_QA = 0, PC_QB = 384, PC_QC = 768, PC_KA = 1152, PC_VA = 1536, PC_KB = 1920, PC_VB = 2304, PC_KC = 2688, PC_VC = 2816, PC_FB = 2944;
constexpr int PC_MERGED = 1152;
constexpr float RMS_EPS = 1e-6f;
constexpr float LOG2E = 1.4426950408889634f;
constexpr float QK_SCALE2 = 0.125f * LOG2E;

constexpr size_t MiB = 1u << 20;
constexpr size_t WS_CTL = 0, CTL_ZERO_BYTES = 65536;
constexpr size_t WS_SSQ1 = 1 * MiB;
constexpr size_t WS_CUMT = 1 * MiB + 256 * 1024;
constexpr size_t WS_LOGF = 2 * MiB;
constexpr size_t WS_KMAX_BASE = 32768;
constexpr size_t WS_ROPE = 3 * MiB;
constexpr size_t WS_W = 12 * MiB, WL_STRIDE = 21 * MiB;
constexpr size_t WL_IN = 0, WL_BR = 12 * MiB, WL_OUT = WL_BR + 2304 * 1024, WL_Q = WL_OUT + 2 * MiB, WL_K12 = WL_Q + 4 * MiB;
static_assert(WL_K12 + 65536 <= WL_STRIDE, "weights");
constexpr size_t WS_HB = 56 * MiB;
constexpr size_t WS_P = 120 * MiB;
constexpr size_t WS_G = 312 * MiB;
constexpr size_t WS_SSQ2P = 504 * MiB;
constexpr size_t WS_END = 506 * MiB;
constexpr size_t WS_Q2 = WS_P;
constexpr size_t WS_IDS = WS_P + 128 * MiB;
constexpr size_t WS_GW = WS_P + 144 * MiB;
constexpr size_t WS_XQ = WS_P + 160 * MiB;
constexpr size_t WS_U16 = WS_G, WS_V16 = WS_G + 32 * MiB;
constexpr size_t WS_U8 = WS_G + 64 * MiB, WS_V8 = WS_G + 80 * MiB, WS_SU = WS_G + 96 * MiB, WS_SV = WS_G + 96 * MiB + 65536;
constexpr int CW_ATT = 64;

constexpr int LDS_BYTES = 147456;
constexpr int NPH = 1 + 8 * DEPTH;
#ifndef PH_MASK
#define PH_MASK 511
#endif

#define LAS __attribute__((address_space(3)))
typedef unsigned short bf16_t;
typedef short bf16x8 __attribute__((ext_vector_type(8)));
typedef float f32x4 __attribute__((ext_vector_type(4)));
typedef float f32x16 __attribute__((ext_vector_type(16)));
typedef unsigned u32x4 __attribute__((ext_vector_type(4)));
typedef unsigned u32x2 __attribute__((ext_vector_type(2)));
typedef short v4i16_t __attribute__((ext_vector_type(4)));
typedef float f32x2_t __attribute__((ext_vector_type(2)));
typedef __bf16 bf16x2_t __attribute__((ext_vector_type(2)));

__device__ __forceinline__ unsigned cvtpk(float lo, float hi) { f32x2_t v = {lo, hi}; bf16x2_t b = __builtin_convertvector(v, bf16x2_t); return __builtin_bit_cast(unsigned, b); }
__device__ __forceinline__ float bflo(unsigned u) { return __uint_as_float(u << 16); }
__device__ __forceinline__ float bfhi(unsigned u) { return __uint_as_float(u & 0xffff0000u); }
__device__ __forceinline__ float wave_sum(float v) {
#pragma unroll
    for (int o = 1; o < 64; o <<= 1) v += __shfl_xor(v, o);
    return v;
}
__device__ __forceinline__ float dot2bf(unsigned a, unsigned b, float acc) {
    return fmaf(bfhi(a), bfhi(b), fmaf(bflo(a), bflo(b), acc));
}

__host__ __device__ __forceinline__ int src_col_in(int n) {
    if (n >= 3072) return 2950 + (n - 3072);
    if (n >= 2950) return -1;
    if (n >= 2944) return 2304 + (n - 2944);
    int seg, src; bool rope;
    if (n < 384)       { seg = 0;    src = 0;    rope = true;  }
    else if (n < 768)  { seg = 384;  src = 1152; rope = false; }
    else if (n < 1152) { seg = 768;  src = 2310; rope = true;  }
    else if (n < 1536) { seg = 1152; src = 384;  rope = true;  }
    else if (n < 1920) { seg = 1536; src = 768;  rope = false; }
    else if (n < 2304) { seg = 1920; src = 1536; rope = false; }
    else if (n < 2688) { seg = 2304; src = 1920; rope = false; }
    else if (n < 2816) { seg = 2688; src = 2694; rope = true;  }
    else               { seg = 2816; src = 2822; rope = false; }
    int off = n - seg;
    if (rope) { const int blk = off >> 6, w = off & 63; off = blk * 64 + (w >> 1) + 32 * (w & 1); }
    return src + off;
}

__device__ __forceinline__ float ssq16(const float* __restrict__ pz, int row) {
    const f32x4* q = (const f32x4*)(pz + (size_t)row * 16);
    const f32x4 a = q[0], b = q[1], c = q[2], d = q[3];
    return (((a[0] + a[1]) + (a[2] + a[3])) + ((b[0] + b[1]) + (b[2] + b[3]))) + (((c[0] + c[1]) + (c[2] + c[3])) + ((d[0] + d[1]) + (d[2] + d[3])));
}

template <int MODE>
__device__ __forceinline__ void transpose_item(const float* __restrict__ W, int K, int Nsrc, bf16_t* __restrict__ WT, const float* __restrict__ kscale,
                                               LAS float* scr, int item, int nblk, int lane) {
    const int kb = item / nblk, nb = item % nblk, k0 = 64 * kb, n0 = 32 * nb;
    const int nn = n0 + (lane & 31);
    const int c = (MODE == 1) ? src_col_in(nn) : nn;
#pragma unroll 8
    for (int i = 0; i < 32; ++i) {
        const int kk = 2 * i + (lane >> 5);
        float v = 0.f;
        if (c >= 0) v = W[(size_t)(k0 + kk) * Nsrc + c];
        if (kscale) v *= kscale[k0 + kk];
        if (MODE == 1 && nn >= 3072) v *= -LOG2E;
        scr[kk * 33 + (lane & 31)] = v;
    }
    asm volatile("s_waitcnt lgkmcnt(0)" ::: "memory");
    const int c8 = lane & 7;
#pragma unroll
    for (int j = 0; j < 4; ++j) {
        const int n = (lane >> 3) + 8 * j; const LAS float* s = scr + (8 * c8) * 33 + n;
        u32x4 o; o.x = cvtpk(s[0 * 33], s[1 * 33]); o.y = cvtpk(s[2 * 33], s[3 * 33]); o.z = cvtpk(s[4 * 33], s[5 * 33]); o.w = cvtpk(s[6 * 33], s[7 * 33]);
        *(u32x4*)(WT + (size_t)(n0 + n) * K + k0 + 8 * c8) = o;
    }
    asm volatile("s_waitcnt lgkmcnt(0)" ::: "memory");
}

struct EpiIn {
    static constexpr bool PERM = true, AFTER_DRAIN = false;
    __device__ __forceinline__ bool keep(const pg8::Unit&) const { return false; }
    bf16_t* P; bf16_t* G; const float* ssq; const float* rope; const float* bgate; const float* bfg; float* logf; int nostore;
    __device__ __forceinline__ void operator()(const pg8::f32x4 (&acc)[2][2][4][2], const pg8::Unit& u, int wr, int wc, int fr, int fq) const {
        const int colw = u.pn * 256 + wc * 32 + 8 * fq;
        const int row0 = u.pm * 256 + wr * 64 + fr;
        float rsv[8];
#pragma unroll
        for (int i = 0; i < 8; ++i) rsv[i] = ssq[row0 + (i >> 2) * 128 + (i & 3) * 16];
#pragma unroll
        for (int i = 0; i < 8; ++i) rsv[i] = rsqrtf(rsv[i] * (1.0f / 1024.0f) + RMS_EPS);
        if (colw >= 3072) {
            const int g0 = colw - 3072;
            f32x4 bg[2][2];
#pragma unroll
            for (int bj = 0; bj < 2; ++bj) { bg[bj][0] = *(const f32x4*)(bgate + g0 + bj * 128) * -LOG2E; bg[bj][1] = *(const f32x4*)(bgate + g0 + bj * 128 + 4) * -LOG2E; }
#pragma unroll
            for (int i = 0; i < 8; ++i) {
                const int ai = i >> 2, m = i & 3;
                const int row = row0 + ai * 128 + m * 16;
                const float rs = rsv[i];
#pragma unroll
                for (int bj = 0; bj < 2; ++bj) {
                    float v[8];
#pragma unroll
                    for (int e = 0; e < 4; ++e) {
                        v[e] = __builtin_amdgcn_rcpf(1.0f + __builtin_amdgcn_exp2f(fmaf(acc[ai][bj][m][0][e], rs, bg[bj][0][e])));
                        v[4 + e] = __builtin_amdgcn_rcpf(1.0f + __builtin_amdgcn_exp2f(fmaf(acc[ai][bj][m][1][e], rs, bg[bj][1][e])));
                    }
                    u32x4 w; w.x = cvtpk(v[0], v[1]); w.y = cvtpk(v[2], v[3]); w.z = cvtpk(v[4], v[5]); w.w = cvtpk(v[6], v[7]);
                    if (!(nostore && w.x != 0x12345678u)) *(u32x4*)(G + (size_t)row * NP + g0 + bj * 128) = w;
                }
            }
        } else {
            bool rp[2];
#pragma unroll
            for (int bj = 0; bj < 2; ++bj) { const int cb = colw + bj * 128; rp[bj] = (cb < 384) || (cb >= 768 && cb < 1536) || (cb >= 2688 && cb < 2816); }
            f32x4 rn[2][2];
#pragma unroll
            for (int bj = 0; bj < 2; ++bj) if (rp[bj]) { const float* r = rope + ((size_t)row0 * 32 + (((colw + bj * 128) & 63) >> 1)) * 2; rn[bj][0] = *(const f32x4*)r; rn[bj][1] = *(const f32x4*)(r + 4); }
#pragma unroll
            for (int i = 0; i < 8; ++i) {
                const int ai = i >> 2, m = i & 3;
                const int row = row0 + ai * 128 + m * 16;
                const float rs = rsv[i];
                f32x4 rc[2][2];
#pragma unroll
                for (int bj = 0; bj < 2; ++bj) { rc[bj][0] = rn[bj][0]; rc[bj][1] = rn[bj][1]; }
                if (i < 7) {
                    const int rown = row0 + ((i + 1) >> 2) * 128 + ((i + 1) & 3) * 16;
#pragma unroll
                    for (int bj = 0; bj < 2; ++bj) if (rp[bj]) { const float* r = rope + ((size_t)rown * 32 + (((colw + bj * 128) & 63) >> 1)) * 2; rn[bj][0] = *(const f32x4*)r; rn[bj][1] = *(const f32x4*)(r + 4); }
                }
#pragma unroll
                for (int bj = 0; bj < 2; ++bj) {
                    const int cb = colw + bj * 128;
                    float v[8];
#pragma unroll
                    for (int e = 0; e < 4; ++e) { v[e] = acc[ai][bj][m][0][e] * rs; v[4 + e] = acc[ai][bj][m][1][e] * rs; }
                    if (rp[bj]) {
                        const f32x4 r0 = rc[bj][0], r1 = rc[bj][1];
                        float a, b;
                        a = v[0]; b = v[1]; v[0] = a * r0[0] - b * r0[1]; v[1] = b * r0[0] + a * r0[1];
                        a = v[2]; b = v[3]; v[2] = a * r0[2] - b * r0[3]; v[3] = b * r0[2] + a * r0[3];
                        a = v[4]; b = v[5]; v[4] = a * r1[0] - b * r1[1]; v[5] = b * r1[0] + a * r1[1];
                        a = v[6]; b = v[7]; v[6] = a * r1[2] - b * r1[3]; v[7] = b * r1[2] + a * r1[3];
                    }
                    if (cb == PC_FB) {
#pragma unroll
                        for (int e = 0; e < 6; ++e) { const float z = v[e] + bfg[e]; logf[(size_t)row * 8 + e] = fminf(z, 0.f) - log1pf(__expf(-fabsf(z))); }
                    }
                    u32x4 w; w.x = cvtpk(v[0], v[1]); w.y = cvtpk(v[2], v[3]); w.z = cvtpk(v[4], v[5]); w.w = cvtpk(v[6], v[7]);
                    if (!(nostore && w.x != 0x12345678u)) *(u32x4*)(P + (size_t)row * NP + cb) = w;
                }
            }
        }
    }
};
struct EpiDry {
    static constexpr bool PERM = true, AFTER_DRAIN = false;
    __device__ __forceinline__ bool keep(const pg8::Unit&) const { return false; }
    float* sink;
    __device__ __forceinline__ void operator()(const pg8::f32x4 (&acc)[2][2][4][2], const pg8::Unit& u, int wr, int wc, int fr, int fq) const {
        float t = 0.f;
#pragma unroll
        for (int ai = 0; ai < 2; ++ai)
#pragma unroll
            for (int bj = 0; bj < 2; ++bj)
#pragma unroll
                for (int m = 0; m < 4; ++m)
#pragma unroll
                    for (int n = 0; n < 2; ++n) t += acc[ai][bj][m][n][0] + acc[ai][bj][m][n][1] + acc[ai][bj][m][n][2] + acc[ai][bj][m][n][3];
        if (t == 1.2345e33f) sink[u.pm] = t;
    }
};
struct EpiBr {
    static constexpr bool PERM = true, AFTER_DRAIN = false;
    __device__ __forceinline__ bool keep(const pg8::Unit&) const { return false; }
    const bf16_t* Gi; bf16_t* Mg; int first;
    __device__ __forceinline__ void operator()(const pg8::f32x4 (&acc)[2][2][4][2], const pg8::Unit& u, int wr, int wc, int fr, int fq) const {
        const int colw = u.pn * 256 + wc * 32 + 8 * fq;
#pragma unroll
        for (int ai = 0; ai < 2; ++ai)
#pragma unroll
            for (int m = 0; m < 4; ++m) {
                const int row = u.pm * 256 + ai * 128 + wr * 64 + m * 16 + fr;
#pragma unroll
                for (int bj = 0; bj < 2; ++bj) {
                    const int cb = colw + bj * 128;
                    const u32x4 g = *(const u32x4*)(Gi + (size_t)row * NP + cb);
                    float v[8];
                    v[0] = bflo(g.x) * acc[ai][bj][m][0][0]; v[1] = bfhi(g.x) * acc[ai][bj][m][0][1]; v[2] = bflo(g.y) * acc[ai][bj][m][0][2]; v[3] = bfhi(g.y) * acc[ai][bj][m][0][3];
                    v[4] = bflo(g.z) * acc[ai][bj][m][1][0]; v[5] = bfhi(g.z) * acc[ai][bj][m][1][1]; v[6] = bflo(g.w) * acc[ai][bj][m][1][2]; v[7] = bfhi(g.w) * acc[ai][bj][m][1][3];
                    bf16_t* mp = Mg + (size_t)row * NP + cb;
                    if (!first) { const u32x4 o = *(const u32x4*)mp;
                        v[0] += bflo(o.x); v[1] += bfhi(o.x); v[2] += bflo(o.y); v[3] += bfhi(o.y); v[4] += bflo(o.z); v[5] += bfhi(o.z); v[6] += bflo(o.w); v[7] += bfhi(o.w); }
                    u32x4 w; w.x = cvtpk(v[0], v[1]); w.y = cvtpk(v[2], v[3]); w.z = cvtpk(v[4], v[5]); w.w = cvtpk(v[6], v[7]);
                    *(u32x4*)mp = w;
                }
                if (m & 1) asm volatile("" ::: "memory");
            }
    }
};
struct BranchOrder {
    pg8::StaticOrder so;
    __device__ __forceinline__ void init(int M, int N, int G_, int c_) { so.init(M, N, G_, c_); }
    __device__ __forceinline__ bool next(int i, pg8::Unit& u) const { const int ti = i / 3; if (!so.next(ti, u)) return false; u.br = i - 3 * ti; return true; }
    __device__ __forceinline__ size_t a_off(const pg8::Unit& u) const { return (size_t)u.br * 384 * 2; }
    __device__ __forceinline__ size_t b_off(const pg8::Unit& u) const { return (size_t)u.br * DM * 384 * 2; }
    __device__ __forceinline__ void a_ready(const pg8::Unit&) const {}
    __device__ __forceinline__ void done(const pg8::Unit&) const {}
};
struct EpiBrChain {
    static constexpr bool PERM = true, AFTER_DRAIN = false;
    const bf16_t* G; bf16_t* Mg;
    __device__ __forceinline__ bool keep(const pg8::Unit& u) const { return u.br < 2; }
    __device__ __forceinline__ void operator()(pg8::f32x4 (&acc)[2][2][4][2], const pg8::Unit& u, int wr, int wc, int fr, int fq) const {
        const int colw = u.pn * 256 + wc * 32 + 8 * fq, br = u.br;
        constexpr float GEPS = 1e-6f;
#pragma unroll
        for (int ai = 0; ai < 2; ++ai)
#pragma unroll
            for (int m = 0; m < 4; ++m) {
                const int row = u.pm * 256 + ai * 128 + wr * 64 + m * 16 + fr;
#pragma unroll
                for (int bj = 0; bj < 2; ++bj) {
                    const int cb = colw + bj * 128;
                    const bf16_t* gp = G + (size_t)row * NP + 1024 * br + cb;
                    const u32x4 gc = *(const u32x4*)gp;
                    float f[8] = {bflo(gc.x), bfhi(gc.x), bflo(gc.y), bfhi(gc.y), bflo(gc.z), bfhi(gc.z), bflo(gc.w), bfhi(gc.w)};
                    if (br > 0) {
#pragma unroll
                        for (int e = 0; e < 8; ++e) f[e] = fmaxf(f[e], GEPS);
                    }
                    if (br < 2) {
                        const u32x4 gn = *(const u32x4*)(gp + 1024);
                        const float d[8] = {bflo(gn.x), bfhi(gn.x), bflo(gn.y), bfhi(gn.y), bflo(gn.z), bfhi(gn.z), bflo(gn.w), bfhi(gn.w)};
#pragma unroll
                        for (int e = 0; e < 8; ++e) f[e] *= __builtin_amdgcn_rcpf(fmaxf(d[e], GEPS));
#pragma unroll
                        for (int e = 0; e < 4; ++e) { acc[ai][bj][m][0][e] *= f[e]; acc[ai][bj][m][1][e] *= f[4 + e]; }
                    } else {
                        float v[8];
#pragma unroll
                        for (int e = 0; e < 4; ++e) { v[e] = acc[ai][bj][m][0][e] * f[e]; v[4 + e] = acc[ai][bj][m][1][e] * f[4 + e]; }
                        u32x4 w; w.x = cvtpk(v[0], v[1]); w.y = cvtpk(v[2], v[3]); w.z = cvtpk(v[4], v[5]); w.w = cvtpk(v[6], v[7]);
                        *(u32x4*)(Mg + (size_t)row * NP + cb) = w;
                    }
                }
                if (m & 1) asm volatile("" ::: "memory");
            }
    }
};
struct EpiOut {
    static constexpr bool PERM = true, AFTER_DRAIN = false;
    __device__ __forceinline__ bool keep(const pg8::Unit&) const { return false; }
    const float* Hin; float* H; bf16_t* HB; float* ssq;
    __device__ __forceinline__ void operator()(const pg8::f32x4 (&acc)[2][2][4][2], const pg8::Unit& u, int wr, int wc, int fr, int fq) const {
        const int colw = u.pn * 256 + wc * 32 + 8 * fq;
        const int row0 = u.pm * 256 + wr * 64 + fr;
        f32x4 hn[2][2];
#pragma unroll
        for (int bj = 0; bj < 2; ++bj) { const float* hi_ = Hin + (size_t)row0 * DM + colw + bj * 128; hn[bj][0] = *(const f32x4*)hi_; hn[bj][1] = *(const f32x4*)(hi_ + 4); }
#pragma unroll
        for (int i = 0; i < 8; ++i) {
            const int ai = i >> 2, m = i & 3;
            const int row = row0 + ai * 128 + m * 16;
            f32x4 hc[2][2];
#pragma unroll
            for (int bj = 0; bj < 2; ++bj) { hc[bj][0] = hn[bj][0]; hc[bj][1] = hn[bj][1]; }
            if (i < 7) {
                const int rown = row0 + ((i + 1) >> 2) * 128 + ((i + 1) & 3) * 16;
#pragma unroll
                for (int bj = 0; bj < 2; ++bj) { const float* hi_ = Hin + (size_t)rown * DM + colw + bj * 128; hn[bj][0] = *(const f32x4*)hi_; hn[bj][1] = *(const f32x4*)(hi_ + 4); }
            }
            float ss = 0.f;
#pragma unroll
            for (int bj = 0; bj < 2; ++bj) {
                const int cb = colw + bj * 128;
                float* hp = H + (size_t)row * DM + cb;
                f32x4 h0 = hc[bj][0] + acc[ai][bj][m][0], h1 = hc[bj][1] + acc[ai][bj][m][1];
                *(f32x4*)hp = h0; *(f32x4*)(hp + 4) = h1;
                u32x4 w; w.x = cvtpk(h0[0], h0[1]); w.y = cvtpk(h0[2], h0[3]); w.z = cvtpk(h1[0], h1[1]); w.w = cvtpk(h1[2], h1[3]);
                *(u32x4*)(HB + (size_t)row * DM + cb) = w;
                ss += (h0[0] * h0[0] + h0[1] * h0[1]) + (h0[2] * h0[2] + h0[3] * h0[3]) + (h1[0] * h1[0] + h1[1] * h1[1]) + (h1[2] * h1[2] + h1[3] * h1[3]);
            }
            ss += __shfl_xor(ss, 16); ss += __shfl_xor(ss, 32);
            if (fq == 0) ssq[(size_t)row * 16 + u.pn * 4 + wc] = ss;
        }
    }
};
struct EpiQ {
    static constexpr bool PERM = true, AFTER_DRAIN = false;
    __device__ __forceinline__ bool keep(const pg8::Unit&) const { return false; }
    bf16_t* Q; const float* ssq;
    __device__ __forceinline__ void operator()(const pg8::f32x4 (&acc)[2][2][4][2], const pg8::Unit& u, int wr, int wc, int fr, int fq) const {
        const int colw = u.pn * 256 + wc * 32 + 8 * fq;
        const int row0 = u.pm * 256 + wr * 64 + fr;
        float rsv[8];
#pragma unroll
        for (int i = 0; i < 4; ++i) rsv[i] = ssq16(ssq, row0 + (i & 3) * 16);
        asm volatile("" ::: "memory");
#pragma unroll
        for (int i = 4; i < 8; ++i) rsv[i] = ssq16(ssq, row0 + 128 + (i & 3) * 16);
#pragma unroll
        for (int i = 0; i < 8; ++i) rsv[i] = rsqrtf(rsv[i] * (1.0f / 1024.0f) + RMS_EPS);
#pragma unroll
        for (int i = 0; i < 8; ++i) {
            const int ai = i >> 2, m = i & 3;
            const int row = row0 + ai * 128 + m * 16;
            const float rs = rsv[i];
#pragma unroll
            for (int bj = 0; bj < 2; ++bj) {
                const int cb = colw + bj * 128;
                const f32x4 a = acc[ai][bj][m][0] * rs, b = acc[ai][bj][m][1] * rs;
                u32x4 w; w.x = cvtpk(a[0], a[1]); w.y = cvtpk(a[2], a[3]); w.z = cvtpk(b[0], b[1]); w.w = cvtpk(b[2], b[3]);
                *(u32x4*)(Q + (size_t)row * 2048 + cb) = w;
            }
        }
    }
};

constexpr int VRP = 144;
constexpr int ATT_WAVE_LDS = 32 * VRP + 256 + 8192;
__device__ __forceinline__ int crow(int r, int hi) { return (r & 3) + 8 * (r >> 2) + 4 * hi; }

struct AttState { float m, l; f32x16 o0, o1; };
struct KTile { u32x4 k0, k1, k2, k3; float ck; };
struct VTile { u32x4 v0, v1, v2, v3; };
struct KFrag { bf16x8 k0, k1, k2, k3; };

template <bool BIAS>
__device__ __forceinline__ void k_load(KTile& t, const bf16_t* __restrict__ Pb, int kcol, int r, int ktile, const float* __restrict__ cumT, int lane) {
    const int row = lane >> 3, ch = lane & 7;
    const bf16_t* base = Pb + kcol + 8 * ch;
    int t0 = ktile + row * r, t1 = t0 + 8 * r, t2 = t0 + 16 * r, t3 = t0 + 24 * r;
    t0 = t0 < 0 ? 0 : (t0 > SEQ - 1 ? SEQ - 1 : t0); t1 = t1 < 0 ? 0 : (t1 > SEQ - 1 ? SEQ - 1 : t1);
    t2 = t2 < 0 ? 0 : (t2 > SEQ - 1 ? SEQ - 1 : t2); t3 = t3 < 0 ? 0 : (t3 > SEQ - 1 ? SEQ - 1 : t3);
    t.k0 = *(const u32x4*)(base + (size_t)t0 * NP); t.k1 = *(const u32x4*)(base + (size_t)t1 * NP); t.k2 = *(const u32x4*)(base + (size_t)t2 * NP); t.k3 = *(const u32x4*)(base + (size_t)t3 * NP);
    t.ck = 0.f;
    if (BIAS) { int tk_l = ktile + (lane & 31) * r; tk_l = tk_l < 0 ? 0 : (tk_l > SEQ - 1 ? SEQ - 1 : tk_l); t.ck = cumT[tk_l]; }
}
__device__ __forceinline__ void v_load(VTile& t, const bf16_t* __restrict__ Pb, int vcol, int r, int ktile, int lane) {
    const int row = lane >> 3, ch = lane & 7;
    const bf16_t* base = Pb + vcol + 8 * ch;
    int t0 = ktile + row * r, t1 = t0 + 8 * r, t2 = t0 + 16 * r, t3 = t0 + 24 * r;
    t0 = t0 < 0 ? 0 : (t0 > SEQ - 1 ? SEQ - 1 : t0); t1 = t1 < 0 ? 0 : (t1 > SEQ - 1 ? SEQ - 1 : t1);
    t2 = t2 < 0 ? 0 : (t2 > SEQ - 1 ? SEQ - 1 : t2); t3 = t3 < 0 ? 0 : (t3 > SEQ - 1 ? SEQ - 1 : t3);
    t.v0 = *(const u32x4*)(base + (size_t)t0 * NP); t.v1 = *(const u32x4*)(base + (size_t)t1 * NP); t.v2 = *(const u32x4*)(base + (size_t)t2 * NP); t.v3 = *(const u32x4*)(base + (size_t)t3 * NP);
}
__device__ __forceinline__ void k_stage(const KTile& t, LAS unsigned char* vl, KFrag& f, int lane) {
    asm volatile("" ::: "memory");
    {
        LAS unsigned char* wp = vl + (lane >> 3) * VRP + (lane & 7) * 16;
        *(LAS u32x4*)(wp) = t.k0; *(LAS u32x4*)(wp + 8 * VRP) = t.k1; *(LAS u32x4*)(wp + 16 * VRP) = t.k2; *(LAS u32x4*)(wp + 24 * VRP) = t.k3;
    }
    asm volatile("s_waitcnt lgkmcnt(0)" ::: "memory");
    const LAS unsigned char* rp = vl + (lane & 31) * VRP + (lane >> 5) * 16;
    f.k0 = *(const LAS bf16x8*)(rp); f.k1 = *(const LAS bf16x8*)(rp + 32); f.k2 = *(const LAS bf16x8*)(rp + 64); f.k3 = *(const LAS bf16x8*)(rp + 96);
    asm volatile("s_waitcnt lgkmcnt(0)" ::: "memory");
}
template <bool BIAS>
__device__ __forceinline__ void v_stage(const VTile& t, float ck, LAS unsigned char* vl, bf16x8 (&vf)[2][2], int lane) {
    const int hi = lane >> 5, l31 = lane & 31, q4 = (lane & 15) >> 2, p4 = lane & 3, g1 = (lane >> 4) & 1;
    asm volatile("" ::: "memory");
    {
        LAS unsigned char* wp = vl + (lane >> 3) * VRP + (lane & 7) * 16;
        *(LAS u32x4*)(wp) = t.v0; *(LAS u32x4*)(wp + 8 * VRP) = t.v1; *(LAS u32x4*)(wp + 16 * VRP) = t.v2; *(LAS u32x4*)(wp + 24 * VRP) = t.v3;
        if (BIAS) { if (hi == 0) ((LAS float*)(vl + 32 * VRP))[l31] = ck; }
    }
    asm volatile("s_waitcnt lgkmcnt(0)" ::: "memory");
    const LAS unsigned char* vb = vl + (4 * hi + q4) * VRP + (16 * g1 + 4 * p4) * 2;
#pragma unroll
    for (int dblk = 0; dblk < 2; ++dblk)
#pragma unroll
        for (int s2 = 0; s2 < 2; ++s2) {
            const LAS unsigned char* a = vb + (16 * s2) * VRP + dblk * 64;
            const v4i16_t lo = __builtin_amdgcn_ds_read_tr16_b64_v4i16((LAS v4i16_t*)a);
            const v4i16_t hh = __builtin_amdgcn_ds_read_tr16_b64_v4i16((LAS v4i16_t*)(a + 8 * VRP));
            vf[dblk][s2] = (bf16x8){lo[0], lo[1], lo[2], lo[3], hh[0], hh[1], hh[2], hh[3]};
        }
}
__device__ __forceinline__ float max_halves(float v) {
    const auto rr = __builtin_amdgcn_permlane32_swap(__float_as_uint(v), __float_as_uint(v), false, false);
    return fmaxf(__uint_as_float(rr[0]), __uint_as_float(rr[1]));
}
__device__ __forceinline__ void softmax_pv(f32x16& s, float scale, AttState& st, const bf16x8 (&vf)[2][2]) {
    float mx = s[0];
#pragma unroll
    for (int i = 1; i < 16; ++i) mx = fmaxf(mx, s[i]);
    mx = max_halves(mx) * scale;
    float m_use = (st.m == -INFINITY) ? 0.f : st.m;
    if (!__all(mx <= st.m + 8.0f)) {
        const float m_new = fmaxf(st.m, mx);
        m_use = (m_new == -INFINITY) ? 0.f : m_new;
        const float alpha = __builtin_amdgcn_exp2f(st.m - m_use);
        st.l *= alpha; st.m = m_new;
#pragma unroll
        for (int i = 0; i < 16; ++i) { st.o0[i] *= alpha; st.o1[i] *= alpha; }
    }
    float rsum = 0.f;
#pragma unroll
    for (int i = 0; i < 16; ++i) { s[i] = __builtin_amdgcn_exp2f(fmaf(s[i], scale, -m_use)); rsum += s[i]; }
    st.l += rsum;
    u32x4 pw0, pw1;
    pw0.x = cvtpk(s[0], s[1]); pw0.y = cvtpk(s[2], s[3]); pw0.z = cvtpk(s[4], s[5]); pw0.w = cvtpk(s[6], s[7]);
    pw1.x = cvtpk(s[8], s[9]); pw1.y = cvtpk(s[10], s[11]); pw1.z = cvtpk(s[12], s[13]); pw1.w = cvtpk(s[14], s[15]);
    const bf16x8 pb0 = __builtin_bit_cast(bf16x8, pw0), pb1 = __builtin_bit_cast(bf16x8, pw1);
    st.o0 = __builtin_amdgcn_mfma_f32_32x32x16_bf16(vf[0][0], pb0, st.o0, 0, 0, 0);
    st.o0 = __builtin_amdgcn_mfma_f32_32x32x16_bf16(vf[0][1], pb1, st.o0, 0, 0, 0);
    st.o1 = __builtin_amdgcn_mfma_f32_32x32x16_bf16(vf[1][0], pb0, st.o1, 0, 0, 0);
    st.o1 = __builtin_amdgcn_mfma_f32_32x32x16_bf16(vf[1][1], pb1, st.o1, 0, 0, 0);
}
__device__ __forceinline__ f32x16 qk_tile(const KFrag& t, const bf16x8 (&qf)[4]) {
    f32x16 s;
#pragma unroll
    for (int i = 0; i < 16; ++i) s[i] = 0.f;
    s = __builtin_amdgcn_mfma_f32_32x32x16_bf16(t.k0, qf[0], s, 0, 0, 0);
    s = __builtin_amdgcn_mfma_f32_32x32x16_bf16(t.k1, qf[1], s, 0, 0, 0);
    s = __builtin_amdgcn_mfma_f32_32x32x16_bf16(t.k2, qf[2], s, 0, 0, 0);
    s = __builtin_amdgcn_mfma_f32_32x32x16_bf16(t.k3, qf[3], s, 0, 0, 0);
    return s;
}

__device__ __forceinline__ f32x16 qk_tile_lds(const KFrag& t, const LAS unsigned char* qb) {
    f32x16 s;
#pragma unroll
    for (int i = 0; i < 16; ++i) s[i] = 0.f;
    s = __builtin_amdgcn_mfma_f32_32x32x16_bf16(t.k0, *(const LAS bf16x8*)(qb), s, 0, 0, 0);
    s = __builtin_amdgcn_mfma_f32_32x32x16_bf16(t.k1, *(const LAS bf16x8*)(qb + 1024), s, 0, 0, 0);
    s = __builtin_amdgcn_mfma_f32_32x32x16_bf16(t.k2, *(const LAS bf16x8*)(qb + 2048), s, 0, 0, 0);
    s = __builtin_amdgcn_mfma_f32_32x32x16_bf16(t.k3, *(const LAS bf16x8*)(qb + 3072), s, 0, 0, 0);
    return s;
}

__device__ __forceinline__ void attn_segment(const bf16_t* __restrict__ Pb, int kcol, int vcol, int r, int maxd_tok, int kt0, int ntiles, int tq,
                                             const bf16x8 (&qf)[4], AttState& st, LAS unsigned char* vl, int lane) {
    const int hi = lane >> 5;
    const int lim = maxd_tok < tq ? maxd_tok : tq;
    KTile nx; VTile vnx;
    k_load<false>(nx, Pb, kcol, r, kt0, nullptr, lane); v_load(vnx, Pb, vcol, r, kt0, lane);
    for (int j = 0; j < ntiles; ++j) {
        const int ktile = kt0 + j * 32 * r;
        const VTile vt = vnx;
        const KTile cur = nx;
        if (j + 1 < ntiles) { k_load<false>(nx, Pb, kcol, r, ktile + 32 * r, nullptr, lane); v_load(vnx, Pb, vcol, r, ktile + 32 * r, lane); }
        KFrag kf; k_stage(cur, vl, kf, lane);
        f32x16 s = qk_tile(kf, qf);
        bf16x8 vf[2][2];
        v_stage<false>(vt, 0.f, vl, vf, lane);
        const int dbase = tq - ktile - 4 * hi * r;
#pragma unroll
        for (int i = 0; i < 16; ++i) {
            const int d = dbase - crow(i, 0) * r;
            s[i] = ((unsigned)d <= (unsigned)lim) ? s[i] : -INFINITY;
        }
        softmax_pv(s, QK_SCALE2, st, vf);
        asm volatile("s_waitcnt lgkmcnt(0)" ::: "memory");
    }
}

__device__ __forceinline__ void attn_load_q(const bf16_t* __restrict__ Pb, int tq, int qcol, int hi, bf16x8 (&qf)[4]) {
    const bf16_t* qp = Pb + (size_t)tq * NP + qcol + 8 * hi;
    qf[0] = *(const bf16x8*)(qp); qf[1] = *(const bf16x8*)(qp + 16); qf[2] = *(const bf16x8*)(qp + 32); qf[3] = *(const bf16x8*)(qp + 48);
}
__device__ __forceinline__ void attn_store_o(bf16_t* __restrict__ Pb, int tq, int ocol, int hi, AttState& st, int dry) {
    float l = st.l + __shfl_xor(st.l, 32);
    if (dry && l >= 0.f) return;
    const float inv = 1.0f / l;
    bf16_t* op = Pb + (size_t)tq * NP + ocol + 4 * hi;
#pragma unroll
    for (int g = 0; g < 4; ++g) {
        u32x2 w0, w1;
        w0.x = cvtpk(st.o0[4 * g] * inv, st.o0[4 * g + 1] * inv); w0.y = cvtpk(st.o0[4 * g + 2] * inv, st.o0[4 * g + 3] * inv);
        w1.x = cvtpk(st.o1[4 * g] * inv, st.o1[4 * g + 1] * inv); w1.y = cvtpk(st.o1[4 * g + 2] * inv, st.o1[4 * g + 3] * inv);
        *(u32x2*)(op + 8 * g) = w0; *(u32x2*)(op + 32 + 8 * g) = w1;
    }
}
__device__ __forceinline__ void att_init(AttState& st) {
#pragma unroll
    for (int i = 0; i < 16; ++i) { st.o0[i] = 0.f; st.o1[i] = 0.f; }
    st.m = -INFINITY; st.l = 0.f;
}

__device__ __forceinline__ void attn_fox_pair(bf16_t* __restrict__ Pb, const float* __restrict__ cumT, float kmax2, int h, int qp, LAS unsigned char* vl, int lane, int dry) {
    const int hi = lane >> 5, l31 = lane & 31;
    const int kcol = PC_KB + 64 * h, vcol = PC_VB + 64 * h, qcol = PC_QB + 64 * h;
    const LAS float* ckl = (const LAS float*)(vl + 32 * VRP);
    AttState st0, st1; att_init(st0); att_init(st1);
    const int tq0 = 64 * qp + l31, tq1 = tq0 + 32;
    LAS unsigned char* qb0 = vl + 32 * VRP + 256 + hi * 512 + l31 * 16;
    LAS unsigned char* qb1 = qb0 + 4096;
    {
        bf16x8 qf[4];
        attn_load_q(Pb, tq0, qcol, hi, qf);
#pragma unroll
        for (int s_ = 0; s_ < 4; ++s_) *(LAS bf16x8*)(qb0 + 1024 * s_) = qf[s_];
        attn_load_q(Pb, tq1, qcol, hi, qf);
#pragma unroll
        for (int s_ = 0; s_ < 4; ++s_) *(LAS bf16x8*)(qb1 + 1024 * s_) = qf[s_];
        asm volatile("s_waitcnt lgkmcnt(0)" ::: "memory");
    }
    const float cq0 = cumT[tq0], cq1 = cumT[tq1];
    float bound0, bound1;
    {
        float n0 = 0.f, n1 = 0.f;
#pragma unroll
        for (int s_ = 0; s_ < 4; ++s_) {
            const bf16x8 a = *(const LAS bf16x8*)(qb0 + 1024 * s_), b = *(const LAS bf16x8*)(qb1 + 1024 * s_);
#pragma unroll
            for (int e = 0; e < 8; ++e) { const float fa = bflo((unsigned)(unsigned short)a[e]), fb = bflo((unsigned)(unsigned short)b[e]); n0 = fmaf(fa, fa, n0); n1 = fmaf(fb, fb, n1); }
        }
        n0 += __shfl_xor(n0, 32); n1 += __shfl_xor(n1, 32);
        bound0 = sqrtf(n0 * kmax2) * QK_SCALE2 * 1.01f + 0.5f; bound1 = sqrtf(n1 * kmax2) * QK_SCALE2 * 1.01f + 0.5f;
    }
    constexpr float FOX_SKIP = 48.0f;
    const int ntiles = 2 * qp + 2;
    KTile nx; VTile vnx;
    k_load<true>(nx, Pb, kcol, 1, 32 * (ntiles - 1), cumT, lane); v_load(vnx, Pb, vcol, 1, 32 * (ntiles - 1), lane);
    for (int j = ntiles - 1; j >= 0; --j) {
        const VTile vt = vnx;
        const KTile cur = nx;
        if (j > 0) { k_load<true>(nx, Pb, kcol, 1, 32 * (j - 1), cumT, lane); v_load(vnx, Pb, vcol, 1, 32 * (j - 1), lane); }
        KFrag kf; k_stage(cur, vl, kf, lane);
        f32x16 s1 = qk_tile_lds(kf, qb1);
        f32x16 s0;
        const bool on0 = (j <= 2 * qp);
        if (on0) s0 = qk_tile_lds(kf, qb0);
        bf16x8 vf[2][2];
        v_stage<true>(vt, cur.ck, vl, vf, lane);
        if (on0) {
            const bool diag = (j == 2 * qp);
#pragma unroll
            for (int g = 0; g < 4; ++g) { const f32x4 c4 = *(const LAS f32x4*)(ckl + 8 * g + 4 * hi);
#pragma unroll
                for (int e = 0; e < 4; ++e) { const int i = 4 * g + e; const float v = fmaf(s0[i], QK_SCALE2, cq0 - c4[e]); s0[i] = (diag && crow(i, hi) > l31) ? -INFINITY : v; } }
            softmax_pv(s0, 1.0f, st0, vf);
        }
        {
            const bool diag = (j == 2 * qp + 1);
#pragma unroll
            for (int g = 0; g < 4; ++g) { const f32x4 c4 = *(const LAS f32x4*)(ckl + 8 * g + 4 * hi);
#pragma unroll
                for (int e = 0; e < 4; ++e) { const int i = 4 * g + e; const float v = fmaf(s1[i], QK_SCALE2, cq1 - c4[e]); s1[i] = (diag && crow(i, hi) > l31) ? -INFINITY : v; } }
            softmax_pv(s1, 1.0f, st1, vf);
        }
        asm volatile("s_waitcnt lgkmcnt(0)" ::: "memory");
        if (j > 0) {
            const float ckn = __int_as_float(__builtin_amdgcn_readlane(__float_as_int(nx.ck), 31));
            const bool dead0 = (cq0 - ckn + bound0) < (st0.m - FOX_SKIP), dead1 = (cq1 - ckn + bound1) < (st1.m - FOX_SKIP);
            if (__all(dead0 && dead1)) break;
        }
    }
    attn_store_o(Pb, tq0, qcol, hi, st0, dry);
    attn_store_o(Pb, tq1, qcol, hi, st1, dry);
}

__device__ __forceinline__ void attention_phase(bf16_t* __restrict__ P, const float* __restrict__ cumT, const float* __restrict__ kmax2, const float* __restrict__ sinks, unsigned* ctr, LAS unsigned char* lds, int wave, int lane, int dry = 0) {
    LAS unsigned char* vl = lds + wave * ATT_WAVE_LDS;
    const int hi = lane >> 5, l31 = lane & 31;
    constexpr int NUB = 3072, NU = 6144;
    for (;;) {
        unsigned u = 0;
        if (lane == 0) u = atomicAdd(ctr, 1u);
        u = __builtin_amdgcn_readfirstlane(u);
        if (u >= (unsigned)(NUB + 2 * NU)) break;
        if (u < (unsigned)NUB) {
            const int qp = 127 - (int)(u / 24), bh = (int)(u % 24), b = bh / 6, h = bh % 6;
            attn_fox_pair(P + (size_t)b * SEQ * NP, cumT + (size_t)bh * SEQ, kmax2[bh], h, qp, vl, lane, dry);
        } else if (u < (unsigned)(NUB + NU)) {
            const int v = (int)u - NUB;
            const int cb = v & 15, rho = (v >> 4) & 15, bh = v >> 8, b = bh / 6, h = bh % 6;
            bf16_t* Pb = P + (size_t)b * SEQ * NP;
            const int tq0 = rho + 512 * cb, tq = tq0 + 16 * l31;
            AttState st; att_init(st); bf16x8 qf[4];
            attn_load_q(Pb, tq, PC_QA + 64 * h, hi, qf);
            attn_segment(Pb, PC_KA + 64 * h, PC_VA + 64 * h, 16, 2048, tq0 - 2048, 5, tq, qf, st, vl, lane);
            attn_segment(Pb, PC_KA + 64 * h, PC_VA + 64 * h, 4, 512, tq0 - 512, 8, tq, qf, st, vl, lane);
            attn_segment(Pb, PC_KA + 64 * h, PC_VA + 64 * h, 1, 128, tq0 - 128, 20, tq, qf, st, vl, lane);
            attn_store_o(Pb, tq, PC_QA + 64 * h, hi, st, dry);
        } else {
            const int v = (int)u - NUB - NU;
            const int qt = v & 255, bh = v >> 8, b = bh / 6, h = bh % 6, hk = h / 3;
            bf16_t* Pb = P + (size_t)b * SEQ * NP;
            const int tq = qt * 32 + l31;
            AttState st; att_init(st); bf16x8 qf[4];
            attn_load_q(Pb, tq, PC_QC + 64 * h, hi, qf);
            st.m = sinks[h] * LOG2E; st.l = (hi == 0) ? 1.f : 0.f;
            attn_segment(Pb, PC_KC + 64 * hk, PC_VC + 64 * hk, 1, 127, qt * 32 - 128, 5, tq, qf, st, vl, lane);
            attn_store_o(Pb, tq, PC_QC + 64 * h, hi, st, dry);
        }
    }
}

__device__ __forceinline__ int f2key(float f) { const int b = __float_as_int(f); return b ^ ((b >> 31) & 0x7fffffff); }
__device__ __forceinline__ float key2f(int k) { return __int_as_float(k ^ ((k >> 31) & 0x7fffffff)); }
#define CE_DESC(a, x) do { const int hi_ = max((a), (x)); (x) = min((a), (x)); (a) = hi_; } while (0)

__device__ __forceinline__ void route_half(const bf16_t* __restrict__ qrow, const LAS unsigned char* kl, int (&list)[16]) {
    unsigned qh[64];
#pragma unroll
    for (int c = 0; c < 16; ++c) { const u32x4 t = *(const u32x4*)(qrow + 8 * c); qh[4 * c] = t.x; qh[4 * c + 1] = t.y; qh[4 * c + 2] = t.z; qh[4 * c + 3] = t.w; }
#pragma unroll
    for (int i = 0; i < 16; ++i) list[i] = (int)0x80000000;
    for (int key = 0; key < 128; ++key) {
        float a0 = 0.f, a1 = 0.f;
        const LAS unsigned char* kp = kl + key * 256;
#pragma unroll
        for (int c = 0; c < 16; ++c) {
            const u32x4 kk = *(const LAS u32x4*)(kp + 16 * c);
            a0 = dot2bf(qh[4 * c], kk.x, a0); a1 = dot2bf(qh[4 * c + 1], kk.y, a1);
            a0 = dot2bf(qh[4 * c + 2], kk.z, a0); a1 = dot2bf(qh[4 * c + 3], kk.w, a1);
        }
        int x = (f2key(a0 + a1) & ~127) | key;
#pragma unroll
        for (int i = 0; i < 16; ++i) CE_DESC(list[i], x);
    }
}

__device__ __forceinline__ void routing_phase(const bf16_t* __restrict__ Q2, const float* __restrict__ k1, const float* __restrict__ k2, int* __restrict__ ids, float* __restrict__ gw,
                                              LAS unsigned char* lds, int tid) {
    for (int e = tid; e < 2 * 8192; e += 512) {
        const int hf = e >> 13, o = (e & 8191) * 2;
        const float* src = (hf ? k2 : k1) + o;
        *(LAS unsigned*)(lds + hf * 32768 + o * 2) = cvtpk(src[0], src[1]);
    }
    __syncthreads();
    const int nthreads = gridDim.x * 512;
    for (int it = blockIdx.x * 512 + tid; it < T * 8; it += nthreads) {
        const int t = it >> 3, h = it & 7;
        const bf16_t* qrow = Q2 + (size_t)t * 2048 + h * 256;
        int l1[16], l2[16];
        route_half(qrow, lds, l1);
        route_half(qrow + 128, lds + 32768, l2);
        float f1[16], f2[16];
#pragma unroll
        for (int i = 0; i < 16; ++i) { f1[i] = key2f(l1[i] & ~127); f2[i] = key2f(l2[i] & ~127); }
        int cl[16];
#pragma unroll
        for (int j = 0; j < 16; ++j) cl[j] = (f2key(f1[0] + f2[j]) & ~255) | j;
#pragma unroll
        for (int i = 1; i < 16; ++i) {
#pragma unroll
            for (int j = 0; j < 16; ++j) {
                if ((i + 1) * (j + 1) <= 16) {
                    int x = (f2key(f1[i] + f2[j]) & ~255) | (i * 16 + j);
#pragma unroll
                    for (int k = 0; k < 16; ++k) CE_DESC(cl[k], x);
                }
            }
        }
        float sc[16]; int idv[16];
#pragma unroll
        for (int k = 0; k < 16; ++k) {
            sc[k] = key2f(cl[k] & ~255);
            const int pi = (cl[k] >> 4) & 15, pj = cl[k] & 15;
            int a = 0, b = 0;
#pragma unroll
            for (int i = 0; i < 16; ++i) { a = (pi == i) ? (l1[i] & 127) : a; b = (pj == i) ? (l2[i] & 127) : b; }
            idv[k] = a * 128 + b;
        }
        float e[16], sum = 0.f;
#pragma unroll
        for (int k = 0; k < 16; ++k) { e[k] = __expf(sc[k] - sc[0]); sum += e[k]; }
        const float inv = 1.0f / sum;
        int* ip = ids + (size_t)it * 16; float* gp = gw + (size_t)it * 16;
#pragma unroll
        for (int k = 0; k < 16; k += 4) {
            *(int4*)(ip + k) = make_int4(idv[k], idv[k + 1], idv[k + 2], idv[k + 3]);
            *(float4*)(gp + k) = make_float4(e[k] * inv, e[k + 1] * inv, e[k + 2] * inv, e[k + 3] * inv);
        }
    }
}

__device__ __forceinline__ float gelu_erf(float x);
constexpr int KPITCH = 272;
constexpr int R2_K_BYTES = 2 * 128 * KPITCH;
#define CE_MAXMIN(a, b) do { const int hi_ = max((a), (b)); const int lo_ = min((a), (b)); (a) = hi_; (b) = lo_; } while (0)
__device__ __forceinline__ void bitonic_merge16_desc(int (&a)[16]) {
#pragma unroll
    for (int js = 3; js >= 0; --js) {
#pragma unroll
        for (int i = 0; i < 16; ++i) { const int l = i ^ (1 << js); if (l > i) CE_MAXMIN(a[i], a[l]); }
    }
}
__device__ __forceinline__ void bitonic_sort16_desc(int (&a)[16]) {
#pragma unroll
    for (int ks = 1; ks <= 4; ++ks) {
#pragma unroll
        for (int js = ks - 1; js >= 0; --js) {
#pragma unroll
            for (int i = 0; i < 16; ++i) { const int l = i ^ (1 << js);
                if (l > i) { if ((i & (1 << ks)) == 0) CE_MAXMIN(a[i], a[l]); else CE_MAXMIN(a[l], a[i]); } }
        }
    }
}
__device__ __forceinline__ void merge_top16(int (&a)[16], const int (&b)[16]) {
#pragma unroll
    for (int i = 0; i < 16; ++i) a[i] = max(a[i], b[15 - i]);
    bitonic_merge16_desc(a);
}
__device__ __forceinline__ void route2_half(const bf16_t* __restrict__ qrow  , const LAS unsigned char* kl  , int hi, int (&L)[16]) {
    f32x16 acc[4];
#pragma unroll
    for (int kt = 0; kt < 4; ++kt)
#pragma unroll
        for (int r = 0; r < 16; ++r) acc[kt][r] = 0.f;
    bf16x8 qf[8];
#pragma unroll
    for (int s = 0; s < 8; ++s) qf[s] = *(const bf16x8*)(qrow + 16 * s);
#pragma unroll
    for (int s = 0; s < 8; ++s) {
#pragma unroll
        for (int kt = 0; kt < 4; ++kt) {
            const bf16x8 kf = *(const LAS bf16x8*)(kl + kt * 32 * KPITCH + 32 * s);
            acc[kt] = __builtin_amdgcn_mfma_f32_32x32x16_bf16(kf, qf[s], acc[kt], 0, 0, 0);
        }
    }
    int kk[4][16];
    const int hi4 = 4 * hi;
#pragma unroll
    for (int kt = 0; kt < 4; ++kt)
#pragma unroll
        for (int r = 0; r < 16; ++r) kk[kt][r] = (f2key(acc[kt][r]) & ~127) | ((32 * kt + (r & 3) + 8 * (r >> 2)) | hi4);
#pragma unroll
    for (int kt = 0; kt < 4; ++kt) bitonic_sort16_desc(kk[kt]);
    merge_top16(kk[0], kk[1]); merge_top16(kk[2], kk[3]); merge_top16(kk[0], kk[2]);
#pragma unroll
    for (int i = 0; i < 16; ++i) L[i] = max(kk[0][i], __shfl_xor(kk[0][15 - i], 32));
    bitonic_merge16_desc(L);
}

__device__ __forceinline__ void routing2_setup(const float* __restrict__ k1, const float* __restrict__ k2, LAS unsigned char* lds, int tid) {
    for (int e = tid; e < 2 * 8192; e += 512) {
        const int hf = e >> 13, o = (e & 8191) * 2, key = o >> 7, d = o & 127;
        const float* src = (hf ? k2 : k1) + o;
        *(LAS unsigned*)(lds + hf * 128 * KPITCH + key * KPITCH + d * 2) = cvtpk(src[0], src[1]);
    }
    __syncthreads();
}
__device__ __forceinline__ void routing2_units(const bf16_t* __restrict__ Q2, int* __restrict__ ids, float* __restrict__ gw,
                                               LAS unsigned char* lds, int wave, int lane, int gwave, int ngw) {
    LAS unsigned char* scr = lds + R2_K_BYTES + wave * 2048 + lane * 32;
    const int hi = lane >> 5, l31 = lane & 31;
    for (int u = (gwave < 0 ? wave : gwave); u < (gwave < 0 ? 32 : (T / 32) * 8); u += (gwave < 0 ? 8 : ngw)) {
        const int tb = gwave < 0 ? (int)blockIdx.x * 4 + (u >> 3) : (u >> 3), h = u & 7;
        const int t = tb * 32 + l31;
        const bf16_t* qrow = Q2 + (size_t)t * 2048 + h * 256 + 8 * hi;
        int l1[16], l2[16];
        route2_half(qrow, lds + l31 * KPITCH + 16 * hi, hi, l1);
        route2_half(qrow + 128, lds + 128 * KPITCH + l31 * KPITCH + 16 * hi, hi, l2);
#pragma unroll
        for (int i = 0; i < 16; i += 4) {
            *(LAS unsigned*)(scr + i) = (unsigned)(l1[i] & 127) | ((unsigned)(l1[i + 1] & 127) << 8) | ((unsigned)(l1[i + 2] & 127) << 16) | ((unsigned)(l1[i + 3] & 127) << 24);
            *(LAS unsigned*)(scr + 16 + i) = (unsigned)(l2[i] & 127) | ((unsigned)(l2[i + 1] & 127) << 8) | ((unsigned)(l2[i + 2] & 127) << 16) | ((unsigned)(l2[i + 3] & 127) << 24);
        }
        float f1[16], f2[16];
#pragma unroll
        for (int i = 0; i < 16; ++i) { f1[i] = key2f(l1[i] & ~127); f2[i] = key2f(l2[i] & ~127); }
        int cl[16];
#pragma unroll
        for (int j = 0; j < 16; ++j) cl[j] = (f2key(f1[0] + f2[j]) & ~255) | j;
#pragma unroll
        for (int i = 1; i < 16; ++i) {
#pragma unroll
            for (int j = 0; j < 16; ++j) {
                if ((i + 1) * (j + 1) <= 16) {
                    int x = (f2key(f1[i] + f2[j]) & ~255) | (i * 16 + j);
#pragma unroll
                    for (int k = 0; k < 16; ++k) CE_DESC(cl[k], x);
                }
            }
        }
        float e[16], sum = 0.f;
        const float mx = key2f(cl[0] & ~255);
#pragma unroll
        for (int k = 0; k < 16; ++k) { e[k] = __expf(key2f(cl[k] & ~255) - mx); sum += e[k]; }
        const float inv = 1.0f / sum;
        asm volatile("s_waitcnt lgkmcnt(0)" ::: "memory");
        int idv[8]; float gv[8];
#pragma unroll
        for (int k = 0; k < 8; ++k) {
            const int c = hi ? cl[8 + k] : cl[k];
            gv[k] = (hi ? e[8 + k] : e[k]) * inv;
            const int pi = (c >> 4) & 15, pj = c & 15;
            const int a = *(const LAS unsigned char*)(scr + pi), b = *(const LAS unsigned char*)(scr + 16 + pj);
            idv[k] = a * 128 + b;
        }
        int* ip = ids + ((size_t)t * 8 + h) * 16 + 8 * hi; float* gp = gw + ((size_t)t * 8 + h) * 16 + 8 * hi;
        *(int4*)(ip) = make_int4(idv[0], idv[1], idv[2], idv[3]); *(int4*)(ip + 4) = make_int4(idv[4], idv[5], idv[6], idv[7]);
        *(float4*)(gp) = make_float4(gv[0], gv[1], gv[2], gv[3]); *(float4*)(gp + 4) = make_float4(gv[4], gv[5], gv[6], gv[7]);
        asm volatile("s_waitcnt lgkmcnt(0)" ::: "memory");
    }
}

typedef __bf16 bf16x2v_t __attribute__((ext_vector_type(2)));
__device__ __forceinline__ float dot2(unsigned a, unsigned b, float acc) { return __builtin_amdgcn_fdot2_f32_bf16(__builtin_bit_cast(bf16x2v_t, a), __builtin_bit_cast(bf16x2v_t, b), acc, false); }
template <int CTRL> __device__ __forceinline__ float dpp_add(float v) { return v + __builtin_bit_cast(float, __builtin_amdgcn_update_dpp(0, __builtin_bit_cast(int, v), CTRL, 0xF, 0xF, true)); }
__device__ __forceinline__ float xor16_add(float v) { return v + __builtin_bit_cast(float, __builtin_amdgcn_ds_swizzle(__builtin_bit_cast(int, v), 0x401F)); }
__device__ __forceinline__ float xor32_add(float v) { return v + __shfl_xor(v, 32); }
constexpr int G2_WAVE_LDS = 4096 + 8192 + 128;

__device__ __forceinline__ void gather2_phase(float* __restrict__ H, bf16_t* __restrict__ HB, const float* __restrict__ ssq2p, float* __restrict__ ssq1,
                                              const bf16_t* __restrict__ U16, const bf16_t* __restrict__ V16, const int* __restrict__ ids, const float* __restrict__ gw,
                                              const float* __restrict__ final_g, int last, LAS unsigned char* lds, int wave, int gwave, int lane) {
    LAS unsigned char* wl = lds + wave * G2_WAVE_LDS;
    LAS unsigned short* idl = (LAS unsigned short*)wl;
    LAS float* al = (LAS float*)(wl + 4096);
    const int t0 = __builtin_amdgcn_readfirstlane(gwave * 16);
    const int g = lane >> 3, p = lane & 7;
    for (int tt = 0; tt < 16; ++tt) {
#pragma unroll
        for (int hf = 0; hf < 2; ++hf) { const int k = lane + 64 * hf; idl[tt * 128 + (k & 7) * 16 + (k >> 3)] = (unsigned short)ids[(size_t)(t0 + tt) * 128 + k]; }
    }
    for (int e = lane; e < 2048; e += 64) al[e] = 0.f;
    asm volatile("s_waitcnt lgkmcnt(0)" ::: "memory");
    const unsigned char* Ub = (const unsigned char*)U16; const unsigned char* Vb = (const unsigned char*)V16;
    for (int c = 0; c < 16; ++c) {
        for (int tt = 0; tt < 16; ++tt) {
            const u32x4 x4 = *(const u32x4*)(HB + (size_t)(t0 + tt) * DM + 64 * c + 8 * p);
            const u32x4 i0 = *(const LAS u32x4*)(idl + tt * 128 + g * 16), i1 = *(const LAS u32x4*)(idl + tt * 128 + g * 16 + 8);
            const unsigned idw[8] = {i0.x, i0.y, i0.z, i0.w, i1.x, i1.y, i1.z, i1.w};
            u32x4 u[16];
#pragma unroll
            for (int i = 0; i < 16; ++i) { const unsigned id = (i & 1) ? (idw[i >> 1] >> 16) : (idw[i >> 1] & 0xffffu);
                u[i] = *(const u32x4*)(Ub + (size_t)(id * 2048u + (unsigned)(c * 128 + p * 16))); }
            float a[16];
#pragma unroll
            for (int i = 0; i < 16; ++i) {
                float s = dot2(x4.x, u[i].x, 0.f); s = dot2(x4.y, u[i].y, s); s = dot2(x4.z, u[i].z, s); s = dot2(x4.w, u[i].w, s);
                s = dpp_add<0xB1>(s); s = dpp_add<0x4E>(s); s = dpp_add<0x141>(s);
                a[i] = s;
            }
            if (p == 0) {
                LAS float* ap = al + tt * 128 + g * 16;
#pragma unroll
                for (int i = 0; i < 16; ++i) (void)__hip_atomic_fetch_add(ap + i, a[i], __ATOMIC_RELAXED, __HIP_MEMORY_SCOPE_WORKGROUP);
            }
        }
    }
    asm volatile("s_waitcnt lgkmcnt(0)" ::: "memory");
    for (int n = 0; n < 32; ++n) {
        const int tt = n >> 1, pos = lane + 64 * (n & 1), k = 8 * (pos & 15) + (pos >> 4);
        const float rs2 = rsqrtf(ssq16(ssq2p, t0 + tt) * (1.0f / 1024.0f) + RMS_EPS);
        const float a = al[tt * 128 + pos] * rs2;
        al[tt * 128 + pos] = gw[(size_t)(t0 + tt) * 128 + k] * gelu_erf(a);
    }
    asm volatile("s_waitcnt lgkmcnt(0)" ::: "memory");
    for (int c = 0; c < 16; ++c) {
        for (int tt = 0; tt < 16; ++tt) {
            const LAS f32x4* wp = (const LAS f32x4*)(al + tt * 128 + g * 16);
            const f32x4 w0 = wp[0], w1 = wp[1], w2 = wp[2], w3 = wp[3];
            const float w[16] = {w0[0], w0[1], w0[2], w0[3], w1[0], w1[1], w1[2], w1[3], w2[0], w2[1], w2[2], w2[3], w3[0], w3[1], w3[2], w3[3]};
            const u32x4 i0 = *(const LAS u32x4*)(idl + tt * 128 + g * 16), i1 = *(const LAS u32x4*)(idl + tt * 128 + g * 16 + 8);
            const unsigned idw[8] = {i0.x, i0.y, i0.z, i0.w, i1.x, i1.y, i1.z, i1.w};
            u32x4 v[16];
#pragma unroll
            for (int i = 0; i < 16; ++i) { const unsigned id = (i & 1) ? (idw[i >> 1] >> 16) : (idw[i >> 1] & 0xffffu);
                v[i] = *(const u32x4*)(Vb + (size_t)(id * 2048u + (unsigned)(c * 128 + p * 16))); }
            float y[8];
#pragma unroll
            for (int j = 0; j < 8; ++j) y[j] = 0.f;
#pragma unroll
            for (int i = 0; i < 16; ++i) {
                y[0] = fmaf(w[i], bflo(v[i].x), y[0]); y[1] = fmaf(w[i], bfhi(v[i].x), y[1]); y[2] = fmaf(w[i], bflo(v[i].y), y[2]); y[3] = fmaf(w[i], bfhi(v[i].y), y[3]);
                y[4] = fmaf(w[i], bflo(v[i].z), y[4]); y[5] = fmaf(w[i], bfhi(v[i].z), y[5]); y[6] = fmaf(w[i], bflo(v[i].w), y[6]); y[7] = fmaf(w[i], bfhi(v[i].w), y[7]);
            }
#pragma unroll
            for (int j = 0; j < 8; ++j) { y[j] = dpp_add<0x128>(y[j]); y[j] = xor16_add(y[j]); y[j] = xor32_add(y[j]); }
            if (g == 0) {
                float* hp = H + (size_t)(t0 + tt) * DM + 64 * c + 8 * p;
                f32x4 h0 = *(const f32x4*)hp, h1 = *(const f32x4*)(hp + 4);
                h0 += (f32x4){y[0], y[1], y[2], y[3]}; h1 += (f32x4){y[4], y[5], y[6], y[7]};
                *(f32x4*)hp = h0; *(f32x4*)(hp + 4) = h1;
            }
        }
    }
    __builtin_amdgcn_fence(__ATOMIC_SEQ_CST, "agent");
    asm volatile("s_waitcnt vmcnt(0)" ::: "memory");
    for (int tt = 0; tt < 16; ++tt) {
        const int t = t0 + tt;
        float* hp = H + (size_t)t * DM + 8 * lane;
        f32x4 h0 = *(const f32x4*)hp, h1 = *(const f32x4*)(hp + 4), h2 = *(const f32x4*)(hp + 512), h3 = *(const f32x4*)(hp + 516);
        float ss = (h0[0] * h0[0] + h0[1] * h0[1]) + (h0[2] * h0[2] + h0[3] * h0[3]) + (h1[0] * h1[0] + h1[1] * h1[1]) + (h1[2] * h1[2] + h1[3] * h1[3])
                 + (h2[0] * h2[0] + h2[1] * h2[1]) + (h2[2] * h2[2] + h2[3] * h2[3]) + (h3[0] * h3[0] + h3[1] * h3[1]) + (h3[2] * h3[2] + h3[3] * h3[3]);
        ss = wave_sum(ss);
        if (last) {
            const float rs = rsqrtf(ss * (1.0f / 1024.0f) + RMS_EPS);
            const f32x4 g0 = *(const f32x4*)(final_g + 8 * lane), g1 = *(const f32x4*)(final_g + 8 * lane + 4), g2 = *(const f32x4*)(final_g + 512 + 8 * lane), g3 = *(const f32x4*)(final_g + 516 + 8 * lane);
            h0 = h0 * rs * g0; h1 = h1 * rs * g1; h2 = h2 * rs * g2; h3 = h3 * rs * g3;
            *(f32x4*)hp = h0; *(f32x4*)(hp + 4) = h1; *(f32x4*)(hp + 512) = h2; *(f32x4*)(hp + 516) = h3;
        } else {
            bf16_t* bp = HB + (size_t)t * DM + 8 * lane;
            u32x4 w; w.x = cvtpk(h0[0], h0[1]); w.y = cvtpk(h0[2], h0[3]); w.z = cvtpk(h1[0], h1[1]); w.w = cvtpk(h1[2], h1[3]);
            *(u32x4*)bp = w;
            w.x = cvtpk(h2[0], h2[1]); w.y = cvtpk(h2[2], h2[3]); w.z = cvtpk(h3[0], h3[1]); w.w = cvtpk(h3[2], h3[3]);
            *(u32x4*)(bp + 512) = w;
            if (lane == 0) ssq1[t] = ss;
        }
    }
}

#ifndef G3_UMFMA
#define G3_UMFMA 0
#endif
#ifndef G3_VF16
#define G3_VF16 1
#endif
typedef _Float16 f16x2_t __attribute__((ext_vector_type(2)));
__device__ __forceinline__ unsigned cvtpk_h(float lo, float hi) { f16x2_t v = {(_Float16)lo, (_Float16)hi}; return __builtin_bit_cast(unsigned, v); }
__device__ __forceinline__ void fma_mix_lo(float& y, float w, unsigned pk) { asm("v_fma_mix_f32 %0, %1, %2, %0 op_sel_hi:[0,1,0]" : "+v"(y) : "v"(w), "v"(pk)); }
__device__ __forceinline__ void fma_mix_hi(float& y, float w, unsigned pk) { asm("v_fma_mix_f32 %0, %1, %2, %0 op_sel:[0,1,0] op_sel_hi:[0,1,0]" : "+v"(y) : "v"(w), "v"(pk)); }
__device__ __forceinline__ float swap32_add(float a, float b) {
    const auto r = __builtin_amdgcn_permlane32_swap(__float_as_uint(a), __float_as_uint(b), false, false);
    return __uint_as_float(r[0]) + __uint_as_float(r[1]);
}

__device__ __forceinline__ void gather3_phase(float* __restrict__ H, bf16_t* __restrict__ HB, const float* __restrict__ ssq2p, float* __restrict__ ssq1,
                                              const bf16_t* __restrict__ U16, const unsigned short* __restrict__ V16h, const int* __restrict__ ids, const float* __restrict__ gw,
                                              const float* __restrict__ final_g, int last, LAS unsigned char* lds, int wave, int gwave, int lane) {
    LAS unsigned char* wl = lds + wave * G2_WAVE_LDS;
    LAS unsigned short* idl = (LAS unsigned short*)wl;
    LAS float* al = (LAS float*)(wl + 4096);
    const int t0 = __builtin_amdgcn_readfirstlane(gwave * 16);
    for (int tt = 0; tt < 16; ++tt) {
        idl[tt * 128 + lane] = (unsigned short)ids[(size_t)(t0 + tt) * 128 + lane];
        idl[tt * 128 + 64 + lane] = (unsigned short)ids[(size_t)(t0 + tt) * 128 + 64 + lane];
    }
    for (int e = lane; e < 2048; e += 64) al[e] = 0.f;
    asm volatile("s_waitcnt lgkmcnt(0)" ::: "memory");
    const unsigned char* Ub = (const unsigned char*)U16; const unsigned char* Vb = (const unsigned char*)V16h;
#if G3_UMFMA
    {
        const int e = lane & 15, q = lane >> 4;
        for (int c = 0; c < 16; ++c) {
            for (int tt = 0; tt < 16; ++tt) {
                const bf16_t* xp = HB + (size_t)(t0 + tt) * DM + 64 * c + 8 * q;
                const bf16x8 xa = *(const bf16x8*)xp, xb = *(const bf16x8*)(xp + 32);
                const u32x4 iv = *(const LAS u32x4*)(idl + tt * 128 + 8 * e);
                const unsigned idw[4] = {iv.x, iv.y, iv.z, iv.w};
                bf16x8 ua[8], ub[8];
#pragma unroll
                for (int gi = 0; gi < 8; ++gi) { const unsigned id = (gi & 1) ? (idw[gi >> 1] >> 16) : (idw[gi >> 1] & 0xffffu);
                    const unsigned char* up = Ub + (size_t)(id * 2048u + (unsigned)(c * 128 + q * 16));
                    ua[gi] = *(const bf16x8*)up; ub[gi] = *(const bf16x8*)(up + 64); }
                float r[8];
#pragma unroll
                for (int gi = 0; gi < 8; ++gi) {
                    f32x4 acc = {0.f, 0.f, 0.f, 0.f};
                    acc = __builtin_amdgcn_mfma_f32_16x16x32_bf16(xa, ua[gi], acc, 0, 0, 0);
                    acc = __builtin_amdgcn_mfma_f32_16x16x32_bf16(xb, ub[gi], acc, 0, 0, 0);
                    r[gi] = acc[0];
                }
                if (q == 0) {
                    LAS float* ap = al + tt * 128 + 8 * e;
#pragma unroll
                    for (int gi = 0; gi < 8; ++gi) (void)__hip_atomic_fetch_add(ap + gi, r[gi], __ATOMIC_RELAXED, __HIP_MEMORY_SCOPE_WORKGROUP);
                }
            }
        }
    }
#else
    {
        const int g = lane >> 3, p = lane & 7;
        for (int c = 0; c < 16; ++c) {
            for (int tt = 0; tt < 16; ++tt) {
                const u32x4 x4 = *(const u32x4*)(HB + (size_t)(t0 + tt) * DM + 64 * c + 8 * p);
                const u32x4 i0 = *(const LAS u32x4*)(idl + tt * 128 + g * 16), i1 = *(const LAS u32x4*)(idl + tt * 128 + g * 16 + 8);
                const unsigned idw[8] = {i0.x, i0.y, i0.z, i0.w, i1.x, i1.y, i1.z, i1.w};
                u32x4 u[16];
#pragma unroll
                for (int i = 0; i < 16; ++i) { const unsigned id = (i & 1) ? (idw[i >> 1] >> 16) : (idw[i >> 1] & 0xffffu);
                    u[i] = *(const u32x4*)(Ub + (size_t)(id * 2048u + (unsigned)(c * 128 + p * 16))); }
                float a[16];
#pragma unroll
                for (int i = 0; i < 16; ++i) {
                    float s_ = dot2(x4.x, u[i].x, 0.f); s_ = dot2(x4.y, u[i].y, s_); s_ = dot2(x4.z, u[i].z, s_); s_ = dot2(x4.w, u[i].w, s_);
                    s_ = dpp_add<0xB1>(s_); s_ = dpp_add<0x4E>(s_); s_ = dpp_add<0x141>(s_);
                    a[i] = s_;
                }
                if (p == 0) {
                    LAS float* ap = al + tt * 128 + g * 16;
#pragma unroll
                    for (int i = 0; i < 16; ++i) (void)__hip_atomic_fetch_add(ap + i, a[i], __ATOMIC_RELAXED, __HIP_MEMORY_SCOPE_WORKGROUP);
                }
            }
        }
    }
#endif
    asm volatile("s_waitcnt lgkmcnt(0)" ::: "memory");
    for (int n = 0; n < 32; ++n) {
        const int tt = n >> 1, k = lane + 64 * (n & 1);
        const float rs2 = rsqrtf(ssq16(ssq2p, t0 + tt) * (1.0f / 1024.0f) + RMS_EPS);
        const float a = al[tt * 128 + k] * rs2;
        al[tt * 128 + k] = gw[(size_t)(t0 + tt) * 128 + k] * gelu_erf(a);
    }
    asm volatile("s_waitcnt lgkmcnt(0)" ::: "memory");
    {
        const int g = lane >> 3, p = lane & 7;
        for (int c = 0; c < 16; ++c) {
            for (int tt = 0; tt < 16; ++tt) {
                const LAS f32x4* wp = (const LAS f32x4*)(al + tt * 128 + g * 16);
                const f32x4 w0 = wp[0], w1 = wp[1], w2 = wp[2], w3 = wp[3];
                const float w[16] = {w0[0], w0[1], w0[2], w0[3], w1[0], w1[1], w1[2], w1[3], w2[0], w2[1], w2[2], w2[3], w3[0], w3[1], w3[2], w3[3]};
                const u32x4 i0 = *(const LAS u32x4*)(idl + tt * 128 + g * 16), i1 = *(const LAS u32x4*)(idl + tt * 128 + g * 16 + 8);
                const unsigned idw[8] = {i0.x, i0.y, i0.z, i0.w, i1.x, i1.y, i1.z, i1.w};
                u32x4 v[16];
#pragma unroll
                for (int i = 0; i < 16; ++i) { const unsigned id = (i & 1) ? (idw[i >> 1] >> 16) : (idw[i >> 1] & 0xffffu);
                    v[i] = *(const u32x4*)(Vb + (size_t)(id * 2048u + (unsigned)(c * 128 + p * 16))); }
                float y[8];
#pragma unroll
                for (int j = 0; j < 8; ++j) y[j] = 0.f;
#pragma unroll
                for (int i = 0; i < 16; ++i) {
#if G3_VF16
                    fma_mix_lo(y[0], w[i], v[i].x); fma_mix_hi(y[1], w[i], v[i].x); fma_mix_lo(y[2], w[i], v[i].y); fma_mix_hi(y[3], w[i], v[i].y);
                    fma_mix_lo(y[4], w[i], v[i].z); fma_mix_hi(y[5], w[i], v[i].z); fma_mix_lo(y[6], w[i], v[i].w); fma_mix_hi(y[7], w[i], v[i].w);
#else
                    y[0] = fmaf(w[i], bflo(v[i].x), y[0]); y[1] = fmaf(w[i], bfhi(v[i].x), y[1]); y[2] = fmaf(w[i], bflo(v[i].y), y[2]); y[3] = fmaf(w[i], bfhi(v[i].y), y[3]);
                    y[4] = fmaf(w[i], bflo(v[i].z), y[4]); y[5] = fmaf(w[i], bfhi(v[i].z), y[5]); y[6] = fmaf(w[i], bflo(v[i].w), y[6]); y[7] = fmaf(w[i], bfhi(v[i].w), y[7]);
#endif
                }
                float z[4];
#pragma unroll
                for (int j = 0; j < 4; ++j) { z[j] = swap32_add(y[j], y[j + 4]); z[j] = xor16_add(z[j]); z[j] = dpp_add<0x128>(z[j]); }
                if ((lane & 0x18) == 0) {
                    float* hp = H + (size_t)(t0 + tt) * DM + 64 * c + 8 * p + 4 * (lane >> 5);
                    f32x4 h0 = *(const f32x4*)hp;
                    h0 += (f32x4){z[0], z[1], z[2], z[3]};
                    *(f32x4*)hp = h0;
                }
            }
        }
    }
    __builtin_amdgcn_fence(__ATOMIC_SEQ_CST, "agent");
    asm volatile("s_waitcnt vmcnt(0)" ::: "memory");
    for (int tt = 0; tt < 16; ++tt) {
        const int t = t0 + tt;
        float* hp = H + (size_t)t * DM + 8 * lane;
        f32x4 h0 = *(const f32x4*)hp, h1 = *(const f32x4*)(hp + 4), h2 = *(const f32x4*)(hp + 512), h3 = *(const f32x4*)(hp + 516);
        float ss = (h0[0] * h0[0] + h0[1] * h0[1]) + (h0[2] * h0[2] + h0[3] * h0[3]) + (h1[0] * h1[0] + h1[1] * h1[1]) + (h1[2] * h1[2] + h1[3] * h1[3])
                 + (h2[0] * h2[0] + h2[1] * h2[1]) + (h2[2] * h2[2] + h2[3] * h2[3]) + (h3[0] * h3[0] + h3[1] * h3[1]) + (h3[2] * h3[2] + h3[3] * h3[3]);
        ss = wave_sum(ss);
        if (last) {
            const float rs = rsqrtf(ss * (1.0f / 1024.0f) + RMS_EPS);
            const f32x4 g0 = *(const f32x4*)(final_g + 8 * lane), g1 = *(const f32x4*)(final_g + 8 * lane + 4), g2 = *(const f32x4*)(final_g + 512 + 8 * lane), g3 = *(const f32x4*)(final_g + 516 + 8 * lane);
            h0 = h0 * rs * g0; h1 = h1 * rs * g1; h2 = h2 * rs * g2; h3 = h3 * rs * g3;
            *(f32x4*)hp = h0; *(f32x4*)(hp + 4) = h1; *(f32x4*)(hp + 512) = h2; *(f32x4*)(hp + 516) = h3;
        } else {
            bf16_t* bp = HB + (size_t)t * DM + 8 * lane;
            u32x4 w; w.x = cvtpk(h0[0], h0[1]); w.y = cvtpk(h0[2], h0[3]); w.z = cvtpk(h1[0], h1[1]); w.w = cvtpk(h1[2], h1[3]);
            *(u32x4*)bp = w;
            w.x = cvtpk(h2[0], h2[1]); w.y = cvtpk(h2[2], h2[3]); w.z = cvtpk(h3[0], h3[1]); w.w = cvtpk(h3[2], h3[3]);
            *(u32x4*)(bp + 512) = w;
            if (lane == 0) ssq1[t] = ss;
        }
    }
}

typedef float f32x2v __attribute__((ext_vector_type(2)));
constexpr float FP8_MAX = 448.0f;

__device__ __forceinline__ void quant_row_fp8(const float* __restrict__ src, const float* __restrict__ colscale, unsigned char* __restrict__ dst, float* __restrict__ scale_out, int lane) {
    f32x4 v[4]; float am = 0.f;
#pragma unroll
    for (int j = 0; j < 4; ++j) {
        v[j] = *(const f32x4*)(src + 4 * (lane + 64 * j));
        if (colscale) v[j] = v[j] * *(const f32x4*)(colscale + 4 * (lane + 64 * j));
        am = fmaxf(am, fmaxf(fmaxf(fabsf(v[j][0]), fabsf(v[j][1])), fmaxf(fabsf(v[j][2]), fabsf(v[j][3]))));
    }
#pragma unroll
    for (int o = 1; o < 64; o <<= 1) am = fmaxf(am, __shfl_xor(am, o));
    const float inv = am > 0.f ? FP8_MAX / am : 1.0f;
#pragma unroll
    for (int j = 0; j < 4; ++j) {
        int w = 0;
        w = __builtin_amdgcn_cvt_pk_fp8_f32(v[j][0] * inv, v[j][1] * inv, w, false);
        w = __builtin_amdgcn_cvt_pk_fp8_f32(v[j][2] * inv, v[j][3] * inv, w, true);
        *(int*)(dst + 4 * (lane + 64 * j)) = w;
    }
    if (lane == 0) *scale_out = am > 0.f ? am / FP8_MAX : 1.0f;
}

__device__ __forceinline__ float dot2v(bf16x2v_t a, unsigned b, float acc) { return __builtin_amdgcn_fdot2_f32_bf16(a, __builtin_bit_cast(bf16x2v_t, b), acc, false); }
__device__ __forceinline__ void g4_issue(u32x4 (&buf)[16], const unsigned char* __restrict__ tab, const LAS unsigned short* idl, int it, int g, int p) {
    const int tt = it & 15, c = it >> 4;
    const u32x4 i0 = *(const LAS u32x4*)(idl + tt * 128 + g * 16), i1 = *(const LAS u32x4*)(idl + tt * 128 + g * 16 + 8);
    const unsigned idw[8] = {i0.x, i0.y, i0.z, i0.w, i1.x, i1.y, i1.z, i1.w};
    const unsigned char* base = tab + (c * 128 + p * 16);
#pragma unroll
    for (int i = 0; i < 16; ++i) { const unsigned id = (i & 1) ? (idw[i >> 1] >> 16) : (idw[i >> 1] & 0xffffu);
        buf[i] = *(const u32x4*)(base + (size_t)(id * 1024u)); }
}
__device__ __forceinline__ void g4_xload(u32x4 (&x)[2], const bf16_t* __restrict__ HB, int t0, int it, int p) {
    const bf16_t* xp = HB + (size_t)(t0 + (it & 15)) * DM + 128 * (it >> 4) + 16 * p;
    x[0] = *(const u32x4*)xp; x[1] = *(const u32x4*)(xp + 8);
}
#define G4_CVT(wd, hi_) __builtin_amdgcn_cvt_scalef32_pk_bf16_fp8((wd), 1.0f, (hi_))
__device__ __forceinline__ void g4_ucompute(const u32x4 (&u)[16], const u32x4 (&x)[2], LAS float* ap, int p) {
    const unsigned xw[8] = {x[0].x, x[0].y, x[0].z, x[0].w, x[1].x, x[1].y, x[1].z, x[1].w};
    float a[16];
#pragma unroll
    for (int i0 = 0; i0 < 16; i0 += 8) {
        float s_[8];
#pragma unroll
        for (int e = 0; e < 8; ++e) s_[e] = 0.f;
#pragma unroll
        for (int q = 0; q < 4; ++q) {
#pragma unroll
            for (int e = 0; e < 8; ++e) { const unsigned wd = (q == 0) ? u[i0 + e].x : (q == 1) ? u[i0 + e].y : (q == 2) ? u[i0 + e].z : u[i0 + e].w;
                s_[e] = dot2v(G4_CVT(wd, false), xw[2 * q], s_[e]); }
#pragma unroll
            for (int e = 0; e < 8; ++e) { const unsigned wd = (q == 0) ? u[i0 + e].x : (q == 1) ? u[i0 + e].y : (q == 2) ? u[i0 + e].z : u[i0 + e].w;
                s_[e] = dot2v(G4_CVT(wd, true), xw[2 * q + 1], s_[e]); }
        }
#pragma unroll
        for (int e = 0; e < 8; ++e) s_[e] = dpp_add<0xB1>(s_[e]);
#pragma unroll
        for (int e = 0; e < 8; ++e) s_[e] = dpp_add<0x4E>(s_[e]);
#pragma unroll
        for (int e = 0; e < 8; ++e) a[i0 + e] = dpp_add<0x141>(s_[e]);
    }
    if (p == 0) {
#pragma unroll
        for (int i = 0; i < 16; ++i) (void)__hip_atomic_fetch_add(ap + i, a[i], __ATOMIC_RELAXED, __HIP_MEMORY_SCOPE_WORKGROUP);
    }
}
__device__ __forceinline__ void g4_vcompute(const u32x4 (&v)[16], const LAS float* wsrc, float* __restrict__ hp, int lane, int dry) {
    const LAS f32x4* wp = (const LAS f32x4*)wsrc;
    const f32x4 w0 = wp[0], w1 = wp[1], w2 = wp[2], w3 = wp[3];
    const float w[16] = {w0[0], w0[1], w0[2], w0[3], w1[0], w1[1], w1[2], w1[3], w2[0], w2[1], w2[2], w2[3], w3[0], w3[1], w3[2], w3[3]};
    float yy[16];
#pragma unroll
    for (int j = 0; j < 16; ++j) yy[j] = 0.f;
#pragma unroll
    for (int i = 0; i < 16; ++i) {
        const unsigned vw[4] = {v[i].x, v[i].y, v[i].z, v[i].w};
#pragma unroll
        for (int q = 0; q < 4; ++q) {
            const f32x2v lo = __builtin_amdgcn_cvt_pk_f32_fp8((int)vw[q], false), hi = __builtin_amdgcn_cvt_pk_f32_fp8((int)vw[q], true);
            yy[4 * q] = fmaf(w[i], lo.x, yy[4 * q]); yy[4 * q + 1] = fmaf(w[i], lo.y, yy[4 * q + 1]); yy[4 * q + 2] = fmaf(w[i], hi.x, yy[4 * q + 2]); yy[4 * q + 3] = fmaf(w[i], hi.y, yy[4 * q + 3]);
        }
    }
    f32x2v y[8];
#pragma unroll
    for (int j = 0; j < 8; ++j) y[j] = (f32x2v){yy[2 * j], yy[2 * j + 1]};
    float z[8];
#pragma unroll
    for (int j = 0; j < 4; ++j) { z[2 * j] = swap32_add(y[j].x, y[j + 4].x); z[2 * j + 1] = swap32_add(y[j].y, y[j + 4].y); }
#pragma unroll
    for (int j = 0; j < 8; ++j) { z[j] = xor16_add(z[j]); z[j] = dpp_add<0x128>(z[j]); }
    if ((lane & 0x18) == 0 && !(dry && z[0] * z[0] >= 0.f)) {
        f32x4 h0 = *(const f32x4*)hp, h1 = *(const f32x4*)(hp + 4);
        h0 += (f32x4){z[0], z[1], z[2], z[3]}; h1 += (f32x4){z[4], z[5], z[6], z[7]};
        *(f32x4*)hp = h0; *(f32x4*)(hp + 4) = h1;
    }
}

__device__ __forceinline__ void gather4_phase(float* __restrict__ H, bf16_t* __restrict__ HB, const float* __restrict__ ssq2p, float* __restrict__ ssq1,
                                              const unsigned char* __restrict__ U8, const unsigned char* __restrict__ V8, const float* __restrict__ su, const float* __restrict__ sv,
                                              const int* __restrict__ ids, const float* __restrict__ gw,
                                              const float* __restrict__ final_g, int last, LAS unsigned char* lds, int wave, int gwave, int lane, int dry = 0, int idmask = 0xffff) {
    LAS unsigned char* wl = lds + wave * G2_WAVE_LDS;
    LAS unsigned short* idl = (LAS unsigned short*)wl;
    LAS float* al = (LAS float*)(wl + 4096);
    const int t0 = __builtin_amdgcn_readfirstlane(gwave * 16);
    for (int tt = 0; tt < 16; ++tt) {
        idl[tt * 128 + lane] = (unsigned short)(ids[(size_t)(t0 + tt) * 128 + lane] & idmask);
        idl[tt * 128 + 64 + lane] = (unsigned short)(ids[(size_t)(t0 + tt) * 128 + 64 + lane] & idmask);
    }
    for (int e = lane; e < 2048; e += 64) al[e] = 0.f;
    asm volatile("s_waitcnt lgkmcnt(0)" ::: "memory");
    const int g = lane >> 3, p = lane & 7;
    if (!(dry & 2)) {
        u32x4 uA[16], uB[16], xA[2], xB[2];
        g4_issue(uA, U8, idl, 0, g, p);
        g4_xload(xA, HB, t0, 0, p);
        for (int it = 0; it < 128; it += 2) {
            g4_issue(uB, U8, idl, it + 1, g, p); g4_xload(xB, HB, t0, it + 1, p);
            g4_ucompute(uA, xA, al + (it & 15) * 128 + g * 16, p);
            if (it + 2 < 128) { g4_issue(uA, U8, idl, it + 2, g, p); g4_xload(xA, HB, t0, it + 2, p); }
            g4_ucompute(uB, xB, al + ((it + 1) & 15) * 128 + g * 16, p);
        }
    }
    asm volatile("s_waitcnt lgkmcnt(0)" ::: "memory");
    for (int n = 0; n < 32; ++n) {
        const int tt = n >> 1, k = lane + 64 * (n & 1);
        const float rs2 = rsqrtf(ssq16(ssq2p, t0 + tt) * (1.0f / 1024.0f) + RMS_EPS);
        const int id = idl[tt * 128 + k];
        const float a = al[tt * 128 + k] * rs2 * su[id];
        al[tt * 128 + k] = gw[(size_t)(t0 + tt) * 128 + k] * gelu_erf(a) * sv[id];
    }
    asm volatile("s_waitcnt lgkmcnt(0)" ::: "memory");
    if (!(dry & 4)) {
        u32x4 vA[16], vB[16];
        g4_issue(vA, V8, idl, 0, g, p);
        for (int it = 0; it < 128; it += 2) {
            g4_issue(vB, V8, idl, it + 1, g, p);
            g4_vcompute(vA, al + (it & 15) * 128 + g * 16, H + (size_t)(t0 + (it & 15)) * DM + 128 * (it >> 4) + 16 * p + 8 * (lane >> 5), lane, dry);
            if (it + 2 < 128) g4_issue(vA, V8, idl, it + 2, g, p);
            g4_vcompute(vB, al + ((it + 1) & 15) * 128 + g * 16, H + (size_t)(t0 + ((it + 1) & 15)) * DM + 128 * ((it + 1) >> 4) + 16 * p + 8 * (lane >> 5), lane, dry);
        }
    }
    if (dry) return;
    __builtin_amdgcn_fence(__ATOMIC_SEQ_CST, "agent");
    asm volatile("s_waitcnt vmcnt(0)" ::: "memory");
    for (int tt = 0; tt < 16; ++tt) {
        const int t = t0 + tt;
        float* hp = H + (size_t)t * DM + 8 * lane;
        f32x4 h0 = *(const f32x4*)hp, h1 = *(const f32x4*)(hp + 4), h2 = *(const f32x4*)(hp + 512), h3 = *(const f32x4*)(hp + 516);
        float ss = (h0[0] * h0[0] + h0[1] * h0[1]) + (h0[2] * h0[2] + h0[3] * h0[3]) + (h1[0] * h1[0] + h1[1] * h1[1]) + (h1[2] * h1[2] + h1[3] * h1[3])
                 + (h2[0] * h2[0] + h2[1] * h2[1]) + (h2[2] * h2[2] + h2[3] * h2[3]) + (h3[0] * h3[0] + h3[1] * h3[1]) + (h3[2] * h3[2] + h3[3] * h3[3]);
        ss = wave_sum(ss);
        if (last) {
            const float rs = rsqrtf(ss * (1.0f / 1024.0f) + RMS_EPS);
            const f32x4 g0 = *(const f32x4*)(final_g + 8 * lane), g1 = *(const f32x4*)(final_g + 8 * lane + 4), g2 = *(const f32x4*)(final_g + 512 + 8 * lane), g3 = *(const f32x4*)(final_g + 516 + 8 * lane);
            h0 = h0 * rs * g0; h1 = h1 * rs * g1; h2 = h2 * rs * g2; h3 = h3 * rs * g3;
            *(f32x4*)hp = h0; *(f32x4*)(hp + 4) = h1; *(f32x4*)(hp + 512) = h2; *(f32x4*)(hp + 516) = h3;
        } else {
            bf16_t* bp = HB + (size_t)t * DM + 8 * lane;
            u32x4 w; w.x = cvtpk(h0[0], h0[1]); w.y = cvtpk(h0[2], h0[3]); w.z = cvtpk(h1[0], h1[1]); w.w = cvtpk(h1[2], h1[3]);
            *(u32x4*)bp = w;
            w.x = cvtpk(h2[0], h2[1]); w.y = cvtpk(h2[2], h2[3]); w.z = cvtpk(h3[0], h3[1]); w.w = cvtpk(h3[2], h3[3]);
            *(u32x4*)(bp + 512) = w;
            if (lane == 0) ssq1[t] = ss;
        }
    }
}

__device__ __forceinline__ void quant_row_i8(const float* __restrict__ src, const float* __restrict__ colscale, unsigned char* __restrict__ dst, float* __restrict__ scale_out, int bias, int lane) {
    f32x4 v[4]; float am = 0.f;
#pragma unroll
    for (int j = 0; j < 4; ++j) {
        v[j] = *(const f32x4*)(src + 4 * (lane + 64 * j));
        if (colscale) v[j] = v[j] * *(const f32x4*)(colscale + 4 * (lane + 64 * j));
        am = fmaxf(am, fmaxf(fmaxf(fabsf(v[j][0]), fabsf(v[j][1])), fmaxf(fabsf(v[j][2]), fabsf(v[j][3]))));
    }
#pragma unroll
    for (int o = 1; o < 64; o <<= 1) am = fmaxf(am, __shfl_xor(am, o));
    const float inv = am > 0.f ? 127.0f / am : 0.f;
#pragma unroll
    for (int j = 0; j < 4; ++j) {
        const int q0 = (int)rintf(v[j][0] * inv) + bias, q1 = (int)rintf(v[j][1] * inv) + bias, q2 = (int)rintf(v[j][2] * inv) + bias, q3 = (int)rintf(v[j][3] * inv) + bias;
        *(unsigned*)(dst + 4 * (lane + 64 * j)) = (unsigned)(q0 & 255) | ((unsigned)(q1 & 255) << 8) | ((unsigned)(q2 & 255) << 16) | ((unsigned)(q3 & 255) << 24);
    }
    if (lane == 0) *scale_out = am > 0.f ? am / 127.0f : 0.f;
}
template <int CTRL> __device__ __forceinline__ int dpp_addi(int v) { return v + __builtin_amdgcn_update_dpp(0, v, CTRL, 0xF, 0xF, true); }
__device__ __forceinline__ void g5_ucompute(const u32x4 (&u)[16], const u32x4& x, LAS int* ap, int p) {
    int a[16];
#pragma unroll
    for (int i = 0; i < 16; ++i) {
        int s_ = __builtin_amdgcn_sdot4((int)u[i].x, (int)x.x, 0, false);
        s_ = __builtin_amdgcn_sdot4((int)u[i].y, (int)x.y, s_, false);
        s_ = __builtin_amdgcn_sdot4((int)u[i].z, (int)x.z, s_, false);
        s_ = __builtin_amdgcn_sdot4((int)u[i].w, (int)x.w, s_, false);
        a[i] = s_;
    }
#pragma unroll
    for (int i = 0; i < 16; ++i) a[i] = dpp_addi<0xB1>(a[i]);
#pragma unroll
    for (int i = 0; i < 16; ++i) a[i] = dpp_addi<0x4E>(a[i]);
    if ((p & 3) == 0) {
#pragma unroll
        for (int i = 0; i < 16; ++i) (void)__hip_atomic_fetch_add(ap + i, a[i], __ATOMIC_RELAXED, __HIP_MEMORY_SCOPE_WORKGROUP);
    }
}
__device__ __forceinline__ void g5_vcompute(const u32x4 (&v)[16], const LAS float* wsrc, float* __restrict__ hp, int lane, int dry) {
    const LAS f32x4* wp = (const LAS f32x4*)wsrc;
    const f32x4 w0 = wp[0], w1 = wp[1], w2 = wp[2], w3 = wp[3];
    const float w[16] = {w0[0], w0[1], w0[2], w0[3], w1[0], w1[1], w1[2], w1[3], w2[0], w2[1], w2[2], w2[3], w3[0], w3[1], w3[2], w3[3]};
    float wsum = ((w[0] + w[1]) + (w[2] + w[3])) + ((w[4] + w[5]) + (w[6] + w[7])) + (((w[8] + w[9]) + (w[10] + w[11])) + ((w[12] + w[13]) + (w[14] + w[15])));
    float yy[16];
    const float y0 = -1152.0f * wsum;
#pragma unroll
    for (int j = 0; j < 16; ++j) yy[j] = y0;
#pragma unroll
    for (int i = 0; i < 16; ++i) {
        const unsigned vw[4] = {v[i].x, v[i].y, v[i].z, v[i].w};
#pragma unroll
        for (int q = 0; q < 4; ++q) {
            const unsigned lo = __builtin_amdgcn_perm(vw[q], 0x64646464u, 0x00050004u), hi = __builtin_amdgcn_perm(vw[q], 0x64646464u, 0x00070006u);
            fma_mix_lo(yy[4 * q], w[i], lo); fma_mix_hi(yy[4 * q + 1], w[i], lo); fma_mix_lo(yy[4 * q + 2], w[i], hi); fma_mix_hi(yy[4 * q + 3], w[i], hi);
        }
    }
    float z[8];
#pragma unroll
    for (int j = 0; j < 8; ++j) z[j] = swap32_add(yy[j], yy[j + 8]);
#pragma unroll
    for (int j = 0; j < 8; ++j) { z[j] = xor16_add(z[j]); z[j] = dpp_add<0x128>(z[j]); }
    if ((lane & 0x18) == 0 && !(dry && z[0] * z[0] >= 0.f)) {
        f32x4 h0 = *(const f32x4*)hp, h1 = *(const f32x4*)(hp + 4);
        h0 += (f32x4){z[0], z[1], z[2], z[3]}; h1 += (f32x4){z[4], z[5], z[6], z[7]};
        *(f32x4*)hp = h0; *(f32x4*)(hp + 4) = h1;
    }
}
#ifndef G5_VDOT4
#define G5_VDOT4 1
#endif
__device__ __forceinline__ void g6_vcompute(const u32x4 (&v)[16], const LAS unsigned char* w8src, float sw, float* __restrict__ hp, int lane, int dry, bf16_t* __restrict__ hbp, LAS float* sspart) {
    const u32x4 w4 = *(const LAS u32x4*)w8src;
    const unsigned ww[4] = {w4.x, w4.y, w4.z, w4.w};
    int yy[16];
#pragma unroll
    for (int j = 0; j < 16; ++j) yy[j] = 0;
#pragma unroll
    for (int a = 0; a < 4; ++a) {
#pragma unroll
        for (int q = 0; q < 4; ++q) {
            const unsigned r0 = (q == 0) ? v[4 * a].x : (q == 1) ? v[4 * a].y : (q == 2) ? v[4 * a].z : v[4 * a].w;
            const unsigned r1 = (q == 0) ? v[4 * a + 1].x : (q == 1) ? v[4 * a + 1].y : (q == 2) ? v[4 * a + 1].z : v[4 * a + 1].w;
            const unsigned r2 = (q == 0) ? v[4 * a + 2].x : (q == 1) ? v[4 * a + 2].y : (q == 2) ? v[4 * a + 2].z : v[4 * a + 2].w;
            const unsigned r3 = (q == 0) ? v[4 * a + 3].x : (q == 1) ? v[4 * a + 3].y : (q == 2) ? v[4 * a + 3].z : v[4 * a + 3].w;
            const unsigned lo01 = __builtin_amdgcn_perm(r1, r0, 0x05010400u), hi01 = __builtin_amdgcn_perm(r1, r0, 0x07030602u);
            const unsigned lo23 = __builtin_amdgcn_perm(r3, r2, 0x05010400u), hi23 = __builtin_amdgcn_perm(r3, r2, 0x07030602u);
            const unsigned c0 = __builtin_amdgcn_perm(lo23, lo01, 0x05040100u), c1 = __builtin_amdgcn_perm(lo23, lo01, 0x07060302u);
            const unsigned c2 = __builtin_amdgcn_perm(hi23, hi01, 0x05040100u), c3 = __builtin_amdgcn_perm(hi23, hi01, 0x07060302u);
            yy[4 * q] = __builtin_amdgcn_sdot4((int)c0, (int)ww[a], yy[4 * q], false); yy[4 * q + 1] = __builtin_amdgcn_sdot4((int)c1, (int)ww[a], yy[4 * q + 1], false);
            yy[4 * q + 2] = __builtin_amdgcn_sdot4((int)c2, (int)ww[a], yy[4 * q + 2], false); yy[4 * q + 3] = __builtin_amdgcn_sdot4((int)c3, (int)ww[a], yy[4 * q + 3], false);
        }
    }
    int z[8];
#pragma unroll
    for (int j = 0; j < 8; ++j) { const auto r = __builtin_amdgcn_permlane32_swap((unsigned)yy[j], (unsigned)yy[j + 8], false, false); z[j] = (int)(r[0] + r[1]); }
#pragma unroll
    for (int j = 0; j < 8; ++j) { z[j] += __builtin_amdgcn_ds_swizzle(z[j], 0x401F); z[j] = dpp_addi<0x128>(z[j]); }
    float ss = 0.f;
    if ((lane & 0x18) == 0 && !(dry && z[0] == 0x7fffffff)) {
        f32x4 h0 = *(const f32x4*)hp, h1 = *(const f32x4*)(hp + 4);
        h0 += (f32x4){(float)z[0] * sw, (float)z[1] * sw, (float)z[2] * sw, (float)z[3] * sw}; h1 += (f32x4){(float)z[4] * sw, (float)z[5] * sw, (float)z[6] * sw, (float)z[7] * sw};
        *(f32x4*)hp = h0; *(f32x4*)(hp + 4) = h1;
        if (hbp) {
            u32x4 w; w.x = cvtpk(h0[0], h0[1]); w.y = cvtpk(h0[2], h0[3]); w.z = cvtpk(h1[0], h1[1]); w.w = cvtpk(h1[2], h1[3]);
            *(u32x4*)hbp = w;
            ss = (h0[0] * h0[0] + h0[1] * h0[1]) + (h0[2] * h0[2] + h0[3] * h0[3]) + (h1[0] * h1[0] + h1[1] * h1[1]) + (h1[2] * h1[2] + h1[3] * h1[3]);
        }
    }
    if (hbp) {
        ss = dpp_add<0xB1>(ss); ss = dpp_add<0x4E>(ss); ss = dpp_add<0x141>(ss);
        if ((lane & 31) == 0) sspart[lane >> 5] = ss;
    }
}
__device__ __forceinline__ void g5_xload(u32x4& x, const unsigned char* __restrict__ XQ, int t0, int it, int p) {
    x = *(const u32x4*)(XQ + (size_t)(t0 + (it & 15)) * DM + 128 * (it >> 4) + 16 * p);
}

__device__ __forceinline__ void gather5_phase(float* __restrict__ H, bf16_t* __restrict__ HB, const float* __restrict__ ssq2p, float* __restrict__ ssq1,
                                              const unsigned char* __restrict__ U8, const unsigned char* __restrict__ V8, const float* __restrict__ su, const float* __restrict__ sv,
                                              unsigned char* __restrict__ XQ, const int* __restrict__ ids, const float* __restrict__ gw,
                                              const float* __restrict__ final_g, int last, LAS unsigned char* lds, int wave, int gwave, int lane, int dry = 0, int idmask = 0xffff) {
    LAS unsigned char* wl = lds + wave * G2_WAVE_LDS;
    LAS unsigned short* idl = (LAS unsigned short*)wl;
    LAS float* al = (LAS float*)(wl + 4096);
    LAS float* sxl = (LAS float*)(wl + 4096 + 8192);
    const int t0 = __builtin_amdgcn_readfirstlane(gwave * 16);
    for (int tt = 0; tt < 16; ++tt) {
        idl[tt * 128 + lane] = (unsigned short)(ids[(size_t)(t0 + tt) * 128 + lane] & idmask);
        idl[tt * 128 + 64 + lane] = (unsigned short)(ids[(size_t)(t0 + tt) * 128 + 64 + lane] & idmask);
    }
    for (int e = lane; e < 2048; e += 64) ((LAS int*)al)[e] = 0;
    for (int tt = 0; tt < 16; ++tt) {
        const bf16_t* xr = HB + (size_t)(t0 + tt) * DM + 8 * lane;
        const u32x4 xa = *(const u32x4*)xr, xb = *(const u32x4*)(xr + 512);
        const float f[16] = {bflo(xa.x), bfhi(xa.x), bflo(xa.y), bfhi(xa.y), bflo(xa.z), bfhi(xa.z), bflo(xa.w), bfhi(xa.w),
                             bflo(xb.x), bfhi(xb.x), bflo(xb.y), bfhi(xb.y), bflo(xb.z), bfhi(xb.z), bflo(xb.w), bfhi(xb.w)};
        float am = 0.f;
#pragma unroll
        for (int j = 0; j < 16; ++j) am = fmaxf(am, fabsf(f[j]));
#pragma unroll
        for (int o = 1; o < 64; o <<= 1) am = fmaxf(am, __shfl_xor(am, o));
        const float inv = am > 0.f ? 127.0f / am : 0.f;
        unsigned wq[4];
#pragma unroll
        for (int j = 0; j < 4; ++j) {
            const int q0 = (int)rintf(f[4 * j] * inv), q1 = (int)rintf(f[4 * j + 1] * inv), q2 = (int)rintf(f[4 * j + 2] * inv), q3 = (int)rintf(f[4 * j + 3] * inv);
            wq[j] = (unsigned)(q0 & 255) | ((unsigned)(q1 & 255) << 8) | ((unsigned)(q2 & 255) << 16) | ((unsigned)(q3 & 255) << 24);
        }
        unsigned char* xq = XQ + (size_t)(t0 + tt) * DM + 8 * lane;
        *(u32x2*)xq = (u32x2){wq[0], wq[1]}; *(u32x2*)(xq + 512) = (u32x2){wq[2], wq[3]};
        if (lane == 0) sxl[tt] = am > 0.f ? am / 127.0f : 0.f;
    }
    asm volatile("s_waitcnt vmcnt(0) lgkmcnt(0)" ::: "memory");
    const int g = lane >> 3, p = lane & 7;
    if (!(dry & 2)) {
        u32x4 uA[16], uB[16], xA, xB;
        g4_issue(uA, U8, idl, 0, g, p); g5_xload(xA, XQ, t0, 0, p);
        for (int it = 0; it < 128; it += 2) {
            g4_issue(uB, U8, idl, it + 1, g, p); g5_xload(xB, XQ, t0, it + 1, p);
            g5_ucompute(uA, xA, (LAS int*)al + (it & 15) * 128 + g * 16, p);
            if (it + 2 < 128) { g4_issue(uA, U8, idl, it + 2, g, p); g5_xload(xA, XQ, t0, it + 2, p); }
            g5_ucompute(uB, xB, (LAS int*)al + ((it + 1) & 15) * 128 + g * 16, p);
        }
    }
    asm volatile("s_waitcnt lgkmcnt(0)" ::: "memory");
#if G5_VDOT4
    LAS unsigned char* w8l = (LAS unsigned char*)al;
    LAS float* swl = sxl + 16;
    for (int tt = 0; tt < 16; ++tt) {
        const float rs2 = rsqrtf(ssq16(ssq2p, t0 + tt) * (1.0f / 1024.0f) + RMS_EPS) * sxl[tt];
        const int id0 = idl[tt * 128 + lane], id1 = idl[tt * 128 + 64 + lane];
        const float a0 = (float)((LAS int*)al)[tt * 128 + lane] * rs2 * su[id0], a1 = (float)((LAS int*)al)[tt * 128 + 64 + lane] * rs2 * su[id1];
        const float w0 = gw[(size_t)(t0 + tt) * 128 + lane] * gelu_erf(a0) * sv[id0], w1 = gw[(size_t)(t0 + tt) * 128 + 64 + lane] * gelu_erf(a1) * sv[id1];
        float am = fmaxf(fabsf(w0), fabsf(w1));
#pragma unroll
        for (int o = 1; o < 64; o <<= 1) am = fmaxf(am, __shfl_xor(am, o));
        const float inv = am > 0.f ? 127.0f / am : 0.f;
        asm volatile("s_waitcnt lgkmcnt(0)" ::: "memory");
        w8l[tt * 128 + lane] = (unsigned char)((int)rintf(w0 * inv) & 255); w8l[tt * 128 + 64 + lane] = (unsigned char)((int)rintf(w1 * inv) & 255);
        if (lane == 0) swl[tt] = am > 0.f ? am / 127.0f : 0.f;
    }
    asm volatile("s_waitcnt lgkmcnt(0)" ::: "memory");
    const bool fold = !last && !dry;
    LAS float* ssp = al + 1024;
    if (!(dry & 4)) {
        u32x4 vA[16], vB[16];
        g4_issue(vA, V8, idl, 0, g, p);
        for (int it = 0; it < 128; it += 2) {
            g4_issue(vB, V8, idl, it + 1, g, p);
            { const size_t o_ = (size_t)(t0 + (it & 15)) * DM + 128 * (it >> 4) + 16 * p + 8 * (lane >> 5);
              g6_vcompute(vA, w8l + (it & 15) * 128 + g * 16, swl[it & 15], H + o_, lane, dry, fold ? HB + o_ : nullptr, ssp + (it & 15) * 16 + (it >> 4) * 2); }
            if (it + 2 < 128) g4_issue(vA, V8, idl, it + 2, g, p);
            { const size_t o_ = (size_t)(t0 + ((it + 1) & 15)) * DM + 128 * ((it + 1) >> 4) + 16 * p + 8 * (lane >> 5);
              g6_vcompute(vB, w8l + ((it + 1) & 15) * 128 + g * 16, swl[(it + 1) & 15], H + o_, lane, dry, fold ? HB + o_ : nullptr, ssp + ((it + 1) & 15) * 16 + ((it + 1) >> 4) * 2); }
        }
    }
#else
    for (int n = 0; n < 32; ++n) {
        const int tt = n >> 1, k = lane + 64 * (n & 1);
        const float rs2 = rsqrtf(ssq16(ssq2p, t0 + tt) * (1.0f / 1024.0f) + RMS_EPS);
        const int id = idl[tt * 128 + k];
        const float a = (float)((LAS int*)al)[tt * 128 + k] * (rs2 * sxl[tt]) * su[id];
        al[tt * 128 + k] = gw[(size_t)(t0 + tt) * 128 + k] * gelu_erf(a) * sv[id];
    }
    asm volatile("s_waitcnt lgkmcnt(0)" ::: "memory");
    if (!(dry & 4)) {
        u32x4 vA[16], vB[16];
        g4_issue(vA, V8, idl, 0, g, p);
        for (int it = 0; it < 128; it += 2) {
            g4_issue(vB, V8, idl, it + 1, g, p);
            g5_vcompute(vA, al + (it & 15) * 128 + g * 16, H + (size_t)(t0 + (it & 15)) * DM + 128 * (it >> 4) + 16 * p + 8 * (lane >> 5), lane, dry);
            if (it + 2 < 128) g4_issue(vA, V8, idl, it + 2, g, p);
            g5_vcompute(vB, al + ((it + 1) & 15) * 128 + g * 16, H + (size_t)(t0 + ((it + 1) & 15)) * DM + 128 * ((it + 1) >> 4) + 16 * p + 8 * (lane >> 5), lane, dry);
        }
    }
#endif
    if (dry) return;
#if G5_VDOT4
    if (fold) {
        asm volatile("s_waitcnt lgkmcnt(0)" ::: "memory");
        if (lane < 16) { float a_ = 0.f;
#pragma unroll
            for (int q_ = 0; q_ < 16; ++q_) a_ += ssp[lane * 16 + q_];
            ssq1[t0 + lane] = a_; }
        return;
    }
#endif
    __builtin_amdgcn_fence(__ATOMIC_SEQ_CST, "agent");
    asm volatile("s_waitcnt vmcnt(0)" ::: "memory");
    for (int tt = 0; tt < 16; ++tt) {
        const int t = t0 + tt;
        float* hp = H + (size_t)t * DM + 8 * lane;
        f32x4 h0 = *(const f32x4*)hp, h1 = *(const f32x4*)(hp + 4), h2 = *(const f32x4*)(hp + 512), h3 = *(const f32x4*)(hp + 516);
        float ss = (h0[0] * h0[0] + h0[1] * h0[1]) + (h0[2] * h0[2] + h0[3] * h0[3]) + (h1[0] * h1[0] + h1[1] * h1[1]) + (h1[2] * h1[2] + h1[3] * h1[3])
                 + (h2[0] * h2[0] + h2[1] * h2[1]) + (h2[2] * h2[2] + h2[3] * h2[3]) + (h3[0] * h3[0] + h3[1] * h3[1]) + (h3[2] * h3[2] + h3[3] * h3[3]);
        ss = wave_sum(ss);
        if (last) {
            const float rs = rsqrtf(ss * (1.0f / 1024.0f) + RMS_EPS);
            const f32x4 g0 = *(const f32x4*)(final_g + 8 * lane), g1 = *(const f32x4*)(final_g + 8 * lane + 4), g2 = *(const f32x4*)(final_g + 512 + 8 * lane), g3 = *(const f32x4*)(final_g + 516 + 8 * lane);
            h0 = h0 * rs * g0; h1 = h1 * rs * g1; h2 = h2 * rs * g2; h3 = h3 * rs * g3;
            *(f32x4*)hp = h0; *(f32x4*)(hp + 4) = h1; *(f32x4*)(hp + 512) = h2; *(f32x4*)(hp + 516) = h3;
        } else {
            bf16_t* bp = HB + (size_t)t * DM + 8 * lane;
            u32x4 w; w.x = cvtpk(h0[0], h0[1]); w.y = cvtpk(h0[2], h0[3]); w.z = cvtpk(h1[0], h1[1]); w.w = cvtpk(h1[2], h1[3]);
            *(u32x4*)bp = w;
            w.x = cvtpk(h2[0], h2[1]); w.y = cvtpk(h2[2], h2[3]); w.z = cvtpk(h3[0], h3[1]); w.w = cvtpk(h3[2], h3[3]);
            *(u32x4*)(bp + 512) = w;
            if (lane == 0) ssq1[t] = ss;
        }
    }
}

__device__ __forceinline__ float gelu_erf(float x) { return 0.5f * x * (1.0f + erff(x * 0.70710678118654752f)); }

__device__ __forceinline__ void gather_phase(float* __restrict__ H, bf16_t* __restrict__ HB, const float* __restrict__ ssq2, float* __restrict__ ssq1,
                                             const bf16_t* __restrict__ U16, const bf16_t* __restrict__ V16, const int* __restrict__ ids, const float* __restrict__ gw,
                                             const float* __restrict__ final_g, int last, int gwave, int ngw, int lane, int dry = 0, int idmask = 0xffff) {
    for (int t0 = gwave; t0 < T; t0 += ngw) {
        const int t = __builtin_amdgcn_readfirstlane(t0);
        const u32x4 xa = *(const u32x4*)(HB + (size_t)t * DM + 8 * lane), xb = *(const u32x4*)(HB + (size_t)t * DM + 512 + 8 * lane);
        const float rs2 = rsqrtf(ssq16(ssq2, t) * (1.0f / 1024.0f) + RMS_EPS);
        float y[16];
#pragma unroll
        for (int i = 0; i < 16; ++i) y[i] = 0.f;
        const int* idp = ids + (size_t)t * 128; const float* gp = gw + (size_t)t * 128;
        for (int c = 0; c < 16; ++c) {
            u32x4 ua[8], ub[8], va[8], vb[8]; float g[8];
#pragma unroll
            for (int e = 0; e < 8; ++e) {
                const int id = __builtin_amdgcn_readfirstlane(idp[c * 8 + e]) & idmask;
                g[e] = gp[c * 8 + e];
                const bf16_t* ur = U16 + (size_t)id * DM + 8 * lane; const bf16_t* vr = V16 + (size_t)id * DM + 8 * lane;
                ua[e] = *(const u32x4*)ur; ub[e] = *(const u32x4*)(ur + 512); va[e] = *(const u32x4*)vr; vb[e] = *(const u32x4*)(vr + 512);
            }
#pragma unroll
            for (int e = 0; e < 8; ++e) {
                float a = 0.f;
                a = dot2bf(xa.x, ua[e].x, a); a = dot2bf(xa.y, ua[e].y, a); a = dot2bf(xa.z, ua[e].z, a); a = dot2bf(xa.w, ua[e].w, a);
                a = dot2bf(xb.x, ub[e].x, a); a = dot2bf(xb.y, ub[e].y, a); a = dot2bf(xb.z, ub[e].z, a); a = dot2bf(xb.w, ub[e].w, a);
                a = wave_sum(a);
                const float w = g[e] * gelu_erf(a * rs2);
                y[0] = fmaf(w, bflo(va[e].x), y[0]); y[1] = fmaf(w, bfhi(va[e].x), y[1]); y[2] = fmaf(w, bflo(va[e].y), y[2]); y[3] = fmaf(w, bfhi(va[e].y), y[3]);
                y[4] = fmaf(w, bflo(va[e].z), y[4]); y[5] = fmaf(w, bfhi(va[e].z), y[5]); y[6] = fmaf(w, bflo(va[e].w), y[6]); y[7] = fmaf(w, bfhi(va[e].w), y[7]);
                y[8] = fmaf(w, bflo(vb[e].x), y[8]); y[9] = fmaf(w, bfhi(vb[e].x), y[9]); y[10] = fmaf(w, bflo(vb[e].y), y[10]); y[11] = fmaf(w, bfhi(vb[e].y), y[11]);
                y[12] = fmaf(w, bflo(vb[e].z), y[12]); y[13] = fmaf(w, bfhi(vb[e].z), y[13]); y[14] = fmaf(w, bflo(vb[e].w), y[14]); y[15] = fmaf(w, bfhi(vb[e].w), y[15]);
            }
        }
        float* hp = H + (size_t)t * DM + 8 * lane;
        f32x4 h0 = *(const f32x4*)hp, h1 = *(const f32x4*)(hp + 4), h2 = *(const f32x4*)(hp + 512), h3 = *(const f32x4*)(hp + 516);
        h0 += (f32x4){y[0], y[1], y[2], y[3]}; h1 += (f32x4){y[4], y[5], y[6], y[7]}; h2 += (f32x4){y[8], y[9], y[10], y[11]}; h3 += (f32x4){y[12], y[13], y[14], y[15]};
        float ss = (h0[0] * h0[0] + h0[1] * h0[1]) + (h0[2] * h0[2] + h0[3] * h0[3]) + (h1[0] * h1[0] + h1[1] * h1[1]) + (h1[2] * h1[2] + h1[3] * h1[3])
                 + (h2[0] * h2[0] + h2[1] * h2[1]) + (h2[2] * h2[2] + h2[3] * h2[3]) + (h3[0] * h3[0] + h3[1] * h3[1]) + (h3[2] * h3[2] + h3[3] * h3[3]);
        ss = wave_sum(ss);
        if (dry && ss >= 0.f) continue;
        if (last) {
            const float rs = rsqrtf(ss * (1.0f / 1024.0f) + RMS_EPS);
            const f32x4 g0 = *(const f32x4*)(final_g + 8 * lane), g1 = *(const f32x4*)(final_g + 8 * lane + 4), g2 = *(const f32x4*)(final_g + 512 + 8 * lane), g3 = *(const f32x4*)(final_g + 516 + 8 * lane);
            h0 = h0 * rs * g0; h1 = h1 * rs * g1; h2 = h2 * rs * g2; h3 = h3 * rs * g3;
            *(f32x4*)hp = h0; *(f32x4*)(hp + 4) = h1; *(f32x4*)(hp + 512) = h2; *(f32x4*)(hp + 516) = h3;
        } else {
            *(f32x4*)hp = h0; *(f32x4*)(hp + 4) = h1; *(f32x4*)(hp + 512) = h2; *(f32x4*)(hp + 516) = h3;
            bf16_t* bp = HB + (size_t)t * DM + 8 * lane;
            u32x4 w; w.x = cvtpk(h0[0], h0[1]); w.y = cvtpk(h0[2], h0[3]); w.z = cvtpk(h1[0], h1[1]); w.w = cvtpk(h1[2], h1[3]);
            *(u32x4*)bp = w;
            w.x = cvtpk(h2[0], h2[1]); w.y = cvtpk(h2[2], h2[3]); w.z = cvtpk(h3[0], h3[1]); w.w = cvtpk(h3[2], h3[3]);
            *(u32x4*)(bp + 512) = w;
            if (lane == 0) ssq1[t] = ss;
        }
    }
}

#define XB_TMO      128
#define XB_XCNT(j)  (256  + 64 * (j))
#define XB_XSUB(j)  (1280 + 64 * (j))
#define XB_XGEN(j)  (2304 + 64 * (j))
#define XB_TOP      3328
#define XB_TOPGEN   3392
#define XCD_BAR_WORDS 3456
#define XB_SPIN_CAP (1u << 18)

__device__ __forceinline__ unsigned xb_ld(unsigned* p)              { return __hip_atomic_load(p, __ATOMIC_RELAXED, __HIP_MEMORY_SCOPE_AGENT); }
__device__ __forceinline__ unsigned xb_add(unsigned* p, unsigned v) { return __hip_atomic_fetch_add(p, v, __ATOMIC_RELAXED, __HIP_MEMORY_SCOPE_AGENT); }
__device__ __forceinline__ unsigned xb_xcc_id() { return (unsigned)__builtin_amdgcn_s_getreg((3 << 11) | 20) & 0xFu; }
#define XB_SPIN(cond, bar) do { unsigned _sp = 0; while (cond) { __builtin_amdgcn_s_sleep(1); \
    if ((++_sp & 255u) == 0u) { if (xb_ld(&(bar)[XB_TMO])) break; if (_sp > XB_SPIN_CAP) { atomicAdd(&(bar)[XB_TMO], 1u); break; } } } } while (0)

struct XcdBarrier {
    unsigned* bar; unsigned x;
    volatile LAS unsigned* st;
};

__device__ __forceinline__ XcdBarrier xcd_barrier_post(unsigned* bar, volatile LAS unsigned* st, int tid) {
    XcdBarrier b; b.bar = bar; b.x = xb_xcc_id(); b.st = st;
    if (tid == 0) (void)xb_add(&bar[XB_XCNT(b.x)], 1u);
    return b;
}
__device__ __forceinline__ void xcd_barrier_complete(unsigned* bar, unsigned x, unsigned& nloc, unsigned& nx) {
    const unsigned G = gridDim.x * gridDim.y * gridDim.z;
    unsigned sum, cnt, mine, sp = 0u;
    for (;;) {
        sum = 0u; cnt = 0u; mine = 0u;
#pragma unroll
        for (unsigned j = 0; j < 16; ++j) { const unsigned c = xb_ld(&bar[XB_XCNT(j)]); sum += c; cnt += (c > 0u) ? 1u : 0u; mine = (j == x) ? c : mine; }
        if (sum == G) break;
        __builtin_amdgcn_s_sleep(1);
        if ((++sp & 255u) == 0u) { if (xb_ld(&bar[XB_TMO])) break; if (sp > XB_SPIN_CAP) { atomicAdd(&bar[XB_TMO], 1u); break; } }
    }
    nloc = mine > 0u ? mine : 1u; nx = cnt > 0u ? cnt : 1u;
}

__device__ __forceinline__ void xcd_barrier(const XcdBarrier& b, int tid) {
    asm volatile("s_waitcnt vmcnt(0)" ::: "memory");
    __syncthreads();
    if (tid == 0) {
        unsigned* bar = b.bar;
        __builtin_amdgcn_s_waitcnt(0);
        unsigned nloc = b.st[0], nx = b.st[1];
        if (nloc == 0u) { xcd_barrier_complete(bar, b.x, nloc, nx); b.st[0] = nloc; b.st[1] = nx; }
        const unsigned old = xb_add(&bar[XB_XSUB(b.x)], 1u);
        const unsigned gen = old / nloc;
        if (old + 1u == (gen + 1u) * nloc) {
            __builtin_amdgcn_fence(__ATOMIC_RELEASE, "agent");
            asm volatile("s_waitcnt vmcnt(0)" ::: "memory");
            const unsigned og = xb_add(&bar[XB_TOP], 1u);
            const unsigned tg = og / nx;
            if (og + 1u == (tg + 1u) * nx) xb_add(&bar[XB_TOPGEN], 1u);
            else XB_SPIN(xb_ld(&bar[XB_TOPGEN]) == tg, bar);
            __builtin_amdgcn_fence(__ATOMIC_ACQUIRE, "agent");
            xb_add(&bar[XB_XGEN(b.x)], 1u);
            asm volatile("s_waitcnt vmcnt(0)" ::: "memory");
        } else {
            XB_SPIN(xb_ld(&bar[XB_XGEN(b.x)]) == gen, bar);
            __builtin_amdgcn_fence(__ATOMIC_ACQUIRE, "agent");
            asm volatile("s_waitcnt vmcnt(0)" ::: "memory");
        }
    }
    __syncthreads();
}
struct Params { const float* in[18]; float* out; unsigned char* ws; int ph_lo, ph_hi; };

typedef const __attribute__((address_space(4))) Params* KP;
#define KARGS() KP pp = (KP)__builtin_amdgcn_kernarg_segment_ptr(); asm volatile("" : "+s"(pp))
#ifndef PEER_FP8
#define PEER_FP8 1
#endif
#ifndef PEER_I8
#define PEER_I8 1
#endif
#ifndef G4P
#define G4P 0
#endif
#ifndef PROBE_DUP
#define PROBE_DUP 0
#endif
#define PH_ON(k, bit) ((PH_MASK & (bit)) && ph_lo <= (k) && (k) < ph_hi)
constexpr int CW_BAR = 4096;
constexpr int MISC_OFF = 131072 + 320;
__device__ __forceinline__ int lane_id_opaque() { int l; asm volatile("v_mbcnt_lo_u32_b32 %0, -1, 0\n\tv_mbcnt_hi_u32_b32 %0, -1, %0" : "=v"(l)); return l; }
#define PH_SYNC(k) do { if ((k) > ph_lo) { { KP pq = (KP)__builtin_amdgcn_kernarg_segment_ptr(); \
    XcdBarrier xb_; xb_.bar = (unsigned*)(pq->ws + WS_CTL) + CW_BAR; xb_.x = xb_xcc_id(); xb_.st = (volatile LAS unsigned*)(lds + MISC_OFF) + 8; xcd_barrier(xb_, tid); } } } while (0)
#define PH_IDS() const int lane = lane_id_opaque(); const int tid = wave * 64 + lane

__device__ __forceinline__ void weight_prep(KP pp, int l, LAS float* scr, int gw0, int ngw, int lane) {
    unsigned char* wl = pp->ws + WS_W + (size_t)l * WL_STRIDE;
    const float* g1 = pp->in[2] + (size_t)l * DM; const float* g2 = pp->in[11] + (size_t)l * DM;
    for (int it = gw0; it < 16 * 192; it += ngw) transpose_item<1>(pp->in[3] + (size_t)l * DM * IN_COLS, DM, IN_COLS, (bf16_t*)(wl + WL_IN), g1, scr, it, 192, lane);
    for (int i = 0; i < 3; ++i)
        for (int it = gw0; it < 6 * 32; it += ngw) transpose_item<0>(pp->in[7 + i] + (size_t)l * 384 * DM, 384, DM, (bf16_t*)(wl + WL_BR) + (size_t)i * DM * 384, nullptr, scr, it, 32, lane);
    for (int it = gw0; it < 16 * 32; it += ngw) transpose_item<0>(pp->in[10] + (size_t)l * DM * DM, DM, DM, (bf16_t*)(wl + WL_OUT), nullptr, scr, it, 32, lane);
    for (int it = gw0; it < 16 * 64; it += ngw) transpose_item<0>(pp->in[12] + (size_t)l * DM * 2048, DM, 2048, (bf16_t*)(wl + WL_Q), g2, scr, it, 64, lane);
}

template <int l>
__device__ __forceinline__ void layer_phases(const int ph_lo, const int ph_hi, LAS unsigned char* lds, const int wave) {
    constexpr int pb = 1 + 8 * l;
        if (PH_ON(pb + 0, 2)) {
            PH_IDS(); PH_SYNC(pb + 0); KARGS();
            unsigned char* ws = pp->ws; unsigned char* wl = ws + WS_W + (size_t)l * WL_STRIDE;
            const int G = gridDim.x;
            pg8::Gemm g{(const bf16_t*)(ws + WS_HB), (const bf16_t*)(wl + WL_IN), T, N_IN, DM, DM};
            pg8::StaticOrder S; S.init(T, N_IN, G, (int)blockIdx.x);
            EpiIn E{(bf16_t*)(ws + WS_P), (bf16_t*)(ws + WS_G), (const float*)(ws + WS_SSQ1), (const float*)(ws + WS_ROPE), pp->in[6] + (size_t)l * 3 * DM, pp->in[4] + (size_t)l * 6, (float*)(ws + WS_LOGF), 0};
            pg8::gemm_phase<EpiIn, pg8::StaticOrder, true, true>(lds, g, S, E, tid);
            if (PROBE_DUP == 1) { __syncthreads(); pg8::gemm_phase<EpiIn, pg8::StaticOrder, true, true>(lds, g, S, E, tid); }
            if (PROBE_DUP == 13) { __syncthreads(); EpiIn En = E; En.nostore = 1; pg8::gemm_phase<EpiIn, pg8::StaticOrder, true, true>(lds, g, S, En, tid); }
            if (PROBE_DUP == 12) { __syncthreads(); EpiDry Ed{(float*)(ws + WS_CTL) + 8192}; pg8::gemm_phase<EpiDry, pg8::StaticOrder, true, true>(lds, g, S, Ed, tid); }
        }
        if (PH_ON(pb + 1, 4)) {
            PH_IDS(); PH_SYNC(pb + 1); KARGS();
            float* logf = (float*)(pp->ws + WS_LOGF); float* cumT = (float*)(pp->ws + WS_CUMT);
            LAS float* wt = (LAS float*)lds;
            for (int r = (int)blockIdx.x * 512 + tid; r < BATCH * 6 * SEQ; r += (int)gridDim.x * 512) {
                const int sq = r >> 13, sp_ = r & (SEQ - 1), b = sq / 6, h = sq % 6;
                const bf16_t* kr = (const bf16_t*)(pp->ws + WS_P) + ((size_t)b * SEQ + sp_) * NP + PC_KB + 64 * h;
                float n2 = 0.f;
#pragma unroll
                for (int c = 0; c < 8; ++c) { const u32x4 kk = *(const u32x4*)(kr + 8 * c);
                    n2 += (bflo(kk.x) * bflo(kk.x) + bfhi(kk.x) * bfhi(kk.x)) + (bflo(kk.y) * bflo(kk.y) + bfhi(kk.y) * bfhi(kk.y)) + (bflo(kk.z) * bflo(kk.z) + bfhi(kk.z) * bfhi(kk.z)) + (bflo(kk.w) * bflo(kk.w) + bfhi(kk.w) * bfhi(kk.w)); }
#pragma unroll
                for (int o = 1; o < 64; o <<= 1) n2 = fmaxf(n2, __shfl_xor(n2, o));
                if (lane == 0) atomicMax((unsigned*)(pp->ws + WS_KMAX_BASE + 256 * l) + sq, __float_as_uint(n2));
            }
            if (l + 1 < DEPTH && (int)blockIdx.x >= BATCH * 6 && (int)gridDim.x > BATCH * 6)
                weight_prep(pp, l + 1, (LAS float*)(lds + wave * 8448), ((int)blockIdx.x - BATCH * 6) * 8 + wave, ((int)gridDim.x - BATCH * 6) * 8, lane);
            for (int sq = blockIdx.x; sq < BATCH * 6; sq += gridDim.x) {
                const int b = sq / 6, h = sq % 6;
                float* base = logf + (size_t)b * SEQ * 8 + h;
                float v[16]; float run = 0.f;
#pragma unroll
                for (int i = 0; i < 16; ++i) { run += base[(size_t)(tid * 16 + i) * 8]; v[i] = run; }
                float inc = run;
#pragma unroll
                for (int o = 1; o < 64; o <<= 1) { const float n = __shfl_up(inc, o); if (lane >= o) inc += n; }
                __syncthreads();
                if (lane == 63) wt[wave] = inc;
                __syncthreads();
                float off = inc - run;
                for (int w = 0; w < wave; ++w) off += wt[w];
#pragma unroll
                for (int i = 0; i < 16; ++i) cumT[(size_t)sq * SEQ + tid * 16 + i] = (v[i] + off) * LOG2E;
            }
        }
        if (PH_ON(pb + 2, 8)) {
            PH_IDS(); PH_SYNC(pb + 2); KARGS();
            if (PROBE_DUP == 2) { attention_phase((bf16_t*)(pp->ws + WS_P), (const float*)(pp->ws + WS_CUMT), (const float*)(pp->ws + WS_KMAX_BASE + 256 * l), pp->in[5] + (size_t)l * 6, (unsigned*)(pp->ws + WS_CTL) + CW_ATT + 64 * (l + 2), lds, wave, lane, 1); }
            attention_phase((bf16_t*)(pp->ws + WS_P), (const float*)(pp->ws + WS_CUMT), (const float*)(pp->ws + WS_KMAX_BASE + 256 * l), pp->in[5] + (size_t)l * 6, (unsigned*)(pp->ws + WS_CTL) + CW_ATT + 64 * l, lds, wave, lane);
        }
        if (PH_ON(pb + 3, 16)) {
            PH_IDS(); PH_SYNC(pb + 3); KARGS();
            unsigned char* ws = pp->ws; unsigned char* wl = ws + WS_W + (size_t)l * WL_STRIDE;
            bf16_t* P = (bf16_t*)(ws + WS_P);
            for (int rep = 0; rep < (PROBE_DUP == 6 ? 2 : 1); ++rep) {
                pg8::Gemm g{P, (const bf16_t*)(wl + WL_BR), T, DM, 384, NP};
                BranchOrder S; S.init(T, DM, (int)gridDim.x, (int)blockIdx.x);
                EpiBrChain E{(const bf16_t*)(ws + WS_G), P + PC_MERGED};
                pg8::gemm_phase<EpiBrChain, BranchOrder, true, true>(lds, g, S, E, tid);
                __syncthreads();
            }
        }
        if (PH_ON(pb + 4, 32)) {
            PH_IDS(); PH_SYNC(pb + 4); KARGS();
            unsigned char* ws = pp->ws; unsigned char* wl = ws + WS_W + (size_t)l * WL_STRIDE;
            pg8::Gemm g{(const bf16_t*)(ws + WS_P) + PC_MERGED, (const bf16_t*)(wl + WL_OUT), T, DM, DM, NP};
            pg8::StaticOrder S; S.init(T, DM, (int)gridDim.x, (int)blockIdx.x);
            EpiOut E{l == 0 ? pp->in[0] : pp->out, pp->out, (bf16_t*)(ws + WS_HB), (float*)(ws + WS_SSQ2P)};
            pg8::gemm_phase<EpiOut, pg8::StaticOrder, true, true>(lds, g, S, E, tid);
            if (PROBE_DUP == 14 && l == 0) { __syncthreads(); pg8::gemm_phase<EpiOut, pg8::StaticOrder, true, true>(lds, g, S, E, tid); }
        }
        if (PH_ON(pb + 5, 64)) {
            PH_IDS(); PH_SYNC(pb + 5); KARGS();
            unsigned char* ws = pp->ws; unsigned char* wl = ws + WS_W + (size_t)l * WL_STRIDE;
            for (int rep = 0; rep < (PROBE_DUP == 7 ? 2 : 1); ++rep) {
            {
                pg8::Gemm g{(const bf16_t*)(ws + WS_HB), (const bf16_t*)(wl + WL_Q), T, 2048, DM, DM};
                pg8::StaticOrder S; S.init(T, 2048, (int)gridDim.x, (int)blockIdx.x);
                EpiQ E{(bf16_t*)(ws + WS_Q2), (const float*)(ws + WS_SSQ2P)};
                pg8::gemm_phase<EpiQ, pg8::StaticOrder, true, true>(lds, g, S, E, tid);
            }
            __syncthreads();
            }
        }
        if (PH_ON(pb + 6, 128)) {
            PH_IDS(); PH_SYNC(pb + 6); KARGS();
            unsigned char* ws = pp->ws;
            if (PROBE_DUP == 3) { routing_phase((const bf16_t*)(ws + WS_Q2), pp->in[13] + (size_t)l * 128 * 128, pp->in[14] + (size_t)l * 128 * 128, (int*)(ws + WS_IDS), (float*)(ws + WS_GW), lds, tid); __syncthreads(); }
            routing2_setup(pp->in[13] + (size_t)l * 128 * 128, pp->in[14] + (size_t)l * 128 * 128, lds, tid);
            if (wave < 4) routing2_units((const bf16_t*)(ws + WS_Q2), (int*)(ws + WS_IDS), (float*)(ws + WS_GW), lds, wave, lane, (int)blockIdx.x * 8 + wave, (int)gridDim.x * 8);
            if (PEER_I8) {
                const float* u = pp->in[15] + (size_t)l * N_EXP * DM; const float* v = pp->in[16] + (size_t)l * N_EXP * DM;
                const float* g2 = pp->in[11] + (size_t)l * DM;
                for (int r = (int)blockIdx.x * 8 + wave; r < N_EXP; r += (int)gridDim.x * 8) {
                    quant_row_i8(u + (size_t)r * DM, g2, ws + WS_U8 + (size_t)r * DM, (float*)(ws + WS_SU) + r, 0, lane);
                    quant_row_i8(v + (size_t)r * DM, nullptr, ws + WS_V8 + (size_t)r * DM, (float*)(ws + WS_SV) + r, G5_VDOT4 ? 0 : 128, lane);
                }
            } else if (PEER_FP8) {
                const float* u = pp->in[15] + (size_t)l * N_EXP * DM; const float* v = pp->in[16] + (size_t)l * N_EXP * DM;
                const float* g2 = pp->in[11] + (size_t)l * DM;
                for (int r = (int)blockIdx.x * 8 + wave; r < N_EXP; r += (int)gridDim.x * 8) {
                    quant_row_fp8(u + (size_t)r * DM, g2, ws + WS_U8 + (size_t)r * DM, (float*)(ws + WS_SU) + r, lane);
                    quant_row_fp8(v + (size_t)r * DM, nullptr, ws + WS_V8 + (size_t)r * DM, (float*)(ws + WS_SV) + r, lane);
                }
            } else {
                const float* u = pp->in[15] + (size_t)l * N_EXP * DM; const float* v = pp->in[16] + (size_t)l * N_EXP * DM;
                const float* g2 = pp->in[11] + (size_t)l * DM;
                bf16_t* U16 = (bf16_t*)(ws + WS_U16); bf16_t* V16 = (bf16_t*)(ws + WS_V16);
                for (unsigned e = blockIdx.x * 512 + tid; e < (unsigned)(N_EXP * DM / 8); e += gridDim.x * 512) {
                    const unsigned o = e * 8; const int c = (int)(o & (DM - 1));
                    const f32x4 a0 = *(const f32x4*)(u + o), a1 = *(const f32x4*)(u + o + 4), s0 = *(const f32x4*)(g2 + c), s1 = *(const f32x4*)(g2 + c + 4);
                    u32x4 w; w.x = cvtpk(a0[0] * s0[0], a0[1] * s0[1]); w.y = cvtpk(a0[2] * s0[2], a0[3] * s0[3]); w.z = cvtpk(a1[0] * s1[0], a1[1] * s1[1]); w.w = cvtpk(a1[2] * s1[2], a1[3] * s1[3]);
                    *(u32x4*)(U16 + o) = w;
                    const f32x4 b0 = *(const f32x4*)(v + o), b1 = *(const f32x4*)(v + o + 4);
                    if (G3_VF16) { w.x = cvtpk_h(b0[0], b0[1]); w.y = cvtpk_h(b0[2], b0[3]); w.z = cvtpk_h(b1[0], b1[1]); w.w = cvtpk_h(b1[2], b1[3]); }
                    else { w.x = cvtpk(b0[0], b0[1]); w.y = cvtpk(b0[2], b0[3]); w.z = cvtpk(b1[0], b1[1]); w.w = cvtpk(b1[2], b1[3]); }
                    *(u32x4*)(V16 + o) = w;
                }
            }
            if (wave >= 4) routing2_units((const bf16_t*)(ws + WS_Q2), (int*)(ws + WS_IDS), (float*)(ws + WS_GW), lds, wave, lane, (int)blockIdx.x * 8 + wave, (int)gridDim.x * 8);
        }
        if (PH_ON(pb + 7, 256)) {
            PH_IDS(); PH_SYNC(pb + 7); KARGS();
            unsigned char* ws = pp->ws;
            if (PROBE_DUP == 4) gather_phase(pp->out, (bf16_t*)(ws + WS_HB), (const float*)(ws + WS_SSQ2P), (float*)(ws + WS_SSQ1), (const bf16_t*)(ws + WS_U16), (const bf16_t*)(ws + WS_V16),
                         (const int*)(ws + WS_IDS), (const float*)(ws + WS_GW), pp->in[17], l == DEPTH - 1 ? 1 : 0, (int)blockIdx.x * 8 + wave, (int)gridDim.x * 8, lane, 1);
            if (PROBE_DUP == 5) gather_phase(pp->out, (bf16_t*)(ws + WS_HB), (const float*)(ws + WS_SSQ2P), (float*)(ws + WS_SSQ1), (const bf16_t*)(ws + WS_U16), (const bf16_t*)(ws + WS_V16),
                         (const int*)(ws + WS_IDS), (const float*)(ws + WS_GW), pp->in[17], l == DEPTH - 1 ? 1 : 0, (int)blockIdx.x * 8 + wave, (int)gridDim.x * 8, lane, 1, 511);
            if (PROBE_DUP == 10 || PROBE_DUP == 11) gather5_phase(pp->out, (bf16_t*)(ws + WS_HB), (const float*)(ws + WS_SSQ2P), (float*)(ws + WS_SSQ1), ws + WS_U8, ws + WS_V8, (const float*)(ws + WS_SU), (const float*)(ws + WS_SV),
                         ws + WS_XQ, (const int*)(ws + WS_IDS), (const float*)(ws + WS_GW), pp->in[17], l == DEPTH - 1 ? 1 : 0, lds, wave, (int)blockIdx.x * 8 + wave, lane, 1 | G4P, PROBE_DUP == 10 ? 7 : 0xffff);
            if (PEER_I8) gather5_phase(pp->out, (bf16_t*)(ws + WS_HB), (const float*)(ws + WS_SSQ2P), (float*)(ws + WS_SSQ1), ws + WS_U8, ws + WS_V8, (const float*)(ws + WS_SU), (const float*)(ws + WS_SV),
                         ws + WS_XQ, (const int*)(ws + WS_IDS), (const float*)(ws + WS_GW), pp->in[17], l == DEPTH - 1 ? 1 : 0, lds, wave, (int)blockIdx.x * 8 + wave, lane);
            else if (PEER_FP8) gather4_phase(pp->out, (bf16_t*)(ws + WS_HB), (const float*)(ws + WS_SSQ2P), (float*)(ws + WS_SSQ1), ws + WS_U8, ws + WS_V8, (const float*)(ws + WS_SU), (const float*)(ws + WS_SV),
                         (const int*)(ws + WS_IDS), (const float*)(ws + WS_GW), pp->in[17], l == DEPTH - 1 ? 1 : 0, lds, wave, (int)blockIdx.x * 8 + wave, lane);
            else gather3_phase(pp->out, (bf16_t*)(ws + WS_HB), (const float*)(ws + WS_SSQ2P), (float*)(ws + WS_SSQ1), (const bf16_t*)(ws + WS_U16), (const unsigned short*)(ws + WS_V16),
                         (const int*)(ws + WS_IDS), (const float*)(ws + WS_GW), pp->in[17], l == DEPTH - 1 ? 1 : 0, lds, wave, (int)blockIdx.x * 8 + wave, lane);
        }
}

__global__ void __launch_bounds__(512, 2) mega(Params p) {
    extern __shared__ __attribute__((aligned(16))) unsigned char lds_raw[];
    LAS unsigned char* lds = (LAS unsigned char*)lds_raw;
    const int ph_lo = p.ph_lo, ph_hi = p.ph_hi;
    const int wave = __builtin_amdgcn_readfirstlane(threadIdx.x >> 6);
    if (ph_lo < -1000) cg::this_grid().sync();
    {
        const int tid0 = threadIdx.x;
        for (int u = tid0; u < (LDS_BYTES - 131072) / 4; u += 512) ((LAS unsigned*)(lds + 131072))[u] = 0u;
        __syncthreads();
        if (ph_hi - ph_lo > 1) { KP pq = (KP)__builtin_amdgcn_kernarg_segment_ptr(); (void)xcd_barrier_post((unsigned*)(pq->ws + WS_CTL) + CW_BAR, (volatile LAS unsigned*)(lds + MISC_OFF) + 8, tid0); }
    }

    if (PH_ON(0, 1)) { KARGS();
        const int tid = threadIdx.x, lane = tid & 63;
        unsigned char* ws = pp->ws;
        const int G = gridDim.x, gwave = blockIdx.x * 8 + wave, ngw = G * 8;
        LAS float* scr = (LAS float*)(lds + wave * 8448);
        for (int rep = 0; rep < (PROBE_DUP == 8 ? 2 : 1); ++rep) {
        if (wave < 4) weight_prep(pp, 0, scr, gwave, ngw, lane);
        {
            const int* pos = (const int*)pp->in[1];
            float* rope = (float*)(ws + WS_ROPE);
            const float inv_freq = (float)exp2(-(double)(tid & 31) * (13.287712379549449 / 32.0));
            for (int e = blockIdx.x * 512 + tid; e < T * 32; e += G * 512) {
                const int t = e >> 5;
                const float ang = (float)pos[t] * inv_freq;
                double rv = (double)ang * 0.15915494309189535; rv -= floor(rv);
                const float rf = (float)rv;
                rope[2 * e] = __builtin_amdgcn_cosf(rf); rope[2 * e + 1] = __builtin_amdgcn_sinf(rf);
            }
        }
        {
            bf16_t* HB = (bf16_t*)(ws + WS_HB); float* ssq1 = (float*)(ws + WS_SSQ1);
            for (int t = gwave; t < T; t += ngw) {
                const f32x4* xr = (const f32x4*)(pp->in[0] + (size_t)t * DM) + lane;
                f32x4 v[4]; float ss = 0.f;
#pragma unroll
                for (int j = 0; j < 4; ++j) { v[j] = xr[64 * j]; ss += (v[j][0] * v[j][0] + v[j][1] * v[j][1]) + (v[j][2] * v[j][2] + v[j][3] * v[j][3]); }
                ss = wave_sum(ss);
                u32x2* br = (u32x2*)(HB + (size_t)t * DM) + lane;
#pragma unroll
                for (int j = 0; j < 4; ++j) { u32x2 w; w.x = cvtpk(v[j][0], v[j][1]); w.y = cvtpk(v[j][2], v[j][3]); br[64 * j] = w; }
                if (lane == 0) ssq1[t] = ss;
            }
        }
        if (wave >= 4) weight_prep(pp, 0, scr, gwave, ngw, lane);
        }
    }

    layer_phases<0>(ph_lo, ph_hi, lds, wave);
    layer_phases<1>(ph_lo, ph_hi, lds, wave);
    static_assert(DEPTH == 2, "two layers");
}

#ifndef MK_PER_PHASE
#define MK_PER_PHASE 0
#endif
extern "C" void kernel_launch(void* const* d_in, const int* in_sizes, int n_in, void* d_out, int out_size, void* d_ws, size_t ws_size, hipStream_t stream) {
    static int grid = 0;
    if (grid == 0) {
        if (n_in != 18 || in_sizes[0] != T * DM || out_size != T * DM || ws_size < WS_END) {
            fprintf(stderr, "kernel_launch: unexpected shapes (n_in %d, in0 %d, out %d, ws %zu); nothing launched\n", n_in, n_in > 0 ? in_sizes[0] : -1, out_size, ws_size); grid = -1; return; }
        int dev = 0, cus = 0, per_cu = 0;
        (void)hipGetDevice(&dev);
        (void)hipDeviceGetAttribute(&cus, hipDeviceAttributeMultiprocessorCount, dev);
        (void)hipFuncSetAttribute((const void*)mega, hipFuncAttributeMaxDynamicSharedMemorySize, LDS_BYTES);
        (void)hipOccupancyMaxActiveBlocksPerMultiprocessor(&per_cu, (const void*)mega, 512, LDS_BYTES);
        if (per_cu < 1) { fprintf(stderr, "kernel_launch: occupancy query says %d blocks per CU\n", per_cu); per_cu = 1; }
        (void)hipGetLastError();
        if (cus < 256) { fprintf(stderr, "kernel_launch: built for a 256-CU device (found %d); nothing launched\n", cus); grid = -1; return; }
        grid = 256;
    }
    if (grid < 0) return;
    (void)hipMemsetAsync((char*)d_ws + WS_CTL, 0, CTL_ZERO_BYTES, stream);
    Params p{};
    for (int i = 0; i < 18; ++i) p.in[i] = (const float*)d_in[i];
    p.out = (float*)d_out; p.ws = (unsigned char*)d_ws;
#if MK_PER_PHASE
    for (int ph = 0; ph < NPH; ++ph) {
        p.ph_lo = ph; p.ph_hi = ph + 1;
        void* args[] = {&p};
        hipError_t e = hipLaunchCooperativeKernel((const void*)mega, dim3(grid), dim3(512), args, LDS_BYTES, stream);
        if (e != hipSuccess) { fprintf(stderr, "cooperative launch %d failed: %s\n", ph, hipGetErrorString(e)); break; }
    }
#else
    p.ph_lo = 0; p.ph_hi = NPH;
    void* args[] = {&p};
    hipError_t e = hipLaunchCooperativeKernel((const void*)mega, dim3(grid), dim3(512), args, LDS_BYTES, stream);
    if (e != hipSuccess) fprintf(stderr, "cooperative launch failed: %s (grid %d)\n", hipGetErrorString(e), grid);
#endif
}
```

```cpp
#define EPI_NT 1
#include <hip/hip_runtime.h>
#include <hip/hip_cooperative_groups.h>
#include <cstdio>
#include <cstdint>
#include <cmath>
namespace cg = cooperative_groups;
namespace pg8 {
#define PG8_LAS __attribute__((address_space(3)))
typedef unsigned short bf16_t;
typedef short bf16x8 __attribute__((ext_vector_type(8)));
typedef float f32x4 __attribute__((ext_vector_type(4)));
typedef unsigned u32x4 __attribute__((ext_vector_type(4)));
constexpr int BM = 256, BK = 64, HALF = 128, HTB = HALF * BK * 2  , STAGE_BYTES = 8 * HTB, NXCD = 8, WGM = 8;

__host__ __device__ __forceinline__ int lds_byte(int r, int c) { const int st = (r >> 4) * 2 + (c >> 5), rr = r & 15, cc = c & 31, ob = rr * 64 + cc * 2; return st * 1024 + (ob ^ (((ob >> 9) & 1) << 5)); }
__host__ __device__ __forceinline__ void stage_rc(int b, int& R, int& C) { const int st = b / 1024, sb = b % 1024, swz = sb ^ (((sb >> 9) & 1) << 5); R = (st >> 1) * 16 + swz / 64; C = (st & 1) * 32 + (swz % 64) / 2; }
__host__ __device__ __forceinline__ int perm32(int rho) { const int n = rho >> 4, i = rho & 15; return 8 * (i >> 2) + 4 * n + (i & 3); }

struct Unit { int pm, pn, br; };
struct Gemm { const bf16_t* A; const bf16_t* Bt; int M, N, K, lda; };

struct StaticOrder {
    int nM, nN, nwg, G, c;
    __host__ __device__ void init(int M, int N, int G_, int c_) { nM = M / BM; nN = N / BM; nwg = nM * nN; G = G_; c = c_; }
    __host__ __device__ bool next(int i, Unit& u) const {
        const long L = (long)i * G + c; if (L >= nwg) return false;
        int wgid = (int)L; { const int q = nwg / NXCD, r = nwg % NXCD, xcd = wgid % NXCD, off = wgid / NXCD; wgid = (xcd < r ? xcd * (q + 1) : r * (q + 1) + (xcd - r) * q) + off; }
        const int nig = WGM * nN, gid = wgid / nig, fm = gid * WGM, gsz = (nM - fm) < WGM ? (nM - fm) : WGM;
        u.pm = fm + ((wgid % nig) % gsz); u.pn = (wgid % nig) / gsz; u.br = 0; return true;
    }
    __device__ __forceinline__ size_t a_off(const Unit&) const { return 0; }
    __device__ __forceinline__ size_t b_off(const Unit&) const { return 0; }
    __device__ __forceinline__ void a_ready(const Unit&) const {}
    __device__ __forceinline__ void done(const Unit&) const {}
};

__device__ __forceinline__ unsigned cvt_pk_bf16(float lo, float hi) { unsigned r; asm volatile("v_cvt_pk_bf16_f32 %0, %1, %2" : "=v"(r) : "v"(lo), "v"(hi)); return r; }
typedef float f32x2 __attribute__((ext_vector_type(2)));
__device__ __forceinline__ f32x2 gelu_pk(f32x2 v) {
    const f32x2 av = __builtin_elementwise_abs(v), d = av * 0.2316418882f + 1.0f;
    f32x2 t; t.x = __builtin_amdgcn_rcpf(d.x); t.y = __builtin_amdgcn_rcpf(d.y);
    f32x2 q = t * 0.5307027145f + (-0.7265760135f); q = q * t + 0.7107068705f; q = q * t + (-0.142248368f); q = q * t + 0.127414796f; q = q * t;
    const f32x2 s = (v * v) * (-0.72134752044f);
    f32x2 e; e.x = __builtin_amdgcn_exp2f(s.x); e.y = __builtin_amdgcn_exp2f(s.y);
    const f32x2 m = v * (q * e), r = v - m;
    f32x2 o; o.x = v.x < 0.f ? m.x : r.x; o.y = v.y < 0.f ? m.y : r.y; return o;
}

template <int ACT  > struct EpiBf16 {
    static constexpr bool PERM = true, AFTER_DRAIN = false; static_assert(ACT == 0 || ACT == 1, "EpiBf16: ACT is 0 (none) or 1 (gelu_pk)");
    bf16_t* O; int ldc; const float* bias; int split_cols; size_t split_stride; float scale0;
    __device__ __forceinline__ void operator()(const f32x4 (&acc)[2][2][4][2], const Unit& u, int wr, int wc, int fr, int fq) const {
        const int row0 = u.pm * BM + wr * 64 + fr; int colt = u.pn * BM; bf16_t* base = O;
        float sc = 1.f; if (split_cols) { const int t = colt / split_cols; base += (size_t)t * split_stride; colt -= t * split_cols; if (t == 0) sc = scale0; }
        const int col0 = colt + wc * 32 + 8 * fq, bcol0 = u.pn * BM + wc * 32 + 8 * fq;
        f32x4 bv[2][2];
#pragma unroll
        for (int bj = 0; bj < 2; ++bj)
#pragma unroll
            for (int n = 0; n < 2; ++n) bv[bj][n] = bias ? *(const f32x4*)(bias + bcol0 + bj * HALF + 4 * n) : (f32x4){0.f, 0.f, 0.f, 0.f};
#pragma unroll
        for (int ai = 0; ai < 2; ++ai)
#pragma unroll
            for (int m = 0; m < 4; ++m) { bf16_t* rowp = base + (size_t)(row0 + ai * HALF + m * 16) * ldc + col0;
#pragma unroll
                for (int bj = 0; bj < 2; ++bj) { f32x4 v0 = acc[ai][bj][m][0] + bv[bj][0], v1 = acc[ai][bj][m][1] + bv[bj][1];
                    if (ACT == 1) { f32x2 a = gelu_pk((f32x2){v0[0], v0[1]}), b = gelu_pk((f32x2){v0[2], v0[3]}), c = gelu_pk((f32x2){v1[0], v1[1]}), d = gelu_pk((f32x2){v1[2], v1[3]});
                        v0 = (f32x4){a.x, a.y, b.x, b.y}; v1 = (f32x4){c.x, c.y, d.x, d.y}; }
                    v0 = v0 * sc; v1 = v1 * sc; u32x4 w; w.x = cvt_pk_bf16(v0[0], v0[1]); w.y = cvt_pk_bf16(v0[2], v0[3]); w.z = cvt_pk_bf16(v1[0], v1[1]); w.w = cvt_pk_bf16(v1[2], v1[3]);
                    *(u32x4*)(rowp + bj * HALF) = w; } }
    }
};
template <class Epi, class Sched, bool ALIGN_EPI = false, bool SP2 = false>
__device__ __forceinline__ void gemm_phase(PG8_LAS unsigned char* lds, const Gemm g, const Sched& S, const Epi& E, const int tid) {
    const int wid = __builtin_amdgcn_readfirstlane(tid >> 6), lane = tid & 63, wr = wid >> 2, wc = wid & 3, fr = lane & 15, fq = lane >> 4;
    const int K = g.K, nt = K / BK;
    unsigned voffA[2], voffB[2];
#pragma unroll
    for (int i = 0; i < 2; ++i) { int R, C; stage_rc(tid * 16 + i * 8192, R, C); const int Rb = Epi::PERM ? ((R & ~31) + perm32(R & 31)) : R;
        voffA[i] = (unsigned)(R * g.lda + C) * 2u; voffB[i] = (unsigned)(Rb * K + C) * 2u; }
    const size_t kstep = (size_t)(BK * 2);
    const size_t hstep = (size_t)HALF * K * 2;
    const size_t tstep = 2 * hstep; const size_t hstepA = (size_t)HALF * g.lda * 2, tstepA = 2 * hstepA;
    const unsigned ldsw = (unsigned)wid * 1024u;
    const int aoff = lds_byte(wr * 64 + fr, fq * 8), boff = lds_byte(wc * 32 + fr, fq * 8);
#define PG8_SA(b, h) (((b) * 2 + (h)) * HTB)
#define PG8_SB(b, h) ((4 + (b) * 2 + (h)) * HTB)
#define PG8_STAGE(bufoff, gbase, voff) do { _Pragma("unroll") for (int _i = 0; _i < 2; ++_i) \
        __builtin_amdgcn_global_load_lds((const unsigned*)((const char*)(gbase) + (voff)[_i]), (PG8_LAS unsigned*)(lds + (bufoff) + ldsw + _i * 8192), 16, 0, 0); } while (0)
#define PG8_LDA(dst, b, h) do { _Pragma("unroll") for (int m = 0; m < 4; ++m) _Pragma("unroll") for (int k = 0; k < 2; ++k) dst[m][k] = *(const PG8_LAS bf16x8*)(lds + PG8_SA(b, h) + aoff + m * 2048 + k * 1024); } while (0)
#define PG8_LDB(dst, b, h) do { _Pragma("unroll") for (int n = 0; n < 2; ++n) _Pragma("unroll") for (int k = 0; k < 2; ++k) dst[n][k] = *(const PG8_LAS bf16x8*)(lds + PG8_SB(b, h) + boff + n * 2048 + k * 1024); } while (0)
#define PG8_MMA(ai, bj, At, Bt) do { __builtin_amdgcn_s_setprio(1); _Pragma("unroll") for (int m = 0; m < 4; ++m) _Pragma("unroll") for (int n = 0; n < 2; ++n) _Pragma("unroll") for (int k = 0; k < 2; ++k) \
        acc[ai][bj][m][n] = __builtin_amdgcn_mfma_f32_16x16x32_bf16(Bt[n][k], At[m][k], acc[ai][bj][m][n], 0, 0, 0); __builtin_amdgcn_s_setprio(0); } while (0)
#define PG8_WAIT_V(n) asm volatile("s_waitcnt vmcnt(" #n ")" ::: "memory")
#define PG8_WAIT_L(n) asm volatile("s_waitcnt lgkmcnt(" #n ")" ::: "memory")
#define PG8_BAR __builtin_amdgcn_s_barrier()
#define PG8_SCHED __builtin_amdgcn_sched_barrier(0)
    Unit cur, nxt; int ui = 0;
    if (!S.next(0, cur)) return;
    f32x4 acc[2][2][4][2];
#pragma unroll
    for (int a = 0; a < 2; ++a)
#pragma unroll
        for (int b = 0; b < 2; ++b)
#pragma unroll
            for (int m = 0; m < 4; ++m)
#pragma unroll
                for (int n = 0; n < 2; ++n) acc[a][b][m][n] = (f32x4){0.f, 0.f, 0.f, 0.f};
    bf16x8 At[4][2], B0[2][2], B1[2][2];
    const char* cA = (const char*)g.A + S.a_off(cur) + (size_t)cur.pm * tstepA; const char* cB = (const char*)g.Bt + S.b_off(cur) + (size_t)cur.pn * tstep;
    S.a_ready(cur);
    if constexpr (SP2) {
        PG8_STAGE(PG8_SB(0, 0), cB, voffB); PG8_STAGE(PG8_SB(0, 1), cB + hstep, voffB); PG8_STAGE(PG8_SA(0, 0), cA, voffA); PG8_STAGE(PG8_SA(0, 1), cA + hstepA, voffA);
        if (wr == 1) PG8_BAR;
        PG8_WAIT_V(2); PG8_BAR;
        PG8_STAGE(PG8_SB(1, 0), cB + kstep, voffB); PG8_STAGE(PG8_SA(1, 0), cA + kstep, voffA); PG8_STAGE(PG8_SB(1, 1), cB + hstep + kstep, voffB);
        PG8_WAIT_V(6); PG8_BAR;
    } else {
        PG8_STAGE(PG8_SB(0, 0), cB, voffB); PG8_STAGE(PG8_SA(0, 0), cA, voffA); PG8_STAGE(PG8_SB(0, 1), cB + hstep, voffB); PG8_STAGE(PG8_SA(0, 1), cA + hstepA, voffA);
        if (wr == 1) PG8_BAR;
        PG8_WAIT_V(4); PG8_BAR;
        PG8_STAGE(PG8_SB(1, 0), cB + kstep, voffB); PG8_STAGE(PG8_SA(1, 0), cA + kstep, voffA); PG8_STAGE(PG8_SB(1, 1), cB + hstep + kstep, voffB);
        PG8_WAIT_V(6); PG8_BAR;
    }
    for (;;) {
        const bool has_next = S.next(ui + 1, nxt);
        const char* nA = has_next ? (const char*)g.A + S.a_off(nxt) + (size_t)nxt.pm * tstepA : cA; const char* nB = has_next ? (const char*)g.Bt + S.b_off(nxt) + (size_t)nxt.pn * tstep : cB;
        for (int t = 0; t < nt; t += 2) {
            const bool last = (t == nt - 2);
            const char* a1 = cA + (size_t)(t + 1) * kstep;
            const char* a2 = last ? nA : cA + (size_t)(t + 2) * kstep; const char* b2 = last ? nB : cB + (size_t)(t + 2) * kstep;
            const char* a3 = a2 + kstep; const char* b3 = b2 + kstep;
            if (last && has_next) S.a_ready(nxt);
            if constexpr (SP2) {
            PG8_LDB(B0, 0, 0); PG8_LDB(B1, 0, 1); PG8_SCHED; PG8_LDA(At, 0, 0); PG8_STAGE(PG8_SA(1, 1), a1 + hstepA, voffA);
            PG8_WAIT_V(8); PG8_WAIT_L(0); PG8_BAR; PG8_MMA(0, 0, At, B0); PG8_MMA(0, 1, At, B1); PG8_BAR; PG8_SCHED;
            PG8_LDA(At, 0, 1); PG8_STAGE(PG8_SB(0, 0), b2, voffB); PG8_STAGE(PG8_SB(0, 1), b2 + hstep, voffB); PG8_STAGE(PG8_SA(0, 0), a2, voffA);
            PG8_WAIT_V(8); PG8_WAIT_L(0); PG8_BAR; PG8_MMA(1, 0, At, B0); PG8_MMA(1, 1, At, B1); PG8_BAR; PG8_SCHED;
            PG8_LDB(B0, 1, 0); PG8_LDB(B1, 1, 1); PG8_SCHED; PG8_LDA(At, 1, 0); PG8_STAGE(PG8_SA(0, 1), a2 + hstepA, voffA);
            PG8_WAIT_V(8); PG8_WAIT_L(0); PG8_BAR; PG8_MMA(0, 0, At, B0); PG8_MMA(0, 1, At, B1); PG8_BAR; PG8_SCHED;
            PG8_LDA(At, 1, 1); PG8_STAGE(PG8_SB(1, 0), b3, voffB); PG8_STAGE(PG8_SB(1, 1), b3 + hstep, voffB); PG8_STAGE(PG8_SA(1, 0), a3, voffA);
            PG8_WAIT_V(8); PG8_WAIT_L(0); PG8_BAR; PG8_MMA(1, 0, At, B0); PG8_MMA(1, 1, At, B1); PG8_BAR; PG8_SCHED;
            } else {
            PG8_LDB(B0, 0, 0); PG8_SCHED; PG8_LDA(At, 0, 0); PG8_STAGE(PG8_SA(1, 1), a1 + hstepA, voffA);
            PG8_WAIT_L(8); PG8_BAR; PG8_WAIT_L(0); PG8_MMA(0, 0, At, B0); PG8_BAR; PG8_SCHED;
            PG8_LDB(B1, 0, 1); PG8_STAGE(PG8_SB(0, 0), b2, voffB);
            PG8_BAR; PG8_WAIT_L(0); PG8_MMA(0, 1, At, B1); PG8_BAR;
            PG8_LDA(At, 0, 1); PG8_STAGE(PG8_SA(0, 0), a2, voffA);
            PG8_BAR; PG8_WAIT_L(0); PG8_MMA(1, 0, At, B0); PG8_BAR; PG8_SCHED;
            PG8_STAGE(PG8_SB(0, 1), b2 + hstep, voffB);
            PG8_WAIT_V(6); PG8_BAR; PG8_MMA(1, 1, At, B1); PG8_BAR;
            PG8_LDB(B0, 1, 0); PG8_SCHED; PG8_LDA(At, 1, 0); PG8_STAGE(PG8_SA(0, 1), a2 + hstepA, voffA);
            PG8_WAIT_L(8); PG8_BAR; PG8_WAIT_L(0); PG8_MMA(0, 0, At, B0); PG8_BAR; PG8_SCHED;
            PG8_LDB(B1, 1, 1); PG8_STAGE(PG8_SB(1, 0), b3, voffB);
            PG8_BAR; PG8_WAIT_L(0); PG8_MMA(0, 1, At, B1); PG8_BAR;
            PG8_LDA(At, 1, 1); PG8_STAGE(PG8_SA(1, 0), a3, voffA);
            PG8_BAR; PG8_WAIT_L(0); PG8_MMA(1, 0, At, B0); PG8_BAR; PG8_SCHED;
            PG8_STAGE(PG8_SB(1, 1), b3 + hstep, voffB);
            PG8_WAIT_V(6); PG8_BAR; PG8_MMA(1, 1, At, B1); PG8_BAR;
            }
        }
        if constexpr (ALIGN_EPI) { if (wr == 0) PG8_BAR; }
        if constexpr (!Epi::AFTER_DRAIN) { E(acc, cur, wr, wc, fr, fq); S.done(cur); }
        if (!has_next) break;
        if (!E.keep(cur)) {
#pragma unroll
        for (int a = 0; a < 2; ++a)
#pragma unroll
            for (int b = 0; b < 2; ++b)
#pragma unroll
                for (int m = 0; m < 4; ++m)
#pragma unroll
                    for (int n = 0; n < 2; ++n) acc[a][b][m][n] = (f32x4){0.f, 0.f, 0.f, 0.f};
        }
        cur = nxt; cA = nA; cB = nB; ++ui;
        if constexpr (ALIGN_EPI) { if (wr == 1) PG8_BAR; }
    }
    PG8_WAIT_V(0);
    if constexpr (!ALIGN_EPI) { if (wr == 0) PG8_BAR; }
    PG8_BAR;
    if constexpr (Epi::AFTER_DRAIN) { E.fused(acc, cur, wr, wc, fr, fq, lds, wid, lane); S.done(cur); }
#undef PG8_SA
#undef PG8_SB
#undef PG8_STAGE
#undef PG8_LDA
#undef PG8_LDB
#undef PG8_MMA
#undef PG8_WAIT_V
#undef PG8_WAIT_L
#undef PG8_BAR
#undef PG8_SCHED
}
}

constexpr int BATCH = 4, SEQ = 8192, T = BATCH * SEQ, DM = 1024, DEPTH = 2;
constexpr int IN_COLS = 6022, NP = 3072, N_IN = 6144;
constexpr int N_EXP = 16384;
constexpr int PC_QA = 0, PC_QB = 384, PC_QC = 768, PC_KA = 1152, PC_VA = 1536, PC_KB = 1920, PC_VB = 2304, PC_KC = 2688, PC_VC = 2816, PC_FB = 2944;
constexpr int PC_MERGED = 1152;
constexpr float RMS_EPS = 1e-6f;
constexpr float LOG2E = 1.4426950408889634f;
constexpr float QK_SCALE2 = 0.125f * LOG2E;

constexpr size_t MiB = 1u << 20;
constexpr size_t WS_CTL = 0, CTL_ZERO_BYTES = 65536;
constexpr size_t WS_SSQ1 = 1 * MiB;
constexpr size_t WS_CUMT = 1 * MiB + 256 * 1024;
constexpr size_t WS_LOGF = 2 * MiB;
constexpr size_t WS_KMAX_BASE = 32768;
constexpr size_t WS_ROPE = 3 * MiB;
constexpr size_t WS_W = 12 * MiB, WL_STRIDE = 21 * MiB;
constexpr size_t WL_IN = 0, WL_BR = 12 * MiB, WL_OUT = WL_BR + 2304 * 1024, WL_Q = WL_OUT + 2 * MiB, WL_K12 = WL_Q + 4 * MiB;
static_assert(WL_K12 + 65536 <= WL_STRIDE, "weights");
constexpr size_t WS_HB = 56 * MiB;
constexpr size_t WS_P = 120 * MiB;
constexpr size_t WS_G = 312 * MiB;
constexpr size_t WS_SSQ2P = 504 * MiB;
constexpr size_t WS_END = 506 * MiB;
constexpr size_t WS_Q2 = WS_P;
constexpr size_t WS_IDS = WS_P + 128 * MiB;
constexpr size_t WS_GW = WS_P + 144 * MiB;
constexpr size_t WS_XQ = WS_P + 160 * MiB;
constexpr size_t WS_U16 = WS_G, WS_V16 = WS_G + 32 * MiB;
constexpr size_t WS_U8 = WS_G + 64 * MiB, WS_V8 = WS_G + 80 * MiB, WS_SU = WS_G + 96 * MiB, WS_SV = WS_G + 96 * MiB + 65536;
constexpr int CW_ATT = 64;

constexpr int LDS_BYTES = 147456;
constexpr int NPH = 1 + 8 * DEPTH;
#ifndef PH_MASK
#define PH_MASK 511
#endif

#define LAS __attribute__((address_space(3)))
typedef unsigned short bf16_t;
typedef short bf16x8 __attribute__((ext_vector_type(8)));
typedef float f32x4 __attribute__((ext_vector_type(4)));
typedef float f32x16 __attribute__((ext_vector_type(16)));
typedef unsigned u32x4 __attribute__((ext_vector_type(4)));
typedef unsigned u32x2 __attribute__((ext_vector_type(2)));
typedef short v4i16_t __attribute__((ext_vector_type(4)));
typedef float f32x2_t __attribute__((ext_vector_type(2)));
typedef __bf16 bf16x2_t __attribute__((ext_vector_type(2)));

__device__ __forceinline__ unsigned cvtpk(float lo, float hi) { f32x2_t v = {lo, hi}; bf16x2_t b = __builtin_convertvector(v, bf16x2_t); return __builtin_bit_cast(unsigned, b); }
__device__ __forceinline__ float bflo(unsigned u) { return __uint_as_float(u << 16); }
__device__ __forceinline__ float bfhi(unsigned u) { return __uint_as_float(u & 0xffff0000u); }
__device__ __forceinline__ float wave_sum(float v) {
#pragma unroll
    for (int o = 1; o < 64; o <<= 1) v += __shfl_xor(v, o);
    return v;
}
__device__ __forceinline__ float dot2bf(unsigned a, unsigned b, float acc) {
    return fmaf(bfhi(a), bfhi(b), fmaf(bflo(a), bflo(b), acc));
}

__host__ __device__ __forceinline__ int src_col_in(int n) {
    if (n >= 3072) return 2950 + (n - 3072);
    if (n >= 2950) return -1;
    if (n >= 2944) return 2304 + (n - 2944);
    int seg, src; bool rope;
    if (n < 384)       { seg = 0;    src = 0;    rope = true;  }
    else if (n < 768)  { seg = 384;  src = 1152; rope = false; }
    else if (n < 1152) { seg = 768;  src = 2310; rope = true;  }
    else if (n < 1536) { seg = 1152; src = 384;  rope = true;  }
    else if (n < 1920) { seg = 1536; src = 768;  rope = false; }
    else if (n < 2304) { seg = 1920; src = 1536; rope = false; }
    else if (n < 2688) { seg = 2304; src = 1920; rope = false; }
    else if (n < 2816) { seg = 2688; src = 2694; rope = true;  }
    else               { seg = 2816; src = 2822; rope = false; }
    int off = n - seg;
    if (rope) { const int blk = off >> 6, w = off & 63; off = blk * 64 + (w >> 1) + 32 * (w & 1); }
    return src + off;
}

__device__ __forceinline__ float ssq16(const float* __restrict__ pz, int row) {
    const f32x4* q = (const f32x4*)(pz + (size_t)row * 16);
    const f32x4 a = q[0], b = q[1], c = q[2], d = q[3];
    return (((a[0] + a[1]) + (a[2] + a[3])) + ((b[0] + b[1]) + (b[2] + b[3]))) + (((c[0] + c[1]) + (c[2] + c[3])) + ((d[0] + d[1]) + (d[2] + d[3])));
}

template <int MODE>
__device__ __forceinline__ void transpose_item(const float* __restrict__ W, int K, int Nsrc, bf16_t* __restrict__ WT, const float* __restrict__ kscale,
                                               LAS float* scr, int item, int nblk, int lane) {
    const int kb = item / nblk, nb = item % nblk, k0 = 64 * kb, n0 = 32 * nb;
    const int nn = n0 + (lane & 31);
    const int c = (MODE == 1) ? src_col_in(nn) : nn;
#pragma unroll 8
    for (int i = 0; i < 32; ++i) {
        const int kk = 2 * i + (lane >> 5);
        float v = 0.f;
        if (c >= 0) v = W[(size_t)(k0 + kk) * Nsrc + c];
        if (kscale) v *= kscale[k0 + kk];
        if (MODE == 1 && nn >= 3072) v *= -LOG2E;
        scr[kk * 33 + (lane & 31)] = v;
    }
    asm volatile("s_waitcnt lgkmcnt(0)" ::: "memory");
    const int c8 = lane & 7;
#pragma unroll
    for (int j = 0; j < 4; ++j) {
        const int n = (lane >> 3) + 8 * j; const LAS float* s = scr + (8 * c8) * 33 + n;
        u32x4 o; o.x = cvtpk(s[0 * 33], s[1 * 33]); o.y = cvtpk(s[2 * 33], s[3 * 33]); o.z = cvtpk(s[4 * 33], s[5 * 33]); o.w = cvtpk(s[6 * 33], s[7 * 33]);
        *(u32x4*)(WT + (size_t)(n0 + n) * K + k0 + 8 * c8) = o;
    }
    asm volatile("s_waitcnt lgkmcnt(0)" ::: "memory");
}

#ifndef EPI_NT
#define EPI_NT 0
#endif
struct EpiIn {
    static constexpr bool PERM = true, AFTER_DRAIN = false;
    __device__ __forceinline__ bool keep(const pg8::Unit&) const { return false; }
    bf16_t* P; bf16_t* G; const float* ssq; const float* rope; const float* bgate; const float* bfg; float* logf; int nostore;
    __device__ __forceinline__ void operator()(const pg8::f32x4 (&acc)[2][2][4][2], const pg8::Unit& u, int wr, int wc, int fr, int fq) const {
        const int colw = u.pn * 256 + wc * 32 + 8 * fq;
        const int row0 = u.pm * 256 + wr * 64 + fr;
        float rsv[8];
#pragma unroll
        for (int i = 0; i < 8; ++i) rsv[i] = ssq[row0 + (i >> 2) * 128 + (i & 3) * 16];
#pragma unroll
        for (int i = 0; i < 8; ++i) rsv[i] = rsqrtf(rsv[i] * (1.0f / 1024.0f) + RMS_EPS);
        if (colw >= 3072) {
            const int g0 = colw - 3072;
            f32x4 bg[2][2];
#pragma unroll
            for (int bj = 0; bj < 2; ++bj) { bg[bj][0] = *(const f32x4*)(bgate + g0 + bj * 128) * -LOG2E; bg[bj][1] = *(const f32x4*)(bgate + g0 + bj * 128 + 4) * -LOG2E; }
            unsigned char* G8 = (unsigned char*)G;
            const int gbyte = (u.pn - 12) * 256 + wc * 64 + fq * 16;
#pragma unroll
            for (int i = 0; i < 8; ++i) {
                const int ai = i >> 2, m = i & 3;
                const int row = row0 + ai * 128 + m * 16;
                const float rs = rsv[i];
                u32x4 w;
#pragma unroll
                for (int bj = 0; bj < 2; ++bj) {
                    float v[8];
#pragma unroll
                    for (int e = 0; e < 4; ++e) {
                        v[e] = 255.0f * __builtin_amdgcn_rcpf(1.0f + __builtin_amdgcn_exp2f(fmaf(acc[ai][bj][m][0][e], rs, bg[bj][0][e])));
                        v[4 + e] = 255.0f * __builtin_amdgcn_rcpf(1.0f + __builtin_amdgcn_exp2f(fmaf(acc[ai][bj][m][1][e], rs, bg[bj][1][e])));
                    }
                    unsigned lo = 0, hi_ = 0;
                    lo = __builtin_amdgcn_cvt_pk_u8_f32(v[0], 0, lo); lo = __builtin_amdgcn_cvt_pk_u8_f32(v[1], 1, lo); lo = __builtin_amdgcn_cvt_pk_u8_f32(v[2], 2, lo); lo = __builtin_amdgcn_cvt_pk_u8_f32(v[3], 3, lo);
                    hi_ = __builtin_amdgcn_cvt_pk_u8_f32(v[4], 0, hi_); hi_ = __builtin_amdgcn_cvt_pk_u8_f32(v[5], 1, hi_); hi_ = __builtin_amdgcn_cvt_pk_u8_f32(v[6], 2, hi_); hi_ = __builtin_amdgcn_cvt_pk_u8_f32(v[7], 3, hi_);
                    if (bj == 0) { w.x = lo; w.y = hi_; } else { w.z = lo; w.w = hi_; }
                }
                if (!(nostore && w.x != 0x12345678u)) { if (EPI_NT & 1) __builtin_nontemporal_store(w, (u32x4*)(G8 + (size_t)row * 3072 + gbyte)); else *(u32x4*)(G8 + (size_t)row * 3072 + gbyte) = w; }
            }
        } else {
            bool rp[2];
#pragma unroll
            for (int bj = 0; bj < 2; ++bj) { const int cb = colw + bj * 128; rp[bj] = (cb < 384) || (cb >= 768 && cb < 1536) || (cb >= 2688 && cb < 2816); }
            f32x4 rn[2][2];
#pragma unroll
            for (int bj = 0; bj < 2; ++bj) if (rp[bj]) { const float* r = rope + ((size_t)row0 * 32 + (((colw + bj * 128) & 63) >> 1)) * 2; rn[bj][0] = *(const f32x4*)r; rn[bj][1] = *(const f32x4*)(r + 4); }
#pragma unroll
            for (int i = 0; i < 8; ++i) {
                const int ai = i >> 2, m = i & 3;
                const int row = row0 + ai * 128 + m * 16;
                const float rs = rsv[i];
                f32x4 rc[2][2];
#pragma unroll
                for (int bj = 0; bj < 2; ++bj) { rc[bj][0] = rn[bj][0]; rc[bj][1] = rn[bj][1]; }
                if (i < 7) {
                    const int rown = row0 + ((i + 1) >> 2) * 128 + ((i + 1) & 3) * 16;
#pragma unroll
                    for (int bj = 0; bj < 2; ++bj) if (rp[bj]) { const float* r = rope + ((size_t)rown * 32 + (((colw + bj * 128) & 63) >> 1)) * 2; rn[bj][0] = *(const f32x4*)r; rn[bj][1] = *(const f32x4*)(r + 4); }
                }
#pragma unroll
                for (int bj = 0; bj < 2; ++bj) {
                    const int cb = colw + bj * 128;
                    float v[8];
#pragma unroll
                    for (int e = 0; e < 4; ++e) { v[e] = acc[ai][bj][m][0][e] * rs; v[4 + e] = acc[ai][bj][m][1][e] * rs; }
                    if (rp[bj]) {
                        const f32x4 r0 = rc[bj][0], r1 = rc[bj][1];
                        float a, b;
                        a = v[0]; b = v[1]; v[0] = a * r0[0] - b * r0[1]; v[1] = b * r0[0] + a * r0[1];
                        a = v[2]; b = v[3]; v[2] = a * r0[2] - b * r0[3]; v[3] = b * r0[2] + a * r0[3];
                        a = v[4]; b = v[5]; v[4] = a * r1[0] - b * r1[1]; v[5] = b * r1[0] + a * r1[1];
                        a = v[6]; b = v[7]; v[6] = a * r1[2] - b * r1[3]; v[7] = b * r1[2] + a * r1[3];
                    }
                    if (cb == PC_FB) {
#pragma unroll
                        for (int e = 0; e < 6; ++e) { const float z = v[e] + bfg[e]; logf[(size_t)row * 8 + e] = fminf(z, 0.f) - log1pf(__expf(-fabsf(z))); }
                    }
                    u32x4 w; w.x = cvtpk(v[0], v[1]); w.y = cvtpk(v[2], v[3]); w.z = cvtpk(v[4], v[5]); w.w = cvtpk(v[6], v[7]);
                    if (!(nostore && w.x != 0x12345678u)) { if (EPI_NT & 1) __builtin_nontemporal_store(w, (u32x4*)(P + (size_t)row * NP + cb)); else *(u32x4*)(P + (size_t)row * NP + cb) = w; }
                }
            }
        }
    }
};
struct EpiDry {
    static constexpr bool PERM = true, AFTER_DRAIN = false;
    __device__ __forceinline__ bool keep(const pg8::Unit&) const { return false; }
    float* sink;
    __device__ __forceinline__ void operator()(const pg8::f32x4 (&acc)[2][2][4][2], const pg8::Unit& u, int wr, int wc, int fr, int fq) const {
        float t = 0.f;
#pragma unroll
        for (int ai = 0; ai < 2; ++ai)
#pragma unroll
            for (int bj = 0; bj < 2; ++bj)
#pragma unroll
                for (int m = 0; m < 4; ++m)
#pragma unroll
                    for (int n = 0; n < 2; ++n) t += acc[ai][bj][m][n][0] + acc[ai][bj][m][n][1] + acc[ai][bj][m][n][2] + acc[ai][bj][m][n][3];
        if (t == 1.2345e33f) sink[u.pm] = t;
    }
};
struct EpiBr {
    static constexpr bool PERM = true, AFTER_DRAIN = false;
    __device__ __forceinline__ bool keep(const pg8::Unit&) const { return false; }
    const bf16_t* Gi; bf16_t* Mg; int first;
    __device__ __forceinline__ void operator()(const pg8::f32x4 (&acc)[2][2][4][2], const pg8::Unit& u, int wr, int wc, int fr, int fq) const {
        const int colw = u.pn * 256 + wc * 32 + 8 * fq;
#pragma unroll
        for (int ai = 0; ai < 2; ++ai)
#pragma unroll
            for (int m = 0; m < 4; ++m) {
                const int row = u.pm * 256 + ai * 128 + wr * 64 + m * 16 + fr;
#pragma unroll
                for (int bj = 0; bj < 2; ++bj) {
                    const int cb = colw + bj * 128;
                    const u32x4 g = *(const u32x4*)(Gi + (size_t)row * NP + cb);
                    float v[8];
                    v[0] = bflo(g.x) * acc[ai][bj][m][0][0]; v[1] = bfhi(g.x) * acc[ai][bj][m][0][1]; v[2] = bflo(g.y) * acc[ai][bj][m][0][2]; v[3] = bfhi(g.y) * acc[ai][bj][m][0][3];
                    v[4] = bflo(g.z) * acc[ai][bj][m][1][0]; v[5] = bfhi(g.z) * acc[ai][bj][m][1][1]; v[6] = bflo(g.w) * acc[ai][bj][m][1][2]; v[7] = bfhi(g.w) * acc[ai][bj][m][1][3];
                    bf16_t* mp = Mg + (size_t)row * NP + cb;
                    if (!first) { const u32x4 o = *(const u32x4*)mp;
                        v[0] += bflo(o.x); v[1] += bfhi(o.x); v[2] += bflo(o.y); v[3] += bfhi(o.y); v[4] += bflo(o.z); v[5] += bfhi(o.z); v[6] += bflo(o.w); v[7] += bfhi(o.w); }
                    u32x4 w; w.x = cvtpk(v[0], v[1]); w.y = cvtpk(v[2], v[3]); w.z = cvtpk(v[4], v[5]); w.w = cvtpk(v[6], v[7]);
                    *(u32x4*)mp = w;
                }
                if (m & 1) asm volatile("" ::: "memory");
            }
    }
};
struct BranchOrder {
    pg8::StaticOrder so;
    __device__ __forceinline__ void init(int M, int N, int G_, int c_) { so.init(M, N, G_, c_); }
    __device__ __forceinline__ bool next(int i, pg8::Unit& u) const { const int ti = i / 3; if (!so.next(ti, u)) return false; u.br = i - 3 * ti; return true; }
    __device__ __forceinline__ size_t a_off(const pg8::Unit& u) const { return (size_t)u.br * 384 * 2; }
    __device__ __forceinline__ size_t b_off(const pg8::Unit& u) const { return (size_t)u.br * DM * 384 * 2; }
    __device__ __forceinline__ void a_ready(const pg8::Unit&) const {}
    __device__ __forceinline__ void done(const pg8::Unit&) const {}
};
struct EpiBrChain {
    static constexpr bool PERM = true, AFTER_DRAIN = false;
    const unsigned char* G8; bf16_t* Mg;
    __device__ __forceinline__ bool keep(const pg8::Unit& u) const { return u.br < 2; }
    __device__ __forceinline__ void operator()(pg8::f32x4 (&acc)[2][2][4][2], const pg8::Unit& u, int wr, int wc, int fr, int fq) const {
        const int colw = u.pn * 256 + wc * 32 + 8 * fq, br = u.br;
        const int row0 = u.pm * 256 + wr * 64 + fr;
        const int gbyte = br * 1024 + u.pn * 256 + wc * 64 + fq * 16;
        constexpr float GEPS = 1e-6f, I255 = 1.0f / 255.0f;
        u32x4 gcn, gnn;
        gcn = *(const u32x4*)(G8 + (size_t)row0 * 3072 + gbyte);
        if (br < 2) gnn = *(const u32x4*)(G8 + (size_t)row0 * 3072 + gbyte + 1024);
#pragma unroll
        for (int i = 0; i < 8; ++i) {
            const int ai = i >> 2, m = i & 3;
            const int row = row0 + ai * 128 + m * 16;
            const u32x4 gc = gcn, gn = gnn;
            if (i < 7) {
                const int rown = row0 + ((i + 1) >> 2) * 128 + ((i + 1) & 3) * 16;
                gcn = *(const u32x4*)(G8 + (size_t)rown * 3072 + gbyte);
                if (br < 2) gnn = *(const u32x4*)(G8 + (size_t)rown * 3072 + gbyte + 1024);
            }
#pragma unroll
            for (int bj = 0; bj < 2; ++bj) {
                const unsigned c0 = bj == 0 ? gc.x : gc.z, c1 = bj == 0 ? gc.y : gc.w;
                float f[8] = {(float)(c0 & 255u), (float)((c0 >> 8) & 255u), (float)((c0 >> 16) & 255u), (float)(c0 >> 24), (float)(c1 & 255u), (float)((c1 >> 8) & 255u), (float)((c1 >> 16) & 255u), (float)(c1 >> 24)};
#pragma unroll
                for (int e = 0; e < 8; ++e) f[e] *= I255;
                if (br > 0) {
#pragma unroll
                    for (int e = 0; e < 8; ++e) f[e] = fmaxf(f[e], GEPS);
                }
                if (br < 2) {
                    const unsigned n0 = bj == 0 ? gn.x : gn.z, n1 = bj == 0 ? gn.y : gn.w;
                    const float d[8] = {(float)(n0 & 255u), (float)((n0 >> 8) & 255u), (float)((n0 >> 16) & 255u), (float)(n0 >> 24), (float)(n1 & 255u), (float)((n1 >> 8) & 255u), (float)((n1 >> 16) & 255u), (float)(n1 >> 24)};
#pragma unroll
                    for (int e = 0; e < 8; ++e) f[e] *= __builtin_amdgcn_rcpf(fmaxf(d[e] * I255, GEPS));
#pragma unroll
                    for (int e = 0; e < 4; ++e) { acc[ai][bj][m][0][e] *= f[e]; acc[ai][bj][m][1][e] *= f[4 + e]; }
                } else {
                    float v[8];
#pragma unroll
                    for (int e = 0; e < 4; ++e) { v[e] = acc[ai][bj][m][0][e] * f[e]; v[4 + e] = acc[ai][bj][m][1][e] * f[4 + e]; }
                    u32x4 w; w.x = cvtpk(v[0], v[1]); w.y = cvtpk(v[2], v[3]); w.z = cvtpk(v[4], v[5]); w.w = cvtpk(v[6], v[7]);
                    *(u32x4*)(Mg + (size_t)row * NP + colw + bj * 128) = w;
                }
            }
        }
    }
};
struct EpiOut {
    static constexpr bool PERM = true, AFTER_DRAIN = false;
    __device__ __forceinline__ bool keep(const pg8::Unit&) const { return false; }
    const float* Hin; float* H; bf16_t* HB; float* ssq;
    __device__ __forceinline__ void operator()(const pg8::f32x4 (&acc)[2][2][4][2], const pg8::Unit& u, int wr, int wc, int fr, int fq) const {
        const int colw = u.pn * 256 + wc * 32 + 8 * fq;
        const int row0 = u.pm * 256 + wr * 64 + fr;
        f32x4 hn[2][2];
#pragma unroll
        for (int bj = 0; bj < 2; ++bj) { const float* hi_ = Hin + (size_t)row0 * DM + colw + bj * 128; hn[bj][0] = *(const f32x4*)hi_; hn[bj][1] = *(const f32x4*)(hi_ + 4); }
#pragma unroll
        for (int i = 0; i < 8; ++i) {
            const int ai = i >> 2, m = i & 3;
            const int row = row0 + ai * 128 + m * 16;
            f32x4 hc[2][2];
#pragma unroll
            for (int bj = 0; bj < 2; ++bj) { hc[bj][0] = hn[bj][0]; hc[bj][1] = hn[bj][1]; }
            if (i < 7) {
                const int rown = row0 + ((i + 1) >> 2) * 128 + ((i + 1) & 3) * 16;
#pragma unroll
                for (int bj = 0; bj < 2; ++bj) { const float* hi_ = Hin + (size_t)rown * DM + colw + bj * 128; hn[bj][0] = *(const f32x4*)hi_; hn[bj][1] = *(const f32x4*)(hi_ + 4); }
            }
            float ss = 0.f;
#pragma unroll
            for (int bj = 0; bj < 2; ++bj) {
                const int cb = colw + bj * 128;
                float* hp = H + (size_t)row * DM + cb;
                f32x4 h0 = hc[bj][0] + acc[ai][bj][m][0], h1 = hc[bj][1] + acc[ai][bj][m][1];
                if (EPI_NT & 2) { __builtin_nontemporal_store(h0, (f32x4*)hp); __builtin_nontemporal_store(h1, (f32x4*)(hp + 4)); } else { *(f32x4*)hp = h0; *(f32x4*)(hp + 4) = h1; }
                u32x4 w; w.x = cvtpk(h0[0], h0[1]); w.y = cvtpk(h0[2], h0[3]); w.z = cvtpk(h1[0], h1[1]); w.w = cvtpk(h1[2], h1[3]);
                *(u32x4*)(HB + (size_t)row * DM + cb) = w;
                ss += (h0[0] * h0[0] + h0[1] * h0[1]) + (h0[2] * h0[2] + h0[3] * h0[3]) + (h1[0] * h1[0] + h1[1] * h1[1]) + (h1[2] * h1[2] + h1[3] * h1[3]);
            }
            ss += __shfl_xor(ss, 16); ss += __shfl_xor(ss, 32);
            if (fq == 0) ssq[(size_t)row * 16 + u.pn * 4 + wc] = ss;
        }
    }
};
struct EpiQ {
    static constexpr bool PERM = true, AFTER_DRAIN = false;
    __device__ __forceinline__ bool keep(const pg8::Unit&) const { return false; }
    bf16_t* Q; const float* ssq;
    __device__ __forceinline__ void operator()(const pg8::f32x4 (&acc)[2][2][4][2], const pg8::Unit& u, int wr, int wc, int fr, int fq) const {
        const int colw = u.pn * 256 + wc * 32 + 8 * fq;
        const int row0 = u.pm * 256 + wr * 64 + fr;
        float rsv[8];
#pragma unroll
        for (int i = 0; i < 4; ++i) rsv[i] = ssq16(ssq, row0 + (i & 3) * 16);
        asm volatile("" ::: "memory");
#pragma unroll
        for (int i = 4; i < 8; ++i) rsv[i] = ssq16(ssq, row0 + 128 + (i & 3) * 16);
#pragma unroll
        for (int i = 0; i < 8; ++i) rsv[i] = rsqrtf(rsv[i] * (1.0f / 1024.0f) + RMS_EPS);
#pragma unroll
        for (int i = 0; i < 8; ++i) {
            const int ai = i >> 2, m = i & 3;
            const int row = row0 + ai * 128 + m * 16;
            const float rs = rsv[i];
#pragma unroll
            for (int bj = 0; bj < 2; ++bj) {
                const int cb = colw + bj * 128;
                const f32x4 a = acc[ai][bj][m][0] * rs, b = acc[ai][bj][m][1] * rs;
                u32x4 w; w.x = cvtpk(a[0], a[1]); w.y = cvtpk(a[2], a[3]); w.z = cvtpk(b[0], b[1]); w.w = cvtpk(b[2], b[3]);
                if (EPI_NT & 4) __builtin_nontemporal_store(w, (u32x4*)(Q + (size_t)row * 2048 + cb)); else *(u32x4*)(Q + (size_t)row * 2048 + cb) = w;
            }
        }
    }
};

constexpr int VRP = 144;
constexpr int ATT_WAVE_LDS = 32 * VRP + 256 + 8192;
__device__ __forceinline__ int crow(int r, int hi) { return (r & 3) + 8 * (r >> 2) + 4 * hi; }

struct AttState { float m, l; f32x16 o0, o1; };
struct KTile { u32x4 k0, k1, k2, k3; float ck; };
struct VTile { u32x4 v0, v1, v2, v3; };
struct KFrag { bf16x8 k0, k1, k2, k3; };

template <bool BIAS>
__device__ __forceinline__ void k_load(KTile& t, const bf16_t* __restrict__ Pb, int kcol, int r, int ktile, const float* __restrict__ cumT, int lane) {
    const int row = lane >> 3, ch = lane & 7;
    const bf16_t* base = Pb + kcol + 8 * ch;
    int t0 = ktile + row * r, t1 = t0 + 8 * r, t2 = t0 + 16 * r, t3 = t0 + 24 * r;
    t0 = t0 < 0 ? 0 : (t0 > SEQ - 1 ? SEQ - 1 : t0); t1 = t1 < 0 ? 0 : (t1 > SEQ - 1 ? SEQ - 1 : t1);
    t2 = t2 < 0 ? 0 : (t2 > SEQ - 1 ? SEQ - 1 : t2); t3 = t3 < 0 ? 0 : (t3 > SEQ - 1 ? SEQ - 1 : t3);
    t.k0 = *(const u32x4*)(base + (size_t)t0 * NP); t.k1 = *(const u32x4*)(base + (size_t)t1 * NP); t.k2 = *(const u32x4*)(base + (size_t)t2 * NP); t.k3 = *(const u32x4*)(base + (size_t)t3 * NP);
    t.ck = 0.f;
    if (BIAS) { int tk_l = ktile + (lane & 31) * r; tk_l = tk_l < 0 ? 0 : (tk_l > SEQ - 1 ? SEQ - 1 : tk_l); t.ck = cumT[tk_l]; }
}
__device__ __forceinline__ void v_load(VTile& t, const bf16_t* __restrict__ Pb, int vcol, int r, int ktile, int lane) {
    const int row = lane >> 3, ch = lane & 7;
    const bf16_t* base = Pb + vcol + 8 * ch;
    int t0 = ktile + row * r, t1 = t0 + 8 * r, t2 = t0 + 16 * r, t3 = t0 + 24 * r;
    t0 = t0 < 0 ? 0 : (t0 > SEQ - 1 ? SEQ - 1 : t0); t1 = t1 < 0 ? 0 : (t1 > SEQ - 1 ? SEQ - 1 : t1);
    t2 = t2 < 0 ? 0 : (t2 > SEQ - 1 ? SEQ - 1 : t2); t3 = t3 < 0 ? 0 : (t3 > SEQ - 1 ? SEQ - 1 : t3);
    t.v0 = *(const u32x4*)(base + (size_t)t0 * NP); t.v1 = *(const u32x4*)(base + (size_t)t1 * NP); t.v2 = *(const u32x4*)(base + (size_t)t2 * NP); t.v3 = *(const u32x4*)(base + (size_t)t3 * NP);
}
__device__ __forceinline__ void k_stage(const KTile& t, LAS unsigned char* vl, KFrag& f, int lane) {
    asm volatile("" ::: "memory");
    {
        LAS unsigned char* wp = vl + (lane >> 3) * VRP + (lane & 7) * 16;
        *(LAS u32x4*)(wp) = t.k0; *(LAS u32x4*)(wp + 8 * VRP) = t.k1; *(LAS u32x4*)(wp + 16 * VRP) = t.k2; *(LAS u32x4*)(wp + 24 * VRP) = t.k3;
    }
    asm volatile("s_waitcnt lgkmcnt(0)" ::: "memory");
    const LAS unsigned char* rp = vl + (lane & 31) * VRP + (lane >> 5) * 16;
    f.k0 = *(const LAS bf16x8*)(rp); f.k1 = *(const LAS bf16x8*)(rp + 32); f.k2 = *(const LAS bf16x8*)(rp + 64); f.k3 = *(const LAS bf16x8*)(rp + 96);
    asm volatile("s_waitcnt lgkmcnt(0)" ::: "memory");
}
template <bool BIAS>
__device__ __forceinline__ void v_stage(const VTile& t, float ck, LAS unsigned char* vl, bf16x8 (&vf)[2][2], int lane) {
    const int hi = lane >> 5, l31 = lane & 31, q4 = (lane & 15) >> 2, p4 = lane & 3, g1 = (lane >> 4) & 1;
    asm volatile("" ::: "memory");
    {
        LAS unsigned char* wp = vl + (lane >> 3) * VRP + (lane & 7) * 16;
        *(LAS u32x4*)(wp) = t.v0; *(LAS u32x4*)(wp + 8 * VRP) = t.v1; *(LAS u32x4*)(wp + 16 * VRP) = t.v2; *(LAS u32x4*)(wp + 24 * VRP) = t.v3;
        if (BIAS) { if (hi == 0) ((LAS float*)(vl + 32 * VRP))[l31] = ck; }
    }
    asm volatile("s_waitcnt lgkmcnt(0)" ::: "memory");
    const LAS unsigned char* vb = vl + (4 * hi + q4) * VRP + (16 * g1 + 4 * p4) * 2;
#pragma unroll
    for (int dblk = 0; dblk < 2; ++dblk)
#pragma unroll
        for (int s2 = 0; s2 < 2; ++s2) {
            const LAS unsigned char* a = vb + (16 * s2) * VRP + dblk * 64;
            const v4i16_t lo = __builtin_amdgcn_ds_read_tr16_b64_v4i16((LAS v4i16_t*)a);
            const v4i16_t hh = __builtin_amdgcn_ds_read_tr16_b64_v4i16((LAS v4i16_t*)(a + 8 * VRP));
            vf[dblk][s2] = (bf16x8){lo[0], lo[1], lo[2], lo[3], hh[0], hh[1], hh[2], hh[3]};
        }
}
__device__ __forceinline__ float max_halves(float v) {
    const auto rr = __builtin_amdgcn_permlane32_swap(__float_as_uint(v), __float_as_uint(v), false, false);
    return fmaxf(__uint_as_float(rr[0]), __uint_as_float(rr[1]));
}
__device__ __forceinline__ void softmax_pv(f32x16& s, float scale, AttState& st, const bf16x8 (&vf)[2][2]) {
    float mx = s[0];
#pragma unroll
    for (int i = 1; i < 16; ++i) mx = fmaxf(mx, s[i]);
    mx = max_halves(mx) * scale;
    float m_use = (st.m == -INFINITY) ? 0.f : st.m;
    if (!__all(mx <= st.m + 8.0f)) {
        const float m_new = fmaxf(st.m, mx);
        m_use = (m_new == -INFINITY) ? 0.f : m_new;
        const float alpha = __builtin_amdgcn_exp2f(st.m - m_use);
        st.l *= alpha; st.m = m_new;
#pragma unroll
        for (int i = 0; i < 16; ++i) { st.o0[i] *= alpha; st.o1[i] *= alpha; }
    }
    float rsum = 0.f;
#pragma unroll
    for (int i = 0; i < 16; ++i) { s[i] = __builtin_amdgcn_exp2f(fmaf(s[i], scale, -m_use)); rsum += s[i]; }
    st.l += rsum;
    u32x4 pw0, pw1;
    pw0.x = cvtpk(s[0], s[1]); pw0.y = cvtpk(s[2], s[3]); pw0.z = cvtpk(s[4], s[5]); pw0.w = cvtpk(s[6], s[7]);
    pw1.x = cvtpk(s[8], s[9]); pw1.y = cvtpk(s[10], s[11]); pw1.z = cvtpk(s[12], s[13]); pw1.w = cvtpk(s[14], s[15]);
    const bf16x8 pb0 = __builtin_bit_cast(bf16x8, pw0), pb1 = __builtin_bit_cast(bf16x8, pw1);
    st.o0 = __builtin_amdgcn_mfma_f32_32x32x16_bf16(vf[0][0], pb0, st.o0, 0, 0, 0);
    st.o0 = __builtin_amdgcn_mfma_f32_32x32x16_bf16(vf[0][1], pb1, st.o0, 0, 0, 0);
    st.o1 = __builtin_amdgcn_mfma_f32_32x32x16_bf16(vf[1][0], pb0, st.o1, 0, 0, 0);
    st.o1 = __builtin_amdgcn_mfma_f32_32x32x16_bf16(vf[1][1], pb1, st.o1, 0, 0, 0);
}
__device__ __forceinline__ f32x16 qk_tile(const KFrag& t, const bf16x8 (&qf)[4]) {
    f32x16 s;
#pragma unroll
    for (int i = 0; i < 16; ++i) s[i] = 0.f;
    s = __builtin_amdgcn_mfma_f32_32x32x16_bf16(t.k0, qf[0], s, 0, 0, 0);
    s = __builtin_amdgcn_mfma_f32_32x32x16_bf16(t.k1, qf[1], s, 0, 0, 0);
    s = __builtin_amdgcn_mfma_f32_32x32x16_bf16(t.k2, qf[2], s, 0, 0, 0);
    s = __builtin_amdgcn_mfma_f32_32x32x16_bf16(t.k3, qf[3], s, 0, 0, 0);
    return s;
}

__device__ __forceinline__ f32x16 qk_tile_lds(const KFrag& t, const LAS unsigned char* qb) {
    f32x16 s;
#pragma unroll
    for (int i = 0; i < 16; ++i) s[i] = 0.f;
    s = __builtin_amdgcn_mfma_f32_32x32x16_bf16(t.k0, *(const LAS bf16x8*)(qb), s, 0, 0, 0);
    s = __builtin_amdgcn_mfma_f32_32x32x16_bf16(t.k1, *(const LAS bf16x8*)(qb + 1024), s, 0, 0, 0);
    s = __builtin_amdgcn_mfma_f32_32x32x16_bf16(t.k2, *(const LAS bf16x8*)(qb + 2048), s, 0, 0, 0);
    s = __builtin_amdgcn_mfma_f32_32x32x16_bf16(t.k3, *(const LAS bf16x8*)(qb + 3072), s, 0, 0, 0);
    return s;
}

__device__ __forceinline__ void attn_segment(const bf16_t* __restrict__ Pb, int kcol, int vcol, int r, int maxd_tok, int kt0, int ntiles, int tq,
                                             const bf16x8 (&qf)[4], AttState& st, LAS unsigned char* vl, int lane) {
    const int hi = lane >> 5;
    const int lim = maxd_tok < tq ? maxd_tok : tq;
    KTile nx; VTile vnx;
    k_load<false>(nx, Pb, kcol, r, kt0, nullptr, lane); v_load(vnx, Pb, vcol, r, kt0, lane);
    for (int j = 0; j < ntiles; ++j) {
        const int ktile = kt0 + j * 32 * r;
        const VTile vt = vnx;
        const KTile cur = nx;
        if (j + 1 < ntiles) { k_load<false>(nx, Pb, kcol, r, ktile + 32 * r, nullptr, lane); v_load(vnx, Pb, vcol, r, ktile + 32 * r, lane); }
        KFrag kf; k_stage(cur, vl, kf, lane);
        f32x16 s = qk_tile(kf, qf);
        bf16x8 vf[2][2];
        v_stage<false>(vt, 0.f, vl, vf, lane);
        const int dbase = tq - ktile - 4 * hi * r;
#pragma unroll
        for (int i = 0; i < 16; ++i) {
            const int d = dbase - crow(i, 0) * r;
            s[i] = ((unsigned)d <= (unsigned)lim) ? s[i] : -INFINITY;
        }
        softmax_pv(s, QK_SCALE2, st, vf);
        asm volatile("s_waitcnt lgkmcnt(0)" ::: "memory");
    }
}

__device__ __forceinline__ void attn_load_q(const bf16_t* __restrict__ Pb, int tq, int qcol, int hi, bf16x8 (&qf)[4]) {
    const bf16_t* qp = Pb + (size_t)tq * NP + qcol + 8 * hi;
    qf[0] = *(const bf16x8*)(qp); qf[1] = *(const bf16x8*)(qp + 16); qf[2] = *(const bf16x8*)(qp + 32); qf[3] = *(const bf16x8*)(qp + 48);
}
__device__ __forceinline__ void attn_store_o(bf16_t* __restrict__ Pb, int tq, int ocol, int hi, AttState& st, int dry) {
    float l = st.l + __shfl_xor(st.l, 32);
    if (dry && l >= 0.f) return;
    const float inv = 1.0f / l;
    bf16_t* op = Pb + (size_t)tq * NP + ocol + 4 * hi;
#pragma unroll
    for (int g = 0; g < 4; ++g) {
        u32x2 w0, w1;
        w0.x = cvtpk(st.o0[4 * g] * inv, st.o0[4 * g + 1] * inv); w0.y = cvtpk(st.o0[4 * g + 2] * inv, st.o0[4 * g + 3] * inv);
        w1.x = cvtpk(st.o1[4 * g] * inv, st.o1[4 * g + 1] * inv); w1.y = cvtpk(st.o1[4 * g + 2] * inv, st.o1[4 * g + 3] * inv);
        *(u32x2*)(op + 8 * g) = w0; *(u32x2*)(op + 32 + 8 * g) = w1;
    }
}
__device__ __forceinline__ void att_init(AttState& st) {
#pragma unroll
    for (int i = 0; i < 16; ++i) { st.o0[i] = 0.f; st.o1[i] = 0.f; }
    st.m = -INFINITY; st.l = 0.f;
}

__device__ __forceinline__ void attn_fox_pair(bf16_t* __restrict__ Pb, const float* __restrict__ cumT, float kmax2, int h, int qp, LAS unsigned char* vl, int lane, int dry) {
    const int hi = lane >> 5, l31 = lane & 31;
    const int kcol = PC_KB + 64 * h, vcol = PC_VB + 64 * h, qcol = PC_QB + 64 * h;
    const LAS float* ckl = (const LAS float*)(vl + 32 * VRP);
    AttState st0, st1; att_init(st0); att_init(st1);
    const int tq0 = 64 * qp + l31, tq1 = tq0 + 32;
    LAS unsigned char* qb0 = vl + 32 * VRP + 256 + hi * 512 + l31 * 16;
    LAS unsigned char* qb1 = qb0 + 4096;
    {
        bf16x8 qf[4];
        attn_load_q(Pb, tq0, qcol, hi, qf);
#pragma unroll
        for (int s_ = 0; s_ < 4; ++s_) *(LAS bf16x8*)(qb0 + 1024 * s_) = qf[s_];
        attn_load_q(Pb, tq1, qcol, hi, qf);
#pragma unroll
        for (int s_ = 0; s_ < 4; ++s_) *(LAS bf16x8*)(qb1 + 1024 * s_) = qf[s_];
        asm volatile("s_waitcnt lgkmcnt(0)" ::: "memory");
    }
    const float cq0 = cumT[tq0], cq1 = cumT[tq1];
    float bound0, bound1;
    {
        float n0 = 0.f, n1 = 0.f;
#pragma unroll
        for (int s_ = 0; s_ < 4; ++s_) {
            const bf16x8 a = *(const LAS bf16x8*)(qb0 + 1024 * s_), b = *(const LAS bf16x8*)(qb1 + 1024 * s_);
#pragma unroll
            for (int e = 0; e < 8; ++e) { const float fa = bflo((unsigned)(unsigned short)a[e]), fb = bflo((unsigned)(unsigned short)b[e]); n0 = fmaf(fa, fa, n0); n1 = fmaf(fb, fb, n1); }
        }
        n0 += __shfl_xor(n0, 32); n1 += __shfl_xor(n1, 32);
        bound0 = sqrtf(n0 * kmax2) * QK_SCALE2 * 1.01f + 0.5f; bound1 = sqrtf(n1 * kmax2) * QK_SCALE2 * 1.01f + 0.5f;
    }
    constexpr float FOX_SKIP = 48.0f;
    const int ntiles = 2 * qp + 2;
    KTile nx; VTile vnx;
    k_load<true>(nx, Pb, kcol, 1, 32 * (ntiles - 1), cumT, lane); v_load(vnx, Pb, vcol, 1, 32 * (ntiles - 1), lane);
    for (int j = ntiles - 1; j >= 0; --j) {
        const VTile vt = vnx;
        const KTile cur = nx;
        if (j > 0) { k_load<true>(nx, Pb, kcol, 1, 32 * (j - 1), cumT, lane); v_load(vnx, Pb, vcol, 1, 32 * (j - 1), lane); }
        KFrag kf; k_stage(cur, vl, kf, lane);
        f32x16 s1 = qk_tile_lds(kf, qb1);
        f32x16 s0;
        const bool on0 = (j <= 2 * qp);
        if (on0) s0 = qk_tile_lds(kf, qb0);
        bf16x8 vf[2][2];
        v_stage<true>(vt, cur.ck, vl, vf, lane);
        if (on0) {
            const bool diag = (j == 2 * qp);
#pragma unroll
            for (int g = 0; g < 4; ++g) { const f32x4 c4 = *(const LAS f32x4*)(ckl + 8 * g + 4 * hi);
#pragma unroll
                for (int e = 0; e < 4; ++e) { const int i = 4 * g + e; const float v = fmaf(s0[i], QK_SCALE2, cq0 - c4[e]); s0[i] = (diag && crow(i, hi) > l31) ? -INFINITY : v; } }
            softmax_pv(s0, 1.0f, st0, vf);
        }
        {
            const bool diag = (j == 2 * qp + 1);
#pragma unroll
            for (int g = 0; g < 4; ++g) { const f32x4 c4 = *(const LAS f32x4*)(ckl + 8 * g + 4 * hi);
#pragma unroll
                for (int e = 0; e < 4; ++e) { const int i = 4 * g + e; const float v = fmaf(s1[i], QK_SCALE2, cq1 - c4[e]); s1[i] = (diag && crow(i, hi) > l31) ? -INFINITY : v; } }
            softmax_pv(s1, 1.0f, st1, vf);
        }
        asm volatile("s_waitcnt lgkmcnt(0)" ::: "memory");
        if (j > 0) {
            const float ckn = __int_as_float(__builtin_amdgcn_readlane(__float_as_int(nx.ck), 31));
            const bool dead0 = (cq0 - ckn + bound0) < (st0.m - FOX_SKIP), dead1 = (cq1 - ckn + bound1) < (st1.m - FOX_SKIP);
            if (__all(dead0 && dead1)) break;
        }
    }
    attn_store_o(Pb, tq0, qcol, hi, st0, dry);
    attn_store_o(Pb, tq1, qcol, hi, st1, dry);
}

__device__ __forceinline__ void attention_phase(bf16_t* __restrict__ P, const float* __restrict__ cumT, const float* __restrict__ kmax2, const float* __restrict__ sinks, unsigned* ctr, LAS unsigned char* lds, int wave, int lane, int dry = 0) {
    LAS unsigned char* vl = lds + wave * ATT_WAVE_LDS;
    const int hi = lane >> 5, l31 = lane & 31;
    constexpr int NUB = 3072, NU = 6144;
    for (;;) {
        unsigned u = 0;
        if (lane == 0) u = atomicAdd(ctr, 1u);
        u = __builtin_amdgcn_readfirstlane(u);
        if (u >= (unsigned)(NUB + 2 * NU)) break;
        if (u < (unsigned)NUB) {
            const int qp = 127 - (int)(u / 24), bh = (int)(u % 24), b = bh / 6, h = bh % 6;
            attn_fox_pair(P + (size_t)b * SEQ * NP, cumT + (size_t)bh * SEQ, kmax2[bh], h, qp, vl, lane, dry);
        } else if (u < (unsigned)(NUB + NU)) {
            const int v = (int)u - NUB;
            const int cb = v & 15, rho = (v >> 4) & 15, bh = v >> 8, b = bh / 6, h = bh % 6;
            bf16_t* Pb = P + (size_t)b * SEQ * NP;
            const int tq0 = rho + 512 * cb, tq = tq0 + 16 * l31;
            AttState st; att_init(st); bf16x8 qf[4];
            attn_load_q(Pb, tq, PC_QA + 64 * h, hi, qf);
            attn_segment(Pb, PC_KA + 64 * h, PC_VA + 64 * h, 16, 2048, tq0 - 2048, 5, tq, qf, st, vl, lane);
            attn_segment(Pb, PC_KA + 64 * h, PC_VA + 64 * h, 4, 512, tq0 - 512, 8, tq, qf, st, vl, lane);
            attn_segment(Pb, PC_KA + 64 * h, PC_VA + 64 * h, 1, 128, tq0 - 128, 20, tq, qf, st, vl, lane);
            attn_store_o(Pb, tq, PC_QA + 64 * h, hi, st, dry);
        } else {
            const int v = (int)u - NUB - NU;
            const int qt = v & 255, bh = v >> 8, b = bh / 6, h = bh % 6, hk = h / 3;
            bf16_t* Pb = P + (size_t)b * SEQ * NP;
            const int tq = qt * 32 + l31;
            AttState st; att_init(st); bf16x8 qf[4];
            attn_load_q(Pb, tq, PC_QC + 64 * h, hi, qf);
            st.m = sinks[h] * LOG2E; st.l = (hi == 0) ? 1.f : 0.f;
            attn_segment(Pb, PC_KC + 64 * hk, PC_VC + 64 * hk, 1, 127, qt * 32 - 128, 5, tq, qf, st, vl, lane);
            attn_store_o(Pb, tq, PC_QC + 64 * h, hi, st, dry);
        }
    }
}

__device__ __forceinline__ int f2key(float f) { const int b = __float_as_int(f); return b ^ ((b >> 31) & 0x7fffffff); }
__device__ __forceinline__ float key2f(int k) { return __int_as_float(k ^ ((k >> 31) & 0x7fffffff)); }
#define CE_DESC(a, x) do { const int hi_ = max((a), (x)); (x) = min((a), (x)); (a) = hi_; } while (0)

__device__ __forceinline__ void route_half(const bf16_t* __restrict__ qrow, const LAS unsigned char* kl, int (&list)[16]) {
    unsigned qh[64];
#pragma unroll
    for (int c = 0; c < 16; ++c) { const u32x4 t = *(const u32x4*)(qrow + 8 * c); qh[4 * c] = t.x; qh[4 * c + 1] = t.y; qh[4 * c + 2] = t.z; qh[4 * c + 3] = t.w; }
#pragma unroll
    for (int i = 0; i < 16; ++i) list[i] = (int)0x80000000;
    for (int key = 0; key < 128; ++key) {
        float a0 = 0.f, a1 = 0.f;
        const LAS unsigned char* kp = kl + key * 256;
#pragma unroll
        for (int c = 0; c < 16; ++c) {
            const u32x4 kk = *(const LAS u32x4*)(kp + 16 * c);
            a0 = dot2bf(qh[4 * c], kk.x, a0); a1 = dot2bf(qh[4 * c + 1], kk.y, a1);
            a0 = dot2bf(qh[4 * c + 2], kk.z, a0); a1 = dot2bf(qh[4 * c + 3], kk.w, a1);
        }
        int x = (f2key(a0 + a1) & ~127) | key;
#pragma unroll
        for (int i = 0; i < 16; ++i) CE_DESC(list[i], x);
    }
}

__device__ __forceinline__ void routing_phase(const bf16_t* __restrict__ Q2, const float* __restrict__ k1, const float* __restrict__ k2, int* __restrict__ ids, float* __restrict__ gw,
                                              LAS unsigned char* lds, int tid) {
    for (int e = tid; e < 2 * 8192; e += 512) {
        const int hf = e >> 13, o = (e & 8191) * 2;
        const float* src = (hf ? k2 : k1) + o;
        *(LAS unsigned*)(lds + hf * 32768 + o * 2) = cvtpk(src[0], src[1]);
    }
    __syncthreads();
    const int nthreads = gridDim.x * 512;
    for (int it = blockIdx.x * 512 + tid; it < T * 8; it += nthreads) {
        const int t = it >> 3, h = it & 7;
        const bf16_t* qrow = Q2 + (size_t)t * 2048 + h * 256;
        int l1[16], l2[16];
        route_half(qrow, lds, l1);
        route_half(qrow + 128, lds + 32768, l2);
        float f1[16], f2[16];
#pragma unroll
        for (int i = 0; i < 16; ++i) { f1[i] = key2f(l1[i] & ~127); f2[i] = key2f(l2[i] & ~127); }
        int cl[16];
#pragma unroll
        for (int j = 0; j < 16; ++j) cl[j] = (f2key(f1[0] + f2[j]) & ~255) | j;
#pragma unroll
        for (int i = 1; i < 16; ++i) {
#pragma unroll
            for (int j = 0; j < 16; ++j) {
                if ((i + 1) * (j + 1) <= 16) {
                    int x = (f2key(f1[i] + f2[j]) & ~255) | (i * 16 + j);
#pragma unroll
                    for (int k = 0; k < 16; ++k) CE_DESC(cl[k], x);
                }
            }
        }
        float sc[16]; int idv[16];
#pragma unroll
        for (int k = 0; k < 16; ++k) {
            sc[k] = key2f(cl[k] & ~255);
            const int pi = (cl[k] >> 4) & 15, pj = cl[k] & 15;
            int a = 0, b = 0;
#pragma unroll
            for (int i = 0; i < 16; ++i) { a = (pi == i) ? (l1[i] & 127) : a; b = (pj == i) ? (l2[i] & 127) : b; }
            idv[k] = a * 128 + b;
        }
        float e[16], sum = 0.f;
#pragma unroll
        for (int k = 0; k < 16; ++k) { e[k] = __expf(sc[k] - sc[0]); sum += e[k]; }
        const float inv = 1.0f / sum;
        int* ip = ids + (size_t)it * 16; float* gp = gw + (size_t)it * 16;
#pragma unroll
        for (int k = 0; k < 16; k += 4) {
            *(int4*)(ip + k) = make_int4(idv[k], idv[k + 1], idv[k + 2], idv[k + 3]);
            *(float4*)(gp + k) = make_float4(e[k] * inv, e[k + 1] * inv, e[k + 2] * inv, e[k + 3] * inv);
        }
    }
}

__device__ __forceinline__ float gelu_erf(float x);
constexpr int KPITCH = 272;
constexpr int R2_K_BYTES = 2 * 128 * KPITCH;
#define CE_MAXMIN(a, b) do { const int hi_ = max((a), (b)); const int lo_ = min((a), (b)); (a) = hi_; (b) = lo_; } while (0)
__device__ __forceinline__ void bitonic_merge16_desc(int (&a)[16]) {
#pragma unroll
    for (int js = 3; js >= 0; --js) {
#pragma unroll
        for (int i = 0; i < 16; ++i) { const int l = i ^ (1 << js); if (l > i) CE_MAXMIN(a[i], a[l]); }
    }
}
__device__ __forceinline__ void bitonic_sort16_desc(int (&a)[16]) {
#pragma unroll
    for (int ks = 1; ks <= 4; ++ks) {
#pragma unroll
        for (int js = ks - 1; js >= 0; --js) {
#pragma unroll
            for (int i = 0; i < 16; ++i) { const int l = i ^ (1 << js);
                if (l > i) { if ((i & (1 << ks)) == 0) CE_MAXMIN(a[i], a[l]); else CE_MAXMIN(a[l], a[i]); } }
        }
    }
}
__device__ __forceinline__ void merge_top16(int (&a)[16], const int (&b)[16]) {
#pragma unroll
    for (int i = 0; i < 16; ++i) a[i] = max(a[i], b[15 - i]);
    bitonic_merge16_desc(a);
}
__device__ __forceinline__ void route2_half(const bf16_t* __restrict__ qrow  , const LAS unsigned char* kl  , int hi, int (&L)[16]) {
    f32x16 acc[4];
#pragma unroll
    for (int kt = 0; kt < 4; ++kt)
#pragma unroll
        for (int r = 0; r < 16; ++r) acc[kt][r] = 0.f;
    bf16x8 qf[8];
#pragma unroll
    for (int s = 0; s < 8; ++s) qf[s] = *(const bf16x8*)(qrow + 16 * s);
#pragma unroll
    for (int s = 0; s < 8; ++s) {
#pragma unroll
        for (int kt = 0; kt < 4; ++kt) {
            const bf16x8 kf = *(const LAS bf16x8*)(kl + kt * 32 * KPITCH + 32 * s);
            acc[kt] = __builtin_amdgcn_mfma_f32_32x32x16_bf16(kf, qf[s], acc[kt], 0, 0, 0);
        }
    }
    int kk[4][16];
    const int hi4 = 4 * hi;
#pragma unroll
    for (int kt = 0; kt < 4; ++kt)
#pragma unroll
        for (int r = 0; r < 16; ++r) kk[kt][r] = (f2key(acc[kt][r]) & ~127) | ((32 * kt + (r & 3) + 8 * (r >> 2)) | hi4);
#pragma unroll
    for (int kt = 0; kt < 4; ++kt) bitonic_sort16_desc(kk[kt]);
    merge_top16(kk[0], kk[1]); merge_top16(kk[2], kk[3]); merge_top16(kk[0], kk[2]);
#pragma unroll
    for (int i = 0; i < 16; ++i) L[i] = max(kk[0][i], __shfl_xor(kk[0][15 - i], 32));
    bitonic_merge16_desc(L);
}

__device__ __forceinline__ void routing2_setup(const float* __restrict__ k1, const float* __restrict__ k2, LAS unsigned char* lds, int tid) {
    for (int e = tid; e < 2 * 8192; e += 512) {
        const int hf = e >> 13, o = (e & 8191) * 2, key = o >> 7, d = o & 127;
        const float* src = (hf ? k2 : k1) + o;
        *(LAS unsigned*)(lds + hf * 128 * KPITCH + key * KPITCH + d * 2) = cvtpk(src[0], src[1]);
    }
    __syncthreads();
}
__device__ __forceinline__ void routing2_units(const bf16_t* __restrict__ Q2, int* __restrict__ ids, float* __restrict__ gw,
                                               LAS unsigned char* lds, int wave, int lane, int gwave, int ngw) {
    LAS unsigned char* scr = lds + R2_K_BYTES + wave * 2048 + lane * 32;
    const int hi = lane >> 5, l31 = lane & 31;
    for (int u = (gwave < 0 ? wave : gwave); u < (gwave < 0 ? 32 : (T / 32) * 8); u += (gwave < 0 ? 8 : ngw)) {
        const int tb = gwave < 0 ? (int)blockIdx.x * 4 + (u >> 3) : (u >> 3), h = u & 7;
        const int t = tb * 32 + l31;
        const bf16_t* qrow = Q2 + (size_t)t * 2048 + h * 256 + 8 * hi;
        int l1[16], l2[16];
        route2_half(qrow, lds + l31 * KPITCH + 16 * hi, hi, l1);
        route2_half(qrow + 128, lds + 128 * KPITCH + l31 * KPITCH + 16 * hi, hi, l2);
#pragma unroll
        for (int i = 0; i < 16; i += 4) {
            *(LAS unsigned*)(scr + i) = (unsigned)(l1[i] & 127) | ((unsigned)(l1[i + 1] & 127) << 8) | ((unsigned)(l1[i + 2] & 127) << 16) | ((unsigned)(l1[i + 3] & 127) << 24);
            *(LAS unsigned*)(scr + 16 + i) = (unsigned)(l2[i] & 127) | ((unsigned)(l2[i + 1] & 127) << 8) | ((unsigned)(l2[i + 2] & 127) << 16) | ((unsigned)(l2[i + 3] & 127) << 24);
        }
        float f1[16], f2[16];
#pragma unroll
        for (int i = 0; i < 16; ++i) { f1[i] = key2f(l1[i] & ~127); f2[i] = key2f(l2[i] & ~127); }
        int cl[16];
#pragma unroll
        for (int j = 0; j < 16; ++j) cl[j] = (f2key(f1[0] + f2[j]) & ~255) | j;
#pragma unroll
        for (int i = 1; i < 16; ++i) {
#pragma unroll
            for (int j = 0; j < 16; ++j) {
                if ((i + 1) * (j + 1) <= 16) {
                    int x = (f2key(f1[i] + f2[j]) & ~255) | (i * 16 + j);
#pragma unroll
                    for (int k = 0; k < 16; ++k) CE_DESC(cl[k], x);
                }
            }
        }
        float e[16], sum = 0.f;
        const float mx = key2f(cl[0] & ~255);
#pragma unroll
        for (int k = 0; k < 16; ++k) { e[k] = __expf(key2f(cl[k] & ~255) - mx); sum += e[k]; }
        const float inv = 1.0f / sum;
        asm volatile("s_waitcnt lgkmcnt(0)" ::: "memory");
        int idv[8]; float gv[8];
#pragma unroll
        for (int k = 0; k < 8; ++k) {
            const int c = hi ? cl[8 + k] : cl[k];
            gv[k] = (hi ? e[8 + k] : e[k]) * inv;
            const int pi = (c >> 4) & 15, pj = c & 15;
            const int a = *(const LAS unsigned char*)(scr + pi), b = *(const LAS unsigned char*)(scr + 16 + pj);
            idv[k] = a * 128 + b;
        }
        int* ip = ids + ((size_t)t * 8 + h) * 16 + 8 * hi; float* gp = gw + ((size_t)t * 8 + h) * 16 + 8 * hi;
        *(int4*)(ip) = make_int4(idv[0], idv[1], idv[2], idv[3]); *(int4*)(ip + 4) = make_int4(idv[4], idv[5], idv[6], idv[7]);
        *(float4*)(gp) = make_float4(gv[0], gv[1], gv[2], gv[3]); *(float4*)(gp + 4) = make_float4(gv[4], gv[5], gv[6], gv[7]);
        asm volatile("s_waitcnt lgkmcnt(0)" ::: "memory");
    }
}

typedef __bf16 bf16x2v_t __attribute__((ext_vector_type(2)));
__device__ __forceinline__ float dot2(unsigned a, unsigned b, float acc) { return __builtin_amdgcn_fdot2_f32_bf16(__builtin_bit_cast(bf16x2v_t, a), __builtin_bit_cast(bf16x2v_t, b), acc, false); }
template <int CTRL> __device__ __forceinline__ float dpp_add(float v) { return v + __builtin_bit_cast(float, __builtin_amdgcn_update_dpp(0, __builtin_bit_cast(int, v), CTRL, 0xF, 0xF, true)); }
__device__ __forceinline__ float xor16_add(float v) { return v + __builtin_bit_cast(float, __builtin_amdgcn_ds_swizzle(__builtin_bit_cast(int, v), 0x401F)); }
__device__ __forceinline__ float xor32_add(float v) { return v + __shfl_xor(v, 32); }
constexpr int G2_WAVE_LDS = 4096 + 8192 + 128;

__device__ __forceinline__ void gather2_phase(float* __restrict__ H, bf16_t* __restrict__ HB, const float* __restrict__ ssq2p, float* __restrict__ ssq1,
                                              const bf16_t* __restrict__ U16, const bf16_t* __restrict__ V16, const int* __restrict__ ids, const float* __restrict__ gw,
                                              const float* __restrict__ final_g, int last, LAS unsigned char* lds, int wave, int gwave, int lane) {
    LAS unsigned char* wl = lds + wave * G2_WAVE_LDS;
    LAS unsigned short* idl = (LAS unsigned short*)wl;
    LAS float* al = (LAS float*)(wl + 4096);
    const int t0 = __builtin_amdgcn_readfirstlane(gwave * 16);
    const int g = lane >> 3, p = lane & 7;
    for (int tt = 0; tt < 16; ++tt) {
#pragma unroll
        for (int hf = 0; hf < 2; ++hf) { const int k = lane + 64 * hf; idl[tt * 128 + (k & 7) * 16 + (k >> 3)] = (unsigned short)ids[(size_t)(t0 + tt) * 128 + k]; }
    }
    for (int e = lane; e < 2048; e += 64) al[e] = 0.f;
    asm volatile("s_waitcnt lgkmcnt(0)" ::: "memory");
    const unsigned char* Ub = (const unsigned char*)U16; const unsigned char* Vb = (const unsigned char*)V16;
    for (int c = 0; c < 16; ++c) {
        for (int tt = 0; tt < 16; ++tt) {
            const u32x4 x4 = *(const u32x4*)(HB + (size_t)(t0 + tt) * DM + 64 * c + 8 * p);
            const u32x4 i0 = *(const LAS u32x4*)(idl + tt * 128 + g * 16), i1 = *(const LAS u32x4*)(idl + tt * 128 + g * 16 + 8);
            const unsigned idw[8] = {i0.x, i0.y, i0.z, i0.w, i1.x, i1.y, i1.z, i1.w};
            u32x4 u[16];
#pragma unroll
            for (int i = 0; i < 16; ++i) { const unsigned id = (i & 1) ? (idw[i >> 1] >> 16) : (idw[i >> 1] & 0xffffu);
                u[i] = *(const u32x4*)(Ub + (size_t)(id * 2048u + (unsigned)(c * 128 + p * 16))); }
            float a[16];
#pragma unroll
            for (int i = 0; i < 16; ++i) {
                float s = dot2(x4.x, u[i].x, 0.f); s = dot2(x4.y, u[i].y, s); s = dot2(x4.z, u[i].z, s); s = dot2(x4.w, u[i].w, s);
                s = dpp_add<0xB1>(s); s = dpp_add<0x4E>(s); s = dpp_add<0x141>(s);
                a[i] = s;
            }
            if (p == 0) {
                LAS float* ap = al + tt * 128 + g * 16;
#pragma unroll
                for (int i = 0; i < 16; ++i) (void)__hip_atomic_fetch_add(ap + i, a[i], __ATOMIC_RELAXED, __HIP_MEMORY_SCOPE_WORKGROUP);
            }
        }
    }
    asm volatile("s_waitcnt lgkmcnt(0)" ::: "memory");
    for (int n = 0; n < 32; ++n) {
        const int tt = n >> 1, pos = lane + 64 * (n & 1), k = 8 * (pos & 15) + (pos >> 4);
        const float rs2 = rsqrtf(ssq16(ssq2p, t0 + tt) * (1.0f / 1024.0f) + RMS_EPS);
        const float a = al[tt * 128 + pos] * rs2;
        al[tt * 128 + pos] = gw[(size_t)(t0 + tt) * 128 + k] * gelu_erf(a);
    }
    asm volatile("s_waitcnt lgkmcnt(0)" ::: "memory");
    for (int c = 0; c < 16; ++c) {
        for (int tt = 0; tt < 16; ++tt) {
            const LAS f32x4* wp = (const LAS f32x4*)(al + tt * 128 + g * 16);
            const f32x4 w0 = wp[0], w1 = wp[1], w2 = wp[2], w3 = wp[3];
            const float w[16] = {w0[0], w0[1], w0[2], w0[3], w1[0], w1[1], w1[2], w1[3], w2[0], w2[1], w2[2], w2[3], w3[0], w3[1], w3[2], w3[3]};
            const u32x4 i0 = *(const LAS u32x4*)(idl + tt * 128 + g * 16), i1 = *(const LAS u32x4*)(idl + tt * 128 + g * 16 + 8);
            const unsigned idw[8] = {i0.x, i0.y, i0.z, i0.w, i1.x, i1.y, i1.z, i1.w};
            u32x4 v[16];
#pragma unroll
            for (int i = 0; i < 16; ++i) { const unsigned id = (i & 1) ? (idw[i >> 1] >> 16) : (idw[i >> 1] & 0xffffu);
                v[i] = *(const u32x4*)(Vb + (size_t)(id * 2048u + (unsigned)(c * 128 + p * 16))); }
            float y[8];
#pragma unroll
            for (int j = 0; j < 8; ++j) y[j] = 0.f;
#pragma unroll
            for (int i = 0; i < 16; ++i) {
                y[0] = fmaf(w[i], bflo(v[i].x), y[0]); y[1] = fmaf(w[i], bfhi(v[i].x), y[1]); y[2] = fmaf(w[i], bflo(v[i].y), y[2]); y[3] = fmaf(w[i], bfhi(v[i].y), y[3]);
                y[4] = fmaf(w[i], bflo(v[i].z), y[4]); y[5] = fmaf(w[i], bfhi(v[i].z), y[5]); y[6] = fmaf(w[i], bflo(v[i].w), y[6]); y[7] = fmaf(w[i], bfhi(v[i].w), y[7]);
            }
#pragma unroll
            for (int j = 0; j < 8; ++j) { y[j] = dpp_add<0x128>(y[j]); y[j] = xor16_add(y[j]); y[j] = xor32_add(y[j]); }
            if (g == 0) {
                float* hp = H + (size_t)(t0 + tt) * DM + 64 * c + 8 * p;
                f32x4 h0 = *(const f32x4*)hp, h1 = *(const f32x4*)(hp + 4);
                h0 += (f32x4){y[0], y[1], y[2], y[3]}; h1 += (f32x4){y[4], y[5], y[6], y[7]};
                *(f32x4*)hp = h0; *(f32x4*)(hp + 4) = h1;
            }
        }
    }
    __builtin_amdgcn_fence(__ATOMIC_SEQ_CST, "agent");
    asm volatile("s_waitcnt vmcnt(0)" ::: "memory");
    for (int tt = 0; tt < 16; ++tt) {
        const int t = t0 + tt;
        float* hp = H + (size_t)t * DM + 8 * lane;
        f32x4 h0 = *(const f32x4*)hp, h1 = *(const f32x4*)(hp + 4), h2 = *(const f32x4*)(hp + 512), h3 = *(const f32x4*)(hp + 516);
        float ss = (h0[0] * h0[0] + h0[1] * h0[1]) + (h0[2] * h0[2] + h0[3] * h0[3]) + (h1[0] * h1[0] + h1[1] * h1[1]) + (h1[2] * h1[2] + h1[3] * h1[3])
                 + (h2[0] * h2[0] + h2[1] * h2[1]) + (h2[2] * h2[2] + h2[3] * h2[3]) + (h3[0] * h3[0] + h3[1] * h3[1]) + (h3[2] * h3[2] + h3[3] * h3[3]);
        ss = wave_sum(ss);
        if (last) {
            const float rs = rsqrtf(ss * (1.0f / 1024.0f) + RMS_EPS);
            const f32x4 g0 = *(const f32x4*)(final_g + 8 * lane), g1 = *(const f32x4*)(final_g + 8 * lane + 4), g2 = *(const f32x4*)(final_g + 512 + 8 * lane), g3 = *(const f32x4*)(final_g + 516 + 8 * lane);
            h0 = h0 * rs * g0; h1 = h1 * rs * g1; h2 = h2 * rs * g2; h3 = h3 * rs * g3;
            *(f32x4*)hp = h0; *(f32x4*)(hp + 4) = h1; *(f32x4*)(hp + 512) = h2; *(f32x4*)(hp + 516) = h3;
        } else {
            bf16_t* bp = HB + (size_t)t * DM + 8 * lane;
            u32x4 w; w.x = cvtpk(h0[0], h0[1]); w.y = cvtpk(h0[2], h0[3]); w.z = cvtpk(h1[0], h1[1]); w.w = cvtpk(h1[2], h1[3]);
            *(u32x4*)bp = w;
            w.x = cvtpk(h2[0], h2[1]); w.y = cvtpk(h2[2], h2[3]); w.z = cvtpk(h3[0], h3[1]); w.w = cvtpk(h3[2], h3[3]);
            *(u32x4*)(bp + 512) = w;
            if (lane == 0) ssq1[t] = ss;
        }
    }
}

#ifndef G3_UMFMA
#define G3_UMFMA 0
#endif
#ifndef G3_VF16
#define G3_VF16 1
#endif
typedef _Float16 f16x2_t __attribute__((ext_vector_type(2)));
__device__ __forceinline__ unsigned cvtpk_h(float lo, float hi) { f16x2_t v = {(_Float16)lo, (_Float16)hi}; return __builtin_bit_cast(unsigned, v); }
__device__ __forceinline__ void fma_mix_lo(float& y, float w, unsigned pk) { asm("v_fma_mix_f32 %0, %1, %2, %0 op_sel_hi:[0,1,0]" : "+v"(y) : "v"(w), "v"(pk)); }
__device__ __forceinline__ void fma_mix_hi(float& y, float w, unsigned pk) { asm("v_fma_mix_f32 %0, %1, %2, %0 op_sel:[0,1,0] op_sel_hi:[0,1,0]" : "+v"(y) : "v"(w), "v"(pk)); }
__device__ __forceinline__ float swap32_add(float a, float b) {
    const auto r = __builtin_amdgcn_permlane32_swap(__float_as_uint(a), __float_as_uint(b), false, false);
    return __uint_as_float(r[0]) + __uint_as_float(r[1]);
}

__device__ __forceinline__ void gather3_phase(float* __restrict__ H, bf16_t* __restrict__ HB, const float* __restrict__ ssq2p, float* __restrict__ ssq1,
                                              const bf16_t* __restrict__ U16, const unsigned short* __restrict__ V16h, const int* __restrict__ ids, const float* __restrict__ gw,
                                              const float* __restrict__ final_g, int last, LAS unsigned char* lds, int wave, int gwave, int lane) {
    LAS unsigned char* wl = lds + wave * G2_WAVE_LDS;
    LAS unsigned short* idl = (LAS unsigned short*)wl;
    LAS float* al = (LAS float*)(wl + 4096);
    const int t0 = __builtin_amdgcn_readfirstlane(gwave * 16);
    for (int tt = 0; tt < 16; ++tt) {
        idl[tt * 128 + lane] = (unsigned short)ids[(size_t)(t0 + tt) * 128 + lane];
        idl[tt * 128 + 64 + lane] = (unsigned short)ids[(size_t)(t0 + tt) * 128 + 64 + lane];
    }
    for (int e = lane; e < 2048; e += 64) al[e] = 0.f;
    asm volatile("s_waitcnt lgkmcnt(0)" ::: "memory");
    const unsigned char* Ub = (const unsigned char*)U16; const unsigned char* Vb = (const unsigned char*)V16h;
#if G3_UMFMA
    {
        const int e = lane & 15, q = lane >> 4;
        for (int c = 0; c < 16; ++c) {
            for (int tt = 0; tt < 16; ++tt) {
                const bf16_t* xp = HB + (size_t)(t0 + tt) * DM + 64 * c + 8 * q;
                const bf16x8 xa = *(const bf16x8*)xp, xb = *(const bf16x8*)(xp + 32);
                const u32x4 iv = *(const LAS u32x4*)(idl + tt * 128 + 8 * e);
                const unsigned idw[4] = {iv.x, iv.y, iv.z, iv.w};
                bf16x8 ua[8], ub[8];
#pragma unroll
                for (int gi = 0; gi < 8; ++gi) { const unsigned id = (gi & 1) ? (idw[gi >> 1] >> 16) : (idw[gi >> 1] & 0xffffu);
                    const unsigned char* up = Ub + (size_t)(id * 2048u + (unsigned)(c * 128 + q * 16));
                    ua[gi] = *(const bf16x8*)up; ub[gi] = *(const bf16x8*)(up + 64); }
                float r[8];
#pragma unroll
                for (int gi = 0; gi < 8; ++gi) {
                    f32x4 acc = {0.f, 0.f, 0.f, 0.f};
                    acc = __builtin_amdgcn_mfma_f32_16x16x32_bf16(xa, ua[gi], acc, 0, 0, 0);
                    acc = __builtin_amdgcn_mfma_f32_16x16x32_bf16(xb, ub[gi], acc, 0, 0, 0);
                    r[gi] = acc[0];
                }
                if (q == 0) {
                    LAS float* ap = al + tt * 128 + 8 * e;
#pragma unroll
                    for (int gi = 0; gi < 8; ++gi) (void)__hip_atomic_fetch_add(ap + gi, r[gi], __ATOMIC_RELAXED, __HIP_MEMORY_SCOPE_WORKGROUP);
                }
            }
        }
    }
#else
    {
        const int g = lane >> 3, p = lane & 7;
        for (int c = 0; c < 16; ++c) {
            for (int tt = 0; tt < 16; ++tt) {
                const u32x4 x4 = *(const u32x4*)(HB + (size_t)(t0 + tt) * DM + 64 * c + 8 * p);
                const u32x4 i0 = *(const LAS u32x4*)(idl + tt * 128 + g * 16), i1 = *(const LAS u32x4*)(idl + tt * 128 + g * 16 + 8);
                const unsigned idw[8] = {i0.x, i0.y, i0.z, i0.w, i1.x, i1.y, i1.z, i1.w};
                u32x4 u[16];
#pragma unroll
                for (int i = 0; i < 16; ++i) { const unsigned id = (i & 1) ? (idw[i >> 1] >> 16) : (idw[i >> 1] & 0xffffu);
                    u[i] = *(const u32x4*)(Ub + (size_t)(id * 2048u + (unsigned)(c * 128 + p * 16))); }
                float a[16];
#pragma unroll
                for (int i = 0; i < 16; ++i) {
                    float s_ = dot2(x4.x, u[i].x, 0.f); s_ = dot2(x4.y, u[i].y, s_); s_ = dot2(x4.z, u[i].z, s_); s_ = dot2(x4.w, u[i].w, s_);
                    s_ = dpp_add<0xB1>(s_); s_ = dpp_add<0x4E>(s_); s_ = dpp_add<0x141>(s_);
                    a[i] = s_;
                }
                if (p == 0) {
                    LAS float* ap = al + tt * 128 + g * 16;
#pragma unroll
                    for (int i = 0; i < 16; ++i) (void)__hip_atomic_fetch_add(ap + i, a[i], __ATOMIC_RELAXED, __HIP_MEMORY_SCOPE_WORKGROUP);
                }
            }
        }
    }
#endif
    asm volatile("s_waitcnt lgkmcnt(0)" ::: "memory");
    for (int n = 0; n < 32; ++n) {
        const int tt = n >> 1, k = lane + 64 * (n & 1);
        const float rs2 = rsqrtf(ssq16(ssq2p, t0 + tt) * (1.0f / 1024.0f) + RMS_EPS);
        const float a = al[tt * 128 + k] * rs2;
        al[tt * 128 + k] = gw[(size_t)(t0 + tt) * 128 + k] * gelu_erf(a);
    }
    asm volatile("s_waitcnt lgkmcnt(0)" ::: "memory");
    {
        const int g = lane >> 3, p = lane & 7;
        for (int c = 0; c < 16; ++c) {
            for (int tt = 0; tt < 16; ++tt) {
                const LAS f32x4* wp = (const LAS f32x4*)(al + tt * 128 + g * 16);
                const f32x4 w0 = wp[0], w1 = wp[1], w2 = wp[2], w3 = wp[3];
                const float w[16] = {w0[0], w0[1], w0[2], w0[3], w1[0], w1[1], w1[2], w1[3], w2[0], w2[1], w2[2], w2[3], w3[0], w3[1], w3[2], w3[3]};
                const u32x4 i0 = *(const LAS u32x4*)(idl + tt * 128 + g * 16), i1 = *(const LAS u32x4*)(idl + tt * 128 + g * 16 + 8);
                const unsigned idw[8] = {i0.x, i0.y, i0.z, i0.w, i1.x, i1.y, i1.z, i1.w};
                u32x4 v[16];
#pragma unroll
                for (int i = 0; i < 16; ++i) { const unsigned id = (i & 1) ? (idw[i >> 1] >> 16) : (idw[i >> 1] & 0xffffu);
                    v[i] = *(const u32x4*)(Vb + (size_t)(id * 2048u + (unsigned)(c * 128 + p * 16))); }
                float y[8];
#pragma unroll
                for (int j = 0; j < 8; ++j) y[j] = 0.f;
#pragma unroll
                for (int i = 0; i < 16; ++i) {
#if G3_VF16
                    fma_mix_lo(y[0], w[i], v[i].x); fma_mix_hi(y[1], w[i], v[i].x); fma_mix_lo(y[2], w[i], v[i].y); fma_mix_hi(y[3], w[i], v[i].y);
                    fma_mix_lo(y[4], w[i], v[i].z); fma_mix_hi(y[5], w[i], v[i].z); fma_mix_lo(y[6], w[i], v[i].w); fma_mix_hi(y[7], w[i], v[i].w);
#else
                    y[0] = fmaf(w[i], bflo(v[i].x), y[0]); y[1] = fmaf(w[i], bfhi(v[i].x), y[1]); y[2] = fmaf(w[i], bflo(v[i].y), y[2]); y[3] = fmaf(w[i], bfhi(v[i].y), y[3]);
                    y[4] = fmaf(w[i], bflo(v[i].z), y[4]); y[5] = fmaf(w[i], bfhi(v[i].z), y[5]); y[6] = fmaf(w[i], bflo(v[i].w), y[6]); y[7] = fmaf(w[i], bfhi(v[i].w), y[7]);
#endif
                }
                float z[4];
#pragma unroll
                for (int j = 0; j < 4; ++j) { z[j] = swap32_add(y[j], y[j + 4]); z[j] = xor16_add(z[j]); z[j] = dpp_add<0x128>(z[j]); }
                if ((lane & 0x18) == 0) {
                    float* hp = H + (size_t)(t0 + tt) * DM + 64 * c + 8 * p + 4 * (lane >> 5);
                    f32x4 h0 = *(const f32x4*)hp;
                    h0 += (f32x4){z[0], z[1], z[2], z[3]};
                    *(f32x4*)hp = h0;
                }
            }
        }
    }
    __builtin_amdgcn_fence(__ATOMIC_SEQ_CST, "agent");
    asm volatile("s_waitcnt vmcnt(0)" ::: "memory");
    for (int tt = 0; tt < 16; ++tt) {
        const int t = t0 + tt;
        float* hp = H + (size_t)t * DM + 8 * lane;
        f32x4 h0 = *(const f32x4*)hp, h1 = *(const f32x4*)(hp + 4), h2 = *(const f32x4*)(hp + 512), h3 = *(const f32x4*)(hp + 516);
        float ss = (h0[0] * h0[0] + h0[1] * h0[1]) + (h0[2] * h0[2] + h0[3] * h0[3]) + (h1[0] * h1[0] + h1[1] * h1[1]) + (h1[2] * h1[2] + h1[3] * h1[3])
                 + (h2[0] * h2[0] + h2[1] * h2[1]) + (h2[2] * h2[2] + h2[3] * h2[3]) + (h3[0] * h3[0] + h3[1] * h3[1]) + (h3[2] * h3[2] + h3[3] * h3[3]);
        ss = wave_sum(ss);
        if (last) {
            const float rs = rsqrtf(ss * (1.0f / 1024.0f) + RMS_EPS);
            const f32x4 g0 = *(const f32x4*)(final_g + 8 * lane), g1 = *(const f32x4*)(final_g + 8 * lane + 4), g2 = *(const f32x4*)(final_g + 512 + 8 * lane), g3 = *(const f32x4*)(final_g + 516 + 8 * lane);
            h0 = h0 * rs * g0; h1 = h1 * rs * g1; h2 = h2 * rs * g2; h3 = h3 * rs * g3;
            *(f32x4*)hp = h0; *(f32x4*)(hp + 4) = h1; *(f32x4*)(hp + 512) = h2; *(f32x4*)(hp + 516) = h3;
        } else {
            bf16_t* bp = HB + (size_t)t * DM + 8 * lane;
            u32x4 w; w.x = cvtpk(h0[0], h0[1]); w.y = cvtpk(h0[2], h0[3]); w.z = cvtpk(h1[0], h1[1]); w.w = cvtpk(h1[2], h1[3]);
            *(u32x4*)bp = w;
            w.x = cvtpk(h2[0], h2[1]); w.y = cvtpk(h2[2], h2[3]); w.z = cvtpk(h3[0], h3[1]); w.w = cvtpk(h3[2], h3[3]);
            *(u32x4*)(bp + 512) = w;
            if (lane == 0) ssq1[t] = ss;
        }
    }
}

typedef float f32x2v __attribute__((ext_vector_type(2)));
constexpr float FP8_MAX = 448.0f;

__device__ __forceinline__ void quant_row_fp8(const float* __restrict__ src, const float* __restrict__ colscale, unsigned char* __restrict__ dst, float* __restrict__ scale_out, int lane) {
    f32x4 v[4]; float am = 0.f;
#pragma unroll
    for (int j = 0; j < 4; ++j) {
        v[j] = *(const f32x4*)(src + 4 * (lane + 64 * j));
        if (colscale) v[j] = v[j] * *(const f32x4*)(colscale + 4 * (lane + 64 * j));
        am = fmaxf(am, fmaxf(fmaxf(fabsf(v[j][0]), fabsf(v[j][1])), fmaxf(fabsf(v[j][2]), fabsf(v[j][3]))));
    }
#pragma unroll
    for (int o = 1; o < 64; o <<= 1) am = fmaxf(am, __shfl_xor(am, o));
    const float inv = am > 0.f ? FP8_MAX / am : 1.0f;
#pragma unroll
    for (int j = 0; j < 4; ++j) {
        int w = 0;
        w = __builtin_amdgcn_cvt_pk_fp8_f32(v[j][0] * inv, v[j][1] * inv, w, false);
        w = __builtin_amdgcn_cvt_pk_fp8_f32(v[j][2] * inv, v[j][3] * inv, w, true);
        *(int*)(dst + 4 * (lane + 64 * j)) = w;
    }
    if (lane == 0) *scale_out = am > 0.f ? am / FP8_MAX : 1.0f;
}

__device__ __forceinline__ float dot2v(bf16x2v_t a, unsigned b, float acc) { return __builtin_amdgcn_fdot2_f32_bf16(a, __builtin_bit_cast(bf16x2v_t, b), acc, false); }
__device__ __forceinline__ void g4_issue(u32x4 (&buf)[16], const unsigned char* __restrict__ tab, const LAS unsigned short* idl, int it, int g, int p) {
    const int tt = it & 15, c = it >> 4;
    const u32x4 i0 = *(const LAS u32x4*)(idl + tt * 128 + g * 16), i1 = *(const LAS u32x4*)(idl + tt * 128 + g * 16 + 8);
    const unsigned idw[8] = {i0.x, i0.y, i0.z, i0.w, i1.x, i1.y, i1.z, i1.w};
    const unsigned char* base = tab + (c * 128 + p * 16);
#pragma unroll
    for (int i = 0; i < 16; ++i) { const unsigned id = (i & 1) ? (idw[i >> 1] >> 16) : (idw[i >> 1] & 0xffffu);
        buf[i] = *(const u32x4*)(base + (size_t)(id * 1024u)); }
}
__device__ __forceinline__ void g4_xload(u32x4 (&x)[2], const bf16_t* __restrict__ HB, int t0, int it, int p) {
    const bf16_t* xp = HB + (size_t)(t0 + (it & 15)) * DM + 128 * (it >> 4) + 16 * p;
    x[0] = *(const u32x4*)xp; x[1] = *(const u32x4*)(xp + 8);
}
#define G4_CVT(wd, hi_) __builtin_amdgcn_cvt_scalef32_pk_bf16_fp8((wd), 1.0f, (hi_))
__device__ __forceinline__ void g4_ucompute(const u32x4 (&u)[16], const u32x4 (&x)[2], LAS float* ap, int p) {
    const unsigned xw[8] = {x[0].x, x[0].y, x[0].z, x[0].w, x[1].x, x[1].y, x[1].z, x[1].w};
    float a[16];
#pragma unroll
    for (int i0 = 0; i0 < 16; i0 += 8) {
        float s_[8];
#pragma unroll
        for (int e = 0; e < 8; ++e) s_[e] = 0.f;
#pragma unroll
        for (int q = 0; q < 4; ++q) {
#pragma unroll
            for (int e = 0; e < 8; ++e) { const unsigned wd = (q == 0) ? u[i0 + e].x : (q == 1) ? u[i0 + e].y : (q == 2) ? u[i0 + e].z : u[i0 + e].w;
                s_[e] = dot2v(G4_CVT(wd, false), xw[2 * q], s_[e]); }
#pragma unroll
            for (int e = 0; e < 8; ++e) { const unsigned wd = (q == 0) ? u[i0 + e].x : (q == 1) ? u[i0 + e].y : (q == 2) ? u[i0 + e].z : u[i0 + e].w;
                s_[e] = dot2v(G4_CVT(wd, true), xw[2 * q + 1], s_[e]); }
        }
#pragma unroll
        for (int e = 0; e < 8; ++e) s_[e] = dpp_add<0xB1>(s_[e]);
#pragma unroll
        for (int e = 0; e < 8; ++e) s_[e] = dpp_add<0x4E>(s_[e]);
#pragma unroll
        for (int e = 0; e < 8; ++e) a[i0 + e] = dpp_add<0x141>(s_[e]);
    }
    if (p == 0) {
#pragma unroll
        for (int i = 0; i < 16; ++i) (void)__hip_atomic_fetch_add(ap + i, a[i], __ATOMIC_RELAXED, __HIP_MEMORY_SCOPE_WORKGROUP);
    }
}
__device__ __forceinline__ void g4_vcompute(const u32x4 (&v)[16], const LAS float* wsrc, float* __restrict__ hp, int lane, int dry) {
    const LAS f32x4* wp = (const LAS f32x4*)wsrc;
    const f32x4 w0 = wp[0], w1 = wp[1], w2 = wp[2], w3 = wp[3];
    const float w[16] = {w0[0], w0[1], w0[2], w0[3], w1[0], w1[1], w1[2], w1[3], w2[0], w2[1], w2[2], w2[3], w3[0], w3[1], w3[2], w3[3]};
    float yy[16];
#pragma unroll
    for (int j = 0; j < 16; ++j) yy[j] = 0.f;
#pragma unroll
    for (int i = 0; i < 16; ++i) {
        const unsigned vw[4] = {v[i].x, v[i].y, v[i].z, v[i].w};
#pragma unroll
        for (int q = 0; q < 4; ++q) {
            const f32x2v lo = __builtin_amdgcn_cvt_pk_f32_fp8((int)vw[q], false), hi = __builtin_amdgcn_cvt_pk_f32_fp8((int)vw[q], true);
            yy[4 * q] = fmaf(w[i], lo.x, yy[4 * q]); yy[4 * q + 1] = fmaf(w[i], lo.y, yy[4 * q + 1]); yy[4 * q + 2] = fmaf(w[i], hi.x, yy[4 * q + 2]); yy[4 * q + 3] = fmaf(w[i], hi.y, yy[4 * q + 3]);
        }
    }
    f32x2v y[8];
#pragma unroll
    for (int j = 0; j < 8; ++j) y[j] = (f32x2v){yy[2 * j], yy[2 * j + 1]};
    float z[8];
#pragma unroll
    for (int j = 0; j < 4; ++j) { z[2 * j] = swap32_add(y[j].x, y[j + 4].x); z[2 * j + 1] = swap32_add(y[j].y, y[j + 4].y); }
#pragma unroll
    for (int j = 0; j < 8; ++j) { z[j] = xor16_add(z[j]); z[j] = dpp_add<0x128>(z[j]); }
    if ((lane & 0x18) == 0 && !(dry && z[0] * z[0] >= 0.f)) {
        f32x4 h0 = *(const f32x4*)hp, h1 = *(const f32x4*)(hp + 4);
        h0 += (f32x4){z[0], z[1], z[2], z[3]}; h1 += (f32x4){z[4], z[5], z[6], z[7]};
        *(f32x4*)hp = h0; *(f32x4*)(hp + 4) = h1;
    }
}

__device__ __forceinline__ void gather4_phase(float* __restrict__ H, bf16_t* __restrict__ HB, const float* __restrict__ ssq2p, float* __restrict__ ssq1,
                                              const unsigned char* __restrict__ U8, const unsigned char* __restrict__ V8, const float* __restrict__ su, const float* __restrict__ sv,
                                              const int* __restrict__ ids, const float* __restrict__ gw,
                                              const float* __restrict__ final_g, int last, LAS unsigned char* lds, int wave, int gwave, int lane, int dry = 0, int idmask = 0xffff) {
    LAS unsigned char* wl = lds + wave * G2_WAVE_LDS;
    LAS unsigned short* idl = (LAS unsigned short*)wl;
    LAS float* al = (LAS float*)(wl + 4096);
    const int t0 = __builtin_amdgcn_readfirstlane(gwave * 16);
    for (int tt = 0; tt < 16; ++tt) {
        idl[tt * 128 + lane] = (unsigned short)(ids[(size_t)(t0 + tt) * 128 + lane] & idmask);
        idl[tt * 128 + 64 + lane] = (unsigned short)(ids[(size_t)(t0 + tt) * 128 + 64 + lane] & idmask);
    }
    for (int e = lane; e < 2048; e += 64) al[e] = 0.f;
    asm volatile("s_waitcnt lgkmcnt(0)" ::: "memory");
    const int g = lane >> 3, p = lane & 7;
    if (!(dry & 2)) {
        u32x4 uA[16], uB[16], xA[2], xB[2];
        g4_issue(uA, U8, idl, 0, g, p);
        g4_xload(xA, HB, t0, 0, p);
        for (int it = 0; it < 128; it += 2) {
            g4_issue(uB, U8, idl, it + 1, g, p); g4_xload(xB, HB, t0, it + 1, p);
            g4_ucompute(uA, xA, al + (it & 15) * 128 + g * 16, p);
            if (it + 2 < 128) { g4_issue(uA, U8, idl, it + 2, g, p); g4_xload(xA, HB, t0, it + 2, p); }
            g4_ucompute(uB, xB, al + ((it + 1) & 15) * 128 + g * 16, p);
        }
    }
    asm volatile("s_waitcnt lgkmcnt(0)" ::: "memory");
    for (int n = 0; n < 32; ++n) {
        const int tt = n >> 1, k = lane + 64 * (n & 1);
        const float rs2 = rsqrtf(ssq16(ssq2p, t0 + tt) * (1.0f / 1024.0f) + RMS_EPS);
        const int id = idl[tt * 128 + k];
        const float a = al[tt * 128 + k] * rs2 * su[id];
        al[tt * 128 + k] = gw[(size_t)(t0 + tt) * 128 + k] * gelu_erf(a) * sv[id];
    }
    asm volatile("s_waitcnt lgkmcnt(0)" ::: "memory");
    if (!(dry & 4)) {
        u32x4 vA[16], vB[16];
        g4_issue(vA, V8, idl, 0, g, p);
        for (int it = 0; it < 128; it += 2) {
            g4_issue(vB, V8, idl, it + 1, g, p);
            g4_vcompute(vA, al + (it & 15) * 128 + g * 16, H + (size_t)(t0 + (it & 15)) * DM + 128 * (it >> 4) + 16 * p + 8 * (lane >> 5), lane, dry);
            if (it + 2 < 128) g4_issue(vA, V8, idl, it + 2, g, p);
            g4_vcompute(vB, al + ((it + 1) & 15) * 128 + g * 16, H + (size_t)(t0 + ((it + 1) & 15)) * DM + 128 * ((it + 1) >> 4) + 16 * p + 8 * (lane >> 5), lane, dry);
        }
    }
    if (dry) return;
    __builtin_amdgcn_fence(__ATOMIC_SEQ_CST, "agent");
    asm volatile("s_waitcnt vmcnt(0)" ::: "memory");
    for (int tt = 0; tt < 16; ++tt) {
        const int t = t0 + tt;
        float* hp = H + (size_t)t * DM + 8 * lane;
        f32x4 h0 = *(const f32x4*)hp, h1 = *(const f32x4*)(hp + 4), h2 = *(const f32x4*)(hp + 512), h3 = *(const f32x4*)(hp + 516);
        float ss = (h0[0] * h0[0] + h0[1] * h0[1]) + (h0[2] * h0[2] + h0[3] * h0[3]) + (h1[0] * h1[0] + h1[1] * h1[1]) + (h1[2] * h1[2] + h1[3] * h1[3])
                 + (h2[0] * h2[0] + h2[1] * h2[1]) + (h2[2] * h2[2] + h2[3] * h2[3]) + (h3[0] * h3[0] + h3[1] * h3[1]) + (h3[2] * h3[2] + h3[3] * h3[3]);
        ss = wave_sum(ss);
        if (last) {
            const float rs = rsqrtf(ss * (1.0f / 1024.0f) + RMS_EPS);
            const f32x4 g0 = *(const f32x4*)(final_g + 8 * lane), g1 = *(const f32x4*)(final_g + 8 * lane + 4), g2 = *(const f32x4*)(final_g + 512 + 8 * lane), g3 = *(const f32x4*)(final_g + 516 + 8 * lane);
            h0 = h0 * rs * g0; h1 = h1 * rs * g1; h2 = h2 * rs * g2; h3 = h3 * rs * g3;
            *(f32x4*)hp = h0; *(f32x4*)(hp + 4) = h1; *(f32x4*)(hp + 512) = h2; *(f32x4*)(hp + 516) = h3;
        } else {
            bf16_t* bp = HB + (size_t)t * DM + 8 * lane;
            u32x4 w; w.x = cvtpk(h0[0], h0[1]); w.y = cvtpk(h0[2], h0[3]); w.z = cvtpk(h1[0], h1[1]); w.w = cvtpk(h1[2], h1[3]);
            *(u32x4*)bp = w;
            w.x = cvtpk(h2[0], h2[1]); w.y = cvtpk(h2[2], h2[3]); w.z = cvtpk(h3[0], h3[1]); w.w = cvtpk(h3[2], h3[3]);
            *(u32x4*)(bp + 512) = w;
            if (lane == 0) ssq1[t] = ss;
        }
    }
}

__device__ __forceinline__ void quant_row_i8(const float* __restrict__ src, const float* __restrict__ colscale, unsigned char* __restrict__ dst, float* __restrict__ scale_out, int bias, int lane) {
    f32x4 v[4]; float am = 0.f;
#pragma unroll
    for (int j = 0; j < 4; ++j) {
        v[j] = *(const f32x4*)(src + 4 * (lane + 64 * j));
        if (colscale) v[j] = v[j] * *(const f32x4*)(colscale + 4 * (lane + 64 * j));
        am = fmaxf(am, fmaxf(fmaxf(fabsf(v[j][0]), fabsf(v[j][1])), fmaxf(fabsf(v[j][2]), fabsf(v[j][3]))));
    }
#pragma unroll
    for (int o = 1; o < 64; o <<= 1) am = fmaxf(am, __shfl_xor(am, o));
    const float inv = am > 0.f ? 127.0f / am : 0.f;
#pragma unroll
    for (int j = 0; j < 4; ++j) {
        const int q0 = (int)rintf(v[j][0] * inv) + bias, q1 = (int)rintf(v[j][1] * inv) + bias, q2 = (int)rintf(v[j][2] * inv) + bias, q3 = (int)rintf(v[j][3] * inv) + bias;
        *(unsigned*)(dst + 4 * (lane + 64 * j)) = (unsigned)(q0 & 255) | ((unsigned)(q1 & 255) << 8) | ((unsigned)(q2 & 255) << 16) | ((unsigned)(q3 & 255) << 24);
    }
    if (lane == 0) *scale_out = am > 0.f ? am / 127.0f : 0.f;
}
template <int CTRL> __device__ __forceinline__ int dpp_addi(int v) { return v + __builtin_amdgcn_update_dpp(0, v, CTRL, 0xF, 0xF, true); }
__device__ __forceinline__ void g5_ucompute(const u32x4 (&u)[16], const u32x4& x, LAS int* ap, int p) {
    int a[16];
#pragma unroll
    for (int i = 0; i < 16; ++i) {
        int s_ = __builtin_amdgcn_sdot4((int)u[i].x, (int)x.x, 0, false);
        s_ = __builtin_amdgcn_sdot4((int)u[i].y, (int)x.y, s_, false);
        s_ = __builtin_amdgcn_sdot4((int)u[i].z, (int)x.z, s_, false);
        s_ = __builtin_amdgcn_sdot4((int)u[i].w, (int)x.w, s_, false);
        a[i] = s_;
    }
#pragma unroll
    for (int i = 0; i < 16; ++i) a[i] = dpp_addi<0xB1>(a[i]);
#pragma unroll
    for (int i = 0; i < 16; ++i) a[i] = dpp_addi<0x4E>(a[i]);
    if ((p & 3) == 0) {
#pragma unroll
        for (int i = 0; i < 16; ++i) (void)__hip_atomic_fetch_add(ap + i, a[i], __ATOMIC_RELAXED, __HIP_MEMORY_SCOPE_WORKGROUP);
    }
}
__device__ __forceinline__ void g5_vcompute(const u32x4 (&v)[16], const LAS float* wsrc, float* __restrict__ hp, int lane, int dry) {
    const LAS f32x4* wp = (const LAS f32x4*)wsrc;
    const f32x4 w0 = wp[0], w1 = wp[1], w2 = wp[2], w3 = wp[3];
    const float w[16] = {w0[0], w0[1], w0[2], w0[3], w1[0], w1[1], w1[2], w1[3], w2[0], w2[1], w2[2], w2[3], w3[0], w3[1], w3[2], w3[3]};
    float wsum = ((w[0] + w[1]) + (w[2] + w[3])) + ((w[4] + w[5]) + (w[6] + w[7])) + (((w[8] + w[9]) + (w[10] + w[11])) + ((w[12] + w[13]) + (w[14] + w[15])));
    float yy[16];
    const float y0 = -1152.0f * wsum;
#pragma unroll
    for (int j = 0; j < 16; ++j) yy[j] = y0;
#pragma unroll
    for (int i = 0; i < 16; ++i) {
        const unsigned vw[4] = {v[i].x, v[i].y, v[i].z, v[i].w};
#pragma unroll
        for (int q = 0; q < 4; ++q) {
            const unsigned lo = __builtin_amdgcn_perm(vw[q], 0x64646464u, 0x00050004u), hi = __builtin_amdgcn_perm(vw[q], 0x64646464u, 0x00070006u);
            fma_mix_lo(yy[4 * q], w[i], lo); fma_mix_hi(yy[4 * q + 1], w[i], lo); fma_mix_lo(yy[4 * q + 2], w[i], hi); fma_mix_hi(yy[4 * q + 3], w[i], hi);
        }
    }
    float z[8];
#pragma unroll
    for (int j = 0; j < 8; ++j) z[j] = swap32_add(yy[j], yy[j + 8]);
#pragma unroll
    for (int j = 0; j < 8; ++j) { z[j] = xor16_add(z[j]); z[j] = dpp_add<0x128>(z[j]); }
    if ((lane & 0x18) == 0 && !(dry && z[0] * z[0] >= 0.f)) {
        f32x4 h0 = *(const f32x4*)hp, h1 = *(const f32x4*)(hp + 4);
        h0 += (f32x4){z[0], z[1], z[2], z[3]}; h1 += (f32x4){z[4], z[5], z[6], z[7]};
        *(f32x4*)hp = h0; *(f32x4*)(hp + 4) = h1;
    }
}
#ifndef G5_VDOT4
#define G5_VDOT4 1
#endif
__device__ __forceinline__ void g6_vcompute(const u32x4 (&v)[16], const LAS unsigned char* w8src, float sw, float* __restrict__ hp, int lane, int dry, bf16_t* __restrict__ hbp, LAS float* sspart) {
    const u32x4 w4 = *(const LAS u32x4*)w8src;
    const unsigned ww[4] = {w4.x, w4.y, w4.z, w4.w};
    int yy[16];
#pragma unroll
    for (int j = 0; j < 16; ++j) yy[j] = 0;
#pragma unroll
    for (int a = 0; a < 4; ++a) {
#pragma unroll
        for (int q = 0; q < 4; ++q) {
            const unsigned r0 = (q == 0) ? v[4 * a].x : (q == 1) ? v[4 * a].y : (q == 2) ? v[4 * a].z : v[4 * a].w;
            const unsigned r1 = (q == 0) ? v[4 * a + 1].x : (q == 1) ? v[4 * a + 1].y : (q == 2) ? v[4 * a + 1].z : v[4 * a + 1].w;
            const unsigned r2 = (q == 0) ? v[4 * a + 2].x : (q == 1) ? v[4 * a + 2].y : (q == 2) ? v[4 * a + 2].z : v[4 * a + 2].w;
            const unsigned r3 = (q == 0) ? v[4 * a + 3].x : (q == 1) ? v[4 * a + 3].y : (q == 2) ? v[4 * a + 3].z : v[4 * a + 3].w;
            const unsigned lo01 = __builtin_amdgcn_perm(r1, r0, 0x05010400u), hi01 = __builtin_amdgcn_perm(r1, r0, 0x07030602u);
            const unsigned lo23 = __builtin_amdgcn_perm(r3, r2, 0x05010400u), hi23 = __builtin_amdgcn_perm(r3, r2, 0x07030602u);
            const unsigned c0 = __builtin_amdgcn_perm(lo23, lo01, 0x05040100u), c1 = __builtin_amdgcn_perm(lo23, lo01, 0x07060302u);
            const unsigned c2 = __builtin_amdgcn_perm(hi23, hi01, 0x05040100u), c3 = __builtin_amdgcn_perm(hi23, hi01, 0x07060302u);
            yy[4 * q] = __builtin_amdgcn_sdot4((int)c0, (int)ww[a], yy[4 * q], false); yy[4 * q + 1] = __builtin_amdgcn_sdot4((int)c1, (int)ww[a], yy[4 * q + 1], false);
            yy[4 * q + 2] = __builtin_amdgcn_sdot4((int)c2, (int)ww[a], yy[4 * q + 2], false); yy[4 * q + 3] = __builtin_amdgcn_sdot4((int)c3, (int)ww[a], yy[4 * q + 3], false);
        }
    }
    int z[8];
#pragma unroll
    for (int j = 0; j < 8; ++j) { const auto r = __builtin_amdgcn_permlane32_swap((unsigned)yy[j], (unsigned)yy[j + 8], false, false); z[j] = (int)(r[0] + r[1]); }
#pragma unroll
    for (int j = 0; j < 8; ++j) { z[j] += __builtin_amdgcn_ds_swizzle(z[j], 0x401F); z[j] = dpp_addi<0x128>(z[j]); }
    float ss = 0.f;
    if ((lane & 0x18) == 0 && !(dry && z[0] == 0x7fffffff)) {
        f32x4 h0 = *(const f32x4*)hp, h1 = *(const f32x4*)(hp + 4);
        h0 += (f32x4){(float)z[0] * sw, (float)z[1] * sw, (float)z[2] * sw, (float)z[3] * sw}; h1 += (f32x4){(float)z[4] * sw, (float)z[5] * sw, (float)z[6] * sw, (float)z[7] * sw};
        *(f32x4*)hp = h0; *(f32x4*)(hp + 4) = h1;
        if (hbp) {
            u32x4 w; w.x = cvtpk(h0[0], h0[1]); w.y = cvtpk(h0[2], h0[3]); w.z = cvtpk(h1[0], h1[1]); w.w = cvtpk(h1[2], h1[3]);
            *(u32x4*)hbp = w;
            ss = (h0[0] * h0[0] + h0[1] * h0[1]) + (h0[2] * h0[2] + h0[3] * h0[3]) + (h1[0] * h1[0] + h1[1] * h1[1]) + (h1[2] * h1[2] + h1[3] * h1[3]);
        }
    }
    if (hbp) {
        ss = dpp_add<0xB1>(ss); ss = dpp_add<0x4E>(ss); ss = dpp_add<0x141>(ss);
        if ((lane & 31) == 0) sspart[lane >> 5] = ss;
    }
}
__device__ __forceinline__ void g5_xload(u32x4& x, const unsigned char* __restrict__ XQ, int t0, int it, int p) {
    x = *(const u32x4*)(XQ + (size_t)(t0 + (it & 15)) * DM + 128 * (it >> 4) + 16 * p);
}

__device__ __forceinline__ void gather5_phase(float* __restrict__ H, bf16_t* __restrict__ HB, const float* __restrict__ ssq2p, float* __restrict__ ssq1,
                                              const unsigned char* __restrict__ U8, const unsigned char* __restrict__ V8, const float* __restrict__ su, const float* __restrict__ sv,
                                              unsigned char* __restrict__ XQ, const int* __restrict__ ids, const float* __restrict__ gw,
                                              const float* __restrict__ final_g, int last, LAS unsigned char* lds, int wave, int gwave, int lane, int dry = 0, int idmask = 0xffff) {
    LAS unsigned char* wl = lds + wave * G2_WAVE_LDS;
    LAS unsigned short* idl = (LAS unsigned short*)wl;
    LAS float* al = (LAS float*)(wl + 4096);
    LAS float* sxl = (LAS float*)(wl + 4096 + 8192);
    const int t0 = __builtin_amdgcn_readfirstlane(gwave * 16);
    for (int tt = 0; tt < 16; ++tt) {
        idl[tt * 128 + lane] = (unsigned short)(ids[(size_t)(t0 + tt) * 128 + lane] & idmask);
        idl[tt * 128 + 64 + lane] = (unsigned short)(ids[(size_t)(t0 + tt) * 128 + 64 + lane] & idmask);
    }
    for (int e = lane; e < 2048; e += 64) ((LAS int*)al)[e] = 0;
    for (int tt = 0; tt < 16; ++tt) {
        const bf16_t* xr = HB + (size_t)(t0 + tt) * DM + 8 * lane;
        const u32x4 xa = *(const u32x4*)xr, xb = *(const u32x4*)(xr + 512);
        const float f[16] = {bflo(xa.x), bfhi(xa.x), bflo(xa.y), bfhi(xa.y), bflo(xa.z), bfhi(xa.z), bflo(xa.w), bfhi(xa.w),
                             bflo(xb.x), bfhi(xb.x), bflo(xb.y), bfhi(xb.y), bflo(xb.z), bfhi(xb.z), bflo(xb.w), bfhi(xb.w)};
        float am = 0.f;
#pragma unroll
        for (int j = 0; j < 16; ++j) am = fmaxf(am, fabsf(f[j]));
#pragma unroll
        for (int o = 1; o < 64; o <<= 1) am = fmaxf(am, __shfl_xor(am, o));
        const float inv = am > 0.f ? 127.0f / am : 0.f;
        unsigned wq[4];
#pragma unroll
        for (int j = 0; j < 4; ++j) {
            const int q0 = (int)rintf(f[4 * j] * inv), q1 = (int)rintf(f[4 * j + 1] * inv), q2 = (int)rintf(f[4 * j + 2] * inv), q3 = (int)rintf(f[4 * j + 3] * inv);
            wq[j] = (unsigned)(q0 & 255) | ((unsigned)(q1 & 255) << 8) | ((unsigned)(q2 & 255) << 16) | ((unsigned)(q3 & 255) << 24);
        }
        unsigned char* xq = XQ + (size_t)(t0 + tt) * DM + 8 * lane;
        *(u32x2*)xq = (u32x2){wq[0], wq[1]}; *(u32x2*)(xq + 512) = (u32x2){wq[2], wq[3]};
        if (lane == 0) sxl[tt] = am > 0.f ? am / 127.0f : 0.f;
    }
    asm volatile("s_waitcnt vmcnt(0) lgkmcnt(0)" ::: "memory");
    const int g = lane >> 3, p = lane & 7;
    if (!(dry & 2)) {
        u32x4 uA[16], uB[16], xA, xB;
        g4_issue(uA, U8, idl, 0, g, p); g5_xload(xA, XQ, t0, 0, p);
        for (int it = 0; it < 128; it += 2) {
            g4_issue(uB, U8, idl, it + 1, g, p); g5_xload(xB, XQ, t0, it + 1, p);
            g5_ucompute(uA, xA, (LAS int*)al + (it & 15) * 128 + g * 16, p);
            if (it + 2 < 128) { g4_issue(uA, U8, idl, it + 2, g, p); g5_xload(xA, XQ, t0, it + 2, p); }
            g5_ucompute(uB, xB, (LAS int*)al + ((it + 1) & 15) * 128 + g * 16, p);
        }
    }
    asm volatile("s_waitcnt lgkmcnt(0)" ::: "memory");
#if G5_VDOT4
    LAS unsigned char* w8l = (LAS unsigned char*)al;
    LAS float* swl = sxl + 16;
    for (int tt = 0; tt < 16; ++tt) {
        const float rs2 = rsqrtf(ssq16(ssq2p, t0 + tt) * (1.0f / 1024.0f) + RMS_EPS) * sxl[tt];
        const int id0 = idl[tt * 128 + lane], id1 = idl[tt * 128 + 64 + lane];
        const float a0 = (float)((LAS int*)al)[tt * 128 + lane] * rs2 * su[id0], a1 = (float)((LAS int*)al)[tt * 128 + 64 + lane] * rs2 * su[id1];
        const float w0 = gw[(size_t)(t0 + tt) * 128 + lane] * gelu_erf(a0) * sv[id0], w1 = gw[(size_t)(t0 + tt) * 128 + 64 + lane] * gelu_erf(a1) * sv[id1];
        float am = fmaxf(fabsf(w0), fabsf(w1));
#pragma unroll
        for (int o = 1; o < 64; o <<= 1) am = fmaxf(am, __shfl_xor(am, o));
        const float inv = am > 0.f ? 127.0f / am : 0.f;
        asm volatile("s_waitcnt lgkmcnt(0)" ::: "memory");
        w8l[tt * 128 + lane] = (unsigned char)((int)rintf(w0 * inv) & 255); w8l[tt * 128 + 64 + lane] = (unsigned char)((int)rintf(w1 * inv) & 255);
        if (lane == 0) swl[tt] = am > 0.f ? am / 127.0f : 0.f;
    }
    asm volatile("s_waitcnt lgkmcnt(0)" ::: "memory");
    const bool fold = !last && !dry;
    LAS float* ssp = al + 1024;
    if (!(dry & 4)) {
        u32x4 vA[16], vB[16];
        g4_issue(vA, V8, idl, 0, g, p);
        for (int it = 0; it < 128; it += 2) {
            g4_issue(vB, V8, idl, it + 1, g, p);
            { const size_t o_ = (size_t)(t0 + (it & 15)) * DM + 128 * (it >> 4) + 16 * p + 8 * (lane >> 5);
              g6_vcompute(vA, w8l + (it & 15) * 128 + g * 16, swl[it & 15], H + o_, lane, dry, fold ? HB + o_ : nullptr, ssp + (it & 15) * 16 + (it >> 4) * 2); }
            if (it + 2 < 128) g4_issue(vA, V8, idl, it + 2, g, p);
            { const size_t o_ = (size_t)(t0 + ((it + 1) & 15)) * DM + 128 * ((it + 1) >> 4) + 16 * p + 8 * (lane >> 5);
              g6_vcompute(vB, w8l + ((it + 1) & 15) * 128 + g * 16, swl[(it + 1) & 15], H + o_, lane, dry, fold ? HB + o_ : nullptr, ssp + ((it + 1) & 15) * 16 + ((it + 1) >> 4) * 2); }
        }
    }
#else
    for (int n = 0; n < 32; ++n) {
        const int tt = n >> 1, k = lane + 64 * (n & 1);
        const float rs2 = rsqrtf(ssq16(ssq2p, t0 + tt) * (1.0f / 1024.0f) + RMS_EPS);
        const int id = idl[tt * 128 + k];
        const float a = (float)((LAS int*)al)[tt * 128 + k] * (rs2 * sxl[tt]) * su[id];
        al[tt * 128 + k] = gw[(size_t)(t0 + tt) * 128 + k] * gelu_erf(a) * sv[id];
    }
    asm volatile("s_waitcnt lgkmcnt(0)" ::: "memory");
    if (!(dry & 4)) {
        u32x4 vA[16], vB[16];
        g4_issue(vA, V8, idl, 0, g, p);
        for (int it = 0; it < 128; it += 2) {
            g4_issue(vB, V8, idl, it + 1, g, p);
            g5_vcompute(vA, al + (it & 15) * 128 + g * 16, H + (size_t)(t0 + (it & 15)) * DM + 128 * (it >> 4) + 16 * p + 8 * (lane >> 5), lane, dry);
            if (it + 2 < 128) g4_issue(vA, V8, idl, it + 2, g, p);
            g5_vcompute(vB, al + ((it + 1) & 15) * 128 + g * 16, H + (size_t)(t0 + ((it + 1) & 15)) * DM + 128 * ((it + 1) >> 4) + 16 * p + 8 * (lane >> 5), lane, dry);
        }
    }
#endif
    if (dry) return;
#if G5_VDOT4
    if (fold) {
        asm volatile("s_waitcnt lgkmcnt(0)" ::: "memory");
        if (lane < 16) { float a_ = 0.f;
#pragma unroll
            for (int q_ = 0; q_ < 16; ++q_) a_ += ssp[lane * 16 + q_];
            ssq1[t0 + lane] = a_; }
        return;
    }
#endif
    __builtin_amdgcn_fence(__ATOMIC_SEQ_CST, "agent");
    asm volatile("s_waitcnt vmcnt(0)" ::: "memory");
    for (int tt = 0; tt < 16; ++tt) {
        const int t = t0 + tt;
        float* hp = H + (size_t)t * DM + 8 * lane;
        f32x4 h0 = *(const f32x4*)hp, h1 = *(const f32x4*)(hp + 4), h2 = *(const f32x4*)(hp + 512), h3 = *(const f32x4*)(hp + 516);
        float ss = (h0[0] * h0[0] + h0[1] * h0[1]) + (h0[2] * h0[2] + h0[3] * h0[3]) + (h1[0] * h1[0] + h1[1] * h1[1]) + (h1[2] * h1[2] + h1[3] * h1[3])
                 + (h2[0] * h2[0] + h2[1] * h2[1]) + (h2[2] * h2[2] + h2[3] * h2[3]) + (h3[0] * h3[0] + h3[1] * h3[1]) + (h3[2] * h3[2] + h3[3] * h3[3]);
        ss = wave_sum(ss);
        if (last) {
            const float rs = rsqrtf(ss * (1.0f / 1024.0f) + RMS_EPS);
            const f32x4 g0 = *(const f32x4*)(final_g + 8 * lane), g1 = *(const f32x4*)(final_g + 8 * lane + 4), g2 = *(const f32x4*)(final_g + 512 + 8 * lane), g3 = *(const f32x4*)(final_g + 516 + 8 * lane);
            h0 = h0 * rs * g0; h1 = h1 * rs * g1; h2 = h2 * rs * g2; h3 = h3 * rs * g3;
            *(f32x4*)hp = h0; *(f32x4*)(hp + 4) = h1; *(f32x4*)(hp + 512) = h2; *(f32x4*)(hp + 516) = h3;
        } else {
            bf16_t* bp = HB + (size_t)t * DM + 8 * lane;
            u32x4 w; w.x = cvtpk(h0[0], h0[1]); w.y = cvtpk(h0[2], h0[3]); w.z = cvtpk(h1[0], h1[1]); w.w = cvtpk(h1[2], h1[3]);
            *(u32x4*)bp = w;
            w.x = cvtpk(h2[0], h2[1]); w.y = cvtpk(h2[2], h2[3]); w.z = cvtpk(h3[0], h3[1]); w.w = cvtpk(h3[2], h3[3]);
            *(u32x4*)(bp + 512) = w;
            if (lane == 0) ssq1[t] = ss;
        }
    }
}

__device__ __forceinline__ float gelu_erf(float x) { return 0.5f * x * (1.0f + erff(x * 0.70710678118654752f)); }

__device__ __forceinline__ void gather_phase(float* __restrict__ H, bf16_t* __restrict__ HB, const float* __restrict__ ssq2, float* __restrict__ ssq1,
                                             const bf16_t* __restrict__ U16, const bf16_t* __restrict__ V16, const int* __restrict__ ids, const float* __restrict__ gw,
                                             const float* __restrict__ final_g, int last, int gwave, int ngw, int lane, int dry = 0, int idmask = 0xffff) {
    for (int t0 = gwave; t0 < T; t0 += ngw) {
        const int t = __builtin_amdgcn_readfirstlane(t0);
        const u32x4 xa = *(const u32x4*)(HB + (size_t)t * DM + 8 * lane), xb = *(const u32x4*)(HB + (size_t)t * DM + 512 + 8 * lane);
        const float rs2 = rsqrtf(ssq16(ssq2, t) * (1.0f / 1024.0f) + RMS_EPS);
        float y[16];
#pragma unroll
        for (int i = 0; i < 16; ++i) y[i] = 0.f;
        const int* idp = ids + (size_t)t * 128; const float* gp = gw + (size_t)t * 128;
        for (int c = 0; c < 16; ++c) {
            u32x4 ua[8], ub[8], va[8], vb[8]; float g[8];
#pragma unroll
            for (int e = 0; e < 8; ++e) {
                const int id = __builtin_amdgcn_readfirstlane(idp[c * 8 + e]) & idmask;
                g[e] = gp[c * 8 + e];
                const bf16_t* ur = U16 + (size_t)id * DM + 8 * lane; const bf16_t* vr = V16 + (size_t)id * DM + 8 * lane;
                ua[e] = *(const u32x4*)ur; ub[e] = *(const u32x4*)(ur + 512); va[e] = *(const u32x4*)vr; vb[e] = *(const u32x4*)(vr + 512);
            }
#pragma unroll
            for (int e = 0; e < 8; ++e) {
                float a = 0.f;
                a = dot2bf(xa.x, ua[e].x, a); a = dot2bf(xa.y, ua[e].y, a); a = dot2bf(xa.z, ua[e].z, a); a = dot2bf(xa.w, ua[e].w, a);
                a = dot2bf(xb.x, ub[e].x, a); a = dot2bf(xb.y, ub[e].y, a); a = dot2bf(xb.z, ub[e].z, a); a = dot2bf(xb.w, ub[e].w, a);
                a = wave_sum(a);
                const float w = g[e] * gelu_erf(a * rs2);
                y[0] = fmaf(w, bflo(va[e].x), y[0]); y[1] = fmaf(w, bfhi(va[e].x), y[1]); y[2] = fmaf(w, bflo(va[e].y), y[2]); y[3] = fmaf(w, bfhi(va[e].y), y[3]);
                y[4] = fmaf(w, bflo(va[e].z), y[4]); y[5] = fmaf(w, bfhi(va[e].z), y[5]); y[6] = fmaf(w, bflo(va[e].w), y[6]); y[7] = fmaf(w, bfhi(va[e].w), y[7]);
                y[8] = fmaf(w, bflo(vb[e].x), y[8]); y[9] = fmaf(w, bfhi(vb[e].x), y[9]); y[10] = fmaf(w, bflo(vb[e].y), y[10]); y[11] = fmaf(w, bfhi(vb[e].y), y[11]);
                y[12] = fmaf(w, bflo(vb[e].z), y[12]); y[13] = fmaf(w, bfhi(vb[e].z), y[13]); y[14] = fmaf(w, bflo(vb[e].w), y[14]); y[15] = fmaf(w, bfhi(vb[e].w), y[15]);
            }
        }
        float* hp = H + (size_t)t * DM + 8 * lane;
        f32x4 h0 = *(const f32x4*)hp, h1 = *(const f32x4*)(hp + 4), h2 = *(const f32x4*)(hp + 512), h3 = *(const f32x4*)(hp + 516);
        h0 += (f32x4){y[0], y[1], y[2], y[3]}; h1 += (f32x4){y[4], y[5], y[6], y[7]}; h2 += (f32x4){y[8], y[9], y[10], y[11]}; h3 += (f32x4){y[12], y[13], y[14], y[15]};
        float ss = (h0[0] * h0[0] + h0[1] * h0[1]) + (h0[2] * h0[2] + h0[3] * h0[3]) + (h1[0] * h1[0] + h1[1] * h1[1]) + (h1[2] * h1[2] + h1[3] * h1[3])
                 + (h2[0] * h2[0] + h2[1] * h2[1]) + (h2[2] * h2[2] + h2[3] * h2[3]) + (h3[0] * h3[0] + h3[1] * h3[1]) + (h3[2] * h3[2] + h3[3] * h3[3]);
        ss = wave_sum(ss);
        if (dry && ss >= 0.f) continue;
        if (last) {
            const float rs = rsqrtf(ss * (1.0f / 1024.0f) + RMS_EPS);
            const f32x4 g0 = *(const f32x4*)(final_g + 8 * lane), g1 = *(const f32x4*)(final_g + 8 * lane + 4), g2 = *(const f32x4*)(final_g + 512 + 8 * lane), g3 = *(const f32x4*)(final_g + 516 + 8 * lane);
            h0 = h0 * rs * g0; h1 = h1 * rs * g1; h2 = h2 * rs * g2; h3 = h3 * rs * g3;
            *(f32x4*)hp = h0; *(f32x4*)(hp + 4) = h1; *(f32x4*)(hp + 512) = h2; *(f32x4*)(hp + 516) = h3;
        } else {
            *(f32x4*)hp = h0; *(f32x4*)(hp + 4) = h1; *(f32x4*)(hp + 512) = h2; *(f32x4*)(hp + 516) = h3;
            bf16_t* bp = HB + (size_t)t * DM + 8 * lane;
            u32x4 w; w.x = cvtpk(h0[0], h0[1]); w.y = cvtpk(h0[2], h0[3]); w.z = cvtpk(h1[0], h1[1]); w.w = cvtpk(h1[2], h1[3]);
            *(u32x4*)bp = w;
            w.x = cvtpk(h2[0], h2[1]); w.y = cvtpk(h2[2], h2[3]); w.z = cvtpk(h3[0], h3[1]); w.w = cvtpk(h3[2], h3[3]);
            *(u32x4*)(bp + 512) = w;
            if (lane == 0) ssq1[t] = ss;
        }
    }
}

#define XB_TMO      128
#define XB_XCNT(j)  (256  + 64 * (j))
#define XB_XSUB(j)  (1280 + 64 * (j))
#define XB_XGEN(j)  (2304 + 64 * (j))
#define XB_TOP      3328
#define XB_TOPGEN   3392
#define XCD_BAR_WORDS 3456
#define XB_SPIN_CAP (1u << 18)

__device__ __forceinline__ unsigned xb_ld(unsigned* p)              { return __hip_atomic_load(p, __ATOMIC_RELAXED, __HIP_MEMORY_SCOPE_AGENT); }
__device__ __forceinline__ unsigned xb_add(unsigned* p, unsigned v) { return __hip_atomic_fetch_add(p, v, __ATOMIC_RELAXED, __HIP_MEMORY_SCOPE_AGENT); }
__device__ __forceinline__ unsigned xb_xcc_id() { return (unsigned)__builtin_amdgcn_s_getreg((3 << 11) | 20) & 0xFu; }
#define XB_SPIN(cond, bar) do { unsigned _sp = 0; while (cond) { __builtin_amdgcn_s_sleep(1); \
    if ((++_sp & 255u) == 0u) { if (xb_ld(&(bar)[XB_TMO])) break; if (_sp > XB_SPIN_CAP) { atomicAdd(&(bar)[XB_TMO], 1u); break; } } } } while (0)

struct XcdBarrier {
    unsigned* bar; unsigned x;
    volatile LAS unsigned* st;
};

__device__ __forceinline__ XcdBarrier xcd_barrier_post(unsigned* bar, volatile LAS unsigned* st, int tid) {
    XcdBarrier b; b.bar = bar; b.x = xb_xcc_id(); b.st = st;
    if (tid == 0) (void)xb_add(&bar[XB_XCNT(b.x)], 1u);
    return b;
}
__device__ __forceinline__ void xcd_barrier_complete(unsigned* bar, unsigned x, unsigned& nloc, unsigned& nx) {
    const unsigned G = gridDim.x * gridDim.y * gridDim.z;
    unsigned sum, cnt, mine, sp = 0u;
    for (;;) {
        sum = 0u; cnt = 0u; mine = 0u;
#pragma unroll
        for (unsigned j = 0; j < 16; ++j) { const unsigned c = xb_ld(&bar[XB_XCNT(j)]); sum += c; cnt += (c > 0u) ? 1u : 0u; mine = (j == x) ? c : mine; }
        if (sum == G) break;
        __builtin_amdgcn_s_sleep(1);
        if ((++sp & 255u) == 0u) { if (xb_ld(&bar[XB_TMO])) break; if (sp > XB_SPIN_CAP) { atomicAdd(&bar[XB_TMO], 1u); break; } }
    }
    nloc = mine > 0u ? mine : 1u; nx = cnt > 0u ? cnt : 1u;
}

__device__ __forceinline__ void xcd_barrier(const XcdBarrier& b, int tid) {
    asm volatile("s_waitcnt vmcnt(0)" ::: "memory");
    __syncthreads();
    if (tid == 0) {
        unsigned* bar = b.bar;
        __builtin_amdgcn_s_waitcnt(0);
        unsigned nloc = b.st[0], nx = b.st[1];
        if (nloc == 0u) { xcd_barrier_complete(bar, b.x, nloc, nx); b.st[0] = nloc; b.st[1] = nx; }
        const unsigned old = xb_add(&bar[XB_XSUB(b.x)], 1u);
        const unsigned gen = old / nloc;
        if (old + 1u == (gen + 1u) * nloc) {
            __builtin_amdgcn_fence(__ATOMIC_RELEASE, "agent");
            asm volatile("s_waitcnt vmcnt(0)" ::: "memory");
            const unsigned og = xb_add(&bar[XB_TOP], 1u);
            const unsigned tg = og / nx;
            if (og + 1u == (tg + 1u) * nx) xb_add(&bar[XB_TOPGEN], 1u);
            else XB_SPIN(xb_ld(&bar[XB_TOPGEN]) == tg, bar);
            __builtin_amdgcn_fence(__ATOMIC_ACQUIRE, "agent");
            xb_add(&bar[XB_XGEN(b.x)], 1u);
            asm volatile("s_waitcnt vmcnt(0)" ::: "memory");
        } else {
            XB_SPIN(xb_ld(&bar[XB_XGEN(b.x)]) == gen, bar);
            __builtin_amdgcn_fence(__ATOMIC_ACQUIRE, "agent");
            asm volatile("s_waitcnt vmcnt(0)" ::: "memory");
        }
    }
    __syncthreads();
}
struct Params { const float* in[18]; float* out; unsigned char* ws; int ph_lo, ph_hi; };

typedef const __attribute__((address_space(4))) Params* KP;
#define KARGS() KP pp = (KP)__builtin_amdgcn_kernarg_segment_ptr(); asm volatile("" : "+s"(pp))
#ifndef PEER_FP8
#define PEER_FP8 1
#endif
#ifndef PEER_I8
#define PEER_I8 1
#endif
#ifndef G4P
#define G4P 0
#endif
#ifndef PROBE_DUP
#define PROBE_DUP 0
#endif
#define PH_ON(k, bit) ((PH_MASK & (bit)) && ph_lo <= (k) && (k) < ph_hi)
constexpr int CW_BAR = 4096;
constexpr int MISC_OFF = 131072 + 320;
__device__ __forceinline__ int lane_id_opaque() { int l; asm volatile("v_mbcnt_lo_u32_b32 %0, -1, 0\n\tv_mbcnt_hi_u32_b32 %0, -1, %0" : "=v"(l)); return l; }
#define PH_SYNC(k) do { if ((k) > ph_lo) { { KP pq = (KP)__builtin_amdgcn_kernarg_segment_ptr(); \
    XcdBarrier xb_; xb_.bar = (unsigned*)(pq->ws + WS_CTL) + CW_BAR; xb_.x = xb_xcc_id(); xb_.st = (volatile LAS unsigned*)(lds + MISC_OFF) + 8; xcd_barrier(xb_, tid); if (PROBE_DUP == 15) { xcd_barrier(xb_, tid); xcd_barrier(xb_, tid); } } } } while (0)
#define PH_IDS() const int lane = lane_id_opaque(); const int tid = wave * 64 + lane

__device__ __forceinline__ void weight_prep(KP pp, int l, LAS float* scr, int gw0, int ngw, int lane) {
    unsigned char* wl = pp->ws + WS_W + (size_t)l * WL_STRIDE;
    const float* g1 = pp->in[2] + (size_t)l * DM; const float* g2 = pp->in[11] + (size_t)l * DM;
    for (int it = gw0; it < 16 * 192; it += ngw) transpose_item<1>(pp->in[3] + (size_t)l * DM * IN_COLS, DM, IN_COLS, (bf16_t*)(wl + WL_IN), g1, scr, it, 192, lane);
    for (int i = 0; i < 3; ++i)
        for (int it = gw0; it < 6 * 32; it += ngw) transpose_item<0>(pp->in[7 + i] + (size_t)l * 384 * DM, 384, DM, (bf16_t*)(wl + WL_BR) + (size_t)i * DM * 384, nullptr, scr, it, 32, lane);
    for (int it = gw0; it < 16 * 32; it += ngw) transpose_item<0>(pp->in[10] + (size_t)l * DM * DM, DM, DM, (bf16_t*)(wl + WL_OUT), nullptr, scr, it, 32, lane);
    for (int it = gw0; it < 16 * 64; it += ngw) transpose_item<0>(pp->in[12] + (size_t)l * DM * 2048, DM, 2048, (bf16_t*)(wl + WL_Q), g2, scr, it, 64, lane);
}

template <int l>
__device__ __forceinline__ void layer_phases(const int ph_lo, const int ph_hi, LAS unsigned char* lds, const int wave) {
    constexpr int pb = 1 + 8 * l;
        if (PH_ON(pb + 0, 2)) {
            PH_IDS(); PH_SYNC(pb + 0); KARGS();
            unsigned char* ws = pp->ws; unsigned char* wl = ws + WS_W + (size_t)l * WL_STRIDE;
            const int G = gridDim.x;
            pg8::Gemm g{(const bf16_t*)(ws + WS_HB), (const bf16_t*)(wl + WL_IN), T, N_IN, DM, DM};
            pg8::StaticOrder S; S.init(T, N_IN, G, (int)blockIdx.x);
            EpiIn E{(bf16_t*)(ws + WS_P), (bf16_t*)(ws + WS_G), (const float*)(ws + WS_SSQ1), (const float*)(ws + WS_ROPE), pp->in[6] + (size_t)l * 3 * DM, pp->in[4] + (size_t)l * 6, (float*)(ws + WS_LOGF), 0};
            pg8::gemm_phase<EpiIn, pg8::StaticOrder, true, true>(lds, g, S, E, tid);
            if (PROBE_DUP == 1) { __syncthreads(); pg8::gemm_phase<EpiIn, pg8::StaticOrder, true, true>(lds, g, S, E, tid); }
            if (PROBE_DUP == 13) { __syncthreads(); EpiIn En = E; En.nostore = 1; pg8::gemm_phase<EpiIn, pg8::StaticOrder, true, true>(lds, g, S, En, tid); }
            if (PROBE_DUP == 12) { __syncthreads(); EpiDry Ed{(float*)(ws + WS_CTL) + 8192}; pg8::gemm_phase<EpiDry, pg8::StaticOrder, true, true>(lds, g, S, Ed, tid); }
        }
        if (PH_ON(pb + 1, 4)) {
            PH_IDS(); PH_SYNC(pb + 1); KARGS();
            float* logf = (float*)(pp->ws + WS_LOGF); float* cumT = (float*)(pp->ws + WS_CUMT);
            LAS float* wt = (LAS float*)lds;
            for (int r = (int)blockIdx.x * 512 + tid; r < BATCH * 6 * SEQ; r += (int)gridDim.x * 512) {
                const int sq = r >> 13, sp_ = r & (SEQ - 1), b = sq / 6, h = sq % 6;
                const bf16_t* kr = (const bf16_t*)(pp->ws + WS_P) + ((size_t)b * SEQ + sp_) * NP + PC_KB + 64 * h;
                float n2 = 0.f;
#pragma unroll
                for (int c = 0; c < 8; ++c) { const u32x4 kk = *(const u32x4*)(kr + 8 * c);
                    n2 += (bflo(kk.x) * bflo(kk.x) + bfhi(kk.x) * bfhi(kk.x)) + (bflo(kk.y) * bflo(kk.y) + bfhi(kk.y) * bfhi(kk.y)) + (bflo(kk.z) * bflo(kk.z) + bfhi(kk.z) * bfhi(kk.z)) + (bflo(kk.w) * bflo(kk.w) + bfhi(kk.w) * bfhi(kk.w)); }
#pragma unroll
                for (int o = 1; o < 64; o <<= 1) n2 = fmaxf(n2, __shfl_xor(n2, o));
                if (lane == 0) atomicMax((unsigned*)(pp->ws + WS_KMAX_BASE + 256 * l) + sq, __float_as_uint(n2));
            }
            if (l + 1 < DEPTH && (int)blockIdx.x >= BATCH * 6 && (int)gridDim.x > BATCH * 6)
                weight_prep(pp, l + 1, (LAS float*)(lds + wave * 8448), ((int)blockIdx.x - BATCH * 6) * 8 + wave, ((int)gridDim.x - BATCH * 6) * 8, lane);
            for (int sq = blockIdx.x; sq < BATCH * 6; sq += gridDim.x) {
                const int b = sq / 6, h = sq % 6;
                float* base = logf + (size_t)b * SEQ * 8 + h;
                float v[16]; float run = 0.f;
#pragma unroll
                for (int i = 0; i < 16; ++i) { run += base[(size_t)(tid * 16 + i) * 8]; v[i] = run; }
                float inc = run;
#pragma unroll
                for (int o = 1; o < 64; o <<= 1) { const float n = __shfl_up(inc, o); if (lane >= o) inc += n; }
                __syncthreads();
                if (lane == 63) wt[wave] = inc;
                __syncthreads();
                float off = inc - run;
                for (int w = 0; w < wave; ++w) off += wt[w];
#pragma unroll
                for (int i = 0; i < 16; ++i) cumT[(size_t)sq * SEQ + tid * 16 + i] = (v[i] + off) * LOG2E;
            }
        }
        if (PH_ON(pb + 2, 8)) {
            PH_IDS(); PH_SYNC(pb + 2); KARGS();
            if (PROBE_DUP == 2) { attention_phase((bf16_t*)(pp->ws + WS_P), (const float*)(pp->ws + WS_CUMT), (const float*)(pp->ws + WS_KMAX_BASE + 256 * l), pp->in[5] + (size_t)l * 6, (unsigned*)(pp->ws + WS_CTL) + CW_ATT + 64 * (l + 2), lds, wave, lane, 1); }
            attention_phase((bf16_t*)(pp->ws + WS_P), (const float*)(pp->ws + WS_CUMT), (const float*)(pp->ws + WS_KMAX_BASE + 256 * l), pp->in[5] + (size_t)l * 6, (unsigned*)(pp->ws + WS_CTL) + CW_ATT + 64 * l, lds, wave, lane);
        }
        if (PH_ON(pb + 3, 16)) {
            PH_IDS(); PH_SYNC(pb + 3); KARGS();
            unsigned char* ws = pp->ws; unsigned char* wl = ws + WS_W + (size_t)l * WL_STRIDE;
            bf16_t* P = (bf16_t*)(ws + WS_P);
            for (int rep = 0; rep < (PROBE_DUP == 6 ? 2 : 1); ++rep) {
                pg8::Gemm g{P, (const bf16_t*)(wl + WL_BR), T, DM, 384, NP};
                BranchOrder S; S.init(T, DM, (int)gridDim.x, (int)blockIdx.x);
                EpiBrChain E{(const unsigned char*)(ws + WS_G), P + PC_MERGED};
                pg8::gemm_phase<EpiBrChain, BranchOrder, true, true>(lds, g, S, E, tid);
                __syncthreads();
            }
        }
        if (PH_ON(pb + 4, 32)) {
            PH_IDS(); PH_SYNC(pb + 4); KARGS();
            unsigned char* ws = pp->ws; unsigned char* wl = ws + WS_W + (size_t)l * WL_STRIDE;
            pg8::Gemm g{(const bf16_t*)(ws + WS_P) + PC_MERGED, (const bf16_t*)(wl + WL_OUT), T, DM, DM, NP};
            pg8::StaticOrder S; S.init(T, DM, (int)gridDim.x, (int)blockIdx.x);
            EpiOut E{l == 0 ? pp->in[0] : pp->out, pp->out, (bf16_t*)(ws + WS_HB), (float*)(ws + WS_SSQ2P)};
            pg8::gemm_phase<EpiOut, pg8::StaticOrder, true, true>(lds, g, S, E, tid);
            if (PROBE_DUP == 14 && l == 0) { __syncthreads(); pg8::gemm_phase<EpiOut, pg8::StaticOrder, true, true>(lds, g, S, E, tid); }
        }
        if (PH_ON(pb + 5, 64)) {
            PH_IDS(); PH_SYNC(pb + 5); KARGS();
            unsigned char* ws = pp->ws; unsigned char* wl = ws + WS_W + (size_t)l * WL_STRIDE;
            for (int rep = 0; rep < (PROBE_DUP == 7 ? 2 : 1); ++rep) {
            {
                pg8::Gemm g{(const bf16_t*)(ws + WS_HB), (const bf16_t*)(wl + WL_Q), T, 2048, DM, DM};
                pg8::StaticOrder S; S.init(T, 2048, (int)gridDim.x, (int)blockIdx.x);
                EpiQ E{(bf16_t*)(ws + WS_Q2), (const float*)(ws + WS_SSQ2P)};
                pg8::gemm_phase<EpiQ, pg8::StaticOrder, true, true>(lds, g, S, E, tid);
            }
            __syncthreads();
            }
        }
        if (PH_ON(pb + 6, 128)) {
            PH_IDS(); PH_SYNC(pb + 6); KARGS();
            unsigned char* ws = pp->ws;
            if (PROBE_DUP == 3) { routing_phase((const bf16_t*)(ws + WS_Q2), pp->in[13] + (size_t)l * 128 * 128, pp->in[14] + (size_t)l * 128 * 128, (int*)(ws + WS_IDS), (float*)(ws + WS_GW), lds, tid); __syncthreads(); }
            routing2_setup(pp->in[13] + (size_t)l * 128 * 128, pp->in[14] + (size_t)l * 128 * 128, lds, tid);
            if (wave < 4) routing2_units((const bf16_t*)(ws + WS_Q2), (int*)(ws + WS_IDS), (float*)(ws + WS_GW), lds, wave, lane, (int)blockIdx.x * 8 + wave, (int)gridDim.x * 8);
            if (PEER_I8) {
                const float* u = pp->in[15] + (size_t)l * N_EXP * DM; const float* v = pp->in[16] + (size_t)l * N_EXP * DM;
                const float* g2 = pp->in[11] + (size_t)l * DM;
                for (int r = (int)blockIdx.x * 8 + wave; r < N_EXP; r += (int)gridDim.x * 8) {
                    quant_row_i8(u + (size_t)r * DM, g2, ws + WS_U8 + (size_t)r * DM, (float*)(ws + WS_SU) + r, 0, lane);
                    quant_row_i8(v + (size_t)r * DM, nullptr, ws + WS_V8 + (size_t)r * DM, (float*)(ws + WS_SV) + r, G5_VDOT4 ? 0 : 128, lane);
                }
            } else if (PEER_FP8) {
                const float* u = pp->in[15] + (size_t)l * N_EXP * DM; const float* v = pp->in[16] + (size_t)l * N_EXP * DM;
                const float* g2 = pp->in[11] + (size_t)l * DM;
                for (int r = (int)blockIdx.x * 8 + wave; r < N_EXP; r += (int)gridDim.x * 8) {
                    quant_row_fp8(u + (size_t)r * DM, g2, ws + WS_U8 + (size_t)r * DM, (float*)(ws + WS_SU) + r, lane);
                    quant_row_fp8(v + (size_t)r * DM, nullptr, ws + WS_V8 + (size_t)r * DM, (float*)(ws + WS_SV) + r, lane);
                }
            } else {
                const float* u = pp->in[15] + (size_t)l * N_EXP * DM; const float* v = pp->in[16] + (size_t)l * N_EXP * DM;
                const float* g2 = pp->in[11] + (size_t)l * DM;
                bf16_t* U16 = (bf16_t*)(ws + WS_U16); bf16_t* V16 = (bf16_t*)(ws + WS_V16);
                for (unsigned e = blockIdx.x * 512 + tid; e < (unsigned)(N_EXP * DM / 8); e += gridDim.x * 512) {
                    const unsigned o = e * 8; const int c = (int)(o & (DM - 1));
                    const f32x4 a0 = *(const f32x4*)(u + o), a1 = *(const f32x4*)(u + o + 4), s0 = *(const f32x4*)(g2 + c), s1 = *(const f32x4*)(g2 + c + 4);
                    u32x4 w; w.x = cvtpk(a0[0] * s0[0], a0[1] * s0[1]); w.y = cvtpk(a0[2] * s0[2], a0[3] * s0[3]); w.z = cvtpk(a1[0] * s1[0], a1[1] * s1[1]); w.w = cvtpk(a1[2] * s1[2], a1[3] * s1[3]);
                    *(u32x4*)(U16 + o) = w;
                    const f32x4 b0 = *(const f32x4*)(v + o), b1 = *(const f32x4*)(v + o + 4);
                    if (G3_VF16) { w.x = cvtpk_h(b0[0], b0[1]); w.y = cvtpk_h(b0[2], b0[3]); w.z = cvtpk_h(b1[0], b1[1]); w.w = cvtpk_h(b1[2], b1[3]); }
                    else { w.x = cvtpk(b0[0], b0[1]); w.y = cvtpk(b0[2], b0[3]); w.z = cvtpk(b1[0], b1[1]); w.w = cvtpk(b1[2], b1[3]); }
                    *(u32x4*)(V16 + o) = w;
                }
            }
            if (wave >= 4) routing2_units((const bf16_t*)(ws + WS_Q2), (int*)(ws + WS_IDS), (float*)(ws + WS_GW), lds, wave, lane, (int)blockIdx.x * 8 + wave, (int)gridDim.x * 8);
        }
        if (PH_ON(pb + 7, 256)) {
            PH_IDS(); PH_SYNC(pb + 7); KARGS();
            unsigned char* ws = pp->ws;
            if (PROBE_DUP == 4) gather_phase(pp->out, (bf16_t*)(ws + WS_HB), (const float*)(ws + WS_SSQ2P), (float*)(ws + WS_SSQ1), (const bf16_t*)(ws + WS_U16), (const bf16_t*)(ws + WS_V16),
                         (const int*)(ws + WS_IDS), (const float*)(ws + WS_GW), pp->in[17], l == DEPTH - 1 ? 1 : 0, (int)blockIdx.x * 8 + wave, (int)gridDim.x * 8, lane, 1);
            if (PROBE_DUP == 5) gather_phase(pp->out, (bf16_t*)(ws + WS_HB), (const float*)(ws + WS_SSQ2P), (float*)(ws + WS_SSQ1), (const bf16_t*)(ws + WS_U16), (const bf16_t*)(ws + WS_V16),
                         (const int*)(ws + WS_IDS), (const float*)(ws + WS_GW), pp->in[17], l == DEPTH - 1 ? 1 : 0, (int)blockIdx.x * 8 + wave, (int)gridDim.x * 8, lane, 1, 511);
            if (PROBE_DUP == 10 || PROBE_DUP == 11) gather5_phase(pp->out, (bf16_t*)(ws + WS_HB), (const float*)(ws + WS_SSQ2P), (float*)(ws + WS_SSQ1), ws + WS_U8, ws + WS_V8, (const float*)(ws + WS_SU), (const float*)(ws + WS_SV),
                         ws + WS_XQ, (const int*)(ws + WS_IDS), (const float*)(ws + WS_GW), pp->in[17], l == DEPTH - 1 ? 1 : 0, lds, wave, (int)blockIdx.x * 8 + wave, lane, 1 | G4P, PROBE_DUP == 10 ? 7 : 0xffff);
            if (PEER_I8) gather5_phase(pp->out, (bf16_t*)(ws + WS_HB), (const float*)(ws + WS_SSQ2P), (float*)(ws + WS_SSQ1), ws + WS_U8, ws + WS_V8, (const float*)(ws + WS_SU), (const float*)(ws + WS_SV),
                         ws + WS_XQ, (const int*)(ws + WS_IDS), (const float*)(ws + WS_GW), pp->in[17], l == DEPTH - 1 ? 1 : 0, lds, wave, (int)blockIdx.x * 8 + wave, lane);
            else if (PEER_FP8) gather4_phase(pp->out, (bf16_t*)(ws + WS_HB), (const float*)(ws + WS_SSQ2P), (float*)(ws + WS_SSQ1), ws + WS_U8, ws + WS_V8, (const float*)(ws + WS_SU), (const float*)(ws + WS_SV),
                         (const int*)(ws + WS_IDS), (const float*)(ws + WS_GW), pp->in[17], l == DEPTH - 1 ? 1 : 0, lds, wave, (int)blockIdx.x * 8 + wave, lane);
            else gather3_phase(pp->out, (bf16_t*)(ws + WS_HB), (const float*)(ws + WS_SSQ2P), (float*)(ws + WS_SSQ1), (const bf16_t*)(ws + WS_U16), (const unsigned short*)(ws + WS_V16),
                         (const int*)(ws + WS_IDS), (const float*)(ws + WS_GW), pp->in[17], l == DEPTH - 1 ? 1 : 0, lds, wave, (int)blockIdx.x * 8 + wave, lane);
        }
}

__global__ void __launch_bounds__(512, 2) mega(Params p) {
    extern __shared__ __attribute__((aligned(16))) unsigned char lds_raw[];
    LAS unsigned char* lds = (LAS unsigned char*)lds_raw;
    const int ph_lo = p.ph_lo, ph_hi = p.ph_hi;
    const int wave = __builtin_amdgcn_readfirstlane(threadIdx.x >> 6);
    if (ph_lo < -1000) cg::this_grid().sync();
    {
        const int tid0 = threadIdx.x;
        for (int u = tid0; u < (LDS_BYTES - 131072) / 4; u += 512) ((LAS unsigned*)(lds + 131072))[u] = 0u;
        __syncthreads();
        if (ph_hi - ph_lo > 1) { KP pq = (KP)__builtin_amdgcn_kernarg_segment_ptr(); (void)xcd_barrier_post((unsigned*)(pq->ws + WS_CTL) + CW_BAR, (volatile LAS unsigned*)(lds + MISC_OFF) + 8, tid0); }
    }

    if (PH_ON(0, 1)) { KARGS();
        const int tid = threadIdx.x, lane = tid & 63;
        unsigned char* ws = pp->ws;
        const int G = gridDim.x, gwave = blockIdx.x * 8 + wave, ngw = G * 8;
        LAS float* scr = (LAS float*)(lds + wave * 8448);
        for (int rep = 0; rep < (PROBE_DUP == 8 ? 2 : 1); ++rep) {
        if (wave < 4) weight_prep(pp, 0, scr, gwave, ngw, lane);
        {
            const int* pos = (const int*)pp->in[1];
            float* rope = (float*)(ws + WS_ROPE);
            const float inv_freq = (float)exp2(-(double)(tid & 31) * (13.287712379549449 / 32.0));
            for (int e = blockIdx.x * 512 + tid; e < T * 32; e += G * 512) {
                const int t = e >> 5;
                const float ang = (float)pos[t] * inv_freq;
                double rv = (double)ang * 0.15915494309189535; rv -= floor(rv);
                const float rf = (float)rv;
                rope[2 * e] = __builtin_amdgcn_cosf(rf); rope[2 * e + 1] = __builtin_amdgcn_sinf(rf);
            }
        }
        {
            bf16_t* HB = (bf16_t*)(ws + WS_HB); float* ssq1 = (float*)(ws + WS_SSQ1);
            for (int t = gwave; t < T; t += ngw) {
                const f32x4* xr = (const f32x4*)(pp->in[0] + (size_t)t * DM) + lane;
                f32x4 v[4]; float ss = 0.f;
#pragma unroll
                for (int j = 0; j < 4; ++j) { v[j] = xr[64 * j]; ss += (v[j][0] * v[j][0] + v[j][1] * v[j][1]) + (v[j][2] * v[j][2] + v[j][3] * v[j][3]); }
                ss = wave_sum(ss);
                u32x2* br = (u32x2*)(HB + (size_t)t * DM) + lane;
#pragma unroll
                for (int j = 0; j < 4; ++j) { u32x2 w; w.x = cvtpk(v[j][0], v[j][1]); w.y = cvtpk(v[j][2], v[j][3]); br[64 * j] = w; }
                if (lane == 0) ssq1[t] = ss;
            }
        }
        if (wave >= 4) weight_prep(pp, 0, scr, gwave, ngw, lane);
        }
    }

    layer_phases<0>(ph_lo, ph_hi, lds, wave);
    layer_phases<1>(ph_lo, ph_hi, lds, wave);
    static_assert(DEPTH == 2, "two layers");
}

#ifndef MK_PER_PHASE
#define MK_PER_PHASE 0
#endif
extern "C" void kernel_launch(void* const* d_in, const int* in_sizes, int n_in, void* d_out, int out_size, void* d_ws, size_t ws_size, hipStream_t stream) {
    static int grid = 0;
    if (grid == 0) {
        if (n_in != 18 || in_sizes[0] != T * DM || out_size != T * DM || ws_size < WS_END) {
            fprintf(stderr, "kernel_launch: unexpected shapes (n_in %d, in0 %d, out %d, ws %zu); nothing launched\n", n_in, n_in > 0 ? in_sizes[0] : -1, out_size, ws_size); grid = -1; return; }
        int dev = 0, cus = 0, per_cu = 0;
        (void)hipGetDevice(&dev);
        (void)hipDeviceGetAttribute(&cus, hipDeviceAttributeMultiprocessorCount, dev);
        (void)hipFuncSetAttribute((const void*)mega, hipFuncAttributeMaxDynamicSharedMemorySize, LDS_BYTES);
        (void)hipOccupancyMaxActiveBlocksPerMultiprocessor(&per_cu, (const void*)mega, 512, LDS_BYTES);
        if (per_cu < 1) { fprintf(stderr, "kernel_launch: occupancy query says %d blocks per CU\n", per_cu); per_cu = 1; }
        (void)hipGetLastError();
        if (cus < 256) { fprintf(stderr, "kernel_launch: built for a 256-CU device (found %d); nothing launched\n", cus); grid = -1; return; }
        grid = 256;
    }
    if (grid < 0) return;
    (void)hipMemsetAsync((char*)d_ws + WS_CTL, 0, CTL_ZERO_BYTES, stream);
    Params p{};
    for (int i = 0; i < 18; ++i) p.in[i] = (const float*)d_in[i];
    p.out = (float*)d_out; p.ws = (unsigned char*)d_ws;
#if MK_PER_PHASE
    for (int ph = 0; ph < NPH; ++ph) {
        p.ph_lo = ph; p.ph_hi = ph + 1;
        void* args[] = {&p};
        hipError_t e = hipLaunchCooperativeKernel((const void*)mega, dim3(grid), dim3(512), args, LDS_BYTES, stream);
        if (e != hipSuccess) { fprintf(stderr, "cooperative launch %d failed: %s\n", ph, hipGetErrorString(e)); break; }
    }
#else
    p.ph_lo = 0; p.ph_hi = NPH;
    void* args[] = {&p};
    hipError_t e = hipLaunchCooperativeKernel((const void*)mega, dim3(grid), dim3(512), args, LDS_BYTES, stream);
    if (e != hipSuccess) fprintf(stderr, "cooperative launch failed: %s (grid %d)\n", hipGetErrorString(e), grid);
#endif
}
```

```cpp
#include <hip/hip_runtime.h>
#include <hip/hip_cooperative_groups.h>
#include <cstdio>
#include <cstdint>
#include <cmath>
namespace cg = cooperative_groups;
namespace pg8 {
#define PG8_LAS __attribute__((address_space(3)))
typedef unsigned short bf16_t;
typedef short bf16x8 __attribute__((ext_vector_type(8)));
typedef float f32x4 __attribute__((ext_vector_type(4)));
typedef unsigned u32x4 __attribute__((ext_vector_type(4)));
typedef int i32x4 __attribute__((ext_vector_type(4)));
typedef long i64x2 __attribute__((ext_vector_type(2)));
#ifndef PG8_I8_SPLIT
#define PG8_I8_SPLIT 0
#endif
#ifndef PG8_I8_ASM
#define PG8_I8_ASM 0
#endif
constexpr int BM = 256, BK = 64, HALF = 128, HTB = HALF * BK * 2  , STAGE_BYTES = 8 * HTB, NXCD = 8, WGM = 8;

__host__ __device__ __forceinline__ int lds_byte(int r, int c) { const int st = (r >> 4) * 2 + (c >> 5), rr = r & 15, cc = c & 31, ob = rr * 64 + cc * 2; return st * 1024 + (ob ^ (((ob >> 9) & 1) << 5)); }
__host__ __device__ __forceinline__ void stage_rc(int b, int& R, int& C) { const int st = b / 1024, sb = b % 1024, swz = sb ^ (((sb >> 9) & 1) << 5); R = (st >> 1) * 16 + swz / 64; C = (st & 1) * 32 + (swz % 64) / 2; }
__host__ __device__ __forceinline__ int perm32(int rho) { const int n = rho >> 4, i = rho & 15; return 8 * (i >> 2) + 4 * n + (i & 3); }

struct Unit { int pm, pn, br; };
struct Gemm { const bf16_t* A; const bf16_t* Bt; int M, N, K, lda; };

struct StaticOrder {
    int nM, nN, nwg, G, c;
    __host__ __device__ void init(int M, int N, int G_, int c_) { nM = M / BM; nN = N / BM; nwg = nM * nN; G = G_; c = c_; }
    __host__ __device__ bool next(int i, Unit& u) const {
        const long L = (long)i * G + c; if (L >= nwg) return false;
        int wgid = (int)L; { const int q = nwg / NXCD, r = nwg % NXCD, xcd = wgid % NXCD, off = wgid / NXCD; wgid = (xcd < r ? xcd * (q + 1) : r * (q + 1) + (xcd - r) * q) + off; }
        const int nig = WGM * nN, gid = wgid / nig, fm = gid * WGM, gsz = (nM - fm) < WGM ? (nM - fm) : WGM;
        u.pm = fm + ((wgid % nig) % gsz); u.pn = (wgid % nig) / gsz; u.br = 0; return true;
    }
    __device__ __forceinline__ size_t a_off(const Unit&) const { return 0; }
    __device__ __forceinline__ size_t b_off(const Unit&) const { return 0; }
    __device__ __forceinline__ void a_ready(const Unit&) const {}
    __device__ __forceinline__ void done(const Unit&) const {}
};

__device__ __forceinline__ unsigned cvt_pk_bf16(float lo, float hi) { unsigned r; asm volatile("v_cvt_pk_bf16_f32 %0, %1, %2" : "=v"(r) : "v"(lo), "v"(hi)); return r; }
typedef float f32x2 __attribute__((ext_vector_type(2)));
__device__ __forceinline__ f32x2 gelu_pk(f32x2 v) {
    const f32x2 av = __builtin_elementwise_abs(v), d = av * 0.2316418882f + 1.0f;
    f32x2 t; t.x = __builtin_amdgcn_rcpf(d.x); t.y = __builtin_amdgcn_rcpf(d.y);
    f32x2 q = t * 0.5307027145f + (-0.7265760135f); q = q * t + 0.7107068705f; q = q * t + (-0.142248368f); q = q * t + 0.127414796f; q = q * t;
    const f32x2 s = (v * v) * (-0.72134752044f);
    f32x2 e; e.x = __builtin_amdgcn_exp2f(s.x); e.y = __builtin_amdgcn_exp2f(s.y);
    const f32x2 m = v * (q * e), r = v - m;
    f32x2 o; o.x = v.x < 0.f ? m.x : r.x; o.y = v.y < 0.f ? m.y : r.y; return o;
}

template <int ACT  > struct EpiBf16 {
    static constexpr bool PERM = true, AFTER_DRAIN = false; static_assert(ACT == 0 || ACT == 1, "EpiBf16: ACT is 0 (none) or 1 (gelu_pk)");
    bf16_t* O; int ldc; const float* bias; int split_cols; size_t split_stride; float scale0;
    __device__ __forceinline__ void operator()(const f32x4 (&acc)[2][2][4][2], const Unit& u, int wr, int wc, int fr, int fq) const {
        const int row0 = u.pm * BM + wr * 64 + fr; int colt = u.pn * BM; bf16_t* base = O;
        float sc = 1.f; if (split_cols) { const int t = colt / split_cols; base += (size_t)t * split_stride; colt -= t * split_cols; if (t == 0) sc = scale0; }
        const int col0 = colt + wc * 32 + 8 * fq, bcol0 = u.pn * BM + wc * 32 + 8 * fq;
        f32x4 bv[2][2];
#pragma unroll
        for (int bj = 0; bj < 2; ++bj)
#pragma unroll
            for (int n = 0; n < 2; ++n) bv[bj][n] = bias ? *(const f32x4*)(bias + bcol0 + bj * HALF + 4 * n) : (f32x4){0.f, 0.f, 0.f, 0.f};
#pragma unroll
        for (int ai = 0; ai < 2; ++ai)
#pragma unroll
            for (int m = 0; m < 4; ++m) { bf16_t* rowp = base + (size_t)(row0 + ai * HALF + m * 16) * ldc + col0;
#pragma unroll
                for (int bj = 0; bj < 2; ++bj) { f32x4 v0 = acc[ai][bj][m][0] + bv[bj][0], v1 = acc[ai][bj][m][1] + bv[bj][1];
                    if (ACT == 1) { f32x2 a = gelu_pk((f32x2){v0[0], v0[1]}), b = gelu_pk((f32x2){v0[2], v0[3]}), c = gelu_pk((f32x2){v1[0], v1[1]}), d = gelu_pk((f32x2){v1[2], v1[3]});
                        v0 = (f32x4){a.x, a.y, b.x, b.y}; v1 = (f32x4){c.x, c.y, d.x, d.y}; }
                    v0 = v0 * sc; v1 = v1 * sc; u32x4 w; w.x = cvt_pk_bf16(v0[0], v0[1]); w.y = cvt_pk_bf16(v0[2], v0[3]); w.z = cvt_pk_bf16(v1[0], v1[1]); w.w = cvt_pk_bf16(v1[2], v1[3]);
                    *(u32x4*)(rowp + bj * HALF) = w; } }
    }
};
template <class Epi, class Sched, bool ALIGN_EPI = false, bool SP2 = false, bool I8 = false>
__device__ __forceinline__ void gemm_phase(PG8_LAS unsigned char* lds, const Gemm g, const Sched& S, const Epi& E, const int tid) {
    const int wid = __builtin_amdgcn_readfirstlane(tid >> 6), lane = tid & 63, wr = wid >> 2, wc = wid & 3, fr = lane & 15, fq = lane >> 4;
    const int K = g.K, nt = K / BK;
    unsigned voffA[2], voffB[2];
#pragma unroll
    for (int i = 0; i < 2; ++i) { int R, C; stage_rc(tid * 16 + i * 8192, R, C); const int Rb = Epi::PERM ? ((R & ~31) + perm32(R & 31)) : R;
        voffA[i] = (unsigned)(R * g.lda + C) * 2u; voffB[i] = (unsigned)(Rb * K + C) * 2u; }
    const size_t kstep = (size_t)(BK * 2);
    const size_t hstep = (size_t)HALF * K * 2;
    const size_t tstep = 2 * hstep; const size_t hstepA = (size_t)HALF * g.lda * 2, tstepA = 2 * hstepA;
    const unsigned ldsw = (unsigned)wid * 1024u;
    const int aoff = lds_byte(wr * 64 + fr, fq * 8), boff = lds_byte(wc * 32 + fr, fq * 8);
#define PG8_SA(b, h) (((b) * 2 + (h)) * HTB)
#define PG8_SB(b, h) ((4 + (b) * 2 + (h)) * HTB)
#define PG8_STAGE(bufoff, gbase, voff) do { _Pragma("unroll") for (int _i = 0; _i < 2; ++_i) \
        __builtin_amdgcn_global_load_lds((const unsigned*)((const char*)(gbase) + (voff)[_i]), (PG8_LAS unsigned*)(lds + (bufoff) + ldsw + _i * 8192), 16, 0, 0); } while (0)
#define PG8_LDA(dst, b, h) do { _Pragma("unroll") for (int m = 0; m < 4; ++m) _Pragma("unroll") for (int k = 0; k < 2; ++k) dst[m][k] = *(const PG8_LAS bf16x8*)(lds + PG8_SA(b, h) + aoff + m * 2048 + k * 1024); } while (0)
#define PG8_LDB(dst, b, h) do { _Pragma("unroll") for (int n = 0; n < 2; ++n) _Pragma("unroll") for (int k = 0; k < 2; ++k) dst[n][k] = *(const PG8_LAS bf16x8*)(lds + PG8_SB(b, h) + boff + n * 2048 + k * 1024); } while (0)
#define PG8_MMA(ai, bj, At, Bt) do { __builtin_amdgcn_s_setprio(1); \
        if constexpr (I8) {   \
            _Pragma("unroll") for (int k = 0; k < 2; ++k) _Pragma("unroll") for (int m = 0; m < 4; ++m) _Pragma("unroll") for (int n = 0; n < 2; ++n) \
                { if (PG8_I8_ASM) asm volatile("v_mfma_i32_16x16x64_i8 %0, %1, %2, %0" : "+v"(acc[ai][bj][m][n]) : "v"(Bt[n][k]), "v"(At[m][k])); \
                  else acc[ai][bj][m][n] = __builtin_bit_cast(f32x4, __builtin_amdgcn_mfma_i32_16x16x64_i8(__builtin_bit_cast(i32x4, Bt[n][k]), __builtin_bit_cast(i32x4, At[m][k]), __builtin_bit_cast(i32x4, acc[ai][bj][m][n]), 0, 0, 0)); } \
        } else { \
            _Pragma("unroll") for (int m = 0; m < 4; ++m) _Pragma("unroll") for (int n = 0; n < 2; ++n) _Pragma("unroll") for (int k = 0; k < 2; ++k) \
                acc[ai][bj][m][n] = __builtin_amdgcn_mfma_f32_16x16x32_bf16(Bt[n][k], At[m][k], acc[ai][bj][m][n], 0, 0, 0); \
        } __builtin_amdgcn_s_setprio(0); } while (0)
#define PG8_WAIT_V(n) asm volatile("s_waitcnt vmcnt(" #n ")" ::: "memory")
#define PG8_WAIT_L(n) asm volatile("s_waitcnt lgkmcnt(" #n ")" ::: "memory")
#define PG8_BAR __builtin_amdgcn_s_barrier()
#define PG8_SCHED __builtin_amdgcn_sched_barrier(0)
    Unit cur, nxt; int ui = 0;
    if (!S.next(0, cur)) return;
    f32x4 acc[2][2][4][2];
#pragma unroll
    for (int a = 0; a < 2; ++a)
#pragma unroll
        for (int b = 0; b < 2; ++b)
#pragma unroll
            for (int m = 0; m < 4; ++m)
#pragma unroll
                for (int n = 0; n < 2; ++n) acc[a][b][m][n] = (f32x4){0.f, 0.f, 0.f, 0.f};
    bf16x8 At[4][2], B0[2][2], B1[2][2];
    const char* cA = (const char*)g.A + S.a_off(cur) + (size_t)cur.pm * tstepA; const char* cB = (const char*)g.Bt + S.b_off(cur) + (size_t)cur.pn * tstep;
    S.a_ready(cur);
    if constexpr (SP2) {
        PG8_STAGE(PG8_SB(0, 0), cB, voffB); PG8_STAGE(PG8_SB(0, 1), cB + hstep, voffB); PG8_STAGE(PG8_SA(0, 0), cA, voffA); PG8_STAGE(PG8_SA(0, 1), cA + hstepA, voffA);
        if (wr == 1) PG8_BAR;
        PG8_WAIT_V(2); PG8_BAR;
        PG8_STAGE(PG8_SB(1, 0), cB + kstep, voffB); PG8_STAGE(PG8_SA(1, 0), cA + kstep, voffA); PG8_STAGE(PG8_SB(1, 1), cB + hstep + kstep, voffB);
        PG8_WAIT_V(6); PG8_BAR;
    } else {
        PG8_STAGE(PG8_SB(0, 0), cB, voffB); PG8_STAGE(PG8_SA(0, 0), cA, voffA); PG8_STAGE(PG8_SB(0, 1), cB + hstep, voffB); PG8_STAGE(PG8_SA(0, 1), cA + hstepA, voffA);
        if (wr == 1) PG8_BAR;
        PG8_WAIT_V(4); PG8_BAR;
        PG8_STAGE(PG8_SB(1, 0), cB + kstep, voffB); PG8_STAGE(PG8_SA(1, 0), cA + kstep, voffA); PG8_STAGE(PG8_SB(1, 1), cB + hstep + kstep, voffB);
        PG8_WAIT_V(6); PG8_BAR;
    }
    for (;;) {
        const bool has_next = S.next(ui + 1, nxt);
        const char* nA = has_next ? (const char*)g.A + S.a_off(nxt) + (size_t)nxt.pm * tstepA : cA; const char* nB = has_next ? (const char*)g.Bt + S.b_off(nxt) + (size_t)nxt.pn * tstep : cB;
        for (int t = 0; t < nt; t += 2) {
            const bool last = (t == nt - 2);
            const char* a1 = cA + (size_t)(t + 1) * kstep;
            const char* a2 = last ? nA : cA + (size_t)(t + 2) * kstep; const char* b2 = last ? nB : cB + (size_t)(t + 2) * kstep;
            const char* a3 = a2 + kstep; const char* b3 = b2 + kstep;
            if (last && has_next) S.a_ready(nxt);
            if constexpr (SP2) {
            PG8_LDB(B0, 0, 0); PG8_LDB(B1, 0, 1); PG8_SCHED; PG8_LDA(At, 0, 0); PG8_STAGE(PG8_SA(1, 1), a1 + hstepA, voffA);
            PG8_WAIT_V(8); PG8_WAIT_L(0); PG8_BAR; PG8_MMA(0, 0, At, B0); PG8_MMA(0, 1, At, B1); PG8_BAR; PG8_SCHED;
            PG8_LDA(At, 0, 1); PG8_STAGE(PG8_SB(0, 0), b2, voffB); PG8_STAGE(PG8_SB(0, 1), b2 + hstep, voffB); PG8_STAGE(PG8_SA(0, 0), a2, voffA);
            PG8_WAIT_V(8); PG8_WAIT_L(0); PG8_BAR; PG8_MMA(1, 0, At, B0); PG8_MMA(1, 1, At, B1); PG8_BAR; PG8_SCHED;
            PG8_LDB(B0, 1, 0); PG8_LDB(B1, 1, 1); PG8_SCHED; PG8_LDA(At, 1, 0); PG8_STAGE(PG8_SA(0, 1), a2 + hstepA, voffA);
            PG8_WAIT_V(8); PG8_WAIT_L(0); PG8_BAR; PG8_MMA(0, 0, At, B0); PG8_MMA(0, 1, At, B1); PG8_BAR; PG8_SCHED;
            PG8_LDA(At, 1, 1); PG8_STAGE(PG8_SB(1, 0), b3, voffB); PG8_STAGE(PG8_SB(1, 1), b3 + hstep, voffB); PG8_STAGE(PG8_SA(1, 0), a3, voffA);
            PG8_WAIT_V(8); PG8_WAIT_L(0); PG8_BAR; PG8_MMA(1, 0, At, B0); PG8_MMA(1, 1, At, B1); PG8_BAR; PG8_SCHED;
            } else {
            PG8_LDB(B0, 0, 0); PG8_SCHED; PG8_LDA(At, 0, 0); PG8_STAGE(PG8_SA(1, 1), a1 + hstepA, voffA);
            PG8_WAIT_L(8); PG8_BAR; PG8_WAIT_L(0); PG8_MMA(0, 0, At, B0); PG8_BAR; PG8_SCHED;
            PG8_LDB(B1, 0, 1); PG8_STAGE(PG8_SB(0, 0), b2, voffB);
            PG8_BAR; PG8_WAIT_L(0); PG8_MMA(0, 1, At, B1); PG8_BAR;
            PG8_LDA(At, 0, 1); PG8_STAGE(PG8_SA(0, 0), a2, voffA);
            PG8_BAR; PG8_WAIT_L(0); PG8_MMA(1, 0, At, B0); PG8_BAR; PG8_SCHED;
            PG8_STAGE(PG8_SB(0, 1), b2 + hstep, voffB);
            PG8_WAIT_V(6); PG8_BAR; PG8_MMA(1, 1, At, B1); PG8_BAR;
            PG8_LDB(B0, 1, 0); PG8_SCHED; PG8_LDA(At, 1, 0); PG8_STAGE(PG8_SA(0, 1), a2 + hstepA, voffA);
            PG8_WAIT_L(8); PG8_BAR; PG8_WAIT_L(0); PG8_MMA(0, 0, At, B0); PG8_BAR; PG8_SCHED;
            PG8_LDB(B1, 1, 1); PG8_STAGE(PG8_SB(1, 0), b3, voffB);
            PG8_BAR; PG8_WAIT_L(0); PG8_MMA(0, 1, At, B1); PG8_BAR;
            PG8_LDA(At, 1, 1); PG8_STAGE(PG8_SA(1, 0), a3, voffA);
            PG8_BAR; PG8_WAIT_L(0); PG8_MMA(1, 0, At, B0); PG8_BAR; PG8_SCHED;
            PG8_STAGE(PG8_SB(1, 1), b3 + hstep, voffB);
            PG8_WAIT_V(6); PG8_BAR; PG8_MMA(1, 1, At, B1); PG8_BAR;
            }
        }
        if constexpr (I8) { if (PG8_I8_ASM) asm volatile("s_nop 15\n\ts_nop 15" ::: "memory"); }
        if constexpr (ALIGN_EPI) { if (wr == 0) PG8_BAR; }
        if constexpr (!Epi::AFTER_DRAIN) { E(acc, cur, wr, wc, fr, fq); S.done(cur); }
        if (!has_next) break;
        if (!E.keep(cur)) {
#pragma unroll
        for (int a = 0; a < 2; ++a)
#pragma unroll
            for (int b = 0; b < 2; ++b)
#pragma unroll
                for (int m = 0; m < 4; ++m)
#pragma unroll
                    for (int n = 0; n < 2; ++n) acc[a][b][m][n] = (f32x4){0.f, 0.f, 0.f, 0.f};
        }
        cur = nxt; cA = nA; cB = nB; ++ui;
        if constexpr (ALIGN_EPI) { if (wr == 1) PG8_BAR; }
    }
    PG8_WAIT_V(0);
    if constexpr (!ALIGN_EPI) { if (wr == 0) PG8_BAR; }
    PG8_BAR;
    if constexpr (Epi::AFTER_DRAIN) { E.fused(acc, cur, wr, wc, fr, fq, lds, wid, lane); S.done(cur); }
#undef PG8_SA
#undef PG8_SB
#undef PG8_STAGE
#undef PG8_LDA
#undef PG8_LDB
#undef PG8_MMA
#undef PG8_WAIT_V
#undef PG8_WAIT_L
#undef PG8_BAR
#undef PG8_SCHED
}
}

constexpr int BATCH = 4, SEQ = 8192, T = BATCH * SEQ, DM = 1024, DEPTH = 2;
constexpr int IN_COLS = 6022, NP = 3072, N_IN = 6144;
constexpr int N_EXP = 16384;
constexpr int PC_QA = 0, PC_QB = 384, PC_QC = 768, PC_KA = 1152, PC_VA = 1536, PC_KB = 1920, PC_VB = 2304, PC_KC = 2688, PC_VC = 2816, PC_FB = 2944;
constexpr int PC_MERGED = 1152;
constexpr float RMS_EPS = 1e-6f;
constexpr float LOG2E = 1.4426950408889634f;
constexpr float QK_SCALE2 = 0.125f * LOG2E;

constexpr size_t MiB = 1u << 20;
constexpr size_t WS_CTL = 0, CTL_ZERO_BYTES = 65536;
constexpr size_t WS_SSQ1 = 1 * MiB;
constexpr size_t WS_CUMT = 1 * MiB + 256 * 1024;
constexpr size_t WS_LOGF = 2 * MiB;
constexpr size_t WS_KMAX_BASE = 32768;
constexpr size_t WS_ROPE = 3 * MiB;
constexpr size_t WS_W = 12 * MiB, WL_STRIDE = 21 * MiB;
constexpr size_t WL_IN = 0, WL_BR = 12 * MiB, WL_OUT = WL_BR + 2304 * 1024, WL_Q = WL_OUT + 2 * MiB, WL_K12 = WL_Q + 4 * MiB;
static_assert(WL_K12 + 65536 <= WL_STRIDE, "weights");
constexpr size_t WS_HB = 56 * MiB;
constexpr size_t WS_P = 120 * MiB;
constexpr size_t WS_G = 312 * MiB;
constexpr size_t WS_SSQ2P = 504 * MiB;
constexpr size_t WS_END = 506 * MiB;
constexpr size_t WS_Q2 = WS_P;
constexpr size_t WS_IDS = WS_P + 128 * MiB;
constexpr size_t WS_GW = WS_P + 144 * MiB;
constexpr size_t WS_AO = WS_G + 96 * MiB;
constexpr size_t WS_ALSE = WS_G + 96 * MiB + 80 * MiB;
constexpr size_t WS_A8 = WS_G + 128 * MiB;
constexpr size_t WS_SA = WS_G + 160 * MiB;
constexpr size_t WS_SX = WS_G + 161 * MiB;
constexpr size_t WL_QSC = 3 * MiB;
constexpr size_t WL_INSC = 8 * MiB;
constexpr size_t WS_XQ = WS_P + 160 * MiB;
constexpr size_t WS_U16 = WS_G, WS_V16 = WS_G + 32 * MiB;
constexpr size_t WS_U8 = WS_G + 64 * MiB, WS_V8 = WS_G + 80 * MiB, WS_SU = WS_G + 96 * MiB, WS_SV = WS_G + 96 * MiB + 65536;
constexpr int CW_GRP = 10240;
constexpr int CW_ATT = 64;

constexpr int LDS_BYTES = 147456;
constexpr int NPH = 1 + 8 * DEPTH;
#ifndef PH_MASK
#define PH_MASK 511
#endif

#define LAS __attribute__((address_space(3)))
typedef unsigned short bf16_t;
typedef short bf16x8 __attribute__((ext_vector_type(8)));
typedef float f32x4 __attribute__((ext_vector_type(4)));
typedef float f32x16 __attribute__((ext_vector_type(16)));
typedef unsigned u32x4 __attribute__((ext_vector_type(4)));
typedef unsigned u32x2 __attribute__((ext_vector_type(2)));
typedef short v4i16_t __attribute__((ext_vector_type(4)));
typedef float f32x2_t __attribute__((ext_vector_type(2)));
typedef __bf16 bf16x2_t __attribute__((ext_vector_type(2)));

__device__ __forceinline__ unsigned cvtpk(float lo, float hi) { f32x2_t v = {lo, hi}; bf16x2_t b = __builtin_convertvector(v, bf16x2_t); return __builtin_bit_cast(unsigned, b); }
__device__ __forceinline__ float bflo(unsigned u) { return __uint_as_float(u << 16); }
__device__ __forceinline__ float bfhi(unsigned u) { return __uint_as_float(u & 0xffff0000u); }
__device__ __forceinline__ float wave_sum(float v) {
#pragma unroll
    for (int o = 1; o < 64; o <<= 1) v += __shfl_xor(v, o);
    return v;
}
__device__ __forceinline__ float dot2bf(unsigned a, unsigned b, float acc) {
    return fmaf(bfhi(a), bfhi(b), fmaf(bflo(a), bflo(b), acc));
}

__host__ __device__ __forceinline__ int src_col_in(int n) {
    if (n >= 3072) return 2950 + (n - 3072);
    if (n >= 2950) return -1;
    if (n >= 2944) return 2304 + (n - 2944);
    int seg, src; bool rope;
    if (n < 384)       { seg = 0;    src = 0;    rope = true;  }
    else if (n < 768)  { seg = 384;  src = 1152; rope = false; }
    else if (n < 1152) { seg = 768;  src = 2310; rope = true;  }
    else if (n < 1536) { seg = 1152; src = 384;  rope = true;  }
    else if (n < 1920) { seg = 1536; src = 768;  rope = false; }
    else if (n < 2304) { seg = 1920; src = 1536; rope = false; }
    else if (n < 2688) { seg = 2304; src = 1920; rope = false; }
    else if (n < 2816) { seg = 2688; src = 2694; rope = true;  }
    else               { seg = 2816; src = 2822; rope = false; }
    int off = n - seg;
    if (rope) { const int blk = off >> 6, w = off & 63; off = blk * 64 + (w >> 1) + 32 * (w & 1); }
    return src + off;
}

__device__ __forceinline__ float ssq16(const float* __restrict__ pz, int row) {
    const f32x4* q = (const f32x4*)(pz + (size_t)row * 16);
    const f32x4 a = q[0], b = q[1], c = q[2], d = q[3];
    return (((a[0] + a[1]) + (a[2] + a[3])) + ((b[0] + b[1]) + (b[2] + b[3]))) + (((c[0] + c[1]) + (c[2] + c[3])) + ((d[0] + d[1]) + (d[2] + d[3])));
}

template <int MODE>
__device__ __forceinline__ void transpose_item(const float* __restrict__ W, int K, int Nsrc, bf16_t* __restrict__ WT, const float* __restrict__ kscale,
                                               LAS float* scr, int item, int nblk, int lane) {
    const int kb = item / nblk, nb = item % nblk, k0 = 64 * kb, n0 = 32 * nb;
    const int nn = n0 + (lane & 31);
    const int c = (MODE == 1) ? src_col_in(nn) : nn;
#pragma unroll 8
    for (int i = 0; i < 32; ++i) {
        const int kk = 2 * i + (lane >> 5);
        float v = 0.f;
        if (c >= 0) v = W[(size_t)(k0 + kk) * Nsrc + c];
        if (kscale) v *= kscale[k0 + kk];
        if (MODE == 1 && nn >= 3072) v *= -LOG2E;
        scr[kk * 33 + (lane & 31)] = v;
    }
    asm volatile("s_waitcnt lgkmcnt(0)" ::: "memory");
    const int c8 = lane & 7;
#pragma unroll
    for (int j = 0; j < 4; ++j) {
        const int n = (lane >> 3) + 8 * j; const LAS float* s = scr + (8 * c8) * 33 + n;
        u32x4 o; o.x = cvtpk(s[0 * 33], s[1 * 33]); o.y = cvtpk(s[2 * 33], s[3 * 33]); o.z = cvtpk(s[4 * 33], s[5 * 33]); o.w = cvtpk(s[6 * 33], s[7 * 33]);
        *(u32x4*)(WT + (size_t)(n0 + n) * K + k0 + 8 * c8) = o;
    }
    asm volatile("s_waitcnt lgkmcnt(0)" ::: "memory");
}

#ifndef G5_SLICE_SYNC
#define G5_SLICE_SYNC 0
#endif
#ifndef TAIL_FENCE_LIGHT
#define TAIL_FENCE_LIGHT 1
#endif
#ifndef IN_I8_LAYERS
#define IN_I8_LAYERS 3
#endif
#ifndef IN_I8
#define IN_I8 1
#endif
template <int MODE = 1, int NSRC = IN_COLS>
__device__ __forceinline__ void quant_win_item(const float* __restrict__ W, const float* __restrict__ kscale, unsigned char* __restrict__ WT8, float* __restrict__ colscale, int item, int lane, bf16_t* deq = nullptr) {
    const int c = lane & 7, rs = lane >> 3, n = 8 * item + c, src = MODE == 1 ? src_col_in(n) : n, k0 = 128 * rs;
    const float post = (MODE == 1 && n >= 3072) ? -LOG2E : 1.0f;
    const float* wp = W + (size_t)k0 * NSRC + (src >= 0 ? src : 0);
    const float* kp = kscale + k0;
    float am = 0.f;
    for (int j = 0; j < 4; ++j) {
        float x[32];
#pragma unroll
        for (int i = 0; i < 32; ++i) x[i] = wp[(size_t)(32 * j + i) * NSRC];
#pragma unroll
        for (int i = 0; i < 32; ++i) am = fmaxf(am, fabsf(x[i] * kp[32 * j + i]));
    }
    if (src < 0) am = 0.f;
    am = fmaxf(am, __shfl_xor(am, 8)); am = fmaxf(am, __shfl_xor(am, 16)); am = fmaxf(am, __shfl_xor(am, 32));
    const float inv = am > 0.f ? 127.0f / am : 0.f;
    unsigned char* dst = WT8 + (size_t)n * DM + k0;
    for (int j = 0; j < 4; ++j) {
        float x[32];
#pragma unroll
        for (int i = 0; i < 32; ++i) x[i] = wp[(size_t)(32 * j + i) * NSRC];
        unsigned w[8];
#pragma unroll
        for (int q = 0; q < 8; ++q) {
            const int b = 4 * q;
            const int q0 = (int)rintf(x[b] * kp[32 * j + b] * inv), q1 = (int)rintf(x[b + 1] * kp[32 * j + b + 1] * inv), q2 = (int)rintf(x[b + 2] * kp[32 * j + b + 2] * inv), q3 = (int)rintf(x[b + 3] * kp[32 * j + b + 3] * inv);
            w[q] = (unsigned)(q0 & 255) | ((unsigned)(q1 & 255) << 8) | ((unsigned)(q2 & 255) << 16) | ((unsigned)(q3 & 255) << 24);
        }
        *(u32x4*)(dst + 32 * j) = (u32x4){w[0], w[1], w[2], w[3]}; *(u32x4*)(dst + 32 * j + 16) = (u32x4){w[4], w[5], w[6], w[7]};
    }
    if (rs == 0) colscale[n] = (am > 0.f ? am / 127.0f : 0.f) * post;
}
__device__ __forceinline__ void quant_arow_i8(const float (&f)[16], unsigned char* __restrict__ dst_row, float* __restrict__ scale_out, int lane) {
    float am = 0.f;
#pragma unroll
    for (int j = 0; j < 16; ++j) am = fmaxf(am, fabsf(f[j]));
#pragma unroll
    for (int o = 1; o < 64; o <<= 1) am = fmaxf(am, __shfl_xor(am, o));
    const float inv = am > 0.f ? 127.0f / am : 0.f;
    unsigned wq[4];
#pragma unroll
    for (int j = 0; j < 4; ++j) {
        const int q0 = (int)rintf(f[4 * j] * inv), q1 = (int)rintf(f[4 * j + 1] * inv), q2 = (int)rintf(f[4 * j + 2] * inv), q3 = (int)rintf(f[4 * j + 3] * inv);
        wq[j] = (unsigned)(q0 & 255) | ((unsigned)(q1 & 255) << 8) | ((unsigned)(q2 & 255) << 16) | ((unsigned)(q3 & 255) << 24);
    }
    *(u32x2*)(dst_row + 8 * lane) = (u32x2){wq[0], wq[1]}; *(u32x2*)(dst_row + 512 + 8 * lane) = (u32x2){wq[2], wq[3]};
    if (lane == 0) *scale_out = am > 0.f ? am / 127.0f : 0.f;
}

#ifndef EPI_NT
#define EPI_NT 1
#endif
template <bool I8> struct EpiInT {
    static constexpr bool PERM = true, AFTER_DRAIN = false;
    __device__ __forceinline__ bool keep(const pg8::Unit&) const { return false; }
    bf16_t* P; bf16_t* G; const float* ssq; const float* rope; const float* bgate; const float* bfg; float* logf; int nostore; const float* sa; const float* swc;
    __device__ __forceinline__ void operator()(const pg8::f32x4 (&acc)[2][2][4][2], const pg8::Unit& u, int wr, int wc, int fr, int fq) const {
        const int colw = u.pn * 256 + wc * 32 + 8 * fq;
        const int row0 = u.pm * 256 + wr * 64 + fr;
        float rsv[8];
#pragma unroll
        for (int i = 0; i < 8; ++i) rsv[i] = ssq[row0 + (i >> 2) * 128 + (i & 3) * 16];
#pragma unroll
        for (int i = 0; i < 8; ++i) rsv[i] = rsqrtf(rsv[i] * (1.0f / 1024.0f) + RMS_EPS);
        f32x4 swv[2][2];
        if constexpr (I8) {
            float sav[8];
#pragma unroll
            for (int i = 0; i < 8; ++i) sav[i] = sa[row0 + (i >> 2) * 128 + (i & 3) * 16];
#pragma unroll
            for (int i = 0; i < 8; ++i) rsv[i] *= sav[i];
#pragma unroll
            for (int bj = 0; bj < 2; ++bj) { swv[bj][0] = *(const f32x4*)(swc + colw + bj * 128); swv[bj][1] = *(const f32x4*)(swc + colw + bj * 128 + 4); }
        }
#define EPIIN_ACC(ai, bj, m, n, e) (I8 ? (float)__float_as_int(acc[ai][bj][m][n][e]) * swv[bj][n][e] : acc[ai][bj][m][n][e])
        if (colw >= 3072) {
            const int g0 = colw - 3072;
            f32x4 bg[2][2];
#pragma unroll
            for (int bj = 0; bj < 2; ++bj) { bg[bj][0] = *(const f32x4*)(bgate + g0 + bj * 128) * -LOG2E; bg[bj][1] = *(const f32x4*)(bgate + g0 + bj * 128 + 4) * -LOG2E; }
            unsigned char* G8 = (unsigned char*)G;
            const int gbyte = (u.pn - 12) * 256 + wc * 64 + fq * 16;
#pragma unroll
            for (int i = 0; i < 8; ++i) {
                const int ai = i >> 2, m = i & 3;
                const int row = row0 + ai * 128 + m * 16;
                const float rs = rsv[i];
                u32x4 w;
#pragma unroll
                for (int bj = 0; bj < 2; ++bj) {
                    float v[8];
#pragma unroll
                    for (int e = 0; e < 4; ++e) {
                        v[e] = 255.0f * __builtin_amdgcn_rcpf(1.0f + __builtin_amdgcn_exp2f(fmaf(EPIIN_ACC(ai, bj, m, 0, e), rs, bg[bj][0][e])));
                        v[4 + e] = 255.0f * __builtin_amdgcn_rcpf(1.0f + __builtin_amdgcn_exp2f(fmaf(EPIIN_ACC(ai, bj, m, 1, e), rs, bg[bj][1][e])));
                    }
                    unsigned lo = 0, hi_ = 0;
                    lo = __builtin_amdgcn_cvt_pk_u8_f32(v[0], 0, lo); lo = __builtin_amdgcn_cvt_pk_u8_f32(v[1], 1, lo); lo = __builtin_amdgcn_cvt_pk_u8_f32(v[2], 2, lo); lo = __builtin_amdgcn_cvt_pk_u8_f32(v[3], 3, lo);
                    hi_ = __builtin_amdgcn_cvt_pk_u8_f32(v[4], 0, hi_); hi_ = __builtin_amdgcn_cvt_pk_u8_f32(v[5], 1, hi_); hi_ = __builtin_amdgcn_cvt_pk_u8_f32(v[6], 2, hi_); hi_ = __builtin_amdgcn_cvt_pk_u8_f32(v[7], 3, hi_);
                    if (bj == 0) { w.x = lo; w.y = hi_; } else { w.z = lo; w.w = hi_; }
                }
                if (!(nostore && w.x != 0x12345678u)) { if (EPI_NT & 1) __builtin_nontemporal_store(w, (u32x4*)(G8 + (size_t)row * 3072 + gbyte)); else *(u32x4*)(G8 + (size_t)row * 3072 + gbyte) = w; }
            }
        } else {
            bool rp[2];
#pragma unroll
            for (int bj = 0; bj < 2; ++bj) { const int cb = colw + bj * 128; rp[bj] = (cb < 384) || (cb >= 768 && cb < 1536) || (cb >= 2688 && cb < 2816); }
            f32x4 rn[2][2];
#pragma unroll
            for (int bj = 0; bj < 2; ++bj) if (rp[bj]) { const float* r = rope + ((size_t)row0 * 32 + (((colw + bj * 128) & 63) >> 1)) * 2; rn[bj][0] = *(const f32x4*)r; rn[bj][1] = *(const f32x4*)(r + 4); }
#pragma unroll
            for (int i = 0; i < 8; ++i) {
                const int ai = i >> 2, m = i & 3;
                const int row = row0 + ai * 128 + m * 16;
                const float rs = rsv[i];
                f32x4 rc[2][2];
#pragma unroll
                for (int bj = 0; bj < 2; ++bj) { rc[bj][0] = rn[bj][0]; rc[bj][1] = rn[bj][1]; }
                if (i < 7) {
                    const int rown = row0 + ((i + 1) >> 2) * 128 + ((i + 1) & 3) * 16;
#pragma unroll
                    for (int bj = 0; bj < 2; ++bj) if (rp[bj]) { const float* r = rope + ((size_t)rown * 32 + (((colw + bj * 128) & 63) >> 1)) * 2; rn[bj][0] = *(const f32x4*)r; rn[bj][1] = *(const f32x4*)(r + 4); }
                }
#pragma unroll
                for (int bj = 0; bj < 2; ++bj) {
                    const int cb = colw + bj * 128;
                    float v[8];
#pragma unroll
                    for (int e = 0; e < 4; ++e) { v[e] = EPIIN_ACC(ai, bj, m, 0, e) * rs; v[4 + e] = EPIIN_ACC(ai, bj, m, 1, e) * rs; }
                    if (rp[bj]) {
                        const f32x4 r0 = rc[bj][0], r1 = rc[bj][1];
                        float a, b;
                        a = v[0]; b = v[1]; v[0] = a * r0[0] - b * r0[1]; v[1] = b * r0[0] + a * r0[1];
                        a = v[2]; b = v[3]; v[2] = a * r0[2] - b * r0[3]; v[3] = b * r0[2] + a * r0[3];
                        a = v[4]; b = v[5]; v[4] = a * r1[0] - b * r1[1]; v[5] = b * r1[0] + a * r1[1];
                        a = v[6]; b = v[7]; v[6] = a * r1[2] - b * r1[3]; v[7] = b * r1[2] + a * r1[3];
                    }
                    if (cb == PC_FB) {
#pragma unroll
                        for (int e = 0; e < 6; ++e) { const float z = v[e] + bfg[e]; logf[(size_t)row * 8 + e] = fminf(z, 0.f) - log1pf(__expf(-fabsf(z))); }
                    }
                    u32x4 w; w.x = cvtpk(v[0], v[1]); w.y = cvtpk(v[2], v[3]); w.z = cvtpk(v[4], v[5]); w.w = cvtpk(v[6], v[7]);
                    if (!(nostore && w.x != 0x12345678u)) { if (EPI_NT & 1) __builtin_nontemporal_store(w, (u32x4*)(P + (size_t)row * NP + cb)); else *(u32x4*)(P + (size_t)row * NP + cb) = w; }
                }
            }
        }
    }
};
struct EpiDry {
    static constexpr bool PERM = true, AFTER_DRAIN = false;
    __device__ __forceinline__ bool keep(const pg8::Unit&) const { return false; }
    float* sink;
    __device__ __forceinline__ void operator()(const pg8::f32x4 (&acc)[2][2][4][2], const pg8::Unit& u, int wr, int wc, int fr, int fq) const {
        float t = 0.f;
#pragma unroll
        for (int ai = 0; ai < 2; ++ai)
#pragma unroll
            for (int bj = 0; bj < 2; ++bj)
#pragma unroll
                for (int m = 0; m < 4; ++m)
#pragma unroll
                    for (int n = 0; n < 2; ++n) t += acc[ai][bj][m][n][0] + acc[ai][bj][m][n][1] + acc[ai][bj][m][n][2] + acc[ai][bj][m][n][3];
        if (t == 1.2345e33f) sink[u.pm] = t;
    }
};
struct EpiBr {
    static constexpr bool PERM = true, AFTER_DRAIN = false;
    __device__ __forceinline__ bool keep(const pg8::Unit&) const { return false; }
    const bf16_t* Gi; bf16_t* Mg; int first;
    __device__ __forceinline__ void operator()(const pg8::f32x4 (&acc)[2][2][4][2], const pg8::Unit& u, int wr, int wc, int fr, int fq) const {
        const int colw = u.pn * 256 + wc * 32 + 8 * fq;
#pragma unroll
        for (int ai = 0; ai < 2; ++ai)
#pragma unroll
            for (int m = 0; m < 4; ++m) {
                const int row = u.pm * 256 + ai * 128 + wr * 64 + m * 16 + fr;
#pragma unroll
                for (int bj = 0; bj < 2; ++bj) {
                    const int cb = colw + bj * 128;
                    const u32x4 g = *(const u32x4*)(Gi + (size_t)row * NP + cb);
                    float v[8];
                    v[0] = bflo(g.x) * acc[ai][bj][m][0][0]; v[1] = bfhi(g.x) * acc[ai][bj][m][0][1]; v[2] = bflo(g.y) * acc[ai][bj][m][0][2]; v[3] = bfhi(g.y) * acc[ai][bj][m][0][3];
                    v[4] = bflo(g.z) * acc[ai][bj][m][1][0]; v[5] = bfhi(g.z) * acc[ai][bj][m][1][1]; v[6] = bflo(g.w) * acc[ai][bj][m][1][2]; v[7] = bfhi(g.w) * acc[ai][bj][m][1][3];
                    bf16_t* mp = Mg + (size_t)row * NP + cb;
                    if (!first) { const u32x4 o = *(const u32x4*)mp;
                        v[0] += bflo(o.x); v[1] += bfhi(o.x); v[2] += bflo(o.y); v[3] += bfhi(o.y); v[4] += bflo(o.z); v[5] += bfhi(o.z); v[6] += bflo(o.w); v[7] += bfhi(o.w); }
                    u32x4 w; w.x = cvtpk(v[0], v[1]); w.y = cvtpk(v[2], v[3]); w.z = cvtpk(v[4], v[5]); w.w = cvtpk(v[6], v[7]);
                    *(u32x4*)mp = w;
                }
                if (m & 1) asm volatile("" ::: "memory");
            }
    }
};
struct BranchOrder {
    pg8::StaticOrder so;
    __device__ __forceinline__ void init(int M, int N, int G_, int c_) { so.init(M, N, G_, c_); }
    __device__ __forceinline__ bool next(int i, pg8::Unit& u) const { const int ti = i / 3; if (!so.next(ti, u)) return false; u.br = i - 3 * ti; return true; }
    __device__ __forceinline__ size_t a_off(const pg8::Unit& u) const { return (size_t)u.br * 384 * 2; }
    __device__ __forceinline__ size_t b_off(const pg8::Unit& u) const { return (size_t)u.br * DM * 384 * 2; }
    __device__ __forceinline__ void a_ready(const pg8::Unit&) const {}
    __device__ __forceinline__ void done(const pg8::Unit&) const {}
};
#ifndef BR_PRELOAD
#define BR_PRELOAD 0
#endif
struct EpiBrChain {
    static constexpr bool PERM = true, AFTER_DRAIN = false;
    const unsigned char* G8; bf16_t* Mg;
    __device__ __forceinline__ bool keep(const pg8::Unit& u) const { return u.br < 2; }
    __device__ __forceinline__ void operator()(pg8::f32x4 (&acc)[2][2][4][2], const pg8::Unit& u, int wr, int wc, int fr, int fq) const {
        const int colw = u.pn * 256 + wc * 32 + 8 * fq, br = u.br;
        const int row0 = u.pm * 256 + wr * 64 + fr;
        const int gbyte = br * 1024 + u.pn * 256 + wc * 64 + fq * 16;
        constexpr float GEPS = 1e-6f, I255 = 1.0f / 255.0f;
#if BR_PRELOAD
        u32x4 gca[8], gna[8];
#pragma unroll
        for (int i = 0; i < 8; ++i) gca[i] = *(const u32x4*)(G8 + (size_t)(row0 + (i >> 2) * 128 + (i & 3) * 16) * 3072 + gbyte);
        if (br < 2) {
#pragma unroll
            for (int i = 0; i < 8; ++i) gna[i] = *(const u32x4*)(G8 + (size_t)(row0 + (i >> 2) * 128 + (i & 3) * 16) * 3072 + gbyte + 1024);
        }
#else
        u32x4 gcn, gnn;
        gcn = *(const u32x4*)(G8 + (size_t)row0 * 3072 + gbyte);
        if (br < 2) gnn = *(const u32x4*)(G8 + (size_t)row0 * 3072 + gbyte + 1024);
#endif
#pragma unroll
        for (int i = 0; i < 8; ++i) {
            const int ai = i >> 2, m = i & 3;
            const int row = row0 + ai * 128 + m * 16;
#if BR_PRELOAD
            const u32x4 gc = gca[i], gn = gna[i];
#else
            const u32x4 gc = gcn, gn = gnn;
            if (i < 7) {
                const int rown = row0 + ((i + 1) >> 2) * 128 + ((i + 1) & 3) * 16;
                gcn = *(const u32x4*)(G8 + (size_t)rown * 3072 + gbyte);
                if (br < 2) gnn = *(const u32x4*)(G8 + (size_t)rown * 3072 + gbyte + 1024);
            }
#endif
#pragma unroll
            for (int bj = 0; bj < 2; ++bj) {
                const unsigned c0 = bj == 0 ? gc.x : gc.z, c1 = bj == 0 ? gc.y : gc.w;
                float f[8] = {(float)(c0 & 255u), (float)((c0 >> 8) & 255u), (float)((c0 >> 16) & 255u), (float)(c0 >> 24), (float)(c1 & 255u), (float)((c1 >> 8) & 255u), (float)((c1 >> 16) & 255u), (float)(c1 >> 24)};
#pragma unroll
                for (int e = 0; e < 8; ++e) f[e] *= I255;
                if (br > 0) {
#pragma unroll
                    for (int e = 0; e < 8; ++e) f[e] = fmaxf(f[e], GEPS);
                }
                if (br < 2) {
                    const unsigned n0 = bj == 0 ? gn.x : gn.z, n1 = bj == 0 ? gn.y : gn.w;
                    const float d[8] = {(float)(n0 & 255u), (float)((n0 >> 8) & 255u), (float)((n0 >> 16) & 255u), (float)(n0 >> 24), (float)(n1 & 255u), (float)((n1 >> 8) & 255u), (float)((n1 >> 16) & 255u), (float)(n1 >> 24)};
#pragma unroll
                    for (int e = 0; e < 8; ++e) f[e] *= __builtin_amdgcn_rcpf(fmaxf(d[e] * I255, GEPS));
#pragma unroll
                    for (int e = 0; e < 4; ++e) { acc[ai][bj][m][0][e] *= f[e]; acc[ai][bj][m][1][e] *= f[4 + e]; }
                } else {
                    float v[8];
#pragma unroll
                    for (int e = 0; e < 4; ++e) { v[e] = acc[ai][bj][m][0][e] * f[e]; v[4 + e] = acc[ai][bj][m][1][e] * f[4 + e]; }
                    u32x4 w; w.x = cvtpk(v[0], v[1]); w.y = cvtpk(v[2], v[3]); w.z = cvtpk(v[4], v[5]); w.w = cvtpk(v[6], v[7]);
                    if (EPI_NT & 8) __builtin_nontemporal_store(w, (u32x4*)(Mg + (size_t)row * NP + colw + bj * 128)); else *(u32x4*)(Mg + (size_t)row * NP + colw + bj * 128) = w;
                }
            }
        }
    }
};
#ifndef RES16
#define RES16 1
#endif
struct EpiOut {
    static constexpr bool PERM = true, AFTER_DRAIN = false;
    __device__ __forceinline__ bool keep(const pg8::Unit&) const { return false; }
    const float* Hin; float* H; bf16_t* HB; float* ssq;
    __device__ __forceinline__ void operator()(const pg8::f32x4 (&acc)[2][2][4][2], const pg8::Unit& u, int wr, int wc, int fr, int fq) const {
        const int colw = u.pn * 256 + wc * 32 + 8 * fq;
        const int row0 = u.pm * 256 + wr * 64 + fr;
#if RES16
        u32x4 hn[2];
#pragma unroll
        for (int bj = 0; bj < 2; ++bj) hn[bj] = *(const u32x4*)(HB + (size_t)row0 * DM + colw + bj * 128);
#else
        f32x4 hn[2][2];
#pragma unroll
        for (int bj = 0; bj < 2; ++bj) { const float* hi_ = Hin + (size_t)row0 * DM + colw + bj * 128; hn[bj][0] = *(const f32x4*)hi_; hn[bj][1] = *(const f32x4*)(hi_ + 4); }
#endif
#pragma unroll
        for (int i = 0; i < 8; ++i) {
            const int ai = i >> 2, m = i & 3;
            const int row = row0 + ai * 128 + m * 16;
            f32x4 hc[2][2];
#if RES16
#pragma unroll
            for (int bj = 0; bj < 2; ++bj) { hc[bj][0] = (f32x4){bflo(hn[bj].x), bfhi(hn[bj].x), bflo(hn[bj].y), bfhi(hn[bj].y)}; hc[bj][1] = (f32x4){bflo(hn[bj].z), bfhi(hn[bj].z), bflo(hn[bj].w), bfhi(hn[bj].w)}; }
            if (i < 7) {
                const int rown = row0 + ((i + 1) >> 2) * 128 + ((i + 1) & 3) * 16;
#pragma unroll
                for (int bj = 0; bj < 2; ++bj) hn[bj] = *(const u32x4*)(HB + (size_t)rown * DM + colw + bj * 128);
            }
#else
#pragma unroll
            for (int bj = 0; bj < 2; ++bj) { hc[bj][0] = hn[bj][0]; hc[bj][1] = hn[bj][1]; }
            if (i < 7) {
                const int rown = row0 + ((i + 1) >> 2) * 128 + ((i + 1) & 3) * 16;
#pragma unroll
                for (int bj = 0; bj < 2; ++bj) { const float* hi_ = Hin + (size_t)rown * DM + colw + bj * 128; hn[bj][0] = *(const f32x4*)hi_; hn[bj][1] = *(const f32x4*)(hi_ + 4); }
            }
#endif
            float ss = 0.f;
#pragma unroll
            for (int bj = 0; bj < 2; ++bj) {
                const int cb = colw + bj * 128;
                f32x4 h0 = hc[bj][0] + acc[ai][bj][m][0], h1 = hc[bj][1] + acc[ai][bj][m][1];
#if !RES16
                float* hp = H + (size_t)row * DM + cb;
                if (EPI_NT & 2) { __builtin_nontemporal_store(h0, (f32x4*)hp); __builtin_nontemporal_store(h1, (f32x4*)(hp + 4)); } else { *(f32x4*)hp = h0; *(f32x4*)(hp + 4) = h1; }
#endif
                u32x4 w; w.x = cvtpk(h0[0], h0[1]); w.y = cvtpk(h0[2], h0[3]); w.z = cvtpk(h1[0], h1[1]); w.w = cvtpk(h1[2], h1[3]);
                *(u32x4*)(HB + (size_t)row * DM + cb) = w;
                ss += (h0[0] * h0[0] + h0[1] * h0[1]) + (h0[2] * h0[2] + h0[3] * h0[3]) + (h1[0] * h1[0] + h1[1] * h1[1]) + (h1[2] * h1[2] + h1[3] * h1[3]);
            }
            ss += __shfl_xor(ss, 16); ss += __shfl_xor(ss, 32);
            if (fq == 0) ssq[(size_t)row * 16 + u.pn * 4 + wc] = ss;
        }
    }
};
#ifndef Q_I8
#define Q_I8 1
#endif
template <bool I8> struct EpiQT {
    static constexpr bool PERM = true, AFTER_DRAIN = false;
    __device__ __forceinline__ bool keep(const pg8::Unit&) const { return false; }
    bf16_t* Q; const float* ssq; const float* sx; const float* swq;
    __device__ __forceinline__ void operator()(const pg8::f32x4 (&acc)[2][2][4][2], const pg8::Unit& u, int wr, int wc, int fr, int fq) const {
        const int colw = u.pn * 256 + wc * 32 + 8 * fq;
        const int row0 = u.pm * 256 + wr * 64 + fr;
        float rsv[8];
#pragma unroll
        for (int i = 0; i < 4; ++i) rsv[i] = ssq16(ssq, row0 + (i & 3) * 16);
        asm volatile("" ::: "memory");
#pragma unroll
        for (int i = 4; i < 8; ++i) rsv[i] = ssq16(ssq, row0 + 128 + (i & 3) * 16);
#pragma unroll
        for (int i = 0; i < 8; ++i) rsv[i] = rsqrtf(rsv[i] * (1.0f / 1024.0f) + RMS_EPS);
        f32x4 swv[2][2];
        if constexpr (I8) {
#pragma unroll
            for (int i = 0; i < 8; ++i) rsv[i] *= sx[row0 + (i >> 2) * 128 + (i & 3) * 16];
#pragma unroll
            for (int bj = 0; bj < 2; ++bj) { swv[bj][0] = *(const f32x4*)(swq + colw + bj * 128); swv[bj][1] = *(const f32x4*)(swq + colw + bj * 128 + 4); }
        }
#pragma unroll
        for (int i = 0; i < 8; ++i) {
            const int ai = i >> 2, m = i & 3;
            const int row = row0 + ai * 128 + m * 16;
            const float rs = rsv[i];
#pragma unroll
            for (int bj = 0; bj < 2; ++bj) {
                const int cb = colw + bj * 128;
                f32x4 a, b;
                if constexpr (I8) {
#pragma unroll
                    for (int e = 0; e < 4; ++e) { a[e] = (float)__float_as_int(acc[ai][bj][m][0][e]) * swv[bj][0][e] * rs; b[e] = (float)__float_as_int(acc[ai][bj][m][1][e]) * swv[bj][1][e] * rs; }
                } else { a = acc[ai][bj][m][0] * rs; b = acc[ai][bj][m][1] * rs; }
                u32x4 w; w.x = cvtpk(a[0], a[1]); w.y = cvtpk(a[2], a[3]); w.z = cvtpk(b[0], b[1]); w.w = cvtpk(b[2], b[3]);
                if (EPI_NT & 4) __builtin_nontemporal_store(w, (u32x4*)(Q + (size_t)row * 2048 + cb)); else *(u32x4*)(Q + (size_t)row * 2048 + cb) = w;
            }
        }
    }
};

constexpr int VRP = 144;
constexpr int ATT_WAVE_LDS = 32 * VRP + 256 + 8192;
__device__ __forceinline__ int crow(int r, int hi) { return (r & 3) + 8 * (r >> 2) + 4 * hi; }

struct AttState { float m, l; f32x16 o0, o1; };
struct KTile { u32x4 k0, k1, k2, k3; float ck; };
struct VTile { u32x4 v0, v1, v2, v3; };
struct KFrag { bf16x8 k0, k1, k2, k3; };

template <bool BIAS>
__device__ __forceinline__ void k_load(KTile& t, const bf16_t* __restrict__ Pb, int kcol, int r, int ktile, const float* __restrict__ cumT, int lane) {
    const int row = lane >> 3, ch = lane & 7;
    const bf16_t* base = Pb + kcol + 8 * ch;
    int t0 = ktile + row * r, t1 = t0 + 8 * r, t2 = t0 + 16 * r, t3 = t0 + 24 * r;
    t0 = t0 < 0 ? 0 : (t0 > SEQ - 1 ? SEQ - 1 : t0); t1 = t1 < 0 ? 0 : (t1 > SEQ - 1 ? SEQ - 1 : t1);
    t2 = t2 < 0 ? 0 : (t2 > SEQ - 1 ? SEQ - 1 : t2); t3 = t3 < 0 ? 0 : (t3 > SEQ - 1 ? SEQ - 1 : t3);
    t.k0 = *(const u32x4*)(base + (size_t)t0 * NP); t.k1 = *(const u32x4*)(base + (size_t)t1 * NP); t.k2 = *(const u32x4*)(base + (size_t)t2 * NP); t.k3 = *(const u32x4*)(base + (size_t)t3 * NP);
    t.ck = 0.f;
    if (BIAS) { int tk_l = ktile + (lane & 31) * r; tk_l = tk_l < 0 ? 0 : (tk_l > SEQ - 1 ? SEQ - 1 : tk_l); t.ck = cumT[tk_l]; }
}
__device__ __forceinline__ void v_load(VTile& t, const bf16_t* __restrict__ Pb, int vcol, int r, int ktile, int lane) {
    const int row = lane >> 3, ch = lane & 7;
    const bf16_t* base = Pb + vcol + 8 * ch;
    int t0 = ktile + row * r, t1 = t0 + 8 * r, t2 = t0 + 16 * r, t3 = t0 + 24 * r;
    t0 = t0 < 0 ? 0 : (t0 > SEQ - 1 ? SEQ - 1 : t0); t1 = t1 < 0 ? 0 : (t1 > SEQ - 1 ? SEQ - 1 : t1);
    t2 = t2 < 0 ? 0 : (t2 > SEQ - 1 ? SEQ - 1 : t2); t3 = t3 < 0 ? 0 : (t3 > SEQ - 1 ? SEQ - 1 : t3);
    t.v0 = *(const u32x4*)(base + (size_t)t0 * NP); t.v1 = *(const u32x4*)(base + (size_t)t1 * NP); t.v2 = *(const u32x4*)(base + (size_t)t2 * NP); t.v3 = *(const u32x4*)(base + (size_t)t3 * NP);
}
__device__ __forceinline__ void k_stage(const KTile& t, LAS unsigned char* vl, KFrag& f, int lane) {
    asm volatile("" ::: "memory");
    {
        LAS unsigned char* wp = vl + (lane >> 3) * VRP + (lane & 7) * 16;
        *(LAS u32x4*)(wp) = t.k0; *(LAS u32x4*)(wp + 8 * VRP) = t.k1; *(LAS u32x4*)(wp + 16 * VRP) = t.k2; *(LAS u32x4*)(wp + 24 * VRP) = t.k3;
    }
    asm volatile("s_waitcnt lgkmcnt(0)" ::: "memory");
    const LAS unsigned char* rp = vl + (lane & 31) * VRP + (lane >> 5) * 16;
    f.k0 = *(const LAS bf16x8*)(rp); f.k1 = *(const LAS bf16x8*)(rp + 32); f.k2 = *(const LAS bf16x8*)(rp + 64); f.k3 = *(const LAS bf16x8*)(rp + 96);
    asm volatile("s_waitcnt lgkmcnt(0)" ::: "memory");
}
template <bool BIAS>
__device__ __forceinline__ void v_stage(const VTile& t, float ck, LAS unsigned char* vl, bf16x8 (&vf)[2][2], int lane) {
    const int hi = lane >> 5, l31 = lane & 31, q4 = (lane & 15) >> 2, p4 = lane & 3, g1 = (lane >> 4) & 1;
    asm volatile("" ::: "memory");
    {
        LAS unsigned char* wp = vl + (lane >> 3) * VRP + (lane & 7) * 16;
        *(LAS u32x4*)(wp) = t.v0; *(LAS u32x4*)(wp + 8 * VRP) = t.v1; *(LAS u32x4*)(wp + 16 * VRP) = t.v2; *(LAS u32x4*)(wp + 24 * VRP) = t.v3;
        if (BIAS) { if (hi == 0) ((LAS float*)(vl + 32 * VRP))[l31] = ck; }
    }
    asm volatile("s_waitcnt lgkmcnt(0)" ::: "memory");
    const LAS unsigned char* vb = vl + (4 * hi + q4) * VRP + (16 * g1 + 4 * p4) * 2;
#pragma unroll
    for (int dblk = 0; dblk < 2; ++dblk)
#pragma unroll
        for (int s2 = 0; s2 < 2; ++s2) {
            const LAS unsigned char* a = vb + (16 * s2) * VRP + dblk * 64;
            const v4i16_t lo = __builtin_amdgcn_ds_read_tr16_b64_v4i16((LAS v4i16_t*)a);
            const v4i16_t hh = __builtin_amdgcn_ds_read_tr16_b64_v4i16((LAS v4i16_t*)(a + 8 * VRP));
            vf[dblk][s2] = (bf16x8){lo[0], lo[1], lo[2], lo[3], hh[0], hh[1], hh[2], hh[3]};
        }
}
__device__ __forceinline__ float max_halves(float v) {
    const auto rr = __builtin_amdgcn_permlane32_swap(__float_as_uint(v), __float_as_uint(v), false, false);
    return fmaxf(__uint_as_float(rr[0]), __uint_as_float(rr[1]));
}
__device__ __forceinline__ void softmax_pv(f32x16& s, float scale, AttState& st, const bf16x8 (&vf)[2][2]) {
    float mx = s[0];
#pragma unroll
    for (int i = 1; i < 16; ++i) mx = fmaxf(mx, s[i]);
    mx = max_halves(mx) * scale;
    float m_use = (st.m == -INFINITY) ? 0.f : st.m;
    if (!__all(mx <= st.m + 8.0f)) {
        const float m_new = fmaxf(st.m, mx);
        m_use = (m_new == -INFINITY) ? 0.f : m_new;
        const float alpha = __builtin_amdgcn_exp2f(st.m - m_use);
        st.l *= alpha; st.m = m_new;
#pragma unroll
        for (int i = 0; i < 16; ++i) { st.o0[i] *= alpha; st.o1[i] *= alpha; }
    }
    float rsum = 0.f;
#pragma unroll
    for (int i = 0; i < 16; ++i) { s[i] = __builtin_amdgcn_exp2f(fmaf(s[i], scale, -m_use)); rsum += s[i]; }
    st.l += rsum;
    u32x4 pw0, pw1;
    pw0.x = cvtpk(s[0], s[1]); pw0.y = cvtpk(s[2], s[3]); pw0.z = cvtpk(s[4], s[5]); pw0.w = cvtpk(s[6], s[7]);
    pw1.x = cvtpk(s[8], s[9]); pw1.y = cvtpk(s[10], s[11]); pw1.z = cvtpk(s[12], s[13]); pw1.w = cvtpk(s[14], s[15]);
    const bf16x8 pb0 = __builtin_bit_cast(bf16x8, pw0), pb1 = __builtin_bit_cast(bf16x8, pw1);
    st.o0 = __builtin_amdgcn_mfma_f32_32x32x16_bf16(vf[0][0], pb0, st.o0, 0, 0, 0);
    st.o0 = __builtin_amdgcn_mfma_f32_32x32x16_bf16(vf[0][1], pb1, st.o0, 0, 0, 0);
    st.o1 = __builtin_amdgcn_mfma_f32_32x32x16_bf16(vf[1][0], pb0, st.o1, 0, 0, 0);
    st.o1 = __builtin_amdgcn_mfma_f32_32x32x16_bf16(vf[1][1], pb1, st.o1, 0, 0, 0);
}
__device__ __forceinline__ f32x16 qk_tile(const KFrag& t, const bf16x8 (&qf)[4]) {
    f32x16 s;
#pragma unroll
    for (int i = 0; i < 16; ++i) s[i] = 0.f;
    s = __builtin_amdgcn_mfma_f32_32x32x16_bf16(t.k0, qf[0], s, 0, 0, 0);
    s = __builtin_amdgcn_mfma_f32_32x32x16_bf16(t.k1, qf[1], s, 0, 0, 0);
    s = __builtin_amdgcn_mfma_f32_32x32x16_bf16(t.k2, qf[2], s, 0, 0, 0);
    s = __builtin_amdgcn_mfma_f32_32x32x16_bf16(t.k3, qf[3], s, 0, 0, 0);
    return s;
}

__device__ __forceinline__ f32x16 qk_tile_lds(const KFrag& t, const LAS unsigned char* qb) {
    f32x16 s;
#pragma unroll
    for (int i = 0; i < 16; ++i) s[i] = 0.f;
    s = __builtin_amdgcn_mfma_f32_32x32x16_bf16(t.k0, *(const LAS bf16x8*)(qb), s, 0, 0, 0);
    s = __builtin_amdgcn_mfma_f32_32x32x16_bf16(t.k1, *(const LAS bf16x8*)(qb + 1024), s, 0, 0, 0);
    s = __builtin_amdgcn_mfma_f32_32x32x16_bf16(t.k2, *(const LAS bf16x8*)(qb + 2048), s, 0, 0, 0);
    s = __builtin_amdgcn_mfma_f32_32x32x16_bf16(t.k3, *(const LAS bf16x8*)(qb + 3072), s, 0, 0, 0);
    return s;
}

template <int r>
__device__ __forceinline__ void attn_segment(const bf16_t* __restrict__ Pb, int kcol, int vcol, int maxd_tok, int kt0, int ntiles, int tq,
                                             const bf16x8 (&qf)[4], AttState& st, LAS unsigned char* vl, int lane) {
    const int hi = lane >> 5;
    const int lim = maxd_tok < tq ? maxd_tok : tq;
    KTile nx; VTile vnx;
    k_load<false>(nx, Pb, kcol, r, kt0, nullptr, lane); v_load(vnx, Pb, vcol, r, kt0, lane);
    for (int j = 0; j < ntiles; ++j) {
        const int ktile = kt0 + j * 32 * r;
        const VTile vt = vnx;
        const KTile cur = nx;
        if (j + 1 < ntiles) { k_load<false>(nx, Pb, kcol, r, ktile + 32 * r, nullptr, lane); v_load(vnx, Pb, vcol, r, ktile + 32 * r, lane); }
        KFrag kf; k_stage(cur, vl, kf, lane);
        f32x16 s = qk_tile(kf, qf);
        bf16x8 vf[2][2];
        v_stage<false>(vt, 0.f, vl, vf, lane);
        const int dbase = tq - ktile - 4 * hi * r;
#pragma unroll
        for (int i = 0; i < 16; ++i) {
            const int d = dbase - crow(i, 0) * r;
            s[i] = ((unsigned)d <= (unsigned)lim) ? s[i] : -INFINITY;
        }
        softmax_pv(s, QK_SCALE2, st, vf);
        asm volatile("s_waitcnt lgkmcnt(0)" ::: "memory");
    }
}

__device__ __forceinline__ void attn_load_q(const bf16_t* __restrict__ Pb, int tq, int qcol, int hi, bf16x8 (&qf)[4]) {
    const bf16_t* qp = Pb + (size_t)tq * NP + qcol + 8 * hi;
    qf[0] = *(const bf16x8*)(qp); qf[1] = *(const bf16x8*)(qp + 16); qf[2] = *(const bf16x8*)(qp + 32); qf[3] = *(const bf16x8*)(qp + 48);
}
__device__ __forceinline__ void attn_store_o(bf16_t* __restrict__ Pb, int tq, int ocol, int hi, AttState& st, int dry) {
    float l = st.l + __shfl_xor(st.l, 32);
    if (dry && l >= 0.f) return;
    const float inv = 1.0f / l;
    bf16_t* op = Pb + (size_t)tq * NP + ocol + 4 * hi;
#pragma unroll
    for (int g = 0; g < 4; ++g) {
        u32x2 w0, w1;
        w0.x = cvtpk(st.o0[4 * g] * inv, st.o0[4 * g + 1] * inv); w0.y = cvtpk(st.o0[4 * g + 2] * inv, st.o0[4 * g + 3] * inv);
        w1.x = cvtpk(st.o1[4 * g] * inv, st.o1[4 * g + 1] * inv); w1.y = cvtpk(st.o1[4 * g + 2] * inv, st.o1[4 * g + 3] * inv);
        *(u32x2*)(op + 8 * g) = w0; *(u32x2*)(op + 32 + 8 * g) = w1;
    }
}
__device__ __forceinline__ void att_init(AttState& st) {
#pragma unroll
    for (int i = 0; i < 16; ++i) { st.o0[i] = 0.f; st.o1[i] = 0.f; }
    st.m = -INFINITY; st.l = 0.f;
}

__device__ __forceinline__ void attn_fox_pair(bf16_t* __restrict__ Pb, const float* __restrict__ cumT, float kmax2, int h, int qp, LAS unsigned char* vl, int lane, int dry) {
    const int hi = lane >> 5, l31 = lane & 31;
    const int kcol = PC_KB + 64 * h, vcol = PC_VB + 64 * h, qcol = PC_QB + 64 * h;
    const LAS float* ckl = (const LAS float*)(vl + 32 * VRP);
    AttState st0, st1; att_init(st0); att_init(st1);
    const int tq0 = 64 * qp + l31, tq1 = tq0 + 32;
    LAS unsigned char* qb0 = vl + 32 * VRP + 256 + hi * 512 + l31 * 16;
    LAS unsigned char* qb1 = qb0 + 4096;
    {
        bf16x8 qf[4];
        attn_load_q(Pb, tq0, qcol, hi, qf);
#pragma unroll
        for (int s_ = 0; s_ < 4; ++s_) *(LAS bf16x8*)(qb0 + 1024 * s_) = qf[s_];
        attn_load_q(Pb, tq1, qcol, hi, qf);
#pragma unroll
        for (int s_ = 0; s_ < 4; ++s_) *(LAS bf16x8*)(qb1 + 1024 * s_) = qf[s_];
        asm volatile("s_waitcnt lgkmcnt(0)" ::: "memory");
    }
    const float cq0 = cumT[tq0], cq1 = cumT[tq1];
    float bound0, bound1;
    {
        float n0 = 0.f, n1 = 0.f;
#pragma unroll
        for (int s_ = 0; s_ < 4; ++s_) {
            const bf16x8 a = *(const LAS bf16x8*)(qb0 + 1024 * s_), b = *(const LAS bf16x8*)(qb1 + 1024 * s_);
#pragma unroll
            for (int e = 0; e < 8; ++e) { const float fa = bflo((unsigned)(unsigned short)a[e]), fb = bflo((unsigned)(unsigned short)b[e]); n0 = fmaf(fa, fa, n0); n1 = fmaf(fb, fb, n1); }
        }
        n0 += __shfl_xor(n0, 32); n1 += __shfl_xor(n1, 32);
        bound0 = sqrtf(n0 * kmax2) * QK_SCALE2 * 1.01f + 0.5f; bound1 = sqrtf(n1 * kmax2) * QK_SCALE2 * 1.01f + 0.5f;
    }
    constexpr float FOX_SKIP = 48.0f;
    const int ntiles = 2 * qp + 2;
    KTile nx;
    k_load<true>(nx, Pb, kcol, 1, 32 * (ntiles - 1), cumT, lane);
    for (int j = ntiles - 1; j >= 0; --j) {
        VTile vt; v_load(vt, Pb, vcol, 1, 32 * j, lane);
        const KTile cur = nx;
        if (j > 0) k_load<true>(nx, Pb, kcol, 1, 32 * (j - 1), cumT, lane);
        KFrag kf; k_stage(cur, vl, kf, lane);
        f32x16 s1 = qk_tile_lds(kf, qb1);
        f32x16 s0;
        const bool on0 = (j <= 2 * qp);
        if (on0) s0 = qk_tile_lds(kf, qb0);
        bf16x8 vf[2][2];
        v_stage<true>(vt, cur.ck, vl, vf, lane);
        if (on0) {
            const bool diag = (j == 2 * qp);
#pragma unroll
            for (int g = 0; g < 4; ++g) { const f32x4 c4 = *(const LAS f32x4*)(ckl + 8 * g + 4 * hi);
#pragma unroll
                for (int e = 0; e < 4; ++e) { const int i = 4 * g + e; const float v = fmaf(s0[i], QK_SCALE2, cq0 - c4[e]); s0[i] = (diag && crow(i, hi) > l31) ? -INFINITY : v; } }
            softmax_pv(s0, 1.0f, st0, vf);
        }
        {
            const bool diag = (j == 2 * qp + 1);
#pragma unroll
            for (int g = 0; g < 4; ++g) { const f32x4 c4 = *(const LAS f32x4*)(ckl + 8 * g + 4 * hi);
#pragma unroll
                for (int e = 0; e < 4; ++e) { const int i = 4 * g + e; const float v = fmaf(s1[i], QK_SCALE2, cq1 - c4[e]); s1[i] = (diag && crow(i, hi) > l31) ? -INFINITY : v; } }
            softmax_pv(s1, 1.0f, st1, vf);
        }
        asm volatile("s_waitcnt lgkmcnt(0)" ::: "memory");
        if (j > 0) {
            const float ckn = __int_as_float(__builtin_amdgcn_readlane(__float_as_int(nx.ck), 31));
            const bool dead0 = (cq0 - ckn + bound0) < (st0.m - FOX_SKIP), dead1 = (cq1 - ckn + bound1) < (st1.m - FOX_SKIP);
            if (__all(dead0 && dead1)) break;
        }
    }
    attn_store_o(Pb, tq0, qcol, hi, st0, dry);
    attn_store_o(Pb, tq1, qcol, hi, st1, dry);
}

#ifndef MIXA_3PASS
#define MIXA_3PASS 0
#endif
#ifndef MIXA_ACQ
#define MIXA_ACQ 1
#endif
#ifndef MIXA_REL
#define MIXA_REL 0
#endif
typedef unsigned long long u64_t;
#ifndef MIXA_ONLY
#define MIXA_ONLY -1
#endif
#ifndef MIXA_PLAIN
#define MIXA_PLAIN 0
#endif
__device__ __forceinline__ void st_wt8(void* p, u32x2 v) { if (MIXA_PLAIN) *(u32x2*)p = v; else __hip_atomic_store((u64_t*)p, ((u64_t)v.y << 32) | v.x, __ATOMIC_RELAXED, __HIP_MEMORY_SCOPE_AGENT); }
__device__ __forceinline__ u32x2 ld_wt8(const void* p) { if (MIXA_PLAIN) return *(const u32x2*)p; const u64_t x = __hip_atomic_load((const u64_t*)p, __ATOMIC_RELAXED, __HIP_MEMORY_SCOPE_AGENT); return (u32x2){(unsigned)x, (unsigned)(x >> 32)}; }
__device__ __forceinline__ void st_wt4(float* p, float v) { if (MIXA_PLAIN) *p = v; else __hip_atomic_store(p, v, __ATOMIC_RELAXED, __HIP_MEMORY_SCOPE_AGENT); }
__device__ __forceinline__ float ld_wt4(const float* p) { if (MIXA_PLAIN) return *p; return __hip_atomic_load(p, __ATOMIC_RELAXED, __HIP_MEMORY_SCOPE_AGENT); }
__device__ __forceinline__ void mixa_store_partial(bf16_t* __restrict__ AO, float* __restrict__ ALSE, int pat, size_t tok  , int bh, int t, int h, int hi, AttState& st) {
    const float l = st.l + __shfl_xor(st.l, 32);
    const float inv = 1.0f / l;
    bf16_t* op = AO + ((size_t)pat * T + tok) * 384 + h * 64 + 4 * hi;
#pragma unroll
    for (int g = 0; g < 4; ++g) {
        u32x2 w0, w1;
        w0.x = cvtpk(st.o0[4 * g] * inv, st.o0[4 * g + 1] * inv); w0.y = cvtpk(st.o0[4 * g + 2] * inv, st.o0[4 * g + 3] * inv);
        w1.x = cvtpk(st.o1[4 * g] * inv, st.o1[4 * g + 1] * inv); w1.y = cvtpk(st.o1[4 * g + 2] * inv, st.o1[4 * g + 3] * inv);
        st_wt8(op + 8 * g, w0); st_wt8(op + 32 + 8 * g, w1);
    }
    if (hi == 0) st_wt4(ALSE + ((size_t)pat * (BATCH * 6) + bh) * SEQ + t, st.m + __builtin_amdgcn_logf(l));
}
__device__ __forceinline__ void mixa_combine(bf16_t* __restrict__ Pb, const bf16_t* __restrict__ AO, const float* __restrict__ ALSE, size_t tok, int bh, int t, int h, int hi) {
    float ls[3], mx;
#pragma unroll
    for (int p = 0; p < 3; ++p) ls[p] = ld_wt4(ALSE + ((size_t)p * (BATCH * 6) + bh) * SEQ + t);
    mx = fmaxf(ls[0], fmaxf(ls[1], ls[2]));
    float w[3], ws = 0.f;
#pragma unroll
    for (int p = 0; p < 3; ++p) { w[p] = __builtin_amdgcn_exp2f(ls[p] - mx); if (MIXA_ONLY >= 0) w[p] = (p == MIXA_ONLY) ? 1.f : 0.f; ws += w[p]; }
    const float iw = 1.0f / ws;
    float acc[32];
#pragma unroll
    for (int i = 0; i < 32; ++i) acc[i] = 0.f;
#pragma unroll
    for (int p = 0; p < 3; ++p) {
        const bf16_t* ip = AO + ((size_t)p * T + tok) * 384 + h * 64 + 32 * hi;
        const float wp = w[p] * iw;
#pragma unroll
        for (int c = 0; c < 8; ++c) { const u32x2 v = ld_wt8(ip + 4 * c);
            acc[4 * c] = fmaf(wp, bflo(v.x), acc[4 * c]); acc[4 * c + 1] = fmaf(wp, bfhi(v.x), acc[4 * c + 1]); acc[4 * c + 2] = fmaf(wp, bflo(v.y), acc[4 * c + 2]); acc[4 * c + 3] = fmaf(wp, bfhi(v.y), acc[4 * c + 3]); }
    }
    bf16_t* op = Pb + (size_t)t * NP + PC_QA + 64 * h + 32 * hi;
#pragma unroll
    for (int c = 0; c < 4; ++c) { u32x4 w4; w4.x = cvtpk(acc[8 * c], acc[8 * c + 1]); w4.y = cvtpk(acc[8 * c + 2], acc[8 * c + 3]); w4.z = cvtpk(acc[8 * c + 4], acc[8 * c + 5]); w4.w = cvtpk(acc[8 * c + 6], acc[8 * c + 7]);
        *(u32x4*)(op + 8 * c) = w4; }
}

__device__ __forceinline__ void attention_phase(unsigned char* __restrict__ ws, const float* __restrict__ sinks, int ctr_word, int grp_word, int kmax_word, LAS unsigned char* lds, int wave, int lane, int dry) {
#define ATT_P ((bf16_t*)(ws + WS_P))
#define ATT_CUMT ((const float*)(ws + WS_CUMT))
#define ATT_AO ((bf16_t*)(ws + WS_AO))
#define ATT_ALSE ((float*)(ws + WS_ALSE))
    LAS unsigned char* vl = lds + wave * ATT_WAVE_LDS;
    const int hi = lane >> 5, l31 = lane & 31;
    constexpr int NUB = 3072, NU = 6144;
    constexpr int NUA = MIXA_3PASS ? 3 * NU : NU;
    constexpr int NUTOT = NUB + NUA + NU + (MIXA_3PASS == 1 ? NU : 0) ;
    int pend = -1;
    for (;;) {
        unsigned u = 0;
        if (lane == 0) {
            if (MIXA_3PASS && pend >= 0) __hip_atomic_fetch_add((unsigned*)ws + grp_word + pend, 1u, __ATOMIC_RELAXED, __HIP_MEMORY_SCOPE_AGENT);
            u = atomicAdd((unsigned*)ws + ctr_word, 1u);
        }
        pend = -1;
        u = __builtin_amdgcn_readfirstlane(u);
        if (u >= (unsigned)NUTOT) break;
        if (u < (unsigned)NUB) {
            const int qp = 127 - (int)(u / 24), bh = (int)(u % 24), b = bh / 6, h = bh % 6;
            attn_fox_pair(ATT_P + (size_t)b * SEQ * NP, ATT_CUMT + (size_t)bh * SEQ, ((const float*)ws)[kmax_word + bh], h, qp, vl, lane, dry);
        } else if (MIXA_3PASS && u < (unsigned)(NUB + NUA)) {
            const int v = (int)u - NUB;
            const int pat = v / NU, w_ = v - pat * NU, bh = w_ >> 8, x_ = w_ & 255, b = bh / 6, h = bh % 6;
            const int r = pat == 0 ? 1 : (pat == 1 ? 4 : 16);
            const int rho = pat == 0 ? 0 : (pat == 1 ? (x_ & 3) : (x_ & 15)), cb = pat == 0 ? x_ : (pat == 1 ? (x_ >> 2) : (x_ >> 4));
            bf16_t* Pb = ATT_P + (size_t)b * SEQ * NP;
            const int tq0 = rho + r * 32 * cb, tq = tq0 + r * l31;
            AttState st; att_init(st); bf16x8 qf[4];
            attn_load_q(Pb, tq, PC_QA + 64 * h, hi, qf);
            if (pat == 0)      attn_segment<1>(Pb, PC_KA + 64 * h, PC_VA + 64 * h, 128, tq0 - 128, 5, tq, qf, st, vl, lane);
            else if (pat == 1) attn_segment<4>(Pb, PC_KA + 64 * h, PC_VA + 64 * h, 512, tq0 - 512, 5, tq, qf, st, vl, lane);
            else               attn_segment<16>(Pb, PC_KA + 64 * h, PC_VA + 64 * h, 2048, tq0 - 2048, 5, tq, qf, st, vl, lane);
            if (!dry) {
                mixa_store_partial(ATT_AO, ATT_ALSE, pat, (size_t)b * SEQ + tq, bh, tq, h, hi, st);
                asm volatile("s_waitcnt vmcnt(0)" ::: "memory");
                if (MIXA_REL) { __builtin_amdgcn_fence(__ATOMIC_RELEASE, "agent"); asm volatile("s_waitcnt vmcnt(0)" ::: "memory"); }
                pend = bh * 16 + (tq0 >> 9);
            }
        } else if (MIXA_3PASS == 1 && u >= (unsigned)(NUB + NUA + NU)) {
            const int v = (int)u - (NUB + NUA + NU);
            const int qt = v & 255, bh = v >> 8, b = bh / 6, h = bh % 6;
            if (!dry) {
                unsigned* cw = (unsigned*)ws + grp_word + bh * 16 + (qt >> 4);
                unsigned spins = 0;
                while ((unsigned)__builtin_amdgcn_readfirstlane((int)__hip_atomic_load(cw, __ATOMIC_RELAXED, __HIP_MEMORY_SCOPE_AGENT)) < 48u) {
                    __builtin_amdgcn_s_sleep(8);
                    if (++spins > (1u << 22)) break;
                }
                if (MIXA_ACQ) { __builtin_amdgcn_fence(__ATOMIC_ACQUIRE, "agent"); asm volatile("s_waitcnt vmcnt(0)" ::: "memory"); }
                mixa_combine(ATT_P + (size_t)b * SEQ * NP, ATT_AO, ATT_ALSE, (size_t)b * SEQ + qt * 32 + l31, bh, qt * 32 + l31, h, hi);
            }
        } else if (!MIXA_3PASS && u < (unsigned)(NUB + NU)) {
            const int v = (int)u - NUB;
            const int cb = v & 15, rho = (v >> 4) & 15, bh = v >> 8, b = bh / 6, h = bh % 6;
            bf16_t* Pb = ATT_P + (size_t)b * SEQ * NP;
            const int tq0 = rho + 512 * cb, tq = tq0 + 16 * l31;
            AttState st; att_init(st); bf16x8 qf[4];
            attn_load_q(Pb, tq, PC_QA + 64 * h, hi, qf);
            attn_segment<16>(Pb, PC_KA + 64 * h, PC_VA + 64 * h, 2048, tq0 - 2048, 5, tq, qf, st, vl, lane);
            attn_segment<4>(Pb, PC_KA + 64 * h, PC_VA + 64 * h, 512, tq0 - 512, 8, tq, qf, st, vl, lane);
            attn_segment<1>(Pb, PC_KA + 64 * h, PC_VA + 64 * h, 128, tq0 - 128, 20, tq, qf, st, vl, lane);
            attn_store_o(Pb, tq, PC_QA + 64 * h, hi, st, dry);
        } else {
            const int v = (int)u - NUB - NUA;
            const int qt = v & 255, bh = v >> 8, b = bh / 6, h = bh % 6, hk = h / 3;
            bf16_t* Pb = ATT_P + (size_t)b * SEQ * NP;
            const int tq = qt * 32 + l31;
            AttState st; att_init(st); bf16x8 qf[4];
            attn_load_q(Pb, tq, PC_QC + 64 * h, hi, qf);
            st.m = sinks[h] * LOG2E; st.l = (hi == 0) ? 1.f : 0.f;
            attn_segment<1>(Pb, PC_KC + 64 * hk, PC_VC + 64 * hk, 127, qt * 32 - 128, 5, tq, qf, st, vl, lane);
            attn_store_o(Pb, tq, PC_QC + 64 * h, hi, st, dry);
        }
    }
}

#ifndef ATT_XCD
#define ATT_XCD 0
#endif
__device__ __forceinline__ void attention_phase_x(unsigned char* __restrict__ ws, const float* __restrict__ sinks, int ctr_word  , int kmax_word, LAS unsigned char* lds, int wave, int lane, int xcc) {
    LAS unsigned char* vl = lds + wave * ATT_WAVE_LDS;
    const int hi = lane >> 5, l31 = lane & 31;
    constexpr int QB = 3 * 128, QA = 3 * 256, QC = 3 * 256, QN = QB + QA + QC;
    int q = xcc & 7;
    int tried = 0;
    for (;;) {
        unsigned j = 0;
        if (lane == 0) j = atomicAdd((unsigned*)ws + ctr_word + q, 1u);
        j = __builtin_amdgcn_readfirstlane(j);
        if (j >= (unsigned)QN) {
            tried |= 1 << q;
            if (tried == 0xff) break;
            const unsigned cv = ((volatile const unsigned*)ws)[ctr_word + (lane & 7)];
            int nq = -1;
#pragma unroll
            for (int k = 1; k < 8; ++k) { const int qq = (q + k) & 7; const unsigned c_ = (unsigned)__builtin_amdgcn_readlane((int)cv, qq); if (nq < 0 && !((tried >> qq) & 1)) { if (c_ < (unsigned)QN) nq = qq; else tried |= 1 << qq; } }
            if (nq < 0) break;
            q = nq; continue;
        }
        if (j < (unsigned)QB) {
            const int bh = q + 8 * (int)(j >> 7), qp = 127 - (int)(j & 127), b = bh / 6, h = bh % 6;
            attn_fox_pair(ATT_P + (size_t)b * SEQ * NP, ATT_CUMT + (size_t)bh * SEQ, ((const float*)ws)[kmax_word + bh], h, qp, vl, lane, 0);
        } else if (j < (unsigned)(QB + QA)) {
            const int jj = (int)j - QB, bh = q + 8 * (jj >> 8), v = jj & 255, b = bh / 6, h = bh % 6;
            const int cb = v & 15, rho = v >> 4;
            bf16_t* Pb = ATT_P + (size_t)b * SEQ * NP;
            const int tq0 = rho + 512 * cb, tq = tq0 + 16 * l31;
            AttState st; att_init(st); bf16x8 qf[4];
            attn_load_q(Pb, tq, PC_QA + 64 * h, hi, qf);
            attn_segment<16>(Pb, PC_KA + 64 * h, PC_VA + 64 * h, 2048, tq0 - 2048, 5, tq, qf, st, vl, lane);
            attn_segment<4>(Pb, PC_KA + 64 * h, PC_VA + 64 * h, 512, tq0 - 512, 8, tq, qf, st, vl, lane);
            attn_segment<1>(Pb, PC_KA + 64 * h, PC_VA + 64 * h, 128, tq0 - 128, 20, tq, qf, st, vl, lane);
            attn_store_o(Pb, tq, PC_QA + 64 * h, hi, st, 0);
        } else {
            const int jj = (int)j - QB - QA, bh = q + 8 * (jj >> 8), qt = jj & 255, b = bh / 6, h = bh % 6, hk = h / 3;
            bf16_t* Pb = ATT_P + (size_t)b * SEQ * NP;
            const int tq = qt * 32 + l31;
            AttState st; att_init(st); bf16x8 qf[4];
            attn_load_q(Pb, tq, PC_QC + 64 * h, hi, qf);
            st.m = sinks[h] * LOG2E; st.l = (hi == 0) ? 1.f : 0.f;
            attn_segment<1>(Pb, PC_KC + 64 * hk, PC_VC + 64 * hk, 127, qt * 32 - 128, 5, tq, qf, st, vl, lane);
            attn_store_o(Pb, tq, PC_QC + 64 * h, hi, st, 0);
        }
    }
}

__device__ __forceinline__ int f2key(float f) { const int b = __float_as_int(f); return b ^ ((b >> 31) & 0x7fffffff); }
__device__ __forceinline__ float key2f(int k) { return __int_as_float(k ^ ((k >> 31) & 0x7fffffff)); }
#define CE_DESC(a, x) do { const int hi_ = max((a), (x)); (x) = min((a), (x)); (a) = hi_; } while (0)

__device__ __forceinline__ void route_half(const bf16_t* __restrict__ qrow, const LAS unsigned char* kl, int (&list)[16]) {
    unsigned qh[64];
#pragma unroll
    for (int c = 0; c < 16; ++c) { const u32x4 t = *(const u32x4*)(qrow + 8 * c); qh[4 * c] = t.x; qh[4 * c + 1] = t.y; qh[4 * c + 2] = t.z; qh[4 * c + 3] = t.w; }
#pragma unroll
    for (int i = 0; i < 16; ++i) list[i] = (int)0x80000000;
    for (int key = 0; key < 128; ++key) {
        float a0 = 0.f, a1 = 0.f;
        const LAS unsigned char* kp = kl + key * 256;
#pragma unroll
        for (int c = 0; c < 16; ++c) {
            const u32x4 kk = *(const LAS u32x4*)(kp + 16 * c);
            a0 = dot2bf(qh[4 * c], kk.x, a0); a1 = dot2bf(qh[4 * c + 1], kk.y, a1);
            a0 = dot2bf(qh[4 * c + 2], kk.z, a0); a1 = dot2bf(qh[4 * c + 3], kk.w, a1);
        }
        int x = (f2key(a0 + a1) & ~127) | key;
#pragma unroll
        for (int i = 0; i < 16; ++i) CE_DESC(list[i], x);
    }
}

__device__ __forceinline__ void routing_phase(const bf16_t* __restrict__ Q2, const float* __restrict__ k1, const float* __restrict__ k2, int* __restrict__ ids, float* __restrict__ gw,
                                              LAS unsigned char* lds, int tid) {
    for (int e = tid; e < 2 * 8192; e += 512) {
        const int hf = e >> 13, o = (e & 8191) * 2;
        const float* src = (hf ? k2 : k1) + o;
        *(LAS unsigned*)(lds + hf * 32768 + o * 2) = cvtpk(src[0], src[1]);
    }
    __syncthreads();
    const int nthreads = gridDim.x * 512;
    for (int it = blockIdx.x * 512 + tid; it < T * 8; it += nthreads) {
        const int t = it >> 3, h = it & 7;
        const bf16_t* qrow = Q2 + (size_t)t * 2048 + h * 256;
        int l1[16], l2[16];
        route_half(qrow, lds, l1);
        route_half(qrow + 128, lds + 32768, l2);
        float f1[16], f2[16];
#pragma unroll
        for (int i = 0; i < 16; ++i) { f1[i] = key2f(l1[i] & ~127); f2[i] = key2f(l2[i] & ~127); }
        int cl[16];
#pragma unroll
        for (int j = 0; j < 16; ++j) cl[j] = (f2key(f1[0] + f2[j]) & ~255) | j;
#pragma unroll
        for (int i = 1; i < 16; ++i) {
#pragma unroll
            for (int j = 0; j < 16; ++j) {
                if ((i + 1) * (j + 1) <= 16) {
                    int x = (f2key(f1[i] + f2[j]) & ~255) | (i * 16 + j);
#pragma unroll
                    for (int k = 0; k < 16; ++k) CE_DESC(cl[k], x);
                }
            }
        }
        float sc[16]; int idv[16];
#pragma unroll
        for (int k = 0; k < 16; ++k) {
            sc[k] = key2f(cl[k] & ~255);
            const int pi = (cl[k] >> 4) & 15, pj = cl[k] & 15;
            int a = 0, b = 0;
#pragma unroll
            for (int i = 0; i < 16; ++i) { a = (pi == i) ? (l1[i] & 127) : a; b = (pj == i) ? (l2[i] & 127) : b; }
            idv[k] = a * 128 + b;
        }
        float e[16], sum = 0.f;
#pragma unroll
        for (int k = 0; k < 16; ++k) { e[k] = __expf(sc[k] - sc[0]); sum += e[k]; }
        const float inv = 1.0f / sum;
        int* ip = ids + (size_t)it * 16; float* gp = gw + (size_t)it * 16;
#pragma unroll
        for (int k = 0; k < 16; k += 4) {
            *(int4*)(ip + k) = make_int4(idv[k], idv[k + 1], idv[k + 2], idv[k + 3]);
            *(float4*)(gp + k) = make_float4(e[k] * inv, e[k + 1] * inv, e[k + 2] * inv, e[k + 3] * inv);
        }
    }
}

__device__ __forceinline__ float gelu_erf(float x);
constexpr int KPITCH = 272;
constexpr int R2_K_BYTES = 2 * 128 * KPITCH;
#define CE_MAXMIN(a, b) do { const int hi_ = max((a), (b)); const int lo_ = min((a), (b)); (a) = hi_; (b) = lo_; } while (0)
__device__ __forceinline__ void bitonic_merge16_desc(int (&a)[16]) {
#pragma unroll
    for (int js = 3; js >= 0; --js) {
#pragma unroll
        for (int i = 0; i < 16; ++i) { const int l = i ^ (1 << js); if (l > i) CE_MAXMIN(a[i], a[l]); }
    }
}
__device__ __forceinline__ void bitonic_sort16_desc(int (&a)[16]) {
#pragma unroll
    for (int ks = 1; ks <= 4; ++ks) {
#pragma unroll
        for (int js = ks - 1; js >= 0; --js) {
#pragma unroll
            for (int i = 0; i < 16; ++i) { const int l = i ^ (1 << js);
                if (l > i) { if ((i & (1 << ks)) == 0) CE_MAXMIN(a[i], a[l]); else CE_MAXMIN(a[l], a[i]); } }
        }
    }
}
__device__ __forceinline__ void merge_top16(int (&a)[16], const int (&b)[16]) {
#pragma unroll
    for (int i = 0; i < 16; ++i) a[i] = max(a[i], b[15 - i]);
    bitonic_merge16_desc(a);
}
__device__ __forceinline__ void route2_half(const bf16_t* __restrict__ qrow  , const LAS unsigned char* kl  , int hi, int (&L)[16]) {
    f32x16 acc[4];
#pragma unroll
    for (int kt = 0; kt < 4; ++kt)
#pragma unroll
        for (int r = 0; r < 16; ++r) acc[kt][r] = 0.f;
    bf16x8 qf[8];
#pragma unroll
    for (int s = 0; s < 8; ++s) qf[s] = *(const bf16x8*)(qrow + 16 * s);
#pragma unroll
    for (int s = 0; s < 8; ++s) {
#pragma unroll
        for (int kt = 0; kt < 4; ++kt) {
            const bf16x8 kf = *(const LAS bf16x8*)(kl + kt * 32 * KPITCH + 32 * s);
            acc[kt] = __builtin_amdgcn_mfma_f32_32x32x16_bf16(kf, qf[s], acc[kt], 0, 0, 0);
        }
    }
    int kk[4][16];
    const int hi4 = 4 * hi;
#pragma unroll
    for (int kt = 0; kt < 4; ++kt)
#pragma unroll
        for (int r = 0; r < 16; ++r) kk[kt][r] = (f2key(acc[kt][r]) & ~127) | ((32 * kt + (r & 3) + 8 * (r >> 2)) | hi4);
#pragma unroll
    for (int kt = 0; kt < 4; ++kt) bitonic_sort16_desc(kk[kt]);
    merge_top16(kk[0], kk[1]); merge_top16(kk[2], kk[3]); merge_top16(kk[0], kk[2]);
#pragma unroll
    for (int i = 0; i < 16; ++i) L[i] = max(kk[0][i], __shfl_xor(kk[0][15 - i], 32));
    bitonic_merge16_desc(L);
}

__device__ __forceinline__ void routing2_setup(const float* __restrict__ k1, const float* __restrict__ k2, LAS unsigned char* lds, int tid) {
    for (int e = tid; e < 2 * 8192; e += 512) {
        const int hf = e >> 13, o = (e & 8191) * 2, key = o >> 7, d = o & 127;
        const float* src = (hf ? k2 : k1) + o;
        *(LAS unsigned*)(lds + hf * 128 * KPITCH + key * KPITCH + d * 2) = cvtpk(src[0], src[1]);
    }
    __syncthreads();
}
__device__ __forceinline__ void routing2_units(const bf16_t* __restrict__ Q2, int* __restrict__ ids, float* __restrict__ gw,
                                               LAS unsigned char* lds, int wave, int lane, int gwave, int ngw) {
    LAS unsigned char* scr = lds + R2_K_BYTES + wave * 2048 + lane * 32;
    const int hi = lane >> 5, l31 = lane & 31;
    for (int u = (gwave < 0 ? wave : gwave); u < (gwave < 0 ? 32 : (T / 32) * 8); u += (gwave < 0 ? 8 : ngw)) {
        const int tb = gwave < 0 ? (int)blockIdx.x * 4 + (u >> 3) : (u >> 3), h = u & 7;
        const int t = tb * 32 + l31;
        const bf16_t* qrow = Q2 + (size_t)t * 2048 + h * 256 + 8 * hi;
        int l1[16], l2[16];
        route2_half(qrow, lds + l31 * KPITCH + 16 * hi, hi, l1);
        route2_half(qrow + 128, lds + 128 * KPITCH + l31 * KPITCH + 16 * hi, hi, l2);
#pragma unroll
        for (int i = 0; i < 16; i += 4) {
            *(LAS unsigned*)(scr + i) = (unsigned)(l1[i] & 127) | ((unsigned)(l1[i + 1] & 127) << 8) | ((unsigned)(l1[i + 2] & 127) << 16) | ((unsigned)(l1[i + 3] & 127) << 24);
            *(LAS unsigned*)(scr + 16 + i) = (unsigned)(l2[i] & 127) | ((unsigned)(l2[i + 1] & 127) << 8) | ((unsigned)(l2[i + 2] & 127) << 16) | ((unsigned)(l2[i + 3] & 127) << 24);
        }
        float f1[16], f2[16];
#pragma unroll
        for (int i = 0; i < 16; ++i) { f1[i] = key2f(l1[i] & ~127); f2[i] = key2f(l2[i] & ~127); }
        int cl[16];
#pragma unroll
        for (int j = 0; j < 16; ++j) cl[j] = (f2key(f1[0] + f2[j]) & ~255) | j;
#pragma unroll
        for (int i = 1; i < 16; ++i) {
#pragma unroll
            for (int j = 0; j < 16; ++j) {
                if ((i + 1) * (j + 1) <= 16) {
                    int x = (f2key(f1[i] + f2[j]) & ~255) | (i * 16 + j);
#pragma unroll
                    for (int k = 0; k < 16; ++k) CE_DESC(cl[k], x);
                }
            }
        }
        float e[16], sum = 0.f;
        const float mx = key2f(cl[0] & ~255);
#pragma unroll
        for (int k = 0; k < 16; ++k) { e[k] = __expf(key2f(cl[k] & ~255) - mx); sum += e[k]; }
        const float inv = 1.0f / sum;
        asm volatile("s_waitcnt lgkmcnt(0)" ::: "memory");
        int idv[8]; float gv[8];
#pragma unroll
        for (int k = 0; k < 8; ++k) {
            const int c = hi ? cl[8 + k] : cl[k];
            gv[k] = (hi ? e[8 + k] : e[k]) * inv;
            const int pi = (c >> 4) & 15, pj = c & 15;
            const int a = *(const LAS unsigned char*)(scr + pi), b = *(const LAS unsigned char*)(scr + 16 + pj);
            idv[k] = a * 128 + b;
        }
        int* ip = ids + ((size_t)t * 8 + h) * 16 + 8 * hi; float* gp = gw + ((size_t)t * 8 + h) * 16 + 8 * hi;
        *(int4*)(ip) = make_int4(idv[0], idv[1], idv[2], idv[3]); *(int4*)(ip + 4) = make_int4(idv[4], idv[5], idv[6], idv[7]);
        *(float4*)(gp) = make_float4(gv[0], gv[1], gv[2], gv[3]); *(float4*)(gp + 4) = make_float4(gv[4], gv[5], gv[6], gv[7]);
        asm volatile("s_waitcnt lgkmcnt(0)" ::: "memory");
    }
}

typedef __bf16 bf16x2v_t __attribute__((ext_vector_type(2)));
__device__ __forceinline__ float dot2(unsigned a, unsigned b, float acc) { return __builtin_amdgcn_fdot2_f32_bf16(__builtin_bit_cast(bf16x2v_t, a), __builtin_bit_cast(bf16x2v_t, b), acc, false); }
template <int CTRL> __device__ __forceinline__ float dpp_add(float v) { return v + __builtin_bit_cast(float, __builtin_amdgcn_update_dpp(0, __builtin_bit_cast(int, v), CTRL, 0xF, 0xF, true)); }
__device__ __forceinline__ float xor16_add(float v) { return v + __builtin_bit_cast(float, __builtin_amdgcn_ds_swizzle(__builtin_bit_cast(int, v), 0x401F)); }
__device__ __forceinline__ float xor32_add(float v) { return v + __shfl_xor(v, 32); }
constexpr int G2_WAVE_LDS = 4096 + 8192 + 128;

__device__ __forceinline__ void gather2_phase(float* __restrict__ H, bf16_t* __restrict__ HB, const float* __restrict__ ssq2p, float* __restrict__ ssq1,
                                              const bf16_t* __restrict__ U16, const bf16_t* __restrict__ V16, const int* __restrict__ ids, const float* __restrict__ gw,
                                              const float* __restrict__ final_g, int last, LAS unsigned char* lds, int wave, int gwave, int lane) {
    LAS unsigned char* wl = lds + wave * G2_WAVE_LDS;
    LAS unsigned short* idl = (LAS unsigned short*)wl;
    LAS float* al = (LAS float*)(wl + 4096);
    const int t0 = __builtin_amdgcn_readfirstlane(gwave * 16);
    const int g = lane >> 3, p = lane & 7;
    for (int tt = 0; tt < 16; ++tt) {
#pragma unroll
        for (int hf = 0; hf < 2; ++hf) { const int k = lane + 64 * hf; idl[tt * 128 + (k & 7) * 16 + (k >> 3)] = (unsigned short)ids[(size_t)(t0 + tt) * 128 + k]; }
    }
    for (int e = lane; e < 2048; e += 64) al[e] = 0.f;
    asm volatile("s_waitcnt lgkmcnt(0)" ::: "memory");
    const unsigned char* Ub = (const unsigned char*)U16; const unsigned char* Vb = (const unsigned char*)V16;
    for (int c = 0; c < 16; ++c) {
        for (int tt = 0; tt < 16; ++tt) {
            const u32x4 x4 = *(const u32x4*)(HB + (size_t)(t0 + tt) * DM + 64 * c + 8 * p);
            const u32x4 i0 = *(const LAS u32x4*)(idl + tt * 128 + g * 16), i1 = *(const LAS u32x4*)(idl + tt * 128 + g * 16 + 8);
            const unsigned idw[8] = {i0.x, i0.y, i0.z, i0.w, i1.x, i1.y, i1.z, i1.w};
            u32x4 u[16];
#pragma unroll
            for (int i = 0; i < 16; ++i) { const unsigned id = (i & 1) ? (idw[i >> 1] >> 16) : (idw[i >> 1] & 0xffffu);
                u[i] = *(const u32x4*)(Ub + (size_t)(id * 2048u + (unsigned)(c * 128 + p * 16))); }
            float a[16];
#pragma unroll
            for (int i = 0; i < 16; ++i) {
                float s = dot2(x4.x, u[i].x, 0.f); s = dot2(x4.y, u[i].y, s); s = dot2(x4.z, u[i].z, s); s = dot2(x4.w, u[i].w, s);
                s = dpp_add<0xB1>(s); s = dpp_add<0x4E>(s); s = dpp_add<0x141>(s);
                a[i] = s;
            }
            if (p == 0) {
                LAS float* ap = al + tt * 128 + g * 16;
#pragma unroll
                for (int i = 0; i < 16; ++i) (void)__hip_atomic_fetch_add(ap + i, a[i], __ATOMIC_RELAXED, __HIP_MEMORY_SCOPE_WORKGROUP);
            }
        }
    }
    asm volatile("s_waitcnt lgkmcnt(0)" ::: "memory");
    for (int n = 0; n < 32; ++n) {
        const int tt = n >> 1, pos = lane + 64 * (n & 1), k = 8 * (pos & 15) + (pos >> 4);
        const float rs2 = rsqrtf(ssq16(ssq2p, t0 + tt) * (1.0f / 1024.0f) + RMS_EPS);
        const float a = al[tt * 128 + pos] * rs2;
        al[tt * 128 + pos] = gw[(size_t)(t0 + tt) * 128 + k] * gelu_erf(a);
    }
    asm volatile("s_waitcnt lgkmcnt(0)" ::: "memory");
    for (int c = 0; c < 16; ++c) {
        for (int tt = 0; tt < 16; ++tt) {
            const LAS f32x4* wp = (const LAS f32x4*)(al + tt * 128 + g * 16);
            const f32x4 w0 = wp[0], w1 = wp[1], w2 = wp[2], w3 = wp[3];
            const float w[16] = {w0[0], w0[1], w0[2], w0[3], w1[0], w1[1], w1[2], w1[3], w2[0], w2[1], w2[2], w2[3], w3[0], w3[1], w3[2], w3[3]};
            const u32x4 i0 = *(const LAS u32x4*)(idl + tt * 128 + g * 16), i1 = *(const LAS u32x4*)(idl + tt * 128 + g * 16 + 8);
            const unsigned idw[8] = {i0.x, i0.y, i0.z, i0.w, i1.x, i1.y, i1.z, i1.w};
            u32x4 v[16];
#pragma unroll
            for (int i = 0; i < 16; ++i) { const unsigned id = (i & 1) ? (idw[i >> 1] >> 16) : (idw[i >> 1] & 0xffffu);
                v[i] = *(const u32x4*)(Vb + (size_t)(id * 2048u + (unsigned)(c * 128 + p * 16))); }
            float y[8];
#pragma unroll
            for (int j = 0; j < 8; ++j) y[j] = 0.f;
#pragma unroll
            for (int i = 0; i < 16; ++i) {
                y[0] = fmaf(w[i], bflo(v[i].x), y[0]); y[1] = fmaf(w[i], bfhi(v[i].x), y[1]); y[2] = fmaf(w[i], bflo(v[i].y), y[2]); y[3] = fmaf(w[i], bfhi(v[i].y), y[3]);
                y[4] = fmaf(w[i], bflo(v[i].z), y[4]); y[5] = fmaf(w[i], bfhi(v[i].z), y[5]); y[6] = fmaf(w[i], bflo(v[i].w), y[6]); y[7] = fmaf(w[i], bfhi(v[i].w), y[7]);
            }
#pragma unroll
            for (int j = 0; j < 8; ++j) { y[j] = dpp_add<0x128>(y[j]); y[j] = xor16_add(y[j]); y[j] = xor32_add(y[j]); }
            if (g == 0) {
                float* hp = H + (size_t)(t0 + tt) * DM + 64 * c + 8 * p;
                f32x4 h0 = *(const f32x4*)hp, h1 = *(const f32x4*)(hp + 4);
                h0 += (f32x4){y[0], y[1], y[2], y[3]}; h1 += (f32x4){y[4], y[5], y[6], y[7]};
                *(f32x4*)hp = h0; *(f32x4*)(hp + 4) = h1;
            }
        }
    }
    __builtin_amdgcn_fence(__ATOMIC_SEQ_CST, "agent");
    asm volatile("s_waitcnt vmcnt(0)" ::: "memory");
    for (int tt = 0; tt < 16; ++tt) {
        const int t = t0 + tt;
        float* hp = H + (size_t)t * DM + 8 * lane;
        f32x4 h0 = *(const f32x4*)hp, h1 = *(const f32x4*)(hp + 4), h2 = *(const f32x4*)(hp + 512), h3 = *(const f32x4*)(hp + 516);
        float ss = (h0[0] * h0[0] + h0[1] * h0[1]) + (h0[2] * h0[2] + h0[3] * h0[3]) + (h1[0] * h1[0] + h1[1] * h1[1]) + (h1[2] * h1[2] + h1[3] * h1[3])
                 + (h2[0] * h2[0] + h2[1] * h2[1]) + (h2[2] * h2[2] + h2[3] * h2[3]) + (h3[0] * h3[0] + h3[1] * h3[1]) + (h3[2] * h3[2] + h3[3] * h3[3]);
        ss = wave_sum(ss);
        if (last) {
            const float rs = rsqrtf(ss * (1.0f / 1024.0f) + RMS_EPS);
            const f32x4 g0 = *(const f32x4*)(final_g + 8 * lane), g1 = *(const f32x4*)(final_g + 8 * lane + 4), g2 = *(const f32x4*)(final_g + 512 + 8 * lane), g3 = *(const f32x4*)(final_g + 516 + 8 * lane);
            h0 = h0 * rs * g0; h1 = h1 * rs * g1; h2 = h2 * rs * g2; h3 = h3 * rs * g3;
            *(f32x4*)hp = h0; *(f32x4*)(hp + 4) = h1; *(f32x4*)(hp + 512) = h2; *(f32x4*)(hp + 516) = h3;
        } else {
            bf16_t* bp = HB + (size_t)t * DM + 8 * lane;
            u32x4 w; w.x = cvtpk(h0[0], h0[1]); w.y = cvtpk(h0[2], h0[3]); w.z = cvtpk(h1[0], h1[1]); w.w = cvtpk(h1[2], h1[3]);
            *(u32x4*)bp = w;
            w.x = cvtpk(h2[0], h2[1]); w.y = cvtpk(h2[2], h2[3]); w.z = cvtpk(h3[0], h3[1]); w.w = cvtpk(h3[2], h3[3]);
            *(u32x4*)(bp + 512) = w;
            if (lane == 0) ssq1[t] = ss;
        }
    }
}

#ifndef G3_UMFMA
#define G3_UMFMA 0
#endif
#ifndef G3_VF16
#define G3_VF16 1
#endif
typedef _Float16 f16x2_t __attribute__((ext_vector_type(2)));
__device__ __forceinline__ unsigned cvtpk_h(float lo, float hi) { f16x2_t v = {(_Float16)lo, (_Float16)hi}; return __builtin_bit_cast(unsigned, v); }
__device__ __forceinline__ void fma_mix_lo(float& y, float w, unsigned pk) { asm("v_fma_mix_f32 %0, %1, %2, %0 op_sel_hi:[0,1,0]" : "+v"(y) : "v"(w), "v"(pk)); }
__device__ __forceinline__ void fma_mix_hi(float& y, float w, unsigned pk) { asm("v_fma_mix_f32 %0, %1, %2, %0 op_sel:[0,1,0] op_sel_hi:[0,1,0]" : "+v"(y) : "v"(w), "v"(pk)); }
__device__ __forceinline__ float swap32_add(float a, float b) {
    const auto r = __builtin_amdgcn_permlane32_swap(__float_as_uint(a), __float_as_uint(b), false, false);
    return __uint_as_float(r[0]) + __uint_as_float(r[1]);
}

__device__ __forceinline__ void gather3_phase(float* __restrict__ H, bf16_t* __restrict__ HB, const float* __restrict__ ssq2p, float* __restrict__ ssq1,
                                              const bf16_t* __restrict__ U16, const unsigned short* __restrict__ V16h, const int* __restrict__ ids, const float* __restrict__ gw,
                                              const float* __restrict__ final_g, int last, LAS unsigned char* lds, int wave, int gwave, int lane) {
    LAS unsigned char* wl = lds + wave * G2_WAVE_LDS;
    LAS unsigned short* idl = (LAS unsigned short*)wl;
    LAS float* al = (LAS float*)(wl + 4096);
    const int t0 = __builtin_amdgcn_readfirstlane(gwave * 16);
    for (int tt = 0; tt < 16; ++tt) {
        idl[tt * 128 + lane] = (unsigned short)ids[(size_t)(t0 + tt) * 128 + lane];
        idl[tt * 128 + 64 + lane] = (unsigned short)ids[(size_t)(t0 + tt) * 128 + 64 + lane];
    }
    for (int e = lane; e < 2048; e += 64) al[e] = 0.f;
    asm volatile("s_waitcnt lgkmcnt(0)" ::: "memory");
    const unsigned char* Ub = (const unsigned char*)U16; const unsigned char* Vb = (const unsigned char*)V16h;
#if G3_UMFMA
    {
        const int e = lane & 15, q = lane >> 4;
        for (int c = 0; c < 16; ++c) {
            for (int tt = 0; tt < 16; ++tt) {
                const bf16_t* xp = HB + (size_t)(t0 + tt) * DM + 64 * c + 8 * q;
                const bf16x8 xa = *(const bf16x8*)xp, xb = *(const bf16x8*)(xp + 32);
                const u32x4 iv = *(const LAS u32x4*)(idl + tt * 128 + 8 * e);
                const unsigned idw[4] = {iv.x, iv.y, iv.z, iv.w};
                bf16x8 ua[8], ub[8];
#pragma unroll
                for (int gi = 0; gi < 8; ++gi) { const unsigned id = (gi & 1) ? (idw[gi >> 1] >> 16) : (idw[gi >> 1] & 0xffffu);
                    const unsigned char* up = Ub + (size_t)(id * 2048u + (unsigned)(c * 128 + q * 16));
                    ua[gi] = *(const bf16x8*)up; ub[gi] = *(const bf16x8*)(up + 64); }
                float r[8];
#pragma unroll
                for (int gi = 0; gi < 8; ++gi) {
                    f32x4 acc = {0.f, 0.f, 0.f, 0.f};
                    acc = __builtin_amdgcn_mfma_f32_16x16x32_bf16(xa, ua[gi], acc, 0, 0, 0);
                    acc = __builtin_amdgcn_mfma_f32_16x16x32_bf16(xb, ub[gi], acc, 0, 0, 0);
                    r[gi] = acc[0];
                }
                if (q == 0) {
                    LAS float* ap = al + tt * 128 + 8 * e;
#pragma unroll
                    for (int gi = 0; gi < 8; ++gi) (void)__hip_atomic_fetch_add(ap + gi, r[gi], __ATOMIC_RELAXED, __HIP_MEMORY_SCOPE_WORKGROUP);
                }
            }
        }
    }
#else
    {
        const int g = lane >> 3, p = lane & 7;
        for (int c = 0; c < 16; ++c) {
            for (int tt = 0; tt < 16; ++tt) {
                const u32x4 x4 = *(const u32x4*)(HB + (size_t)(t0 + tt) * DM + 64 * c + 8 * p);
                const u32x4 i0 = *(const LAS u32x4*)(idl + tt * 128 + g * 16), i1 = *(const LAS u32x4*)(idl + tt * 128 + g * 16 + 8);
                const unsigned idw[8] = {i0.x, i0.y, i0.z, i0.w, i1.x, i1.y, i1.z, i1.w};
                u32x4 u[16];
#pragma unroll
                for (int i = 0; i < 16; ++i) { const unsigned id = (i & 1) ? (idw[i >> 1] >> 16) : (idw[i >> 1] & 0xffffu);
                    u[i] = *(const u32x4*)(Ub + (size_t)(id * 2048u + (unsigned)(c * 128 + p * 16))); }
                float a[16];
#pragma unroll
                for (int i = 0; i < 16; ++i) {
                    float s_ = dot2(x4.x, u[i].x, 0.f); s_ = dot2(x4.y, u[i].y, s_); s_ = dot2(x4.z, u[i].z, s_); s_ = dot2(x4.w, u[i].w, s_);
                    s_ = dpp_add<0xB1>(s_); s_ = dpp_add<0x4E>(s_); s_ = dpp_add<0x141>(s_);
                    a[i] = s_;
                }
                if (p == 0) {
                    LAS float* ap = al + tt * 128 + g * 16;
#pragma unroll
                    for (int i = 0; i < 16; ++i) (void)__hip_atomic_fetch_add(ap + i, a[i], __ATOMIC_RELAXED, __HIP_MEMORY_SCOPE_WORKGROUP);
                }
            }
        }
    }
#endif
    asm volatile("s_waitcnt lgkmcnt(0)" ::: "memory");
    for (int n = 0; n < 32; ++n) {
        const int tt = n >> 1, k = lane + 64 * (n & 1);
        const float rs2 = rsqrtf(ssq16(ssq2p, t0 + tt) * (1.0f / 1024.0f) + RMS_EPS);
        const float a = al[tt * 128 + k] * rs2;
        al[tt * 128 + k] = gw[(size_t)(t0 + tt) * 128 + k] * gelu_erf(a);
    }
    asm volatile("s_waitcnt lgkmcnt(0)" ::: "memory");
    {
        const int g = lane >> 3, p = lane & 7;
        for (int c = 0; c < 16; ++c) {
            for (int tt = 0; tt < 16; ++tt) {
                const LAS f32x4* wp = (const LAS f32x4*)(al + tt * 128 + g * 16);
                const f32x4 w0 = wp[0], w1 = wp[1], w2 = wp[2], w3 = wp[3];
                const float w[16] = {w0[0], w0[1], w0[2], w0[3], w1[0], w1[1], w1[2], w1[3], w2[0], w2[1], w2[2], w2[3], w3[0], w3[1], w3[2], w3[3]};
                const u32x4 i0 = *(const LAS u32x4*)(idl + tt * 128 + g * 16), i1 = *(const LAS u32x4*)(idl + tt * 128 + g * 16 + 8);
                const unsigned idw[8] = {i0.x, i0.y, i0.z, i0.w, i1.x, i1.y, i1.z, i1.w};
                u32x4 v[16];
#pragma unroll
                for (int i = 0; i < 16; ++i) { const unsigned id = (i & 1) ? (idw[i >> 1] >> 16) : (idw[i >> 1] & 0xffffu);
                    v[i] = *(const u32x4*)(Vb + (size_t)(id * 2048u + (unsigned)(c * 128 + p * 16))); }
                float y[8];
#pragma unroll
                for (int j = 0; j < 8; ++j) y[j] = 0.f;
#pragma unroll
                for (int i = 0; i < 16; ++i) {
#if G3_VF16
                    fma_mix_lo(y[0], w[i], v[i].x); fma_mix_hi(y[1], w[i], v[i].x); fma_mix_lo(y[2], w[i], v[i].y); fma_mix_hi(y[3], w[i], v[i].y);
                    fma_mix_lo(y[4], w[i], v[i].z); fma_mix_hi(y[5], w[i], v[i].z); fma_mix_lo(y[6], w[i], v[i].w); fma_mix_hi(y[7], w[i], v[i].w);
#else
                    y[0] = fmaf(w[i], bflo(v[i].x), y[0]); y[1] = fmaf(w[i], bfhi(v[i].x), y[1]); y[2] = fmaf(w[i], bflo(v[i].y), y[2]); y[3] = fmaf(w[i], bfhi(v[i].y), y[3]);
                    y[4] = fmaf(w[i], bflo(v[i].z), y[4]); y[5] = fmaf(w[i], bfhi(v[i].z), y[5]); y[6] = fmaf(w[i], bflo(v[i].w), y[6]); y[7] = fmaf(w[i], bfhi(v[i].w), y[7]);
#endif
                }
                float z[4];
#pragma unroll
                for (int j = 0; j < 4; ++j) { z[j] = swap32_add(y[j], y[j + 4]); z[j] = xor16_add(z[j]); z[j] = dpp_add<0x128>(z[j]); }
                if ((lane & 0x18) == 0) {
                    float* hp = H + (size_t)(t0 + tt) * DM + 64 * c + 8 * p + 4 * (lane >> 5);
                    f32x4 h0 = *(const f32x4*)hp;
                    h0 += (f32x4){z[0], z[1], z[2], z[3]};
                    *(f32x4*)hp = h0;
                }
            }
        }
    }
    __builtin_amdgcn_fence(__ATOMIC_SEQ_CST, "agent");
    asm volatile("s_waitcnt vmcnt(0)" ::: "memory");
    for (int tt = 0; tt < 16; ++tt) {
        const int t = t0 + tt;
        float* hp = H + (size_t)t * DM + 8 * lane;
        f32x4 h0 = *(const f32x4*)hp, h1 = *(const f32x4*)(hp + 4), h2 = *(const f32x4*)(hp + 512), h3 = *(const f32x4*)(hp + 516);
        float ss = (h0[0] * h0[0] + h0[1] * h0[1]) + (h0[2] * h0[2] + h0[3] * h0[3]) + (h1[0] * h1[0] + h1[1] * h1[1]) + (h1[2] * h1[2] + h1[3] * h1[3])
                 + (h2[0] * h2[0] + h2[1] * h2[1]) + (h2[2] * h2[2] + h2[3] * h2[3]) + (h3[0] * h3[0] + h3[1] * h3[1]) + (h3[2] * h3[2] + h3[3] * h3[3]);
        ss = wave_sum(ss);
        if (last) {
            const float rs = rsqrtf(ss * (1.0f / 1024.0f) + RMS_EPS);
            const f32x4 g0 = *(const f32x4*)(final_g + 8 * lane), g1 = *(const f32x4*)(final_g + 8 * lane + 4), g2 = *(const f32x4*)(final_g + 512 + 8 * lane), g3 = *(const f32x4*)(final_g + 516 + 8 * lane);
            h0 = h0 * rs * g0; h1 = h1 * rs * g1; h2 = h2 * rs * g2; h3 = h3 * rs * g3;
            *(f32x4*)hp = h0; *(f32x4*)(hp + 4) = h1; *(f32x4*)(hp + 512) = h2; *(f32x4*)(hp + 516) = h3;
        } else {
            bf16_t* bp = HB + (size_t)t * DM + 8 * lane;
            u32x4 w; w.x = cvtpk(h0[0], h0[1]); w.y = cvtpk(h0[2], h0[3]); w.z = cvtpk(h1[0], h1[1]); w.w = cvtpk(h1[2], h1[3]);
            *(u32x4*)bp = w;
            w.x = cvtpk(h2[0], h2[1]); w.y = cvtpk(h2[2], h2[3]); w.z = cvtpk(h3[0], h3[1]); w.w = cvtpk(h3[2], h3[3]);
            *(u32x4*)(bp + 512) = w;
            if (lane == 0) ssq1[t] = ss;
        }
    }
}

typedef float f32x2v __attribute__((ext_vector_type(2)));
constexpr float FP8_MAX = 448.0f;

__device__ __forceinline__ void quant_row_fp8(const float* __restrict__ src, const float* __restrict__ colscale, unsigned char* __restrict__ dst, float* __restrict__ scale_out, int lane) {
    f32x4 v[4]; float am = 0.f;
#pragma unroll
    for (int j = 0; j < 4; ++j) {
        v[j] = *(const f32x4*)(src + 4 * (lane + 64 * j));
        if (colscale) v[j] = v[j] * *(const f32x4*)(colscale + 4 * (lane + 64 * j));
        am = fmaxf(am, fmaxf(fmaxf(fabsf(v[j][0]), fabsf(v[j][1])), fmaxf(fabsf(v[j][2]), fabsf(v[j][3]))));
    }
#pragma unroll
    for (int o = 1; o < 64; o <<= 1) am = fmaxf(am, __shfl_xor(am, o));
    const float inv = am > 0.f ? FP8_MAX / am : 1.0f;
#pragma unroll
    for (int j = 0; j < 4; ++j) {
        int w = 0;
        w = __builtin_amdgcn_cvt_pk_fp8_f32(v[j][0] * inv, v[j][1] * inv, w, false);
        w = __builtin_amdgcn_cvt_pk_fp8_f32(v[j][2] * inv, v[j][3] * inv, w, true);
        *(int*)(dst + 4 * (lane + 64 * j)) = w;
    }
    if (lane == 0) *scale_out = am > 0.f ? am / FP8_MAX : 1.0f;
}

__device__ __forceinline__ float dot2v(bf16x2v_t a, unsigned b, float acc) { return __builtin_amdgcn_fdot2_f32_bf16(a, __builtin_bit_cast(bf16x2v_t, b), acc, false); }
__device__ __forceinline__ void g4_issue(u32x4 (&buf)[16], const unsigned char* __restrict__ tab, const LAS unsigned short* idl, int it, int g, int p) {
    const int tt = it & 15, c = it >> 4;
    const u32x4 i0 = *(const LAS u32x4*)(idl + tt * 128 + g * 16), i1 = *(const LAS u32x4*)(idl + tt * 128 + g * 16 + 8);
    const unsigned idw[8] = {i0.x, i0.y, i0.z, i0.w, i1.x, i1.y, i1.z, i1.w};
    const unsigned char* base = tab + (c * 128 + p * 16);
#pragma unroll
    for (int i = 0; i < 16; ++i) { const unsigned id = (i & 1) ? (idw[i >> 1] >> 16) : (idw[i >> 1] & 0xffffu);
        buf[i] = *(const u32x4*)(base + (size_t)(id * 1024u)); }
}
struct G4Ids { u32x4 i0, i1; };
__device__ __forceinline__ void g4_ids(G4Ids& d, const LAS unsigned short* idl, int it, int g) {
    const int tt = it & 15;
    d.i0 = *(const LAS u32x4*)(idl + tt * 128 + g * 16); d.i1 = *(const LAS u32x4*)(idl + tt * 128 + g * 16 + 8);
}
__device__ __forceinline__ void g4_rows(u32x4 (&buf)[16], const unsigned char* __restrict__ tab, const G4Ids& d, int it, int p) {
    const int c = it >> 4;
    const unsigned idw[8] = {d.i0.x, d.i0.y, d.i0.z, d.i0.w, d.i1.x, d.i1.y, d.i1.z, d.i1.w};
    const unsigned char* base = tab + (c * 128 + p * 16);
#pragma unroll
    for (int i = 0; i < 16; ++i) { const unsigned id = (i & 1) ? (idw[i >> 1] >> 16) : (idw[i >> 1] & 0xffffu);
        buf[i] = *(const u32x4*)(base + (size_t)(id * 1024u)); }
}
__device__ __forceinline__ void g4_xload(u32x4 (&x)[2], const bf16_t* __restrict__ HB, int t0, int it, int p) {
    const bf16_t* xp = HB + (size_t)(t0 + (it & 15)) * DM + 128 * (it >> 4) + 16 * p;
    x[0] = *(const u32x4*)xp; x[1] = *(const u32x4*)(xp + 8);
}
#define G4_CVT(wd, hi_) __builtin_amdgcn_cvt_scalef32_pk_bf16_fp8((wd), 1.0f, (hi_))
__device__ __forceinline__ void g4_ucompute(const u32x4 (&u)[16], const u32x4 (&x)[2], LAS float* ap, int p) {
    const unsigned xw[8] = {x[0].x, x[0].y, x[0].z, x[0].w, x[1].x, x[1].y, x[1].z, x[1].w};
    float a[16];
#pragma unroll
    for (int i0 = 0; i0 < 16; i0 += 8) {
        float s_[8];
#pragma unroll
        for (int e = 0; e < 8; ++e) s_[e] = 0.f;
#pragma unroll
        for (int q = 0; q < 4; ++q) {
#pragma unroll
            for (int e = 0; e < 8; ++e) { const unsigned wd = (q == 0) ? u[i0 + e].x : (q == 1) ? u[i0 + e].y : (q == 2) ? u[i0 + e].z : u[i0 + e].w;
                s_[e] = dot2v(G4_CVT(wd, false), xw[2 * q], s_[e]); }
#pragma unroll
            for (int e = 0; e < 8; ++e) { const unsigned wd = (q == 0) ? u[i0 + e].x : (q == 1) ? u[i0 + e].y : (q == 2) ? u[i0 + e].z : u[i0 + e].w;
                s_[e] = dot2v(G4_CVT(wd, true), xw[2 * q + 1], s_[e]); }
        }
#pragma unroll
        for (int e = 0; e < 8; ++e) s_[e] = dpp_add<0xB1>(s_[e]);
#pragma unroll
        for (int e = 0; e < 8; ++e) s_[e] = dpp_add<0x4E>(s_[e]);
#pragma unroll
        for (int e = 0; e < 8; ++e) a[i0 + e] = dpp_add<0x141>(s_[e]);
    }
    if (p == 0) {
#pragma unroll
        for (int i = 0; i < 16; ++i) (void)__hip_atomic_fetch_add(ap + i, a[i], __ATOMIC_RELAXED, __HIP_MEMORY_SCOPE_WORKGROUP);
    }
}
__device__ __forceinline__ void g4_vcompute(const u32x4 (&v)[16], const LAS float* wsrc, float* __restrict__ hp, int lane, int dry) {
    const LAS f32x4* wp = (const LAS f32x4*)wsrc;
    const f32x4 w0 = wp[0], w1 = wp[1], w2 = wp[2], w3 = wp[3];
    const float w[16] = {w0[0], w0[1], w0[2], w0[3], w1[0], w1[1], w1[2], w1[3], w2[0], w2[1], w2[2], w2[3], w3[0], w3[1], w3[2], w3[3]};
    float yy[16];
#pragma unroll
    for (int j = 0; j < 16; ++j) yy[j] = 0.f;
#pragma unroll
    for (int i = 0; i < 16; ++i) {
        const unsigned vw[4] = {v[i].x, v[i].y, v[i].z, v[i].w};
#pragma unroll
        for (int q = 0; q < 4; ++q) {
            const f32x2v lo = __builtin_amdgcn_cvt_pk_f32_fp8((int)vw[q], false), hi = __builtin_amdgcn_cvt_pk_f32_fp8((int)vw[q], true);
            yy[4 * q] = fmaf(w[i], lo.x, yy[4 * q]); yy[4 * q + 1] = fmaf(w[i], lo.y, yy[4 * q + 1]); yy[4 * q + 2] = fmaf(w[i], hi.x, yy[4 * q + 2]); yy[4 * q + 3] = fmaf(w[i], hi.y, yy[4 * q + 3]);
        }
    }
    f32x2v y[8];
#pragma unroll
    for (int j = 0; j < 8; ++j) y[j] = (f32x2v){yy[2 * j], yy[2 * j + 1]};
    float z[8];
#pragma unroll
    for (int j = 0; j < 4; ++j) { z[2 * j] = swap32_add(y[j].x, y[j + 4].x); z[2 * j + 1] = swap32_add(y[j].y, y[j + 4].y); }
#pragma unroll
    for (int j = 0; j < 8; ++j) { z[j] = xor16_add(z[j]); z[j] = dpp_add<0x128>(z[j]); }
    if ((lane & 0x18) == 0 && !(dry && z[0] * z[0] >= 0.f)) {
        f32x4 h0 = *(const f32x4*)hp, h1 = *(const f32x4*)(hp + 4);
        h0 += (f32x4){z[0], z[1], z[2], z[3]}; h1 += (f32x4){z[4], z[5], z[6], z[7]};
        *(f32x4*)hp = h0; *(f32x4*)(hp + 4) = h1;
    }
}

__device__ __forceinline__ void gather4_phase(float* __restrict__ H, bf16_t* __restrict__ HB, const float* __restrict__ ssq2p, float* __restrict__ ssq1,
                                              const unsigned char* __restrict__ U8, const unsigned char* __restrict__ V8, const float* __restrict__ su, const float* __restrict__ sv,
                                              const int* __restrict__ ids, const float* __restrict__ gw,
                                              const float* __restrict__ final_g, int last, LAS unsigned char* lds, int wave, int gwave, int lane, int dry = 0, int idmask = 0xffff) {
    LAS unsigned char* wl = lds + wave * G2_WAVE_LDS;
    LAS unsigned short* idl = (LAS unsigned short*)wl;
    LAS float* al = (LAS float*)(wl + 4096);
    const int t0 = __builtin_amdgcn_readfirstlane(gwave * 16);
    for (int tt = 0; tt < 16; ++tt) {
        idl[tt * 128 + lane] = (unsigned short)(ids[(size_t)(t0 + tt) * 128 + lane] & idmask);
        idl[tt * 128 + 64 + lane] = (unsigned short)(ids[(size_t)(t0 + tt) * 128 + 64 + lane] & idmask);
    }
    for (int e = lane; e < 2048; e += 64) al[e] = 0.f;
    asm volatile("s_waitcnt lgkmcnt(0)" ::: "memory");
    const int g = lane >> 3, p = lane & 7;
    if (!(dry & 2)) {
        u32x4 uA[16], uB[16], xA[2], xB[2];
        g4_issue(uA, U8, idl, 0, g, p);
        g4_xload(xA, HB, t0, 0, p);
        for (int it = 0; it < 128; it += 2) {
            g4_issue(uB, U8, idl, it + 1, g, p); g4_xload(xB, HB, t0, it + 1, p);
            g4_ucompute(uA, xA, al + (it & 15) * 128 + g * 16, p);
            if (it + 2 < 128) { g4_issue(uA, U8, idl, it + 2, g, p); g4_xload(xA, HB, t0, it + 2, p); }
            g4_ucompute(uB, xB, al + ((it + 1) & 15) * 128 + g * 16, p);
        }
    }
    asm volatile("s_waitcnt lgkmcnt(0)" ::: "memory");
    for (int n = 0; n < 32; ++n) {
        const int tt = n >> 1, k = lane + 64 * (n & 1);
        const float rs2 = rsqrtf(ssq16(ssq2p, t0 + tt) * (1.0f / 1024.0f) + RMS_EPS);
        const int id = idl[tt * 128 + k];
        const float a = al[tt * 128 + k] * rs2 * su[id];
        al[tt * 128 + k] = gw[(size_t)(t0 + tt) * 128 + k] * gelu_erf(a) * sv[id];
    }
    asm volatile("s_waitcnt lgkmcnt(0)" ::: "memory");
    if (!(dry & 4)) {
        u32x4 vA[16], vB[16];
        g4_issue(vA, V8, idl, 0, g, p);
        for (int it = 0; it < 128; it += 2) {
            g4_issue(vB, V8, idl, it + 1, g, p);
            g4_vcompute(vA, al + (it & 15) * 128 + g * 16, H + (size_t)(t0 + (it & 15)) * DM + 128 * (it >> 4) + 16 * p + 8 * (lane >> 5), lane, dry);
            if (it + 2 < 128) g4_issue(vA, V8, idl, it + 2, g, p);
            g4_vcompute(vB, al + ((it + 1) & 15) * 128 + g * 16, H + (size_t)(t0 + ((it + 1) & 15)) * DM + 128 * ((it + 1) >> 4) + 16 * p + 8 * (lane >> 5), lane, dry);
        }
    }
    if (dry) return;
    __builtin_amdgcn_fence(__ATOMIC_SEQ_CST, "agent");
    asm volatile("s_waitcnt vmcnt(0)" ::: "memory");
    for (int tt = 0; tt < 16; ++tt) {
        const int t = t0 + tt;
        float* hp = H + (size_t)t * DM + 8 * lane;
        f32x4 h0 = *(const f32x4*)hp, h1 = *(const f32x4*)(hp + 4), h2 = *(const f32x4*)(hp + 512), h3 = *(const f32x4*)(hp + 516);
        float ss = (h0[0] * h0[0] + h0[1] * h0[1]) + (h0[2] * h0[2] + h0[3] * h0[3]) + (h1[0] * h1[0] + h1[1] * h1[1]) + (h1[2] * h1[2] + h1[3] * h1[3])
                 + (h2[0] * h2[0] + h2[1] * h2[1]) + (h2[2] * h2[2] + h2[3] * h2[3]) + (h3[0] * h3[0] + h3[1] * h3[1]) + (h3[2] * h3[2] + h3[3] * h3[3]);
        ss = wave_sum(ss);
        if (last) {
            const float rs = rsqrtf(ss * (1.0f / 1024.0f) + RMS_EPS);
            const f32x4 g0 = *(const f32x4*)(final_g + 8 * lane), g1 = *(const f32x4*)(final_g + 8 * lane + 4), g2 = *(const f32x4*)(final_g + 512 + 8 * lane), g3 = *(const f32x4*)(final_g + 516 + 8 * lane);
            h0 = h0 * rs * g0; h1 = h1 * rs * g1; h2 = h2 * rs * g2; h3 = h3 * rs * g3;
            *(f32x4*)hp = h0; *(f32x4*)(hp + 4) = h1; *(f32x4*)(hp + 512) = h2; *(f32x4*)(hp + 516) = h3;
        } else {
            bf16_t* bp = HB + (size_t)t * DM + 8 * lane;
            u32x4 w; w.x = cvtpk(h0[0], h0[1]); w.y = cvtpk(h0[2], h0[3]); w.z = cvtpk(h1[0], h1[1]); w.w = cvtpk(h1[2], h1[3]);
            *(u32x4*)bp = w;
            w.x = cvtpk(h2[0], h2[1]); w.y = cvtpk(h2[2], h2[3]); w.z = cvtpk(h3[0], h3[1]); w.w = cvtpk(h3[2], h3[3]);
            *(u32x4*)(bp + 512) = w;
            if (lane == 0) ssq1[t] = ss;
        }
    }
}

__device__ __forceinline__ void quant_row_i8(const float* __restrict__ src, const float* __restrict__ colscale, unsigned char* __restrict__ dst, float* __restrict__ scale_out, int bias, int lane) {
    f32x4 v[4]; float am = 0.f;
#pragma unroll
    for (int j = 0; j < 4; ++j) {
        v[j] = *(const f32x4*)(src + 4 * (lane + 64 * j));
        if (colscale) v[j] = v[j] * *(const f32x4*)(colscale + 4 * (lane + 64 * j));
        am = fmaxf(am, fmaxf(fmaxf(fabsf(v[j][0]), fabsf(v[j][1])), fmaxf(fabsf(v[j][2]), fabsf(v[j][3]))));
    }
#pragma unroll
    for (int o = 1; o < 64; o <<= 1) am = fmaxf(am, __shfl_xor(am, o));
    const float inv = am > 0.f ? 127.0f / am : 0.f;
#pragma unroll
    for (int j = 0; j < 4; ++j) {
        const int q0 = (int)rintf(v[j][0] * inv) + bias, q1 = (int)rintf(v[j][1] * inv) + bias, q2 = (int)rintf(v[j][2] * inv) + bias, q3 = (int)rintf(v[j][3] * inv) + bias;
        *(unsigned*)(dst + 4 * (lane + 64 * j)) = (unsigned)(q0 & 255) | ((unsigned)(q1 & 255) << 8) | ((unsigned)(q2 & 255) << 16) | ((unsigned)(q3 & 255) << 24);
    }
    if (lane == 0) *scale_out = am > 0.f ? am / 127.0f : 0.f;
}
template <int CTRL> __device__ __forceinline__ int dpp_addi(int v) { return v + __builtin_amdgcn_update_dpp(0, v, CTRL, 0xF, 0xF, true); }
__device__ __forceinline__ void g5_ucompute(const u32x4 (&u)[16], const u32x4& x, LAS int* ap, int p) {
    int a[16];
#pragma unroll
    for (int i = 0; i < 16; ++i) {
        int s_ = __builtin_amdgcn_sdot4((int)u[i].x, (int)x.x, 0, false);
        s_ = __builtin_amdgcn_sdot4((int)u[i].y, (int)x.y, s_, false);
        s_ = __builtin_amdgcn_sdot4((int)u[i].z, (int)x.z, s_, false);
        s_ = __builtin_amdgcn_sdot4((int)u[i].w, (int)x.w, s_, false);
        a[i] = s_;
    }
#pragma unroll
    for (int i = 0; i < 16; ++i) a[i] = dpp_addi<0xB1>(a[i]);
#pragma unroll
    for (int i = 0; i < 16; ++i) a[i] = dpp_addi<0x4E>(a[i]);
    if ((p & 3) == 0) {
#pragma unroll
        for (int i = 0; i < 16; ++i) (void)__hip_atomic_fetch_add(ap + i, a[i], __ATOMIC_RELAXED, __HIP_MEMORY_SCOPE_WORKGROUP);
    }
}
__device__ __forceinline__ void g5_vcompute(const u32x4 (&v)[16], const LAS float* wsrc, float* __restrict__ hp, int lane, int dry) {
    const LAS f32x4* wp = (const LAS f32x4*)wsrc;
    const f32x4 w0 = wp[0], w1 = wp[1], w2 = wp[2], w3 = wp[3];
    const float w[16] = {w0[0], w0[1], w0[2], w0[3], w1[0], w1[1], w1[2], w1[3], w2[0], w2[1], w2[2], w2[3], w3[0], w3[1], w3[2], w3[3]};
    float wsum = ((w[0] + w[1]) + (w[2] + w[3])) + ((w[4] + w[5]) + (w[6] + w[7])) + (((w[8] + w[9]) + (w[10] + w[11])) + ((w[12] + w[13]) + (w[14] + w[15])));
    float yy[16];
    const float y0 = -1152.0f * wsum;
#pragma unroll
    for (int j = 0; j < 16; ++j) yy[j] = y0;
#pragma unroll
    for (int i = 0; i < 16; ++i) {
        const unsigned vw[4] = {v[i].x, v[i].y, v[i].z, v[i].w};
#pragma unroll
        for (int q = 0; q < 4; ++q) {
            const unsigned lo = __builtin_amdgcn_perm(vw[q], 0x64646464u, 0x00050004u), hi = __builtin_amdgcn_perm(vw[q], 0x64646464u, 0x00070006u);
            fma_mix_lo(yy[4 * q], w[i], lo); fma_mix_hi(yy[4 * q + 1], w[i], lo); fma_mix_lo(yy[4 * q + 2], w[i], hi); fma_mix_hi(yy[4 * q + 3], w[i], hi);
        }
    }
    float z[8];
#pragma unroll
    for (int j = 0; j < 8; ++j) z[j] = swap32_add(yy[j], yy[j + 8]);
#pragma unroll
    for (int j = 0; j < 8; ++j) { z[j] = xor16_add(z[j]); z[j] = dpp_add<0x128>(z[j]); }
    if ((lane & 0x18) == 0 && !(dry && z[0] * z[0] >= 0.f)) {
        f32x4 h0 = *(const f32x4*)hp, h1 = *(const f32x4*)(hp + 4);
        h0 += (f32x4){z[0], z[1], z[2], z[3]}; h1 += (f32x4){z[4], z[5], z[6], z[7]};
        *(f32x4*)hp = h0; *(f32x4*)(hp + 4) = h1;
    }
}
#ifndef G5_VDOT4
#define G5_VDOT4 1
#endif
__device__ __forceinline__ void g6_vcompute(const u32x4 (&v)[16], const LAS unsigned char* w8src, float sw, float* __restrict__ hp, int lane, int dry, bf16_t* hbp, LAS float* sspart, const u32x4 hb_pre) {
    const u32x4 w4 = *(const LAS u32x4*)w8src;
    const unsigned ww[4] = {w4.x, w4.y, w4.z, w4.w};
    int yy[16];
#pragma unroll
    for (int j = 0; j < 16; ++j) yy[j] = 0;
#pragma unroll
    for (int a = 0; a < 4; ++a) {
#pragma unroll
        for (int q = 0; q < 4; ++q) {
            const unsigned r0 = (q == 0) ? v[4 * a].x : (q == 1) ? v[4 * a].y : (q == 2) ? v[4 * a].z : v[4 * a].w;
            const unsigned r1 = (q == 0) ? v[4 * a + 1].x : (q == 1) ? v[4 * a + 1].y : (q == 2) ? v[4 * a + 1].z : v[4 * a + 1].w;
            const unsigned r2 = (q == 0) ? v[4 * a + 2].x : (q == 1) ? v[4 * a + 2].y : (q == 2) ? v[4 * a + 2].z : v[4 * a + 2].w;
            const unsigned r3 = (q == 0) ? v[4 * a + 3].x : (q == 1) ? v[4 * a + 3].y : (q == 2) ? v[4 * a + 3].z : v[4 * a + 3].w;
            const unsigned lo01 = __builtin_amdgcn_perm(r1, r0, 0x05010400u), hi01 = __builtin_amdgcn_perm(r1, r0, 0x07030602u);
            const unsigned lo23 = __builtin_amdgcn_perm(r3, r2, 0x05010400u), hi23 = __builtin_amdgcn_perm(r3, r2, 0x07030602u);
            const unsigned c0 = __builtin_amdgcn_perm(lo23, lo01, 0x05040100u), c1 = __builtin_amdgcn_perm(lo23, lo01, 0x07060302u);
            const unsigned c2 = __builtin_amdgcn_perm(hi23, hi01, 0x05040100u), c3 = __builtin_amdgcn_perm(hi23, hi01, 0x07060302u);
            yy[4 * q] = __builtin_amdgcn_sdot4((int)c0, (int)ww[a], yy[4 * q], false); yy[4 * q + 1] = __builtin_amdgcn_sdot4((int)c1, (int)ww[a], yy[4 * q + 1], false);
            yy[4 * q + 2] = __builtin_amdgcn_sdot4((int)c2, (int)ww[a], yy[4 * q + 2], false); yy[4 * q + 3] = __builtin_amdgcn_sdot4((int)c3, (int)ww[a], yy[4 * q + 3], false);
        }
    }
    int z[8];
#pragma unroll
    for (int j = 0; j < 8; ++j) { const auto r = __builtin_amdgcn_permlane32_swap((unsigned)yy[j], (unsigned)yy[j + 8], false, false); z[j] = (int)(r[0] + r[1]); }
#pragma unroll
    for (int j = 0; j < 8; ++j) { z[j] += __builtin_amdgcn_ds_swizzle(z[j], 0x401F); z[j] = dpp_addi<0x128>(z[j]); }
    float ss = 0.f;
    if ((lane & 0x18) == 0 && !(dry && z[0] == 0x7fffffff)) {
#if RES16
        const u32x4 hb_ = hb_pre;
        f32x4 h0 = (f32x4){bflo(hb_.x), bfhi(hb_.x), bflo(hb_.y), bfhi(hb_.y)}, h1 = (f32x4){bflo(hb_.z), bfhi(hb_.z), bflo(hb_.w), bfhi(hb_.w)};
#else
        f32x4 h0 = *(const f32x4*)hp, h1 = *(const f32x4*)(hp + 4);
#endif
        h0 += (f32x4){(float)z[0] * sw, (float)z[1] * sw, (float)z[2] * sw, (float)z[3] * sw}; h1 += (f32x4){(float)z[4] * sw, (float)z[5] * sw, (float)z[6] * sw, (float)z[7] * sw};
        if (!RES16 || !hbp) { *(f32x4*)hp = h0; *(f32x4*)(hp + 4) = h1; }
        if (hbp) {
            u32x4 w; w.x = cvtpk(h0[0], h0[1]); w.y = cvtpk(h0[2], h0[3]); w.z = cvtpk(h1[0], h1[1]); w.w = cvtpk(h1[2], h1[3]);
            *(u32x4*)hbp = w;
            ss = (h0[0] * h0[0] + h0[1] * h0[1]) + (h0[2] * h0[2] + h0[3] * h0[3]) + (h1[0] * h1[0] + h1[1] * h1[1]) + (h1[2] * h1[2] + h1[3] * h1[3]);
        }
    }
    if (hbp) {
        ss = dpp_add<0xB1>(ss); ss = dpp_add<0x4E>(ss); ss = dpp_add<0x141>(ss);
        if ((lane & 31) == 0) sspart[lane >> 5] = ss;
    }
}
__device__ __forceinline__ void g5_xload(u32x4& x, const unsigned char* __restrict__ XQ, int t0, int it, int p) {
    x = *(const u32x4*)(XQ + (size_t)(t0 + (it & 15)) * DM + 128 * (it >> 4) + 16 * p);
}

__device__ __forceinline__ void gather5_phase(float* __restrict__ H, bf16_t* __restrict__ HB, const float* __restrict__ ssq2p, float* __restrict__ ssq1,
                                              const unsigned char* __restrict__ U8, const unsigned char* __restrict__ V8, const float* __restrict__ su, const float* __restrict__ sv,
                                              unsigned char* __restrict__ XQ, const int* __restrict__ ids, const float* __restrict__ gw,
                                              const float* __restrict__ final_g, int last, LAS unsigned char* lds, int wave, int gwave, int lane, int dry = 0, int idmask = 0xffff, unsigned char* A8 = nullptr, float* SA = nullptr, const float* SXg = nullptr) {
    LAS unsigned char* wl = lds + wave * G2_WAVE_LDS;
    LAS unsigned short* idl = (LAS unsigned short*)wl;
    LAS float* al = (LAS float*)(wl + 4096);
    LAS float* sxl = (LAS float*)(wl + 4096 + 8192);
    const int t0 = __builtin_amdgcn_readfirstlane(gwave * 16);
    for (int tt = 0; tt < 16; ++tt) {
        idl[tt * 128 + lane] = (unsigned short)(ids[(size_t)(t0 + tt) * 128 + lane] & idmask);
        idl[tt * 128 + 64 + lane] = (unsigned short)(ids[(size_t)(t0 + tt) * 128 + 64 + lane] & idmask);
    }
    for (int e = lane; e < 2048; e += 64) ((LAS int*)al)[e] = 0;
    if (SXg) {
        if (lane < 16) sxl[lane] = SXg[t0 + lane];
#pragma unroll
        for (int i = 0; i < 16; ++i) { const u32x4 t_ = *(const u32x4*)(XQ + (size_t)(t0 + i) * DM + 16 * lane); asm volatile("" :: "v"(t_)); }
    }
    else for (int tt = 0; tt < 16; ++tt) {
        const bf16_t* xr = HB + (size_t)(t0 + tt) * DM + 8 * lane;
        const u32x4 xa = *(const u32x4*)xr, xb = *(const u32x4*)(xr + 512);
        const float f[16] = {bflo(xa.x), bfhi(xa.x), bflo(xa.y), bfhi(xa.y), bflo(xa.z), bfhi(xa.z), bflo(xa.w), bfhi(xa.w),
                             bflo(xb.x), bfhi(xb.x), bflo(xb.y), bfhi(xb.y), bflo(xb.z), bfhi(xb.z), bflo(xb.w), bfhi(xb.w)};
        float am = 0.f;
#pragma unroll
        for (int j = 0; j < 16; ++j) am = fmaxf(am, fabsf(f[j]));
#pragma unroll
        for (int o = 1; o < 64; o <<= 1) am = fmaxf(am, __shfl_xor(am, o));
        const float inv = am > 0.f ? 127.0f / am : 0.f;
        unsigned wq[4];
#pragma unroll
        for (int j = 0; j < 4; ++j) {
            const int q0 = (int)rintf(f[4 * j] * inv), q1 = (int)rintf(f[4 * j + 1] * inv), q2 = (int)rintf(f[4 * j + 2] * inv), q3 = (int)rintf(f[4 * j + 3] * inv);
            wq[j] = (unsigned)(q0 & 255) | ((unsigned)(q1 & 255) << 8) | ((unsigned)(q2 & 255) << 16) | ((unsigned)(q3 & 255) << 24);
        }
        unsigned char* xq = XQ + (size_t)(t0 + tt) * DM + 8 * lane;
        *(u32x2*)xq = (u32x2){wq[0], wq[1]}; *(u32x2*)(xq + 512) = (u32x2){wq[2], wq[3]};
        if (lane == 0) sxl[tt] = am > 0.f ? am / 127.0f : 0.f;
    }
    asm volatile("s_waitcnt vmcnt(0) lgkmcnt(0)" ::: "memory");
    const int g = lane >> 3, p = lane & 7;
    if (!(dry & 2)) {
        u32x4 uA[16], uB[16], xA, xB;
        G4Ids dA, dB;
        g4_ids(dA, idl, 0, g); g4_ids(dB, idl, 1, g);
        g4_rows(uA, U8, dA, 0, p); g5_xload(xA, XQ, t0, 0, p);
        for (int it = 0; it < 128; it += 2) {
            g4_rows(uB, U8, dB, it + 1, p); g5_xload(xB, XQ, t0, it + 1, p);
            g4_ids(dA, idl, (it + 2) & 127, g);
            g5_ucompute(uA, xA, (LAS int*)al + (it & 15) * 128 + g * 16, p);
            if (it + 2 < 128) { g4_rows(uA, U8, dA, it + 2, p); g5_xload(xA, XQ, t0, it + 2, p); }
            g4_ids(dB, idl, (it + 3) & 127, g);
            g5_ucompute(uB, xB, (LAS int*)al + ((it + 1) & 15) * 128 + g * 16, p);
        }
    }
    asm volatile("s_waitcnt lgkmcnt(0)" ::: "memory");
#if G5_VDOT4
    LAS unsigned char* w8l = (LAS unsigned char*)al;
    LAS float* swl = sxl + 16;
    for (int tt = 0; tt < 16; ++tt) {
        const float rs2 = rsqrtf(ssq16(ssq2p, t0 + tt) * (1.0f / 1024.0f) + RMS_EPS) * sxl[tt];
        const int id0 = idl[tt * 128 + lane], id1 = idl[tt * 128 + 64 + lane];
        const float a0 = (float)((LAS int*)al)[tt * 128 + lane] * rs2 * su[id0], a1 = (float)((LAS int*)al)[tt * 128 + 64 + lane] * rs2 * su[id1];
        const float w0 = gw[(size_t)(t0 + tt) * 128 + lane] * gelu_erf(a0) * sv[id0], w1 = gw[(size_t)(t0 + tt) * 128 + 64 + lane] * gelu_erf(a1) * sv[id1];
        float am = fmaxf(fabsf(w0), fabsf(w1));
#pragma unroll
        for (int o = 1; o < 64; o <<= 1) am = fmaxf(am, __shfl_xor(am, o));
        const float inv = am > 0.f ? 127.0f / am : 0.f;
        asm volatile("s_waitcnt lgkmcnt(0)" ::: "memory");
        w8l[tt * 128 + lane] = (unsigned char)((int)rintf(w0 * inv) & 255); w8l[tt * 128 + 64 + lane] = (unsigned char)((int)rintf(w1 * inv) & 255);
        if (lane == 0) swl[tt] = am > 0.f ? am / 127.0f : 0.f;
    }
    asm volatile("s_waitcnt lgkmcnt(0)" ::: "memory");
    const bool fold = (RES16 || !last) && !dry;
    LAS float* ssp = al + 1024;
    if (!(dry & 4)) {
        u32x4 vA[16], vB[16];
        u32x4 hA = {0u, 0u, 0u, 0u}, hB = {0u, 0u, 0u, 0u};
        const bool wlane = (lane & 0x18) == 0;
#define G6_OFF(i_) ((size_t)(t0 + ((i_) & 15)) * DM + 128 * ((i_) >> 4) + 16 * p + 8 * (lane >> 5))
        G4Ids eA, eB;
        g4_ids(eA, idl, 0, g); g4_ids(eB, idl, 1, g);
        g4_rows(vA, V8, eA, 0, p); if (wlane) hA = *(const u32x4*)(HB + G6_OFF(0));
        for (int it = 0; it < 128; it += 2) {
            g4_rows(vB, V8, eB, it + 1, p); if (wlane) hB = *(const u32x4*)(HB + G6_OFF(it + 1));
            g4_ids(eA, idl, (it + 2) & 127, g);
            { const size_t o_ = G6_OFF(it);
              g6_vcompute(vA, w8l + (it & 15) * 128 + g * 16, swl[it & 15], H + o_, lane, dry, fold ? HB + o_ : nullptr, ssp + (it & 15) * 16 + (it >> 4) * 2, hA); }
            if (it + 2 < 128) { g4_rows(vA, V8, eA, it + 2, p); if (wlane) hA = *(const u32x4*)(HB + G6_OFF(it + 2)); }
            g4_ids(eB, idl, (it + 3) & 127, g);
            { const size_t o_ = G6_OFF(it + 1);
              g6_vcompute(vB, w8l + ((it + 1) & 15) * 128 + g * 16, swl[(it + 1) & 15], H + o_, lane, dry, fold ? HB + o_ : nullptr, ssp + ((it + 1) & 15) * 16 + ((it + 1) >> 4) * 2, hB); }
        }
#undef G6_OFF
    }
#else
    for (int n = 0; n < 32; ++n) {
        const int tt = n >> 1, k = lane + 64 * (n & 1);
        const float rs2 = rsqrtf(ssq16(ssq2p, t0 + tt) * (1.0f / 1024.0f) + RMS_EPS);
        const int id = idl[tt * 128 + k];
        const float a = (float)((LAS int*)al)[tt * 128 + k] * (rs2 * sxl[tt]) * su[id];
        al[tt * 128 + k] = gw[(size_t)(t0 + tt) * 128 + k] * gelu_erf(a) * sv[id];
    }
    asm volatile("s_waitcnt lgkmcnt(0)" ::: "memory");
    if (!(dry & 4)) {
        u32x4 vA[16], vB[16];
        g4_issue(vA, V8, idl, 0, g, p);
        for (int it = 0; it < 128; it += 2) {
            g4_issue(vB, V8, idl, it + 1, g, p);
            g5_vcompute(vA, al + (it & 15) * 128 + g * 16, H + (size_t)(t0 + (it & 15)) * DM + 128 * (it >> 4) + 16 * p + 8 * (lane >> 5), lane, dry);
            if (it + 2 < 128) g4_issue(vA, V8, idl, it + 2, g, p);
            g5_vcompute(vB, al + ((it + 1) & 15) * 128 + g * 16, H + (size_t)(t0 + ((it + 1) & 15)) * DM + 128 * ((it + 1) >> 4) + 16 * p + 8 * (lane >> 5), lane, dry);
        }
    }
#endif
    if (dry) return;
#if G5_VDOT4
    if (fold) {
        asm volatile("s_waitcnt lgkmcnt(0)" ::: "memory");
        if (!last) {
            if (lane < 16) { float a_ = 0.f;
#pragma unroll
                for (int q_ = 0; q_ < 16; ++q_) a_ += ssp[lane * 16 + q_];
                ssq1[t0 + lane] = a_; }
#if IN_I8
            asm volatile("s_waitcnt vmcnt(0)" ::: "memory");
            if (TAIL_FENCE_LIGHT) __builtin_amdgcn_fence(__ATOMIC_ACQUIRE, "agent"); else __builtin_amdgcn_fence(__ATOMIC_SEQ_CST, "agent");
            asm volatile("s_waitcnt vmcnt(0)" ::: "memory");
            for (int hb_ = 0; hb_ < 2; ++hb_) {
                u32x4 xa[8], xb[8];
#pragma unroll
                for (int tt = 0; tt < 8; ++tt) { const bf16_t* xr = HB + (size_t)(t0 + 8 * hb_ + tt) * DM + 8 * lane; xa[tt] = *(const u32x4*)xr; xb[tt] = *(const u32x4*)(xr + 512); }
#pragma unroll
                for (int tt = 0; tt < 8; ++tt) {
                    const float f[16] = {bflo(xa[tt].x), bfhi(xa[tt].x), bflo(xa[tt].y), bfhi(xa[tt].y), bflo(xa[tt].z), bfhi(xa[tt].z), bflo(xa[tt].w), bfhi(xa[tt].w),
                                         bflo(xb[tt].x), bfhi(xb[tt].x), bflo(xb[tt].y), bfhi(xb[tt].y), bflo(xb[tt].z), bfhi(xb[tt].z), bflo(xb[tt].w), bfhi(xb[tt].w)};
                    quant_arow_i8(f, A8 + (size_t)(t0 + 8 * hb_ + tt) * DM, SA + t0 + 8 * hb_ + tt, lane);
                }
            }
#endif
            return;
        }
        asm volatile("s_waitcnt vmcnt(0)" ::: "memory");
        if (TAIL_FENCE_LIGHT) __builtin_amdgcn_fence(__ATOMIC_ACQUIRE, "agent"); else __builtin_amdgcn_fence(__ATOMIC_SEQ_CST, "agent");
        asm volatile("s_waitcnt vmcnt(0)" ::: "memory");
        const f32x4 g0 = *(const f32x4*)(final_g + 8 * lane), g1 = *(const f32x4*)(final_g + 8 * lane + 4), g2 = *(const f32x4*)(final_g + 512 + 8 * lane), g3 = *(const f32x4*)(final_g + 516 + 8 * lane);
        for (int tt = 0; tt < 16; ++tt) {
            const int t = t0 + tt;
            float ss = 0.f;
#pragma unroll
            for (int q_ = 0; q_ < 16; ++q_) ss += ssp[tt * 16 + q_];
            float rs = rsqrtf(ss * (1.0f / 1024.0f) + RMS_EPS);
            const bf16_t* bp = HB + (size_t)t * DM + 8 * lane;
            const u32x4 a_ = *(const u32x4*)bp, b_ = *(const u32x4*)(bp + 512);
            float* hp = H + (size_t)t * DM + 8 * lane;
            const f32x4 h0 = (f32x4){bflo(a_.x), bfhi(a_.x), bflo(a_.y), bfhi(a_.y)} * rs * g0, h1 = (f32x4){bflo(a_.z), bfhi(a_.z), bflo(a_.w), bfhi(a_.w)} * rs * g1;
            const f32x4 h2 = (f32x4){bflo(b_.x), bfhi(b_.x), bflo(b_.y), bfhi(b_.y)} * rs * g2, h3 = (f32x4){bflo(b_.z), bfhi(b_.z), bflo(b_.w), bfhi(b_.w)} * rs * g3;
            __builtin_nontemporal_store(h0, (f32x4*)hp); __builtin_nontemporal_store(h1, (f32x4*)(hp + 4)); __builtin_nontemporal_store(h2, (f32x4*)(hp + 512)); __builtin_nontemporal_store(h3, (f32x4*)(hp + 516));
        }
        return;
    }
#endif
    __builtin_amdgcn_fence(__ATOMIC_SEQ_CST, "agent");
    asm volatile("s_waitcnt vmcnt(0)" ::: "memory");
    for (int tt = 0; tt < 16; ++tt) {
        const int t = t0 + tt;
        float* hp = H + (size_t)t * DM + 8 * lane;
        f32x4 h0 = *(const f32x4*)hp, h1 = *(const f32x4*)(hp + 4), h2 = *(const f32x4*)(hp + 512), h3 = *(const f32x4*)(hp + 516);
        float ss = (h0[0] * h0[0] + h0[1] * h0[1]) + (h0[2] * h0[2] + h0[3] * h0[3]) + (h1[0] * h1[0] + h1[1] * h1[1]) + (h1[2] * h1[2] + h1[3] * h1[3])
                 + (h2[0] * h2[0] + h2[1] * h2[1]) + (h2[2] * h2[2] + h2[3] * h2[3]) + (h3[0] * h3[0] + h3[1] * h3[1]) + (h3[2] * h3[2] + h3[3] * h3[3]);
        ss = wave_sum(ss);
        if (last) {
            const float rs = rsqrtf(ss * (1.0f / 1024.0f) + RMS_EPS);
            const f32x4 g0 = *(const f32x4*)(final_g + 8 * lane), g1 = *(const f32x4*)(final_g + 8 * lane + 4), g2 = *(const f32x4*)(final_g + 512 + 8 * lane), g3 = *(const f32x4*)(final_g + 516 + 8 * lane);
            h0 = h0 * rs * g0; h1 = h1 * rs * g1; h2 = h2 * rs * g2; h3 = h3 * rs * g3;
            *(f32x4*)hp = h0; *(f32x4*)(hp + 4) = h1; *(f32x4*)(hp + 512) = h2; *(f32x4*)(hp + 516) = h3;
        } else {
            bf16_t* bp = HB + (size_t)t * DM + 8 * lane;
            u32x4 w; w.x = cvtpk(h0[0], h0[1]); w.y = cvtpk(h0[2], h0[3]); w.z = cvtpk(h1[0], h1[1]); w.w = cvtpk(h1[2], h1[3]);
            *(u32x4*)bp = w;
            w.x = cvtpk(h2[0], h2[1]); w.y = cvtpk(h2[2], h2[3]); w.z = cvtpk(h3[0], h3[1]); w.w = cvtpk(h3[2], h3[3]);
            *(u32x4*)(bp + 512) = w;
            if (lane == 0) ssq1[t] = ss;
        }
    }
}

__device__ __forceinline__ float gelu_erf(float x) { return 0.5f * x * (1.0f + erff(x * 0.70710678118654752f)); }

__device__ __forceinline__ void gather_phase(float* __restrict__ H, bf16_t* __restrict__ HB, const float* __restrict__ ssq2, float* __restrict__ ssq1,
                                             const bf16_t* __restrict__ U16, const bf16_t* __restrict__ V16, const int* __restrict__ ids, const float* __restrict__ gw,
                                             const float* __restrict__ final_g, int last, int gwave, int ngw, int lane, int dry = 0, int idmask = 0xffff) {
    for (int t0 = gwave; t0 < T; t0 += ngw) {
        const int t = __builtin_amdgcn_readfirstlane(t0);
        const u32x4 xa = *(const u32x4*)(HB + (size_t)t * DM + 8 * lane), xb = *(const u32x4*)(HB + (size_t)t * DM + 512 + 8 * lane);
        const float rs2 = rsqrtf(ssq16(ssq2, t) * (1.0f / 1024.0f) + RMS_EPS);
        float y[16];
#pragma unroll
        for (int i = 0; i < 16; ++i) y[i] = 0.f;
        const int* idp = ids + (size_t)t * 128; const float* gp = gw + (size_t)t * 128;
        for (int c = 0; c < 16; ++c) {
            u32x4 ua[8], ub[8], va[8], vb[8]; float g[8];
#pragma unroll
            for (int e = 0; e < 8; ++e) {
                const int id = __builtin_amdgcn_readfirstlane(idp[c * 8 + e]) & idmask;
                g[e] = gp[c * 8 + e];
                const bf16_t* ur = U16 + (size_t)id * DM + 8 * lane; const bf16_t* vr = V16 + (size_t)id * DM + 8 * lane;
                ua[e] = *(const u32x4*)ur; ub[e] = *(const u32x4*)(ur + 512); va[e] = *(const u32x4*)vr; vb[e] = *(const u32x4*)(vr + 512);
            }
#pragma unroll
            for (int e = 0; e < 8; ++e) {
                float a = 0.f;
                a = dot2bf(xa.x, ua[e].x, a); a = dot2bf(xa.y, ua[e].y, a); a = dot2bf(xa.z, ua[e].z, a); a = dot2bf(xa.w, ua[e].w, a);
                a = dot2bf(xb.x, ub[e].x, a); a = dot2bf(xb.y, ub[e].y, a); a = dot2bf(xb.z, ub[e].z, a); a = dot2bf(xb.w, ub[e].w, a);
                a = wave_sum(a);
                const float w = g[e] * gelu_erf(a * rs2);
                y[0] = fmaf(w, bflo(va[e].x), y[0]); y[1] = fmaf(w, bfhi(va[e].x), y[1]); y[2] = fmaf(w, bflo(va[e].y), y[2]); y[3] = fmaf(w, bfhi(va[e].y), y[3]);
                y[4] = fmaf(w, bflo(va[e].z), y[4]); y[5] = fmaf(w, bfhi(va[e].z), y[5]); y[6] = fmaf(w, bflo(va[e].w), y[6]); y[7] = fmaf(w, bfhi(va[e].w), y[7]);
                y[8] = fmaf(w, bflo(vb[e].x), y[8]); y[9] = fmaf(w, bfhi(vb[e].x), y[9]); y[10] = fmaf(w, bflo(vb[e].y), y[10]); y[11] = fmaf(w, bfhi(vb[e].y), y[11]);
                y[12] = fmaf(w, bflo(vb[e].z), y[12]); y[13] = fmaf(w, bfhi(vb[e].z), y[13]); y[14] = fmaf(w, bflo(vb[e].w), y[14]); y[15] = fmaf(w, bfhi(vb[e].w), y[15]);
            }
        }
        float* hp = H + (size_t)t * DM + 8 * lane;
        f32x4 h0 = *(const f32x4*)hp, h1 = *(const f32x4*)(hp + 4), h2 = *(const f32x4*)(hp + 512), h3 = *(const f32x4*)(hp + 516);
        h0 += (f32x4){y[0], y[1], y[2], y[3]}; h1 += (f32x4){y[4], y[5], y[6], y[7]}; h2 += (f32x4){y[8], y[9], y[10], y[11]}; h3 += (f32x4){y[12], y[13], y[14], y[15]};
        float ss = (h0[0] * h0[0] + h0[1] * h0[1]) + (h0[2] * h0[2] + h0[3] * h0[3]) + (h1[0] * h1[0] + h1[1] * h1[1]) + (h1[2] * h1[2] + h1[3] * h1[3])
                 + (h2[0] * h2[0] + h2[1] * h2[1]) + (h2[2] * h2[2] + h2[3] * h2[3]) + (h3[0] * h3[0] + h3[1] * h3[1]) + (h3[2] * h3[2] + h3[3] * h3[3]);
        ss = wave_sum(ss);
        if (dry && ss >= 0.f) continue;
        if (last) {
            const float rs = rsqrtf(ss * (1.0f / 1024.0f) + RMS_EPS);
            const f32x4 g0 = *(const f32x4*)(final_g + 8 * lane), g1 = *(const f32x4*)(final_g + 8 * lane + 4), g2 = *(const f32x4*)(final_g + 512 + 8 * lane), g3 = *(const f32x4*)(final_g + 516 + 8 * lane);
            h0 = h0 * rs * g0; h1 = h1 * rs * g1; h2 = h2 * rs * g2; h3 = h3 * rs * g3;
            *(f32x4*)hp = h0; *(f32x4*)(hp + 4) = h1; *(f32x4*)(hp + 512) = h2; *(f32x4*)(hp + 516) = h3;
        } else {
            *(f32x4*)hp = h0; *(f32x4*)(hp + 4) = h1; *(f32x4*)(hp + 512) = h2; *(f32x4*)(hp + 516) = h3;
            bf16_t* bp = HB + (size_t)t * DM + 8 * lane;
            u32x4 w; w.x = cvtpk(h0[0], h0[1]); w.y = cvtpk(h0[2], h0[3]); w.z = cvtpk(h1[0], h1[1]); w.w = cvtpk(h1[2], h1[3]);
            *(u32x4*)bp = w;
            w.x = cvtpk(h2[0], h2[1]); w.y = cvtpk(h2[2], h2[3]); w.z = cvtpk(h3[0], h3[1]); w.w = cvtpk(h3[2], h3[3]);
            *(u32x4*)(bp + 512) = w;
            if (lane == 0) ssq1[t] = ss;
        }
    }
}

#define XB_TMO      128
#define XB_XCNT(j)  (256  + 64 * (j))
#define XB_XSUB(j)  (1280 + 64 * (j))
#define XB_XGEN(j)  (2304 + 64 * (j))
#define XB_TOP      3328
#define XB_TOPGEN   3392
#define XCD_BAR_WORDS 3456
#define XB_SPIN_CAP (1u << 18)

__device__ __forceinline__ unsigned xb_ld(unsigned* p)              { return __hip_atomic_load(p, __ATOMIC_RELAXED, __HIP_MEMORY_SCOPE_AGENT); }
__device__ __forceinline__ unsigned xb_add(unsigned* p, unsigned v) { return __hip_atomic_fetch_add(p, v, __ATOMIC_RELAXED, __HIP_MEMORY_SCOPE_AGENT); }
__device__ __forceinline__ unsigned xb_xcc_id() { return (unsigned)__builtin_amdgcn_s_getreg((3 << 11) | 20) & 0xFu; }
#define XB_SPIN(cond, bar) do { unsigned _sp = 0; while (cond) { __builtin_amdgcn_s_sleep(1); \
    if ((++_sp & 255u) == 0u) { if (xb_ld(&(bar)[XB_TMO])) break; if (_sp > XB_SPIN_CAP) { atomicAdd(&(bar)[XB_TMO], 1u); break; } } } } while (0)

struct XcdBarrier {
    unsigned* bar; unsigned x;
    volatile LAS unsigned* st;
};

__device__ __forceinline__ XcdBarrier xcd_barrier_post(unsigned* bar, volatile LAS unsigned* st, int tid) {
    XcdBarrier b; b.bar = bar; b.x = xb_xcc_id(); b.st = st;
    if (tid == 0) (void)xb_add(&bar[XB_XCNT(b.x)], 1u);
    return b;
}
__device__ __forceinline__ void xcd_barrier_complete(unsigned* bar, unsigned x, unsigned& nloc, unsigned& nx) {
    const unsigned G = gridDim.x * gridDim.y * gridDim.z;
    unsigned sum, cnt, mine, sp = 0u;
    for (;;) {
        sum = 0u; cnt = 0u; mine = 0u;
#pragma unroll
        for (unsigned j = 0; j < 16; ++j) { const unsigned c = xb_ld(&bar[XB_XCNT(j)]); sum += c; cnt += (c > 0u) ? 1u : 0u; mine = (j == x) ? c : mine; }
        if (sum == G) break;
        __builtin_amdgcn_s_sleep(1);
        if ((++sp & 255u) == 0u) { if (xb_ld(&bar[XB_TMO])) break; if (sp > XB_SPIN_CAP) { atomicAdd(&bar[XB_TMO], 1u); break; } }
    }
    nloc = mine > 0u ? mine : 1u; nx = cnt > 0u ? cnt : 1u;
}

__device__ __forceinline__ void xcd_barrier(const XcdBarrier& b, int tid) {
    asm volatile("s_waitcnt vmcnt(0)" ::: "memory");
    __syncthreads();
    if (tid == 0) {
        unsigned* bar = b.bar;
        __builtin_amdgcn_s_waitcnt(0);
        unsigned nloc = b.st[0], nx = b.st[1];
        if (nloc == 0u) { xcd_barrier_complete(bar, b.x, nloc, nx); b.st[0] = nloc; b.st[1] = nx; }
        const unsigned old = xb_add(&bar[XB_XSUB(b.x)], 1u);
        const unsigned gen = old / nloc;
        if (old + 1u == (gen + 1u) * nloc) {
            __builtin_amdgcn_fence(__ATOMIC_RELEASE, "agent");
            asm volatile("s_waitcnt vmcnt(0)" ::: "memory");
            const unsigned og = xb_add(&bar[XB_TOP], 1u);
            const unsigned tg = og / nx;
            if (og + 1u == (tg + 1u) * nx) xb_add(&bar[XB_TOPGEN], 1u);
            else XB_SPIN(xb_ld(&bar[XB_TOPGEN]) == tg, bar);
            __builtin_amdgcn_fence(__ATOMIC_ACQUIRE, "agent");
            xb_add(&bar[XB_XGEN(b.x)], 1u);
            asm volatile("s_waitcnt vmcnt(0)" ::: "memory");
        } else {
            XB_SPIN(xb_ld(&bar[XB_XGEN(b.x)]) == gen, bar);
            __builtin_amdgcn_fence(__ATOMIC_ACQUIRE, "agent");
            asm volatile("s_waitcnt vmcnt(0)" ::: "memory");
        }
    }
    __syncthreads();
}
struct Params { const float* in[18]; float* out; unsigned char* ws; int ph_lo, ph_hi; };

typedef const __attribute__((address_space(4))) Params* KP;
#define KARGS() KP pp = (KP)__builtin_amdgcn_kernarg_segment_ptr(); asm volatile("" : "+s"(pp))
#ifndef PEER_FP8
#define PEER_FP8 1
#endif
#ifndef PEER_I8
#define PEER_I8 1
#endif
#ifndef G4P
#define G4P 0
#endif
#ifndef STAGGER_TICKS
#define STAGGER_TICKS 0
#endif
#ifndef PROBE_DUP
#define PROBE_DUP 0
#endif
#define PH_ON(k, bit) ((PH_MASK & (bit)) && ph_lo <= (k) && (k) < ph_hi)
constexpr int CW_BAR = 4096;
constexpr int MISC_OFF = 131072 + 320;
__device__ __forceinline__ int lane_id_opaque() { int l; asm volatile("v_mbcnt_lo_u32_b32 %0, -1, 0\n\tv_mbcnt_hi_u32_b32 %0, -1, %0" : "=v"(l)); return l; }
#define PH_SYNC(k) do { if ((k) > ph_lo) { { KP pq = (KP)__builtin_amdgcn_kernarg_segment_ptr(); \
    XcdBarrier xb_; xb_.bar = (unsigned*)(pq->ws + WS_CTL) + CW_BAR; xb_.x = xb_xcc_id(); xb_.st = (volatile LAS unsigned*)(lds + MISC_OFF) + 8; xcd_barrier(xb_, tid); if (PROBE_DUP == 15) { xcd_barrier(xb_, tid); xcd_barrier(xb_, tid); } } } } while (0)
#define PH_IDS() const int lane = lane_id_opaque(); const int tid = wave * 64 + lane

__device__ __forceinline__ void weight_prep(KP pp, int l, LAS float* scr, int gw0, int ngw, int lane) {
    unsigned char* wl = pp->ws + WS_W + (size_t)l * WL_STRIDE;
    const float* g1 = pp->in[2] + (size_t)l * DM; const float* g2 = pp->in[11] + (size_t)l * DM;
    constexpr int N_BR = 3 * 192, N_OUT = 512, N_INQ = N_IN / 8, N_QQ = 2048 / 8;
    static_assert(IN_I8 && Q_I8 && IN_I8_LAYERS == 3, "the flat weight-preparation list is written for the int8 in-projection and query projection");
    for (int it = gw0; it < N_BR + N_OUT + N_INQ + N_QQ; it += ngw) {
        if (it < N_BR) { const int i = it / 192, j = it - 192 * i;
            transpose_item<0>(pp->in[7 + i] + (size_t)l * 384 * DM, 384, DM, (bf16_t*)(wl + WL_BR) + (size_t)i * DM * 384, nullptr, scr, j, 32, lane); }
        else if (it < N_BR + N_OUT) transpose_item<0>(pp->in[10] + (size_t)l * DM * DM, DM, DM, (bf16_t*)(wl + WL_OUT), nullptr, scr, it - N_BR, 32, lane);
        else if (it < N_BR + N_OUT + N_INQ) quant_win_item(pp->in[3] + (size_t)l * DM * IN_COLS, g1, wl + WL_IN, (float*)(wl + WL_INSC), it - N_BR - N_OUT, lane);
        else quant_win_item<0, 2048>(pp->in[12] + (size_t)l * DM * 2048, g2, wl + WL_Q, (float*)(wl + WL_Q + WL_QSC), it - N_BR - N_OUT - N_INQ, lane);
    }
}

template <int l>
__device__ __forceinline__ void layer_phases(const int ph_lo, const int ph_hi, LAS unsigned char* lds, const int wave) {
    constexpr int pb = 1 + 8 * l;
        if (PH_ON(pb + 0, 2)) {
            PH_IDS(); PH_SYNC(pb + 0); KARGS();
            unsigned char* ws = pp->ws; unsigned char* wl = ws + WS_W + (size_t)l * WL_STRIDE;
            const int G = gridDim.x;
            constexpr bool I8L = IN_I8 && ((IN_I8_LAYERS >> l) & 1);
            pg8::Gemm g{(const bf16_t*)(ws + (I8L ? WS_A8 : WS_HB)), (const bf16_t*)(wl + WL_IN), T, N_IN, I8L ? DM / 2 : DM, I8L ? DM / 2 : DM};
            pg8::StaticOrder S; S.init(T, N_IN, G, (int)blockIdx.x);
            EpiInT<I8L> E{(bf16_t*)(ws + WS_P), (bf16_t*)(ws + WS_G), (const float*)(ws + WS_SSQ1), (const float*)(ws + WS_ROPE), pp->in[6] + (size_t)l * 3 * DM, pp->in[4] + (size_t)l * 6, (float*)(ws + WS_LOGF), 0,
                    (const float*)(ws + WS_SA), (const float*)(wl + WL_INSC)};
            if (STAGGER_TICKS > 0 && (blockIdx.x & 1)) { const unsigned long long t0_ = __builtin_amdgcn_s_memrealtime(); while (__builtin_amdgcn_s_memrealtime() - t0_ < (unsigned long long)STAGGER_TICKS) __builtin_amdgcn_s_sleep(20); }
            pg8::gemm_phase<EpiInT<I8L>, pg8::StaticOrder, true, true, I8L>(lds, g, S, E, tid);
            if (PROBE_DUP == 1) { __syncthreads(); pg8::gemm_phase<EpiInT<I8L>, pg8::StaticOrder, true, true, I8L>(lds, g, S, E, tid); }
            if (PROBE_DUP == 13) { __syncthreads(); EpiInT<I8L> En = E; En.nostore = 1; pg8::gemm_phase<EpiInT<I8L>, pg8::StaticOrder, true, true, I8L>(lds, g, S, En, tid); }
            if (PROBE_DUP == 12) { __syncthreads(); EpiDry Ed{(float*)(ws + WS_CTL) + 8192}; pg8::gemm_phase<EpiDry, pg8::StaticOrder, true, true>(lds, g, S, Ed, tid); }
        }
        if (PH_ON(pb + 1, 4)) {
            PH_IDS(); PH_SYNC(pb + 1); KARGS();
            float* logf = (float*)(pp->ws + WS_LOGF); float* cumT = (float*)(pp->ws + WS_CUMT);
            LAS float* wt = (LAS float*)lds;
            for (int r = (int)blockIdx.x * 512 + tid; r < BATCH * 6 * SEQ; r += (int)gridDim.x * 512) {
                const int sq = r >> 13, sp_ = r & (SEQ - 1), b = sq / 6, h = sq % 6;
                const bf16_t* kr = (const bf16_t*)(pp->ws + WS_P) + ((size_t)b * SEQ + sp_) * NP + PC_KB + 64 * h;
                float n2 = 0.f;
#pragma unroll
                for (int c = 0; c < 8; ++c) { const u32x4 kk = *(const u32x4*)(kr + 8 * c);
                    n2 += (bflo(kk.x) * bflo(kk.x) + bfhi(kk.x) * bfhi(kk.x)) + (bflo(kk.y) * bflo(kk.y) + bfhi(kk.y) * bfhi(kk.y)) + (bflo(kk.z) * bflo(kk.z) + bfhi(kk.z) * bfhi(kk.z)) + (bflo(kk.w) * bflo(kk.w) + bfhi(kk.w) * bfhi(kk.w)); }
#pragma unroll
                for (int o = 1; o < 64; o <<= 1) n2 = fmaxf(n2, __shfl_xor(n2, o));
                if (lane == 0) atomicMax((unsigned*)(pp->ws + WS_KMAX_BASE + 256 * l) + sq, __float_as_uint(n2));
            }
            if (l + 1 < DEPTH && (int)blockIdx.x >= BATCH * 6 && (int)gridDim.x > BATCH * 6)
                weight_prep(pp, l + 1, (LAS float*)(lds + wave * 8448), ((int)blockIdx.x - BATCH * 6) * 8 + wave, ((int)gridDim.x - BATCH * 6) * 8, lane);
            for (int sq = blockIdx.x; sq < BATCH * 6; sq += gridDim.x) {
                const int b = sq / 6, h = sq % 6;
                float* base = logf + (size_t)b * SEQ * 8 + h;
                float v[16]; float run = 0.f;
#pragma unroll
                for (int i = 0; i < 16; ++i) { run += base[(size_t)(tid * 16 + i) * 8]; v[i] = run; }
                float inc = run;
#pragma unroll
                for (int o = 1; o < 64; o <<= 1) { const float n = __shfl_up(inc, o); if (lane >= o) inc += n; }
                __syncthreads();
                if (lane == 63) wt[wave] = inc;
                __syncthreads();
                float off = inc - run;
                for (int w = 0; w < wave; ++w) off += wt[w];
#pragma unroll
                for (int i = 0; i < 16; ++i) cumT[(size_t)sq * SEQ + tid * 16 + i] = (v[i] + off) * LOG2E;
            }
        }
        if (PH_ON(pb + 2, 8)) {
            PH_IDS(); PH_SYNC(pb + 2); KARGS();
            if (ATT_XCD && MIXA_3PASS == 0) attention_phase_x(pp->ws, pp->in[5] + (size_t)l * 6, CW_ATT + 64 * l, (int)(WS_KMAX_BASE / 4) + 64 * l, lds, wave, lane, (int)xb_xcc_id());
            else attention_phase(pp->ws, pp->in[5] + (size_t)l * 6, CW_ATT + 64 * l, CW_GRP + 512 * l, (int)(WS_KMAX_BASE / 4) + 64 * l, lds, wave, lane, 0);
            if (PROBE_DUP == 21) { __syncthreads(); KP pq3 = (KP)__builtin_amdgcn_kernarg_segment_ptr(); attention_phase(pq3->ws, pq3->in[5] + (size_t)l * 6, CW_ATT + 64 * l + 16, CW_GRP + 512 * l, (int)(WS_KMAX_BASE / 4) + 64 * l, lds, wave, lane, 1); }
        }
        if (PH_ON(pb + 3, 16)) {
            PH_IDS(); PH_SYNC(pb + 3); KARGS();
            unsigned char* ws = pp->ws; unsigned char* wl = ws + WS_W + (size_t)l * WL_STRIDE;
            bf16_t* P = (bf16_t*)(ws + WS_P);
            for (int rep = 0; rep < (PROBE_DUP == 6 ? 2 : 1); ++rep) {
                pg8::Gemm g{P, (const bf16_t*)(wl + WL_BR), T, DM, 384, NP};
                BranchOrder S; S.init(T, DM, (int)gridDim.x, (int)blockIdx.x);
                EpiBrChain E{(const unsigned char*)(ws + WS_G), P + PC_MERGED};
                pg8::gemm_phase<EpiBrChain, BranchOrder, true, true>(lds, g, S, E, tid);
                __syncthreads();
            }
        }
        if (PH_ON(pb + 4, 32)) {
            PH_IDS(); PH_SYNC(pb + 4); KARGS();
            unsigned char* ws = pp->ws; unsigned char* wl = ws + WS_W + (size_t)l * WL_STRIDE;
            pg8::Gemm g{(const bf16_t*)(ws + WS_P) + PC_MERGED, (const bf16_t*)(wl + WL_OUT), T, DM, DM, NP};
            pg8::StaticOrder S; S.init(T, DM, (int)gridDim.x, (int)blockIdx.x);
            EpiOut E{l == 0 ? pp->in[0] : pp->out, pp->out, (bf16_t*)(ws + WS_HB), (float*)(ws + WS_SSQ2P)};
            pg8::gemm_phase<EpiOut, pg8::StaticOrder, true, true>(lds, g, S, E, tid);
            if (PROBE_DUP == 14 && l == 0) { __syncthreads(); pg8::gemm_phase<EpiOut, pg8::StaticOrder, true, true>(lds, g, S, E, tid); }
        }
        if (PH_ON(pb + 5, 64)) {
            PH_IDS(); PH_SYNC(pb + 5); KARGS();
            unsigned char* ws = pp->ws; unsigned char* wl = ws + WS_W + (size_t)l * WL_STRIDE;
            for (int rep = 0; rep < (PROBE_DUP == 7 ? 2 : 1); ++rep) {
            {
                if (Q_I8) {
                    const int t0_ = ((int)blockIdx.x * 8 + wave) * 16;
                    for (int hb_ = 0; hb_ < (PROBE_DUP == 18 ? 8 : 2); ++hb_) {
                        u32x4 xa[8], xb[8];
#pragma unroll
                        for (int tt = 0; tt < 8; ++tt) { const bf16_t* xr = (const bf16_t*)(ws + WS_HB) + (size_t)(t0_ + 8 * (hb_ & 1) + tt) * DM + 8 * lane; xa[tt] = *(const u32x4*)xr; xb[tt] = *(const u32x4*)(xr + 512); }
#pragma unroll
                        for (int tt = 0; tt < 8; ++tt) {
                            const float f[16] = {bflo(xa[tt].x), bfhi(xa[tt].x), bflo(xa[tt].y), bfhi(xa[tt].y), bflo(xa[tt].z), bfhi(xa[tt].z), bflo(xa[tt].w), bfhi(xa[tt].w),
                                                 bflo(xb[tt].x), bfhi(xb[tt].x), bflo(xb[tt].y), bfhi(xb[tt].y), bflo(xb[tt].z), bfhi(xb[tt].z), bflo(xb[tt].w), bfhi(xb[tt].w)};
                            quant_arow_i8(f, ws + WS_XQ + (size_t)(t0_ + 8 * (hb_ & 1) + tt) * DM, (float*)(ws + WS_SX) + t0_ + 8 * (hb_ & 1) + tt, lane);
                        }
                    }
                    { KP pq = (KP)__builtin_amdgcn_kernarg_segment_ptr(); XcdBarrier xb_; xb_.bar = (unsigned*)(pq->ws + WS_CTL) + CW_BAR; xb_.x = xb_xcc_id(); xb_.st = (volatile LAS unsigned*)(lds + MISC_OFF) + 8; xcd_barrier(xb_, tid); }
                }
                pg8::Gemm g{(const bf16_t*)(ws + (Q_I8 ? WS_XQ : WS_HB)), (const bf16_t*)(wl + WL_Q), T, 2048, Q_I8 ? DM / 2 : DM, Q_I8 ? DM / 2 : DM};
                pg8::StaticOrder S; S.init(T, 2048, (int)gridDim.x, (int)blockIdx.x);
                EpiQT<Q_I8 != 0> E{(bf16_t*)(ws + WS_Q2), (const float*)(ws + WS_SSQ2P), (const float*)(ws + WS_SX), (const float*)(wl + WL_Q + WL_QSC)};
                pg8::gemm_phase<EpiQT<Q_I8 != 0>, pg8::StaticOrder, true, true, Q_I8 != 0>(lds, g, S, E, tid);
                if (PROBE_DUP == 17) { __syncthreads(); pg8::gemm_phase<EpiQT<Q_I8 != 0>, pg8::StaticOrder, true, true, Q_I8 != 0>(lds, g, S, E, tid); }
            }
            __syncthreads();
            }
        }
        if (PH_ON(pb + 6, 128)) {
            PH_IDS(); PH_SYNC(pb + 6); KARGS();
            unsigned char* ws = pp->ws;
            if (PROBE_DUP == 3) { routing_phase((const bf16_t*)(ws + WS_Q2), pp->in[13] + (size_t)l * 128 * 128, pp->in[14] + (size_t)l * 128 * 128, (int*)(ws + WS_IDS), (float*)(ws + WS_GW), lds, tid); __syncthreads(); }
            routing2_setup(pp->in[13] + (size_t)l * 128 * 128, pp->in[14] + (size_t)l * 128 * 128, lds, tid);
            if (wave < 4) routing2_units((const bf16_t*)(ws + WS_Q2), (int*)(ws + WS_IDS), (float*)(ws + WS_GW), lds, wave, lane, (int)blockIdx.x * 8 + wave, (int)gridDim.x * 8);
            if (PEER_I8) {
                const float* u = pp->in[15] + (size_t)l * N_EXP * DM; const float* v = pp->in[16] + (size_t)l * N_EXP * DM;
                const float* g2 = pp->in[11] + (size_t)l * DM;
                for (int r = (int)blockIdx.x * 8 + wave; r < N_EXP; r += (int)gridDim.x * 8) {
                    quant_row_i8(u + (size_t)r * DM, g2, ws + WS_U8 + (size_t)r * DM, (float*)(ws + WS_SU) + r, 0, lane);
                    quant_row_i8(v + (size_t)r * DM, nullptr, ws + WS_V8 + (size_t)r * DM, (float*)(ws + WS_SV) + r, G5_VDOT4 ? 0 : 128, lane);
                }
            } else if (PEER_FP8) {
                const float* u = pp->in[15] + (size_t)l * N_EXP * DM; const float* v = pp->in[16] + (size_t)l * N_EXP * DM;
                const float* g2 = pp->in[11] + (size_t)l * DM;
                for (int r = (int)blockIdx.x * 8 + wave; r < N_EXP; r += (int)gridDim.x * 8) {
                    quant_row_fp8(u + (size_t)r * DM, g2, ws + WS_U8 + (size_t)r * DM, (float*)(ws + WS_SU) + r, lane);
                    quant_row_fp8(v + (size_t)r * DM, nullptr, ws + WS_V8 + (size_t)r * DM, (float*)(ws + WS_SV) + r, lane);
                }
            } else {
                const float* u = pp->in[15] + (size_t)l * N_EXP * DM; const float* v = pp->in[16] + (size_t)l * N_EXP * DM;
                const float* g2 = pp->in[11] + (size_t)l * DM;
                bf16_t* U16 = (bf16_t*)(ws + WS_U16); bf16_t* V16 = (bf16_t*)(ws + WS_V16);
                for (unsigned e = blockIdx.x * 512 + tid; e < (unsigned)(N_EXP * DM / 8); e += gridDim.x * 512) {
                    const unsigned o = e * 8; const int c = (int)(o & (DM - 1));
                    const f32x4 a0 = *(const f32x4*)(u + o), a1 = *(const f32x4*)(u + o + 4), s0 = *(const f32x4*)(g2 + c), s1 = *(const f32x4*)(g2 + c + 4);
                    u32x4 w; w.x = cvtpk(a0[0] * s0[0], a0[1] * s0[1]); w.y = cvtpk(a0[2] * s0[2], a0[3] * s0[3]); w.z = cvtpk(a1[0] * s1[0], a1[1] * s1[1]); w.w = cvtpk(a1[2] * s1[2], a1[3] * s1[3]);
                    *(u32x4*)(U16 + o) = w;
                    const f32x4 b0 = *(const f32x4*)(v + o), b1 = *(const f32x4*)(v + o + 4);
                    if (G3_VF16) { w.x = cvtpk_h(b0[0], b0[1]); w.y = cvtpk_h(b0[2], b0[3]); w.z = cvtpk_h(b1[0], b1[1]); w.w = cvtpk_h(b1[2], b1[3]); }
                    else { w.x = cvtpk(b0[0], b0[1]); w.y = cvtpk(b0[2], b0[3]); w.z = cvtpk(b1[0], b1[1]); w.w = cvtpk(b1[2], b1[3]); }
                    *(u32x4*)(V16 + o) = w;
                }
            }
            if (wave >= 4) routing2_units((const bf16_t*)(ws + WS_Q2), (int*)(ws + WS_IDS), (float*)(ws + WS_GW), lds, wave, lane, (int)blockIdx.x * 8 + wave, (int)gridDim.x * 8);
            if (PROBE_DUP == 19) routing2_units((const bf16_t*)(ws + WS_Q2), (int*)(ws + WS_IDS), (float*)(ws + WS_GW), lds, wave, lane, (int)blockIdx.x * 8 + wave, (int)gridDim.x * 8);
        }
        if (PH_ON(pb + 7, 256)) {
            PH_IDS(); PH_SYNC(pb + 7); KARGS();
            unsigned char* ws = pp->ws;
            if (PROBE_DUP == 4) gather_phase(pp->out, (bf16_t*)(ws + WS_HB), (const float*)(ws + WS_SSQ2P), (float*)(ws + WS_SSQ1), (const bf16_t*)(ws + WS_U16), (const bf16_t*)(ws + WS_V16),
                         (const int*)(ws + WS_IDS), (const float*)(ws + WS_GW), pp->in[17], l == DEPTH - 1 ? 1 : 0, (int)blockIdx.x * 8 + wave, (int)gridDim.x * 8, lane, 1);
            if (PROBE_DUP == 5) gather_phase(pp->out, (bf16_t*)(ws + WS_HB), (const float*)(ws + WS_SSQ2P), (float*)(ws + WS_SSQ1), (const bf16_t*)(ws + WS_U16), (const bf16_t*)(ws + WS_V16),
                         (const int*)(ws + WS_IDS), (const float*)(ws + WS_GW), pp->in[17], l == DEPTH - 1 ? 1 : 0, (int)blockIdx.x * 8 + wave, (int)gridDim.x * 8, lane, 1, 511);
            if (PROBE_DUP == 10 || PROBE_DUP == 11) gather5_phase(pp->out, (bf16_t*)(ws + WS_HB), (const float*)(ws + WS_SSQ2P), (float*)(ws + WS_SSQ1), ws + WS_U8, ws + WS_V8, (const float*)(ws + WS_SU), (const float*)(ws + WS_SV),
                         ws + WS_XQ, (const int*)(ws + WS_IDS), (const float*)(ws + WS_GW), pp->in[17], l == DEPTH - 1 ? 1 : 0, lds, wave, (int)blockIdx.x * 8 + wave, lane, 1 | G4P, PROBE_DUP == 10 ? 7 : 0xffff);
            if (PROBE_DUP == 20) { gather5_phase(pp->out, (bf16_t*)(ws + WS_HB), (const float*)(ws + WS_SSQ2P), (float*)(ws + WS_SSQ1), ws + WS_U8, ws + WS_V8, (const float*)(ws + WS_SU), (const float*)(ws + WS_SV),
                         ws + WS_XQ, (const int*)(ws + WS_IDS), (const float*)(ws + WS_GW), pp->in[17], l == DEPTH - 1 ? 1 : 0, lds, wave, (int)blockIdx.x * 8 + wave, lane, 4, 0xffff, ws + WS_A8, (float*)(ws + WS_SA), Q_I8 ? (const float*)(ws + WS_SX) : nullptr); __syncthreads(); }
            if (PEER_I8) gather5_phase(pp->out, (bf16_t*)(ws + WS_HB), (const float*)(ws + WS_SSQ2P), (float*)(ws + WS_SSQ1), ws + WS_U8, ws + WS_V8, (const float*)(ws + WS_SU), (const float*)(ws + WS_SV),
                         ws + WS_XQ, (const int*)(ws + WS_IDS), (const float*)(ws + WS_GW), pp->in[17], l == DEPTH - 1 ? 1 : 0, lds, wave, (int)blockIdx.x * 8 + wave, lane, 0, 0xffff, ws + WS_A8, (float*)(ws + WS_SA), Q_I8 ? (const float*)(ws + WS_SX) : nullptr);
            else if (PEER_FP8) gather4_phase(pp->out, (bf16_t*)(ws + WS_HB), (const float*)(ws + WS_SSQ2P), (float*)(ws + WS_SSQ1), ws + WS_U8, ws + WS_V8, (const float*)(ws + WS_SU), (const float*)(ws + WS_SV),
                         (const int*)(ws + WS_IDS), (const float*)(ws + WS_GW), pp->in[17], l == DEPTH - 1 ? 1 : 0, lds, wave, (int)blockIdx.x * 8 + wave, lane);
            else gather3_phase(pp->out, (bf16_t*)(ws + WS_HB), (const float*)(ws + WS_SSQ2P), (float*)(ws + WS_SSQ1), (const bf16_t*)(ws + WS_U16), (const unsigned short*)(ws + WS_V16),
                         (const int*)(ws + WS_IDS), (const float*)(ws + WS_GW), pp->in[17], l == DEPTH - 1 ? 1 : 0, lds, wave, (int)blockIdx.x * 8 + wave, lane);
        }
}

__global__ void __launch_bounds__(512, 2) mega(Params p) {
    extern __shared__ __attribute__((aligned(16))) unsigned char lds_raw[];
    LAS unsigned char* lds = (LAS unsigned char*)lds_raw;
    const int ph_lo = p.ph_lo, ph_hi = p.ph_hi;
    const int wave = __builtin_amdgcn_readfirstlane(threadIdx.x >> 6);
    if (ph_lo < -1000) cg::this_grid().sync();
    {
        const int tid0 = threadIdx.x;
        for (int u = tid0; u < (LDS_BYTES - 131072) / 4; u += 512) ((LAS unsigned*)(lds + 131072))[u] = 0u;
        __syncthreads();
        if (ph_hi - ph_lo > 1) { KP pq = (KP)__builtin_amdgcn_kernarg_segment_ptr(); (void)xcd_barrier_post((unsigned*)(pq->ws + WS_CTL) + CW_BAR, (volatile LAS unsigned*)(lds + MISC_OFF) + 8, tid0); }
    }

    if (PH_ON(0, 1)) { KARGS();
        const int tid = threadIdx.x, lane = tid & 63;
        unsigned char* ws = pp->ws;
        const int G = gridDim.x, gwave = blockIdx.x * 8 + wave, ngw = G * 8;
        LAS float* scr = (LAS float*)(lds + wave * 8448);
        for (int rep = 0; rep < (PROBE_DUP == 8 ? 2 : 1); ++rep) {
        if (wave < 4) weight_prep(pp, 0, scr, gwave, ngw, lane);
        {
            const int* pos = (const int*)pp->in[1];
            float* rope = (float*)(ws + WS_ROPE);
            const float inv_freq = (float)exp2(-(double)(tid & 31) * (13.287712379549449 / 32.0));
            for (int e = blockIdx.x * 512 + tid; e < T * 32; e += G * 512) {
                const int t = e >> 5;
                const float ang = (float)pos[t] * inv_freq;
                double rv = (double)ang * 0.15915494309189535; rv -= floor(rv);
                const float rf = (float)rv;
                rope[2 * e] = __builtin_amdgcn_cosf(rf); rope[2 * e + 1] = __builtin_amdgcn_sinf(rf);
            }
        }
        {
            bf16_t* HB = (bf16_t*)(ws + WS_HB); float* ssq1 = (float*)(ws + WS_SSQ1);
            f32x4 vn[4];
            { const f32x4* xr0 = (const f32x4*)(pp->in[0] + (size_t)gwave * DM) + lane;
#pragma unroll
              for (int j = 0; j < 4; ++j) vn[j] = xr0[64 * j]; }
            for (int t = gwave; t < T; t += ngw) {
                f32x4 v[4]; float ss = 0.f;
#pragma unroll
                for (int j = 0; j < 4; ++j) v[j] = vn[j];
                if (t + ngw < T) { const f32x4* xr1 = (const f32x4*)(pp->in[0] + (size_t)(t + ngw) * DM) + lane;
#pragma unroll
                    for (int j = 0; j < 4; ++j) vn[j] = xr1[64 * j]; }
#pragma unroll
                for (int j = 0; j < 4; ++j) ss += (v[j][0] * v[j][0] + v[j][1] * v[j][1]) + (v[j][2] * v[j][2] + v[j][3] * v[j][3]);
                ss = wave_sum(ss);
                u32x2* br = (u32x2*)(HB + (size_t)t * DM) + lane;
#pragma unroll
                for (int j = 0; j < 4; ++j) { u32x2 w; w.x = cvtpk(v[j][0], v[j][1]); w.y = cvtpk(v[j][2], v[j][3]); br[64 * j] = w; }
                if (lane == 0) ssq1[t] = ss;
                if (IN_I8) {
                    float am = 0.f;
#pragma unroll
                    for (int j = 0; j < 4; ++j) am = fmaxf(am, fmaxf(fmaxf(fabsf(v[j][0]), fabsf(v[j][1])), fmaxf(fabsf(v[j][2]), fabsf(v[j][3]))));
#pragma unroll
                    for (int o = 1; o < 64; o <<= 1) am = fmaxf(am, __shfl_xor(am, o));
                    const float inv = am > 0.f ? 127.0f / am : 0.f;
                    unsigned* ar = (unsigned*)(ws + WS_A8 + (size_t)t * DM) + lane;
#pragma unroll
                    for (int j = 0; j < 4; ++j) {
                        int q0 = (int)rintf(v[j][0] * inv), q1 = (int)rintf(v[j][1] * inv), q2 = (int)rintf(v[j][2] * inv), q3 = (int)rintf(v[j][3] * inv);
                        ar[64 * j] = (unsigned)(q0 & 255) | ((unsigned)(q1 & 255) << 8) | ((unsigned)(q2 & 255) << 16) | ((unsigned)(q3 & 255) << 24);
                    }
                    if (lane == 0) ((float*)(ws + WS_SA))[t] = am > 0.f ? am / 127.0f : 0.f;
                }
            }
        }
        if (wave >= 4) weight_prep(pp, 0, scr, gwave, ngw, lane);
        }
    }

    layer_phases<0>(ph_lo, ph_hi, lds, wave);
    layer_phases<1>(ph_lo, ph_hi, lds, wave);
    static_assert(DEPTH == 2, "two layers");
}

#ifndef MK_PER_PHASE
#define MK_PER_PHASE 0
#endif
extern "C" void kernel_launch(void* const* d_in, const int* in_sizes, int n_in, void* d_out, int out_size, void* d_ws, size_t ws_size, hipStream_t stream) {
    static int grid = 0;
    if (grid == 0) {
        if (n_in != 18 || in_sizes[0] != T * DM || out_size != T * DM || ws_size < WS_END) {
            fprintf(stderr, "kernel_launch: unexpected shapes (n_in %d, in0 %d, out %d, ws %zu); nothing launched\n", n_in, n_in > 0 ? in_sizes[0] : -1, out_size, ws_size); grid = -1; return; }
        int dev = 0, cus = 0, per_cu = 0;
        (void)hipGetDevice(&dev);
        (void)hipDeviceGetAttribute(&cus, hipDeviceAttributeMultiprocessorCount, dev);
        (void)hipFuncSetAttribute((const void*)mega, hipFuncAttributeMaxDynamicSharedMemorySize, LDS_BYTES);
        (void)hipOccupancyMaxActiveBlocksPerMultiprocessor(&per_cu, (const void*)mega, 512, LDS_BYTES);
        if (per_cu < 1) { fprintf(stderr, "kernel_launch: occupancy query says %d blocks per CU\n", per_cu); per_cu = 1; }
        (void)hipGetLastError();
        if (cus < 256) { fprintf(stderr, "kernel_launch: built for a 256-CU device (found %d); nothing launched\n", cus); grid = -1; return; }
        grid = 256;
    }
    if (grid < 0) return;
    (void)hipMemsetAsync((char*)d_ws + WS_CTL, 0, CTL_ZERO_BYTES, stream);
    Params p{};
    for (int i = 0; i < 18; ++i) p.in[i] = (const float*)d_in[i];
    p.out = (float*)d_out; p.ws = (unsigned char*)d_ws;
#if MK_PER_PHASE
    for (int ph = 0; ph < NPH; ++ph) {
        p.ph_lo = ph; p.ph_hi = ph + 1;
        void* args[] = {&p};
        hipError_t e = hipLaunchCooperativeKernel((const void*)mega, dim3(grid), dim3(512), args, LDS_BYTES, stream);
        if (e != hipSuccess) { fprintf(stderr, "cooperative launch %d failed: %s\n", ph, hipGetErrorString(e)); break; }
    }
#else
    p.ph_lo = 0; p.ph_hi = NPH;
    void* args[] = {&p};
    hipError_t e = hipLaunchCooperativeKernel((const void*)mega, dim3(grid), dim3(512), args, LDS_BYTES, stream);
    if (e != hipSuccess) fprintf(stderr, "cooperative launch failed: %s (grid %d)\n", hipGetErrorString(e), grid);
#endif
}
```

```cpp
#include <hip/hip_runtime.h>
#include <hip/hip_cooperative_groups.h>
#include <cstdio>
#include <cstdint>
#include <cmath>
namespace cg = cooperative_groups;
namespace pg8 {
#define PG8_LAS __attribute__((address_space(3)))
typedef unsigned short bf16_t;
typedef short bf16x8 __attribute__((ext_vector_type(8)));
typedef float f32x4 __attribute__((ext_vector_type(4)));
typedef unsigned u32x4 __attribute__((ext_vector_type(4)));
typedef int i32x4 __attribute__((ext_vector_type(4)));
typedef long i64x2 __attribute__((ext_vector_type(2)));
#ifndef PG8_I8_SPLIT
#define PG8_I8_SPLIT 0
#endif
#ifndef PG8_I8_ASM
#define PG8_I8_ASM 0
#endif
constexpr int BM = 256, BK = 64, HALF = 128, HTB = HALF * BK * 2  , STAGE_BYTES = 8 * HTB, NXCD = 8, WGM = 8;

__host__ __device__ __forceinline__ int lds_byte(int r, int c) { const int st = (r >> 4) * 2 + (c >> 5), rr = r & 15, cc = c & 31, ob = rr * 64 + cc * 2; return st * 1024 + (ob ^ (((ob >> 9) & 1) << 5)); }
__host__ __device__ __forceinline__ void stage_rc(int b, int& R, int& C) { const int st = b / 1024, sb = b % 1024, swz = sb ^ (((sb >> 9) & 1) << 5); R = (st >> 1) * 16 + swz / 64; C = (st & 1) * 32 + (swz % 64) / 2; }
__host__ __device__ __forceinline__ int perm32(int rho) { const int n = rho >> 4, i = rho & 15; return 8 * (i >> 2) + 4 * n + (i & 3); }

struct Unit { int pm, pn, br; };
struct Gemm { const bf16_t* A; const bf16_t* Bt; int M, N, K, lda; };

struct StaticOrder {
    int nM, nN, nwg, G, c;
    __host__ __device__ void init(int M, int N, int G_, int c_) { nM = M / BM; nN = N / BM; nwg = nM * nN; G = G_; c = c_; }
    __host__ __device__ bool next(int i, Unit& u) const {
        const long L = (long)i * G + c; if (L >= nwg) return false;
        int wgid = (int)L; { const int q = nwg / NXCD, r = nwg % NXCD, xcd = wgid % NXCD, off = wgid / NXCD; wgid = (xcd < r ? xcd * (q + 1) : r * (q + 1) + (xcd - r) * q) + off; }
        const int nig = WGM * nN, gid = wgid / nig, fm = gid * WGM, gsz = (nM - fm) < WGM ? (nM - fm) : WGM;
        u.pm = fm + ((wgid % nig) % gsz); u.pn = (wgid % nig) / gsz; u.br = 0; return true;
    }
    __device__ __forceinline__ size_t a_off(const Unit&) const { return 0; }
    __device__ __forceinline__ size_t b_off(const Unit&) const { return 0; }
    __device__ __forceinline__ void a_ready(const Unit&) const {}
    __device__ __forceinline__ void done(const Unit&) const {}
};

__device__ __forceinline__ unsigned cvt_pk_bf16(float lo, float hi) { unsigned r; asm volatile("v_cvt_pk_bf16_f32 %0, %1, %2" : "=v"(r) : "v"(lo), "v"(hi)); return r; }
typedef float f32x2 __attribute__((ext_vector_type(2)));
__device__ __forceinline__ f32x2 gelu_pk(f32x2 v) {
    const f32x2 av = __builtin_elementwise_abs(v), d = av * 0.2316418882f + 1.0f;
    f32x2 t; t.x = __builtin_amdgcn_rcpf(d.x); t.y = __builtin_amdgcn_rcpf(d.y);
    f32x2 q = t * 0.5307027145f + (-0.7265760135f); q = q * t + 0.7107068705f; q = q * t + (-0.142248368f); q = q * t + 0.127414796f; q = q * t;
    const f32x2 s = (v * v) * (-0.72134752044f);
    f32x2 e; e.x = __builtin_amdgcn_exp2f(s.x); e.y = __builtin_amdgcn_exp2f(s.y);
    const f32x2 m = v * (q * e), r = v - m;
    f32x2 o; o.x = v.x < 0.f ? m.x : r.x; o.y = v.y < 0.f ? m.y : r.y; return o;
}

template <int ACT  > struct EpiBf16 {
    static constexpr bool PERM = true, AFTER_DRAIN = false; static_assert(ACT == 0 || ACT == 1, "EpiBf16: ACT is 0 (none) or 1 (gelu_pk)");
    bf16_t* O; int ldc; const float* bias; int split_cols; size_t split_stride; float scale0;
    __device__ __forceinline__ void operator()(const f32x4 (&acc)[2][2][4][2], const Unit& u, int wr, int wc, int fr, int fq) const {
        const int row0 = u.pm * BM + wr * 64 + fr; int colt = u.pn * BM; bf16_t* base = O;
        float sc = 1.f; if (split_cols) { const int t = colt / split_cols; base += (size_t)t * split_stride; colt -= t * split_cols; if (t == 0) sc = scale0; }
        const int col0 = colt + wc * 32 + 8 * fq, bcol0 = u.pn * BM + wc * 32 + 8 * fq;
        f32x4 bv[2][2];
#pragma unroll
        for (int bj = 0; bj < 2; ++bj)
#pragma unroll
            for (int n = 0; n < 2; ++n) bv[bj][n] = bias ? *(const f32x4*)(bias + bcol0 + bj * HALF + 4 * n) : (f32x4){0.f, 0.f, 0.f, 0.f};
#pragma unroll
        for (int ai = 0; ai < 2; ++ai)
#pragma unroll
            for (int m = 0; m < 4; ++m) { bf16_t* rowp = base + (size_t)(row0 + ai * HALF + m * 16) * ldc + col0;
#pragma unroll
                for (int bj = 0; bj < 2; ++bj) { f32x4 v0 = acc[ai][bj][m][0] + bv[bj][0], v1 = acc[ai][bj][m][1] + bv[bj][1];
                    if (ACT == 1) { f32x2 a = gelu_pk((f32x2){v0[0], v0[1]}), b = gelu_pk((f32x2){v0[2], v0[3]}), c = gelu_pk((f32x2){v1[0], v1[1]}), d = gelu_pk((f32x2){v1[2], v1[3]});
                        v0 = (f32x4){a.x, a.y, b.x, b.y}; v1 = (f32x4){c.x, c.y, d.x, d.y}; }
                    v0 = v0 * sc; v1 = v1 * sc; u32x4 w; w.x = cvt_pk_bf16(v0[0], v0[1]); w.y = cvt_pk_bf16(v0[2], v0[3]); w.z = cvt_pk_bf16(v1[0], v1[1]); w.w = cvt_pk_bf16(v1[2], v1[3]);
                    *(u32x4*)(rowp + bj * HALF) = w; } }
    }
};
template <class Epi, class Sched, bool ALIGN_EPI = false, bool SP2 = false, bool I8 = false>
__device__ __forceinline__ void gemm_phase(PG8_LAS unsigned char* lds, const Gemm g, const Sched& S, const Epi& E, const int tid) {
    const int wid = __builtin_amdgcn_readfirstlane(tid >> 6), lane = tid & 63, wr = wid >> 2, wc = wid & 3, fr = lane & 15, fq = lane >> 4;
    const int K = g.K, nt = K / BK;
    unsigned voffA[2], voffB[2];
#pragma unroll
    for (int i = 0; i < 2; ++i) { int R, C; stage_rc(tid * 16 + i * 8192, R, C); const int Rb = Epi::PERM ? ((R & ~31) + perm32(R & 31)) : R;
        voffA[i] = (unsigned)(R * g.lda + C) * 2u; voffB[i] = (unsigned)(Rb * K + C) * 2u; }
    const size_t kstep = (size_t)(BK * 2);
    const size_t hstep = (size_t)HALF * K * 2;
    const size_t tstep = 2 * hstep; const size_t hstepA = (size_t)HALF * g.lda * 2, tstepA = 2 * hstepA;
    const unsigned ldsw = (unsigned)wid * 1024u;
    const int aoff = lds_byte(wr * 64 + fr, fq * 8), boff = lds_byte(wc * 32 + fr, fq * 8);
#define PG8_SA(b, h) (((b) * 2 + (h)) * HTB)
#define PG8_SB(b, h) ((4 + (b) * 2 + (h)) * HTB)
#define PG8_STAGE(bufoff, gbase, voff) do { _Pragma("unroll") for (int _i = 0; _i < 2; ++_i) \
        __builtin_amdgcn_global_load_lds((const unsigned*)((const char*)(gbase) + (voff)[_i]), (PG8_LAS unsigned*)(lds + (bufoff) + ldsw + _i * 8192), 16, 0, 0); } while (0)
#define PG8_LDA(dst, b, h) do { _Pragma("unroll") for (int m = 0; m < 4; ++m) _Pragma("unroll") for (int k = 0; k < 2; ++k) dst[m][k] = *(const PG8_LAS bf16x8*)(lds + PG8_SA(b, h) + aoff + m * 2048 + k * 1024); } while (0)
#define PG8_LDB(dst, b, h) do { _Pragma("unroll") for (int n = 0; n < 2; ++n) _Pragma("unroll") for (int k = 0; k < 2; ++k) dst[n][k] = *(const PG8_LAS bf16x8*)(lds + PG8_SB(b, h) + boff + n * 2048 + k * 1024); } while (0)
#define PG8_MMA(ai, bj, At, Bt) do { __builtin_amdgcn_s_setprio(1); \
        if constexpr (I8) {   \
            _Pragma("unroll") for (int k = 0; k < 2; ++k) _Pragma("unroll") for (int m = 0; m < 4; ++m) _Pragma("unroll") for (int n = 0; n < 2; ++n) \
                { if (PG8_I8_ASM) asm volatile("v_mfma_i32_16x16x64_i8 %0, %1, %2, %0" : "+v"(acc[ai][bj][m][n]) : "v"(Bt[n][k]), "v"(At[m][k])); \
                  else acc[ai][bj][m][n] = __builtin_bit_cast(f32x4, __builtin_amdgcn_mfma_i32_16x16x64_i8(__builtin_bit_cast(i32x4, Bt[n][k]), __builtin_bit_cast(i32x4, At[m][k]), __builtin_bit_cast(i32x4, acc[ai][bj][m][n]), 0, 0, 0)); } \
        } else { \
            _Pragma("unroll") for (int m = 0; m < 4; ++m) _Pragma("unroll") for (int n = 0; n < 2; ++n) _Pragma("unroll") for (int k = 0; k < 2; ++k) \
                acc[ai][bj][m][n] = __builtin_amdgcn_mfma_f32_16x16x32_bf16(Bt[n][k], At[m][k], acc[ai][bj][m][n], 0, 0, 0); \
        } __builtin_amdgcn_s_setprio(0); } while (0)
#define PG8_WAIT_V(n) asm volatile("s_waitcnt vmcnt(" #n ")" ::: "memory")
#define PG8_WAIT_L(n) asm volatile("s_waitcnt lgkmcnt(" #n ")" ::: "memory")
#define PG8_BAR __builtin_amdgcn_s_barrier()
#define PG8_SCHED __builtin_amdgcn_sched_barrier(0)
    Unit cur, nxt; int ui = 0;
    if (!S.next(0, cur)) return;
    f32x4 acc[2][2][4][2];
#pragma unroll
    for (int a = 0; a < 2; ++a)
#pragma unroll
        for (int b = 0; b < 2; ++b)
#pragma unroll
            for (int m = 0; m < 4; ++m)
#pragma unroll
                for (int n = 0; n < 2; ++n) acc[a][b][m][n] = (f32x4){0.f, 0.f, 0.f, 0.f};
    bf16x8 At[4][2], B0[2][2], B1[2][2];
    const char* cA = (const char*)g.A + S.a_off(cur) + (size_t)cur.pm * tstepA; const char* cB = (const char*)g.Bt + S.b_off(cur) + (size_t)cur.pn * tstep;
    S.a_ready(cur);
    if constexpr (SP2) {
        PG8_STAGE(PG8_SB(0, 0), cB, voffB); PG8_STAGE(PG8_SB(0, 1), cB + hstep, voffB); PG8_STAGE(PG8_SA(0, 0), cA, voffA); PG8_STAGE(PG8_SA(0, 1), cA + hstepA, voffA);
        if (wr == 1) PG8_BAR;
        PG8_WAIT_V(2); PG8_BAR;
        PG8_STAGE(PG8_SB(1, 0), cB + kstep, voffB); PG8_STAGE(PG8_SA(1, 0), cA + kstep, voffA); PG8_STAGE(PG8_SB(1, 1), cB + hstep + kstep, voffB);
        PG8_WAIT_V(6); PG8_BAR;
    } else {
        PG8_STAGE(PG8_SB(0, 0), cB, voffB); PG8_STAGE(PG8_SA(0, 0), cA, voffA); PG8_STAGE(PG8_SB(0, 1), cB + hstep, voffB); PG8_STAGE(PG8_SA(0, 1), cA + hstepA, voffA);
        if (wr == 1) PG8_BAR;
        PG8_WAIT_V(4); PG8_BAR;
        PG8_STAGE(PG8_SB(1, 0), cB + kstep, voffB); PG8_STAGE(PG8_SA(1, 0), cA + kstep, voffA); PG8_STAGE(PG8_SB(1, 1), cB + hstep + kstep, voffB);
        PG8_WAIT_V(6); PG8_BAR;
    }
    for (;;) {
        const bool has_next = S.next(ui + 1, nxt);
        const char* nA = has_next ? (const char*)g.A + S.a_off(nxt) + (size_t)nxt.pm * tstepA : cA; const char* nB = has_next ? (const char*)g.Bt + S.b_off(nxt) + (size_t)nxt.pn * tstep : cB;
        for (int t = 0; t < nt; t += 2) {
            const bool last = (t == nt - 2);
            const char* a1 = cA + (size_t)(t + 1) * kstep;
            const char* a2 = last ? nA : cA + (size_t)(t + 2) * kstep; const char* b2 = last ? nB : cB + (size_t)(t + 2) * kstep;
            const char* a3 = a2 + kstep; const char* b3 = b2 + kstep;
            if (last && has_next) S.a_ready(nxt);
            if constexpr (SP2) {
            PG8_LDB(B0, 0, 0); PG8_LDB(B1, 0, 1); PG8_SCHED; PG8_LDA(At, 0, 0); PG8_STAGE(PG8_SA(1, 1), a1 + hstepA, voffA);
            PG8_WAIT_V(8); PG8_WAIT_L(0); PG8_BAR; PG8_MMA(0, 0, At, B0); PG8_MMA(0, 1, At, B1); PG8_BAR; PG8_SCHED;
            PG8_LDA(At, 0, 1); PG8_STAGE(PG8_SB(0, 0), b2, voffB); PG8_STAGE(PG8_SB(0, 1), b2 + hstep, voffB); PG8_STAGE(PG8_SA(0, 0), a2, voffA);
            PG8_WAIT_V(8); PG8_WAIT_L(0); PG8_BAR; PG8_MMA(1, 0, At, B0); PG8_MMA(1, 1, At, B1); PG8_BAR; PG8_SCHED;
            PG8_LDB(B0, 1, 0); PG8_LDB(B1, 1, 1); PG8_SCHED; PG8_LDA(At, 1, 0); PG8_STAGE(PG8_SA(0, 1), a2 + hstepA, voffA);
            PG8_WAIT_V(8); PG8_WAIT_L(0); PG8_BAR; PG8_MMA(0, 0, At, B0); PG8_MMA(0, 1, At, B1); PG8_BAR; PG8_SCHED;
            PG8_LDA(At, 1, 1); PG8_STAGE(PG8_SB(1, 0), b3, voffB); PG8_STAGE(PG8_SB(1, 1), b3 + hstep, voffB); PG8_STAGE(PG8_SA(1, 0), a3, voffA);
            PG8_WAIT_V(8); PG8_WAIT_L(0); PG8_BAR; PG8_MMA(1, 0, At, B0); PG8_MMA(1, 1, At, B1); PG8_BAR; PG8_SCHED;
            } else {
            PG8_LDB(B0, 0, 0); PG8_SCHED; PG8_LDA(At, 0, 0); PG8_STAGE(PG8_SA(1, 1), a1 + hstepA, voffA);
            PG8_WAIT_L(8); PG8_BAR; PG8_WAIT_L(0); PG8_MMA(0, 0, At, B0); PG8_BAR; PG8_SCHED;
            PG8_LDB(B1, 0, 1); PG8_STAGE(PG8_SB(0, 0), b2, voffB);
            PG8_BAR; PG8_WAIT_L(0); PG8_MMA(0, 1, At, B1); PG8_BAR;
            PG8_LDA(At, 0, 1); PG8_STAGE(PG8_SA(0, 0), a2, voffA);
            PG8_BAR; PG8_WAIT_L(0); PG8_MMA(1, 0, At, B0); PG8_BAR; PG8_SCHED;
            PG8_STAGE(PG8_SB(0, 1), b2 + hstep, voffB);
            PG8_WAIT_V(6); PG8_BAR; PG8_MMA(1, 1, At, B1); PG8_BAR;
            PG8_LDB(B0, 1, 0); PG8_SCHED; PG8_LDA(At, 1, 0); PG8_STAGE(PG8_SA(0, 1), a2 + hstepA, voffA);
            PG8_WAIT_L(8); PG8_BAR; PG8_WAIT_L(0); PG8_MMA(0, 0, At, B0); PG8_BAR; PG8_SCHED;
            PG8_LDB(B1, 1, 1); PG8_STAGE(PG8_SB(1, 0), b3, voffB);
            PG8_BAR; PG8_WAIT_L(0); PG8_MMA(0, 1, At, B1); PG8_BAR;
            PG8_LDA(At, 1, 1); PG8_STAGE(PG8_SA(1, 0), a3, voffA);
            PG8_BAR; PG8_WAIT_L(0); PG8_MMA(1, 0, At, B0); PG8_BAR; PG8_SCHED;
            PG8_STAGE(PG8_SB(1, 1), b3 + hstep, voffB);
            PG8_WAIT_V(6); PG8_BAR; PG8_MMA(1, 1, At, B1); PG8_BAR;
            }
        }
        if constexpr (I8) { if (PG8_I8_ASM) asm volatile("s_nop 15\n\ts_nop 15" ::: "memory"); }
        if constexpr (ALIGN_EPI) { if (wr == 0) PG8_BAR; }
        if constexpr (!Epi::AFTER_DRAIN) { E(acc, cur, wr, wc, fr, fq); S.done(cur); }
        if (!has_next) break;
        if (!E.keep(cur)) {
#pragma unroll
        for (int a = 0; a < 2; ++a)
#pragma unroll
            for (int b = 0; b < 2; ++b)
#pragma unroll
                for (int m = 0; m < 4; ++m)
#pragma unroll
                    for (int n = 0; n < 2; ++n) acc[a][b][m][n] = (f32x4){0.f, 0.f, 0.f, 0.f};
        }
        cur = nxt; cA = nA; cB = nB; ++ui;
        if constexpr (ALIGN_EPI) { if (wr == 1) PG8_BAR; }
    }
    PG8_WAIT_V(0);
    if constexpr (!ALIGN_EPI) { if (wr == 0) PG8_BAR; }
    PG8_BAR;
    if constexpr (Epi::AFTER_DRAIN) { E.fused(acc, cur, wr, wc, fr, fq, lds, wid, lane); S.done(cur); }
#undef PG8_SA
#undef PG8_SB
#undef PG8_STAGE
#undef PG8_LDA
#undef PG8_LDB
#undef PG8_MMA
#undef PG8_WAIT_V
#undef PG8_WAIT_L
#undef PG8_BAR
#undef PG8_SCHED
}
}

constexpr int BATCH = 4, SEQ = 8192, T = BATCH * SEQ, DM = 1024, DEPTH = 2;
constexpr int IN_COLS = 6022, NP = 3072, N_IN = 6144;
constexpr int N_EXP = 16384;
constexpr int PC_QA = 0, PC_QB = 384, PC_QC = 768, PC_KA = 1152, PC_VA = 1536, PC_KB = 1920, PC_VB = 2304, PC_KC = 2688, PC_VC = 2816, PC_FB = 2944;
constexpr int PC_MERGED = 1152;
constexpr float RMS_EPS = 1e-6f;
constexpr float LOG2E = 1.4426950408889634f;
constexpr float QK_SCALE2 = 0.125f * LOG2E;

constexpr size_t MiB = 1u << 20;
constexpr size_t WS_CTL = 0, CTL_ZERO_BYTES = 65536;
constexpr size_t WS_SSQ1 = 1 * MiB;
constexpr size_t WS_CUMT = 1 * MiB + 256 * 1024;
constexpr size_t WS_LOGF = 2 * MiB;
constexpr size_t WS_KMAX_BASE = 32768;
constexpr size_t WS_ROPE = 3 * MiB;
constexpr size_t WS_W = 12 * MiB, WL_STRIDE = 21 * MiB;
constexpr size_t WL_IN = 0, WL_BR = 12 * MiB, WL_OUT = WL_BR + 2304 * 1024, WL_Q = WL_OUT + 2 * MiB, WL_K12 = WL_Q + 4 * MiB;
static_assert(WL_K12 + 65536 <= WL_STRIDE, "weights");
constexpr size_t WS_HB = 56 * MiB;
constexpr size_t WS_P = 120 * MiB;
constexpr size_t WS_G = 312 * MiB;
constexpr size_t WS_SSQ2P = 504 * MiB;
constexpr size_t WS_END = 506 * MiB;
constexpr size_t WS_Q2 = WS_P;
constexpr size_t WS_IDS = WS_P + 128 * MiB;
constexpr size_t WS_GW = WS_P + 144 * MiB;
constexpr size_t WS_AO = WS_G + 96 * MiB;
constexpr size_t WS_ALSE = WS_G + 96 * MiB + 80 * MiB;
constexpr size_t WS_A8 = WS_G + 128 * MiB;
constexpr size_t WS_SA = WS_G + 160 * MiB;
constexpr size_t WS_SX = WS_G + 161 * MiB;
constexpr size_t WL_QSC = 3 * MiB;
constexpr size_t WL_INSC = 8 * MiB;
constexpr size_t WS_XQ = WS_P + 160 * MiB;
constexpr size_t WS_U16 = WS_G, WS_V16 = WS_G + 32 * MiB;
constexpr size_t WS_U8 = WS_G + 64 * MiB, WS_V8 = WS_G + 80 * MiB, WS_SU = WS_G + 96 * MiB, WS_SV = WS_G + 96 * MiB + 65536;
constexpr int CW_GRP = 10240;
constexpr int CW_ATT = 64;

constexpr int LDS_BYTES = 147456;
constexpr int NPH = 1 + 8 * DEPTH;
#ifndef PH_MASK
#define PH_MASK 511
#endif

#define LAS __attribute__((address_space(3)))
typedef unsigned short bf16_t;
typedef short bf16x8 __attribute__((ext_vector_type(8)));
typedef float f32x4 __attribute__((ext_vector_type(4)));
typedef float f32x16 __attribute__((ext_vector_type(16)));
typedef unsigned u32x4 __attribute__((ext_vector_type(4)));
typedef unsigned u32x2 __attribute__((ext_vector_type(2)));
typedef short v4i16_t __attribute__((ext_vector_type(4)));
typedef float f32x2_t __attribute__((ext_vector_type(2)));
typedef __bf16 bf16x2_t __attribute__((ext_vector_type(2)));

__device__ __forceinline__ unsigned cvtpk(float lo, float hi) { f32x2_t v = {lo, hi}; bf16x2_t b = __builtin_convertvector(v, bf16x2_t); return __builtin_bit_cast(unsigned, b); }
__device__ __forceinline__ float bflo(unsigned u) { return __uint_as_float(u << 16); }
__device__ __forceinline__ float bfhi(unsigned u) { return __uint_as_float(u & 0xffff0000u); }
__device__ __forceinline__ float wave_sum(float v) {
#pragma unroll
    for (int o = 1; o < 64; o <<= 1) v += __shfl_xor(v, o);
    return v;
}
__device__ __forceinline__ float dot2bf(unsigned a, unsigned b, float acc) {
    return fmaf(bfhi(a), bfhi(b), fmaf(bflo(a), bflo(b), acc));
}

__host__ __device__ __forceinline__ int src_col_in(int n) {
    if (n >= 3072) return 2950 + (n - 3072);
    if (n >= 2950) return -1;
    if (n >= 2944) return 2304 + (n - 2944);
    int seg, src; bool rope;
    if (n < 384)       { seg = 0;    src = 0;    rope = true;  }
    else if (n < 768)  { seg = 384;  src = 1152; rope = false; }
    else if (n < 1152) { seg = 768;  src = 2310; rope = true;  }
    else if (n < 1536) { seg = 1152; src = 384;  rope = true;  }
    else if (n < 1920) { seg = 1536; src = 768;  rope = false; }
    else if (n < 2304) { seg = 1920; src = 1536; rope = false; }
    else if (n < 2688) { seg = 2304; src = 1920; rope = false; }
    else if (n < 2816) { seg = 2688; src = 2694; rope = true;  }
    else               { seg = 2816; src = 2822; rope = false; }
    int off = n - seg;
    if (rope) { const int blk = off >> 6, w = off & 63; off = blk * 64 + (w >> 1) + 32 * (w & 1); }
    return src + off;
}

__device__ __forceinline__ float ssq16(const float* __restrict__ pz, int row) {
    const f32x4* q = (const f32x4*)(pz + (size_t)row * 16);
    const f32x4 a = q[0], b = q[1], c = q[2], d = q[3];
    return (((a[0] + a[1]) + (a[2] + a[3])) + ((b[0] + b[1]) + (b[2] + b[3]))) + (((c[0] + c[1]) + (c[2] + c[3])) + ((d[0] + d[1]) + (d[2] + d[3])));
}

template <int MODE>
__device__ __forceinline__ void transpose_item(const float* __restrict__ W, int K, int Nsrc, bf16_t* __restrict__ WT, const float* __restrict__ kscale,
                                               LAS float* scr, int item, int nblk, int lane) {
    const int kb = item / nblk, nb = item % nblk, k0 = 64 * kb, n0 = 32 * nb;
    const int nn = n0 + (lane & 31);
    const int c = (MODE == 1) ? src_col_in(nn) : nn;
#pragma unroll 8
    for (int i = 0; i < 32; ++i) {
        const int kk = 2 * i + (lane >> 5);
        float v = 0.f;
        if (c >= 0) v = W[(size_t)(k0 + kk) * Nsrc + c];
        if (kscale) v *= kscale[k0 + kk];
        if (MODE == 1 && nn >= 3072) v *= -LOG2E;
        scr[kk * 33 + (lane & 31)] = v;
    }
    asm volatile("s_waitcnt lgkmcnt(0)" ::: "memory");
    const int c8 = lane & 7;
#pragma unroll
    for (int j = 0; j < 4; ++j) {
        const int n = (lane >> 3) + 8 * j; const LAS float* s = scr + (8 * c8) * 33 + n;
        u32x4 o; o.x = cvtpk(s[0 * 33], s[1 * 33]); o.y = cvtpk(s[2 * 33], s[3 * 33]); o.z = cvtpk(s[4 * 33], s[5 * 33]); o.w = cvtpk(s[6 * 33], s[7 * 33]);
        *(u32x4*)(WT + (size_t)(n0 + n) * K + k0 + 8 * c8) = o;
    }
    asm volatile("s_waitcnt lgkmcnt(0)" ::: "memory");
}

#ifndef G5_SLICE_SYNC
#define G5_SLICE_SYNC 0
#endif
#ifndef TAIL_FENCE_LIGHT
#define TAIL_FENCE_LIGHT 1
#endif
#ifndef IN_I8_LAYERS
#define IN_I8_LAYERS 3
#endif
#ifndef IN_I8
#define IN_I8 1
#endif
template <int MODE = 1, int NSRC = IN_COLS>
__device__ __forceinline__ void quant_win_item(const float* __restrict__ W, const float* __restrict__ kscale, unsigned char* __restrict__ WT8, float* __restrict__ colscale, int item, int lane, bf16_t* deq = nullptr) {
    const int c = lane & 7, rs = lane >> 3, n = 8 * item + c, src = MODE == 1 ? src_col_in(n) : n, k0 = 128 * rs;
    const float post = (MODE == 1 && n >= 3072) ? -LOG2E : 1.0f;
    const float* wp = W + (size_t)k0 * NSRC + (src >= 0 ? src : 0);
    const float* kp = kscale + k0;
    float am = 0.f;
    for (int j = 0; j < 4; ++j) {
        float x[32];
#pragma unroll
        for (int i = 0; i < 32; ++i) x[i] = wp[(size_t)(32 * j + i) * NSRC];
#pragma unroll
        for (int i = 0; i < 32; ++i) am = fmaxf(am, fabsf(x[i] * kp[32 * j + i]));
    }
    if (src < 0) am = 0.f;
    am = fmaxf(am, __shfl_xor(am, 8)); am = fmaxf(am, __shfl_xor(am, 16)); am = fmaxf(am, __shfl_xor(am, 32));
    const float inv = am > 0.f ? 127.0f / am : 0.f;
    unsigned char* dst = WT8 + (size_t)n * DM + k0;
    for (int j = 0; j < 4; ++j) {
        float x[32];
#pragma unroll
        for (int i = 0; i < 32; ++i) x[i] = wp[(size_t)(32 * j + i) * NSRC];
        unsigned w[8];
#pragma unroll
        for (int q = 0; q < 8; ++q) {
            const int b = 4 * q;
            const int q0 = (int)rintf(x[b] * kp[32 * j + b] * inv), q1 = (int)rintf(x[b + 1] * kp[32 * j + b + 1] * inv), q2 = (int)rintf(x[b + 2] * kp[32 * j + b + 2] * inv), q3 = (int)rintf(x[b + 3] * kp[32 * j + b + 3] * inv);
            w[q] = (unsigned)(q0 & 255) | ((unsigned)(q1 & 255) << 8) | ((unsigned)(q2 & 255) << 16) | ((unsigned)(q3 & 255) << 24);
        }
        *(u32x4*)(dst + 32 * j) = (u32x4){w[0], w[1], w[2], w[3]}; *(u32x4*)(dst + 32 * j + 16) = (u32x4){w[4], w[5], w[6], w[7]};
    }
    if (rs == 0) colscale[n] = (am > 0.f ? am / 127.0f : 0.f) * post;
}
__device__ __forceinline__ void quant_arow_i8(const float (&f)[16], unsigned char* __restrict__ dst_row, float* __restrict__ scale_out, int lane) {
    float am = 0.f;
#pragma unroll
    for (int j = 0; j < 16; ++j) am = fmaxf(am, fabsf(f[j]));
#pragma unroll
    for (int o = 1; o < 64; o <<= 1) am = fmaxf(am, __shfl_xor(am, o));
    const float inv = am > 0.f ? 127.0f / am : 0.f;
    unsigned wq[4];
#pragma unroll
    for (int j = 0; j < 4; ++j) {
        const int q0 = (int)rintf(f[4 * j] * inv), q1 = (int)rintf(f[4 * j + 1] * inv), q2 = (int)rintf(f[4 * j + 2] * inv), q3 = (int)rintf(f[4 * j + 3] * inv);
        wq[j] = (unsigned)(q0 & 255) | ((unsigned)(q1 & 255) << 8) | ((unsigned)(q2 & 255) << 16) | ((unsigned)(q3 & 255) << 24);
    }
    *(u32x2*)(dst_row + 8 * lane) = (u32x2){wq[0], wq[1]}; *(u32x2*)(dst_row + 512 + 8 * lane) = (u32x2){wq[2], wq[3]};
    if (lane == 0) *scale_out = am > 0.f ? am / 127.0f : 0.f;
}

#ifndef EPI_NT
#define EPI_NT 1
#endif
template <bool I8> struct EpiInT {
    static constexpr bool PERM = true, AFTER_DRAIN = false;
    __device__ __forceinline__ bool keep(const pg8::Unit&) const { return false; }
    bf16_t* P; bf16_t* G; const float* ssq; const float* rope; const float* bgate; const float* bfg; float* logf; int nostore; const float* sa; const float* swc;
    __device__ __forceinline__ void operator()(const pg8::f32x4 (&acc)[2][2][4][2], const pg8::Unit& u, int wr, int wc, int fr, int fq) const {
        const int colw = u.pn * 256 + wc * 32 + 8 * fq;
        const int row0 = u.pm * 256 + wr * 64 + fr;
        float rsv[8];
#pragma unroll
        for (int i = 0; i < 8; ++i) rsv[i] = ssq[row0 + (i >> 2) * 128 + (i & 3) * 16];
#pragma unroll
        for (int i = 0; i < 8; ++i) rsv[i] = rsqrtf(rsv[i] * (1.0f / 1024.0f) + RMS_EPS);
        f32x4 swv[2][2];
        if constexpr (I8) {
            float sav[8];
#pragma unroll
            for (int i = 0; i < 8; ++i) sav[i] = sa[row0 + (i >> 2) * 128 + (i & 3) * 16];
#pragma unroll
            for (int i = 0; i < 8; ++i) rsv[i] *= sav[i];
#pragma unroll
            for (int bj = 0; bj < 2; ++bj) { swv[bj][0] = *(const f32x4*)(swc + colw + bj * 128); swv[bj][1] = *(const f32x4*)(swc + colw + bj * 128 + 4); }
        }
#define EPIIN_ACC(ai, bj, m, n, e) (I8 ? (float)__float_as_int(acc[ai][bj][m][n][e]) * swv[bj][n][e] : acc[ai][bj][m][n][e])
        if (colw >= 3072) {
            const int g0 = colw - 3072;
            f32x4 bg[2][2];
#pragma unroll
            for (int bj = 0; bj < 2; ++bj) { bg[bj][0] = *(const f32x4*)(bgate + g0 + bj * 128) * -LOG2E; bg[bj][1] = *(const f32x4*)(bgate + g0 + bj * 128 + 4) * -LOG2E; }
            unsigned char* G8 = (unsigned char*)G;
            const int gbyte = (u.pn - 12) * 256 + wc * 64 + fq * 16;
#pragma unroll
            for (int i = 0; i < 8; ++i) {
                const int ai = i >> 2, m = i & 3;
                const int row = row0 + ai * 128 + m * 16;
                const float rs = rsv[i];
                u32x4 w;
#pragma unroll
                for (int bj = 0; bj < 2; ++bj) {
                    float v[8];
#pragma unroll
                    for (int e = 0; e < 4; ++e) {
                        v[e] = 255.0f * __builtin_amdgcn_rcpf(1.0f + __builtin_amdgcn_exp2f(fmaf(EPIIN_ACC(ai, bj, m, 0, e), rs, bg[bj][0][e])));
                        v[4 + e] = 255.0f * __builtin_amdgcn_rcpf(1.0f + __builtin_amdgcn_exp2f(fmaf(EPIIN_ACC(ai, bj, m, 1, e), rs, bg[bj][1][e])));
                    }
                    unsigned lo = 0, hi_ = 0;
                    lo = __builtin_amdgcn_cvt_pk_u8_f32(v[0], 0, lo); lo = __builtin_amdgcn_cvt_pk_u8_f32(v[1], 1, lo); lo = __builtin_amdgcn_cvt_pk_u8_f32(v[2], 2, lo); lo = __builtin_amdgcn_cvt_pk_u8_f32(v[3], 3, lo);
                    hi_ = __builtin_amdgcn_cvt_pk_u8_f32(v[4], 0, hi_); hi_ = __builtin_amdgcn_cvt_pk_u8_f32(v[5], 1, hi_); hi_ = __builtin_amdgcn_cvt_pk_u8_f32(v[6], 2, hi_); hi_ = __builtin_amdgcn_cvt_pk_u8_f32(v[7], 3, hi_);
                    if (bj == 0) { w.x = lo; w.y = hi_; } else { w.z = lo; w.w = hi_; }
                }
                if (!(nostore && w.x != 0x12345678u)) { if (EPI_NT & 1) __builtin_nontemporal_store(w, (u32x4*)(G8 + (size_t)row * 3072 + gbyte)); else *(u32x4*)(G8 + (size_t)row * 3072 + gbyte) = w; }
            }
        } else {
            bool rp[2];
#pragma unroll
            for (int bj = 0; bj < 2; ++bj) { const int cb = colw + bj * 128; rp[bj] = (cb < 384) || (cb >= 768 && cb < 1536) || (cb >= 2688 && cb < 2816); }
            f32x4 rn[2][2];
#pragma unroll
            for (int bj = 0; bj < 2; ++bj) if (rp[bj]) { const float* r = rope + ((size_t)row0 * 32 + (((colw + bj * 128) & 63) >> 1)) * 2; rn[bj][0] = *(const f32x4*)r; rn[bj][1] = *(const f32x4*)(r + 4); }
#pragma unroll
            for (int i = 0; i < 8; ++i) {
                const int ai = i >> 2, m = i & 3;
                const int row = row0 + ai * 128 + m * 16;
                const float rs = rsv[i];
                f32x4 rc[2][2];
#pragma unroll
                for (int bj = 0; bj < 2; ++bj) { rc[bj][0] = rn[bj][0]; rc[bj][1] = rn[bj][1]; }
                if (i < 7) {
                    const int rown = row0 + ((i + 1) >> 2) * 128 + ((i + 1) & 3) * 16;
#pragma unroll
                    for (int bj = 0; bj < 2; ++bj) if (rp[bj]) { const float* r = rope + ((size_t)rown * 32 + (((colw + bj * 128) & 63) >> 1)) * 2; rn[bj][0] = *(const f32x4*)r; rn[bj][1] = *(const f32x4*)(r + 4); }
                }
#pragma unroll
                for (int bj = 0; bj < 2; ++bj) {
                    const int cb = colw + bj * 128;
                    float v[8];
#pragma unroll
                    for (int e = 0; e < 4; ++e) { v[e] = EPIIN_ACC(ai, bj, m, 0, e) * rs; v[4 + e] = EPIIN_ACC(ai, bj, m, 1, e) * rs; }
                    if (rp[bj]) {
                        const f32x4 r0 = rc[bj][0], r1 = rc[bj][1];
                        float a, b;
                        a = v[0]; b = v[1]; v[0] = a * r0[0] - b * r0[1]; v[1] = b * r0[0] + a * r0[1];
                        a = v[2]; b = v[3]; v[2] = a * r0[2] - b * r0[3]; v[3] = b * r0[2] + a * r0[3];
                        a = v[4]; b = v[5]; v[4] = a * r1[0] - b * r1[1]; v[5] = b * r1[0] + a * r1[1];
                        a = v[6]; b = v[7]; v[6] = a * r1[2] - b * r1[3]; v[7] = b * r1[2] + a * r1[3];
                    }
                    if (cb == PC_FB) {
#pragma unroll
                        for (int e = 0; e < 6; ++e) { const float z = v[e] + bfg[e]; logf[(size_t)row * 8 + e] = fminf(z, 0.f) - log1pf(__expf(-fabsf(z))); }
                    }
                    u32x4 w; w.x = cvtpk(v[0], v[1]); w.y = cvtpk(v[2], v[3]); w.z = cvtpk(v[4], v[5]); w.w = cvtpk(v[6], v[7]);
                    if (!(nostore && w.x != 0x12345678u)) { if (EPI_NT & 1) __builtin_nontemporal_store(w, (u32x4*)(P + (size_t)row * NP + cb)); else *(u32x4*)(P + (size_t)row * NP + cb) = w; }
                }
            }
        }
    }
};
struct EpiDry {
    static constexpr bool PERM = true, AFTER_DRAIN = false;
    __device__ __forceinline__ bool keep(const pg8::Unit&) const { return false; }
    float* sink;
    __device__ __forceinline__ void operator()(const pg8::f32x4 (&acc)[2][2][4][2], const pg8::Unit& u, int wr, int wc, int fr, int fq) const {
        float t = 0.f;
#pragma unroll
        for (int ai = 0; ai < 2; ++ai)
#pragma unroll
            for (int bj = 0; bj < 2; ++bj)
#pragma unroll
                for (int m = 0; m < 4; ++m)
#pragma unroll
                    for (int n = 0; n < 2; ++n) t += acc[ai][bj][m][n][0] + acc[ai][bj][m][n][1] + acc[ai][bj][m][n][2] + acc[ai][bj][m][n][3];
        if (t == 1.2345e33f) sink[u.pm] = t;
    }
};
struct EpiBr {
    static constexpr bool PERM = true, AFTER_DRAIN = false;
    __device__ __forceinline__ bool keep(const pg8::Unit&) const { return false; }
    const bf16_t* Gi; bf16_t* Mg; int first;
    __device__ __forceinline__ void operator()(const pg8::f32x4 (&acc)[2][2][4][2], const pg8::Unit& u, int wr, int wc, int fr, int fq) const {
        const int colw = u.pn * 256 + wc * 32 + 8 * fq;
#pragma unroll
        for (int ai = 0; ai < 2; ++ai)
#pragma unroll
            for (int m = 0; m < 4; ++m) {
                const int row = u.pm * 256 + ai * 128 + wr * 64 + m * 16 + fr;
#pragma unroll
                for (int bj = 0; bj < 2; ++bj) {
                    const int cb = colw + bj * 128;
                    const u32x4 g = *(const u32x4*)(Gi + (size_t)row * NP + cb);
                    float v[8];
                    v[0] = bflo(g.x) * acc[ai][bj][m][0][0]; v[1] = bfhi(g.x) * acc[ai][bj][m][0][1]; v[2] = bflo(g.y) * acc[ai][bj][m][0][2]; v[3] = bfhi(g.y) * acc[ai][bj][m][0][3];
                    v[4] = bflo(g.z) * acc[ai][bj][m][1][0]; v[5] = bfhi(g.z) * acc[ai][bj][m][1][1]; v[6] = bflo(g.w) * acc[ai][bj][m][1][2]; v[7] = bfhi(g.w) * acc[ai][bj][m][1][3];
                    bf16_t* mp = Mg + (size_t)row * NP + cb;
                    if (!first) { const u32x4 o = *(const u32x4*)mp;
                        v[0] += bflo(o.x); v[1] += bfhi(o.x); v[2] += bflo(o.y); v[3] += bfhi(o.y); v[4] += bflo(o.z); v[5] += bfhi(o.z); v[6] += bflo(o.w); v[7] += bfhi(o.w); }
                    u32x4 w; w.x = cvtpk(v[0], v[1]); w.y = cvtpk(v[2], v[3]); w.z = cvtpk(v[4], v[5]); w.w = cvtpk(v[6], v[7]);
                    *(u32x4*)mp = w;
                }
                if (m & 1) asm volatile("" ::: "memory");
            }
    }
};
struct BranchOrder {
    pg8::StaticOrder so;
    __device__ __forceinline__ void init(int M, int N, int G_, int c_) { so.init(M, N, G_, c_); }
    __device__ __forceinline__ bool next(int i, pg8::Unit& u) const { const int ti = i / 3; if (!so.next(ti, u)) return false; u.br = i - 3 * ti; return true; }
    __device__ __forceinline__ size_t a_off(const pg8::Unit& u) const { return (size_t)u.br * 384 * 2; }
    __device__ __forceinline__ size_t b_off(const pg8::Unit& u) const { return (size_t)u.br * DM * 384 * 2; }
    __device__ __forceinline__ void a_ready(const pg8::Unit&) const {}
    __device__ __forceinline__ void done(const pg8::Unit&) const {}
};
#ifndef BR_PRELOAD
#define BR_PRELOAD 0
#endif
struct EpiBrChain {
    static constexpr bool PERM = true, AFTER_DRAIN = false;
    const unsigned char* G8; bf16_t* Mg;
    __device__ __forceinline__ bool keep(const pg8::Unit& u) const { return u.br < 2; }
    __device__ __forceinline__ void operator()(pg8::f32x4 (&acc)[2][2][4][2], const pg8::Unit& u, int wr, int wc, int fr, int fq) const {
        const int colw = u.pn * 256 + wc * 32 + 8 * fq, br = u.br;
        const int row0 = u.pm * 256 + wr * 64 + fr;
        const int gbyte = br * 1024 + u.pn * 256 + wc * 64 + fq * 16;
        constexpr float GEPS = 1e-6f, I255 = 1.0f / 255.0f;
#if BR_PRELOAD
        u32x4 gca[8], gna[8];
#pragma unroll
        for (int i = 0; i < 8; ++i) gca[i] = *(const u32x4*)(G8 + (size_t)(row0 + (i >> 2) * 128 + (i & 3) * 16) * 3072 + gbyte);
        if (br < 2) {
#pragma unroll
            for (int i = 0; i < 8; ++i) gna[i] = *(const u32x4*)(G8 + (size_t)(row0 + (i >> 2) * 128 + (i & 3) * 16) * 3072 + gbyte + 1024);
        }
#else
        u32x4 gcn, gnn;
        gcn = *(const u32x4*)(G8 + (size_t)row0 * 3072 + gbyte);
        if (br < 2) gnn = *(const u32x4*)(G8 + (size_t)row0 * 3072 + gbyte + 1024);
#endif
#pragma unroll
        for (int i = 0; i < 8; ++i) {
            const int ai = i >> 2, m = i & 3;
            const int row = row0 + ai * 128 + m * 16;
#if BR_PRELOAD
            const u32x4 gc = gca[i], gn = gna[i];
#else
            const u32x4 gc = gcn, gn = gnn;
            if (i < 7) {
                const int rown = row0 + ((i + 1) >> 2) * 128 + ((i + 1) & 3) * 16;
                gcn = *(const u32x4*)(G8 + (size_t)rown * 3072 + gbyte);
                if (br < 2) gnn = *(const u32x4*)(G8 + (size_t)rown * 3072 + gbyte + 1024);
            }
#endif
#pragma unroll
            for (int bj = 0; bj < 2; ++bj) {
                const unsigned c0 = bj == 0 ? gc.x : gc.z, c1 = bj == 0 ? gc.y : gc.w;
                float f[8] = {(float)(c0 & 255u), (float)((c0 >> 8) & 255u), (float)((c0 >> 16) & 255u), (float)(c0 >> 24), (float)(c1 & 255u), (float)((c1 >> 8) & 255u), (float)((c1 >> 16) & 255u), (float)(c1 >> 24)};
#pragma unroll
                for (int e = 0; e < 8; ++e) f[e] *= I255;
                if (br > 0) {
#pragma unroll
                    for (int e = 0; e < 8; ++e) f[e] = fmaxf(f[e], GEPS);
                }
                if (br < 2) {
                    const unsigned n0 = bj == 0 ? gn.x : gn.z, n1 = bj == 0 ? gn.y : gn.w;
                    const float d[8] = {(float)(n0 & 255u), (float)((n0 >> 8) & 255u), (float)((n0 >> 16) & 255u), (float)(n0 >> 24), (float)(n1 & 255u), (float)((n1 >> 8) & 255u), (float)((n1 >> 16) & 255u), (float)(n1 >> 24)};
#pragma unroll
                    for (int e = 0; e < 8; ++e) f[e] *= __builtin_amdgcn_rcpf(fmaxf(d[e] * I255, GEPS));
#pragma unroll
                    for (int e = 0; e < 4; ++e) { acc[ai][bj][m][0][e] *= f[e]; acc[ai][bj][m][1][e] *= f[4 + e]; }
                } else {
                    float v[8];
#pragma unroll
                    for (int e = 0; e < 4; ++e) { v[e] = acc[ai][bj][m][0][e] * f[e]; v[4 + e] = acc[ai][bj][m][1][e] * f[4 + e]; }
                    u32x4 w; w.x = cvtpk(v[0], v[1]); w.y = cvtpk(v[2], v[3]); w.z = cvtpk(v[4], v[5]); w.w = cvtpk(v[6], v[7]);
                    if (EPI_NT & 8) __builtin_nontemporal_store(w, (u32x4*)(Mg + (size_t)row * NP + colw + bj * 128)); else *(u32x4*)(Mg + (size_t)row * NP + colw + bj * 128) = w;
                }
            }
        }
    }
};
#ifndef RES16
#define RES16 1
#endif
struct EpiOut {
    static constexpr bool PERM = true, AFTER_DRAIN = false;
    __device__ __forceinline__ bool keep(const pg8::Unit&) const { return false; }
    const float* Hin; float* H; bf16_t* HB; float* ssq;
    __device__ __forceinline__ void operator()(const pg8::f32x4 (&acc)[2][2][4][2], const pg8::Unit& u, int wr, int wc, int fr, int fq) const {
        const int colw = u.pn * 256 + wc * 32 + 8 * fq;
        const int row0 = u.pm * 256 + wr * 64 + fr;
#if RES16
        u32x4 hn[2];
#pragma unroll
        for (int bj = 0; bj < 2; ++bj) hn[bj] = *(const u32x4*)(HB + (size_t)row0 * DM + colw + bj * 128);
#else
        f32x4 hn[2][2];
#pragma unroll
        for (int bj = 0; bj < 2; ++bj) { const float* hi_ = Hin + (size_t)row0 * DM + colw + bj * 128; hn[bj][0] = *(const f32x4*)hi_; hn[bj][1] = *(const f32x4*)(hi_ + 4); }
#endif
#pragma unroll
        for (int i = 0; i < 8; ++i) {
            const int ai = i >> 2, m = i & 3;
            const int row = row0 + ai * 128 + m * 16;
            f32x4 hc[2][2];
#if RES16
#pragma unroll
            for (int bj = 0; bj < 2; ++bj) { hc[bj][0] = (f32x4){bflo(hn[bj].x), bfhi(hn[bj].x), bflo(hn[bj].y), bfhi(hn[bj].y)}; hc[bj][1] = (f32x4){bflo(hn[bj].z), bfhi(hn[bj].z), bflo(hn[bj].w), bfhi(hn[bj].w)}; }
            if (i < 7) {
                const int rown = row0 + ((i + 1) >> 2) * 128 + ((i + 1) & 3) * 16;
#pragma unroll
                for (int bj = 0; bj < 2; ++bj) hn[bj] = *(const u32x4*)(HB + (size_t)rown * DM + colw + bj * 128);
            }
#else
#pragma unroll
            for (int bj = 0; bj < 2; ++bj) { hc[bj][0] = hn[bj][0]; hc[bj][1] = hn[bj][1]; }
            if (i < 7) {
                const int rown = row0 + ((i + 1) >> 2) * 128 + ((i + 1) & 3) * 16;
#pragma unroll
                for (int bj = 0; bj < 2; ++bj) { const float* hi_ = Hin + (size_t)rown * DM + colw + bj * 128; hn[bj][0] = *(const f32x4*)hi_; hn[bj][1] = *(const f32x4*)(hi_ + 4); }
            }
#endif
            float ss = 0.f;
#pragma unroll
            for (int bj = 0; bj < 2; ++bj) {
                const int cb = colw + bj * 128;
                f32x4 h0 = hc[bj][0] + acc[ai][bj][m][0], h1 = hc[bj][1] + acc[ai][bj][m][1];
#if !RES16
                float* hp = H + (size_t)row * DM + cb;
                if (EPI_NT & 2) { __builtin_nontemporal_store(h0, (f32x4*)hp); __builtin_nontemporal_store(h1, (f32x4*)(hp + 4)); } else { *(f32x4*)hp = h0; *(f32x4*)(hp + 4) = h1; }
#endif
                u32x4 w; w.x = cvtpk(h0[0], h0[1]); w.y = cvtpk(h0[2], h0[3]); w.z = cvtpk(h1[0], h1[1]); w.w = cvtpk(h1[2], h1[3]);
                *(u32x4*)(HB + (size_t)row * DM + cb) = w;
                ss += (h0[0] * h0[0] + h0[1] * h0[1]) + (h0[2] * h0[2] + h0[3] * h0[3]) + (h1[0] * h1[0] + h1[1] * h1[1]) + (h1[2] * h1[2] + h1[3] * h1[3]);
            }
            ss += __shfl_xor(ss, 16); ss += __shfl_xor(ss, 32);
            if (fq == 0) ssq[(size_t)row * 16 + u.pn * 4 + wc] = ss;
        }
    }
};
#ifndef Q_I8
#define Q_I8 1
#endif
template <bool I8> struct EpiQT {
    static constexpr bool PERM = true, AFTER_DRAIN = false;
    __device__ __forceinline__ bool keep(const pg8::Unit&) const { return false; }
    bf16_t* Q; const float* ssq; const float* sx; const float* swq;
    __device__ __forceinline__ void operator()(const pg8::f32x4 (&acc)[2][2][4][2], const pg8::Unit& u, int wr, int wc, int fr, int fq) const {
        const int colw = u.pn * 256 + wc * 32 + 8 * fq;
        const int row0 = u.pm * 256 + wr * 64 + fr;
        float rsv[8];
#pragma unroll
        for (int i = 0; i < 4; ++i) rsv[i] = ssq16(ssq, row0 + (i & 3) * 16);
        asm volatile("" ::: "memory");
#pragma unroll
        for (int i = 4; i < 8; ++i) rsv[i] = ssq16(ssq, row0 + 128 + (i & 3) * 16);
#pragma unroll
        for (int i = 0; i < 8; ++i) rsv[i] = rsqrtf(rsv[i] * (1.0f / 1024.0f) + RMS_EPS);
        f32x4 swv[2][2];
        if constexpr (I8) {
#pragma unroll
            for (int i = 0; i < 8; ++i) rsv[i] *= sx[row0 + (i >> 2) * 128 + (i & 3) * 16];
#pragma unroll
            for (int bj = 0; bj < 2; ++bj) { swv[bj][0] = *(const f32x4*)(swq + colw + bj * 128); swv[bj][1] = *(const f32x4*)(swq + colw + bj * 128 + 4); }
        }
#pragma unroll
        for (int i = 0; i < 8; ++i) {
            const int ai = i >> 2, m = i & 3;
            const int row = row0 + ai * 128 + m * 16;
            const float rs = rsv[i];
#pragma unroll
            for (int bj = 0; bj < 2; ++bj) {
                const int cb = colw + bj * 128;
                f32x4 a, b;
                if constexpr (I8) {
#pragma unroll
                    for (int e = 0; e < 4; ++e) { a[e] = (float)__float_as_int(acc[ai][bj][m][0][e]) * swv[bj][0][e] * rs; b[e] = (float)__float_as_int(acc[ai][bj][m][1][e]) * swv[bj][1][e] * rs; }
                } else { a = acc[ai][bj][m][0] * rs; b = acc[ai][bj][m][1] * rs; }
                u32x4 w; w.x = cvtpk(a[0], a[1]); w.y = cvtpk(a[2], a[3]); w.z = cvtpk(b[0], b[1]); w.w = cvtpk(b[2], b[3]);
                if (EPI_NT & 4) __builtin_nontemporal_store(w, (u32x4*)(Q + (size_t)row * 2048 + cb)); else *(u32x4*)(Q + (size_t)row * 2048 + cb) = w;
            }
        }
    }
};

constexpr int VRP = 144;
constexpr int ATT_WAVE_LDS = 32 * VRP + 256 + 8192;
__device__ __forceinline__ int crow(int r, int hi) { return (r & 3) + 8 * (r >> 2) + 4 * hi; }

struct AttState { float m, l; f32x16 o0, o1; };
struct KTile { u32x4 k0, k1, k2, k3; float ck; };
struct VTile { u32x4 v0, v1, v2, v3; };
struct KFrag { bf16x8 k0, k1, k2, k3; };

#ifndef PROBE_HOT
#define PROBE_HOT 0
#endif
template <bool BIAS>
__device__ __forceinline__ void k_load(KTile& t, const bf16_t* __restrict__ Pb, int kcol, int r, int ktile, const float* __restrict__ cumT, int lane, int hot = 0) {
    const int row = lane >> 3, ch = lane & 7;
    const bf16_t* base = Pb + kcol + 8 * ch;
    int t0 = ktile + row * r, t1 = t0 + 8 * r, t2 = t0 + 16 * r, t3 = t0 + 24 * r;
    t0 = t0 < 0 ? 0 : (t0 > SEQ - 1 ? SEQ - 1 : t0); t1 = t1 < 0 ? 0 : (t1 > SEQ - 1 ? SEQ - 1 : t1);
    t2 = t2 < 0 ? 0 : (t2 > SEQ - 1 ? SEQ - 1 : t2); t3 = t3 < 0 ? 0 : (t3 > SEQ - 1 ? SEQ - 1 : t3);
    if (PROBE_HOT && hot) { t0 &= 255; t1 &= 255; t2 &= 255; t3 &= 255; }
    t.k0 = *(const u32x4*)(base + (size_t)t0 * NP); t.k1 = *(const u32x4*)(base + (size_t)t1 * NP); t.k2 = *(const u32x4*)(base + (size_t)t2 * NP); t.k3 = *(const u32x4*)(base + (size_t)t3 * NP);
    t.ck = 0.f;
    if (BIAS) { int tk_l = ktile + (lane & 31) * r; tk_l = tk_l < 0 ? 0 : (tk_l > SEQ - 1 ? SEQ - 1 : tk_l); t.ck = cumT[tk_l]; }
}
__device__ __forceinline__ void v_load(VTile& t, const bf16_t* __restrict__ Pb, int vcol, int r, int ktile, int lane, int hot = 0) {
    const int row = lane >> 3, ch = lane & 7;
    const bf16_t* base = Pb + vcol + 8 * ch;
    int t0 = ktile + row * r, t1 = t0 + 8 * r, t2 = t0 + 16 * r, t3 = t0 + 24 * r;
    t0 = t0 < 0 ? 0 : (t0 > SEQ - 1 ? SEQ - 1 : t0); t1 = t1 < 0 ? 0 : (t1 > SEQ - 1 ? SEQ - 1 : t1);
    t2 = t2 < 0 ? 0 : (t2 > SEQ - 1 ? SEQ - 1 : t2); t3 = t3 < 0 ? 0 : (t3 > SEQ - 1 ? SEQ - 1 : t3);
    if (PROBE_HOT && hot) { t0 &= 255; t1 &= 255; t2 &= 255; t3 &= 255; }
    t.v0 = *(const u32x4*)(base + (size_t)t0 * NP); t.v1 = *(const u32x4*)(base + (size_t)t1 * NP); t.v2 = *(const u32x4*)(base + (size_t)t2 * NP); t.v3 = *(const u32x4*)(base + (size_t)t3 * NP);
}
__device__ __forceinline__ void k_stage(const KTile& t, LAS unsigned char* vl, KFrag& f, int lane) {
    asm volatile("" ::: "memory");
    {
        LAS unsigned char* wp = vl + (lane >> 3) * VRP + (lane & 7) * 16;
        *(LAS u32x4*)(wp) = t.k0; *(LAS u32x4*)(wp + 8 * VRP) = t.k1; *(LAS u32x4*)(wp + 16 * VRP) = t.k2; *(LAS u32x4*)(wp + 24 * VRP) = t.k3;
    }
    asm volatile("s_waitcnt lgkmcnt(0)" ::: "memory");
    const LAS unsigned char* rp = vl + (lane & 31) * VRP + (lane >> 5) * 16;
    f.k0 = *(const LAS bf16x8*)(rp); f.k1 = *(const LAS bf16x8*)(rp + 32); f.k2 = *(const LAS bf16x8*)(rp + 64); f.k3 = *(const LAS bf16x8*)(rp + 96);
    asm volatile("s_waitcnt lgkmcnt(0)" ::: "memory");
}
template <bool BIAS>
__device__ __forceinline__ void v_stage(const VTile& t, float ck, LAS unsigned char* vl, bf16x8 (&vf)[2][2], int lane) {
    const int hi = lane >> 5, l31 = lane & 31, q4 = (lane & 15) >> 2, p4 = lane & 3, g1 = (lane >> 4) & 1;
    asm volatile("" ::: "memory");
    {
        LAS unsigned char* wp = vl + (lane >> 3) * VRP + (lane & 7) * 16;
        *(LAS u32x4*)(wp) = t.v0; *(LAS u32x4*)(wp + 8 * VRP) = t.v1; *(LAS u32x4*)(wp + 16 * VRP) = t.v2; *(LAS u32x4*)(wp + 24 * VRP) = t.v3;
        if (BIAS) { if (hi == 0) ((LAS float*)(vl + 32 * VRP))[l31] = ck; }
    }
    asm volatile("s_waitcnt lgkmcnt(0)" ::: "memory");
    const LAS unsigned char* vb = vl + (4 * hi + q4) * VRP + (16 * g1 + 4 * p4) * 2;
#pragma unroll
    for (int dblk = 0; dblk < 2; ++dblk)
#pragma unroll
        for (int s2 = 0; s2 < 2; ++s2) {
            const LAS unsigned char* a = vb + (16 * s2) * VRP + dblk * 64;
            const v4i16_t lo = __builtin_amdgcn_ds_read_tr16_b64_v4i16((LAS v4i16_t*)a);
            const v4i16_t hh = __builtin_amdgcn_ds_read_tr16_b64_v4i16((LAS v4i16_t*)(a + 8 * VRP));
            vf[dblk][s2] = (bf16x8){lo[0], lo[1], lo[2], lo[3], hh[0], hh[1], hh[2], hh[3]};
        }
}
__device__ __forceinline__ float max_halves(float v) {
    const auto rr = __builtin_amdgcn_permlane32_swap(__float_as_uint(v), __float_as_uint(v), false, false);
    return fmaxf(__uint_as_float(rr[0]), __uint_as_float(rr[1]));
}
__device__ __forceinline__ void softmax_pv(f32x16& s, float scale, AttState& st, const bf16x8 (&vf)[2][2]) {
    float mx = s[0];
#pragma unroll
    for (int i = 1; i < 16; ++i) mx = fmaxf(mx, s[i]);
    mx = max_halves(mx) * scale;
    float m_use = (st.m == -INFINITY) ? 0.f : st.m;
    if (!__all(mx <= st.m + 8.0f)) {
        const float m_new = fmaxf(st.m, mx);
        m_use = (m_new == -INFINITY) ? 0.f : m_new;
        const float alpha = __builtin_amdgcn_exp2f(st.m - m_use);
        st.l *= alpha; st.m = m_new;
#pragma unroll
        for (int i = 0; i < 16; ++i) { st.o0[i] *= alpha; st.o1[i] *= alpha; }
    }
    float rsum = 0.f;
#pragma unroll
    for (int i = 0; i < 16; ++i) { s[i] = __builtin_amdgcn_exp2f(fmaf(s[i], scale, -m_use)); rsum += s[i]; }
    st.l += rsum;
    u32x4 pw0, pw1;
    pw0.x = cvtpk(s[0], s[1]); pw0.y = cvtpk(s[2], s[3]); pw0.z = cvtpk(s[4], s[5]); pw0.w = cvtpk(s[6], s[7]);
    pw1.x = cvtpk(s[8], s[9]); pw1.y = cvtpk(s[10], s[11]); pw1.z = cvtpk(s[12], s[13]); pw1.w = cvtpk(s[14], s[15]);
    const bf16x8 pb0 = __builtin_bit_cast(bf16x8, pw0), pb1 = __builtin_bit_cast(bf16x8, pw1);
    st.o0 = __builtin_amdgcn_mfma_f32_32x32x16_bf16(vf[0][0], pb0, st.o0, 0, 0, 0);
    st.o0 = __builtin_amdgcn_mfma_f32_32x32x16_bf16(vf[0][1], pb1, st.o0, 0, 0, 0);
    st.o1 = __builtin_amdgcn_mfma_f32_32x32x16_bf16(vf[1][0], pb0, st.o1, 0, 0, 0);
    st.o1 = __builtin_amdgcn_mfma_f32_32x32x16_bf16(vf[1][1], pb1, st.o1, 0, 0, 0);
}
__device__ __forceinline__ f32x16 qk_tile(const KFrag& t, const bf16x8 (&qf)[4]) {
    f32x16 s;
#pragma unroll
    for (int i = 0; i < 16; ++i) s[i] = 0.f;
    s = __builtin_amdgcn_mfma_f32_32x32x16_bf16(t.k0, qf[0], s, 0, 0, 0);
    s = __builtin_amdgcn_mfma_f32_32x32x16_bf16(t.k1, qf[1], s, 0, 0, 0);
    s = __builtin_amdgcn_mfma_f32_32x32x16_bf16(t.k2, qf[2], s, 0, 0, 0);
    s = __builtin_amdgcn_mfma_f32_32x32x16_bf16(t.k3, qf[3], s, 0, 0, 0);
    return s;
}

__device__ __forceinline__ f32x16 qk_tile_lds(const KFrag& t, const LAS unsigned char* qb) {
    f32x16 s;
#pragma unroll
    for (int i = 0; i < 16; ++i) s[i] = 0.f;
    s = __builtin_amdgcn_mfma_f32_32x32x16_bf16(t.k0, *(const LAS bf16x8*)(qb), s, 0, 0, 0);
    s = __builtin_amdgcn_mfma_f32_32x32x16_bf16(t.k1, *(const LAS bf16x8*)(qb + 1024), s, 0, 0, 0);
    s = __builtin_amdgcn_mfma_f32_32x32x16_bf16(t.k2, *(const LAS bf16x8*)(qb + 2048), s, 0, 0, 0);
    s = __builtin_amdgcn_mfma_f32_32x32x16_bf16(t.k3, *(const LAS bf16x8*)(qb + 3072), s, 0, 0, 0);
    return s;
}

template <int r>
__device__ __forceinline__ void attn_segment(const bf16_t* __restrict__ Pb, int kcol, int vcol, int maxd_tok, int kt0, int ntiles, int tq,
                                             const bf16x8 (&qf)[4], AttState& st, LAS unsigned char* vl, int lane, int hot = 0) {
    const int hi = lane >> 5;
    const int lim = maxd_tok < tq ? maxd_tok : tq;
    KTile nx; VTile vnx;
    k_load<false>(nx, Pb, kcol, r, kt0, nullptr, lane, hot); v_load(vnx, Pb, vcol, r, kt0, lane, hot);
    for (int j = 0; j < ntiles; ++j) {
        const int ktile = kt0 + j * 32 * r;
        const VTile vt = vnx;
        const KTile cur = nx;
        if (j + 1 < ntiles) { k_load<false>(nx, Pb, kcol, r, ktile + 32 * r, nullptr, lane, hot); v_load(vnx, Pb, vcol, r, ktile + 32 * r, lane, hot); }
        KFrag kf; k_stage(cur, vl, kf, lane);
        f32x16 s = qk_tile(kf, qf);
        bf16x8 vf[2][2];
        v_stage<false>(vt, 0.f, vl, vf, lane);
        const int dbase = tq - ktile - 4 * hi * r;
#pragma unroll
        for (int i = 0; i < 16; ++i) {
            const int d = dbase - crow(i, 0) * r;
            s[i] = ((unsigned)d <= (unsigned)lim) ? s[i] : -INFINITY;
        }
        softmax_pv(s, QK_SCALE2, st, vf);
        asm volatile("s_waitcnt lgkmcnt(0)" ::: "memory");
    }
}

__device__ __forceinline__ void attn_load_q(const bf16_t* __restrict__ Pb, int tq, int qcol, int hi, bf16x8 (&qf)[4]) {
    const bf16_t* qp = Pb + (size_t)tq * NP + qcol + 8 * hi;
    qf[0] = *(const bf16x8*)(qp); qf[1] = *(const bf16x8*)(qp + 16); qf[2] = *(const bf16x8*)(qp + 32); qf[3] = *(const bf16x8*)(qp + 48);
}
__device__ __forceinline__ void attn_store_o(bf16_t* __restrict__ Pb, int tq, int ocol, int hi, AttState& st, int dry) {
    float l = st.l + __shfl_xor(st.l, 32);
    if (dry && l >= 0.f) return;
    const float inv = 1.0f / l;
    bf16_t* op = Pb + (size_t)tq * NP + ocol + 4 * hi;
#pragma unroll
    for (int g = 0; g < 4; ++g) {
        u32x2 w0, w1;
        w0.x = cvtpk(st.o0[4 * g] * inv, st.o0[4 * g + 1] * inv); w0.y = cvtpk(st.o0[4 * g + 2] * inv, st.o0[4 * g + 3] * inv);
        w1.x = cvtpk(st.o1[4 * g] * inv, st.o1[4 * g + 1] * inv); w1.y = cvtpk(st.o1[4 * g + 2] * inv, st.o1[4 * g + 3] * inv);
        *(u32x2*)(op + 8 * g) = w0; *(u32x2*)(op + 32 + 8 * g) = w1;
    }
}
__device__ __forceinline__ void att_init(AttState& st) {
#pragma unroll
    for (int i = 0; i < 16; ++i) { st.o0[i] = 0.f; st.o1[i] = 0.f; }
    st.m = -INFINITY; st.l = 0.f;
}

__device__ __forceinline__ void attn_fox_pair(bf16_t* __restrict__ Pb, const float* __restrict__ cumT, float kmax2, int h, int qp, LAS unsigned char* vl, int lane, int dry) {
    const int hi = lane >> 5, l31 = lane & 31;
    const int kcol = PC_KB + 64 * h, vcol = PC_VB + 64 * h, qcol = PC_QB + 64 * h;
    const LAS float* ckl = (const LAS float*)(vl + 32 * VRP);
    AttState st0, st1; att_init(st0); att_init(st1);
    const int tq0 = 64 * qp + l31, tq1 = tq0 + 32;
    LAS unsigned char* qb0 = vl + 32 * VRP + 256 + hi * 512 + l31 * 16;
    LAS unsigned char* qb1 = qb0 + 4096;
    {
        bf16x8 qf[4];
        attn_load_q(Pb, tq0, qcol, hi, qf);
#pragma unroll
        for (int s_ = 0; s_ < 4; ++s_) *(LAS bf16x8*)(qb0 + 1024 * s_) = qf[s_];
        attn_load_q(Pb, tq1, qcol, hi, qf);
#pragma unroll
        for (int s_ = 0; s_ < 4; ++s_) *(LAS bf16x8*)(qb1 + 1024 * s_) = qf[s_];
        asm volatile("s_waitcnt lgkmcnt(0)" ::: "memory");
    }
    const float cq0 = cumT[tq0], cq1 = cumT[tq1];
    float bound0, bound1;
    {
        float n0 = 0.f, n1 = 0.f;
#pragma unroll
        for (int s_ = 0; s_ < 4; ++s_) {
            const bf16x8 a = *(const LAS bf16x8*)(qb0 + 1024 * s_), b = *(const LAS bf16x8*)(qb1 + 1024 * s_);
#pragma unroll
            for (int e = 0; e < 8; ++e) { const float fa = bflo((unsigned)(unsigned short)a[e]), fb = bflo((unsigned)(unsigned short)b[e]); n0 = fmaf(fa, fa, n0); n1 = fmaf(fb, fb, n1); }
        }
        n0 += __shfl_xor(n0, 32); n1 += __shfl_xor(n1, 32);
        bound0 = sqrtf(n0 * kmax2) * QK_SCALE2 * 1.01f + 0.5f; bound1 = sqrtf(n1 * kmax2) * QK_SCALE2 * 1.01f + 0.5f;
    }
    constexpr float FOX_SKIP = 48.0f;
    const int ntiles = 2 * qp + 2;
    KTile nx;
    k_load<true>(nx, Pb, kcol, 1, 32 * (ntiles - 1), cumT, lane);
    for (int j = ntiles - 1; j >= 0; --j) {
        VTile vt; v_load(vt, Pb, vcol, 1, 32 * j, lane);
        const KTile cur = nx;
        if (j > 0) k_load<true>(nx, Pb, kcol, 1, 32 * (j - 1), cumT, lane);
        KFrag kf; k_stage(cur, vl, kf, lane);
        f32x16 s1 = qk_tile_lds(kf, qb1);
        f32x16 s0;
        const bool on0 = (j <= 2 * qp);
        if (on0) s0 = qk_tile_lds(kf, qb0);
        bf16x8 vf[2][2];
        v_stage<true>(vt, cur.ck, vl, vf, lane);
        if (on0) {
            const bool diag = (j == 2 * qp);
#pragma unroll
            for (int g = 0; g < 4; ++g) { const f32x4 c4 = *(const LAS f32x4*)(ckl + 8 * g + 4 * hi);
#pragma unroll
                for (int e = 0; e < 4; ++e) { const int i = 4 * g + e; const float v = fmaf(s0[i], QK_SCALE2, cq0 - c4[e]); s0[i] = (diag && crow(i, hi) > l31) ? -INFINITY : v; } }
            softmax_pv(s0, 1.0f, st0, vf);
        }
        {
            const bool diag = (j == 2 * qp + 1);
#pragma unroll
            for (int g = 0; g < 4; ++g) { const f32x4 c4 = *(const LAS f32x4*)(ckl + 8 * g + 4 * hi);
#pragma unroll
                for (int e = 0; e < 4; ++e) { const int i = 4 * g + e; const float v = fmaf(s1[i], QK_SCALE2, cq1 - c4[e]); s1[i] = (diag && crow(i, hi) > l31) ? -INFINITY : v; } }
            softmax_pv(s1, 1.0f, st1, vf);
        }
        asm volatile("s_waitcnt lgkmcnt(0)" ::: "memory");
        if (j > 0) {
            const float ckn = __int_as_float(__builtin_amdgcn_readlane(__float_as_int(nx.ck), 31));
            const bool dead0 = (cq0 - ckn + bound0) < (st0.m - FOX_SKIP), dead1 = (cq1 - ckn + bound1) < (st1.m - FOX_SKIP);
            if (__all(dead0 && dead1)) break;
        }
    }
    attn_store_o(Pb, tq0, qcol, hi, st0, dry);
    attn_store_o(Pb, tq1, qcol, hi, st1, dry);
}

#ifndef ATT_POP_G
#define ATT_POP_G 1
#endif
#ifndef MIXA_3PASS
#define MIXA_3PASS 0
#endif
#ifndef MIXA_ACQ
#define MIXA_ACQ 1
#endif
#ifndef MIXA_REL
#define MIXA_REL 0
#endif
typedef unsigned long long u64_t;
#ifndef MIXA_ONLY
#define MIXA_ONLY -1
#endif
#ifndef MIXA_PLAIN
#define MIXA_PLAIN 0
#endif
__device__ __forceinline__ void st_wt8(void* p, u32x2 v) { if (MIXA_PLAIN) *(u32x2*)p = v; else __hip_atomic_store((u64_t*)p, ((u64_t)v.y << 32) | v.x, __ATOMIC_RELAXED, __HIP_MEMORY_SCOPE_AGENT); }
__device__ __forceinline__ u32x2 ld_wt8(const void* p) { if (MIXA_PLAIN) return *(const u32x2*)p; const u64_t x = __hip_atomic_load((const u64_t*)p, __ATOMIC_RELAXED, __HIP_MEMORY_SCOPE_AGENT); return (u32x2){(unsigned)x, (unsigned)(x >> 32)}; }
__device__ __forceinline__ void st_wt4(float* p, float v) { if (MIXA_PLAIN) *p = v; else __hip_atomic_store(p, v, __ATOMIC_RELAXED, __HIP_MEMORY_SCOPE_AGENT); }
__device__ __forceinline__ float ld_wt4(const float* p) { if (MIXA_PLAIN) return *p; return __hip_atomic_load(p, __ATOMIC_RELAXED, __HIP_MEMORY_SCOPE_AGENT); }
__device__ __forceinline__ void mixa_store_partial(bf16_t* __restrict__ AO, float* __restrict__ ALSE, int pat, size_t tok  , int bh, int t, int h, int hi, AttState& st) {
    const float l = st.l + __shfl_xor(st.l, 32);
    const float inv = 1.0f / l;
    bf16_t* op = AO + ((size_t)pat * T + tok) * 384 + h * 64 + 4 * hi;
#pragma unroll
    for (int g = 0; g < 4; ++g) {
        u32x2 w0, w1;
        w0.x = cvtpk(st.o0[4 * g] * inv, st.o0[4 * g + 1] * inv); w0.y = cvtpk(st.o0[4 * g + 2] * inv, st.o0[4 * g + 3] * inv);
        w1.x = cvtpk(st.o1[4 * g] * inv, st.o1[4 * g + 1] * inv); w1.y = cvtpk(st.o1[4 * g + 2] * inv, st.o1[4 * g + 3] * inv);
        st_wt8(op + 8 * g, w0); st_wt8(op + 32 + 8 * g, w1);
    }
    if (hi == 0) st_wt4(ALSE + ((size_t)pat * (BATCH * 6) + bh) * SEQ + t, st.m + __builtin_amdgcn_logf(l));
}
__device__ __forceinline__ void mixa_combine(bf16_t* __restrict__ Pb, const bf16_t* __restrict__ AO, const float* __restrict__ ALSE, size_t tok, int bh, int t, int h, int hi) {
    float ls[3], mx;
#pragma unroll
    for (int p = 0; p < 3; ++p) ls[p] = ld_wt4(ALSE + ((size_t)p * (BATCH * 6) + bh) * SEQ + t);
    mx = fmaxf(ls[0], fmaxf(ls[1], ls[2]));
    float w[3], ws = 0.f;
#pragma unroll
    for (int p = 0; p < 3; ++p) { w[p] = __builtin_amdgcn_exp2f(ls[p] - mx); if (MIXA_ONLY >= 0) w[p] = (p == MIXA_ONLY) ? 1.f : 0.f; ws += w[p]; }
    const float iw = 1.0f / ws;
    float acc[32];
#pragma unroll
    for (int i = 0; i < 32; ++i) acc[i] = 0.f;
#pragma unroll
    for (int p = 0; p < 3; ++p) {
        const bf16_t* ip = AO + ((size_t)p * T + tok) * 384 + h * 64 + 32 * hi;
        const float wp = w[p] * iw;
#pragma unroll
        for (int c = 0; c < 8; ++c) { const u32x2 v = ld_wt8(ip + 4 * c);
            acc[4 * c] = fmaf(wp, bflo(v.x), acc[4 * c]); acc[4 * c + 1] = fmaf(wp, bfhi(v.x), acc[4 * c + 1]); acc[4 * c + 2] = fmaf(wp, bflo(v.y), acc[4 * c + 2]); acc[4 * c + 3] = fmaf(wp, bfhi(v.y), acc[4 * c + 3]); }
    }
    bf16_t* op = Pb + (size_t)t * NP + PC_QA + 64 * h + 32 * hi;
#pragma unroll
    for (int c = 0; c < 4; ++c) { u32x4 w4; w4.x = cvtpk(acc[8 * c], acc[8 * c + 1]); w4.y = cvtpk(acc[8 * c + 2], acc[8 * c + 3]); w4.z = cvtpk(acc[8 * c + 4], acc[8 * c + 5]); w4.w = cvtpk(acc[8 * c + 6], acc[8 * c + 7]);
        *(u32x4*)(op + 8 * c) = w4; }
}

__device__ __forceinline__ void attention_phase(unsigned char* __restrict__ ws, const float* __restrict__ sinks, int ctr_word, int grp_word, int kmax_word, LAS unsigned char* lds, int wave, int lane, int dry) {
#define ATT_P ((bf16_t*)(ws + WS_P))
#define ATT_CUMT ((const float*)(ws + WS_CUMT))
#define ATT_AO ((bf16_t*)(ws + WS_AO))
#define ATT_ALSE ((float*)(ws + WS_ALSE))
    LAS unsigned char* vl = lds + wave * ATT_WAVE_LDS;
    const int hi = lane >> 5, l31 = lane & 31;
    constexpr int NUB = 3072, NU = 6144;
    constexpr int NUA = MIXA_3PASS ? 3 * NU : NU;
    constexpr int NUTOT = NUB + NUA + NU + (MIXA_3PASS == 1 ? NU : 0) ;
    int pend = -1;
    unsigned ucur = 0, uend = 0;
    for (;;) {
        if (ucur == uend) {
            unsigned u0 = 0;
            if (lane == 0) {
                if (MIXA_3PASS && pend >= 0) __hip_atomic_fetch_add((unsigned*)ws + grp_word + pend, 1u, __ATOMIC_RELAXED, __HIP_MEMORY_SCOPE_AGENT);
                u0 = atomicAdd((unsigned*)ws + ctr_word, (unsigned)ATT_POP_G);
            }
            pend = -1;
            ucur = (unsigned)__builtin_amdgcn_readfirstlane((int)u0); uend = ucur + ATT_POP_G;
        }
        const unsigned u = ucur++;
        if (u >= (unsigned)NUTOT) break;
        if (u < (unsigned)NUB) {
            const int qp = 127 - (int)(u / 24), bh = (int)(u % 24), b = bh / 6, h = bh % 6;
            attn_fox_pair(ATT_P + (size_t)b * SEQ * NP, ATT_CUMT + (size_t)bh * SEQ, ((const float*)ws)[kmax_word + bh], h, qp, vl, lane, dry);
        } else if (MIXA_3PASS && u < (unsigned)(NUB + NUA)) {
            const int v = (int)u - NUB;
            const int pat = v / NU, w_ = v - pat * NU, bh = w_ >> 8, x_ = w_ & 255, b = bh / 6, h = bh % 6;
            const int r = pat == 0 ? 1 : (pat == 1 ? 4 : 16);
            const int rho = pat == 0 ? 0 : (pat == 1 ? (x_ & 3) : (x_ & 15)), cb = pat == 0 ? x_ : (pat == 1 ? (x_ >> 2) : (x_ >> 4));
            bf16_t* Pb = ATT_P + (size_t)b * SEQ * NP;
            const int tq0 = rho + r * 32 * cb, tq = tq0 + r * l31;
            AttState st; att_init(st); bf16x8 qf[4];
            attn_load_q(Pb, tq, PC_QA + 64 * h, hi, qf);
            if (pat == 0)      attn_segment<1>(Pb, PC_KA + 64 * h, PC_VA + 64 * h, 128, tq0 - 128, 5, tq, qf, st, vl, lane);
            else if (pat == 1) attn_segment<4>(Pb, PC_KA + 64 * h, PC_VA + 64 * h, 512, tq0 - 512, 5, tq, qf, st, vl, lane);
            else               attn_segment<16>(Pb, PC_KA + 64 * h, PC_VA + 64 * h, 2048, tq0 - 2048, 5, tq, qf, st, vl, lane);
            if (!dry) {
                mixa_store_partial(ATT_AO, ATT_ALSE, pat, (size_t)b * SEQ + tq, bh, tq, h, hi, st);
                asm volatile("s_waitcnt vmcnt(0)" ::: "memory");
                if (MIXA_REL) { __builtin_amdgcn_fence(__ATOMIC_RELEASE, "agent"); asm volatile("s_waitcnt vmcnt(0)" ::: "memory"); }
                pend = bh * 16 + (tq0 >> 9);
            }
        } else if (MIXA_3PASS == 1 && u >= (unsigned)(NUB + NUA + NU)) {
            const int v = (int)u - (NUB + NUA + NU);
            const int qt = v & 255, bh = v >> 8, b = bh / 6, h = bh % 6;
            if (!dry) {
                unsigned* cw = (unsigned*)ws + grp_word + bh * 16 + (qt >> 4);
                unsigned spins = 0;
                while ((unsigned)__builtin_amdgcn_readfirstlane((int)__hip_atomic_load(cw, __ATOMIC_RELAXED, __HIP_MEMORY_SCOPE_AGENT)) < 48u) {
                    __builtin_amdgcn_s_sleep(8);
                    if (++spins > (1u << 22)) break;
                }
                if (MIXA_ACQ) { __builtin_amdgcn_fence(__ATOMIC_ACQUIRE, "agent"); asm volatile("s_waitcnt vmcnt(0)" ::: "memory"); }
                mixa_combine(ATT_P + (size_t)b * SEQ * NP, ATT_AO, ATT_ALSE, (size_t)b * SEQ + qt * 32 + l31, bh, qt * 32 + l31, h, hi);
            }
        } else if (!MIXA_3PASS && u < (unsigned)(NUB + NU)) {
            const int v = (int)u - NUB;
            const int cb = v & 15, rho = (v >> 4) & 15, bh = v >> 8, b = bh / 6, h = bh % 6;
            bf16_t* Pb = ATT_P + (size_t)b * SEQ * NP;
            const int tq0 = rho + 512 * cb, tq = tq0 + 16 * l31;
            AttState st; att_init(st); bf16x8 qf[4];
            attn_load_q(Pb, tq, PC_QA + 64 * h, hi, qf);
            attn_segment<16>(Pb, PC_KA + 64 * h, PC_VA + 64 * h, 2048, tq0 - 2048, 5, tq, qf, st, vl, lane, dry);
            attn_segment<4>(Pb, PC_KA + 64 * h, PC_VA + 64 * h, 512, tq0 - 512, 8, tq, qf, st, vl, lane, dry);
            attn_segment<1>(Pb, PC_KA + 64 * h, PC_VA + 64 * h, 128, tq0 - 128, 20, tq, qf, st, vl, lane, dry);
            attn_store_o(Pb, tq, PC_QA + 64 * h, hi, st, dry);
        } else {
            const int v = (int)u - NUB - NUA;
            const int qt = v & 255, bh = v >> 8, b = bh / 6, h = bh % 6, hk = h / 3;
            bf16_t* Pb = ATT_P + (size_t)b * SEQ * NP;
            const int tq = qt * 32 + l31;
            AttState st; att_init(st); bf16x8 qf[4];
            attn_load_q(Pb, tq, PC_QC + 64 * h, hi, qf);
            st.m = sinks[h] * LOG2E; st.l = (hi == 0) ? 1.f : 0.f;
            attn_segment<1>(Pb, PC_KC + 64 * hk, PC_VC + 64 * hk, 127, qt * 32 - 128, 5, tq, qf, st, vl, lane);
            attn_store_o(Pb, tq, PC_QC + 64 * h, hi, st, dry);
        }
    }
}

#ifndef ATT_XCD
#define ATT_XCD 0
#endif
__device__ __forceinline__ void attention_phase_x(unsigned char* __restrict__ ws, const float* __restrict__ sinks, int ctr_word  , int kmax_word, LAS unsigned char* lds, int wave, int lane, int xcc) {
    LAS unsigned char* vl = lds + wave * ATT_WAVE_LDS;
    const int hi = lane >> 5, l31 = lane & 31;
    constexpr int QB = 3 * 128, QA = 3 * 256, QC = 3 * 256, QN = QB + QA + QC;
    int q = xcc & 7;
    int tried = 0;
    for (;;) {
        unsigned j = 0;
        if (lane == 0) j = atomicAdd((unsigned*)ws + ctr_word + q, 1u);
        j = __builtin_amdgcn_readfirstlane(j);
        if (j >= (unsigned)QN) {
            tried |= 1 << q;
            if (tried == 0xff) break;
            const unsigned cv = ((volatile const unsigned*)ws)[ctr_word + (lane & 7)];
            int nq = -1;
#pragma unroll
            for (int k = 1; k < 8; ++k) { const int qq = (q + k) & 7; const unsigned c_ = (unsigned)__builtin_amdgcn_readlane((int)cv, qq); if (nq < 0 && !((tried >> qq) & 1)) { if (c_ < (unsigned)QN) nq = qq; else tried |= 1 << qq; } }
            if (nq < 0) break;
            q = nq; continue;
        }
        if (j < (unsigned)QB) {
            const int bh = q + 8 * (int)(j >> 7), qp = 127 - (int)(j & 127), b = bh / 6, h = bh % 6;
            attn_fox_pair(ATT_P + (size_t)b * SEQ * NP, ATT_CUMT + (size_t)bh * SEQ, ((const float*)ws)[kmax_word + bh], h, qp, vl, lane, 0);
        } else if (j < (unsigned)(QB + QA)) {
            const int jj = (int)j - QB, bh = q + 8 * (jj >> 8), v = jj & 255, b = bh / 6, h = bh % 6;
            const int cb = v & 15, rho = v >> 4;
            bf16_t* Pb = ATT_P + (size_t)b * SEQ * NP;
            const int tq0 = rho + 512 * cb, tq = tq0 + 16 * l31;
            AttState st; att_init(st); bf16x8 qf[4];
            attn_load_q(Pb, tq, PC_QA + 64 * h, hi, qf);
            attn_segment<16>(Pb, PC_KA + 64 * h, PC_VA + 64 * h, 2048, tq0 - 2048, 5, tq, qf, st, vl, lane);
            attn_segment<4>(Pb, PC_KA + 64 * h, PC_VA + 64 * h, 512, tq0 - 512, 8, tq, qf, st, vl, lane);
            attn_segment<1>(Pb, PC_KA + 64 * h, PC_VA + 64 * h, 128, tq0 - 128, 20, tq, qf, st, vl, lane);
            attn_store_o(Pb, tq, PC_QA + 64 * h, hi, st, 0);
        } else {
            const int jj = (int)j - QB - QA, bh = q + 8 * (jj >> 8), qt = jj & 255, b = bh / 6, h = bh % 6, hk = h / 3;
            bf16_t* Pb = ATT_P + (size_t)b * SEQ * NP;
            const int tq = qt * 32 + l31;
            AttState st; att_init(st); bf16x8 qf[4];
            attn_load_q(Pb, tq, PC_QC + 64 * h, hi, qf);
            st.m = sinks[h] * LOG2E; st.l = (hi == 0) ? 1.f : 0.f;
            attn_segment<1>(Pb, PC_KC + 64 * hk, PC_VC + 64 * hk, 127, qt * 32 - 128, 5, tq, qf, st, vl, lane);
            attn_store_o(Pb, tq, PC_QC + 64 * h, hi, st, 0);
        }
    }
}

__device__ __forceinline__ int f2key(float f) { const int b = __float_as_int(f); return b ^ ((b >> 31) & 0x7fffffff); }
__device__ __forceinline__ float key2f(int k) { return __int_as_float(k ^ ((k >> 31) & 0x7fffffff)); }
#define CE_DESC(a, x) do { const int hi_ = max((a), (x)); (x) = min((a), (x)); (a) = hi_; } while (0)

__device__ __forceinline__ void route_half(const bf16_t* __restrict__ qrow, const LAS unsigned char* kl, int (&list)[16]) {
    unsigned qh[64];
#pragma unroll
    for (int c = 0; c < 16; ++c) { const u32x4 t = *(const u32x4*)(qrow + 8 * c); qh[4 * c] = t.x; qh[4 * c + 1] = t.y; qh[4 * c + 2] = t.z; qh[4 * c + 3] = t.w; }
#pragma unroll
    for (int i = 0; i < 16; ++i) list[i] = (int)0x80000000;
    for (int key = 0; key < 128; ++key) {
        float a0 = 0.f, a1 = 0.f;
        const LAS unsigned char* kp = kl + key * 256;
#pragma unroll
        for (int c = 0; c < 16; ++c) {
            const u32x4 kk = *(const LAS u32x4*)(kp + 16 * c);
            a0 = dot2bf(qh[4 * c], kk.x, a0); a1 = dot2bf(qh[4 * c + 1], kk.y, a1);
            a0 = dot2bf(qh[4 * c + 2], kk.z, a0); a1 = dot2bf(qh[4 * c + 3], kk.w, a1);
        }
        int x = (f2key(a0 + a1) & ~127) | key;
#pragma unroll
        for (int i = 0; i < 16; ++i) CE_DESC(list[i], x);
    }
}

__device__ __forceinline__ void routing_phase(const bf16_t* __restrict__ Q2, const float* __restrict__ k1, const float* __restrict__ k2, int* __restrict__ ids, float* __restrict__ gw,
                                              LAS unsigned char* lds, int tid) {
    for (int e = tid; e < 2 * 8192; e += 512) {
        const int hf = e >> 13, o = (e & 8191) * 2;
        const float* src = (hf ? k2 : k1) + o;
        *(LAS unsigned*)(lds + hf * 32768 + o * 2) = cvtpk(src[0], src[1]);
    }
    __syncthreads();
    const int nthreads = gridDim.x * 512;
    for (int it = blockIdx.x * 512 + tid; it < T * 8; it += nthreads) {
        const int t = it >> 3, h = it & 7;
        const bf16_t* qrow = Q2 + (size_t)t * 2048 + h * 256;
        int l1[16], l2[16];
        route_half(qrow, lds, l1);
        route_half(qrow + 128, lds + 32768, l2);
        float f1[16], f2[16];
#pragma unroll
        for (int i = 0; i < 16; ++i) { f1[i] = key2f(l1[i] & ~127); f2[i] = key2f(l2[i] & ~127); }
        int cl[16];
#pragma unroll
        for (int j = 0; j < 16; ++j) cl[j] = (f2key(f1[0] + f2[j]) & ~255) | j;
#pragma unroll
        for (int i = 1; i < 16; ++i) {
#pragma unroll
            for (int j = 0; j < 16; ++j) {
                if ((i + 1) * (j + 1) <= 16) {
                    int x = (f2key(f1[i] + f2[j]) & ~255) | (i * 16 + j);
#pragma unroll
                    for (int k = 0; k < 16; ++k) CE_DESC(cl[k], x);
                }
            }
        }
        float sc[16]; int idv[16];
#pragma unroll
        for (int k = 0; k < 16; ++k) {
            sc[k] = key2f(cl[k] & ~255);
            const int pi = (cl[k] >> 4) & 15, pj = cl[k] & 15;
            int a = 0, b = 0;
#pragma unroll
            for (int i = 0; i < 16; ++i) { a = (pi == i) ? (l1[i] & 127) : a; b = (pj == i) ? (l2[i] & 127) : b; }
            idv[k] = a * 128 + b;
        }
        float e[16], sum = 0.f;
#pragma unroll
        for (int k = 0; k < 16; ++k) { e[k] = __expf(sc[k] - sc[0]); sum += e[k]; }
        const float inv = 1.0f / sum;
        int* ip = ids + (size_t)it * 16; float* gp = gw + (size_t)it * 16;
#pragma unroll
        for (int k = 0; k < 16; k += 4) {
            *(int4*)(ip + k) = make_int4(idv[k], idv[k + 1], idv[k + 2], idv[k + 3]);
            *(float4*)(gp + k) = make_float4(e[k] * inv, e[k + 1] * inv, e[k + 2] * inv, e[k + 3] * inv);
        }
    }
}

__device__ __forceinline__ float gelu_erf(float x);
constexpr int KPITCH = 272;
constexpr int R2_K_BYTES = 2 * 128 * KPITCH;
#define CE_MAXMIN(a, b) do { const int hi_ = max((a), (b)); const int lo_ = min((a), (b)); (a) = hi_; (b) = lo_; } while (0)
__device__ __forceinline__ void bitonic_merge16_desc(int (&a)[16]) {
#pragma unroll
    for (int js = 3; js >= 0; --js) {
#pragma unroll
        for (int i = 0; i < 16; ++i) { const int l = i ^ (1 << js); if (l > i) CE_MAXMIN(a[i], a[l]); }
    }
}
__device__ __forceinline__ void bitonic_sort16_desc(int (&a)[16]) {
#pragma unroll
    for (int ks = 1; ks <= 4; ++ks) {
#pragma unroll
        for (int js = ks - 1; js >= 0; --js) {
#pragma unroll
            for (int i = 0; i < 16; ++i) { const int l = i ^ (1 << js);
                if (l > i) { if ((i & (1 << ks)) == 0) CE_MAXMIN(a[i], a[l]); else CE_MAXMIN(a[l], a[i]); } }
        }
    }
}
__device__ __forceinline__ void merge_top16(int (&a)[16], const int (&b)[16]) {
#pragma unroll
    for (int i = 0; i < 16; ++i) a[i] = max(a[i], b[15 - i]);
    bitonic_merge16_desc(a);
}
__device__ __forceinline__ void route2_half(const bf16_t* __restrict__ qrow  , const LAS unsigned char* kl  , int hi, int (&L)[16]) {
    f32x16 acc[4];
#pragma unroll
    for (int kt = 0; kt < 4; ++kt)
#pragma unroll
        for (int r = 0; r < 16; ++r) acc[kt][r] = 0.f;
    bf16x8 qf[8];
#pragma unroll
    for (int s = 0; s < 8; ++s) qf[s] = *(const bf16x8*)(qrow + 16 * s);
#pragma unroll
    for (int s = 0; s < 8; ++s) {
#pragma unroll
        for (int kt = 0; kt < 4; ++kt) {
            const bf16x8 kf = *(const LAS bf16x8*)(kl + kt * 32 * KPITCH + 32 * s);
            acc[kt] = __builtin_amdgcn_mfma_f32_32x32x16_bf16(kf, qf[s], acc[kt], 0, 0, 0);
        }
    }
    int kk[4][16];
    const int hi4 = 4 * hi;
#pragma unroll
    for (int kt = 0; kt < 4; ++kt)
#pragma unroll
        for (int r = 0; r < 16; ++r) kk[kt][r] = (f2key(acc[kt][r]) & ~127) | ((32 * kt + (r & 3) + 8 * (r >> 2)) | hi4);
#pragma unroll
    for (int kt = 0; kt < 4; ++kt) bitonic_sort16_desc(kk[kt]);
    merge_top16(kk[0], kk[1]); merge_top16(kk[2], kk[3]); merge_top16(kk[0], kk[2]);
#pragma unroll
    for (int i = 0; i < 16; ++i) L[i] = max(kk[0][i], __shfl_xor(kk[0][15 - i], 32));
    bitonic_merge16_desc(L);
}

__device__ __forceinline__ void routing2_setup(const float* __restrict__ k1, const float* __restrict__ k2, LAS unsigned char* lds, int tid) {
    for (int e = tid; e < 2 * 8192; e += 512) {
        const int hf = e >> 13, o = (e & 8191) * 2, key = o >> 7, d = o & 127;
        const float* src = (hf ? k2 : k1) + o;
        *(LAS unsigned*)(lds + hf * 128 * KPITCH + key * KPITCH + d * 2) = cvtpk(src[0], src[1]);
    }
    __syncthreads();
}
__device__ __forceinline__ void routing2_units(const bf16_t* __restrict__ Q2, int* __restrict__ ids, float* __restrict__ gw,
                                               LAS unsigned char* lds, int wave, int lane, int gwave, int ngw) {
    LAS unsigned char* scr = lds + R2_K_BYTES + wave * 2048 + lane * 32;
    const int hi = lane >> 5, l31 = lane & 31;
    for (int u = (gwave < 0 ? wave : gwave); u < (gwave < 0 ? 32 : (T / 32) * 8); u += (gwave < 0 ? 8 : ngw)) {
        const int tb = gwave < 0 ? (int)blockIdx.x * 4 + (u >> 3) : (u >> 3), h = u & 7;
        const int t = tb * 32 + l31;
        const bf16_t* qrow = Q2 + (size_t)t * 2048 + h * 256 + 8 * hi;
        int l1[16], l2[16];
        route2_half(qrow, lds + l31 * KPITCH + 16 * hi, hi, l1);
        route2_half(qrow + 128, lds + 128 * KPITCH + l31 * KPITCH + 16 * hi, hi, l2);
#pragma unroll
        for (int i = 0; i < 16; i += 4) {
            *(LAS unsigned*)(scr + i) = (unsigned)(l1[i] & 127) | ((unsigned)(l1[i + 1] & 127) << 8) | ((unsigned)(l1[i + 2] & 127) << 16) | ((unsigned)(l1[i + 3] & 127) << 24);
            *(LAS unsigned*)(scr + 16 + i) = (unsigned)(l2[i] & 127) | ((unsigned)(l2[i + 1] & 127) << 8) | ((unsigned)(l2[i + 2] & 127) << 16) | ((unsigned)(l2[i + 3] & 127) << 24);
        }
        float f1[16], f2[16];
#pragma unroll
        for (int i = 0; i < 16; ++i) { f1[i] = key2f(l1[i] & ~127); f2[i] = key2f(l2[i] & ~127); }
        int cl[16];
#pragma unroll
        for (int j = 0; j < 16; ++j) cl[j] = (f2key(f1[0] + f2[j]) & ~255) | (255 - j);
#pragma unroll
        for (int i = 1; i < 16; ++i) {
#pragma unroll
            for (int j = 0; j < 16; ++j) {
                if ((i + 1) * (j + 1) <= 16) {
                    int x = (f2key(f1[i] + f2[j]) & ~255) | (255 - (i * 16 + j));
#pragma unroll
                    for (int k = (i + 1) * (j + 1) - 1; k < 16; ++k) CE_DESC(cl[k], x);
                }
            }
        }
        float e[16], sum = 0.f;
        const float mx = key2f(cl[0] & ~255);
#pragma unroll
        for (int k = 0; k < 16; ++k) { e[k] = __expf(key2f(cl[k] & ~255) - mx); sum += e[k]; }
        const float inv = 1.0f / sum;
        asm volatile("s_waitcnt lgkmcnt(0)" ::: "memory");
        int idv[8]; float gv[8];
#pragma unroll
        for (int k = 0; k < 8; ++k) {
            const int c = 255 - ((hi ? cl[8 + k] : cl[k]) & 255);
            gv[k] = (hi ? e[8 + k] : e[k]) * inv;
            const int pi = (c >> 4) & 15, pj = c & 15;
            const int a = *(const LAS unsigned char*)(scr + pi), b = *(const LAS unsigned char*)(scr + 16 + pj);
            idv[k] = a * 128 + b;
        }
        int* ip = ids + ((size_t)t * 8 + h) * 16 + 8 * hi; float* gp = gw + ((size_t)t * 8 + h) * 16 + 8 * hi;
        *(int4*)(ip) = make_int4(idv[0], idv[1], idv[2], idv[3]); *(int4*)(ip + 4) = make_int4(idv[4], idv[5], idv[6], idv[7]);
        *(float4*)(gp) = make_float4(gv[0], gv[1], gv[2], gv[3]); *(float4*)(gp + 4) = make_float4(gv[4], gv[5], gv[6], gv[7]);
        asm volatile("s_waitcnt lgkmcnt(0)" ::: "memory");
    }
}

typedef __bf16 bf16x2v_t __attribute__((ext_vector_type(2)));
__device__ __forceinline__ float dot2(unsigned a, unsigned b, float acc) { return __builtin_amdgcn_fdot2_f32_bf16(__builtin_bit_cast(bf16x2v_t, a), __builtin_bit_cast(bf16x2v_t, b), acc, false); }
template <int CTRL> __device__ __forceinline__ float dpp_add(float v) { return v + __builtin_bit_cast(float, __builtin_amdgcn_update_dpp(0, __builtin_bit_cast(int, v), CTRL, 0xF, 0xF, true)); }
__device__ __forceinline__ float xor16_add(float v) { return v + __builtin_bit_cast(float, __builtin_amdgcn_ds_swizzle(__builtin_bit_cast(int, v), 0x401F)); }
__device__ __forceinline__ float xor32_add(float v) { return v + __shfl_xor(v, 32); }
constexpr int G2_WAVE_LDS = 4096 + 8192 + 128;

__device__ __forceinline__ void gather2_phase(float* __restrict__ H, bf16_t* __restrict__ HB, const float* __restrict__ ssq2p, float* __restrict__ ssq1,
                                              const bf16_t* __restrict__ U16, const bf16_t* __restrict__ V16, const int* __restrict__ ids, const float* __restrict__ gw,
                                              const float* __restrict__ final_g, int last, LAS unsigned char* lds, int wave, int gwave, int lane) {
    LAS unsigned char* wl = lds + wave * G2_WAVE_LDS;
    LAS unsigned short* idl = (LAS unsigned short*)wl;
    LAS float* al = (LAS float*)(wl + 4096);
    const int t0 = __builtin_amdgcn_readfirstlane(gwave * 16);
    const int g = lane >> 3, p = lane & 7;
    for (int tt = 0; tt < 16; ++tt) {
#pragma unroll
        for (int hf = 0; hf < 2; ++hf) { const int k = lane + 64 * hf; idl[tt * 128 + (k & 7) * 16 + (k >> 3)] = (unsigned short)ids[(size_t)(t0 + tt) * 128 + k]; }
    }
    for (int e = lane; e < 2048; e += 64) al[e] = 0.f;
    asm volatile("s_waitcnt lgkmcnt(0)" ::: "memory");
    const unsigned char* Ub = (const unsigned char*)U16; const unsigned char* Vb = (const unsigned char*)V16;
    for (int c = 0; c < 16; ++c) {
        for (int tt = 0; tt < 16; ++tt) {
            const u32x4 x4 = *(const u32x4*)(HB + (size_t)(t0 + tt) * DM + 64 * c + 8 * p);
            const u32x4 i0 = *(const LAS u32x4*)(idl + tt * 128 + g * 16), i1 = *(const LAS u32x4*)(idl + tt * 128 + g * 16 + 8);
            const unsigned idw[8] = {i0.x, i0.y, i0.z, i0.w, i1.x, i1.y, i1.z, i1.w};
            u32x4 u[16];
#pragma unroll
            for (int i = 0; i < 16; ++i) { const unsigned id = (i & 1) ? (idw[i >> 1] >> 16) : (idw[i >> 1] & 0xffffu);
                u[i] = *(const u32x4*)(Ub + (size_t)(id * 2048u + (unsigned)(c * 128 + p * 16))); }
            float a[16];
#pragma unroll
            for (int i = 0; i < 16; ++i) {
                float s = dot2(x4.x, u[i].x, 0.f); s = dot2(x4.y, u[i].y, s); s = dot2(x4.z, u[i].z, s); s = dot2(x4.w, u[i].w, s);
                s = dpp_add<0xB1>(s); s = dpp_add<0x4E>(s); s = dpp_add<0x141>(s);
                a[i] = s;
            }
            if (p == 0) {
                LAS float* ap = al + tt * 128 + g * 16;
#pragma unroll
                for (int i = 0; i < 16; ++i) (void)__hip_atomic_fetch_add(ap + i, a[i], __ATOMIC_RELAXED, __HIP_MEMORY_SCOPE_WORKGROUP);
            }
        }
    }
    asm volatile("s_waitcnt lgkmcnt(0)" ::: "memory");
    for (int n = 0; n < 32; ++n) {
        const int tt = n >> 1, pos = lane + 64 * (n & 1), k = 8 * (pos & 15) + (pos >> 4);
        const float rs2 = rsqrtf(ssq16(ssq2p, t0 + tt) * (1.0f / 1024.0f) + RMS_EPS);
        const float a = al[tt * 128 + pos] * rs2;
        al[tt * 128 + pos] = gw[(size_t)(t0 + tt) * 128 + k] * gelu_erf(a);
    }
    asm volatile("s_waitcnt lgkmcnt(0)" ::: "memory");
    for (int c = 0; c < 16; ++c) {
        for (int tt = 0; tt < 16; ++tt) {
            const LAS f32x4* wp = (const LAS f32x4*)(al + tt * 128 + g * 16);
            const f32x4 w0 = wp[0], w1 = wp[1], w2 = wp[2], w3 = wp[3];
            const float w[16] = {w0[0], w0[1], w0[2], w0[3], w1[0], w1[1], w1[2], w1[3], w2[0], w2[1], w2[2], w2[3], w3[0], w3[1], w3[2], w3[3]};
            const u32x4 i0 = *(const LAS u32x4*)(idl + tt * 128 + g * 16), i1 = *(const LAS u32x4*)(idl + tt * 128 + g * 16 + 8);
            const unsigned idw[8] = {i0.x, i0.y, i0.z, i0.w, i1.x, i1.y, i1.z, i1.w};
            u32x4 v[16];
#pragma unroll
            for (int i = 0; i < 16; ++i) { const unsigned id = (i & 1) ? (idw[i >> 1] >> 16) : (idw[i >> 1] & 0xffffu);
                v[i] = *(const u32x4*)(Vb + (size_t)(id * 2048u + (unsigned)(c * 128 + p * 16))); }
            float y[8];
#pragma unroll
            for (int j = 0; j < 8; ++j) y[j] = 0.f;
#pragma unroll
            for (int i = 0; i < 16; ++i) {
                y[0] = fmaf(w[i], bflo(v[i].x), y[0]); y[1] = fmaf(w[i], bfhi(v[i].x), y[1]); y[2] = fmaf(w[i], bflo(v[i].y), y[2]); y[3] = fmaf(w[i], bfhi(v[i].y), y[3]);
                y[4] = fmaf(w[i], bflo(v[i].z), y[4]); y[5] = fmaf(w[i], bfhi(v[i].z), y[5]); y[6] = fmaf(w[i], bflo(v[i].w), y[6]); y[7] = fmaf(w[i], bfhi(v[i].w), y[7]);
            }
#pragma unroll
            for (int j = 0; j < 8; ++j) { y[j] = dpp_add<0x128>(y[j]); y[j] = xor16_add(y[j]); y[j] = xor32_add(y[j]); }
            if (g == 0) {
                float* hp = H + (size_t)(t0 + tt) * DM + 64 * c + 8 * p;
                f32x4 h0 = *(const f32x4*)hp, h1 = *(const f32x4*)(hp + 4);
                h0 += (f32x4){y[0], y[1], y[2], y[3]}; h1 += (f32x4){y[4], y[5], y[6], y[7]};
                *(f32x4*)hp = h0; *(f32x4*)(hp + 4) = h1;
            }
        }
    }
    __builtin_amdgcn_fence(__ATOMIC_SEQ_CST, "agent");
    asm volatile("s_waitcnt vmcnt(0)" ::: "memory");
    for (int tt = 0; tt < 16; ++tt) {
        const int t = t0 + tt;
        float* hp = H + (size_t)t * DM + 8 * lane;
        f32x4 h0 = *(const f32x4*)hp, h1 = *(const f32x4*)(hp + 4), h2 = *(const f32x4*)(hp + 512), h3 = *(const f32x4*)(hp + 516);
        float ss = (h0[0] * h0[0] + h0[1] * h0[1]) + (h0[2] * h0[2] + h0[3] * h0[3]) + (h1[0] * h1[0] + h1[1] * h1[1]) + (h1[2] * h1[2] + h1[3] * h1[3])
                 + (h2[0] * h2[0] + h2[1] * h2[1]) + (h2[2] * h2[2] + h2[3] * h2[3]) + (h3[0] * h3[0] + h3[1] * h3[1]) + (h3[2] * h3[2] + h3[3] * h3[3]);
        ss = wave_sum(ss);
        if (last) {
            const float rs = rsqrtf(ss * (1.0f / 1024.0f) + RMS_EPS);
            const f32x4 g0 = *(const f32x4*)(final_g + 8 * lane), g1 = *(const f32x4*)(final_g + 8 * lane + 4), g2 = *(const f32x4*)(final_g + 512 + 8 * lane), g3 = *(const f32x4*)(final_g + 516 + 8 * lane);
            h0 = h0 * rs * g0; h1 = h1 * rs * g1; h2 = h2 * rs * g2; h3 = h3 * rs * g3;
            *(f32x4*)hp = h0; *(f32x4*)(hp + 4) = h1; *(f32x4*)(hp + 512) = h2; *(f32x4*)(hp + 516) = h3;
        } else {
            bf16_t* bp = HB + (size_t)t * DM + 8 * lane;
            u32x4 w; w.x = cvtpk(h0[0], h0[1]); w.y = cvtpk(h0[2], h0[3]); w.z = cvtpk(h1[0], h1[1]); w.w = cvtpk(h1[2], h1[3]);
            *(u32x4*)bp = w;
            w.x = cvtpk(h2[0], h2[1]); w.y = cvtpk(h2[2], h2[3]); w.z = cvtpk(h3[0], h3[1]); w.w = cvtpk(h3[2], h3[3]);
            *(u32x4*)(bp + 512) = w;
            if (lane == 0) ssq1[t] = ss;
        }
    }
}

#ifndef G3_UMFMA
#define G3_UMFMA 0
#endif
#ifndef G3_VF16
#define G3_VF16 1
#endif
typedef _Float16 f16x2_t __attribute__((ext_vector_type(2)));
__device__ __forceinline__ unsigned cvtpk_h(float lo, float hi) { f16x2_t v = {(_Float16)lo, (_Float16)hi}; return __builtin_bit_cast(unsigned, v); }
__device__ __forceinline__ void fma_mix_lo(float& y, float w, unsigned pk) { asm("v_fma_mix_f32 %0, %1, %2, %0 op_sel_hi:[0,1,0]" : "+v"(y) : "v"(w), "v"(pk)); }
__device__ __forceinline__ void fma_mix_hi(float& y, float w, unsigned pk) { asm("v_fma_mix_f32 %0, %1, %2, %0 op_sel:[0,1,0] op_sel_hi:[0,1,0]" : "+v"(y) : "v"(w), "v"(pk)); }
__device__ __forceinline__ float swap32_add(float a, float b) {
    const auto r = __builtin_amdgcn_permlane32_swap(__float_as_uint(a), __float_as_uint(b), false, false);
    return __uint_as_float(r[0]) + __uint_as_float(r[1]);
}

__device__ __forceinline__ void gather3_phase(float* __restrict__ H, bf16_t* __restrict__ HB, const float* __restrict__ ssq2p, float* __restrict__ ssq1,
                                              const bf16_t* __restrict__ U16, const unsigned short* __restrict__ V16h, const int* __restrict__ ids, const float* __restrict__ gw,
                                              const float* __restrict__ final_g, int last, LAS unsigned char* lds, int wave, int gwave, int lane) {
    LAS unsigned char* wl = lds + wave * G2_WAVE_LDS;
    LAS unsigned short* idl = (LAS unsigned short*)wl;
    LAS float* al = (LAS float*)(wl + 4096);
    const int t0 = __builtin_amdgcn_readfirstlane(gwave * 16);
    for (int tt = 0; tt < 16; ++tt) {
        idl[tt * 128 + lane] = (unsigned short)ids[(size_t)(t0 + tt) * 128 + lane];
        idl[tt * 128 + 64 + lane] = (unsigned short)ids[(size_t)(t0 + tt) * 128 + 64 + lane];
    }
    for (int e = lane; e < 2048; e += 64) al[e] = 0.f;
    asm volatile("s_waitcnt lgkmcnt(0)" ::: "memory");
    const unsigned char* Ub = (const unsigned char*)U16; const unsigned char* Vb = (const unsigned char*)V16h;
#if G3_UMFMA
    {
        const int e = lane & 15, q = lane >> 4;
        for (int c = 0; c < 16; ++c) {
            for (int tt = 0; tt < 16; ++tt) {
                const bf16_t* xp = HB + (size_t)(t0 + tt) * DM + 64 * c + 8 * q;
                const bf16x8 xa = *(const bf16x8*)xp, xb = *(const bf16x8*)(xp + 32);
                const u32x4 iv = *(const LAS u32x4*)(idl + tt * 128 + 8 * e);
                const unsigned idw[4] = {iv.x, iv.y, iv.z, iv.w};
                bf16x8 ua[8], ub[8];
#pragma unroll
                for (int gi = 0; gi < 8; ++gi) { const unsigned id = (gi & 1) ? (idw[gi >> 1] >> 16) : (idw[gi >> 1] & 0xffffu);
                    const unsigned char* up = Ub + (size_t)(id * 2048u + (unsigned)(c * 128 + q * 16));
                    ua[gi] = *(const bf16x8*)up; ub[gi] = *(const bf16x8*)(up + 64); }
                float r[8];
#pragma unroll
                for (int gi = 0; gi < 8; ++gi) {
                    f32x4 acc = {0.f, 0.f, 0.f, 0.f};
                    acc = __builtin_amdgcn_mfma_f32_16x16x32_bf16(xa, ua[gi], acc, 0, 0, 0);
                    acc = __builtin_amdgcn_mfma_f32_16x16x32_bf16(xb, ub[gi], acc, 0, 0, 0);
                    r[gi] = acc[0];
                }
                if (q == 0) {
                    LAS float* ap = al + tt * 128 + 8 * e;
#pragma unroll
                    for (int gi = 0; gi < 8; ++gi) (void)__hip_atomic_fetch_add(ap + gi, r[gi], __ATOMIC_RELAXED, __HIP_MEMORY_SCOPE_WORKGROUP);
                }
            }
        }
    }
#else
    {
        const int g = lane >> 3, p = lane & 7;
        for (int c = 0; c < 16; ++c) {
            for (int tt = 0; tt < 16; ++tt) {
                const u32x4 x4 = *(const u32x4*)(HB + (size_t)(t0 + tt) * DM + 64 * c + 8 * p);
                const u32x4 i0 = *(const LAS u32x4*)(idl + tt * 128 + g * 16), i1 = *(const LAS u32x4*)(idl + tt * 128 + g * 16 + 8);
                const unsigned idw[8] = {i0.x, i0.y, i0.z, i0.w, i1.x, i1.y, i1.z, i1.w};
                u32x4 u[16];
#pragma unroll
                for (int i = 0; i < 16; ++i) { const unsigned id = (i & 1) ? (idw[i >> 1] >> 16) : (idw[i >> 1] & 0xffffu);
                    u[i] = *(const u32x4*)(Ub + (size_t)(id * 2048u + (unsigned)(c * 128 + p * 16))); }
                float a[16];
#pragma unroll
                for (int i = 0; i < 16; ++i) {
                    float s_ = dot2(x4.x, u[i].x, 0.f); s_ = dot2(x4.y, u[i].y, s_); s_ = dot2(x4.z, u[i].z, s_); s_ = dot2(x4.w, u[i].w, s_);
                    s_ = dpp_add<0xB1>(s_); s_ = dpp_add<0x4E>(s_); s_ = dpp_add<0x141>(s_);
                    a[i] = s_;
                }
                if (p == 0) {
                    LAS float* ap = al + tt * 128 + g * 16;
#pragma unroll
                    for (int i = 0; i < 16; ++i) (void)__hip_atomic_fetch_add(ap + i, a[i], __ATOMIC_RELAXED, __HIP_MEMORY_SCOPE_WORKGROUP);
                }
            }
        }
    }
#endif
    asm volatile("s_waitcnt lgkmcnt(0)" ::: "memory");
    for (int n = 0; n < 32; ++n) {
        const int tt = n >> 1, k = lane + 64 * (n & 1);
        const float rs2 = rsqrtf(ssq16(ssq2p, t0 + tt) * (1.0f / 1024.0f) + RMS_EPS);
        const float a = al[tt * 128 + k] * rs2;
        al[tt * 128 + k] = gw[(size_t)(t0 + tt) * 128 + k] * gelu_erf(a);
    }
    asm volatile("s_waitcnt lgkmcnt(0)" ::: "memory");
    {
        const int g = lane >> 3, p = lane & 7;
        for (int c = 0; c < 16; ++c) {
            for (int tt = 0; tt < 16; ++tt) {
                const LAS f32x4* wp = (const LAS f32x4*)(al + tt * 128 + g * 16);
                const f32x4 w0 = wp[0], w1 = wp[1], w2 = wp[2], w3 = wp[3];
                const float w[16] = {w0[0], w0[1], w0[2], w0[3], w1[0], w1[1], w1[2], w1[3], w2[0], w2[1], w2[2], w2[3], w3[0], w3[1], w3[2], w3[3]};
                const u32x4 i0 = *(const LAS u32x4*)(idl + tt * 128 + g * 16), i1 = *(const LAS u32x4*)(idl + tt * 128 + g * 16 + 8);
                const unsigned idw[8] = {i0.x, i0.y, i0.z, i0.w, i1.x, i1.y, i1.z, i1.w};
                u32x4 v[16];
#pragma unroll
                for (int i = 0; i < 16; ++i) { const unsigned id = (i & 1) ? (idw[i >> 1] >> 16) : (idw[i >> 1] & 0xffffu);
                    v[i] = *(const u32x4*)(Vb + (size_t)(id * 2048u + (unsigned)(c * 128 + p * 16))); }
                float y[8];
#pragma unroll
                for (int j = 0; j < 8; ++j) y[j] = 0.f;
#pragma unroll
                for (int i = 0; i < 16; ++i) {
#if G3_VF16
                    fma_mix_lo(y[0], w[i], v[i].x); fma_mix_hi(y[1], w[i], v[i].x); fma_mix_lo(y[2], w[i], v[i].y); fma_mix_hi(y[3], w[i], v[i].y);
                    fma_mix_lo(y[4], w[i], v[i].z); fma_mix_hi(y[5], w[i], v[i].z); fma_mix_lo(y[6], w[i], v[i].w); fma_mix_hi(y[7], w[i], v[i].w);
#else
                    y[0] = fmaf(w[i], bflo(v[i].x), y[0]); y[1] = fmaf(w[i], bfhi(v[i].x), y[1]); y[2] = fmaf(w[i], bflo(v[i].y), y[2]); y[3] = fmaf(w[i], bfhi(v[i].y), y[3]);
                    y[4] = fmaf(w[i], bflo(v[i].z), y[4]); y[5] = fmaf(w[i], bfhi(v[i].z), y[5]); y[6] = fmaf(w[i], bflo(v[i].w), y[6]); y[7] = fmaf(w[i], bfhi(v[i].w), y[7]);
#endif
                }
                float z[4];
#pragma unroll
                for (int j = 0; j < 4; ++j) { z[j] = swap32_add(y[j], y[j + 4]); z[j] = xor16_add(z[j]); z[j] = dpp_add<0x128>(z[j]); }
                if ((lane & 0x18) == 0) {
                    float* hp = H + (size_t)(t0 + tt) * DM + 64 * c + 8 * p + 4 * (lane >> 5);
                    f32x4 h0 = *(const f32x4*)hp;
                    h0 += (f32x4){z[0], z[1], z[2], z[3]};
                    *(f32x4*)hp = h0;
                }
            }
        }
    }
    __builtin_amdgcn_fence(__ATOMIC_SEQ_CST, "agent");
    asm volatile("s_waitcnt vmcnt(0)" ::: "memory");
    for (int tt = 0; tt < 16; ++tt) {
        const int t = t0 + tt;
        float* hp = H + (size_t)t * DM + 8 * lane;
        f32x4 h0 = *(const f32x4*)hp, h1 = *(const f32x4*)(hp + 4), h2 = *(const f32x4*)(hp + 512), h3 = *(const f32x4*)(hp + 516);
        float ss = (h0[0] * h0[0] + h0[1] * h0[1]) + (h0[2] * h0[2] + h0[3] * h0[3]) + (h1[0] * h1[0] + h1[1] * h1[1]) + (h1[2] * h1[2] + h1[3] * h1[3])
                 + (h2[0] * h2[0] + h2[1] * h2[1]) + (h2[2] * h2[2] + h2[3] * h2[3]) + (h3[0] * h3[0] + h3[1] * h3[1]) + (h3[2] * h3[2] + h3[3] * h3[3]);
        ss = wave_sum(ss);
        if (last) {
            const float rs = rsqrtf(ss * (1.0f / 1024.0f) + RMS_EPS);
            const f32x4 g0 = *(const f32x4*)(final_g + 8 * lane), g1 = *(const f32x4*)(final_g + 8 * lane + 4), g2 = *(const f32x4*)(final_g + 512 + 8 * lane), g3 = *(const f32x4*)(final_g + 516 + 8 * lane);
            h0 = h0 * rs * g0; h1 = h1 * rs * g1; h2 = h2 * rs * g2; h3 = h3 * rs * g3;
            *(f32x4*)hp = h0; *(f32x4*)(hp + 4) = h1; *(f32x4*)(hp + 512) = h2; *(f32x4*)(hp + 516) = h3;
        } else {
            bf16_t* bp = HB + (size_t)t * DM + 8 * lane;
            u32x4 w; w.x = cvtpk(h0[0], h0[1]); w.y = cvtpk(h0[2], h0[3]); w.z = cvtpk(h1[0], h1[1]); w.w = cvtpk(h1[2], h1[3]);
            *(u32x4*)bp = w;
            w.x = cvtpk(h2[0], h2[1]); w.y = cvtpk(h2[2], h2[3]); w.z = cvtpk(h3[0], h3[1]); w.w = cvtpk(h3[2], h3[3]);
            *(u32x4*)(bp + 512) = w;
            if (lane == 0) ssq1[t] = ss;
        }
    }
}

typedef float f32x2v __attribute__((ext_vector_type(2)));
constexpr float FP8_MAX = 448.0f;

__device__ __forceinline__ void quant_row_fp8(const float* __restrict__ src, const float* __restrict__ colscale, unsigned char* __restrict__ dst, float* __restrict__ scale_out, int lane) {
    f32x4 v[4]; float am = 0.f;
#pragma unroll
    for (int j = 0; j < 4; ++j) {
        v[j] = *(const f32x4*)(src + 4 * (lane + 64 * j));
        if (colscale) v[j] = v[j] * *(const f32x4*)(colscale + 4 * (lane + 64 * j));
        am = fmaxf(am, fmaxf(fmaxf(fabsf(v[j][0]), fabsf(v[j][1])), fmaxf(fabsf(v[j][2]), fabsf(v[j][3]))));
    }
#pragma unroll
    for (int o = 1; o < 64; o <<= 1) am = fmaxf(am, __shfl_xor(am, o));
    const float inv = am > 0.f ? FP8_MAX / am : 1.0f;
#pragma unroll
    for (int j = 0; j < 4; ++j) {
        int w = 0;
        w = __builtin_amdgcn_cvt_pk_fp8_f32(v[j][0] * inv, v[j][1] * inv, w, false);
        w = __builtin_amdgcn_cvt_pk_fp8_f32(v[j][2] * inv, v[j][3] * inv, w, true);
        *(int*)(dst + 4 * (lane + 64 * j)) = w;
    }
    if (lane == 0) *scale_out = am > 0.f ? am / FP8_MAX : 1.0f;
}

__device__ __forceinline__ float dot2v(bf16x2v_t a, unsigned b, float acc) { return __builtin_amdgcn_fdot2_f32_bf16(a, __builtin_bit_cast(bf16x2v_t, b), acc, false); }
__device__ __forceinline__ void g4_issue(u32x4 (&buf)[16], const unsigned char* __restrict__ tab, const LAS unsigned short* idl, int it, int g, int p) {
    const int tt = it & 15, c = it >> 4;
    const u32x4 i0 = *(const LAS u32x4*)(idl + tt * 128 + g * 16), i1 = *(const LAS u32x4*)(idl + tt * 128 + g * 16 + 8);
    const unsigned idw[8] = {i0.x, i0.y, i0.z, i0.w, i1.x, i1.y, i1.z, i1.w};
    const unsigned char* base = tab + (c * 128 + p * 16);
#pragma unroll
    for (int i = 0; i < 16; ++i) { const unsigned id = (i & 1) ? (idw[i >> 1] >> 16) : (idw[i >> 1] & 0xffffu);
        buf[i] = *(const u32x4*)(base + (size_t)(id * 1024u)); }
}
struct G4Ids { u32x4 i0, i1; };
__device__ __forceinline__ void g4_ids(G4Ids& d, const LAS unsigned short* idl, int it, int g) {
    const int tt = it & 15;
    d.i0 = *(const LAS u32x4*)(idl + tt * 128 + g * 16); d.i1 = *(const LAS u32x4*)(idl + tt * 128 + g * 16 + 8);
}
__device__ __forceinline__ void g4_rows(u32x4 (&buf)[16], const unsigned char* __restrict__ tab, const G4Ids& d, int it, int p) {
    const int c = it >> 4;
    const unsigned idw[8] = {d.i0.x, d.i0.y, d.i0.z, d.i0.w, d.i1.x, d.i1.y, d.i1.z, d.i1.w};
    const unsigned char* base = tab + (c * 128 + p * 16);
#pragma unroll
    for (int i = 0; i < 16; ++i) { const unsigned id = (i & 1) ? (idw[i >> 1] >> 16) : (idw[i >> 1] & 0xffffu);
        buf[i] = *(const u32x4*)(base + (size_t)(id * 1024u)); }
}
__device__ __forceinline__ void g4_xload(u32x4 (&x)[2], const bf16_t* __restrict__ HB, int t0, int it, int p) {
    const bf16_t* xp = HB + (size_t)(t0 + (it & 15)) * DM + 128 * (it >> 4) + 16 * p;
    x[0] = *(const u32x4*)xp; x[1] = *(const u32x4*)(xp + 8);
}
#define G4_CVT(wd, hi_) __builtin_amdgcn_cvt_scalef32_pk_bf16_fp8((wd), 1.0f, (hi_))
__device__ __forceinline__ void g4_ucompute(const u32x4 (&u)[16], const u32x4 (&x)[2], LAS float* ap, int p) {
    const unsigned xw[8] = {x[0].x, x[0].y, x[0].z, x[0].w, x[1].x, x[1].y, x[1].z, x[1].w};
    float a[16];
#pragma unroll
    for (int i0 = 0; i0 < 16; i0 += 8) {
        float s_[8];
#pragma unroll
        for (int e = 0; e < 8; ++e) s_[e] = 0.f;
#pragma unroll
        for (int q = 0; q < 4; ++q) {
#pragma unroll
            for (int e = 0; e < 8; ++e) { const unsigned wd = (q == 0) ? u[i0 + e].x : (q == 1) ? u[i0 + e].y : (q == 2) ? u[i0 + e].z : u[i0 + e].w;
                s_[e] = dot2v(G4_CVT(wd, false), xw[2 * q], s_[e]); }
#pragma unroll
            for (int e = 0; e < 8; ++e) { const unsigned wd = (q == 0) ? u[i0 + e].x : (q == 1) ? u[i0 + e].y : (q == 2) ? u[i0 + e].z : u[i0 + e].w;
                s_[e] = dot2v(G4_CVT(wd, true), xw[2 * q + 1], s_[e]); }
        }
#pragma unroll
        for (int e = 0; e < 8; ++e) s_[e] = dpp_add<0xB1>(s_[e]);
#pragma unroll
        for (int e = 0; e < 8; ++e) s_[e] = dpp_add<0x4E>(s_[e]);
#pragma unroll
        for (int e = 0; e < 8; ++e) a[i0 + e] = dpp_add<0x141>(s_[e]);
    }
    if (p == 0) {
#pragma unroll
        for (int i = 0; i < 16; ++i) (void)__hip_atomic_fetch_add(ap + i, a[i], __ATOMIC_RELAXED, __HIP_MEMORY_SCOPE_WORKGROUP);
    }
}
__device__ __forceinline__ void g4_vcompute(const u32x4 (&v)[16], const LAS float* wsrc, float* __restrict__ hp, int lane, int dry) {
    const LAS f32x4* wp = (const LAS f32x4*)wsrc;
    const f32x4 w0 = wp[0], w1 = wp[1], w2 = wp[2], w3 = wp[3];
    const float w[16] = {w0[0], w0[1], w0[2], w0[3], w1[0], w1[1], w1[2], w1[3], w2[0], w2[1], w2[2], w2[3], w3[0], w3[1], w3[2], w3[3]};
    float yy[16];
#pragma unroll
    for (int j = 0; j < 16; ++j) yy[j] = 0.f;
#pragma unroll
    for (int i = 0; i < 16; ++i) {
        const unsigned vw[4] = {v[i].x, v[i].y, v[i].z, v[i].w};
#pragma unroll
        for (int q = 0; q < 4; ++q) {
            const f32x2v lo = __builtin_amdgcn_cvt_pk_f32_fp8((int)vw[q], false), hi = __builtin_amdgcn_cvt_pk_f32_fp8((int)vw[q], true);
            yy[4 * q] = fmaf(w[i], lo.x, yy[4 * q]); yy[4 * q + 1] = fmaf(w[i], lo.y, yy[4 * q + 1]); yy[4 * q + 2] = fmaf(w[i], hi.x, yy[4 * q + 2]); yy[4 * q + 3] = fmaf(w[i], hi.y, yy[4 * q + 3]);
        }
    }
    f32x2v y[8];
#pragma unroll
    for (int j = 0; j < 8; ++j) y[j] = (f32x2v){yy[2 * j], yy[2 * j + 1]};
    float z[8];
#pragma unroll
    for (int j = 0; j < 4; ++j) { z[2 * j] = swap32_add(y[j].x, y[j + 4].x); z[2 * j + 1] = swap32_add(y[j].y, y[j + 4].y); }
#pragma unroll
    for (int j = 0; j < 8; ++j) { z[j] = xor16_add(z[j]); z[j] = dpp_add<0x128>(z[j]); }
    if ((lane & 0x18) == 0 && !(dry && z[0] * z[0] >= 0.f)) {
        f32x4 h0 = *(const f32x4*)hp, h1 = *(const f32x4*)(hp + 4);
        h0 += (f32x4){z[0], z[1], z[2], z[3]}; h1 += (f32x4){z[4], z[5], z[6], z[7]};
        *(f32x4*)hp = h0; *(f32x4*)(hp + 4) = h1;
    }
}

__device__ __forceinline__ void gather4_phase(float* __restrict__ H, bf16_t* __restrict__ HB, const float* __restrict__ ssq2p, float* __restrict__ ssq1,
                                              const unsigned char* __restrict__ U8, const unsigned char* __restrict__ V8, const float* __restrict__ su, const float* __restrict__ sv,
                                              const int* __restrict__ ids, const float* __restrict__ gw,
                                              const float* __restrict__ final_g, int last, LAS unsigned char* lds, int wave, int gwave, int lane, int dry = 0, int idmask = 0xffff) {
    LAS unsigned char* wl = lds + wave * G2_WAVE_LDS;
    LAS unsigned short* idl = (LAS unsigned short*)wl;
    LAS float* al = (LAS float*)(wl + 4096);
    const int t0 = __builtin_amdgcn_readfirstlane(gwave * 16);
    for (int tt = 0; tt < 16; ++tt) {
        idl[tt * 128 + lane] = (unsigned short)(ids[(size_t)(t0 + tt) * 128 + lane] & idmask);
        idl[tt * 128 + 64 + lane] = (unsigned short)(ids[(size_t)(t0 + tt) * 128 + 64 + lane] & idmask);
    }
    for (int e = lane; e < 2048; e += 64) al[e] = 0.f;
    asm volatile("s_waitcnt lgkmcnt(0)" ::: "memory");
    const int g = lane >> 3, p = lane & 7;
    if (!(dry & 2)) {
        u32x4 uA[16], uB[16], xA[2], xB[2];
        g4_issue(uA, U8, idl, 0, g, p);
        g4_xload(xA, HB, t0, 0, p);
        for (int it = 0; it < 128; it += 2) {
            g4_issue(uB, U8, idl, it + 1, g, p); g4_xload(xB, HB, t0, it + 1, p);
            g4_ucompute(uA, xA, al + (it & 15) * 128 + g * 16, p);
            if (it + 2 < 128) { g4_issue(uA, U8, idl, it + 2, g, p); g4_xload(xA, HB, t0, it + 2, p); }
            g4_ucompute(uB, xB, al + ((it + 1) & 15) * 128 + g * 16, p);
        }
    }
    asm volatile("s_waitcnt lgkmcnt(0)" ::: "memory");
    for (int n = 0; n < 32; ++n) {
        const int tt = n >> 1, k = lane + 64 * (n & 1);
        const float rs2 = rsqrtf(ssq16(ssq2p, t0 + tt) * (1.0f / 1024.0f) + RMS_EPS);
        const int id = idl[tt * 128 + k];
        const float a = al[tt * 128 + k] * rs2 * su[id];
        al[tt * 128 + k] = gw[(size_t)(t0 + tt) * 128 + k] * gelu_erf(a) * sv[id];
    }
    asm volatile("s_waitcnt lgkmcnt(0)" ::: "memory");
    if (!(dry & 4)) {
        u32x4 vA[16], vB[16];
        g4_issue(vA, V8, idl, 0, g, p);
        for (int it = 0; it < 128; it += 2) {
            g4_issue(vB, V8, idl, it + 1, g, p);
            g4_vcompute(vA, al + (it & 15) * 128 + g * 16, H + (size_t)(t0 + (it & 15)) * DM + 128 * (it >> 4) + 16 * p + 8 * (lane >> 5), lane, dry);
            if (it + 2 < 128) g4_issue(vA, V8, idl, it + 2, g, p);
            g4_vcompute(vB, al + ((it + 1) & 15) * 128 + g * 16, H + (size_t)(t0 + ((it + 1) & 15)) * DM + 128 * ((it + 1) >> 4) + 16 * p + 8 * (lane >> 5), lane, dry);
        }
    }
    if (dry) return;
    __builtin_amdgcn_fence(__ATOMIC_SEQ_CST, "agent");
    asm volatile("s_waitcnt vmcnt(0)" ::: "memory");
    for (int tt = 0; tt < 16; ++tt) {
        const int t = t0 + tt;
        float* hp = H + (size_t)t * DM + 8 * lane;
        f32x4 h0 = *(const f32x4*)hp, h1 = *(const f32x4*)(hp + 4), h2 = *(const f32x4*)(hp + 512), h3 = *(const f32x4*)(hp + 516);
        float ss = (h0[0] * h0[0] + h0[1] * h0[1]) + (h0[2] * h0[2] + h0[3] * h0[3]) + (h1[0] * h1[0] + h1[1] * h1[1]) + (h1[2] * h1[2] + h1[3] * h1[3])
                 + (h2[0] * h2[0] + h2[1] * h2[1]) + (h2[2] * h2[2] + h2[3] * h2[3]) + (h3[0] * h3[0] + h3[1] * h3[1]) + (h3[2] * h3[2] + h3[3] * h3[3]);
        ss = wave_sum(ss);
        if (last) {
            const float rs = rsqrtf(ss * (1.0f / 1024.0f) + RMS_EPS);
            const f32x4 g0 = *(const f32x4*)(final_g + 8 * lane), g1 = *(const f32x4*)(final_g + 8 * lane + 4), g2 = *(const f32x4*)(final_g + 512 + 8 * lane), g3 = *(const f32x4*)(final_g + 516 + 8 * lane);
            h0 = h0 * rs * g0; h1 = h1 * rs * g1; h2 = h2 * rs * g2; h3 = h3 * rs * g3;
            *(f32x4*)hp = h0; *(f32x4*)(hp + 4) = h1; *(f32x4*)(hp + 512) = h2; *(f32x4*)(hp + 516) = h3;
        } else {
            bf16_t* bp = HB + (size_t)t * DM + 8 * lane;
            u32x4 w; w.x = cvtpk(h0[0], h0[1]); w.y = cvtpk(h0[2], h0[3]); w.z = cvtpk(h1[0], h1[1]); w.w = cvtpk(h1[2], h1[3]);
            *(u32x4*)bp = w;
            w.x = cvtpk(h2[0], h2[1]); w.y = cvtpk(h2[2], h2[3]); w.z = cvtpk(h3[0], h3[1]); w.w = cvtpk(h3[2], h3[3]);
            *(u32x4*)(bp + 512) = w;
            if (lane == 0) ssq1[t] = ss;
        }
    }
}

__device__ __forceinline__ void quant_row_i8(const float* __restrict__ src, const float* __restrict__ colscale, unsigned char* __restrict__ dst, float* __restrict__ scale_out, int bias, int lane) {
    f32x4 v[4]; float am = 0.f;
#pragma unroll
    for (int j = 0; j < 4; ++j) {
        v[j] = *(const f32x4*)(src + 4 * (lane + 64 * j));
        if (colscale) v[j] = v[j] * *(const f32x4*)(colscale + 4 * (lane + 64 * j));
        am = fmaxf(am, fmaxf(fmaxf(fabsf(v[j][0]), fabsf(v[j][1])), fmaxf(fabsf(v[j][2]), fabsf(v[j][3]))));
    }
#pragma unroll
    for (int o = 1; o < 64; o <<= 1) am = fmaxf(am, __shfl_xor(am, o));
    const float inv = am > 0.f ? 127.0f / am : 0.f;
#pragma unroll
    for (int j = 0; j < 4; ++j) {
        const int q0 = (int)rintf(v[j][0] * inv) + bias, q1 = (int)rintf(v[j][1] * inv) + bias, q2 = (int)rintf(v[j][2] * inv) + bias, q3 = (int)rintf(v[j][3] * inv) + bias;
        *(unsigned*)(dst + 4 * (lane + 64 * j)) = (unsigned)(q0 & 255) | ((unsigned)(q1 & 255) << 8) | ((unsigned)(q2 & 255) << 16) | ((unsigned)(q3 & 255) << 24);
    }
    if (lane == 0) *scale_out = am > 0.f ? am / 127.0f : 0.f;
}
__device__ __forceinline__ void quant_row_load(f32x4 (&v)[4], const float* __restrict__ src, int lane) {
#pragma unroll
    for (int j = 0; j < 4; ++j) v[j] = *(const f32x4*)(src + 4 * (lane + 64 * j));
}
__device__ __forceinline__ void quant_row_finish(f32x4 (&v)[4], const float* __restrict__ colscale, unsigned char* __restrict__ dst, float* __restrict__ scale_out, int bias, int lane) {
    float am = 0.f;
#pragma unroll
    for (int j = 0; j < 4; ++j) {
        if (colscale) v[j] = v[j] * *(const f32x4*)(colscale + 4 * (lane + 64 * j));
        am = fmaxf(am, fmaxf(fmaxf(fabsf(v[j][0]), fabsf(v[j][1])), fmaxf(fabsf(v[j][2]), fabsf(v[j][3]))));
    }
#pragma unroll
    for (int o = 1; o < 64; o <<= 1) am = fmaxf(am, __shfl_xor(am, o));
    const float inv = am > 0.f ? 127.0f / am : 0.f;
#pragma unroll
    for (int j = 0; j < 4; ++j) {
        const int q0 = (int)rintf(v[j][0] * inv) + bias, q1 = (int)rintf(v[j][1] * inv) + bias, q2 = (int)rintf(v[j][2] * inv) + bias, q3 = (int)rintf(v[j][3] * inv) + bias;
        *(unsigned*)(dst + 4 * (lane + 64 * j)) = (unsigned)(q0 & 255) | ((unsigned)(q1 & 255) << 8) | ((unsigned)(q2 & 255) << 16) | ((unsigned)(q3 & 255) << 24);
    }
    if (lane == 0) *scale_out = am > 0.f ? am / 127.0f : 0.f;
}
template <int CTRL> __device__ __forceinline__ int dpp_addi(int v) { return v + __builtin_amdgcn_update_dpp(0, v, CTRL, 0xF, 0xF, true); }
__device__ __forceinline__ void g5_ucompute(const u32x4 (&u)[16], const u32x4& x, LAS int* ap, int p) {
    int a[16];
#pragma unroll
    for (int i = 0; i < 16; ++i) {
        int s_ = __builtin_amdgcn_sdot4((int)u[i].x, (int)x.x, 0, false);
        s_ = __builtin_amdgcn_sdot4((int)u[i].y, (int)x.y, s_, false);
        s_ = __builtin_amdgcn_sdot4((int)u[i].z, (int)x.z, s_, false);
        s_ = __builtin_amdgcn_sdot4((int)u[i].w, (int)x.w, s_, false);
        a[i] = s_;
    }
#pragma unroll
    for (int i = 0; i < 16; ++i) a[i] = dpp_addi<0xB1>(a[i]);
#pragma unroll
    for (int i = 0; i < 16; ++i) a[i] = dpp_addi<0x4E>(a[i]);
    if ((p & 3) == 0) {
#pragma unroll
        for (int i = 0; i < 16; ++i) (void)__hip_atomic_fetch_add(ap + i, a[i], __ATOMIC_RELAXED, __HIP_MEMORY_SCOPE_WORKGROUP);
    }
}
__device__ __forceinline__ void g5_vcompute(const u32x4 (&v)[16], const LAS float* wsrc, float* __restrict__ hp, int lane, int dry) {
    const LAS f32x4* wp = (const LAS f32x4*)wsrc;
    const f32x4 w0 = wp[0], w1 = wp[1], w2 = wp[2], w3 = wp[3];
    const float w[16] = {w0[0], w0[1], w0[2], w0[3], w1[0], w1[1], w1[2], w1[3], w2[0], w2[1], w2[2], w2[3], w3[0], w3[1], w3[2], w3[3]};
    float wsum = ((w[0] + w[1]) + (w[2] + w[3])) + ((w[4] + w[5]) + (w[6] + w[7])) + (((w[8] + w[9]) + (w[10] + w[11])) + ((w[12] + w[13]) + (w[14] + w[15])));
    float yy[16];
    const float y0 = -1152.0f * wsum;
#pragma unroll
    for (int j = 0; j < 16; ++j) yy[j] = y0;
#pragma unroll
    for (int i = 0; i < 16; ++i) {
        const unsigned vw[4] = {v[i].x, v[i].y, v[i].z, v[i].w};
#pragma unroll
        for (int q = 0; q < 4; ++q) {
            const unsigned lo = __builtin_amdgcn_perm(vw[q], 0x64646464u, 0x00050004u), hi = __builtin_amdgcn_perm(vw[q], 0x64646464u, 0x00070006u);
            fma_mix_lo(yy[4 * q], w[i], lo); fma_mix_hi(yy[4 * q + 1], w[i], lo); fma_mix_lo(yy[4 * q + 2], w[i], hi); fma_mix_hi(yy[4 * q + 3], w[i], hi);
        }
    }
    float z[8];
#pragma unroll
    for (int j = 0; j < 8; ++j) z[j] = swap32_add(yy[j], yy[j + 8]);
#pragma unroll
    for (int j = 0; j < 8; ++j) { z[j] = xor16_add(z[j]); z[j] = dpp_add<0x128>(z[j]); }
    if ((lane & 0x18) == 0 && !(dry && z[0] * z[0] >= 0.f)) {
        f32x4 h0 = *(const f32x4*)hp, h1 = *(const f32x4*)(hp + 4);
        h0 += (f32x4){z[0], z[1], z[2], z[3]}; h1 += (f32x4){z[4], z[5], z[6], z[7]};
        *(f32x4*)hp = h0; *(f32x4*)(hp + 4) = h1;
    }
}
#ifndef G5_VDOT4
#define G5_VDOT4 1
#endif
__device__ __forceinline__ void g6_vcompute(const u32x4 (&v)[16], const LAS unsigned char* w8src, float sw, float* __restrict__ hp, int lane, int dry, bf16_t* hbp, LAS float* sspart, const u32x4 hb_pre) {
    const u32x4 w4 = *(const LAS u32x4*)w8src;
    const unsigned ww[4] = {w4.x, w4.y, w4.z, w4.w};
    int yy[16];
#pragma unroll
    for (int j = 0; j < 16; ++j) yy[j] = 0;
#pragma unroll
    for (int a = 0; a < 4; ++a) {
#pragma unroll
        for (int q = 0; q < 4; ++q) {
            const unsigned r0 = (q == 0) ? v[4 * a].x : (q == 1) ? v[4 * a].y : (q == 2) ? v[4 * a].z : v[4 * a].w;
            const unsigned r1 = (q == 0) ? v[4 * a + 1].x : (q == 1) ? v[4 * a + 1].y : (q == 2) ? v[4 * a + 1].z : v[4 * a + 1].w;
            const unsigned r2 = (q == 0) ? v[4 * a + 2].x : (q == 1) ? v[4 * a + 2].y : (q == 2) ? v[4 * a + 2].z : v[4 * a + 2].w;
            const unsigned r3 = (q == 0) ? v[4 * a + 3].x : (q == 1) ? v[4 * a + 3].y : (q == 2) ? v[4 * a + 3].z : v[4 * a + 3].w;
            const unsigned lo01 = __builtin_amdgcn_perm(r1, r0, 0x05010400u), hi01 = __builtin_amdgcn_perm(r1, r0, 0x07030602u);
            const unsigned lo23 = __builtin_amdgcn_perm(r3, r2, 0x05010400u), hi23 = __builtin_amdgcn_perm(r3, r2, 0x07030602u);
            const unsigned c0 = __builtin_amdgcn_perm(lo23, lo01, 0x05040100u), c1 = __builtin_amdgcn_perm(lo23, lo01, 0x07060302u);
            const unsigned c2 = __builtin_amdgcn_perm(hi23, hi01, 0x05040100u), c3 = __builtin_amdgcn_perm(hi23, hi01, 0x07060302u);
            yy[4 * q] = __builtin_amdgcn_sdot4((int)c0, (int)ww[a], yy[4 * q], false); yy[4 * q + 1] = __builtin_amdgcn_sdot4((int)c1, (int)ww[a], yy[4 * q + 1], false);
            yy[4 * q + 2] = __builtin_amdgcn_sdot4((int)c2, (int)ww[a], yy[4 * q + 2], false); yy[4 * q + 3] = __builtin_amdgcn_sdot4((int)c3, (int)ww[a], yy[4 * q + 3], false);
        }
    }
    int z[8];
#pragma unroll
    for (int j = 0; j < 8; ++j) { const auto r = __builtin_amdgcn_permlane32_swap((unsigned)yy[j], (unsigned)yy[j + 8], false, false); z[j] = (int)(r[0] + r[1]); }
#pragma unroll
    for (int j = 0; j < 8; ++j) { z[j] += __builtin_amdgcn_ds_swizzle(z[j], 0x401F); z[j] = dpp_addi<0x128>(z[j]); }
    float ss = 0.f;
    if ((lane & 0x18) == 0 && !(dry && z[0] == 0x7fffffff)) {
#if RES16
        const u32x4 hb_ = hb_pre;
        f32x4 h0 = (f32x4){bflo(hb_.x), bfhi(hb_.x), bflo(hb_.y), bfhi(hb_.y)}, h1 = (f32x4){bflo(hb_.z), bfhi(hb_.z), bflo(hb_.w), bfhi(hb_.w)};
#else
        f32x4 h0 = *(const f32x4*)hp, h1 = *(const f32x4*)(hp + 4);
#endif
        h0 += (f32x4){(float)z[0] * sw, (float)z[1] * sw, (float)z[2] * sw, (float)z[3] * sw}; h1 += (f32x4){(float)z[4] * sw, (float)z[5] * sw, (float)z[6] * sw, (float)z[7] * sw};
        if (!RES16 || !hbp) { *(f32x4*)hp = h0; *(f32x4*)(hp + 4) = h1; }
        if (hbp) {
            u32x4 w; w.x = cvtpk(h0[0], h0[1]); w.y = cvtpk(h0[2], h0[3]); w.z = cvtpk(h1[0], h1[1]); w.w = cvtpk(h1[2], h1[3]);
            *(u32x4*)hbp = w;
            ss = (h0[0] * h0[0] + h0[1] * h0[1]) + (h0[2] * h0[2] + h0[3] * h0[3]) + (h1[0] * h1[0] + h1[1] * h1[1]) + (h1[2] * h1[2] + h1[3] * h1[3]);
        }
    }
    if (hbp) {
        ss = dpp_add<0xB1>(ss); ss = dpp_add<0x4E>(ss); ss = dpp_add<0x141>(ss);
        if ((lane & 31) == 0) sspart[lane >> 5] = ss;
    }
}
__device__ __forceinline__ void g5_xload(u32x4& x, const unsigned char* __restrict__ XQ, int t0, int it, int p) {
    x = *(const u32x4*)(XQ + (size_t)(t0 + (it & 15)) * DM + 128 * (it >> 4) + 16 * p);
}

__device__ __forceinline__ void gather5_phase(float* __restrict__ H, bf16_t* __restrict__ HB, const float* __restrict__ ssq2p, float* __restrict__ ssq1,
                                              const unsigned char* __restrict__ U8, const unsigned char* __restrict__ V8, const float* __restrict__ su, const float* __restrict__ sv,
                                              unsigned char* __restrict__ XQ, const int* __restrict__ ids, const float* __restrict__ gw,
                                              const float* __restrict__ final_g, int last, LAS unsigned char* lds, int wave, int gwave, int lane, int dry = 0, int idmask = 0xffff, unsigned char* A8 = nullptr, float* SA = nullptr, const float* SXg = nullptr) {
    LAS unsigned char* wl = lds + wave * G2_WAVE_LDS;
    LAS unsigned short* idl = (LAS unsigned short*)wl;
    LAS float* al = (LAS float*)(wl + 4096);
    LAS float* sxl = (LAS float*)(wl + 4096 + 8192);
    const int t0 = __builtin_amdgcn_readfirstlane(gwave * 16);
    for (int tt = 0; tt < 16; ++tt) {
        idl[tt * 128 + lane] = (unsigned short)(ids[(size_t)(t0 + tt) * 128 + lane] & idmask);
        idl[tt * 128 + 64 + lane] = (unsigned short)(ids[(size_t)(t0 + tt) * 128 + 64 + lane] & idmask);
    }
    for (int e = lane; e < 2048; e += 64) ((LAS int*)al)[e] = 0;
    if (SXg) {
        if (lane < 16) sxl[lane] = SXg[t0 + lane];
#pragma unroll
        for (int i = 0; i < 16; ++i) { const u32x4 t_ = *(const u32x4*)(XQ + (size_t)(t0 + i) * DM + 16 * lane); asm volatile("" :: "v"(t_)); }
    }
    else for (int tt = 0; tt < 16; ++tt) {
        const bf16_t* xr = HB + (size_t)(t0 + tt) * DM + 8 * lane;
        const u32x4 xa = *(const u32x4*)xr, xb = *(const u32x4*)(xr + 512);
        const float f[16] = {bflo(xa.x), bfhi(xa.x), bflo(xa.y), bfhi(xa.y), bflo(xa.z), bfhi(xa.z), bflo(xa.w), bfhi(xa.w),
                             bflo(xb.x), bfhi(xb.x), bflo(xb.y), bfhi(xb.y), bflo(xb.z), bfhi(xb.z), bflo(xb.w), bfhi(xb.w)};
        float am = 0.f;
#pragma unroll
        for (int j = 0; j < 16; ++j) am = fmaxf(am, fabsf(f[j]));
#pragma unroll
        for (int o = 1; o < 64; o <<= 1) am = fmaxf(am, __shfl_xor(am, o));
        const float inv = am > 0.f ? 127.0f / am : 0.f;
        unsigned wq[4];
#pragma unroll
        for (int j = 0; j < 4; ++j) {
            const int q0 = (int)rintf(f[4 * j] * inv), q1 = (int)rintf(f[4 * j + 1] * inv), q2 = (int)rintf(f[4 * j + 2] * inv), q3 = (int)rintf(f[4 * j + 3] * inv);
            wq[j] = (unsigned)(q0 & 255) | ((unsigned)(q1 & 255) << 8) | ((unsigned)(q2 & 255) << 16) | ((unsigned)(q3 & 255) << 24);
        }
        unsigned char* xq = XQ + (size_t)(t0 + tt) * DM + 8 * lane;
        *(u32x2*)xq = (u32x2){wq[0], wq[1]}; *(u32x2*)(xq + 512) = (u32x2){wq[2], wq[3]};
        if (lane == 0) sxl[tt] = am > 0.f ? am / 127.0f : 0.f;
    }
    asm volatile("s_waitcnt vmcnt(0) lgkmcnt(0)" ::: "memory");
    const int g = lane >> 3, p = lane & 7;
    if (!(dry & 2)) {
        u32x4 uA[16], uB[16], xA, xB;
        G4Ids dA, dB;
        g4_ids(dA, idl, 0, g); g4_ids(dB, idl, 1, g);
        g4_rows(uA, U8, dA, 0, p); g5_xload(xA, XQ, t0, 0, p);
        for (int it = 0; it < 128; it += 2) {
            g4_rows(uB, U8, dB, it + 1, p); g5_xload(xB, XQ, t0, it + 1, p);
            g4_ids(dA, idl, (it + 2) & 127, g);
            g5_ucompute(uA, xA, (LAS int*)al + (it & 15) * 128 + g * 16, p);
            if (it + 2 < 128) { g4_rows(uA, U8, dA, it + 2, p); g5_xload(xA, XQ, t0, it + 2, p); }
            g4_ids(dB, idl, (it + 3) & 127, g);
            g5_ucompute(uB, xB, (LAS int*)al + ((it + 1) & 15) * 128 + g * 16, p);
        }
    }
    asm volatile("s_waitcnt lgkmcnt(0)" ::: "memory");
#if G5_VDOT4
    LAS unsigned char* w8l = (LAS unsigned char*)al;
    LAS float* swl = sxl + 16;
    for (int tt = 0; tt < 16; ++tt) {
        const float rs2 = rsqrtf(ssq16(ssq2p, t0 + tt) * (1.0f / 1024.0f) + RMS_EPS) * sxl[tt];
        const int id0 = idl[tt * 128 + lane], id1 = idl[tt * 128 + 64 + lane];
        const float a0 = (float)((LAS int*)al)[tt * 128 + lane] * rs2 * su[id0], a1 = (float)((LAS int*)al)[tt * 128 + 64 + lane] * rs2 * su[id1];
        const float w0 = gw[(size_t)(t0 + tt) * 128 + lane] * gelu_erf(a0) * sv[id0], w1 = gw[(size_t)(t0 + tt) * 128 + 64 + lane] * gelu_erf(a1) * sv[id1];
        float am = fmaxf(fabsf(w0), fabsf(w1));
#pragma unroll
        for (int o = 1; o < 64; o <<= 1) am = fmaxf(am, __shfl_xor(am, o));
        const float inv = am > 0.f ? 127.0f / am : 0.f;
        asm volatile("s_waitcnt lgkmcnt(0)" ::: "memory");
        w8l[tt * 128 + lane] = (unsigned char)((int)rintf(w0 * inv) & 255); w8l[tt * 128 + 64 + lane] = (unsigned char)((int)rintf(w1 * inv) & 255);
        if (lane == 0) swl[tt] = am > 0.f ? am / 127.0f : 0.f;
    }
    asm volatile("s_waitcnt lgkmcnt(0)" ::: "memory");
    const bool fold = (RES16 || !last) && !dry;
    LAS float* ssp = al + 1024;
    if (!(dry & 4)) {
        u32x4 vA[16], vB[16];
        u32x4 hA = {0u, 0u, 0u, 0u}, hB = {0u, 0u, 0u, 0u};
        const bool wlane = (lane & 0x18) == 0;
#define G6_OFF(i_) ((size_t)(t0 + ((i_) & 15)) * DM + 128 * ((i_) >> 4) + 16 * p + 8 * (lane >> 5))
        G4Ids eA, eB;
        g4_ids(eA, idl, 0, g); g4_ids(eB, idl, 1, g);
        g4_rows(vA, V8, eA, 0, p); if (wlane) hA = *(const u32x4*)(HB + G6_OFF(0));
        for (int it = 0; it < 128; it += 2) {
            g4_rows(vB, V8, eB, it + 1, p); if (wlane) hB = *(const u32x4*)(HB + G6_OFF(it + 1));
            g4_ids(eA, idl, (it + 2) & 127, g);
            { const size_t o_ = G6_OFF(it);
              g6_vcompute(vA, w8l + (it & 15) * 128 + g * 16, swl[it & 15], H + o_, lane, dry, fold ? HB + o_ : nullptr, ssp + (it & 15) * 16 + (it >> 4) * 2, hA); }
            if (it + 2 < 128) { g4_rows(vA, V8, eA, it + 2, p); if (wlane) hA = *(const u32x4*)(HB + G6_OFF(it + 2)); }
            g4_ids(eB, idl, (it + 3) & 127, g);
            { const size_t o_ = G6_OFF(it + 1);
              g6_vcompute(vB, w8l + ((it + 1) & 15) * 128 + g * 16, swl[(it + 1) & 15], H + o_, lane, dry, fold ? HB + o_ : nullptr, ssp + ((it + 1) & 15) * 16 + ((it + 1) >> 4) * 2, hB); }
        }
#undef G6_OFF
    }
#else
    for (int n = 0; n < 32; ++n) {
        const int tt = n >> 1, k = lane + 64 * (n & 1);
        const float rs2 = rsqrtf(ssq16(ssq2p, t0 + tt) * (1.0f / 1024.0f) + RMS_EPS);
        const int id = idl[tt * 128 + k];
        const float a = (float)((LAS int*)al)[tt * 128 + k] * (rs2 * sxl[tt]) * su[id];
        al[tt * 128 + k] = gw[(size_t)(t0 + tt) * 128 + k] * gelu_erf(a) * sv[id];
    }
    asm volatile("s_waitcnt lgkmcnt(0)" ::: "memory");
    if (!(dry & 4)) {
        u32x4 vA[16], vB[16];
        g4_issue(vA, V8, idl, 0, g, p);
        for (int it = 0; it < 128; it += 2) {
            g4_issue(vB, V8, idl, it + 1, g, p);
            g5_vcompute(vA, al + (it & 15) * 128 + g * 16, H + (size_t)(t0 + (it & 15)) * DM + 128 * (it >> 4) + 16 * p + 8 * (lane >> 5), lane, dry);
            if (it + 2 < 128) g4_issue(vA, V8, idl, it + 2, g, p);
            g5_vcompute(vB, al + ((it + 1) & 15) * 128 + g * 16, H + (size_t)(t0 + ((it + 1) & 15)) * DM + 128 * ((it + 1) >> 4) + 16 * p + 8 * (lane >> 5), lane, dry);
        }
    }
#endif
    if (dry) return;
#if G5_VDOT4
    if (fold) {
        asm volatile("s_waitcnt lgkmcnt(0)" ::: "memory");
        if (!last) {
            if (lane < 16) { float a_ = 0.f;
#pragma unroll
                for (int q_ = 0; q_ < 16; ++q_) a_ += ssp[lane * 16 + q_];
                ssq1[t0 + lane] = a_; }
#if IN_I8
            asm volatile("s_waitcnt vmcnt(0)" ::: "memory");
            if (TAIL_FENCE_LIGHT) __builtin_amdgcn_fence(__ATOMIC_ACQUIRE, "agent"); else __builtin_amdgcn_fence(__ATOMIC_SEQ_CST, "agent");
            asm volatile("s_waitcnt vmcnt(0)" ::: "memory");
            for (int hb_ = 0; hb_ < 2; ++hb_) {
                u32x4 xa[8], xb[8];
#pragma unroll
                for (int tt = 0; tt < 8; ++tt) { const bf16_t* xr = HB + (size_t)(t0 + 8 * hb_ + tt) * DM + 8 * lane; xa[tt] = *(const u32x4*)xr; xb[tt] = *(const u32x4*)(xr + 512); }
#pragma unroll
                for (int tt = 0; tt < 8; ++tt) {
                    const float f[16] = {bflo(xa[tt].x), bfhi(xa[tt].x), bflo(xa[tt].y), bfhi(xa[tt].y), bflo(xa[tt].z), bfhi(xa[tt].z), bflo(xa[tt].w), bfhi(xa[tt].w),
                                         bflo(xb[tt].x), bfhi(xb[tt].x), bflo(xb[tt].y), bfhi(xb[tt].y), bflo(xb[tt].z), bfhi(xb[tt].z), bflo(xb[tt].w), bfhi(xb[tt].w)};
                    quant_arow_i8(f, A8 + (size_t)(t0 + 8 * hb_ + tt) * DM, SA + t0 + 8 * hb_ + tt, lane);
                }
            }
#endif
            return;
        }
        asm volatile("s_waitcnt vmcnt(0)" ::: "memory");
        if (TAIL_FENCE_LIGHT) __builtin_amdgcn_fence(__ATOMIC_ACQUIRE, "agent"); else __builtin_amdgcn_fence(__ATOMIC_SEQ_CST, "agent");
        asm volatile("s_waitcnt vmcnt(0)" ::: "memory");
        const f32x4 g0 = *(const f32x4*)(final_g + 8 * lane), g1 = *(const f32x4*)(final_g + 8 * lane + 4), g2 = *(const f32x4*)(final_g + 512 + 8 * lane), g3 = *(const f32x4*)(final_g + 516 + 8 * lane);
        for (int tt = 0; tt < 16; ++tt) {
            const int t = t0 + tt;
            float ss = 0.f;
#pragma unroll
            for (int q_ = 0; q_ < 16; ++q_) ss += ssp[tt * 16 + q_];
            float rs = rsqrtf(ss * (1.0f / 1024.0f) + RMS_EPS);
            const bf16_t* bp = HB + (size_t)t * DM + 8 * lane;
            const u32x4 a_ = *(const u32x4*)bp, b_ = *(const u32x4*)(bp + 512);
            float* hp = H + (size_t)t * DM + 8 * lane;
            const f32x4 h0 = (f32x4){bflo(a_.x), bfhi(a_.x), bflo(a_.y), bfhi(a_.y)} * rs * g0, h1 = (f32x4){bflo(a_.z), bfhi(a_.z), bflo(a_.w), bfhi(a_.w)} * rs * g1;
            const f32x4 h2 = (f32x4){bflo(b_.x), bfhi(b_.x), bflo(b_.y), bfhi(b_.y)} * rs * g2, h3 = (f32x4){bflo(b_.z), bfhi(b_.z), bflo(b_.w), bfhi(b_.w)} * rs * g3;
            __builtin_nontemporal_store(h0, (f32x4*)hp); __builtin_nontemporal_store(h1, (f32x4*)(hp + 4)); __builtin_nontemporal_store(h2, (f32x4*)(hp + 512)); __builtin_nontemporal_store(h3, (f32x4*)(hp + 516));
        }
        return;
    }
#endif
    __builtin_amdgcn_fence(__ATOMIC_SEQ_CST, "agent");
    asm volatile("s_waitcnt vmcnt(0)" ::: "memory");
    for (int tt = 0; tt < 16; ++tt) {
        const int t = t0 + tt;
        float* hp = H + (size_t)t * DM + 8 * lane;
        f32x4 h0 = *(const f32x4*)hp, h1 = *(const f32x4*)(hp + 4), h2 = *(const f32x4*)(hp + 512), h3 = *(const f32x4*)(hp + 516);
        float ss = (h0[0] * h0[0] + h0[1] * h0[1]) + (h0[2] * h0[2] + h0[3] * h0[3]) + (h1[0] * h1[0] + h1[1] * h1[1]) + (h1[2] * h1[2] + h1[3] * h1[3])
                 + (h2[0] * h2[0] + h2[1] * h2[1]) + (h2[2] * h2[2] + h2[3] * h2[3]) + (h3[0] * h3[0] + h3[1] * h3[1]) + (h3[2] * h3[2] + h3[3] * h3[3]);
        ss = wave_sum(ss);
        if (last) {
            const float rs = rsqrtf(ss * (1.0f / 1024.0f) + RMS_EPS);
            const f32x4 g0 = *(const f32x4*)(final_g + 8 * lane), g1 = *(const f32x4*)(final_g + 8 * lane + 4), g2 = *(const f32x4*)(final_g + 512 + 8 * lane), g3 = *(const f32x4*)(final_g + 516 + 8 * lane);
            h0 = h0 * rs * g0; h1 = h1 * rs * g1; h2 = h2 * rs * g2; h3 = h3 * rs * g3;
            *(f32x4*)hp = h0; *(f32x4*)(hp + 4) = h1; *(f32x4*)(hp + 512) = h2; *(f32x4*)(hp + 516) = h3;
        } else {
            bf16_t* bp = HB + (size_t)t * DM + 8 * lane;
            u32x4 w; w.x = cvtpk(h0[0], h0[1]); w.y = cvtpk(h0[2], h0[3]); w.z = cvtpk(h1[0], h1[1]); w.w = cvtpk(h1[2], h1[3]);
            *(u32x4*)bp = w;
            w.x = cvtpk(h2[0], h2[1]); w.y = cvtpk(h2[2], h2[3]); w.z = cvtpk(h3[0], h3[1]); w.w = cvtpk(h3[2], h3[3]);
            *(u32x4*)(bp + 512) = w;
            if (lane == 0) ssq1[t] = ss;
        }
    }
}

__device__ __forceinline__ float gelu_erf(float x) { return 0.5f * x * (1.0f + erff(x * 0.70710678118654752f)); }

__device__ __forceinline__ void gather_phase(float* __restrict__ H, bf16_t* __restrict__ HB, const float* __restrict__ ssq2, float* __restrict__ ssq1,
                                             const bf16_t* __restrict__ U16, const bf16_t* __restrict__ V16, const int* __restrict__ ids, const float* __restrict__ gw,
                                             const float* __restrict__ final_g, int last, int gwave, int ngw, int lane, int dry = 0, int idmask = 0xffff) {
    for (int t0 = gwave; t0 < T; t0 += ngw) {
        const int t = __builtin_amdgcn_readfirstlane(t0);
        const u32x4 xa = *(const u32x4*)(HB + (size_t)t * DM + 8 * lane), xb = *(const u32x4*)(HB + (size_t)t * DM + 512 + 8 * lane);
        const float rs2 = rsqrtf(ssq16(ssq2, t) * (1.0f / 1024.0f) + RMS_EPS);
        float y[16];
#pragma unroll
        for (int i = 0; i < 16; ++i) y[i] = 0.f;
        const int* idp = ids + (size_t)t * 128; const float* gp = gw + (size_t)t * 128;
        for (int c = 0; c < 16; ++c) {
            u32x4 ua[8], ub[8], va[8], vb[8]; float g[8];
#pragma unroll
            for (int e = 0; e < 8; ++e) {
                const int id = __builtin_amdgcn_readfirstlane(idp[c * 8 + e]) & idmask;
                g[e] = gp[c * 8 + e];
                const bf16_t* ur = U16 + (size_t)id * DM + 8 * lane; const bf16_t* vr = V16 + (size_t)id * DM + 8 * lane;
                ua[e] = *(const u32x4*)ur; ub[e] = *(const u32x4*)(ur + 512); va[e] = *(const u32x4*)vr; vb[e] = *(const u32x4*)(vr + 512);
            }
#pragma unroll
            for (int e = 0; e < 8; ++e) {
                float a = 0.f;
                a = dot2bf(xa.x, ua[e].x, a); a = dot2bf(xa.y, ua[e].y, a); a = dot2bf(xa.z, ua[e].z, a); a = dot2bf(xa.w, ua[e].w, a);
                a = dot2bf(xb.x, ub[e].x, a); a = dot2bf(xb.y, ub[e].y, a); a = dot2bf(xb.z, ub[e].z, a); a = dot2bf(xb.w, ub[e].w, a);
                a = wave_sum(a);
                const float w = g[e] * gelu_erf(a * rs2);
                y[0] = fmaf(w, bflo(va[e].x), y[0]); y[1] = fmaf(w, bfhi(va[e].x), y[1]); y[2] = fmaf(w, bflo(va[e].y), y[2]); y[3] = fmaf(w, bfhi(va[e].y), y[3]);
                y[4] = fmaf(w, bflo(va[e].z), y[4]); y[5] = fmaf(w, bfhi(va[e].z), y[5]); y[6] = fmaf(w, bflo(va[e].w), y[6]); y[7] = fmaf(w, bfhi(va[e].w), y[7]);
                y[8] = fmaf(w, bflo(vb[e].x), y[8]); y[9] = fmaf(w, bfhi(vb[e].x), y[9]); y[10] = fmaf(w, bflo(vb[e].y), y[10]); y[11] = fmaf(w, bfhi(vb[e].y), y[11]);
                y[12] = fmaf(w, bflo(vb[e].z), y[12]); y[13] = fmaf(w, bfhi(vb[e].z), y[13]); y[14] = fmaf(w, bflo(vb[e].w), y[14]); y[15] = fmaf(w, bfhi(vb[e].w), y[15]);
            }
        }
        float* hp = H + (size_t)t * DM + 8 * lane;
        f32x4 h0 = *(const f32x4*)hp, h1 = *(const f32x4*)(hp + 4), h2 = *(const f32x4*)(hp + 512), h3 = *(const f32x4*)(hp + 516);
        h0 += (f32x4){y[0], y[1], y[2], y[3]}; h1 += (f32x4){y[4], y[5], y[6], y[7]}; h2 += (f32x4){y[8], y[9], y[10], y[11]}; h3 += (f32x4){y[12], y[13], y[14], y[15]};
        float ss = (h0[0] * h0[0] + h0[1] * h0[1]) + (h0[2] * h0[2] + h0[3] * h0[3]) + (h1[0] * h1[0] + h1[1] * h1[1]) + (h1[2] * h1[2] + h1[3] * h1[3])
                 + (h2[0] * h2[0] + h2[1] * h2[1]) + (h2[2] * h2[2] + h2[3] * h2[3]) + (h3[0] * h3[0] + h3[1] * h3[1]) + (h3[2] * h3[2] + h3[3] * h3[3]);
        ss = wave_sum(ss);
        if (dry && ss >= 0.f) continue;
        if (last) {
            const float rs = rsqrtf(ss * (1.0f / 1024.0f) + RMS_EPS);
            const f32x4 g0 = *(const f32x4*)(final_g + 8 * lane), g1 = *(const f32x4*)(final_g + 8 * lane + 4), g2 = *(const f32x4*)(final_g + 512 + 8 * lane), g3 = *(const f32x4*)(final_g + 516 + 8 * lane);
            h0 = h0 * rs * g0; h1 = h1 * rs * g1; h2 = h2 * rs * g2; h3 = h3 * rs * g3;
            *(f32x4*)hp = h0; *(f32x4*)(hp + 4) = h1; *(f32x4*)(hp + 512) = h2; *(f32x4*)(hp + 516) = h3;
        } else {
            *(f32x4*)hp = h0; *(f32x4*)(hp + 4) = h1; *(f32x4*)(hp + 512) = h2; *(f32x4*)(hp + 516) = h3;
            bf16_t* bp = HB + (size_t)t * DM + 8 * lane;
            u32x4 w; w.x = cvtpk(h0[0], h0[1]); w.y = cvtpk(h0[2], h0[3]); w.z = cvtpk(h1[0], h1[1]); w.w = cvtpk(h1[2], h1[3]);
            *(u32x4*)bp = w;
            w.x = cvtpk(h2[0], h2[1]); w.y = cvtpk(h2[2], h2[3]); w.z = cvtpk(h3[0], h3[1]); w.w = cvtpk(h3[2], h3[3]);
            *(u32x4*)(bp + 512) = w;
            if (lane == 0) ssq1[t] = ss;
        }
    }
}

#define XB_TMO      128
#define XB_XCNT(j)  (256  + 64 * (j))
#define XB_XSUB(j)  (1280 + 64 * (j))
#define XB_XGEN(j)  (2304 + 64 * (j))
#define XB_TOP      3328
#define XB_TOPGEN   3392
#define XCD_BAR_WORDS 3456
#define XB_SPIN_CAP (1u << 18)

__device__ __forceinline__ unsigned xb_ld(unsigned* p)              { return __hip_atomic_load(p, __ATOMIC_RELAXED, __HIP_MEMORY_SCOPE_AGENT); }
__device__ __forceinline__ unsigned xb_add(unsigned* p, unsigned v) { return __hip_atomic_fetch_add(p, v, __ATOMIC_RELAXED, __HIP_MEMORY_SCOPE_AGENT); }
__device__ __forceinline__ unsigned xb_xcc_id() { return (unsigned)__builtin_amdgcn_s_getreg((3 << 11) | 20) & 0xFu; }
#define XB_SPIN(cond, bar) do { unsigned _sp = 0; while (cond) { __builtin_amdgcn_s_sleep(1); \
    if ((++_sp & 255u) == 0u) { if (xb_ld(&(bar)[XB_TMO])) break; if (_sp > XB_SPIN_CAP) { atomicAdd(&(bar)[XB_TMO], 1u); break; } } } } while (0)

struct XcdBarrier {
    unsigned* bar; unsigned x;
    volatile LAS unsigned* st;
};

__device__ __forceinline__ XcdBarrier xcd_barrier_post(unsigned* bar, volatile LAS unsigned* st, int tid) {
    XcdBarrier b; b.bar = bar; b.x = xb_xcc_id(); b.st = st;
    if (tid == 0) (void)xb_add(&bar[XB_XCNT(b.x)], 1u);
    return b;
}
__device__ __forceinline__ void xcd_barrier_complete(unsigned* bar, unsigned x, unsigned& nloc, unsigned& nx) {
    const unsigned G = gridDim.x * gridDim.y * gridDim.z;
    unsigned sum, cnt, mine, sp = 0u;
    for (;;) {
        sum = 0u; cnt = 0u; mine = 0u;
#pragma unroll
        for (unsigned j = 0; j < 16; ++j) { const unsigned c = xb_ld(&bar[XB_XCNT(j)]); sum += c; cnt += (c > 0u) ? 1u : 0u; mine = (j == x) ? c : mine; }
        if (sum == G) break;
        __builtin_amdgcn_s_sleep(1);
        if ((++sp & 255u) == 0u) { if (xb_ld(&bar[XB_TMO])) break; if (sp > XB_SPIN_CAP) { atomicAdd(&bar[XB_TMO], 1u); break; } }
    }
    nloc = mine > 0u ? mine : 1u; nx = cnt > 0u ? cnt : 1u;
}

__device__ __forceinline__ void xcd_barrier(const XcdBarrier& b, int tid) {
    asm volatile("s_waitcnt vmcnt(0)" ::: "memory");
    __syncthreads();
    if (tid == 0) {
        unsigned* bar = b.bar;
        __builtin_amdgcn_s_waitcnt(0);
        unsigned nloc = b.st[0], nx = b.st[1];
        if (nloc == 0u) { xcd_barrier_complete(bar, b.x, nloc, nx); b.st[0] = nloc; b.st[1] = nx; }
        const unsigned old = xb_add(&bar[XB_XSUB(b.x)], 1u);
        const unsigned gen = old / nloc;
        if (old + 1u == (gen + 1u) * nloc) {
            __builtin_amdgcn_fence(__ATOMIC_RELEASE, "agent");
            asm volatile("s_waitcnt vmcnt(0)" ::: "memory");
            const unsigned og = xb_add(&bar[XB_TOP], 1u);
            const unsigned tg = og / nx;
            if (og + 1u == (tg + 1u) * nx) xb_add(&bar[XB_TOPGEN], 1u);
            else XB_SPIN(xb_ld(&bar[XB_TOPGEN]) == tg, bar);
            __builtin_amdgcn_fence(__ATOMIC_ACQUIRE, "agent");
            xb_add(&bar[XB_XGEN(b.x)], 1u);
            asm volatile("s_waitcnt vmcnt(0)" ::: "memory");
        } else {
            XB_SPIN(xb_ld(&bar[XB_XGEN(b.x)]) == gen, bar);
            __builtin_amdgcn_fence(__ATOMIC_ACQUIRE, "agent");
            asm volatile("s_waitcnt vmcnt(0)" ::: "memory");
        }
    }
    __syncthreads();
}
struct Params { const float* in[18]; float* out; unsigned char* ws; int ph_lo, ph_hi; };

typedef const __attribute__((address_space(4))) Params* KP;
#define KARGS() KP pp = (KP)__builtin_amdgcn_kernarg_segment_ptr(); asm volatile("" : "+s"(pp))
#ifndef PEER_FP8
#define PEER_FP8 1
#endif
#ifndef PEER_I8
#define PEER_I8 1
#endif
#ifndef G4P
#define G4P 0
#endif
#ifndef STAGGER_TICKS
#define STAGGER_TICKS 0
#endif
#ifndef PROBE_DUP
#define PROBE_DUP 0
#endif
#define PH_ON(k, bit) ((PH_MASK & (bit)) && ph_lo <= (k) && (k) < ph_hi)
constexpr int CW_BAR = 4096;
constexpr int MISC_OFF = 131072 + 320;
__device__ __forceinline__ int lane_id_opaque() { int l; asm volatile("v_mbcnt_lo_u32_b32 %0, -1, 0\n\tv_mbcnt_hi_u32_b32 %0, -1, %0" : "=v"(l)); return l; }
#define PH_SYNC(k) do { if ((k) > ph_lo) { { KP pq = (KP)__builtin_amdgcn_kernarg_segment_ptr(); \
    XcdBarrier xb_; xb_.bar = (unsigned*)(pq->ws + WS_CTL) + CW_BAR; xb_.x = xb_xcc_id(); xb_.st = (volatile LAS unsigned*)(lds + MISC_OFF) + 8; xcd_barrier(xb_, tid); if (PROBE_DUP == 15) { xcd_barrier(xb_, tid); xcd_barrier(xb_, tid); } } } } while (0)
#define PH_IDS() const int lane = lane_id_opaque(); const int tid = wave * 64 + lane

__device__ __forceinline__ void weight_prep(KP pp, int l, LAS float* scr, int gw0, int ngw, int lane) {
    unsigned char* wl = pp->ws + WS_W + (size_t)l * WL_STRIDE;
    const float* g1 = pp->in[2] + (size_t)l * DM; const float* g2 = pp->in[11] + (size_t)l * DM;
    constexpr int N_BR = 3 * 192, N_OUT = 512, N_INQ = N_IN / 8, N_QQ = 2048 / 8;
    static_assert(IN_I8 && Q_I8 && IN_I8_LAYERS == 3, "the flat weight-preparation list is written for the int8 in-projection and query projection");
    for (int it = gw0; it < N_BR + N_OUT + N_INQ + N_QQ; it += ngw) {
        if (it < N_BR) { const int i = it / 192, j = it - 192 * i;
            transpose_item<0>(pp->in[7 + i] + (size_t)l * 384 * DM, 384, DM, (bf16_t*)(wl + WL_BR) + (size_t)i * DM * 384, nullptr, scr, j, 32, lane); }
        else if (it < N_BR + N_OUT) transpose_item<0>(pp->in[10] + (size_t)l * DM * DM, DM, DM, (bf16_t*)(wl + WL_OUT), nullptr, scr, it - N_BR, 32, lane);
        else if (it < N_BR + N_OUT + N_INQ) quant_win_item(pp->in[3] + (size_t)l * DM * IN_COLS, g1, wl + WL_IN, (float*)(wl + WL_INSC), it - N_BR - N_OUT, lane);
        else quant_win_item<0, 2048>(pp->in[12] + (size_t)l * DM * 2048, g2, wl + WL_Q, (float*)(wl + WL_Q + WL_QSC), it - N_BR - N_OUT - N_INQ, lane);
    }
}

template <int l>
__device__ __forceinline__ void layer_phases(const int ph_lo, const int ph_hi, LAS unsigned char* lds, const int wave) {
    constexpr int pb = 1 + 8 * l;
        if (PH_ON(pb + 0, 2)) {
            PH_IDS(); PH_SYNC(pb + 0); KARGS();
            unsigned char* ws = pp->ws; unsigned char* wl = ws + WS_W + (size_t)l * WL_STRIDE;
            const int G = gridDim.x;
            constexpr bool I8L = IN_I8 && ((IN_I8_LAYERS >> l) & 1);
            pg8::Gemm g{(const bf16_t*)(ws + (I8L ? WS_A8 : WS_HB)), (const bf16_t*)(wl + WL_IN), T, N_IN, I8L ? DM / 2 : DM, I8L ? DM / 2 : DM};
            pg8::StaticOrder S; S.init(T, N_IN, G, (int)blockIdx.x);
            EpiInT<I8L> E{(bf16_t*)(ws + WS_P), (bf16_t*)(ws + WS_G), (const float*)(ws + WS_SSQ1), (const float*)(ws + WS_ROPE), pp->in[6] + (size_t)l * 3 * DM, pp->in[4] + (size_t)l * 6, (float*)(ws + WS_LOGF), 0,
                    (const float*)(ws + WS_SA), (const float*)(wl + WL_INSC)};
            if (STAGGER_TICKS > 0 && (blockIdx.x & 1)) { const unsigned long long t0_ = __builtin_amdgcn_s_memrealtime(); while (__builtin_amdgcn_s_memrealtime() - t0_ < (unsigned long long)STAGGER_TICKS) __builtin_amdgcn_s_sleep(20); }
            pg8::gemm_phase<EpiInT<I8L>, pg8::StaticOrder, true, true, I8L>(lds, g, S, E, tid);
            if (PROBE_DUP == 1) { __syncthreads(); pg8::gemm_phase<EpiInT<I8L>, pg8::StaticOrder, true, true, I8L>(lds, g, S, E, tid); }
            if (PROBE_DUP == 13) { __syncthreads(); EpiInT<I8L> En = E; En.nostore = 1; pg8::gemm_phase<EpiInT<I8L>, pg8::StaticOrder, true, true, I8L>(lds, g, S, En, tid); }
            if (PROBE_DUP == 12) { __syncthreads(); EpiDry Ed{(float*)(ws + WS_CTL) + 8192}; pg8::gemm_phase<EpiDry, pg8::StaticOrder, true, true>(lds, g, S, Ed, tid); }
        }
        if (PH_ON(pb + 1, 4)) {
            PH_IDS(); PH_SYNC(pb + 1); KARGS();
            float* logf = (float*)(pp->ws + WS_LOGF); float* cumT = (float*)(pp->ws + WS_CUMT);
            LAS float* wt = (LAS float*)lds;
            for (int r = (int)blockIdx.x * 512 + tid; r < BATCH * 6 * SEQ; r += (int)gridDim.x * 512) {
                const int sq = r >> 13, sp_ = r & (SEQ - 1), b = sq / 6, h = sq % 6;
                const bf16_t* kr = (const bf16_t*)(pp->ws + WS_P) + ((size_t)b * SEQ + sp_) * NP + PC_KB + 64 * h;
                float n2 = 0.f;
#pragma unroll
                for (int c = 0; c < 8; ++c) { const u32x4 kk = *(const u32x4*)(kr + 8 * c);
                    n2 += (bflo(kk.x) * bflo(kk.x) + bfhi(kk.x) * bfhi(kk.x)) + (bflo(kk.y) * bflo(kk.y) + bfhi(kk.y) * bfhi(kk.y)) + (bflo(kk.z) * bflo(kk.z) + bfhi(kk.z) * bfhi(kk.z)) + (bflo(kk.w) * bflo(kk.w) + bfhi(kk.w) * bfhi(kk.w)); }
#pragma unroll
                for (int o = 1; o < 64; o <<= 1) n2 = fmaxf(n2, __shfl_xor(n2, o));
                if (lane == 0) atomicMax((unsigned*)(pp->ws + WS_KMAX_BASE + 256 * l) + sq, __float_as_uint(n2));
            }
            if (l + 1 < DEPTH && (int)blockIdx.x >= BATCH * 6 && (int)gridDim.x > BATCH * 6)
                weight_prep(pp, l + 1, (LAS float*)(lds + wave * 8448), ((int)blockIdx.x - BATCH * 6) * 8 + wave, ((int)gridDim.x - BATCH * 6) * 8, lane);
            for (int sq = blockIdx.x; sq < BATCH * 6; sq += gridDim.x) {
                const int b = sq / 6, h = sq % 6;
                float* base = logf + (size_t)b * SEQ * 8 + h;
                float v[16]; float run = 0.f;
#pragma unroll
                for (int i = 0; i < 16; ++i) { run += base[(size_t)(tid * 16 + i) * 8]; v[i] = run; }
                float inc = run;
#pragma unroll
                for (int o = 1; o < 64; o <<= 1) { const float n = __shfl_up(inc, o); if (lane >= o) inc += n; }
                __syncthreads();
                if (lane == 63) wt[wave] = inc;
                __syncthreads();
                float off = inc - run;
                for (int w = 0; w < wave; ++w) off += wt[w];
#pragma unroll
                for (int i = 0; i < 16; ++i) cumT[(size_t)sq * SEQ + tid * 16 + i] = (v[i] + off) * LOG2E;
            }
        }
        if (PH_ON(pb + 2, 8)) {
            PH_IDS(); PH_SYNC(pb + 2); KARGS();
            if (ATT_XCD && MIXA_3PASS == 0) attention_phase_x(pp->ws, pp->in[5] + (size_t)l * 6, CW_ATT + 64 * l, (int)(WS_KMAX_BASE / 4) + 64 * l, lds, wave, lane, (int)xb_xcc_id());
            else attention_phase(pp->ws, pp->in[5] + (size_t)l * 6, CW_ATT + 64 * l, CW_GRP + 512 * l, (int)(WS_KMAX_BASE / 4) + 64 * l, lds, wave, lane, 0);
            if (PROBE_DUP == 21) { __syncthreads(); KP pq3 = (KP)__builtin_amdgcn_kernarg_segment_ptr(); attention_phase(pq3->ws, pq3->in[5] + (size_t)l * 6, CW_ATT + 64 * l + 16, CW_GRP + 512 * l, (int)(WS_KMAX_BASE / 4) + 64 * l, lds, wave, lane, 1); }
        }
        if (PH_ON(pb + 3, 16)) {
            PH_IDS(); PH_SYNC(pb + 3); KARGS();
            unsigned char* ws = pp->ws; unsigned char* wl = ws + WS_W + (size_t)l * WL_STRIDE;
            bf16_t* P = (bf16_t*)(ws + WS_P);
            for (int rep = 0; rep < (PROBE_DUP == 6 ? 2 : 1); ++rep) {
                pg8::Gemm g{P, (const bf16_t*)(wl + WL_BR), T, DM, 384, NP};
                BranchOrder S; S.init(T, DM, (int)gridDim.x, (int)blockIdx.x);
                EpiBrChain E{(const unsigned char*)(ws + WS_G), P + PC_MERGED};
                pg8::gemm_phase<EpiBrChain, BranchOrder, true, true>(lds, g, S, E, tid);
                __syncthreads();
            }
        }
        if (PH_ON(pb + 4, 32)) {
            PH_IDS(); PH_SYNC(pb + 4); KARGS();
            unsigned char* ws = pp->ws; unsigned char* wl = ws + WS_W + (size_t)l * WL_STRIDE;
            pg8::Gemm g{(const bf16_t*)(ws + WS_P) + PC_MERGED, (const bf16_t*)(wl + WL_OUT), T, DM, DM, NP};
            pg8::StaticOrder S; S.init(T, DM, (int)gridDim.x, (int)blockIdx.x);
            EpiOut E{l == 0 ? pp->in[0] : pp->out, pp->out, (bf16_t*)(ws + WS_HB), (float*)(ws + WS_SSQ2P)};
            pg8::gemm_phase<EpiOut, pg8::StaticOrder, true, true>(lds, g, S, E, tid);
            if (PROBE_DUP == 14 && l == 0) { __syncthreads(); pg8::gemm_phase<EpiOut, pg8::StaticOrder, true, true>(lds, g, S, E, tid); }
        }
        if (PH_ON(pb + 5, 64)) {
            PH_IDS(); PH_SYNC(pb + 5); KARGS();
            unsigned char* ws = pp->ws; unsigned char* wl = ws + WS_W + (size_t)l * WL_STRIDE;
            for (int rep = 0; rep < (PROBE_DUP == 7 ? 2 : 1); ++rep) {
            {
                if (Q_I8) {
                    const int t0_ = ((int)blockIdx.x * 8 + wave) * 16;
                    for (int hb_ = 0; hb_ < (PROBE_DUP == 18 ? 8 : 2); ++hb_) {
                        u32x4 xa[8], xb[8];
#pragma unroll
                        for (int tt = 0; tt < 8; ++tt) { const bf16_t* xr = (const bf16_t*)(ws + WS_HB) + (size_t)(t0_ + 8 * (hb_ & 1) + tt) * DM + 8 * lane; xa[tt] = *(const u32x4*)xr; xb[tt] = *(const u32x4*)(xr + 512); }
#pragma unroll
                        for (int tt = 0; tt < 8; ++tt) {
                            const float f[16] = {bflo(xa[tt].x), bfhi(xa[tt].x), bflo(xa[tt].y), bfhi(xa[tt].y), bflo(xa[tt].z), bfhi(xa[tt].z), bflo(xa[tt].w), bfhi(xa[tt].w),
                                                 bflo(xb[tt].x), bfhi(xb[tt].x), bflo(xb[tt].y), bfhi(xb[tt].y), bflo(xb[tt].z), bfhi(xb[tt].z), bflo(xb[tt].w), bfhi(xb[tt].w)};
                            quant_arow_i8(f, ws + WS_XQ + (size_t)(t0_ + 8 * (hb_ & 1) + tt) * DM, (float*)(ws + WS_SX) + t0_ + 8 * (hb_ & 1) + tt, lane);
                        }
                    }
                    { KP pq = (KP)__builtin_amdgcn_kernarg_segment_ptr(); XcdBarrier xb_; xb_.bar = (unsigned*)(pq->ws + WS_CTL) + CW_BAR; xb_.x = xb_xcc_id(); xb_.st = (volatile LAS unsigned*)(lds + MISC_OFF) + 8; xcd_barrier(xb_, tid); }
                }
                pg8::Gemm g{(const bf16_t*)(ws + (Q_I8 ? WS_XQ : WS_HB)), (const bf16_t*)(wl + WL_Q), T, 2048, Q_I8 ? DM / 2 : DM, Q_I8 ? DM / 2 : DM};
                pg8::StaticOrder S; S.init(T, 2048, (int)gridDim.x, (int)blockIdx.x);
                EpiQT<Q_I8 != 0> E{(bf16_t*)(ws + WS_Q2), (const float*)(ws + WS_SSQ2P), (const float*)(ws + WS_SX), (const float*)(wl + WL_Q + WL_QSC)};
                pg8::gemm_phase<EpiQT<Q_I8 != 0>, pg8::StaticOrder, true, true, Q_I8 != 0>(lds, g, S, E, tid);
                if (PROBE_DUP == 17) { __syncthreads(); pg8::gemm_phase<EpiQT<Q_I8 != 0>, pg8::StaticOrder, true, true, Q_I8 != 0>(lds, g, S, E, tid); }
            }
            __syncthreads();
            }
        }
        if (PH_ON(pb + 6, 128)) {
            PH_IDS(); PH_SYNC(pb + 6); KARGS();
            unsigned char* ws = pp->ws;
            if (PROBE_DUP == 3) { routing_phase((const bf16_t*)(ws + WS_Q2), pp->in[13] + (size_t)l * 128 * 128, pp->in[14] + (size_t)l * 128 * 128, (int*)(ws + WS_IDS), (float*)(ws + WS_GW), lds, tid); __syncthreads(); }
            routing2_setup(pp->in[13] + (size_t)l * 128 * 128, pp->in[14] + (size_t)l * 128 * 128, lds, tid);
            if (wave < 4) routing2_units((const bf16_t*)(ws + WS_Q2), (int*)(ws + WS_IDS), (float*)(ws + WS_GW), lds, wave, lane, (int)blockIdx.x * 8 + wave, (int)gridDim.x * 8);
            if (PEER_I8) {
                const float* u = pp->in[15] + (size_t)l * N_EXP * DM; const float* v = pp->in[16] + (size_t)l * N_EXP * DM;
                const float* g2 = pp->in[11] + (size_t)l * DM;
                {
                    const int rstep = (int)gridDim.x * 8;
                    int r = (int)blockIdx.x * 8 + wave;
                    f32x4 cu[4], cv[4], nu[4], nv[4];
                    if (r < N_EXP) { quant_row_load(cu, u + (size_t)r * DM, lane); quant_row_load(cv, v + (size_t)r * DM, lane); }
                    for (; r < N_EXP; r += rstep) {
                        const int rn = r + rstep;
                        if (rn < N_EXP) { quant_row_load(nu, u + (size_t)rn * DM, lane); quant_row_load(nv, v + (size_t)rn * DM, lane); }
                        quant_row_finish(cu, g2, ws + WS_U8 + (size_t)r * DM, (float*)(ws + WS_SU) + r, 0, lane);
                        quant_row_finish(cv, nullptr, ws + WS_V8 + (size_t)r * DM, (float*)(ws + WS_SV) + r, G5_VDOT4 ? 0 : 128, lane);
#pragma unroll
                        for (int j = 0; j < 4; ++j) { cu[j] = nu[j]; cv[j] = nv[j]; }
                    }
                }
            } else if (PEER_FP8) {
                const float* u = pp->in[15] + (size_t)l * N_EXP * DM; const float* v = pp->in[16] + (size_t)l * N_EXP * DM;
                const float* g2 = pp->in[11] + (size_t)l * DM;
                for (int r = (int)blockIdx.x * 8 + wave; r < N_EXP; r += (int)gridDim.x * 8) {
                    quant_row_fp8(u + (size_t)r * DM, g2, ws + WS_U8 + (size_t)r * DM, (float*)(ws + WS_SU) + r, lane);
                    quant_row_fp8(v + (size_t)r * DM, nullptr, ws + WS_V8 + (size_t)r * DM, (float*)(ws + WS_SV) + r, lane);
                }
            } else {
                const float* u = pp->in[15] + (size_t)l * N_EXP * DM; const float* v = pp->in[16] + (size_t)l * N_EXP * DM;
                const float* g2 = pp->in[11] + (size_t)l * DM;
                bf16_t* U16 = (bf16_t*)(ws + WS_U16); bf16_t* V16 = (bf16_t*)(ws + WS_V16);
                for (unsigned e = blockIdx.x * 512 + tid; e < (unsigned)(N_EXP * DM / 8); e += gridDim.x * 512) {
                    const unsigned o = e * 8; const int c = (int)(o & (DM - 1));
                    const f32x4 a0 = *(const f32x4*)(u + o), a1 = *(const f32x4*)(u + o + 4), s0 = *(const f32x4*)(g2 + c), s1 = *(const f32x4*)(g2 + c + 4);
                    u32x4 w; w.x = cvtpk(a0[0] * s0[0], a0[1] * s0[1]); w.y = cvtpk(a0[2] * s0[2], a0[3] * s0[3]); w.z = cvtpk(a1[0] * s1[0], a1[1] * s1[1]); w.w = cvtpk(a1[2] * s1[2], a1[3] * s1[3]);
                    *(u32x4*)(U16 + o) = w;
                    const f32x4 b0 = *(const f32x4*)(v + o), b1 = *(const f32x4*)(v + o + 4);
                    if (G3_VF16) { w.x = cvtpk_h(b0[0], b0[1]); w.y = cvtpk_h(b0[2], b0[3]); w.z = cvtpk_h(b1[0], b1[1]); w.w = cvtpk_h(b1[2], b1[3]); }
                    else { w.x = cvtpk(b0[0], b0[1]); w.y = cvtpk(b0[2], b0[3]); w.z = cvtpk(b1[0], b1[1]); w.w = cvtpk(b1[2], b1[3]); }
                    *(u32x4*)(V16 + o) = w;
                }
            }
            if (wave >= 4) routing2_units((const bf16_t*)(ws + WS_Q2), (int*)(ws + WS_IDS), (float*)(ws + WS_GW), lds, wave, lane, (int)blockIdx.x * 8 + wave, (int)gridDim.x * 8);
            if (PROBE_DUP == 19) routing2_units((const bf16_t*)(ws + WS_Q2), (int*)(ws + WS_IDS), (float*)(ws + WS_GW), lds, wave, lane, (int)blockIdx.x * 8 + wave, (int)gridDim.x * 8);
        }
        if (PH_ON(pb + 7, 256)) {
            PH_IDS(); PH_SYNC(pb + 7); KARGS();
            unsigned char* ws = pp->ws;
            if (PROBE_DUP == 4) gather_phase(pp->out, (bf16_t*)(ws + WS_HB), (const float*)(ws + WS_SSQ2P), (float*)(ws + WS_SSQ1), (const bf16_t*)(ws + WS_U16), (const bf16_t*)(ws + WS_V16),
                         (const int*)(ws + WS_IDS), (const float*)(ws + WS_GW), pp->in[17], l == DEPTH - 1 ? 1 : 0, (int)blockIdx.x * 8 + wave, (int)gridDim.x * 8, lane, 1);
            if (PROBE_DUP == 5) gather_phase(pp->out, (bf16_t*)(ws + WS_HB), (const float*)(ws + WS_SSQ2P), (float*)(ws + WS_SSQ1), (const bf16_t*)(ws + WS_U16), (const bf16_t*)(ws + WS_V16),
                         (const int*)(ws + WS_IDS), (const float*)(ws + WS_GW), pp->in[17], l == DEPTH - 1 ? 1 : 0, (int)blockIdx.x * 8 + wave, (int)gridDim.x * 8, lane, 1, 511);
            if (PROBE_DUP == 10 || PROBE_DUP == 11) gather5_phase(pp->out, (bf16_t*)(ws + WS_HB), (const float*)(ws + WS_SSQ2P), (float*)(ws + WS_SSQ1), ws + WS_U8, ws + WS_V8, (const float*)(ws + WS_SU), (const float*)(ws + WS_SV),
                         ws + WS_XQ, (const int*)(ws + WS_IDS), (const float*)(ws + WS_GW), pp->in[17], l == DEPTH - 1 ? 1 : 0, lds, wave, (int)blockIdx.x * 8 + wave, lane, 1 | G4P, PROBE_DUP == 10 ? 7 : 0xffff);
            if (PROBE_DUP == 20) { gather5_phase(pp->out, (bf16_t*)(ws + WS_HB), (const float*)(ws + WS_SSQ2P), (float*)(ws + WS_SSQ1), ws + WS_U8, ws + WS_V8, (const float*)(ws + WS_SU), (const float*)(ws + WS_SV),
                         ws + WS_XQ, (const int*)(ws + WS_IDS), (const float*)(ws + WS_GW), pp->in[17], l == DEPTH - 1 ? 1 : 0, lds, wave, (int)blockIdx.x * 8 + wave, lane, 4, 0xffff, ws + WS_A8, (float*)(ws + WS_SA), Q_I8 ? (const float*)(ws + WS_SX) : nullptr); __syncthreads(); }
            if (PEER_I8) gather5_phase(pp->out, (bf16_t*)(ws + WS_HB), (const float*)(ws + WS_SSQ2P), (float*)(ws + WS_SSQ1), ws + WS_U8, ws + WS_V8, (const float*)(ws + WS_SU), (const float*)(ws + WS_SV),
                         ws + WS_XQ, (const int*)(ws + WS_IDS), (const float*)(ws + WS_GW), pp->in[17], l == DEPTH - 1 ? 1 : 0, lds, wave, (int)blockIdx.x * 8 + wave, lane, 0, 0xffff, ws + WS_A8, (float*)(ws + WS_SA), Q_I8 ? (const float*)(ws + WS_SX) : nullptr);
            else if (PEER_FP8) gather4_phase(pp->out, (bf16_t*)(ws + WS_HB), (const float*)(ws + WS_SSQ2P), (float*)(ws + WS_SSQ1), ws + WS_U8, ws + WS_V8, (const float*)(ws + WS_SU), (const float*)(ws + WS_SV),
                         (const int*)(ws + WS_IDS), (const float*)(ws + WS_GW), pp->in[17], l == DEPTH - 1 ? 1 : 0, lds, wave, (int)blockIdx.x * 8 + wave, lane);
            else gather3_phase(pp->out, (bf16_t*)(ws + WS_HB), (const float*)(ws + WS_SSQ2P), (float*)(ws + WS_SSQ1), (const bf16_t*)(ws + WS_U16), (const unsigned short*)(ws + WS_V16),
                         (const int*)(ws + WS_IDS), (const float*)(ws + WS_GW), pp->in[17], l == DEPTH - 1 ? 1 : 0, lds, wave, (int)blockIdx.x * 8 + wave, lane);
        }
}

__global__ void __launch_bounds__(512, 2) mega(Params p) {
    extern __shared__ __attribute__((aligned(16))) unsigned char lds_raw[];
    LAS unsigned char* lds = (LAS unsigned char*)lds_raw;
    const int ph_lo = p.ph_lo, ph_hi = p.ph_hi;
    const int wave = __builtin_amdgcn_readfirstlane(threadIdx.x >> 6);
    if (ph_lo < -1000) cg::this_grid().sync();
    {
        const int tid0 = threadIdx.x;
        for (int u = tid0; u < (LDS_BYTES - 131072) / 4; u += 512) ((LAS unsigned*)(lds + 131072))[u] = 0u;
        __syncthreads();
        if (ph_hi - ph_lo > 1) { KP pq = (KP)__builtin_amdgcn_kernarg_segment_ptr(); (void)xcd_barrier_post((unsigned*)(pq->ws + WS_CTL) + CW_BAR, (volatile LAS unsigned*)(lds + MISC_OFF) + 8, tid0); }
    }

    if (PH_ON(0, 1)) { KARGS();
        const int tid = threadIdx.x, lane = tid & 63;
        unsigned char* ws = pp->ws;
        const int G = gridDim.x, gwave = blockIdx.x * 8 + wave, ngw = G * 8;
        LAS float* scr = (LAS float*)(lds + wave * 8448);
        for (int rep = 0; rep < (PROBE_DUP == 8 ? 2 : 1); ++rep) {
        if (wave < 4) weight_prep(pp, 0, scr, gwave, ngw, lane);
        {
            const int* pos = (const int*)pp->in[1];
            float* rope = (float*)(ws + WS_ROPE);
            const float inv_freq = (float)exp2(-(double)(tid & 31) * (13.287712379549449 / 32.0));
            for (int e = blockIdx.x * 512 + tid; e < T * 32; e += G * 512) {
                const int t = e >> 5;
                const float ang = (float)pos[t] * inv_freq;
                double rv = (double)ang * 0.15915494309189535; rv -= floor(rv);
                const float rf = (float)rv;
                rope[2 * e] = __builtin_amdgcn_cosf(rf); rope[2 * e + 1] = __builtin_amdgcn_sinf(rf);
            }
        }
        {
            bf16_t* HB = (bf16_t*)(ws + WS_HB); float* ssq1 = (float*)(ws + WS_SSQ1);
            f32x4 vn[4];
            { const f32x4* xr0 = (const f32x4*)(pp->in[0] + (size_t)gwave * DM) + lane;
#pragma unroll
              for (int j = 0; j < 4; ++j) vn[j] = xr0[64 * j]; }
            for (int t = gwave; t < T; t += ngw) {
                f32x4 v[4]; float ss = 0.f;
#pragma unroll
                for (int j = 0; j < 4; ++j) v[j] = vn[j];
                if (t + ngw < T) { const f32x4* xr1 = (const f32x4*)(pp->in[0] + (size_t)(t + ngw) * DM) + lane;
#pragma unroll
                    for (int j = 0; j < 4; ++j) vn[j] = xr1[64 * j]; }
#pragma unroll
                for (int j = 0; j < 4; ++j) ss += (v[j][0] * v[j][0] + v[j][1] * v[j][1]) + (v[j][2] * v[j][2] + v[j][3] * v[j][3]);
                ss = wave_sum(ss);
                u32x2* br = (u32x2*)(HB + (size_t)t * DM) + lane;
#pragma unroll
                for (int j = 0; j < 4; ++j) { u32x2 w; w.x = cvtpk(v[j][0], v[j][1]); w.y = cvtpk(v[j][2], v[j][3]); br[64 * j] = w; }
                if (lane == 0) ssq1[t] = ss;
                if (IN_I8) {
                    float am = 0.f;
#pragma unroll
                    for (int j = 0; j < 4; ++j) am = fmaxf(am, fmaxf(fmaxf(fabsf(v[j][0]), fabsf(v[j][1])), fmaxf(fabsf(v[j][2]), fabsf(v[j][3]))));
#pragma unroll
                    for (int o = 1; o < 64; o <<= 1) am = fmaxf(am, __shfl_xor(am, o));
                    const float inv = am > 0.f ? 127.0f / am : 0.f;
                    unsigned* ar = (unsigned*)(ws + WS_A8 + (size_t)t * DM) + lane;
#pragma unroll
                    for (int j = 0; j < 4; ++j) {
                        int q0 = (int)rintf(v[j][0] * inv), q1 = (int)rintf(v[j][1] * inv), q2 = (int)rintf(v[j][2] * inv), q3 = (int)rintf(v[j][3] * inv);
                        ar[64 * j] = (unsigned)(q0 & 255) | ((unsigned)(q1 & 255) << 8) | ((unsigned)(q2 & 255) << 16) | ((unsigned)(q3 & 255) << 24);
                    }
                    if (lane == 0) ((float*)(ws + WS_SA))[t] = am > 0.f ? am / 127.0f : 0.f;
                }
            }
        }
        if (wave >= 4) weight_prep(pp, 0, scr, gwave, ngw, lane);
        }
    }

    layer_phases<0>(ph_lo, ph_hi, lds, wave);
    layer_phases<1>(ph_lo, ph_hi, lds, wave);
    static_assert(DEPTH == 2, "two layers");
}

#ifndef MK_PER_PHASE
#define MK_PER_PHASE 0
#endif
extern "C" void kernel_launch(void* const* d_in, const int* in_sizes, int n_in, void* d_out, int out_size, void* d_ws, size_t ws_size, hipStream_t stream) {
    static int grid = 0;
    if (grid == 0) {
        if (n_in != 18 || in_sizes[0] != T * DM || out_size != T * DM || ws_size < WS_END) {
            fprintf(stderr, "kernel_launch: unexpected shapes (n_in %d, in0 %d, out %d, ws %zu); nothing launched\n", n_in, n_in > 0 ? in_sizes[0] : -1, out_size, ws_size); grid = -1; return; }
        int dev = 0, cus = 0, per_cu = 0;
        (void)hipGetDevice(&dev);
        (void)hipDeviceGetAttribute(&cus, hipDeviceAttributeMultiprocessorCount, dev);
        (void)hipFuncSetAttribute((const void*)mega, hipFuncAttributeMaxDynamicSharedMemorySize, LDS_BYTES);
        (void)hipOccupancyMaxActiveBlocksPerMultiprocessor(&per_cu, (const void*)mega, 512, LDS_BYTES);
        if (per_cu < 1) { fprintf(stderr, "kernel_launch: occupancy query says %d blocks per CU\n", per_cu); per_cu = 1; }
        (void)hipGetLastError();
        if (cus < 256) { fprintf(stderr, "kernel_launch: built for a 256-CU device (found %d); nothing launched\n", cus); grid = -1; return; }
        grid = 256;
    }
    if (grid < 0) return;
    (void)hipMemsetAsync((char*)d_ws + WS_CTL, 0, CTL_ZERO_BYTES, stream);
    Params p{};
    for (int i = 0; i < 18; ++i) p.in[i] = (const float*)d_in[i];
    p.out = (float*)d_out; p.ws = (unsigned char*)d_ws;
#if MK_PER_PHASE
    for (int ph = 0; ph < NPH; ++ph) {
        p.ph_lo = ph; p.ph_hi = ph + 1;
        void* args[] = {&p};
        hipError_t e = hipLaunchCooperativeKernel((const void*)mega, dim3(grid), dim3(512), args, LDS_BYTES, stream);
        if (e != hipSuccess) { fprintf(stderr, "cooperative launch %d failed: %s\n", ph, hipGetErrorString(e)); break; }
    }
#else
    p.ph_lo = 0; p.ph_hi = NPH;
    void* args[] = {&p};
    hipError_t e = hipLaunchCooperativeKernel((const void*)mega, dim3(grid), dim3(512), args, LDS_BYTES, stream);
    if (e != hipSuccess) fprintf(stderr, "cooperative launch failed: %s (grid %d)\n", hipGetErrorString(e), grid);
#endif
}
```

```cpp
#define MIXA_3PASS 4
#include <hip/hip_runtime.h>
#include <hip/hip_cooperative_groups.h>
#include <cstdio>
#include <cstdint>
#include <cmath>
namespace cg = cooperative_groups;
namespace pg8 {
#define PG8_LAS __attribute__((address_space(3)))
typedef unsigned short bf16_t;
typedef short bf16x8 __attribute__((ext_vector_type(8)));
typedef float f32x4 __attribute__((ext_vector_type(4)));
typedef unsigned u32x4 __attribute__((ext_vector_type(4)));
typedef int i32x4 __attribute__((ext_vector_type(4)));
typedef long i64x2 __attribute__((ext_vector_type(2)));
#ifndef PG8_I8_SPLIT
#define PG8_I8_SPLIT 0
#endif
#ifndef PG8_I8_ASM
#define PG8_I8_ASM 0
#endif
constexpr int BM = 256, BK = 64, HALF = 128, HTB = HALF * BK * 2  , STAGE_BYTES = 8 * HTB, NXCD = 8, WGM = 8;

__host__ __device__ __forceinline__ int lds_byte(int r, int c) { const int st = (r >> 4) * 2 + (c >> 5), rr = r & 15, cc = c & 31, ob = rr * 64 + cc * 2; return st * 1024 + (ob ^ (((ob >> 9) & 1) << 5)); }
__host__ __device__ __forceinline__ void stage_rc(int b, int& R, int& C) { const int st = b / 1024, sb = b % 1024, swz = sb ^ (((sb >> 9) & 1) << 5); R = (st >> 1) * 16 + swz / 64; C = (st & 1) * 32 + (swz % 64) / 2; }
__host__ __device__ __forceinline__ int perm32(int rho) { const int n = rho >> 4, i = rho & 15; return 8 * (i >> 2) + 4 * n + (i & 3); }

struct Unit { int pm, pn, br; };
struct Gemm { const bf16_t* A; const bf16_t* Bt; int M, N, K, lda; };

struct StaticOrder {
    int nM, nN, nwg, G, c;
    __host__ __device__ void init(int M, int N, int G_, int c_) { nM = M / BM; nN = N / BM; nwg = nM * nN; G = G_; c = c_; }
    __host__ __device__ bool next(int i, Unit& u) const {
        const long L = (long)i * G + c; if (L >= nwg) return false;
        int wgid = (int)L; { const int q = nwg / NXCD, r = nwg % NXCD, xcd = wgid % NXCD, off = wgid / NXCD; wgid = (xcd < r ? xcd * (q + 1) : r * (q + 1) + (xcd - r) * q) + off; }
        const int nig = WGM * nN, gid = wgid / nig, fm = gid * WGM, gsz = (nM - fm) < WGM ? (nM - fm) : WGM;
        u.pm = fm + ((wgid % nig) % gsz); u.pn = (wgid % nig) / gsz; u.br = 0; return true;
    }
    __device__ __forceinline__ size_t a_off(const Unit&) const { return 0; }
    __device__ __forceinline__ size_t b_off(const Unit&) const { return 0; }
    __device__ __forceinline__ void a_ready(const Unit&) const {}
    __device__ __forceinline__ void done(const Unit&) const {}
};

__device__ __forceinline__ unsigned cvt_pk_bf16(float lo, float hi) { unsigned r; asm volatile("v_cvt_pk_bf16_f32 %0, %1, %2" : "=v"(r) : "v"(lo), "v"(hi)); return r; }
typedef float f32x2 __attribute__((ext_vector_type(2)));
__device__ __forceinline__ f32x2 gelu_pk(f32x2 v) {
    const f32x2 av = __builtin_elementwise_abs(v), d = av * 0.2316418882f + 1.0f;
    f32x2 t; t.x = __builtin_amdgcn_rcpf(d.x); t.y = __builtin_amdgcn_rcpf(d.y);
    f32x2 q = t * 0.5307027145f + (-0.7265760135f); q = q * t + 0.7107068705f; q = q * t + (-0.142248368f); q = q * t + 0.127414796f; q = q * t;
    const f32x2 s = (v * v) * (-0.72134752044f);
    f32x2 e; e.x = __builtin_amdgcn_exp2f(s.x); e.y = __builtin_amdgcn_exp2f(s.y);
    const f32x2 m = v * (q * e), r = v - m;
    f32x2 o; o.x = v.x < 0.f ? m.x : r.x; o.y = v.y < 0.f ? m.y : r.y; return o;
}

template <int ACT  > struct EpiBf16 {
    static constexpr bool PERM = true, AFTER_DRAIN = false; static_assert(ACT == 0 || ACT == 1, "EpiBf16: ACT is 0 (none) or 1 (gelu_pk)");
    bf16_t* O; int ldc; const float* bias; int split_cols; size_t split_stride; float scale0;
    __device__ __forceinline__ void operator()(const f32x4 (&acc)[2][2][4][2], const Unit& u, int wr, int wc, int fr, int fq) const {
        const int row0 = u.pm * BM + wr * 64 + fr; int colt = u.pn * BM; bf16_t* base = O;
        float sc = 1.f; if (split_cols) { const int t = colt / split_cols; base += (size_t)t * split_stride; colt -= t * split_cols; if (t == 0) sc = scale0; }
        const int col0 = colt + wc * 32 + 8 * fq, bcol0 = u.pn * BM + wc * 32 + 8 * fq;
        f32x4 bv[2][2];
#pragma unroll
        for (int bj = 0; bj < 2; ++bj)
#pragma unroll
            for (int n = 0; n < 2; ++n) bv[bj][n] = bias ? *(const f32x4*)(bias + bcol0 + bj * HALF + 4 * n) : (f32x4){0.f, 0.f, 0.f, 0.f};
#pragma unroll
        for (int ai = 0; ai < 2; ++ai)
#pragma unroll
            for (int m = 0; m < 4; ++m) { bf16_t* rowp = base + (size_t)(row0 + ai * HALF + m * 16) * ldc + col0;
#pragma unroll
                for (int bj = 0; bj < 2; ++bj) { f32x4 v0 = acc[ai][bj][m][0] + bv[bj][0], v1 = acc[ai][bj][m][1] + bv[bj][1];
                    if (ACT == 1) { f32x2 a = gelu_pk((f32x2){v0[0], v0[1]}), b = gelu_pk((f32x2){v0[2], v0[3]}), c = gelu_pk((f32x2){v1[0], v1[1]}), d = gelu_pk((f32x2){v1[2], v1[3]});
                        v0 = (f32x4){a.x, a.y, b.x, b.y}; v1 = (f32x4){c.x, c.y, d.x, d.y}; }
                    v0 = v0 * sc; v1 = v1 * sc; u32x4 w; w.x = cvt_pk_bf16(v0[0], v0[1]); w.y = cvt_pk_bf16(v0[2], v0[3]); w.z = cvt_pk_bf16(v1[0], v1[1]); w.w = cvt_pk_bf16(v1[2], v1[3]);
                    *(u32x4*)(rowp + bj * HALF) = w; } }
    }
};
template <class Epi, class Sched, bool ALIGN_EPI = false, bool SP2 = false, bool I8 = false>
__device__ __forceinline__ void gemm_phase(PG8_LAS unsigned char* lds, const Gemm g, const Sched& S, const Epi& E, const int tid) {
    const int wid = __builtin_amdgcn_readfirstlane(tid >> 6), lane = tid & 63, wr = wid >> 2, wc = wid & 3, fr = lane & 15, fq = lane >> 4;
    const int K = g.K, nt = K / BK;
    unsigned voffA[2], voffB[2];
#pragma unroll
    for (int i = 0; i < 2; ++i) { int R, C; stage_rc(tid * 16 + i * 8192, R, C); const int Rb = Epi::PERM ? ((R & ~31) + perm32(R & 31)) : R;
        voffA[i] = (unsigned)(R * g.lda + C) * 2u; voffB[i] = (unsigned)(Rb * K + C) * 2u; }
    const size_t kstep = (size_t)(BK * 2);
    const size_t hstep = (size_t)HALF * K * 2;
    const size_t tstep = 2 * hstep; const size_t hstepA = (size_t)HALF * g.lda * 2, tstepA = 2 * hstepA;
    const unsigned ldsw = (unsigned)wid * 1024u;
    const int aoff = lds_byte(wr * 64 + fr, fq * 8), boff = lds_byte(wc * 32 + fr, fq * 8);
#define PG8_SA(b, h) (((b) * 2 + (h)) * HTB)
#define PG8_SB(b, h) ((4 + (b) * 2 + (h)) * HTB)
#define PG8_STAGE(bufoff, gbase, voff) do { _Pragma("unroll") for (int _i = 0; _i < 2; ++_i) \
        __builtin_amdgcn_global_load_lds((const unsigned*)((const char*)(gbase) + (voff)[_i]), (PG8_LAS unsigned*)(lds + (bufoff) + ldsw + _i * 8192), 16, 0, 0); } while (0)
#define PG8_LDA(dst, b, h) do { _Pragma("unroll") for (int m = 0; m < 4; ++m) _Pragma("unroll") for (int k = 0; k < 2; ++k) dst[m][k] = *(const PG8_LAS bf16x8*)(lds + PG8_SA(b, h) + aoff + m * 2048 + k * 1024); } while (0)
#define PG8_LDB(dst, b, h) do { _Pragma("unroll") for (int n = 0; n < 2; ++n) _Pragma("unroll") for (int k = 0; k < 2; ++k) dst[n][k] = *(const PG8_LAS bf16x8*)(lds + PG8_SB(b, h) + boff + n * 2048 + k * 1024); } while (0)
#define PG8_MMA(ai, bj, At, Bt) do { __builtin_amdgcn_s_setprio(1); \
        if constexpr (I8) {   \
            _Pragma("unroll") for (int k = 0; k < 2; ++k) _Pragma("unroll") for (int m = 0; m < 4; ++m) _Pragma("unroll") for (int n = 0; n < 2; ++n) \
                { if (PG8_I8_ASM) asm volatile("v_mfma_i32_16x16x64_i8 %0, %1, %2, %0" : "+v"(acc[ai][bj][m][n]) : "v"(Bt[n][k]), "v"(At[m][k])); \
                  else acc[ai][bj][m][n] = __builtin_bit_cast(f32x4, __builtin_amdgcn_mfma_i32_16x16x64_i8(__builtin_bit_cast(i32x4, Bt[n][k]), __builtin_bit_cast(i32x4, At[m][k]), __builtin_bit_cast(i32x4, acc[ai][bj][m][n]), 0, 0, 0)); } \
        } else { \
            _Pragma("unroll") for (int m = 0; m < 4; ++m) _Pragma("unroll") for (int n = 0; n < 2; ++n) _Pragma("unroll") for (int k = 0; k < 2; ++k) \
                acc[ai][bj][m][n] = __builtin_amdgcn_mfma_f32_16x16x32_bf16(Bt[n][k], At[m][k], acc[ai][bj][m][n], 0, 0, 0); \
        } __builtin_amdgcn_s_setprio(0); } while (0)
#define PG8_WAIT_V(n) asm volatile("s_waitcnt vmcnt(" #n ")" ::: "memory")
#define PG8_WAIT_L(n) asm volatile("s_waitcnt lgkmcnt(" #n ")" ::: "memory")
#define PG8_BAR __builtin_amdgcn_s_barrier()
#define PG8_SCHED __builtin_amdgcn_sched_barrier(0)
    Unit cur, nxt; int ui = 0;
    if (!S.next(0, cur)) return;
    f32x4 acc[2][2][4][2];
#pragma unroll
    for (int a = 0; a < 2; ++a)
#pragma unroll
        for (int b = 0; b < 2; ++b)
#pragma unroll
            for (int m = 0; m < 4; ++m)
#pragma unroll
                for (int n = 0; n < 2; ++n) acc[a][b][m][n] = (f32x4){0.f, 0.f, 0.f, 0.f};
    bf16x8 At[4][2], B0[2][2], B1[2][2];
    const char* cA = (const char*)g.A + S.a_off(cur) + (size_t)cur.pm * tstepA; const char* cB = (const char*)g.Bt + S.b_off(cur) + (size_t)cur.pn * tstep;
    S.a_ready(cur);
    if constexpr (SP2) {
        PG8_STAGE(PG8_SB(0, 0), cB, voffB); PG8_STAGE(PG8_SB(0, 1), cB + hstep, voffB); PG8_STAGE(PG8_SA(0, 0), cA, voffA); PG8_STAGE(PG8_SA(0, 1), cA + hstepA, voffA);
        if (wr == 1) PG8_BAR;
        PG8_WAIT_V(2); PG8_BAR;
        PG8_STAGE(PG8_SB(1, 0), cB + kstep, voffB); PG8_STAGE(PG8_SA(1, 0), cA + kstep, voffA); PG8_STAGE(PG8_SB(1, 1), cB + hstep + kstep, voffB);
        PG8_WAIT_V(6); PG8_BAR;
    } else {
        PG8_STAGE(PG8_SB(0, 0), cB, voffB); PG8_STAGE(PG8_SA(0, 0), cA, voffA); PG8_STAGE(PG8_SB(0, 1), cB + hstep, voffB); PG8_STAGE(PG8_SA(0, 1), cA + hstepA, voffA);
        if (wr == 1) PG8_BAR;
        PG8_WAIT_V(4); PG8_BAR;
        PG8_STAGE(PG8_SB(1, 0), cB + kstep, voffB); PG8_STAGE(PG8_SA(1, 0), cA + kstep, voffA); PG8_STAGE(PG8_SB(1, 1), cB + hstep + kstep, voffB);
        PG8_WAIT_V(6); PG8_BAR;
    }
    for (;;) {
        const bool has_next = S.next(ui + 1, nxt);
        const char* nA = has_next ? (const char*)g.A + S.a_off(nxt) + (size_t)nxt.pm * tstepA : cA; const char* nB = has_next ? (const char*)g.Bt + S.b_off(nxt) + (size_t)nxt.pn * tstep : cB;
        for (int t = 0; t < nt; t += 2) {
            const bool last = (t == nt - 2);
            const char* a1 = cA + (size_t)(t + 1) * kstep;
            const char* a2 = last ? nA : cA + (size_t)(t + 2) * kstep; const char* b2 = last ? nB : cB + (size_t)(t + 2) * kstep;
            const char* a3 = a2 + kstep; const char* b3 = b2 + kstep;
            if (last && has_next) S.a_ready(nxt);
            if constexpr (SP2) {
            PG8_LDB(B0, 0, 0); PG8_LDB(B1, 0, 1); PG8_SCHED; PG8_LDA(At, 0, 0); PG8_STAGE(PG8_SA(1, 1), a1 + hstepA, voffA);
            PG8_WAIT_V(8); PG8_WAIT_L(0); PG8_BAR; PG8_MMA(0, 0, At, B0); PG8_MMA(0, 1, At, B1); PG8_BAR; PG8_SCHED;
            PG8_LDA(At, 0, 1); PG8_STAGE(PG8_SB(0, 0), b2, voffB); PG8_STAGE(PG8_SB(0, 1), b2 + hstep, voffB); PG8_STAGE(PG8_SA(0, 0), a2, voffA);
            PG8_WAIT_V(8); PG8_WAIT_L(0); PG8_BAR; PG8_MMA(1, 0, At, B0); PG8_MMA(1, 1, At, B1); PG8_BAR; PG8_SCHED;
            PG8_LDB(B0, 1, 0); PG8_LDB(B1, 1, 1); PG8_SCHED; PG8_LDA(At, 1, 0); PG8_STAGE(PG8_SA(0, 1), a2 + hstepA, voffA);
            PG8_WAIT_V(8); PG8_WAIT_L(0); PG8_BAR; PG8_MMA(0, 0, At, B0); PG8_MMA(0, 1, At, B1); PG8_BAR; PG8_SCHED;
            PG8_LDA(At, 1, 1); PG8_STAGE(PG8_SB(1, 0), b3, voffB); PG8_STAGE(PG8_SB(1, 1), b3 + hstep, voffB); PG8_STAGE(PG8_SA(1, 0), a3, voffA);
            PG8_WAIT_V(8); PG8_WAIT_L(0); PG8_BAR; PG8_MMA(1, 0, At, B0); PG8_MMA(1, 1, At, B1); PG8_BAR; PG8_SCHED;
            } else {
            PG8_LDB(B0, 0, 0); PG8_SCHED; PG8_LDA(At, 0, 0); PG8_STAGE(PG8_SA(1, 1), a1 + hstepA, voffA);
            PG8_WAIT_L(8); PG8_BAR; PG8_WAIT_L(0); PG8_MMA(0, 0, At, B0); PG8_BAR; PG8_SCHED;
            PG8_LDB(B1, 0, 1); PG8_STAGE(PG8_SB(0, 0), b2, voffB);
            PG8_BAR; PG8_WAIT_L(0); PG8_MMA(0, 1, At, B1); PG8_BAR;
            PG8_LDA(At, 0, 1); PG8_STAGE(PG8_SA(0, 0), a2, voffA);
            PG8_BAR; PG8_WAIT_L(0); PG8_MMA(1, 0, At, B0); PG8_BAR; PG8_SCHED;
            PG8_STAGE(PG8_SB(0, 1), b2 + hstep, voffB);
            PG8_WAIT_V(6); PG8_BAR; PG8_MMA(1, 1, At, B1); PG8_BAR;
            PG8_LDB(B0, 1, 0); PG8_SCHED; PG8_LDA(At, 1, 0); PG8_STAGE(PG8_SA(0, 1), a2 + hstepA, voffA);
            PG8_WAIT_L(8); PG8_BAR; PG8_WAIT_L(0); PG8_MMA(0, 0, At, B0); PG8_BAR; PG8_SCHED;
            PG8_LDB(B1, 1, 1); PG8_STAGE(PG8_SB(1, 0), b3, voffB);
            PG8_BAR; PG8_WAIT_L(0); PG8_MMA(0, 1, At, B1); PG8_BAR;
            PG8_LDA(At, 1, 1); PG8_STAGE(PG8_SA(1, 0), a3, voffA);
            PG8_BAR; PG8_WAIT_L(0); PG8_MMA(1, 0, At, B0); PG8_BAR; PG8_SCHED;
            PG8_STAGE(PG8_SB(1, 1), b3 + hstep, voffB);
            PG8_WAIT_V(6); PG8_BAR; PG8_MMA(1, 1, At, B1); PG8_BAR;
            }
        }
        if constexpr (I8) { if (PG8_I8_ASM) asm volatile("s_nop 15\n\ts_nop 15" ::: "memory"); }
        if constexpr (ALIGN_EPI) { if (wr == 0) PG8_BAR; }
        if constexpr (!Epi::AFTER_DRAIN) { E(acc, cur, wr, wc, fr, fq); S.done(cur); }
        if (!has_next) break;
        if (!E.keep(cur)) {
#pragma unroll
        for (int a = 0; a < 2; ++a)
#pragma unroll
            for (int b = 0; b < 2; ++b)
#pragma unroll
                for (int m = 0; m < 4; ++m)
#pragma unroll
                    for (int n = 0; n < 2; ++n) acc[a][b][m][n] = (f32x4){0.f, 0.f, 0.f, 0.f};
        }
        cur = nxt; cA = nA; cB = nB; ++ui;
        if constexpr (ALIGN_EPI) { if (wr == 1) PG8_BAR; }
    }
    PG8_WAIT_V(0);
    if constexpr (!ALIGN_EPI) { if (wr == 0) PG8_BAR; }
    PG8_BAR;
    if constexpr (Epi::AFTER_DRAIN) { E.fused(acc, cur, wr, wc, fr, fq, lds, wid, lane); S.done(cur); }
#undef PG8_SA
#undef PG8_SB
#undef PG8_STAGE
#undef PG8_LDA
#undef PG8_LDB
#undef PG8_MMA
#undef PG8_WAIT_V
#undef PG8_WAIT_L
#undef PG8_BAR
#undef PG8_SCHED
}
}

constexpr int BATCH = 4, SEQ = 8192, T = BATCH * SEQ, DM = 1024, DEPTH = 2;
constexpr int IN_COLS = 6022, NP = 3072, N_IN = 6144;
constexpr int N_EXP = 16384;
constexpr int PC_QA = 0, PC_QB = 384, PC_QC = 768, PC_KA = 1152, PC_VA = 1536, PC_KB = 1920, PC_VB = 2304, PC_KC = 2688, PC_VC = 2816, PC_FB = 2944;
constexpr int PC_MERGED = 1152;
constexpr float RMS_EPS = 1e-6f;
constexpr float LOG2E = 1.4426950408889634f;
constexpr float QK_SCALE2 = 0.125f * LOG2E;

constexpr size_t MiB = 1u << 20;
constexpr size_t WS_CTL = 0, CTL_ZERO_BYTES = 65536;
constexpr size_t WS_SSQ1 = 1 * MiB;
constexpr size_t WS_CUMT = 1 * MiB + 256 * 1024;
constexpr size_t WS_LOGF = 2 * MiB;
constexpr size_t WS_KMAX_BASE = 32768;
constexpr size_t WS_ROPE = 3 * MiB;
constexpr size_t WS_W = 12 * MiB, WL_STRIDE = 21 * MiB;
constexpr size_t WL_IN = 0, WL_BR = 12 * MiB, WL_OUT = WL_BR + 2304 * 1024, WL_Q = WL_OUT + 2 * MiB, WL_K12 = WL_Q + 4 * MiB;
static_assert(WL_K12 + 65536 <= WL_STRIDE, "weights");
constexpr size_t WS_HB = 56 * MiB;
constexpr size_t WS_P = 120 * MiB;
constexpr size_t WS_G = 312 * MiB;
constexpr size_t WS_SSQ2P = 504 * MiB;
constexpr size_t WS_END = 506 * MiB;
constexpr size_t WS_Q2 = WS_P;
constexpr size_t WS_IDS = WS_P + 128 * MiB;
constexpr size_t WS_GW = WS_P + 144 * MiB;
constexpr size_t WS_AO = WS_G + 96 * MiB;
constexpr size_t WS_ALSE = WS_G + 96 * MiB + 80 * MiB;
constexpr size_t WS_A8 = WS_G + 128 * MiB;
constexpr size_t WS_SA = WS_G + 160 * MiB;
constexpr size_t WS_SX = WS_G + 161 * MiB;
constexpr size_t WL_QSC = 3 * MiB;
constexpr size_t WL_INSC = 8 * MiB;
constexpr size_t WS_XQ = WS_P + 160 * MiB;
constexpr size_t WS_U16 = WS_G, WS_V16 = WS_G + 32 * MiB;
constexpr size_t WS_U8 = WS_G + 64 * MiB, WS_V8 = WS_G + 80 * MiB, WS_SU = WS_G + 96 * MiB, WS_SV = WS_G + 96 * MiB + 65536;
constexpr int CW_GRP = 10240;
constexpr int CW_ATT = 64;

constexpr int LDS_BYTES = 147456;
constexpr int NPH = 1 + 8 * DEPTH;
#ifndef PH_MASK
#define PH_MASK 511
#endif

#define LAS __attribute__((address_space(3)))
typedef unsigned short bf16_t;
typedef short bf16x8 __attribute__((ext_vector_type(8)));
typedef float f32x4 __attribute__((ext_vector_type(4)));
typedef float f32x16 __attribute__((ext_vector_type(16)));
typedef unsigned u32x4 __attribute__((ext_vector_type(4)));
typedef unsigned u32x2 __attribute__((ext_vector_type(2)));
typedef short v4i16_t __attribute__((ext_vector_type(4)));
typedef float f32x2_t __attribute__((ext_vector_type(2)));
typedef __bf16 bf16x2_t __attribute__((ext_vector_type(2)));

__device__ __forceinline__ unsigned cvtpk(float lo, float hi) { f32x2_t v = {lo, hi}; bf16x2_t b = __builtin_convertvector(v, bf16x2_t); return __builtin_bit_cast(unsigned, b); }
__device__ __forceinline__ float bflo(unsigned u) { return __uint_as_float(u << 16); }
__device__ __forceinline__ float bfhi(unsigned u) { return __uint_as_float(u & 0xffff0000u); }
__device__ __forceinline__ float wave_sum(float v) {
#pragma unroll
    for (int o = 1; o < 64; o <<= 1) v += __shfl_xor(v, o);
    return v;
}
__device__ __forceinline__ float dot2bf(unsigned a, unsigned b, float acc) {
    return fmaf(bfhi(a), bfhi(b), fmaf(bflo(a), bflo(b), acc));
}

__host__ __device__ __forceinline__ int src_col_in(int n) {
    if (n >= 3072) return 2950 + (n - 3072);
    if (n >= 2950) return -1;
    if (n >= 2944) return 2304 + (n - 2944);
    int seg, src; bool rope;
    if (n < 384)       { seg = 0;    src = 0;    rope = true;  }
    else if (n < 768)  { seg = 384;  src = 1152; rope = false; }
    else if (n < 1152) { seg = 768;  src = 2310; rope = true;  }
    else if (n < 1536) { seg = 1152; src = 384;  rope = true;  }
    else if (n < 1920) { seg = 1536; src = 768;  rope = false; }
    else if (n < 2304) { seg = 1920; src = 1536; rope = false; }
    else if (n < 2688) { seg = 2304; src = 1920; rope = false; }
    else if (n < 2816) { seg = 2688; src = 2694; rope = true;  }
    else               { seg = 2816; src = 2822; rope = false; }
    int off = n - seg;
    if (rope) { const int blk = off >> 6, w = off & 63; off = blk * 64 + (w >> 1) + 32 * (w & 1); }
    return src + off;
}

__device__ __forceinline__ float ssq16(const float* __restrict__ pz, int row) {
    const f32x4* q = (const f32x4*)(pz + (size_t)row * 16);
    const f32x4 a = q[0], b = q[1], c = q[2], d = q[3];
    return (((a[0] + a[1]) + (a[2] + a[3])) + ((b[0] + b[1]) + (b[2] + b[3]))) + (((c[0] + c[1]) + (c[2] + c[3])) + ((d[0] + d[1]) + (d[2] + d[3])));
}

template <int MODE>
__device__ __forceinline__ void transpose_item(const float* __restrict__ W, int K, int Nsrc, bf16_t* __restrict__ WT, const float* __restrict__ kscale,
                                               LAS float* scr, int item, int nblk, int lane) {
    const int kb = item / nblk, nb = item % nblk, k0 = 64 * kb, n0 = 32 * nb;
    const int nn = n0 + (lane & 31);
    const int c = (MODE == 1) ? src_col_in(nn) : nn;
#pragma unroll 8
    for (int i = 0; i < 32; ++i) {
        const int kk = 2 * i + (lane >> 5);
        float v = 0.f;
        if (c >= 0) v = W[(size_t)(k0 + kk) * Nsrc + c];
        if (kscale) v *= kscale[k0 + kk];
        if (MODE == 1 && nn >= 3072) v *= -LOG2E;
        scr[kk * 33 + (lane & 31)] = v;
    }
    asm volatile("s_waitcnt lgkmcnt(0)" ::: "memory");
    const int c8 = lane & 7;
#pragma unroll
    for (int j = 0; j < 4; ++j) {
        const int n = (lane >> 3) + 8 * j; const LAS float* s = scr + (8 * c8) * 33 + n;
        u32x4 o; o.x = cvtpk(s[0 * 33], s[1 * 33]); o.y = cvtpk(s[2 * 33], s[3 * 33]); o.z = cvtpk(s[4 * 33], s[5 * 33]); o.w = cvtpk(s[6 * 33], s[7 * 33]);
        *(u32x4*)(WT + (size_t)(n0 + n) * K + k0 + 8 * c8) = o;
    }
    asm volatile("s_waitcnt lgkmcnt(0)" ::: "memory");
}

#ifndef G5_SLICE_SYNC
#define G5_SLICE_SYNC 0
#endif
#ifndef TAIL_FENCE_LIGHT
#define TAIL_FENCE_LIGHT 1
#endif
#ifndef IN_I8_LAYERS
#define IN_I8_LAYERS 3
#endif
#ifndef IN_I8
#define IN_I8 1
#endif
template <int MODE = 1, int NSRC = IN_COLS>
__device__ __forceinline__ void quant_win_item(const float* __restrict__ W, const float* __restrict__ kscale, unsigned char* __restrict__ WT8, float* __restrict__ colscale, int item, int lane, bf16_t* deq = nullptr) {
    const int c = lane & 7, rs = lane >> 3, n = 8 * item + c, src = MODE == 1 ? src_col_in(n) : n, k0 = 128 * rs;
    const float post = (MODE == 1 && n >= 3072) ? -LOG2E : 1.0f;
    const float* wp = W + (size_t)k0 * NSRC + (src >= 0 ? src : 0);
    const float* kp = kscale + k0;
    float am = 0.f;
    for (int j = 0; j < 4; ++j) {
        float x[32];
#pragma unroll
        for (int i = 0; i < 32; ++i) x[i] = wp[(size_t)(32 * j + i) * NSRC];
#pragma unroll
        for (int i = 0; i < 32; ++i) am = fmaxf(am, fabsf(x[i] * kp[32 * j + i]));
    }
    if (src < 0) am = 0.f;
    am = fmaxf(am, __shfl_xor(am, 8)); am = fmaxf(am, __shfl_xor(am, 16)); am = fmaxf(am, __shfl_xor(am, 32));
    const float inv = am > 0.f ? 127.0f / am : 0.f;
    unsigned char* dst = WT8 + (size_t)n * DM + k0;
    for (int j = 0; j < 4; ++j) {
        float x[32];
#pragma unroll
        for (int i = 0; i < 32; ++i) x[i] = wp[(size_t)(32 * j + i) * NSRC];
        unsigned w[8];
#pragma unroll
        for (int q = 0; q < 8; ++q) {
            const int b = 4 * q;
            const int q0 = (int)rintf(x[b] * kp[32 * j + b] * inv), q1 = (int)rintf(x[b + 1] * kp[32 * j + b + 1] * inv), q2 = (int)rintf(x[b + 2] * kp[32 * j + b + 2] * inv), q3 = (int)rintf(x[b + 3] * kp[32 * j + b + 3] * inv);
            w[q] = (unsigned)(q0 & 255) | ((unsigned)(q1 & 255) << 8) | ((unsigned)(q2 & 255) << 16) | ((unsigned)(q3 & 255) << 24);
        }
        *(u32x4*)(dst + 32 * j) = (u32x4){w[0], w[1], w[2], w[3]}; *(u32x4*)(dst + 32 * j + 16) = (u32x4){w[4], w[5], w[6], w[7]};
    }
    if (rs == 0) colscale[n] = (am > 0.f ? am / 127.0f : 0.f) * post;
}
__device__ __forceinline__ void quant_arow_i8(const float (&f)[16], unsigned char* __restrict__ dst_row, float* __restrict__ scale_out, int lane) {
    float am = 0.f;
#pragma unroll
    for (int j = 0; j < 16; ++j) am = fmaxf(am, fabsf(f[j]));
#pragma unroll
    for (int o = 1; o < 64; o <<= 1) am = fmaxf(am, __shfl_xor(am, o));
    const float inv = am > 0.f ? 127.0f / am : 0.f;
    unsigned wq[4];
#pragma unroll
    for (int j = 0; j < 4; ++j) {
        const int q0 = (int)rintf(f[4 * j] * inv), q1 = (int)rintf(f[4 * j + 1] * inv), q2 = (int)rintf(f[4 * j + 2] * inv), q3 = (int)rintf(f[4 * j + 3] * inv);
        wq[j] = (unsigned)(q0 & 255) | ((unsigned)(q1 & 255) << 8) | ((unsigned)(q2 & 255) << 16) | ((unsigned)(q3 & 255) << 24);
    }
    *(u32x2*)(dst_row + 8 * lane) = (u32x2){wq[0], wq[1]}; *(u32x2*)(dst_row + 512 + 8 * lane) = (u32x2){wq[2], wq[3]};
    if (lane == 0) *scale_out = am > 0.f ? am / 127.0f : 0.f;
}

#ifndef EPI_NT
#define EPI_NT 1
#endif
template <bool I8> struct EpiInT {
    static constexpr bool PERM = true, AFTER_DRAIN = false;
    __device__ __forceinline__ bool keep(const pg8::Unit&) const { return false; }
    bf16_t* P; bf16_t* G; const float* ssq; const float* rope; const float* bgate; const float* bfg; float* logf; int nostore; const float* sa; const float* swc;
    __device__ __forceinline__ void operator()(const pg8::f32x4 (&acc)[2][2][4][2], const pg8::Unit& u, int wr, int wc, int fr, int fq) const {
        const int colw = u.pn * 256 + wc * 32 + 8 * fq;
        const int row0 = u.pm * 256 + wr * 64 + fr;
        float rsv[8];
#pragma unroll
        for (int i = 0; i < 8; ++i) rsv[i] = ssq[row0 + (i >> 2) * 128 + (i & 3) * 16];
#pragma unroll
        for (int i = 0; i < 8; ++i) rsv[i] = rsqrtf(rsv[i] * (1.0f / 1024.0f) + RMS_EPS);
        f32x4 swv[2][2];
        if constexpr (I8) {
            float sav[8];
#pragma unroll
            for (int i = 0; i < 8; ++i) sav[i] = sa[row0 + (i >> 2) * 128 + (i & 3) * 16];
#pragma unroll
            for (int i = 0; i < 8; ++i) rsv[i] *= sav[i];
#pragma unroll
            for (int bj = 0; bj < 2; ++bj) { swv[bj][0] = *(const f32x4*)(swc + colw + bj * 128); swv[bj][1] = *(const f32x4*)(swc + colw + bj * 128 + 4); }
        }
#define EPIIN_ACC(ai, bj, m, n, e) (I8 ? (float)__float_as_int(acc[ai][bj][m][n][e]) * swv[bj][n][e] : acc[ai][bj][m][n][e])
        if (colw >= 3072) {
            const int g0 = colw - 3072;
            f32x4 bg[2][2];
#pragma unroll
            for (int bj = 0; bj < 2; ++bj) { bg[bj][0] = *(const f32x4*)(bgate + g0 + bj * 128) * -LOG2E; bg[bj][1] = *(const f32x4*)(bgate + g0 + bj * 128 + 4) * -LOG2E; }
            unsigned char* G8 = (unsigned char*)G;
            const int gbyte = (u.pn - 12) * 256 + wc * 64 + fq * 16;
#pragma unroll
            for (int i = 0; i < 8; ++i) {
                const int ai = i >> 2, m = i & 3;
                const int row = row0 + ai * 128 + m * 16;
                const float rs = rsv[i];
                u32x4 w;
#pragma unroll
                for (int bj = 0; bj < 2; ++bj) {
                    float v[8];
#pragma unroll
                    for (int e = 0; e < 4; ++e) {
                        v[e] = 255.0f * __builtin_amdgcn_rcpf(1.0f + __builtin_amdgcn_exp2f(fmaf(EPIIN_ACC(ai, bj, m, 0, e), rs, bg[bj][0][e])));
                        v[4 + e] = 255.0f * __builtin_amdgcn_rcpf(1.0f + __builtin_amdgcn_exp2f(fmaf(EPIIN_ACC(ai, bj, m, 1, e), rs, bg[bj][1][e])));
                    }
                    unsigned lo = 0, hi_ = 0;
                    lo = __builtin_amdgcn_cvt_pk_u8_f32(v[0], 0, lo); lo = __builtin_amdgcn_cvt_pk_u8_f32(v[1], 1, lo); lo = __builtin_amdgcn_cvt_pk_u8_f32(v[2], 2, lo); lo = __builtin_amdgcn_cvt_pk_u8_f32(v[3], 3, lo);
                    hi_ = __builtin_amdgcn_cvt_pk_u8_f32(v[4], 0, hi_); hi_ = __builtin_amdgcn_cvt_pk_u8_f32(v[5], 1, hi_); hi_ = __builtin_amdgcn_cvt_pk_u8_f32(v[6], 2, hi_); hi_ = __builtin_amdgcn_cvt_pk_u8_f32(v[7], 3, hi_);
                    if (bj == 0) { w.x = lo; w.y = hi_; } else { w.z = lo; w.w = hi_; }
                }
                if (!(nostore && w.x != 0x12345678u)) { if (EPI_NT & 1) __builtin_nontemporal_store(w, (u32x4*)(G8 + (size_t)row * 3072 + gbyte)); else *(u32x4*)(G8 + (size_t)row * 3072 + gbyte) = w; }
            }
        } else {
            bool rp[2];
#pragma unroll
            for (int bj = 0; bj < 2; ++bj) { const int cb = colw + bj * 128; rp[bj] = (cb < 384) || (cb >= 768 && cb < 1536) || (cb >= 2688 && cb < 2816); }
            f32x4 rn[2][2];
#pragma unroll
            for (int bj = 0; bj < 2; ++bj) if (rp[bj]) { const float* r = rope + ((size_t)row0 * 32 + (((colw + bj * 128) & 63) >> 1)) * 2; rn[bj][0] = *(const f32x4*)r; rn[bj][1] = *(const f32x4*)(r + 4); }
#pragma unroll
            for (int i = 0; i < 8; ++i) {
                const int ai = i >> 2, m = i & 3;
                const int row = row0 + ai * 128 + m * 16;
                const float rs = rsv[i];
                f32x4 rc[2][2];
#pragma unroll
                for (int bj = 0; bj < 2; ++bj) { rc[bj][0] = rn[bj][0]; rc[bj][1] = rn[bj][1]; }
                if (i < 7) {
                    const int rown = row0 + ((i + 1) >> 2) * 128 + ((i + 1) & 3) * 16;
#pragma unroll
                    for (int bj = 0; bj < 2; ++bj) if (rp[bj]) { const float* r = rope + ((size_t)rown * 32 + (((colw + bj * 128) & 63) >> 1)) * 2; rn[bj][0] = *(const f32x4*)r; rn[bj][1] = *(const f32x4*)(r + 4); }
                }
#pragma unroll
                for (int bj = 0; bj < 2; ++bj) {
                    const int cb = colw + bj * 128;
                    float v[8];
#pragma unroll
                    for (int e = 0; e < 4; ++e) { v[e] = EPIIN_ACC(ai, bj, m, 0, e) * rs; v[4 + e] = EPIIN_ACC(ai, bj, m, 1, e) * rs; }
                    if (rp[bj]) {
                        const f32x4 r0 = rc[bj][0], r1 = rc[bj][1];
                        float a, b;
                        a = v[0]; b = v[1]; v[0] = a * r0[0] - b * r0[1]; v[1] = b * r0[0] + a * r0[1];
                        a = v[2]; b = v[3]; v[2] = a * r0[2] - b * r0[3]; v[3] = b * r0[2] + a * r0[3];
                        a = v[4]; b = v[5]; v[4] = a * r1[0] - b * r1[1]; v[5] = b * r1[0] + a * r1[1];
                        a = v[6]; b = v[7]; v[6] = a * r1[2] - b * r1[3]; v[7] = b * r1[2] + a * r1[3];
                    }
                    if (cb == PC_FB) {
#pragma unroll
                        for (int e = 0; e < 6; ++e) { const float z = v[e] + bfg[e]; logf[(size_t)row * 8 + e] = fminf(z, 0.f) - log1pf(__expf(-fabsf(z))); }
                    }
                    u32x4 w; w.x = cvtpk(v[0], v[1]); w.y = cvtpk(v[2], v[3]); w.z = cvtpk(v[4], v[5]); w.w = cvtpk(v[6], v[7]);
                    if (!(nostore && w.x != 0x12345678u)) { if (EPI_NT & 1) __builtin_nontemporal_store(w, (u32x4*)(P + (size_t)row * NP + cb)); else *(u32x4*)(P + (size_t)row * NP + cb) = w; }
                }
            }
        }
    }
};
struct EpiDry {
    static constexpr bool PERM = true, AFTER_DRAIN = false;
    __device__ __forceinline__ bool keep(const pg8::Unit&) const { return false; }
    float* sink;
    __device__ __forceinline__ void operator()(const pg8::f32x4 (&acc)[2][2][4][2], const pg8::Unit& u, int wr, int wc, int fr, int fq) const {
        float t = 0.f;
#pragma unroll
        for (int ai = 0; ai < 2; ++ai)
#pragma unroll
            for (int bj = 0; bj < 2; ++bj)
#pragma unroll
                for (int m = 0; m < 4; ++m)
#pragma unroll
                    for (int n = 0; n < 2; ++n) t += acc[ai][bj][m][n][0] + acc[ai][bj][m][n][1] + acc[ai][bj][m][n][2] + acc[ai][bj][m][n][3];
        if (t == 1.2345e33f) sink[u.pm] = t;
    }
};
struct EpiBr {
    static constexpr bool PERM = true, AFTER_DRAIN = false;
    __device__ __forceinline__ bool keep(const pg8::Unit&) const { return false; }
    const bf16_t* Gi; bf16_t* Mg; int first;
    __device__ __forceinline__ void operator()(const pg8::f32x4 (&acc)[2][2][4][2], const pg8::Unit& u, int wr, int wc, int fr, int fq) const {
        const int colw = u.pn * 256 + wc * 32 + 8 * fq;
#pragma unroll
        for (int ai = 0; ai < 2; ++ai)
#pragma unroll
            for (int m = 0; m < 4; ++m) {
                const int row = u.pm * 256 + ai * 128 + wr * 64 + m * 16 + fr;
#pragma unroll
                for (int bj = 0; bj < 2; ++bj) {
                    const int cb = colw + bj * 128;
                    const u32x4 g = *(const u32x4*)(Gi + (size_t)row * NP + cb);
                    float v[8];
                    v[0] = bflo(g.x) * acc[ai][bj][m][0][0]; v[1] = bfhi(g.x) * acc[ai][bj][m][0][1]; v[2] = bflo(g.y) * acc[ai][bj][m][0][2]; v[3] = bfhi(g.y) * acc[ai][bj][m][0][3];
                    v[4] = bflo(g.z) * acc[ai][bj][m][1][0]; v[5] = bfhi(g.z) * acc[ai][bj][m][1][1]; v[6] = bflo(g.w) * acc[ai][bj][m][1][2]; v[7] = bfhi(g.w) * acc[ai][bj][m][1][3];
                    bf16_t* mp = Mg + (size_t)row * NP + cb;
                    if (!first) { const u32x4 o = *(const u32x4*)mp;
                        v[0] += bflo(o.x); v[1] += bfhi(o.x); v[2] += bflo(o.y); v[3] += bfhi(o.y); v[4] += bflo(o.z); v[5] += bfhi(o.z); v[6] += bflo(o.w); v[7] += bfhi(o.w); }
                    u32x4 w; w.x = cvtpk(v[0], v[1]); w.y = cvtpk(v[2], v[3]); w.z = cvtpk(v[4], v[5]); w.w = cvtpk(v[6], v[7]);
                    *(u32x4*)mp = w;
                }
                if (m & 1) asm volatile("" ::: "memory");
            }
    }
};
struct BranchOrder {
    pg8::StaticOrder so;
    __device__ __forceinline__ void init(int M, int N, int G_, int c_) { so.init(M, N, G_, c_); }
    __device__ __forceinline__ bool next(int i, pg8::Unit& u) const { const int ti = i / 3; if (!so.next(ti, u)) return false; u.br = i - 3 * ti; return true; }
    __device__ __forceinline__ size_t a_off(const pg8::Unit& u) const { return (size_t)u.br * 384 * 2; }
    __device__ __forceinline__ size_t b_off(const pg8::Unit& u) const { return (size_t)u.br * DM * 384 * 2; }
    __device__ __forceinline__ void a_ready(const pg8::Unit&) const {}
    __device__ __forceinline__ void done(const pg8::Unit&) const {}
};
#ifndef BR_PRELOAD
#define BR_PRELOAD 0
#endif
struct EpiBrChain {
    static constexpr bool PERM = true, AFTER_DRAIN = false;
    const unsigned char* G8; bf16_t* Mg;
    __device__ __forceinline__ bool keep(const pg8::Unit& u) const { return u.br < 2; }
    __device__ __forceinline__ void operator()(pg8::f32x4 (&acc)[2][2][4][2], const pg8::Unit& u, int wr, int wc, int fr, int fq) const {
        const int colw = u.pn * 256 + wc * 32 + 8 * fq, br = u.br;
        const int row0 = u.pm * 256 + wr * 64 + fr;
        const int gbyte = br * 1024 + u.pn * 256 + wc * 64 + fq * 16;
        constexpr float GEPS = 1e-6f, I255 = 1.0f / 255.0f;
#if BR_PRELOAD
        u32x4 gca[8], gna[8];
#pragma unroll
        for (int i = 0; i < 8; ++i) gca[i] = *(const u32x4*)(G8 + (size_t)(row0 + (i >> 2) * 128 + (i & 3) * 16) * 3072 + gbyte);
        if (br < 2) {
#pragma unroll
            for (int i = 0; i < 8; ++i) gna[i] = *(const u32x4*)(G8 + (size_t)(row0 + (i >> 2) * 128 + (i & 3) * 16) * 3072 + gbyte + 1024);
        }
#else
        u32x4 gcn, gnn;
        gcn = *(const u32x4*)(G8 + (size_t)row0 * 3072 + gbyte);
        if (br < 2) gnn = *(const u32x4*)(G8 + (size_t)row0 * 3072 + gbyte + 1024);
#endif
#pragma unroll
        for (int i = 0; i < 8; ++i) {
            const int ai = i >> 2, m = i & 3;
            const int row = row0 + ai * 128 + m * 16;
#if BR_PRELOAD
            const u32x4 gc = gca[i], gn = gna[i];
#else
            const u32x4 gc = gcn, gn = gnn;
            if (i < 7) {
                const int rown = row0 + ((i + 1) >> 2) * 128 + ((i + 1) & 3) * 16;
                gcn = *(const u32x4*)(G8 + (size_t)rown * 3072 + gbyte);
                if (br < 2) gnn = *(const u32x4*)(G8 + (size_t)rown * 3072 + gbyte + 1024);
            }
#endif
#pragma unroll
            for (int bj = 0; bj < 2; ++bj) {
                const unsigned c0 = bj == 0 ? gc.x : gc.z, c1 = bj == 0 ? gc.y : gc.w;
                float f[8] = {(float)(c0 & 255u), (float)((c0 >> 8) & 255u), (float)((c0 >> 16) & 255u), (float)(c0 >> 24), (float)(c1 & 255u), (float)((c1 >> 8) & 255u), (float)((c1 >> 16) & 255u), (float)(c1 >> 24)};
#pragma unroll
                for (int e = 0; e < 8; ++e) f[e] *= I255;
                if (br > 0) {
#pragma unroll
                    for (int e = 0; e < 8; ++e) f[e] = fmaxf(f[e], GEPS);
                }
                if (br < 2) {
                    const unsigned n0 = bj == 0 ? gn.x : gn.z, n1 = bj == 0 ? gn.y : gn.w;
                    const float d[8] = {(float)(n0 & 255u), (float)((n0 >> 8) & 255u), (float)((n0 >> 16) & 255u), (float)(n0 >> 24), (float)(n1 & 255u), (float)((n1 >> 8) & 255u), (float)((n1 >> 16) & 255u), (float)(n1 >> 24)};
#pragma unroll
                    for (int e = 0; e < 8; ++e) f[e] *= __builtin_amdgcn_rcpf(fmaxf(d[e] * I255, GEPS));
#pragma unroll
                    for (int e = 0; e < 4; ++e) { acc[ai][bj][m][0][e] *= f[e]; acc[ai][bj][m][1][e] *= f[4 + e]; }
                } else {
                    float v[8];
#pragma unroll
                    for (int e = 0; e < 4; ++e) { v[e] = acc[ai][bj][m][0][e] * f[e]; v[4 + e] = acc[ai][bj][m][1][e] * f[4 + e]; }
                    u32x4 w; w.x = cvtpk(v[0], v[1]); w.y = cvtpk(v[2], v[3]); w.z = cvtpk(v[4], v[5]); w.w = cvtpk(v[6], v[7]);
                    if (EPI_NT & 8) __builtin_nontemporal_store(w, (u32x4*)(Mg + (size_t)row * NP + colw + bj * 128)); else *(u32x4*)(Mg + (size_t)row * NP + colw + bj * 128) = w;
                }
            }
        }
    }
};
#ifndef RES16
#define RES16 1
#endif
struct EpiOut {
    static constexpr bool PERM = true, AFTER_DRAIN = false;
    __device__ __forceinline__ bool keep(const pg8::Unit&) const { return false; }
    const float* Hin; float* H; bf16_t* HB; float* ssq;
    __device__ __forceinline__ void operator()(const pg8::f32x4 (&acc)[2][2][4][2], const pg8::Unit& u, int wr, int wc, int fr, int fq) const {
        const int colw = u.pn * 256 + wc * 32 + 8 * fq;
        const int row0 = u.pm * 256 + wr * 64 + fr;
#if RES16
        u32x4 hn[2];
#pragma unroll
        for (int bj = 0; bj < 2; ++bj) hn[bj] = *(const u32x4*)(HB + (size_t)row0 * DM + colw + bj * 128);
#else
        f32x4 hn[2][2];
#pragma unroll
        for (int bj = 0; bj < 2; ++bj) { const float* hi_ = Hin + (size_t)row0 * DM + colw + bj * 128; hn[bj][0] = *(const f32x4*)hi_; hn[bj][1] = *(const f32x4*)(hi_ + 4); }
#endif
#pragma unroll
        for (int i = 0; i < 8; ++i) {
            const int ai = i >> 2, m = i & 3;
            const int row = row0 + ai * 128 + m * 16;
            f32x4 hc[2][2];
#if RES16
#pragma unroll
            for (int bj = 0; bj < 2; ++bj) { hc[bj][0] = (f32x4){bflo(hn[bj].x), bfhi(hn[bj].x), bflo(hn[bj].y), bfhi(hn[bj].y)}; hc[bj][1] = (f32x4){bflo(hn[bj].z), bfhi(hn[bj].z), bflo(hn[bj].w), bfhi(hn[bj].w)}; }
            if (i < 7) {
                const int rown = row0 + ((i + 1) >> 2) * 128 + ((i + 1) & 3) * 16;
#pragma unroll
                for (int bj = 0; bj < 2; ++bj) hn[bj] = *(const u32x4*)(HB + (size_t)rown * DM + colw + bj * 128);
            }
#else
#pragma unroll
            for (int bj = 0; bj < 2; ++bj) { hc[bj][0] = hn[bj][0]; hc[bj][1] = hn[bj][1]; }
            if (i < 7) {
                const int rown = row0 + ((i + 1) >> 2) * 128 + ((i + 1) & 3) * 16;
#pragma unroll
                for (int bj = 0; bj < 2; ++bj) { const float* hi_ = Hin + (size_t)rown * DM + colw + bj * 128; hn[bj][0] = *(const f32x4*)hi_; hn[bj][1] = *(const f32x4*)(hi_ + 4); }
            }
#endif
            float ss = 0.f;
#pragma unroll
            for (int bj = 0; bj < 2; ++bj) {
                const int cb = colw + bj * 128;
                f32x4 h0 = hc[bj][0] + acc[ai][bj][m][0], h1 = hc[bj][1] + acc[ai][bj][m][1];
#if !RES16
                float* hp = H + (size_t)row * DM + cb;
                if (EPI_NT & 2) { __builtin_nontemporal_store(h0, (f32x4*)hp); __builtin_nontemporal_store(h1, (f32x4*)(hp + 4)); } else { *(f32x4*)hp = h0; *(f32x4*)(hp + 4) = h1; }
#endif
                u32x4 w; w.x = cvtpk(h0[0], h0[1]); w.y = cvtpk(h0[2], h0[3]); w.z = cvtpk(h1[0], h1[1]); w.w = cvtpk(h1[2], h1[3]);
                *(u32x4*)(HB + (size_t)row * DM + cb) = w;
                ss += (h0[0] * h0[0] + h0[1] * h0[1]) + (h0[2] * h0[2] + h0[3] * h0[3]) + (h1[0] * h1[0] + h1[1] * h1[1]) + (h1[2] * h1[2] + h1[3] * h1[3]);
            }
            ss += __shfl_xor(ss, 16); ss += __shfl_xor(ss, 32);
            if (fq == 0) ssq[(size_t)row * 16 + u.pn * 4 + wc] = ss;
        }
    }
};
#ifndef Q_I8
#define Q_I8 1
#endif
template <bool I8> struct EpiQT {
    static constexpr bool PERM = true, AFTER_DRAIN = false;
    __device__ __forceinline__ bool keep(const pg8::Unit&) const { return false; }
    bf16_t* Q; const float* ssq; const float* sx; const float* swq;
    __device__ __forceinline__ void operator()(const pg8::f32x4 (&acc)[2][2][4][2], const pg8::Unit& u, int wr, int wc, int fr, int fq) const {
        const int colw = u.pn * 256 + wc * 32 + 8 * fq;
        const int row0 = u.pm * 256 + wr * 64 + fr;
        float rsv[8];
#pragma unroll
        for (int i = 0; i < 4; ++i) rsv[i] = ssq16(ssq, row0 + (i & 3) * 16);
        asm volatile("" ::: "memory");
#pragma unroll
        for (int i = 4; i < 8; ++i) rsv[i] = ssq16(ssq, row0 + 128 + (i & 3) * 16);
#pragma unroll
        for (int i = 0; i < 8; ++i) rsv[i] = rsqrtf(rsv[i] * (1.0f / 1024.0f) + RMS_EPS);
        f32x4 swv[2][2];
        if constexpr (I8) {
#pragma unroll
            for (int i = 0; i < 8; ++i) rsv[i] *= sx[row0 + (i >> 2) * 128 + (i & 3) * 16];
#pragma unroll
            for (int bj = 0; bj < 2; ++bj) { swv[bj][0] = *(const f32x4*)(swq + colw + bj * 128); swv[bj][1] = *(const f32x4*)(swq + colw + bj * 128 + 4); }
        }
#pragma unroll
        for (int i = 0; i < 8; ++i) {
            const int ai = i >> 2, m = i & 3;
            const int row = row0 + ai * 128 + m * 16;
            const float rs = rsv[i];
#pragma unroll
            for (int bj = 0; bj < 2; ++bj) {
                const int cb = colw + bj * 128;
                f32x4 a, b;
                if constexpr (I8) {
#pragma unroll
                    for (int e = 0; e < 4; ++e) { a[e] = (float)__float_as_int(acc[ai][bj][m][0][e]) * swv[bj][0][e] * rs; b[e] = (float)__float_as_int(acc[ai][bj][m][1][e]) * swv[bj][1][e] * rs; }
                } else { a = acc[ai][bj][m][0] * rs; b = acc[ai][bj][m][1] * rs; }
                u32x4 w; w.x = cvtpk(a[0], a[1]); w.y = cvtpk(a[2], a[3]); w.z = cvtpk(b[0], b[1]); w.w = cvtpk(b[2], b[3]);
                if (EPI_NT & 4) __builtin_nontemporal_store(w, (u32x4*)(Q + (size_t)row * 2048 + cb)); else *(u32x4*)(Q + (size_t)row * 2048 + cb) = w;
            }
        }
    }
};

constexpr int VRP = 144;
constexpr int ATT_WAVE_LDS = 32 * VRP + 256 + 8192;
__device__ __forceinline__ int crow(int r, int hi) { return (r & 3) + 8 * (r >> 2) + 4 * hi; }

struct AttState { float m, l; f32x16 o0, o1; };
struct KTile { u32x4 k0, k1, k2, k3; float ck; };
struct VTile { u32x4 v0, v1, v2, v3; };
struct KFrag { bf16x8 k0, k1, k2, k3; };

#ifndef PROBE_HOT
#define PROBE_HOT 0
#endif
#ifndef ATT_KVSTAGE
#define ATT_KVSTAGE 0
#endif
#ifndef PROBE_SHORT
#define PROBE_SHORT 0
#endif
#ifndef ATT_PIPE
#define ATT_PIPE 0
#endif
template <bool BIAS>
__device__ __forceinline__ void k_load(KTile& t, const bf16_t* __restrict__ Pb, int kcol, int r, int ktile, const float* __restrict__ cumT, int lane, int hot = 0) {
    const int row = lane >> 3, ch = lane & 7;
    const bf16_t* base = Pb + kcol + 8 * ch;
    int t0 = ktile + row * r, t1 = t0 + 8 * r, t2 = t0 + 16 * r, t3 = t0 + 24 * r;
    t0 = t0 < 0 ? 0 : (t0 > SEQ - 1 ? SEQ - 1 : t0); t1 = t1 < 0 ? 0 : (t1 > SEQ - 1 ? SEQ - 1 : t1);
    t2 = t2 < 0 ? 0 : (t2 > SEQ - 1 ? SEQ - 1 : t2); t3 = t3 < 0 ? 0 : (t3 > SEQ - 1 ? SEQ - 1 : t3);
    if (PROBE_HOT && hot) { t0 &= 255; t1 &= 255; t2 &= 255; t3 &= 255; }
    t.k0 = *(const u32x4*)(base + (size_t)t0 * NP); t.k1 = *(const u32x4*)(base + (size_t)t1 * NP); t.k2 = *(const u32x4*)(base + (size_t)t2 * NP); t.k3 = *(const u32x4*)(base + (size_t)t3 * NP);
    t.ck = 0.f;
    if (BIAS) { int tk_l = ktile + (lane & 31) * r; tk_l = tk_l < 0 ? 0 : (tk_l > SEQ - 1 ? SEQ - 1 : tk_l); t.ck = cumT[tk_l]; }
}
__device__ __forceinline__ void v_load(VTile& t, const bf16_t* __restrict__ Pb, int vcol, int r, int ktile, int lane, int hot = 0) {
    const int row = lane >> 3, ch = lane & 7;
    const bf16_t* base = Pb + vcol + 8 * ch;
    int t0 = ktile + row * r, t1 = t0 + 8 * r, t2 = t0 + 16 * r, t3 = t0 + 24 * r;
    t0 = t0 < 0 ? 0 : (t0 > SEQ - 1 ? SEQ - 1 : t0); t1 = t1 < 0 ? 0 : (t1 > SEQ - 1 ? SEQ - 1 : t1);
    t2 = t2 < 0 ? 0 : (t2 > SEQ - 1 ? SEQ - 1 : t2); t3 = t3 < 0 ? 0 : (t3 > SEQ - 1 ? SEQ - 1 : t3);
    if (PROBE_HOT && hot) { t0 &= 255; t1 &= 255; t2 &= 255; t3 &= 255; }
    t.v0 = *(const u32x4*)(base + (size_t)t0 * NP); t.v1 = *(const u32x4*)(base + (size_t)t1 * NP); t.v2 = *(const u32x4*)(base + (size_t)t2 * NP); t.v3 = *(const u32x4*)(base + (size_t)t3 * NP);
}
__device__ __forceinline__ void k_stage(const KTile& t, LAS unsigned char* vl, KFrag& f, int lane) {
    asm volatile("" ::: "memory");
    {
        LAS unsigned char* wp = vl + (lane >> 3) * VRP + (lane & 7) * 16;
        *(LAS u32x4*)(wp) = t.k0; *(LAS u32x4*)(wp + 8 * VRP) = t.k1; *(LAS u32x4*)(wp + 16 * VRP) = t.k2; *(LAS u32x4*)(wp + 24 * VRP) = t.k3;
    }
    asm volatile("s_waitcnt lgkmcnt(0)" ::: "memory");
    const LAS unsigned char* rp = vl + (lane & 31) * VRP + (lane >> 5) * 16;
    f.k0 = *(const LAS bf16x8*)(rp); f.k1 = *(const LAS bf16x8*)(rp + 32); f.k2 = *(const LAS bf16x8*)(rp + 64); f.k3 = *(const LAS bf16x8*)(rp + 96);
    asm volatile("s_waitcnt lgkmcnt(0)" ::: "memory");
}
template <bool BIAS>
__device__ __forceinline__ void v_stage(const VTile& t, float ck, LAS unsigned char* vl, bf16x8 (&vf)[2][2], int lane) {
    const int hi = lane >> 5, l31 = lane & 31, q4 = (lane & 15) >> 2, p4 = lane & 3, g1 = (lane >> 4) & 1;
    asm volatile("" ::: "memory");
    {
        LAS unsigned char* wp = vl + (lane >> 3) * VRP + (lane & 7) * 16;
        *(LAS u32x4*)(wp) = t.v0; *(LAS u32x4*)(wp + 8 * VRP) = t.v1; *(LAS u32x4*)(wp + 16 * VRP) = t.v2; *(LAS u32x4*)(wp + 24 * VRP) = t.v3;
        if (BIAS) { if (hi == 0) ((LAS float*)(vl + 32 * VRP))[l31] = ck; }
    }
    asm volatile("s_waitcnt lgkmcnt(0)" ::: "memory");
    const LAS unsigned char* vb = vl + (4 * hi + q4) * VRP + (16 * g1 + 4 * p4) * 2;
#pragma unroll
    for (int dblk = 0; dblk < 2; ++dblk)
#pragma unroll
        for (int s2 = 0; s2 < 2; ++s2) {
            const LAS unsigned char* a = vb + (16 * s2) * VRP + dblk * 64;
            const v4i16_t lo = __builtin_amdgcn_ds_read_tr16_b64_v4i16((LAS v4i16_t*)a);
            const v4i16_t hh = __builtin_amdgcn_ds_read_tr16_b64_v4i16((LAS v4i16_t*)(a + 8 * VRP));
            vf[dblk][s2] = (bf16x8){lo[0], lo[1], lo[2], lo[3], hh[0], hh[1], hh[2], hh[3]};
        }
}
__device__ __forceinline__ float max_halves(float v) {
    const auto rr = __builtin_amdgcn_permlane32_swap(__float_as_uint(v), __float_as_uint(v), false, false);
    return fmaxf(__uint_as_float(rr[0]), __uint_as_float(rr[1]));
}
__device__ __forceinline__ void softmax_pv(f32x16& s, float scale, AttState& st, const bf16x8 (&vf)[2][2]) {
    float mx = s[0];
#pragma unroll
    for (int i = 1; i < 16; ++i) mx = fmaxf(mx, s[i]);
    mx = max_halves(mx) * scale;
    float m_use = (st.m == -INFINITY) ? 0.f : st.m;
    if (!__all(mx <= st.m + 8.0f)) {
        const float m_new = fmaxf(st.m, mx);
        m_use = (m_new == -INFINITY) ? 0.f : m_new;
        const float alpha = __builtin_amdgcn_exp2f(st.m - m_use);
        st.l *= alpha; st.m = m_new;
#pragma unroll
        for (int i = 0; i < 16; ++i) { st.o0[i] *= alpha; st.o1[i] *= alpha; }
    }
    float rsum = 0.f;
#pragma unroll
    for (int i = 0; i < 16; ++i) { s[i] = __builtin_amdgcn_exp2f(fmaf(s[i], scale, -m_use)); rsum += s[i]; }
    st.l += rsum;
    u32x4 pw0, pw1;
    pw0.x = cvtpk(s[0], s[1]); pw0.y = cvtpk(s[2], s[3]); pw0.z = cvtpk(s[4], s[5]); pw0.w = cvtpk(s[6], s[7]);
    pw1.x = cvtpk(s[8], s[9]); pw1.y = cvtpk(s[10], s[11]); pw1.z = cvtpk(s[12], s[13]); pw1.w = cvtpk(s[14], s[15]);
    const bf16x8 pb0 = __builtin_bit_cast(bf16x8, pw0), pb1 = __builtin_bit_cast(bf16x8, pw1);
    st.o0 = __builtin_amdgcn_mfma_f32_32x32x16_bf16(vf[0][0], pb0, st.o0, 0, 0, 0);
    st.o0 = __builtin_amdgcn_mfma_f32_32x32x16_bf16(vf[0][1], pb1, st.o0, 0, 0, 0);
    st.o1 = __builtin_amdgcn_mfma_f32_32x32x16_bf16(vf[1][0], pb0, st.o1, 0, 0, 0);
    st.o1 = __builtin_amdgcn_mfma_f32_32x32x16_bf16(vf[1][1], pb1, st.o1, 0, 0, 0);
}
__device__ __forceinline__ f32x16 qk_tile(const KFrag& t, const bf16x8 (&qf)[4]) {
    f32x16 s;
#pragma unroll
    for (int i = 0; i < 16; ++i) s[i] = 0.f;
    s = __builtin_amdgcn_mfma_f32_32x32x16_bf16(t.k0, qf[0], s, 0, 0, 0);
    s = __builtin_amdgcn_mfma_f32_32x32x16_bf16(t.k1, qf[1], s, 0, 0, 0);
    s = __builtin_amdgcn_mfma_f32_32x32x16_bf16(t.k2, qf[2], s, 0, 0, 0);
    s = __builtin_amdgcn_mfma_f32_32x32x16_bf16(t.k3, qf[3], s, 0, 0, 0);
    return s;
}

__device__ __forceinline__ f32x16 qk_tile_lds(const KFrag& t, const LAS unsigned char* qb) {
    f32x16 s;
#pragma unroll
    for (int i = 0; i < 16; ++i) s[i] = 0.f;
    s = __builtin_amdgcn_mfma_f32_32x32x16_bf16(t.k0, *(const LAS bf16x8*)(qb), s, 0, 0, 0);
    s = __builtin_amdgcn_mfma_f32_32x32x16_bf16(t.k1, *(const LAS bf16x8*)(qb + 1024), s, 0, 0, 0);
    s = __builtin_amdgcn_mfma_f32_32x32x16_bf16(t.k2, *(const LAS bf16x8*)(qb + 2048), s, 0, 0, 0);
    s = __builtin_amdgcn_mfma_f32_32x32x16_bf16(t.k3, *(const LAS bf16x8*)(qb + 3072), s, 0, 0, 0);
    return s;
}

constexpr int KV_KOFF = 32 * VRP + 256;
__device__ __forceinline__ void kv_stage(const KTile& kt, const VTile& vt, LAS unsigned char* vl, KFrag& f, bf16x8 (&vf)[2][2], int lane) {
    const int hi = lane >> 5, q4 = (lane & 15) >> 2, p4 = lane & 3, g1 = (lane >> 4) & 1;
    asm volatile("" ::: "memory");
    {
        LAS unsigned char* wk = vl + KV_KOFF + (lane >> 3) * VRP + (lane & 7) * 16;
        *(LAS u32x4*)(wk) = kt.k0; *(LAS u32x4*)(wk + 8 * VRP) = kt.k1; *(LAS u32x4*)(wk + 16 * VRP) = kt.k2; *(LAS u32x4*)(wk + 24 * VRP) = kt.k3;
        LAS unsigned char* wp = vl + (lane >> 3) * VRP + (lane & 7) * 16;
        *(LAS u32x4*)(wp) = vt.v0; *(LAS u32x4*)(wp + 8 * VRP) = vt.v1; *(LAS u32x4*)(wp + 16 * VRP) = vt.v2; *(LAS u32x4*)(wp + 24 * VRP) = vt.v3;
    }
    asm volatile("s_waitcnt lgkmcnt(0)" ::: "memory");
    const LAS unsigned char* rp = vl + KV_KOFF + (lane & 31) * VRP + (lane >> 5) * 16;
    f.k0 = *(const LAS bf16x8*)(rp); f.k1 = *(const LAS bf16x8*)(rp + 32); f.k2 = *(const LAS bf16x8*)(rp + 64); f.k3 = *(const LAS bf16x8*)(rp + 96);
    const LAS unsigned char* vb = vl + (4 * hi + q4) * VRP + (16 * g1 + 4 * p4) * 2;
#pragma unroll
    for (int dblk = 0; dblk < 2; ++dblk)
#pragma unroll
        for (int s2 = 0; s2 < 2; ++s2) {
            const LAS unsigned char* a = vb + (16 * s2) * VRP + dblk * 64;
            const v4i16_t lo = __builtin_amdgcn_ds_read_tr16_b64_v4i16((LAS v4i16_t*)a);
            const v4i16_t hh = __builtin_amdgcn_ds_read_tr16_b64_v4i16((LAS v4i16_t*)(a + 8 * VRP));
            vf[dblk][s2] = (bf16x8){lo[0], lo[1], lo[2], lo[3], hh[0], hh[1], hh[2], hh[3]};
        }
}
template <int r>
__device__ __forceinline__ void attn_segment(const bf16_t* __restrict__ Pb, int kcol, int vcol, int maxd_tok, int kt0, int ntiles, int tq,
                                             const bf16x8 (&qf)[4], AttState& st, LAS unsigned char* vl, int lane, int hot = 0) {
    const int hi = lane >> 5;
    const int lim = maxd_tok < tq ? maxd_tok : tq;
#if ATT_PIPE
    {
        KTile k1; VTile vcur;
        f32x16 s_cur;
        {
            KTile k0; k_load<false>(k0, Pb, kcol, r, kt0, nullptr, lane, hot); v_load(vcur, Pb, vcol, r, kt0, lane, hot);
            if (ntiles > 1) k_load<false>(k1, Pb, kcol, r, kt0 + 32 * r, nullptr, lane, hot);
            KFrag kf; k_stage(k0, vl, kf, lane);
            s_cur = qk_tile(kf, qf);
        }
        for (int j = 0; j < ntiles; ++j) {
            const int ktile = kt0 + j * 32 * r;
            VTile vnext; KTile k2;
            if (j + 1 < ntiles) v_load(vnext, Pb, vcol, r, ktile + 32 * r, lane, hot);
            if (j + 2 < ntiles) k_load<false>(k2, Pb, kcol, r, ktile + 64 * r, nullptr, lane, hot);
            f32x16 s_next;
            if (j + 1 < ntiles) { KFrag kf1; k_stage(k1, vl, kf1, lane); s_next = qk_tile(kf1, qf); }
            bf16x8 vf[2][2];
            v_stage<false>(vcur, 0.f, vl, vf, lane);
            const int dbase = tq - ktile - 4 * hi * r;
#pragma unroll
            for (int i = 0; i < 16; ++i) {
                const int d = dbase - crow(i, 0) * r;
                s_cur[i] = ((unsigned)d <= (unsigned)lim) ? s_cur[i] : -INFINITY;
            }
            softmax_pv(s_cur, QK_SCALE2, st, vf);
            asm volatile("s_waitcnt lgkmcnt(0)" ::: "memory");
            if (j + 1 < ntiles) { s_cur = s_next; vcur = vnext; }
            if (j + 2 < ntiles) k1 = k2;
        }
        return;
    }
#endif
    KTile nx; VTile vnx;
    k_load<false>(nx, Pb, kcol, r, kt0, nullptr, lane, hot); v_load(vnx, Pb, vcol, r, kt0, lane, hot);
    for (int j = 0; j < ntiles; ++j) {
        const int ktile = kt0 + j * 32 * r;
        const VTile vt = vnx;
        const KTile cur = nx;
        if (j + 1 < ntiles) { k_load<false>(nx, Pb, kcol, r, ktile + 32 * r, nullptr, lane, hot); v_load(vnx, Pb, vcol, r, ktile + 32 * r, lane, hot); }
        KFrag kf; bf16x8 vf[2][2];
#if ATT_KVSTAGE
        kv_stage(cur, vt, vl, kf, vf, lane);
        f32x16 s = qk_tile(kf, qf);
#else
        k_stage(cur, vl, kf, lane);
        f32x16 s = qk_tile(kf, qf);
        v_stage<false>(vt, 0.f, vl, vf, lane);
#endif
        const int dbase = tq - ktile - 4 * hi * r;
#pragma unroll
        for (int i = 0; i < 16; ++i) {
            const int d = dbase - crow(i, 0) * r;
            s[i] = ((unsigned)d <= (unsigned)lim) ? s[i] : -INFINITY;
        }
        softmax_pv(s, QK_SCALE2, st, vf);
        asm volatile("s_waitcnt lgkmcnt(0)" ::: "memory");
    }
}

__device__ __forceinline__ void attn_load_q(const bf16_t* __restrict__ Pb, int tq, int qcol, int hi, bf16x8 (&qf)[4]) {
    const bf16_t* qp = Pb + (size_t)tq * NP + qcol + 8 * hi;
    qf[0] = *(const bf16x8*)(qp); qf[1] = *(const bf16x8*)(qp + 16); qf[2] = *(const bf16x8*)(qp + 32); qf[3] = *(const bf16x8*)(qp + 48);
}
__device__ __forceinline__ void attn_store_o(bf16_t* __restrict__ Pb, int tq, int ocol, int hi, AttState& st, int dry) {
    float l = st.l + __shfl_xor(st.l, 32);
    if (dry && l >= 0.f) return;
    const float inv = 1.0f / l;
    bf16_t* op = Pb + (size_t)tq * NP + ocol + 4 * hi;
#pragma unroll
    for (int g = 0; g < 4; ++g) {
        u32x2 w0, w1;
        w0.x = cvtpk(st.o0[4 * g] * inv, st.o0[4 * g + 1] * inv); w0.y = cvtpk(st.o0[4 * g + 2] * inv, st.o0[4 * g + 3] * inv);
        w1.x = cvtpk(st.o1[4 * g] * inv, st.o1[4 * g + 1] * inv); w1.y = cvtpk(st.o1[4 * g + 2] * inv, st.o1[4 * g + 3] * inv);
        *(u32x2*)(op + 8 * g) = w0; *(u32x2*)(op + 32 + 8 * g) = w1;
    }
}
__device__ __forceinline__ void att_init(AttState& st) {
#pragma unroll
    for (int i = 0; i < 16; ++i) { st.o0[i] = 0.f; st.o1[i] = 0.f; }
    st.m = -INFINITY; st.l = 0.f;
}

__device__ __forceinline__ void attn_fox_pair(bf16_t* __restrict__ Pb, const float* __restrict__ cumT, float kmax2, int h, int qp, LAS unsigned char* vl, int lane, int dry) {
    const int hi = lane >> 5, l31 = lane & 31;
    const int kcol = PC_KB + 64 * h, vcol = PC_VB + 64 * h, qcol = PC_QB + 64 * h;
    const LAS float* ckl = (const LAS float*)(vl + 32 * VRP);
    AttState st0, st1; att_init(st0); att_init(st1);
    const int tq0 = 64 * qp + l31, tq1 = tq0 + 32;
    LAS unsigned char* qb0 = vl + 32 * VRP + 256 + hi * 512 + l31 * 16;
    LAS unsigned char* qb1 = qb0 + 4096;
    {
        bf16x8 qf[4];
        attn_load_q(Pb, tq0, qcol, hi, qf);
#pragma unroll
        for (int s_ = 0; s_ < 4; ++s_) *(LAS bf16x8*)(qb0 + 1024 * s_) = qf[s_];
        attn_load_q(Pb, tq1, qcol, hi, qf);
#pragma unroll
        for (int s_ = 0; s_ < 4; ++s_) *(LAS bf16x8*)(qb1 + 1024 * s_) = qf[s_];
        asm volatile("s_waitcnt lgkmcnt(0)" ::: "memory");
    }
    const float cq0 = cumT[tq0], cq1 = cumT[tq1];
    float bound0, bound1;
    {
        float n0 = 0.f, n1 = 0.f;
#pragma unroll
        for (int s_ = 0; s_ < 4; ++s_) {
            const bf16x8 a = *(const LAS bf16x8*)(qb0 + 1024 * s_), b = *(const LAS bf16x8*)(qb1 + 1024 * s_);
#pragma unroll
            for (int e = 0; e < 8; ++e) { const float fa = bflo((unsigned)(unsigned short)a[e]), fb = bflo((unsigned)(unsigned short)b[e]); n0 = fmaf(fa, fa, n0); n1 = fmaf(fb, fb, n1); }
        }
        n0 += __shfl_xor(n0, 32); n1 += __shfl_xor(n1, 32);
        bound0 = sqrtf(n0 * kmax2) * QK_SCALE2 * 1.01f + 0.5f; bound1 = sqrtf(n1 * kmax2) * QK_SCALE2 * 1.01f + 0.5f;
    }
    constexpr float FOX_SKIP = 48.0f;
    const int ntiles = 2 * qp + 2;
    KTile nx;
    k_load<true>(nx, Pb, kcol, 1, 32 * (ntiles - 1), cumT, lane);
    for (int j = ntiles - 1; j >= 0; --j) {
        VTile vt; v_load(vt, Pb, vcol, 1, 32 * j, lane);
        const KTile cur = nx;
        if (j > 0) k_load<true>(nx, Pb, kcol, 1, 32 * (j - 1), cumT, lane);
        KFrag kf; k_stage(cur, vl, kf, lane);
        f32x16 s1 = qk_tile_lds(kf, qb1);
        f32x16 s0;
        const bool on0 = (j <= 2 * qp);
        if (on0) s0 = qk_tile_lds(kf, qb0);
        bf16x8 vf[2][2];
        v_stage<true>(vt, cur.ck, vl, vf, lane);
        if (on0) {
            const bool diag = (j == 2 * qp);
#pragma unroll
            for (int g = 0; g < 4; ++g) { const f32x4 c4 = *(const LAS f32x4*)(ckl + 8 * g + 4 * hi);
#pragma unroll
                for (int e = 0; e < 4; ++e) { const int i = 4 * g + e; const float v = fmaf(s0[i], QK_SCALE2, cq0 - c4[e]); s0[i] = (diag && crow(i, hi) > l31) ? -INFINITY : v; } }
            softmax_pv(s0, 1.0f, st0, vf);
        }
        {
            const bool diag = (j == 2 * qp + 1);
#pragma unroll
            for (int g = 0; g < 4; ++g) { const f32x4 c4 = *(const LAS f32x4*)(ckl + 8 * g + 4 * hi);
#pragma unroll
                for (int e = 0; e < 4; ++e) { const int i = 4 * g + e; const float v = fmaf(s1[i], QK_SCALE2, cq1 - c4[e]); s1[i] = (diag && crow(i, hi) > l31) ? -INFINITY : v; } }
            softmax_pv(s1, 1.0f, st1, vf);
        }
        asm volatile("s_waitcnt lgkmcnt(0)" ::: "memory");
        if (j > 0) {
            const float ckn = __int_as_float(__builtin_amdgcn_readlane(__float_as_int(nx.ck), 31));
            const bool dead0 = (cq0 - ckn + bound0) < (st0.m - FOX_SKIP), dead1 = (cq1 - ckn + bound1) < (st1.m - FOX_SKIP);
            if (__all(dead0 && dead1)) break;
        }
    }
    attn_store_o(Pb, tq0, qcol, hi, st0, dry);
    attn_store_o(Pb, tq1, qcol, hi, st1, dry);
}

#ifndef BQP
#define BQP 2
#endif
#ifndef CQT
#define CQT 4
#endif
#ifndef ATT_POP_G
#define ATT_POP_G 1
#endif
#ifndef MIXA_3PASS
#define MIXA_3PASS 0
#endif
#ifndef MIXA_ACQ
#define MIXA_ACQ 1
#endif
#ifndef MIXA_REL
#define MIXA_REL 0
#endif
typedef unsigned long long u64_t;
#ifndef MIXA_ONLY
#define MIXA_ONLY -1
#endif
#ifndef MIXA_PLAIN
#define MIXA_PLAIN 0
#endif
__device__ __forceinline__ void st_wt8(void* p, u32x2 v) { if (MIXA_PLAIN) *(u32x2*)p = v; else __hip_atomic_store((u64_t*)p, ((u64_t)v.y << 32) | v.x, __ATOMIC_RELAXED, __HIP_MEMORY_SCOPE_AGENT); }
__device__ __forceinline__ u32x2 ld_wt8(const void* p) { if (MIXA_PLAIN) return *(const u32x2*)p; const u64_t x = __hip_atomic_load((const u64_t*)p, __ATOMIC_RELAXED, __HIP_MEMORY_SCOPE_AGENT); return (u32x2){(unsigned)x, (unsigned)(x >> 32)}; }
__device__ __forceinline__ void st_wt4(float* p, float v) { if (MIXA_PLAIN) *p = v; else __hip_atomic_store(p, v, __ATOMIC_RELAXED, __HIP_MEMORY_SCOPE_AGENT); }
__device__ __forceinline__ float ld_wt4(const float* p) { if (MIXA_PLAIN) return *p; return __hip_atomic_load(p, __ATOMIC_RELAXED, __HIP_MEMORY_SCOPE_AGENT); }
__device__ __forceinline__ void mixa_store_partial(bf16_t* __restrict__ AO, float* __restrict__ ALSE, int pat, size_t tok  , int bh, int t, int h, int hi, AttState& st) {
    const float l = st.l + __shfl_xor(st.l, 32);
    const float inv = 1.0f / l;
    bf16_t* op = AO + ((size_t)pat * T + tok) * 384 + h * 64 + 4 * hi;
#pragma unroll
    for (int g = 0; g < 4; ++g) {
        u32x2 w0, w1;
        w0.x = cvtpk(st.o0[4 * g] * inv, st.o0[4 * g + 1] * inv); w0.y = cvtpk(st.o0[4 * g + 2] * inv, st.o0[4 * g + 3] * inv);
        w1.x = cvtpk(st.o1[4 * g] * inv, st.o1[4 * g + 1] * inv); w1.y = cvtpk(st.o1[4 * g + 2] * inv, st.o1[4 * g + 3] * inv);
        st_wt8(op + 8 * g, w0); st_wt8(op + 32 + 8 * g, w1);
    }
    if (hi == 0) st_wt4(ALSE + ((size_t)pat * (BATCH * 6) + bh) * SEQ + t, st.m + __builtin_amdgcn_logf(l));
}
__device__ __forceinline__ void mixa_combine(bf16_t* __restrict__ Pb, const bf16_t* __restrict__ AO, const float* __restrict__ ALSE, size_t tok, int bh, int t, int h, int hi) {
    float ls[3], mx;
#pragma unroll
    for (int p = 0; p < 3; ++p) ls[p] = ld_wt4(ALSE + ((size_t)p * (BATCH * 6) + bh) * SEQ + t);
    mx = fmaxf(ls[0], fmaxf(ls[1], ls[2]));
    float w[3], ws = 0.f;
#pragma unroll
    for (int p = 0; p < 3; ++p) { w[p] = __builtin_amdgcn_exp2f(ls[p] - mx); if (MIXA_ONLY >= 0) w[p] = (p == MIXA_ONLY) ? 1.f : 0.f; ws += w[p]; }
    const float iw = 1.0f / ws;
    float acc[32];
#pragma unroll
    for (int i = 0; i < 32; ++i) acc[i] = 0.f;
#pragma unroll
    for (int p = 0; p < 3; ++p) {
        const bf16_t* ip = AO + ((size_t)p * T + tok) * 384 + h * 64 + 32 * hi;
        const float wp = w[p] * iw;
#pragma unroll
        for (int c = 0; c < 8; ++c) { const u32x2 v = ld_wt8(ip + 4 * c);
            acc[4 * c] = fmaf(wp, bflo(v.x), acc[4 * c]); acc[4 * c + 1] = fmaf(wp, bfhi(v.x), acc[4 * c + 1]); acc[4 * c + 2] = fmaf(wp, bflo(v.y), acc[4 * c + 2]); acc[4 * c + 3] = fmaf(wp, bfhi(v.y), acc[4 * c + 3]); }
    }
    bf16_t* op = Pb + (size_t)t * NP + PC_QA + 64 * h + 32 * hi;
#pragma unroll
    for (int c = 0; c < 4; ++c) { u32x4 w4; w4.x = cvtpk(acc[8 * c], acc[8 * c + 1]); w4.y = cvtpk(acc[8 * c + 2], acc[8 * c + 3]); w4.z = cvtpk(acc[8 * c + 4], acc[8 * c + 5]); w4.w = cvtpk(acc[8 * c + 6], acc[8 * c + 7]);
        *(u32x4*)(op + 8 * c) = w4; }
}

__device__ __forceinline__ void attention_phase(unsigned char* __restrict__ ws, const float* __restrict__ sinks, int ctr_word, int grp_word, int kmax_word, LAS unsigned char* lds, int wave, int lane, int dry) {
#define ATT_P ((bf16_t*)(ws + WS_P))
#define ATT_CUMT ((const float*)(ws + WS_CUMT))
#define ATT_AO ((bf16_t*)(ws + WS_AO))
#define ATT_ALSE ((float*)(ws + WS_ALSE))
    LAS unsigned char* vl = lds + wave * ATT_WAVE_LDS;
    const int hi = lane >> 5, l31 = lane & 31;
    constexpr int NUB = 3072 / BQP, NU = 6144;
    constexpr int NUA = MIXA_3PASS ? 3 * NU : NU;
    constexpr int NUTOT = NUB + NUA + NU / CQT + (MIXA_3PASS == 1 ? NU : 0) ;
    int pend = -1;
    unsigned ucur = 0, uend = 0;
    for (;;) {
        if (ucur == uend) {
            unsigned u0 = 0;
            if (lane == 0) {
                if (MIXA_3PASS && pend >= 0) __hip_atomic_fetch_add((unsigned*)ws + grp_word + pend, 1u, __ATOMIC_RELAXED, __HIP_MEMORY_SCOPE_AGENT);
                u0 = atomicAdd((unsigned*)ws + ctr_word, (unsigned)ATT_POP_G);
            }
            pend = -1;
            ucur = (unsigned)__builtin_amdgcn_readfirstlane((int)u0); uend = ucur + ATT_POP_G;
        }
        const unsigned u = ucur++;
        if (u >= (unsigned)NUTOT) break;
        if (PROBE_SHORT == 3 && dry) continue;
        if (u < (unsigned)NUB) {
            const int bh = (int)(u % 24), b = bh / 6, h = bh % 6;
            for (int sub = 0; sub < BQP; ++sub) {
                const int qp = 127 - (int)(u / 24) * BQP - sub;
                if (!(PROBE_SHORT == 2 && dry)) attn_fox_pair(ATT_P + (size_t)b * SEQ * NP, ATT_CUMT + (size_t)bh * SEQ, ((const float*)ws)[kmax_word + bh], h, qp, vl, lane, dry);
            }
        } else if (MIXA_3PASS && u < (unsigned)(NUB + NUA)) {
            const int v = (int)u - NUB;
            const int pat = v / NU, w_ = v - pat * NU, bh = w_ >> 8, x_ = w_ & 255, b = bh / 6, h = bh % 6;
            const int r = pat == 0 ? 1 : (pat == 1 ? 4 : 16);
            const int rho = pat == 0 ? 0 : (pat == 1 ? (x_ & 3) : (x_ & 15)), cb = pat == 0 ? x_ : (pat == 1 ? (x_ >> 2) : (x_ >> 4));
            bf16_t* Pb = ATT_P + (size_t)b * SEQ * NP;
            const int tq0 = rho + r * 32 * cb, tq = tq0 + r * l31;
            AttState st; att_init(st); bf16x8 qf[4];
            attn_load_q(Pb, tq, PC_QA + 64 * h, hi, qf);
            if (pat == 0)      attn_segment<1>(Pb, PC_KA + 64 * h, PC_VA + 64 * h, 128, tq0 - 128, 5, tq, qf, st, vl, lane);
            else if (pat == 1) attn_segment<4>(Pb, PC_KA + 64 * h, PC_VA + 64 * h, 512, tq0 - 512, 5, tq, qf, st, vl, lane);
            else               attn_segment<16>(Pb, PC_KA + 64 * h, PC_VA + 64 * h, 2048, tq0 - 2048, 5, tq, qf, st, vl, lane);
            if (!dry) {
                mixa_store_partial(ATT_AO, ATT_ALSE, pat, (size_t)b * SEQ + tq, bh, tq, h, hi, st);
                asm volatile("s_waitcnt vmcnt(0)" ::: "memory");
                if (MIXA_REL) { __builtin_amdgcn_fence(__ATOMIC_RELEASE, "agent"); asm volatile("s_waitcnt vmcnt(0)" ::: "memory"); }
                pend = bh * 16 + (tq0 >> 9);
            }
        } else if (MIXA_3PASS == 1 && u >= (unsigned)(NUB + NUA + NU)) {
            const int v = (int)u - (NUB + NUA + NU);
            const int qt = v & 255, bh = v >> 8, b = bh / 6, h = bh % 6;
            if (!dry) {
                unsigned* cw = (unsigned*)ws + grp_word + bh * 16 + (qt >> 4);
                unsigned spins = 0;
                while ((unsigned)__builtin_amdgcn_readfirstlane((int)__hip_atomic_load(cw, __ATOMIC_RELAXED, __HIP_MEMORY_SCOPE_AGENT)) < 48u) {
                    __builtin_amdgcn_s_sleep(8);
                    if (++spins > (1u << 22)) break;
                }
                if (MIXA_ACQ) { __builtin_amdgcn_fence(__ATOMIC_ACQUIRE, "agent"); asm volatile("s_waitcnt vmcnt(0)" ::: "memory"); }
                mixa_combine(ATT_P + (size_t)b * SEQ * NP, ATT_AO, ATT_ALSE, (size_t)b * SEQ + qt * 32 + l31, bh, qt * 32 + l31, h, hi);
            }
        } else if (!MIXA_3PASS && u < (unsigned)(NUB + NU)) {
            const int v = (int)u - NUB;
            const int cb = v & 15, rho = (v >> 4) & 15, bh = v >> 8, b = bh / 6, h = bh % 6;
            bf16_t* Pb = ATT_P + (size_t)b * SEQ * NP;
            const int tq0 = rho + 512 * cb, tq = tq0 + 16 * l31;
            AttState st; att_init(st); bf16x8 qf[4];
            attn_load_q(Pb, tq, PC_QA + 64 * h, hi, qf);
            attn_segment<16>(Pb, PC_KA + 64 * h, PC_VA + 64 * h, 2048, tq0 - 2048, (PROBE_SHORT && dry) ? 1 : 5, tq, qf, st, vl, lane, dry);
            attn_segment<4>(Pb, PC_KA + 64 * h, PC_VA + 64 * h, 512, tq0 - 512, (PROBE_SHORT && dry) ? 1 : 8, tq, qf, st, vl, lane, dry);
            attn_segment<1>(Pb, PC_KA + 64 * h, PC_VA + 64 * h, 128, tq0 - 128, (PROBE_SHORT && dry) ? 1 : 20, tq, qf, st, vl, lane, dry);
            attn_store_o(Pb, tq, PC_QA + 64 * h, hi, st, dry);
        } else {
            const int v = (int)u - NUB - NUA;
            const int bh = v / (256 / CQT), qg = v - bh * (256 / CQT), b = bh / 6, h = bh % 6, hk = h / 3;
            bf16_t* Pb = ATT_P + (size_t)b * SEQ * NP;
            const float sink = sinks[h] * LOG2E;
            for (int sub = 0; sub < CQT; ++sub) {
                const int qt = qg * CQT + sub;
                const int tq = qt * 32 + l31;
                AttState st; att_init(st); bf16x8 qf[4];
                attn_load_q(Pb, tq, PC_QC + 64 * h, hi, qf);
                st.m = sink; st.l = (hi == 0) ? 1.f : 0.f;
                attn_segment<1>(Pb, PC_KC + 64 * hk, PC_VC + 64 * hk, 127, qt * 32 - 128, 5, tq, qf, st, vl, lane);
                attn_store_o(Pb, tq, PC_QC + 64 * h, hi, st, dry);
            }
        }
    }
}

__device__ __forceinline__ void st_sc1_16(void* p, u32x4 v) { *(u32x4*)p = v; }
__device__ __forceinline__ void mixa2_store_partial(unsigned char* __restrict__ AO2, float* __restrict__ ALSE, int pat2, size_t tok, int bh, int t, int h, int hi, AttState& st) {
    const float l = st.l + __shfl_xor(st.l, 32);
    const float inv = 1.0f / l;
    unsigned char* op = AO2 + (((size_t)pat2 * T + tok) * 6 + h) * 128 + hi * 64;
    u32x4 a, b;
    a.x = cvtpk(st.o0[0] * inv, st.o0[1] * inv); a.y = cvtpk(st.o0[2] * inv, st.o0[3] * inv); a.z = cvtpk(st.o0[4] * inv, st.o0[5] * inv); a.w = cvtpk(st.o0[6] * inv, st.o0[7] * inv);
    b.x = cvtpk(st.o0[8] * inv, st.o0[9] * inv); b.y = cvtpk(st.o0[10] * inv, st.o0[11] * inv); b.z = cvtpk(st.o0[12] * inv, st.o0[13] * inv); b.w = cvtpk(st.o0[14] * inv, st.o0[15] * inv);
    st_sc1_16(op, a); st_sc1_16(op + 16, b);
    a.x = cvtpk(st.o1[0] * inv, st.o1[1] * inv); a.y = cvtpk(st.o1[2] * inv, st.o1[3] * inv); a.z = cvtpk(st.o1[4] * inv, st.o1[5] * inv); a.w = cvtpk(st.o1[6] * inv, st.o1[7] * inv);
    b.x = cvtpk(st.o1[8] * inv, st.o1[9] * inv); b.y = cvtpk(st.o1[10] * inv, st.o1[11] * inv); b.z = cvtpk(st.o1[12] * inv, st.o1[13] * inv); b.w = cvtpk(st.o1[14] * inv, st.o1[15] * inv);
    st_sc1_16(op + 32, a); st_sc1_16(op + 48, b);
    if (hi == 0) ALSE[((size_t)pat2 * (BATCH * 6) + bh) * SEQ + t] = st.m + __builtin_amdgcn_logf(l);
}
__device__ __forceinline__ void mixa2_combine_store(bf16_t* __restrict__ Pb, const unsigned char* __restrict__ AO2, const float* __restrict__ ALSE, size_t tok, int bh, int t, int h, int hi, AttState& st) {
    const float l0 = st.l + __shfl_xor(st.l, 32);
    const float lse0 = st.m + __builtin_amdgcn_logf(l0);
    const float lse1 = ALSE[((size_t)0 * (BATCH * 6) + bh) * SEQ + t], lse2 = ALSE[((size_t)1 * (BATCH * 6) + bh) * SEQ + t];
    const float mx = fmaxf(lse0, fmaxf(lse1, lse2));
    const float w0 = __builtin_amdgcn_exp2f(lse0 - mx), w1 = __builtin_amdgcn_exp2f(lse1 - mx), w2 = __builtin_amdgcn_exp2f(lse2 - mx);
    const float iw = 1.0f / (w0 + w1 + w2);
    const float c0 = w0 * iw / l0, c1 = w1 * iw, c2 = w2 * iw;
    const unsigned char* p1 = AO2 + (((size_t)0 * T + tok) * 6 + h) * 128 + hi * 64;
    const unsigned char* p2 = AO2 + (((size_t)1 * T + tok) * 6 + h) * 128 + hi * 64;
    const u32x4 a1 = *(const u32x4*)p1, b1 = *(const u32x4*)(p1 + 16), c1v = *(const u32x4*)(p1 + 32), d1 = *(const u32x4*)(p1 + 48);
    const u32x4 a2 = *(const u32x4*)p2, b2 = *(const u32x4*)(p2 + 16), c2v = *(const u32x4*)(p2 + 32), d2 = *(const u32x4*)(p2 + 48);
    const unsigned q1[16] = {a1.x, a1.y, a1.z, a1.w, b1.x, b1.y, b1.z, b1.w, c1v.x, c1v.y, c1v.z, c1v.w, d1.x, d1.y, d1.z, d1.w};
    const unsigned q2[16] = {a2.x, a2.y, a2.z, a2.w, b2.x, b2.y, b2.z, b2.w, c2v.x, c2v.y, c2v.z, c2v.w, d2.x, d2.y, d2.z, d2.w};
    float r0[16], r1[16];
#pragma unroll
    for (int j = 0; j < 8; ++j) {
        r0[2 * j] = fmaf(c0, st.o0[2 * j], fmaf(c1, bflo(q1[j]), c2 * bflo(q2[j]))); r0[2 * j + 1] = fmaf(c0, st.o0[2 * j + 1], fmaf(c1, bfhi(q1[j]), c2 * bfhi(q2[j])));
        r1[2 * j] = fmaf(c0, st.o1[2 * j], fmaf(c1, bflo(q1[8 + j]), c2 * bflo(q2[8 + j]))); r1[2 * j + 1] = fmaf(c0, st.o1[2 * j + 1], fmaf(c1, bfhi(q1[8 + j]), c2 * bfhi(q2[8 + j])));
    }
    bf16_t* op = Pb + (size_t)t * NP + PC_QA + 64 * h + 4 * hi;
#pragma unroll
    for (int g = 0; g < 4; ++g) {
        u32x2 x0, x1;
        x0.x = cvtpk(r0[4 * g], r0[4 * g + 1]); x0.y = cvtpk(r0[4 * g + 2], r0[4 * g + 3]);
        x1.x = cvtpk(r1[4 * g], r1[4 * g + 1]); x1.y = cvtpk(r1[4 * g + 2], r1[4 * g + 3]);
        *(u32x2*)(op + 8 * g) = x0; *(u32x2*)(op + 32 + 8 * g) = x1;
    }
}
__device__ __forceinline__ void attention_phase_v2(unsigned char* __restrict__ ws, const float* __restrict__ sinks, int ctr_word, int kmax_word, LAS unsigned char* lds, int wave, int lane, int half) {
    LAS unsigned char* vl = lds + wave * ATT_WAVE_LDS;
    const int hi = lane >> 5, l31 = lane & 31;
    constexpr int NUB = 3072 / BQP, NUP = 6144 / 4, NUC = 6144 / CQT, NU1 = 6144 / 4;
    const unsigned ntot = half == 0 ? (unsigned)(NUB + 2 * NUP) : (unsigned)(NUC + NU1);
    for (;;) {
        unsigned u = 0;
        if (lane == 0) u = atomicAdd((unsigned*)ws + ctr_word + half, 1u);
        u = __builtin_amdgcn_readfirstlane(u);
        if (u >= ntot) break;
        if (half == 0 && u < (unsigned)NUB) {
            const int bh = (int)(u % 24), b = bh / 6, h = bh % 6;
            for (int sub = 0; sub < BQP; ++sub) {
                const int qp = 127 - (int)(u / 24) * BQP - sub;
                attn_fox_pair(ATT_P + (size_t)b * SEQ * NP, ATT_CUMT + (size_t)bh * SEQ, ((const float*)ws)[kmax_word + bh], h, qp, vl, lane, 0);
            }
        } else if (half == 0) {
            const int v = (int)u - NUB;
            const int pat2 = v / NUP, w_ = v - pat2 * NUP, bh = w_ >> 6, xg = w_ & 63, b = bh / 6, h = bh % 6;
            const int r = pat2 == 0 ? 16 : 4;
            bf16_t* Pb = ATT_P + (size_t)b * SEQ * NP;
            for (int sub = 0; sub < 4; ++sub) {
                const int x_ = 4 * xg + sub;
                const int rho = pat2 == 0 ? (x_ & 15) : (x_ & 3), cb = pat2 == 0 ? (x_ >> 4) : (x_ >> 2);
                const int tq0 = rho + r * 32 * cb, tq = tq0 + r * l31;
                AttState st; att_init(st); bf16x8 qf[4];
                attn_load_q(Pb, tq, PC_QA + 64 * h, hi, qf);
                if (pat2 == 0) attn_segment<16>(Pb, PC_KA + 64 * h, PC_VA + 64 * h, 2048, tq0 - 2048, 5, tq, qf, st, vl, lane);
                else           attn_segment<4>(Pb, PC_KA + 64 * h, PC_VA + 64 * h, 512, tq0 - 512, 5, tq, qf, st, vl, lane);
                mixa2_store_partial(ws + WS_AO, ATT_ALSE, pat2, (size_t)b * SEQ + tq, bh, tq, h, hi, st);
            }
        } else if (u < (unsigned)NUC) {
            const int v = (int)u;
            const int bh = v / (256 / CQT), qg = v - bh * (256 / CQT), b = bh / 6, h = bh % 6, hk = h / 3;
            bf16_t* Pb = ATT_P + (size_t)b * SEQ * NP;
            const float sink = sinks[h] * LOG2E;
            for (int sub = 0; sub < CQT; ++sub) {
                const int qt = qg * CQT + sub;
                const int tq = qt * 32 + l31;
                AttState st; att_init(st); bf16x8 qf[4];
                attn_load_q(Pb, tq, PC_QC + 64 * h, hi, qf);
                st.m = sink; st.l = (hi == 0) ? 1.f : 0.f;
                attn_segment<1>(Pb, PC_KC + 64 * hk, PC_VC + 64 * hk, 127, qt * 32 - 128, 5, tq, qf, st, vl, lane);
                attn_store_o(Pb, tq, PC_QC + 64 * h, hi, st, 0);
            }
        } else {
            const int v = (int)u - NUC;
            const int bh = v >> 6, qg = v & 63, b = bh / 6, h = bh % 6;
            bf16_t* Pb = ATT_P + (size_t)b * SEQ * NP;
            for (int sub = 0; sub < 4; ++sub) {
                const int qt = 4 * qg + sub;
                const int tq = qt * 32 + l31;
                AttState st; att_init(st); bf16x8 qf[4];
                attn_load_q(Pb, tq, PC_QA + 64 * h, hi, qf);
                attn_segment<1>(Pb, PC_KA + 64 * h, PC_VA + 64 * h, 128, qt * 32 - 128, 5, tq, qf, st, vl, lane);
                mixa2_combine_store(Pb, ws + WS_AO, ATT_ALSE, (size_t)b * SEQ + tq, bh, tq, h, hi, st);
            }
        }
    }
}

#ifndef ATT_XCD
#define ATT_XCD 0
#endif
__device__ __forceinline__ void attention_phase_x(unsigned char* __restrict__ ws, const float* __restrict__ sinks, int ctr_word  , int kmax_word, LAS unsigned char* lds, int wave, int lane, int xcc) {
    LAS unsigned char* vl = lds + wave * ATT_WAVE_LDS;
    const int hi = lane >> 5, l31 = lane & 31;
    constexpr int QB = 3 * 128, QA = 3 * 256, QC = 3 * 256, QN = QB + QA + QC;
    int q = xcc & 7;
    int tried = 0;
    for (;;) {
        unsigned j = 0;
        if (lane == 0) j = atomicAdd((unsigned*)ws + ctr_word + q, 1u);
        j = __builtin_amdgcn_readfirstlane(j);
        if (j >= (unsigned)QN) {
            tried |= 1 << q;
            if (tried == 0xff) break;
            const unsigned cv = ((volatile const unsigned*)ws)[ctr_word + (lane & 7)];
            int nq = -1;
#pragma unroll
            for (int k = 1; k < 8; ++k) { const int qq = (q + k) & 7; const unsigned c_ = (unsigned)__builtin_amdgcn_readlane((int)cv, qq); if (nq < 0 && !((tried >> qq) & 1)) { if (c_ < (unsigned)QN) nq = qq; else tried |= 1 << qq; } }
            if (nq < 0) break;
            q = nq; continue;
        }
        if (j < (unsigned)QB) {
            const int bh = q + 8 * (int)(j >> 7), qp = 127 - (int)(j & 127), b = bh / 6, h = bh % 6;
            attn_fox_pair(ATT_P + (size_t)b * SEQ * NP, ATT_CUMT + (size_t)bh * SEQ, ((const float*)ws)[kmax_word + bh], h, qp, vl, lane, 0);
        } else if (j < (unsigned)(QB + QA)) {
            const int jj = (int)j - QB, bh = q + 8 * (jj >> 8), v = jj & 255, b = bh / 6, h = bh % 6;
            const int cb = v & 15, rho = v >> 4;
            bf16_t* Pb = ATT_P + (size_t)b * SEQ * NP;
            const int tq0 = rho + 512 * cb, tq = tq0 + 16 * l31;
            AttState st; att_init(st); bf16x8 qf[4];
            attn_load_q(Pb, tq, PC_QA + 64 * h, hi, qf);
            attn_segment<16>(Pb, PC_KA + 64 * h, PC_VA + 64 * h, 2048, tq0 - 2048, 5, tq, qf, st, vl, lane);
            attn_segment<4>(Pb, PC_KA + 64 * h, PC_VA + 64 * h, 512, tq0 - 512, 8, tq, qf, st, vl, lane);
            attn_segment<1>(Pb, PC_KA + 64 * h, PC_VA + 64 * h, 128, tq0 - 128, 20, tq, qf, st, vl, lane);
            attn_store_o(Pb, tq, PC_QA + 64 * h, hi, st, 0);
        } else {
            const int jj = (int)j - QB - QA, bh = q + 8 * (jj >> 8), qt = jj & 255, b = bh / 6, h = bh % 6, hk = h / 3;
            bf16_t* Pb = ATT_P + (size_t)b * SEQ * NP;
            const int tq = qt * 32 + l31;
            AttState st; att_init(st); bf16x8 qf[4];
            attn_load_q(Pb, tq, PC_QC + 64 * h, hi, qf);
            st.m = sinks[h] * LOG2E; st.l = (hi == 0) ? 1.f : 0.f;
            attn_segment<1>(Pb, PC_KC + 64 * hk, PC_VC + 64 * hk, 127, qt * 32 - 128, 5, tq, qf, st, vl, lane);
            attn_store_o(Pb, tq, PC_QC + 64 * h, hi, st, 0);
        }
    }
}

__device__ __forceinline__ int f2key(float f) { const int b = __float_as_int(f); return b ^ ((b >> 31) & 0x7fffffff); }
__device__ __forceinline__ float key2f(int k) { return __int_as_float(k ^ ((k >> 31) & 0x7fffffff)); }
#define CE_DESC(a, x) do { const int hi_ = max((a), (x)); (x) = min((a), (x)); (a) = hi_; } while (0)

__device__ __forceinline__ void route_half(const bf16_t* __restrict__ qrow, const LAS unsigned char* kl, int (&list)[16]) {
    unsigned qh[64];
#pragma unroll
    for (int c = 0; c < 16; ++c) { const u32x4 t = *(const u32x4*)(qrow + 8 * c); qh[4 * c] = t.x; qh[4 * c + 1] = t.y; qh[4 * c + 2] = t.z; qh[4 * c + 3] = t.w; }
#pragma unroll
    for (int i = 0; i < 16; ++i) list[i] = (int)0x80000000;
    for (int key = 0; key < 128; ++key) {
        float a0 = 0.f, a1 = 0.f;
        const LAS unsigned char* kp = kl + key * 256;
#pragma unroll
        for (int c = 0; c < 16; ++c) {
            const u32x4 kk = *(const LAS u32x4*)(kp + 16 * c);
            a0 = dot2bf(qh[4 * c], kk.x, a0); a1 = dot2bf(qh[4 * c + 1], kk.y, a1);
            a0 = dot2bf(qh[4 * c + 2], kk.z, a0); a1 = dot2bf(qh[4 * c + 3], kk.w, a1);
        }
        int x = (f2key(a0 + a1) & ~127) | key;
#pragma unroll
        for (int i = 0; i < 16; ++i) CE_DESC(list[i], x);
    }
}

__device__ __forceinline__ void routing_phase(const bf16_t* __restrict__ Q2, const float* __restrict__ k1, const float* __restrict__ k2, int* __restrict__ ids, float* __restrict__ gw,
                                              LAS unsigned char* lds, int tid) {
    for (int e = tid; e < 2 * 8192; e += 512) {
        const int hf = e >> 13, o = (e & 8191) * 2;
        const float* src = (hf ? k2 : k1) + o;
        *(LAS unsigned*)(lds + hf * 32768 + o * 2) = cvtpk(src[0], src[1]);
    }
    __syncthreads();
    const int nthreads = gridDim.x * 512;
    for (int it = blockIdx.x * 512 + tid; it < T * 8; it += nthreads) {
        const int t = it >> 3, h = it & 7;
        const bf16_t* qrow = Q2 + (size_t)t * 2048 + h * 256;
        int l1[16], l2[16];
        route_half(qrow, lds, l1);
        route_half(qrow + 128, lds + 32768, l2);
        float f1[16], f2[16];
#pragma unroll
        for (int i = 0; i < 16; ++i) { f1[i] = key2f(l1[i] & ~127); f2[i] = key2f(l2[i] & ~127); }
        int cl[16];
#pragma unroll
        for (int j = 0; j < 16; ++j) cl[j] = (f2key(f1[0] + f2[j]) & ~255) | j;
#pragma unroll
        for (int i = 1; i < 16; ++i) {
#pragma unroll
            for (int j = 0; j < 16; ++j) {
                if ((i + 1) * (j + 1) <= 16) {
                    int x = (f2key(f1[i] + f2[j]) & ~255) | (i * 16 + j);
#pragma unroll
                    for (int k = 0; k < 16; ++k) CE_DESC(cl[k], x);
                }
            }
        }
        float sc[16]; int idv[16];
#pragma unroll
        for (int k = 0; k < 16; ++k) {
            sc[k] = key2f(cl[k] & ~255);
            const int pi = (cl[k] >> 4) & 15, pj = cl[k] & 15;
            int a = 0, b = 0;
#pragma unroll
            for (int i = 0; i < 16; ++i) { a = (pi == i) ? (l1[i] & 127) : a; b = (pj == i) ? (l2[i] & 127) : b; }
            idv[k] = a * 128 + b;
        }
        float e[16], sum = 0.f;
#pragma unroll
        for (int k = 0; k < 16; ++k) { e[k] = __expf(sc[k] - sc[0]); sum += e[k]; }
        const float inv = 1.0f / sum;
        int* ip = ids + (size_t)it * 16; float* gp = gw + (size_t)it * 16;
#pragma unroll
        for (int k = 0; k < 16; k += 4) {
            *(int4*)(ip + k) = make_int4(idv[k], idv[k + 1], idv[k + 2], idv[k + 3]);
            *(float4*)(gp + k) = make_float4(e[k] * inv, e[k + 1] * inv, e[k + 2] * inv, e[k + 3] * inv);
        }
    }
}

__device__ __forceinline__ float gelu_erf(float x);
constexpr int KPITCH = 272;
constexpr int R2_K_BYTES = 2 * 128 * KPITCH;
#define CE_MAXMIN(a, b) do { const int hi_ = max((a), (b)); const int lo_ = min((a), (b)); (a) = hi_; (b) = lo_; } while (0)
__device__ __forceinline__ void bitonic_merge16_desc(int (&a)[16]) {
#pragma unroll
    for (int js = 3; js >= 0; --js) {
#pragma unroll
        for (int i = 0; i < 16; ++i) { const int l = i ^ (1 << js); if (l > i) CE_MAXMIN(a[i], a[l]); }
    }
}
__device__ __forceinline__ void bitonic_sort16_desc(int (&a)[16]) {
#pragma unroll
    for (int ks = 1; ks <= 4; ++ks) {
#pragma unroll
        for (int js = ks - 1; js >= 0; --js) {
#pragma unroll
            for (int i = 0; i < 16; ++i) { const int l = i ^ (1 << js);
                if (l > i) { if ((i & (1 << ks)) == 0) CE_MAXMIN(a[i], a[l]); else CE_MAXMIN(a[l], a[i]); } }
        }
    }
}
__device__ __forceinline__ void merge_top16(int (&a)[16], const int (&b)[16]) {
#pragma unroll
    for (int i = 0; i < 16; ++i) a[i] = max(a[i], b[15 - i]);
    bitonic_merge16_desc(a);
}
__device__ __forceinline__ void route2_half(const bf16_t* __restrict__ qrow  , const LAS unsigned char* kl  , int hi, int (&L)[16]) {
    f32x16 acc[4];
#pragma unroll
    for (int kt = 0; kt < 4; ++kt)
#pragma unroll
        for (int r = 0; r < 16; ++r) acc[kt][r] = 0.f;
    bf16x8 qf[8];
#pragma unroll
    for (int s = 0; s < 8; ++s) qf[s] = *(const bf16x8*)(qrow + 16 * s);
#pragma unroll
    for (int s = 0; s < 8; ++s) {
#pragma unroll
        for (int kt = 0; kt < 4; ++kt) {
            const bf16x8 kf = *(const LAS bf16x8*)(kl + kt * 32 * KPITCH + 32 * s);
            acc[kt] = __builtin_amdgcn_mfma_f32_32x32x16_bf16(kf, qf[s], acc[kt], 0, 0, 0);
        }
    }
    int kk[4][16];
    const int hi4 = 4 * hi;
#pragma unroll
    for (int kt = 0; kt < 4; ++kt)
#pragma unroll
        for (int r = 0; r < 16; ++r) kk[kt][r] = (f2key(acc[kt][r]) & ~127) | ((32 * kt + (r & 3) + 8 * (r >> 2)) | hi4);
#pragma unroll
    for (int kt = 0; kt < 4; ++kt) bitonic_sort16_desc(kk[kt]);
    merge_top16(kk[0], kk[1]); merge_top16(kk[2], kk[3]); merge_top16(kk[0], kk[2]);
#pragma unroll
    for (int i = 0; i < 16; ++i) L[i] = max(kk[0][i], __shfl_xor(kk[0][15 - i], 32));
    bitonic_merge16_desc(L);
}

__device__ __forceinline__ void routing2_setup(const float* __restrict__ k1, const float* __restrict__ k2, LAS unsigned char* lds, int tid) {
    for (int e = tid; e < 2 * 8192; e += 512) {
        const int hf = e >> 13, o = (e & 8191) * 2, key = o >> 7, d = o & 127;
        const float* src = (hf ? k2 : k1) + o;
        *(LAS unsigned*)(lds + hf * 128 * KPITCH + key * KPITCH + d * 2) = cvtpk(src[0], src[1]);
    }
    __syncthreads();
}
__device__ __forceinline__ void routing2_units(const bf16_t* __restrict__ Q2, int* __restrict__ ids, float* __restrict__ gw,
                                               LAS unsigned char* lds, int wave, int lane, int gwave, int ngw) {
    LAS unsigned char* scr = lds + R2_K_BYTES + wave * 2048 + lane * 32;
    const int hi = lane >> 5, l31 = lane & 31;
    for (int u = (gwave < 0 ? wave : gwave); u < (gwave < 0 ? 32 : (T / 32) * 8); u += (gwave < 0 ? 8 : ngw)) {
        const int tb = gwave < 0 ? (int)blockIdx.x * 4 + (u >> 3) : (u >> 3), h = u & 7;
        const int t = tb * 32 + l31;
        const bf16_t* qrow = Q2 + (size_t)t * 2048 + h * 256 + 8 * hi;
        int l1[16], l2[16];
        route2_half(qrow, lds + l31 * KPITCH + 16 * hi, hi, l1);
        route2_half(qrow + 128, lds + 128 * KPITCH + l31 * KPITCH + 16 * hi, hi, l2);
#pragma unroll
        for (int i = 0; i < 16; i += 4) {
            *(LAS unsigned*)(scr + i) = (unsigned)(l1[i] & 127) | ((unsigned)(l1[i + 1] & 127) << 8) | ((unsigned)(l1[i + 2] & 127) << 16) | ((unsigned)(l1[i + 3] & 127) << 24);
            *(LAS unsigned*)(scr + 16 + i) = (unsigned)(l2[i] & 127) | ((unsigned)(l2[i + 1] & 127) << 8) | ((unsigned)(l2[i + 2] & 127) << 16) | ((unsigned)(l2[i + 3] & 127) << 24);
        }
        float f1[16], f2[16];
#pragma unroll
        for (int i = 0; i < 16; ++i) { f1[i] = key2f(l1[i] & ~127); f2[i] = key2f(l2[i] & ~127); }
        int cl[16];
#pragma unroll
        for (int j = 0; j < 16; ++j) cl[j] = (f2key(f1[0] + f2[j]) & ~255) | (255 - j);
#pragma unroll
        for (int i = 1; i < 16; ++i) {
#pragma unroll
            for (int j = 0; j < 16; ++j) {
                if ((i + 1) * (j + 1) <= 16) {
                    int x = (f2key(f1[i] + f2[j]) & ~255) | (255 - (i * 16 + j));
#pragma unroll
                    for (int k = (i + 1) * (j + 1) - 1; k < 16; ++k) CE_DESC(cl[k], x);
                }
            }
        }
        float e[16], sum = 0.f;
        const float mx = key2f(cl[0] & ~255);
#pragma unroll
        for (int k = 0; k < 16; ++k) { e[k] = __expf(key2f(cl[k] & ~255) - mx); sum += e[k]; }
        const float inv = 1.0f / sum;
        asm volatile("s_waitcnt lgkmcnt(0)" ::: "memory");
        int idv[8]; float gv[8];
#pragma unroll
        for (int k = 0; k < 8; ++k) {
            const int c = 255 - ((hi ? cl[8 + k] : cl[k]) & 255);
            gv[k] = (hi ? e[8 + k] : e[k]) * inv;
            const int pi = (c >> 4) & 15, pj = c & 15;
            const int a = *(const LAS unsigned char*)(scr + pi), b = *(const LAS unsigned char*)(scr + 16 + pj);
            idv[k] = a * 128 + b;
        }
        int* ip = ids + ((size_t)t * 8 + h) * 16 + 8 * hi; float* gp = gw + ((size_t)t * 8 + h) * 16 + 8 * hi;
        *(int4*)(ip) = make_int4(idv[0], idv[1], idv[2], idv[3]); *(int4*)(ip + 4) = make_int4(idv[4], idv[5], idv[6], idv[7]);
        *(float4*)(gp) = make_float4(gv[0], gv[1], gv[2], gv[3]); *(float4*)(gp + 4) = make_float4(gv[4], gv[5], gv[6], gv[7]);
        asm volatile("s_waitcnt lgkmcnt(0)" ::: "memory");
    }
}

typedef __bf16 bf16x2v_t __attribute__((ext_vector_type(2)));
__device__ __forceinline__ float dot2(unsigned a, unsigned b, float acc) { return __builtin_amdgcn_fdot2_f32_bf16(__builtin_bit_cast(bf16x2v_t, a), __builtin_bit_cast(bf16x2v_t, b), acc, false); }
template <int CTRL> __device__ __forceinline__ float dpp_add(float v) { return v + __builtin_bit_cast(float, __builtin_amdgcn_update_dpp(0, __builtin_bit_cast(int, v), CTRL, 0xF, 0xF, true)); }
__device__ __forceinline__ float xor16_add(float v) { return v + __builtin_bit_cast(float, __builtin_amdgcn_ds_swizzle(__builtin_bit_cast(int, v), 0x401F)); }
__device__ __forceinline__ float xor32_add(float v) { return v + __shfl_xor(v, 32); }
constexpr int G2_WAVE_LDS = 4096 + 8192 + 128;

__device__ __forceinline__ void gather2_phase(float* __restrict__ H, bf16_t* __restrict__ HB, const float* __restrict__ ssq2p, float* __restrict__ ssq1,
                                              const bf16_t* __restrict__ U16, const bf16_t* __restrict__ V16, const int* __restrict__ ids, const float* __restrict__ gw,
                                              const float* __restrict__ final_g, int last, LAS unsigned char* lds, int wave, int gwave, int lane) {
    LAS unsigned char* wl = lds + wave * G2_WAVE_LDS;
    LAS unsigned short* idl = (LAS unsigned short*)wl;
    LAS float* al = (LAS float*)(wl + 4096);
    const int t0 = __builtin_amdgcn_readfirstlane(gwave * 16);
    const int g = lane >> 3, p = lane & 7;
    for (int tt = 0; tt < 16; ++tt) {
#pragma unroll
        for (int hf = 0; hf < 2; ++hf) { const int k = lane + 64 * hf; idl[tt * 128 + (k & 7) * 16 + (k >> 3)] = (unsigned short)ids[(size_t)(t0 + tt) * 128 + k]; }
    }
    for (int e = lane; e < 2048; e += 64) al[e] = 0.f;
    asm volatile("s_waitcnt lgkmcnt(0)" ::: "memory");
    const unsigned char* Ub = (const unsigned char*)U16; const unsigned char* Vb = (const unsigned char*)V16;
    for (int c = 0; c < 16; ++c) {
        for (int tt = 0; tt < 16; ++tt) {
            const u32x4 x4 = *(const u32x4*)(HB + (size_t)(t0 + tt) * DM + 64 * c + 8 * p);
            const u32x4 i0 = *(const LAS u32x4*)(idl + tt * 128 + g * 16), i1 = *(const LAS u32x4*)(idl + tt * 128 + g * 16 + 8);
            const unsigned idw[8] = {i0.x, i0.y, i0.z, i0.w, i1.x, i1.y, i1.z, i1.w};
            u32x4 u[16];
#pragma unroll
            for (int i = 0; i < 16; ++i) { const unsigned id = (i & 1) ? (idw[i >> 1] >> 16) : (idw[i >> 1] & 0xffffu);
                u[i] = *(const u32x4*)(Ub + (size_t)(id * 2048u + (unsigned)(c * 128 + p * 16))); }
            float a[16];
#pragma unroll
            for (int i = 0; i < 16; ++i) {
                float s = dot2(x4.x, u[i].x, 0.f); s = dot2(x4.y, u[i].y, s); s = dot2(x4.z, u[i].z, s); s = dot2(x4.w, u[i].w, s);
                s = dpp_add<0xB1>(s); s = dpp_add<0x4E>(s); s = dpp_add<0x141>(s);
                a[i] = s;
            }
            if (p == 0) {
                LAS float* ap = al + tt * 128 + g * 16;
#pragma unroll
                for (int i = 0; i < 16; ++i) (void)__hip_atomic_fetch_add(ap + i, a[i], __ATOMIC_RELAXED, __HIP_MEMORY_SCOPE_WORKGROUP);
            }
        }
    }
    asm volatile("s_waitcnt lgkmcnt(0)" ::: "memory");
    for (int n = 0; n < 32; ++n) {
        const int tt = n >> 1, pos = lane + 64 * (n & 1), k = 8 * (pos & 15) + (pos >> 4);
        const float rs2 = rsqrtf(ssq16(ssq2p, t0 + tt) * (1.0f / 1024.0f) + RMS_EPS);
        const float a = al[tt * 128 + pos] * rs2;
        al[tt * 128 + pos] = gw[(size_t)(t0 + tt) * 128 + k] * gelu_erf(a);
    }
    asm volatile("s_waitcnt lgkmcnt(0)" ::: "memory");
    for (int c = 0; c < 16; ++c) {
        for (int tt = 0; tt < 16; ++tt) {
            const LAS f32x4* wp = (const LAS f32x4*)(al + tt * 128 + g * 16);
            const f32x4 w0 = wp[0], w1 = wp[1], w2 = wp[2], w3 = wp[3];
            const float w[16] = {w0[0], w0[1], w0[2], w0[3], w1[0], w1[1], w1[2], w1[3], w2[0], w2[1], w2[2], w2[3], w3[0], w3[1], w3[2], w3[3]};
            const u32x4 i0 = *(const LAS u32x4*)(idl + tt * 128 + g * 16), i1 = *(const LAS u32x4*)(idl + tt * 128 + g * 16 + 8);
            const unsigned idw[8] = {i0.x, i0.y, i0.z, i0.w, i1.x, i1.y, i1.z, i1.w};
            u32x4 v[16];
#pragma unroll
            for (int i = 0; i < 16; ++i) { const unsigned id = (i & 1) ? (idw[i >> 1] >> 16) : (idw[i >> 1] & 0xffffu);
                v[i] = *(const u32x4*)(Vb + (size_t)(id * 2048u + (unsigned)(c * 128 + p * 16))); }
            float y[8];
#pragma unroll
            for (int j = 0; j < 8; ++j) y[j] = 0.f;
#pragma unroll
            for (int i = 0; i < 16; ++i) {
                y[0] = fmaf(w[i], bflo(v[i].x), y[0]); y[1] = fmaf(w[i], bfhi(v[i].x), y[1]); y[2] = fmaf(w[i], bflo(v[i].y), y[2]); y[3] = fmaf(w[i], bfhi(v[i].y), y[3]);
                y[4] = fmaf(w[i], bflo(v[i].z), y[4]); y[5] = fmaf(w[i], bfhi(v[i].z), y[5]); y[6] = fmaf(w[i], bflo(v[i].w), y[6]); y[7] = fmaf(w[i], bfhi(v[i].w), y[7]);
            }
#pragma unroll
            for (int j = 0; j < 8; ++j) { y[j] = dpp_add<0x128>(y[j]); y[j] = xor16_add(y[j]); y[j] = xor32_add(y[j]); }
            if (g == 0) {
                float* hp = H + (size_t)(t0 + tt) * DM + 64 * c + 8 * p;
                f32x4 h0 = *(const f32x4*)hp, h1 = *(const f32x4*)(hp + 4);
                h0 += (f32x4){y[0], y[1], y[2], y[3]}; h1 += (f32x4){y[4], y[5], y[6], y[7]};
                *(f32x4*)hp = h0; *(f32x4*)(hp + 4) = h1;
            }
        }
    }
    __builtin_amdgcn_fence(__ATOMIC_SEQ_CST, "agent");
    asm volatile("s_waitcnt vmcnt(0)" ::: "memory");
    for (int tt = 0; tt < 16; ++tt) {
        const int t = t0 + tt;
        float* hp = H + (size_t)t * DM + 8 * lane;
        f32x4 h0 = *(const f32x4*)hp, h1 = *(const f32x4*)(hp + 4), h2 = *(const f32x4*)(hp + 512), h3 = *(const f32x4*)(hp + 516);
        float ss = (h0[0] * h0[0] + h0[1] * h0[1]) + (h0[2] * h0[2] + h0[3] * h0[3]) + (h1[0] * h1[0] + h1[1] * h1[1]) + (h1[2] * h1[2] + h1[3] * h1[3])
                 + (h2[0] * h2[0] + h2[1] * h2[1]) + (h2[2] * h2[2] + h2[3] * h2[3]) + (h3[0] * h3[0] + h3[1] * h3[1]) + (h3[2] * h3[2] + h3[3] * h3[3]);
        ss = wave_sum(ss);
        if (last) {
            const float rs = rsqrtf(ss * (1.0f / 1024.0f) + RMS_EPS);
            const f32x4 g0 = *(const f32x4*)(final_g + 8 * lane), g1 = *(const f32x4*)(final_g + 8 * lane + 4), g2 = *(const f32x4*)(final_g + 512 + 8 * lane), g3 = *(const f32x4*)(final_g + 516 + 8 * lane);
            h0 = h0 * rs * g0; h1 = h1 * rs * g1; h2 = h2 * rs * g2; h3 = h3 * rs * g3;
            *(f32x4*)hp = h0; *(f32x4*)(hp + 4) = h1; *(f32x4*)(hp + 512) = h2; *(f32x4*)(hp + 516) = h3;
        } else {
            bf16_t* bp = HB + (size_t)t * DM + 8 * lane;
            u32x4 w; w.x = cvtpk(h0[0], h0[1]); w.y = cvtpk(h0[2], h0[3]); w.z = cvtpk(h1[0], h1[1]); w.w = cvtpk(h1[2], h1[3]);
            *(u32x4*)bp = w;
            w.x = cvtpk(h2[0], h2[1]); w.y = cvtpk(h2[2], h2[3]); w.z = cvtpk(h3[0], h3[1]); w.w = cvtpk(h3[2], h3[3]);
            *(u32x4*)(bp + 512) = w;
            if (lane == 0) ssq1[t] = ss;
        }
    }
}

#ifndef G3_UMFMA
#define G3_UMFMA 0
#endif
#ifndef G3_VF16
#define G3_VF16 1
#endif
typedef _Float16 f16x2_t __attribute__((ext_vector_type(2)));
__device__ __forceinline__ unsigned cvtpk_h(float lo, float hi) { f16x2_t v = {(_Float16)lo, (_Float16)hi}; return __builtin_bit_cast(unsigned, v); }
__device__ __forceinline__ void fma_mix_lo(float& y, float w, unsigned pk) { asm("v_fma_mix_f32 %0, %1, %2, %0 op_sel_hi:[0,1,0]" : "+v"(y) : "v"(w), "v"(pk)); }
__device__ __forceinline__ void fma_mix_hi(float& y, float w, unsigned pk) { asm("v_fma_mix_f32 %0, %1, %2, %0 op_sel:[0,1,0] op_sel_hi:[0,1,0]" : "+v"(y) : "v"(w), "v"(pk)); }
__device__ __forceinline__ float swap32_add(float a, float b) {
    const auto r = __builtin_amdgcn_permlane32_swap(__float_as_uint(a), __float_as_uint(b), false, false);
    return __uint_as_float(r[0]) + __uint_as_float(r[1]);
}

__device__ __forceinline__ void gather3_phase(float* __restrict__ H, bf16_t* __restrict__ HB, const float* __restrict__ ssq2p, float* __restrict__ ssq1,
                                              const bf16_t* __restrict__ U16, const unsigned short* __restrict__ V16h, const int* __restrict__ ids, const float* __restrict__ gw,
                                              const float* __restrict__ final_g, int last, LAS unsigned char* lds, int wave, int gwave, int lane) {
    LAS unsigned char* wl = lds + wave * G2_WAVE_LDS;
    LAS unsigned short* idl = (LAS unsigned short*)wl;
    LAS float* al = (LAS float*)(wl + 4096);
    const int t0 = __builtin_amdgcn_readfirstlane(gwave * 16);
    for (int tt = 0; tt < 16; ++tt) {
        idl[tt * 128 + lane] = (unsigned short)ids[(size_t)(t0 + tt) * 128 + lane];
        idl[tt * 128 + 64 + lane] = (unsigned short)ids[(size_t)(t0 + tt) * 128 + 64 + lane];
    }
    for (int e = lane; e < 2048; e += 64) al[e] = 0.f;
    asm volatile("s_waitcnt lgkmcnt(0)" ::: "memory");
    const unsigned char* Ub = (const unsigned char*)U16; const unsigned char* Vb = (const unsigned char*)V16h;
#if G3_UMFMA
    {
        const int e = lane & 15, q = lane >> 4;
        for (int c = 0; c < 16; ++c) {
            for (int tt = 0; tt < 16; ++tt) {
                const bf16_t* xp = HB + (size_t)(t0 + tt) * DM + 64 * c + 8 * q;
                const bf16x8 xa = *(const bf16x8*)xp, xb = *(const bf16x8*)(xp + 32);
                const u32x4 iv = *(const LAS u32x4*)(idl + tt * 128 + 8 * e);
                const unsigned idw[4] = {iv.x, iv.y, iv.z, iv.w};
                bf16x8 ua[8], ub[8];
#pragma unroll
                for (int gi = 0; gi < 8; ++gi) { const unsigned id = (gi & 1) ? (idw[gi >> 1] >> 16) : (idw[gi >> 1] & 0xffffu);
                    const unsigned char* up = Ub + (size_t)(id * 2048u + (unsigned)(c * 128 + q * 16));
                    ua[gi] = *(const bf16x8*)up; ub[gi] = *(const bf16x8*)(up + 64); }
                float r[8];
#pragma unroll
                for (int gi = 0; gi < 8; ++gi) {
                    f32x4 acc = {0.f, 0.f, 0.f, 0.f};
                    acc = __builtin_amdgcn_mfma_f32_16x16x32_bf16(xa, ua[gi], acc, 0, 0, 0);
                    acc = __builtin_amdgcn_mfma_f32_16x16x32_bf16(xb, ub[gi], acc, 0, 0, 0);
                    r[gi] = acc[0];
                }
                if (q == 0) {
                    LAS float* ap = al + tt * 128 + 8 * e;
#pragma unroll
                    for (int gi = 0; gi < 8; ++gi) (void)__hip_atomic_fetch_add(ap + gi, r[gi], __ATOMIC_RELAXED, __HIP_MEMORY_SCOPE_WORKGROUP);
                }
            }
        }
    }
#else
    {
        const int g = lane >> 3, p = lane & 7;
        for (int c = 0; c < 16; ++c) {
            for (int tt = 0; tt < 16; ++tt) {
                const u32x4 x4 = *(const u32x4*)(HB + (size_t)(t0 + tt) * DM + 64 * c + 8 * p);
                const u32x4 i0 = *(const LAS u32x4*)(idl + tt * 128 + g * 16), i1 = *(const LAS u32x4*)(idl + tt * 128 + g * 16 + 8);
                const unsigned idw[8] = {i0.x, i0.y, i0.z, i0.w, i1.x, i1.y, i1.z, i1.w};
                u32x4 u[16];
#pragma unroll
                for (int i = 0; i < 16; ++i) { const unsigned id = (i & 1) ? (idw[i >> 1] >> 16) : (idw[i >> 1] & 0xffffu);
                    u[i] = *(const u32x4*)(Ub + (size_t)(id * 2048u + (unsigned)(c * 128 + p * 16))); }
                float a[16];
#pragma unroll
                for (int i = 0; i < 16; ++i) {
                    float s_ = dot2(x4.x, u[i].x, 0.f); s_ = dot2(x4.y, u[i].y, s_); s_ = dot2(x4.z, u[i].z, s_); s_ = dot2(x4.w, u[i].w, s_);
                    s_ = dpp_add<0xB1>(s_); s_ = dpp_add<0x4E>(s_); s_ = dpp_add<0x141>(s_);
                    a[i] = s_;
                }
                if (p == 0) {
                    LAS float* ap = al + tt * 128 + g * 16;
#pragma unroll
                    for (int i = 0; i < 16; ++i) (void)__hip_atomic_fetch_add(ap + i, a[i], __ATOMIC_RELAXED, __HIP_MEMORY_SCOPE_WORKGROUP);
                }
            }
        }
    }
#endif
    asm volatile("s_waitcnt lgkmcnt(0)" ::: "memory");
    for (int n = 0; n < 32; ++n) {
        const int tt = n >> 1, k = lane + 64 * (n & 1);
        const float rs2 = rsqrtf(ssq16(ssq2p, t0 + tt) * (1.0f / 1024.0f) + RMS_EPS);
        const float a = al[tt * 128 + k] * rs2;
        al[tt * 128 + k] = gw[(size_t)(t0 + tt) * 128 + k] * gelu_erf(a);
    }
    asm volatile("s_waitcnt lgkmcnt(0)" ::: "memory");
    {
        const int g = lane >> 3, p = lane & 7;
        for (int c = 0; c < 16; ++c) {
            for (int tt = 0; tt < 16; ++tt) {
                const LAS f32x4* wp = (const LAS f32x4*)(al + tt * 128 + g * 16);
                const f32x4 w0 = wp[0], w1 = wp[1], w2 = wp[2], w3 = wp[3];
                const float w[16] = {w0[0], w0[1], w0[2], w0[3], w1[0], w1[1], w1[2], w1[3], w2[0], w2[1], w2[2], w2[3], w3[0], w3[1], w3[2], w3[3]};
                const u32x4 i0 = *(const LAS u32x4*)(idl + tt * 128 + g * 16), i1 = *(const LAS u32x4*)(idl + tt * 128 + g * 16 + 8);
                const unsigned idw[8] = {i0.x, i0.y, i0.z, i0.w, i1.x, i1.y, i1.z, i1.w};
                u32x4 v[16];
#pragma unroll
                for (int i = 0; i < 16; ++i) { const unsigned id = (i & 1) ? (idw[i >> 1] >> 16) : (idw[i >> 1] & 0xffffu);
                    v[i] = *(const u32x4*)(Vb + (size_t)(id * 2048u + (unsigned)(c * 128 + p * 16))); }
                float y[8];
#pragma unroll
                for (int j = 0; j < 8; ++j) y[j] = 0.f;
#pragma unroll
                for (int i = 0; i < 16; ++i) {
#if G3_VF16
                    fma_mix_lo(y[0], w[i], v[i].x); fma_mix_hi(y[1], w[i], v[i].x); fma_mix_lo(y[2], w[i], v[i].y); fma_mix_hi(y[3], w[i], v[i].y);
                    fma_mix_lo(y[4], w[i], v[i].z); fma_mix_hi(y[5], w[i], v[i].z); fma_mix_lo(y[6], w[i], v[i].w); fma_mix_hi(y[7], w[i], v[i].w);
#else
                    y[0] = fmaf(w[i], bflo(v[i].x), y[0]); y[1] = fmaf(w[i], bfhi(v[i].x), y[1]); y[2] = fmaf(w[i], bflo(v[i].y), y[2]); y[3] = fmaf(w[i], bfhi(v[i].y), y[3]);
                    y[4] = fmaf(w[i], bflo(v[i].z), y[4]); y[5] = fmaf(w[i], bfhi(v[i].z), y[5]); y[6] = fmaf(w[i], bflo(v[i].w), y[6]); y[7] = fmaf(w[i], bfhi(v[i].w), y[7]);
#endif
                }
                float z[4];
#pragma unroll
                for (int j = 0; j < 4; ++j) { z[j] = swap32_add(y[j], y[j + 4]); z[j] = xor16_add(z[j]); z[j] = dpp_add<0x128>(z[j]); }
                if ((lane & 0x18) == 0) {
                    float* hp = H + (size_t)(t0 + tt) * DM + 64 * c + 8 * p + 4 * (lane >> 5);
                    f32x4 h0 = *(const f32x4*)hp;
                    h0 += (f32x4){z[0], z[1], z[2], z[3]};
                    *(f32x4*)hp = h0;
                }
            }
        }
    }
    __builtin_amdgcn_fence(__ATOMIC_SEQ_CST, "agent");
    asm volatile("s_waitcnt vmcnt(0)" ::: "memory");
    for (int tt = 0; tt < 16; ++tt) {
        const int t = t0 + tt;
        float* hp = H + (size_t)t * DM + 8 * lane;
        f32x4 h0 = *(const f32x4*)hp, h1 = *(const f32x4*)(hp + 4), h2 = *(const f32x4*)(hp + 512), h3 = *(const f32x4*)(hp + 516);
        float ss = (h0[0] * h0[0] + h0[1] * h0[1]) + (h0[2] * h0[2] + h0[3] * h0[3]) + (h1[0] * h1[0] + h1[1] * h1[1]) + (h1[2] * h1[2] + h1[3] * h1[3])
                 + (h2[0] * h2[0] + h2[1] * h2[1]) + (h2[2] * h2[2] + h2[3] * h2[3]) + (h3[0] * h3[0] + h3[1] * h3[1]) + (h3[2] * h3[2] + h3[3] * h3[3]);
        ss = wave_sum(ss);
        if (last) {
            const float rs = rsqrtf(ss * (1.0f / 1024.0f) + RMS_EPS);
            const f32x4 g0 = *(const f32x4*)(final_g + 8 * lane), g1 = *(const f32x4*)(final_g + 8 * lane + 4), g2 = *(const f32x4*)(final_g + 512 + 8 * lane), g3 = *(const f32x4*)(final_g + 516 + 8 * lane);
            h0 = h0 * rs * g0; h1 = h1 * rs * g1; h2 = h2 * rs * g2; h3 = h3 * rs * g3;
            *(f32x4*)hp = h0; *(f32x4*)(hp + 4) = h1; *(f32x4*)(hp + 512) = h2; *(f32x4*)(hp + 516) = h3;
        } else {
            bf16_t* bp = HB + (size_t)t * DM + 8 * lane;
            u32x4 w; w.x = cvtpk(h0[0], h0[1]); w.y = cvtpk(h0[2], h0[3]); w.z = cvtpk(h1[0], h1[1]); w.w = cvtpk(h1[2], h1[3]);
            *(u32x4*)bp = w;
            w.x = cvtpk(h2[0], h2[1]); w.y = cvtpk(h2[2], h2[3]); w.z = cvtpk(h3[0], h3[1]); w.w = cvtpk(h3[2], h3[3]);
            *(u32x4*)(bp + 512) = w;
            if (lane == 0) ssq1[t] = ss;
        }
    }
}

typedef float f32x2v __attribute__((ext_vector_type(2)));
constexpr float FP8_MAX = 448.0f;

__device__ __forceinline__ void quant_row_fp8(const float* __restrict__ src, const float* __restrict__ colscale, unsigned char* __restrict__ dst, float* __restrict__ scale_out, int lane) {
    f32x4 v[4]; float am = 0.f;
#pragma unroll
    for (int j = 0; j < 4; ++j) {
        v[j] = *(const f32x4*)(src + 4 * (lane + 64 * j));
        if (colscale) v[j] = v[j] * *(const f32x4*)(colscale + 4 * (lane + 64 * j));
        am = fmaxf(am, fmaxf(fmaxf(fabsf(v[j][0]), fabsf(v[j][1])), fmaxf(fabsf(v[j][2]), fabsf(v[j][3]))));
    }
#pragma unroll
    for (int o = 1; o < 64; o <<= 1) am = fmaxf(am, __shfl_xor(am, o));
    const float inv = am > 0.f ? FP8_MAX / am : 1.0f;
#pragma unroll
    for (int j = 0; j < 4; ++j) {
        int w = 0;
        w = __builtin_amdgcn_cvt_pk_fp8_f32(v[j][0] * inv, v[j][1] * inv, w, false);
        w = __builtin_amdgcn_cvt_pk_fp8_f32(v[j][2] * inv, v[j][3] * inv, w, true);
        *(int*)(dst + 4 * (lane + 64 * j)) = w;
    }
    if (lane == 0) *scale_out = am > 0.f ? am / FP8_MAX : 1.0f;
}

__device__ __forceinline__ float dot2v(bf16x2v_t a, unsigned b, float acc) { return __builtin_amdgcn_fdot2_f32_bf16(a, __builtin_bit_cast(bf16x2v_t, b), acc, false); }
__device__ __forceinline__ void g4_issue(u32x4 (&buf)[16], const unsigned char* __restrict__ tab, const LAS unsigned short* idl, int it, int g, int p) {
    const int tt = it & 15, c = it >> 4;
    const u32x4 i0 = *(const LAS u32x4*)(idl + tt * 128 + g * 16), i1 = *(const LAS u32x4*)(idl + tt * 128 + g * 16 + 8);
    const unsigned idw[8] = {i0.x, i0.y, i0.z, i0.w, i1.x, i1.y, i1.z, i1.w};
    const unsigned char* base = tab + (c * 128 + p * 16);
#pragma unroll
    for (int i = 0; i < 16; ++i) { const unsigned id = (i & 1) ? (idw[i >> 1] >> 16) : (idw[i >> 1] & 0xffffu);
        buf[i] = *(const u32x4*)(base + (size_t)(id * 1024u)); }
}
#ifndef G4_NT
#define G4_NT 0
#endif
#ifndef G5_STREAM_NT
#define G5_STREAM_NT 0
#endif
struct G4Ids { u32x4 i0, i1; };
__device__ __forceinline__ void g4_ids(G4Ids& d, const LAS unsigned short* idl, int it, int g) {
    const int tt = it & 15;
    d.i0 = *(const LAS u32x4*)(idl + tt * 128 + g * 16); d.i1 = *(const LAS u32x4*)(idl + tt * 128 + g * 16 + 8);
}
__device__ __forceinline__ void g4_rows(u32x4 (&buf)[16], const unsigned char* __restrict__ tab, const G4Ids& d, int it, int p) {
    const int c = it >> 4;
    const unsigned idw[8] = {d.i0.x, d.i0.y, d.i0.z, d.i0.w, d.i1.x, d.i1.y, d.i1.z, d.i1.w};
    const unsigned char* base = tab + (c * 128 + p * 16);
#pragma unroll
    for (int i = 0; i < 16; ++i) { const unsigned id = (i & 1) ? (idw[i >> 1] >> 16) : (idw[i >> 1] & 0xffffu);
        buf[i] = G4_NT ? __builtin_nontemporal_load((const u32x4*)(base + (size_t)(id * 1024u))) : *(const u32x4*)(base + (size_t)(id * 1024u)); }
}
__device__ __forceinline__ void g4_xload(u32x4 (&x)[2], const bf16_t* __restrict__ HB, int t0, int it, int p) {
    const bf16_t* xp = HB + (size_t)(t0 + (it & 15)) * DM + 128 * (it >> 4) + 16 * p;
    x[0] = *(const u32x4*)xp; x[1] = *(const u32x4*)(xp + 8);
}
#define G4_CVT(wd, hi_) __builtin_amdgcn_cvt_scalef32_pk_bf16_fp8((wd), 1.0f, (hi_))
__device__ __forceinline__ void g4_ucompute(const u32x4 (&u)[16], const u32x4 (&x)[2], LAS float* ap, int p) {
    const unsigned xw[8] = {x[0].x, x[0].y, x[0].z, x[0].w, x[1].x, x[1].y, x[1].z, x[1].w};
    float a[16];
#pragma unroll
    for (int i0 = 0; i0 < 16; i0 += 8) {
        float s_[8];
#pragma unroll
        for (int e = 0; e < 8; ++e) s_[e] = 0.f;
#pragma unroll
        for (int q = 0; q < 4; ++q) {
#pragma unroll
            for (int e = 0; e < 8; ++e) { const unsigned wd = (q == 0) ? u[i0 + e].x : (q == 1) ? u[i0 + e].y : (q == 2) ? u[i0 + e].z : u[i0 + e].w;
                s_[e] = dot2v(G4_CVT(wd, false), xw[2 * q], s_[e]); }
#pragma unroll
            for (int e = 0; e < 8; ++e) { const unsigned wd = (q == 0) ? u[i0 + e].x : (q == 1) ? u[i0 + e].y : (q == 2) ? u[i0 + e].z : u[i0 + e].w;
                s_[e] = dot2v(G4_CVT(wd, true), xw[2 * q + 1], s_[e]); }
        }
#pragma unroll
        for (int e = 0; e < 8; ++e) s_[e] = dpp_add<0xB1>(s_[e]);
#pragma unroll
        for (int e = 0; e < 8; ++e) s_[e] = dpp_add<0x4E>(s_[e]);
#pragma unroll
        for (int e = 0; e < 8; ++e) a[i0 + e] = dpp_add<0x141>(s_[e]);
    }
    if (p == 0) {
#pragma unroll
        for (int i = 0; i < 16; ++i) (void)__hip_atomic_fetch_add(ap + i, a[i], __ATOMIC_RELAXED, __HIP_MEMORY_SCOPE_WORKGROUP);
    }
}
__device__ __forceinline__ void g4_vcompute(const u32x4 (&v)[16], const LAS float* wsrc, float* __restrict__ hp, int lane, int dry) {
    const LAS f32x4* wp = (const LAS f32x4*)wsrc;
    const f32x4 w0 = wp[0], w1 = wp[1], w2 = wp[2], w3 = wp[3];
    const float w[16] = {w0[0], w0[1], w0[2], w0[3], w1[0], w1[1], w1[2], w1[3], w2[0], w2[1], w2[2], w2[3], w3[0], w3[1], w3[2], w3[3]};
    float yy[16];
#pragma unroll
    for (int j = 0; j < 16; ++j) yy[j] = 0.f;
#pragma unroll
    for (int i = 0; i < 16; ++i) {
        const unsigned vw[4] = {v[i].x, v[i].y, v[i].z, v[i].w};
#pragma unroll
        for (int q = 0; q < 4; ++q) {
            const f32x2v lo = __builtin_amdgcn_cvt_pk_f32_fp8((int)vw[q], false), hi = __builtin_amdgcn_cvt_pk_f32_fp8((int)vw[q], true);
            yy[4 * q] = fmaf(w[i], lo.x, yy[4 * q]); yy[4 * q + 1] = fmaf(w[i], lo.y, yy[4 * q + 1]); yy[4 * q + 2] = fmaf(w[i], hi.x, yy[4 * q + 2]); yy[4 * q + 3] = fmaf(w[i], hi.y, yy[4 * q + 3]);
        }
    }
    f32x2v y[8];
#pragma unroll
    for (int j = 0; j < 8; ++j) y[j] = (f32x2v){yy[2 * j], yy[2 * j + 1]};
    float z[8];
#pragma unroll
    for (int j = 0; j < 4; ++j) { z[2 * j] = swap32_add(y[j].x, y[j + 4].x); z[2 * j + 1] = swap32_add(y[j].y, y[j + 4].y); }
#pragma unroll
    for (int j = 0; j < 8; ++j) { z[j] = xor16_add(z[j]); z[j] = dpp_add<0x128>(z[j]); }
    if ((lane & 0x18) == 0 && !(dry && z[0] * z[0] >= 0.f)) {
        f32x4 h0 = *(const f32x4*)hp, h1 = *(const f32x4*)(hp + 4);
        h0 += (f32x4){z[0], z[1], z[2], z[3]}; h1 += (f32x4){z[4], z[5], z[6], z[7]};
        *(f32x4*)hp = h0; *(f32x4*)(hp + 4) = h1;
    }
}

__device__ __forceinline__ void gather4_phase(float* __restrict__ H, bf16_t* __restrict__ HB, const float* __restrict__ ssq2p, float* __restrict__ ssq1,
                                              const unsigned char* __restrict__ U8, const unsigned char* __restrict__ V8, const float* __restrict__ su, const float* __restrict__ sv,
                                              const int* __restrict__ ids, const float* __restrict__ gw,
                                              const float* __restrict__ final_g, int last, LAS unsigned char* lds, int wave, int gwave, int lane, int dry = 0, int idmask = 0xffff) {
    LAS unsigned char* wl = lds + wave * G2_WAVE_LDS;
    LAS unsigned short* idl = (LAS unsigned short*)wl;
    LAS float* al = (LAS float*)(wl + 4096);
    const int t0 = __builtin_amdgcn_readfirstlane(gwave * 16);
    for (int tt = 0; tt < 16; ++tt) {
        idl[tt * 128 + lane] = (unsigned short)(ids[(size_t)(t0 + tt) * 128 + lane] & idmask);
        idl[tt * 128 + 64 + lane] = (unsigned short)(ids[(size_t)(t0 + tt) * 128 + 64 + lane] & idmask);
    }
    for (int e = lane; e < 2048; e += 64) al[e] = 0.f;
    asm volatile("s_waitcnt lgkmcnt(0)" ::: "memory");
    const int g = lane >> 3, p = lane & 7;
    if (!(dry & 2)) {
        u32x4 uA[16], uB[16], xA[2], xB[2];
        g4_issue(uA, U8, idl, 0, g, p);
        g4_xload(xA, HB, t0, 0, p);
        for (int it = 0; it < 128; it += 2) {
            g4_issue(uB, U8, idl, it + 1, g, p); g4_xload(xB, HB, t0, it + 1, p);
            g4_ucompute(uA, xA, al + (it & 15) * 128 + g * 16, p);
            if (it + 2 < 128) { g4_issue(uA, U8, idl, it + 2, g, p); g4_xload(xA, HB, t0, it + 2, p); }
            g4_ucompute(uB, xB, al + ((it + 1) & 15) * 128 + g * 16, p);
        }
    }
    asm volatile("s_waitcnt lgkmcnt(0)" ::: "memory");
    for (int n = 0; n < 32; ++n) {
        const int tt = n >> 1, k = lane + 64 * (n & 1);
        const float rs2 = rsqrtf(ssq16(ssq2p, t0 + tt) * (1.0f / 1024.0f) + RMS_EPS);
        const int id = idl[tt * 128 + k];
        const float a = al[tt * 128 + k] * rs2 * su[id];
        al[tt * 128 + k] = gw[(size_t)(t0 + tt) * 128 + k] * gelu_erf(a) * sv[id];
    }
    asm volatile("s_waitcnt lgkmcnt(0)" ::: "memory");
    if (!(dry & 4)) {
        u32x4 vA[16], vB[16];
        g4_issue(vA, V8, idl, 0, g, p);
        for (int it = 0; it < 128; it += 2) {
            g4_issue(vB, V8, idl, it + 1, g, p);
            g4_vcompute(vA, al + (it & 15) * 128 + g * 16, H + (size_t)(t0 + (it & 15)) * DM + 128 * (it >> 4) + 16 * p + 8 * (lane >> 5), lane, dry);
            if (it + 2 < 128) g4_issue(vA, V8, idl, it + 2, g, p);
            g4_vcompute(vB, al + ((it + 1) & 15) * 128 + g * 16, H + (size_t)(t0 + ((it + 1) & 15)) * DM + 128 * ((it + 1) >> 4) + 16 * p + 8 * (lane >> 5), lane, dry);
        }
    }
    if (dry) return;
    __builtin_amdgcn_fence(__ATOMIC_SEQ_CST, "agent");
    asm volatile("s_waitcnt vmcnt(0)" ::: "memory");
    for (int tt = 0; tt < 16; ++tt) {
        const int t = t0 + tt;
        float* hp = H + (size_t)t * DM + 8 * lane;
        f32x4 h0 = *(const f32x4*)hp, h1 = *(const f32x4*)(hp + 4), h2 = *(const f32x4*)(hp + 512), h3 = *(const f32x4*)(hp + 516);
        float ss = (h0[0] * h0[0] + h0[1] * h0[1]) + (h0[2] * h0[2] + h0[3] * h0[3]) + (h1[0] * h1[0] + h1[1] * h1[1]) + (h1[2] * h1[2] + h1[3] * h1[3])
                 + (h2[0] * h2[0] + h2[1] * h2[1]) + (h2[2] * h2[2] + h2[3] * h2[3]) + (h3[0] * h3[0] + h3[1] * h3[1]) + (h3[2] * h3[2] + h3[3] * h3[3]);
        ss = wave_sum(ss);
        if (last) {
            const float rs = rsqrtf(ss * (1.0f / 1024.0f) + RMS_EPS);
            const f32x4 g0 = *(const f32x4*)(final_g + 8 * lane), g1 = *(const f32x4*)(final_g + 8 * lane + 4), g2 = *(const f32x4*)(final_g + 512 + 8 * lane), g3 = *(const f32x4*)(final_g + 516 + 8 * lane);
            h0 = h0 * rs * g0; h1 = h1 * rs * g1; h2 = h2 * rs * g2; h3 = h3 * rs * g3;
            *(f32x4*)hp = h0; *(f32x4*)(hp + 4) = h1; *(f32x4*)(hp + 512) = h2; *(f32x4*)(hp + 516) = h3;
        } else {
            bf16_t* bp = HB + (size_t)t * DM + 8 * lane;
            u32x4 w; w.x = cvtpk(h0[0], h0[1]); w.y = cvtpk(h0[2], h0[3]); w.z = cvtpk(h1[0], h1[1]); w.w = cvtpk(h1[2], h1[3]);
            *(u32x4*)bp = w;
            w.x = cvtpk(h2[0], h2[1]); w.y = cvtpk(h2[2], h2[3]); w.z = cvtpk(h3[0], h3[1]); w.w = cvtpk(h3[2], h3[3]);
            *(u32x4*)(bp + 512) = w;
            if (lane == 0) ssq1[t] = ss;
        }
    }
}

__device__ __forceinline__ void quant_row_i8(const float* __restrict__ src, const float* __restrict__ colscale, unsigned char* __restrict__ dst, float* __restrict__ scale_out, int bias, int lane) {
    f32x4 v[4]; float am = 0.f;
#pragma unroll
    for (int j = 0; j < 4; ++j) {
        v[j] = *(const f32x4*)(src + 4 * (lane + 64 * j));
        if (colscale) v[j] = v[j] * *(const f32x4*)(colscale + 4 * (lane + 64 * j));
        am = fmaxf(am, fmaxf(fmaxf(fabsf(v[j][0]), fabsf(v[j][1])), fmaxf(fabsf(v[j][2]), fabsf(v[j][3]))));
    }
#pragma unroll
    for (int o = 1; o < 64; o <<= 1) am = fmaxf(am, __shfl_xor(am, o));
    const float inv = am > 0.f ? 127.0f / am : 0.f;
#pragma unroll
    for (int j = 0; j < 4; ++j) {
        const int q0 = (int)rintf(v[j][0] * inv) + bias, q1 = (int)rintf(v[j][1] * inv) + bias, q2 = (int)rintf(v[j][2] * inv) + bias, q3 = (int)rintf(v[j][3] * inv) + bias;
        *(unsigned*)(dst + 4 * (lane + 64 * j)) = (unsigned)(q0 & 255) | ((unsigned)(q1 & 255) << 8) | ((unsigned)(q2 & 255) << 16) | ((unsigned)(q3 & 255) << 24);
    }
    if (lane == 0) *scale_out = am > 0.f ? am / 127.0f : 0.f;
}
__device__ __forceinline__ void quant_row_load(f32x4 (&v)[4], const float* __restrict__ src, int lane) {
#pragma unroll
    for (int j = 0; j < 4; ++j) v[j] = *(const f32x4*)(src + 4 * (lane + 64 * j));
}
__device__ __forceinline__ void quant_row_finish(f32x4 (&v)[4], const float* __restrict__ colscale, unsigned char* __restrict__ dst, float* __restrict__ scale_out, int bias, int lane) {
    float am = 0.f;
#pragma unroll
    for (int j = 0; j < 4; ++j) {
        if (colscale) v[j] = v[j] * *(const f32x4*)(colscale + 4 * (lane + 64 * j));
        am = fmaxf(am, fmaxf(fmaxf(fabsf(v[j][0]), fabsf(v[j][1])), fmaxf(fabsf(v[j][2]), fabsf(v[j][3]))));
    }
#pragma unroll
    for (int o = 1; o < 64; o <<= 1) am = fmaxf(am, __shfl_xor(am, o));
    const float inv = am > 0.f ? 127.0f / am : 0.f;
#pragma unroll
    for (int j = 0; j < 4; ++j) {
        const int q0 = (int)rintf(v[j][0] * inv) + bias, q1 = (int)rintf(v[j][1] * inv) + bias, q2 = (int)rintf(v[j][2] * inv) + bias, q3 = (int)rintf(v[j][3] * inv) + bias;
        *(unsigned*)(dst + 4 * (lane + 64 * j)) = (unsigned)(q0 & 255) | ((unsigned)(q1 & 255) << 8) | ((unsigned)(q2 & 255) << 16) | ((unsigned)(q3 & 255) << 24);
    }
    if (lane == 0) *scale_out = am > 0.f ? am / 127.0f : 0.f;
}
template <int CTRL> __device__ __forceinline__ int dpp_addi(int v) { return v + __builtin_amdgcn_update_dpp(0, v, CTRL, 0xF, 0xF, true); }
__device__ __forceinline__ void g5_ucompute(const u32x4 (&u)[16], const u32x4& x, LAS int* ap, int p) {
    int a[16];
#pragma unroll
    for (int i = 0; i < 16; ++i) {
        int s_ = __builtin_amdgcn_sdot4((int)u[i].x, (int)x.x, 0, false);
        s_ = __builtin_amdgcn_sdot4((int)u[i].y, (int)x.y, s_, false);
        s_ = __builtin_amdgcn_sdot4((int)u[i].z, (int)x.z, s_, false);
        s_ = __builtin_amdgcn_sdot4((int)u[i].w, (int)x.w, s_, false);
        a[i] = s_;
    }
#pragma unroll
    for (int i = 0; i < 16; ++i) a[i] = dpp_addi<0xB1>(a[i]);
#pragma unroll
    for (int i = 0; i < 16; ++i) a[i] = dpp_addi<0x4E>(a[i]);
    if ((p & 3) == 0) {
#pragma unroll
        for (int i = 0; i < 16; ++i) (void)__hip_atomic_fetch_add(ap + i, a[i], __ATOMIC_RELAXED, __HIP_MEMORY_SCOPE_WORKGROUP);
    }
}
__device__ __forceinline__ void g5_vcompute(const u32x4 (&v)[16], const LAS float* wsrc, float* __restrict__ hp, int lane, int dry) {
    const LAS f32x4* wp = (const LAS f32x4*)wsrc;
    const f32x4 w0 = wp[0], w1 = wp[1], w2 = wp[2], w3 = wp[3];
    const float w[16] = {w0[0], w0[1], w0[2], w0[3], w1[0], w1[1], w1[2], w1[3], w2[0], w2[1], w2[2], w2[3], w3[0], w3[1], w3[2], w3[3]};
    float wsum = ((w[0] + w[1]) + (w[2] + w[3])) + ((w[4] + w[5]) + (w[6] + w[7])) + (((w[8] + w[9]) + (w[10] + w[11])) + ((w[12] + w[13]) + (w[14] + w[15])));
    float yy[16];
    const float y0 = -1152.0f * wsum;
#pragma unroll
    for (int j = 0; j < 16; ++j) yy[j] = y0;
#pragma unroll
    for (int i = 0; i < 16; ++i) {
        const unsigned vw[4] = {v[i].x, v[i].y, v[i].z, v[i].w};
#pragma unroll
        for (int q = 0; q < 4; ++q) {
            const unsigned lo = __builtin_amdgcn_perm(vw[q], 0x64646464u, 0x00050004u), hi = __builtin_amdgcn_perm(vw[q], 0x64646464u, 0x00070006u);
            fma_mix_lo(yy[4 * q], w[i], lo); fma_mix_hi(yy[4 * q + 1], w[i], lo); fma_mix_lo(yy[4 * q + 2], w[i], hi); fma_mix_hi(yy[4 * q + 3], w[i], hi);
        }
    }
    float z[8];
#pragma unroll
    for (int j = 0; j < 8; ++j) z[j] = swap32_add(yy[j], yy[j + 8]);
#pragma unroll
    for (int j = 0; j < 8; ++j) { z[j] = xor16_add(z[j]); z[j] = dpp_add<0x128>(z[j]); }
    if ((lane & 0x18) == 0 && !(dry && z[0] * z[0] >= 0.f)) {
        f32x4 h0 = *(const f32x4*)hp, h1 = *(const f32x4*)(hp + 4);
        h0 += (f32x4){z[0], z[1], z[2], z[3]}; h1 += (f32x4){z[4], z[5], z[6], z[7]};
        *(f32x4*)hp = h0; *(f32x4*)(hp + 4) = h1;
    }
}
#ifndef G5_VDOT4
#define G5_VDOT4 1
#endif
__device__ __forceinline__ void g6_vcompute(const u32x4 (&v)[16], const LAS unsigned char* w8src, float sw, float* __restrict__ hp, int lane, int dry, bf16_t* hbp, LAS float* sspart, const u32x4 hb_pre) {
    const u32x4 w4 = *(const LAS u32x4*)w8src;
    const unsigned ww[4] = {w4.x, w4.y, w4.z, w4.w};
    int yy[16];
#pragma unroll
    for (int j = 0; j < 16; ++j) yy[j] = 0;
#pragma unroll
    for (int a = 0; a < 4; ++a) {
#pragma unroll
        for (int q = 0; q < 4; ++q) {
            const unsigned r0 = (q == 0) ? v[4 * a].x : (q == 1) ? v[4 * a].y : (q == 2) ? v[4 * a].z : v[4 * a].w;
            const unsigned r1 = (q == 0) ? v[4 * a + 1].x : (q == 1) ? v[4 * a + 1].y : (q == 2) ? v[4 * a + 1].z : v[4 * a + 1].w;
            const unsigned r2 = (q == 0) ? v[4 * a + 2].x : (q == 1) ? v[4 * a + 2].y : (q == 2) ? v[4 * a + 2].z : v[4 * a + 2].w;
            const unsigned r3 = (q == 0) ? v[4 * a + 3].x : (q == 1) ? v[4 * a + 3].y : (q == 2) ? v[4 * a + 3].z : v[4 * a + 3].w;
            const unsigned lo01 = __builtin_amdgcn_perm(r1, r0, 0x05010400u), hi01 = __builtin_amdgcn_perm(r1, r0, 0x07030602u);
            const unsigned lo23 = __builtin_amdgcn_perm(r3, r2, 0x05010400u), hi23 = __builtin_amdgcn_perm(r3, r2, 0x07030602u);
            const unsigned c0 = __builtin_amdgcn_perm(lo23, lo01, 0x05040100u), c1 = __builtin_amdgcn_perm(lo23, lo01, 0x07060302u);
            const unsigned c2 = __builtin_amdgcn_perm(hi23, hi01, 0x05040100u), c3 = __builtin_amdgcn_perm(hi23, hi01, 0x07060302u);
            yy[4 * q] = __builtin_amdgcn_sdot4((int)c0, (int)ww[a], yy[4 * q], false); yy[4 * q + 1] = __builtin_amdgcn_sdot4((int)c1, (int)ww[a], yy[4 * q + 1], false);
            yy[4 * q + 2] = __builtin_amdgcn_sdot4((int)c2, (int)ww[a], yy[4 * q + 2], false); yy[4 * q + 3] = __builtin_amdgcn_sdot4((int)c3, (int)ww[a], yy[4 * q + 3], false);
        }
    }
    int z[8];
#pragma unroll
    for (int j = 0; j < 8; ++j) { const auto r = __builtin_amdgcn_permlane32_swap((unsigned)yy[j], (unsigned)yy[j + 8], false, false); z[j] = (int)(r[0] + r[1]); }
#pragma unroll
    for (int j = 0; j < 8; ++j) { z[j] += __builtin_amdgcn_ds_swizzle(z[j], 0x401F); z[j] = dpp_addi<0x128>(z[j]); }
    float ss = 0.f;
    if ((lane & 0x18) == 0 && !(dry && z[0] == 0x7fffffff)) {
#if RES16
        const u32x4 hb_ = hb_pre;
        f32x4 h0 = (f32x4){bflo(hb_.x), bfhi(hb_.x), bflo(hb_.y), bfhi(hb_.y)}, h1 = (f32x4){bflo(hb_.z), bfhi(hb_.z), bflo(hb_.w), bfhi(hb_.w)};
#else
        f32x4 h0 = *(const f32x4*)hp, h1 = *(const f32x4*)(hp + 4);
#endif
        h0 += (f32x4){(float)z[0] * sw, (float)z[1] * sw, (float)z[2] * sw, (float)z[3] * sw}; h1 += (f32x4){(float)z[4] * sw, (float)z[5] * sw, (float)z[6] * sw, (float)z[7] * sw};
        if (!RES16 || !hbp) { *(f32x4*)hp = h0; *(f32x4*)(hp + 4) = h1; }
        if (hbp) {
            u32x4 w; w.x = cvtpk(h0[0], h0[1]); w.y = cvtpk(h0[2], h0[3]); w.z = cvtpk(h1[0], h1[1]); w.w = cvtpk(h1[2], h1[3]);
            if (G5_STREAM_NT) __builtin_nontemporal_store(w, (u32x4*)hbp); else *(u32x4*)hbp = w;
            ss = (h0[0] * h0[0] + h0[1] * h0[1]) + (h0[2] * h0[2] + h0[3] * h0[3]) + (h1[0] * h1[0] + h1[1] * h1[1]) + (h1[2] * h1[2] + h1[3] * h1[3]);
        }
    }
    if (hbp) {
        ss = dpp_add<0xB1>(ss); ss = dpp_add<0x4E>(ss); ss = dpp_add<0x141>(ss);
        if ((lane & 31) == 0) sspart[lane >> 5] = ss;
    }
}
__device__ __forceinline__ void g5_xload(u32x4& x, const unsigned char* __restrict__ XQ, int t0, int it, int p) {
    x = G5_STREAM_NT ? __builtin_nontemporal_load((const u32x4*)(XQ + (size_t)(t0 + (it & 15)) * DM + 128 * (it >> 4) + 16 * p)) : *(const u32x4*)(XQ + (size_t)(t0 + (it & 15)) * DM + 128 * (it >> 4) + 16 * p);
}

__device__ __forceinline__ void gather5_phase(float* __restrict__ H, bf16_t* __restrict__ HB, const float* __restrict__ ssq2p, float* __restrict__ ssq1,
                                              const unsigned char* __restrict__ U8, const unsigned char* __restrict__ V8, const float* __restrict__ su, const float* __restrict__ sv,
                                              unsigned char* __restrict__ XQ, const int* __restrict__ ids, const float* __restrict__ gw,
                                              const float* __restrict__ final_g, int last, LAS unsigned char* lds, int wave, int gwave, int lane, int dry = 0, int idmask = 0xffff, unsigned char* A8 = nullptr, float* SA = nullptr, const float* SXg = nullptr) {
    LAS unsigned char* wl = lds + wave * G2_WAVE_LDS;
    LAS unsigned short* idl = (LAS unsigned short*)wl;
    LAS float* al = (LAS float*)(wl + 4096);
    LAS float* sxl = (LAS float*)(wl + 4096 + 8192);
    const int t0 = __builtin_amdgcn_readfirstlane(gwave * 16);
    for (int tt = 0; tt < 16; ++tt) {
        idl[tt * 128 + lane] = (unsigned short)(ids[(size_t)(t0 + tt) * 128 + lane] & idmask);
        idl[tt * 128 + 64 + lane] = (unsigned short)(ids[(size_t)(t0 + tt) * 128 + 64 + lane] & idmask);
    }
    for (int e = lane; e < 2048; e += 64) ((LAS int*)al)[e] = 0;
    if (SXg) {
        if (lane < 16) sxl[lane] = SXg[t0 + lane];
#pragma unroll
        for (int i = 0; i < 16; ++i) { const u32x4 t_ = *(const u32x4*)(XQ + (size_t)(t0 + i) * DM + 16 * lane); asm volatile("" :: "v"(t_)); }
    }
    else for (int tt = 0; tt < 16; ++tt) {
        const bf16_t* xr = HB + (size_t)(t0 + tt) * DM + 8 * lane;
        const u32x4 xa = *(const u32x4*)xr, xb = *(const u32x4*)(xr + 512);
        const float f[16] = {bflo(xa.x), bfhi(xa.x), bflo(xa.y), bfhi(xa.y), bflo(xa.z), bfhi(xa.z), bflo(xa.w), bfhi(xa.w),
                             bflo(xb.x), bfhi(xb.x), bflo(xb.y), bfhi(xb.y), bflo(xb.z), bfhi(xb.z), bflo(xb.w), bfhi(xb.w)};
        float am = 0.f;
#pragma unroll
        for (int j = 0; j < 16; ++j) am = fmaxf(am, fabsf(f[j]));
#pragma unroll
        for (int o = 1; o < 64; o <<= 1) am = fmaxf(am, __shfl_xor(am, o));
        const float inv = am > 0.f ? 127.0f / am : 0.f;
        unsigned wq[4];
#pragma unroll
        for (int j = 0; j < 4; ++j) {
            const int q0 = (int)rintf(f[4 * j] * inv), q1 = (int)rintf(f[4 * j + 1] * inv), q2 = (int)rintf(f[4 * j + 2] * inv), q3 = (int)rintf(f[4 * j + 3] * inv);
            wq[j] = (unsigned)(q0 & 255) | ((unsigned)(q1 & 255) << 8) | ((unsigned)(q2 & 255) << 16) | ((unsigned)(q3 & 255) << 24);
        }
        unsigned char* xq = XQ + (size_t)(t0 + tt) * DM + 8 * lane;
        *(u32x2*)xq = (u32x2){wq[0], wq[1]}; *(u32x2*)(xq + 512) = (u32x2){wq[2], wq[3]};
        if (lane == 0) sxl[tt] = am > 0.f ? am / 127.0f : 0.f;
    }
    asm volatile("s_waitcnt vmcnt(0) lgkmcnt(0)" ::: "memory");
    const int g = lane >> 3, p = lane & 7;
    if (!(dry & 2)) {
        u32x4 uA[16], uB[16], xA, xB;
        G4Ids dA, dB;
        g4_ids(dA, idl, 0, g); g4_ids(dB, idl, 1, g);
        g4_rows(uA, U8, dA, 0, p); g5_xload(xA, XQ, t0, 0, p);
        for (int it = 0; it < 128; it += 2) {
            g4_rows(uB, U8, dB, it + 1, p); g5_xload(xB, XQ, t0, it + 1, p);
            g4_ids(dA, idl, (it + 2) & 127, g);
            g5_ucompute(uA, xA, (LAS int*)al + (it & 15) * 128 + g * 16, p);
            if (it + 2 < 128) { g4_rows(uA, U8, dA, it + 2, p); g5_xload(xA, XQ, t0, it + 2, p); }
            g4_ids(dB, idl, (it + 3) & 127, g);
            g5_ucompute(uB, xB, (LAS int*)al + ((it + 1) & 15) * 128 + g * 16, p);
        }
    }
    asm volatile("s_waitcnt lgkmcnt(0)" ::: "memory");
#if G5_VDOT4
    LAS unsigned char* w8l = (LAS unsigned char*)al;
    LAS float* swl = sxl + 16;
    for (int tt = 0; tt < 16; ++tt) {
        const float rs2 = rsqrtf(ssq16(ssq2p, t0 + tt) * (1.0f / 1024.0f) + RMS_EPS) * sxl[tt];
        const int id0 = idl[tt * 128 + lane], id1 = idl[tt * 128 + 64 + lane];
        const float a0 = (float)((LAS int*)al)[tt * 128 + lane] * rs2 * su[id0], a1 = (float)((LAS int*)al)[tt * 128 + 64 + lane] * rs2 * su[id1];
        const float w0 = gw[(size_t)(t0 + tt) * 128 + lane] * gelu_erf(a0) * sv[id0], w1 = gw[(size_t)(t0 + tt) * 128 + 64 + lane] * gelu_erf(a1) * sv[id1];
        float am = fmaxf(fabsf(w0), fabsf(w1));
#pragma unroll
        for (int o = 1; o < 64; o <<= 1) am = fmaxf(am, __shfl_xor(am, o));
        const float inv = am > 0.f ? 127.0f / am : 0.f;
        asm volatile("s_waitcnt lgkmcnt(0)" ::: "memory");
        w8l[tt * 128 + lane] = (unsigned char)((int)rintf(w0 * inv) & 255); w8l[tt * 128 + 64 + lane] = (unsigned char)((int)rintf(w1 * inv) & 255);
        if (lane == 0) swl[tt] = am > 0.f ? am / 127.0f : 0.f;
    }
    asm volatile("s_waitcnt lgkmcnt(0)" ::: "memory");
    const bool fold = (RES16 || !last) && !dry;
    LAS float* ssp = al + 1024;
    if (!(dry & 4)) {
        u32x4 vA[16], vB[16];
        u32x4 hA = {0u, 0u, 0u, 0u}, hB = {0u, 0u, 0u, 0u};
        const bool wlane = (lane & 0x18) == 0;
#define G6_OFF(i_) ((size_t)(t0 + ((i_) & 15)) * DM + 128 * ((i_) >> 4) + 16 * p + 8 * (lane >> 5))
        G4Ids eA, eB;
        g4_ids(eA, idl, 0, g); g4_ids(eB, idl, 1, g);
        g4_rows(vA, V8, eA, 0, p); if (wlane) hA = G5_STREAM_NT ? __builtin_nontemporal_load((const u32x4*)(HB + G6_OFF(0))) : *(const u32x4*)(HB + G6_OFF(0));
        for (int it = 0; it < 128; it += 2) {
            g4_rows(vB, V8, eB, it + 1, p); if (wlane) hB = G5_STREAM_NT ? __builtin_nontemporal_load((const u32x4*)(HB + G6_OFF(it + 1))) : *(const u32x4*)(HB + G6_OFF(it + 1));
            g4_ids(eA, idl, (it + 2) & 127, g);
            { const size_t o_ = G6_OFF(it);
              g6_vcompute(vA, w8l + (it & 15) * 128 + g * 16, swl[it & 15], H + o_, lane, dry, fold ? HB + o_ : nullptr, ssp + (it & 15) * 16 + (it >> 4) * 2, hA); }
            if (it + 2 < 128) { g4_rows(vA, V8, eA, it + 2, p); if (wlane) hA = G5_STREAM_NT ? __builtin_nontemporal_load((const u32x4*)(HB + G6_OFF(it + 2))) : *(const u32x4*)(HB + G6_OFF(it + 2)); }
            g4_ids(eB, idl, (it + 3) & 127, g);
            { const size_t o_ = G6_OFF(it + 1);
              g6_vcompute(vB, w8l + ((it + 1) & 15) * 128 + g * 16, swl[(it + 1) & 15], H + o_, lane, dry, fold ? HB + o_ : nullptr, ssp + ((it + 1) & 15) * 16 + ((it + 1) >> 4) * 2, hB); }
        }
#undef G6_OFF
    }
#else
    for (int n = 0; n < 32; ++n) {
        const int tt = n >> 1, k = lane + 64 * (n & 1);
        const float rs2 = rsqrtf(ssq16(ssq2p, t0 + tt) * (1.0f / 1024.0f) + RMS_EPS);
        const int id = idl[tt * 128 + k];
        const float a = (float)((LAS int*)al)[tt * 128 + k] * (rs2 * sxl[tt]) * su[id];
        al[tt * 128 + k] = gw[(size_t)(t0 + tt) * 128 + k] * gelu_erf(a) * sv[id];
    }
    asm volatile("s_waitcnt lgkmcnt(0)" ::: "memory");
    if (!(dry & 4)) {
        u32x4 vA[16], vB[16];
        g4_issue(vA, V8, idl, 0, g, p);
        for (int it = 0; it < 128; it += 2) {
            g4_issue(vB, V8, idl, it + 1, g, p);
            g5_vcompute(vA, al + (it & 15) * 128 + g * 16, H + (size_t)(t0 + (it & 15)) * DM + 128 * (it >> 4) + 16 * p + 8 * (lane >> 5), lane, dry);
            if (it + 2 < 128) g4_issue(vA, V8, idl, it + 2, g, p);
            g5_vcompute(vB, al + ((it + 1) & 15) * 128 + g * 16, H + (size_t)(t0 + ((it + 1) & 15)) * DM + 128 * ((it + 1) >> 4) + 16 * p + 8 * (lane >> 5), lane, dry);
        }
    }
#endif
    if (dry) return;
#if G5_VDOT4
    if (fold) {
        asm volatile("s_waitcnt lgkmcnt(0)" ::: "memory");
        if (!last) {
            if (lane < 16) { float a_ = 0.f;
#pragma unroll
                for (int q_ = 0; q_ < 16; ++q_) a_ += ssp[lane * 16 + q_];
                ssq1[t0 + lane] = a_; }
#if IN_I8
            asm volatile("s_waitcnt vmcnt(0)" ::: "memory");
            if (TAIL_FENCE_LIGHT) __builtin_amdgcn_fence(__ATOMIC_ACQUIRE, "agent"); else __builtin_amdgcn_fence(__ATOMIC_SEQ_CST, "agent");
            asm volatile("s_waitcnt vmcnt(0)" ::: "memory");
            for (int hb_ = 0; hb_ < 2; ++hb_) {
                u32x4 xa[8], xb[8];
#pragma unroll
                for (int tt = 0; tt < 8; ++tt) { const bf16_t* xr = HB + (size_t)(t0 + 8 * hb_ + tt) * DM + 8 * lane; xa[tt] = *(const u32x4*)xr; xb[tt] = *(const u32x4*)(xr + 512); }
#pragma unroll
                for (int tt = 0; tt < 8; ++tt) {
                    const float f[16] = {bflo(xa[tt].x), bfhi(xa[tt].x), bflo(xa[tt].y), bfhi(xa[tt].y), bflo(xa[tt].z), bfhi(xa[tt].z), bflo(xa[tt].w), bfhi(xa[tt].w),
                                         bflo(xb[tt].x), bfhi(xb[tt].x), bflo(xb[tt].y), bfhi(xb[tt].y), bflo(xb[tt].z), bfhi(xb[tt].z), bflo(xb[tt].w), bfhi(xb[tt].w)};
                    quant_arow_i8(f, A8 + (size_t)(t0 + 8 * hb_ + tt) * DM, SA + t0 + 8 * hb_ + tt, lane);
                }
            }
#endif
            return;
        }
        asm volatile("s_waitcnt vmcnt(0)" ::: "memory");
        if (TAIL_FENCE_LIGHT) __builtin_amdgcn_fence(__ATOMIC_ACQUIRE, "agent"); else __builtin_amdgcn_fence(__ATOMIC_SEQ_CST, "agent");
        asm volatile("s_waitcnt vmcnt(0)" ::: "memory");
        const f32x4 g0 = *(const f32x4*)(final_g + 8 * lane), g1 = *(const f32x4*)(final_g + 8 * lane + 4), g2 = *(const f32x4*)(final_g + 512 + 8 * lane), g3 = *(const f32x4*)(final_g + 516 + 8 * lane);
        for (int tt = 0; tt < 16; ++tt) {
            const int t = t0 + tt;
            float ss = 0.f;
#pragma unroll
            for (int q_ = 0; q_ < 16; ++q_) ss += ssp[tt * 16 + q_];
            float rs = rsqrtf(ss * (1.0f / 1024.0f) + RMS_EPS);
            const bf16_t* bp = HB + (size_t)t * DM + 8 * lane;
            const u32x4 a_ = *(const u32x4*)bp, b_ = *(const u32x4*)(bp + 512);
            float* hp = H + (size_t)t * DM + 8 * lane;
            const f32x4 h0 = (f32x4){bflo(a_.x), bfhi(a_.x), bflo(a_.y), bfhi(a_.y)} * rs * g0, h1 = (f32x4){bflo(a_.z), bfhi(a_.z), bflo(a_.w), bfhi(a_.w)} * rs * g1;
            const f32x4 h2 = (f32x4){bflo(b_.x), bfhi(b_.x), bflo(b_.y), bfhi(b_.y)} * rs * g2, h3 = (f32x4){bflo(b_.z), bfhi(b_.z), bflo(b_.w), bfhi(b_.w)} * rs * g3;
            __builtin_nontemporal_store(h0, (f32x4*)hp); __builtin_nontemporal_store(h1, (f32x4*)(hp + 4)); __builtin_nontemporal_store(h2, (f32x4*)(hp + 512)); __builtin_nontemporal_store(h3, (f32x4*)(hp + 516));
        }
        return;
    }
#endif
    __builtin_amdgcn_fence(__ATOMIC_SEQ_CST, "agent");
    asm volatile("s_waitcnt vmcnt(0)" ::: "memory");
    for (int tt = 0; tt < 16; ++tt) {
        const int t = t0 + tt;
        float* hp = H + (size_t)t * DM + 8 * lane;
        f32x4 h0 = *(const f32x4*)hp, h1 = *(const f32x4*)(hp + 4), h2 = *(const f32x4*)(hp + 512), h3 = *(const f32x4*)(hp + 516);
        float ss = (h0[0] * h0[0] + h0[1] * h0[1]) + (h0[2] * h0[2] + h0[3] * h0[3]) + (h1[0] * h1[0] + h1[1] * h1[1]) + (h1[2] * h1[2] + h1[3] * h1[3])
                 + (h2[0] * h2[0] + h2[1] * h2[1]) + (h2[2] * h2[2] + h2[3] * h2[3]) + (h3[0] * h3[0] + h3[1] * h3[1]) + (h3[2] * h3[2] + h3[3] * h3[3]);
        ss = wave_sum(ss);
        if (last) {
            const float rs = rsqrtf(ss * (1.0f / 1024.0f) + RMS_EPS);
            const f32x4 g0 = *(const f32x4*)(final_g + 8 * lane), g1 = *(const f32x4*)(final_g + 8 * lane + 4), g2 = *(const f32x4*)(final_g + 512 + 8 * lane), g3 = *(const f32x4*)(final_g + 516 + 8 * lane);
            h0 = h0 * rs * g0; h1 = h1 * rs * g1; h2 = h2 * rs * g2; h3 = h3 * rs * g3;
            *(f32x4*)hp = h0; *(f32x4*)(hp + 4) = h1; *(f32x4*)(hp + 512) = h2; *(f32x4*)(hp + 516) = h3;
        } else {
            bf16_t* bp = HB + (size_t)t * DM + 8 * lane;
            u32x4 w; w.x = cvtpk(h0[0], h0[1]); w.y = cvtpk(h0[2], h0[3]); w.z = cvtpk(h1[0], h1[1]); w.w = cvtpk(h1[2], h1[3]);
            *(u32x4*)bp = w;
            w.x = cvtpk(h2[0], h2[1]); w.y = cvtpk(h2[2], h2[3]); w.z = cvtpk(h3[0], h3[1]); w.w = cvtpk(h3[2], h3[3]);
            *(u32x4*)(bp + 512) = w;
            if (lane == 0) ssq1[t] = ss;
        }
    }
}

__device__ __forceinline__ float gelu_erf(float x) { return 0.5f * x * (1.0f + erff(x * 0.70710678118654752f)); }

__device__ __forceinline__ void gather_phase(float* __restrict__ H, bf16_t* __restrict__ HB, const float* __restrict__ ssq2, float* __restrict__ ssq1,
                                             const bf16_t* __restrict__ U16, const bf16_t* __restrict__ V16, const int* __restrict__ ids, const float* __restrict__ gw,
                                             const float* __restrict__ final_g, int last, int gwave, int ngw, int lane, int dry = 0, int idmask = 0xffff) {
    for (int t0 = gwave; t0 < T; t0 += ngw) {
        const int t = __builtin_amdgcn_readfirstlane(t0);
        const u32x4 xa = *(const u32x4*)(HB + (size_t)t * DM + 8 * lane), xb = *(const u32x4*)(HB + (size_t)t * DM + 512 + 8 * lane);
        const float rs2 = rsqrtf(ssq16(ssq2, t) * (1.0f / 1024.0f) + RMS_EPS);
        float y[16];
#pragma unroll
        for (int i = 0; i < 16; ++i) y[i] = 0.f;
        const int* idp = ids + (size_t)t * 128; const float* gp = gw + (size_t)t * 128;
        for (int c = 0; c < 16; ++c) {
            u32x4 ua[8], ub[8], va[8], vb[8]; float g[8];
#pragma unroll
            for (int e = 0; e < 8; ++e) {
                const int id = __builtin_amdgcn_readfirstlane(idp[c * 8 + e]) & idmask;
                g[e] = gp[c * 8 + e];
                const bf16_t* ur = U16 + (size_t)id * DM + 8 * lane; const bf16_t* vr = V16 + (size_t)id * DM + 8 * lane;
                ua[e] = *(const u32x4*)ur; ub[e] = *(const u32x4*)(ur + 512); va[e] = *(const u32x4*)vr; vb[e] = *(const u32x4*)(vr + 512);
            }
#pragma unroll
            for (int e = 0; e < 8; ++e) {
                float a = 0.f;
                a = dot2bf(xa.x, ua[e].x, a); a = dot2bf(xa.y, ua[e].y, a); a = dot2bf(xa.z, ua[e].z, a); a = dot2bf(xa.w, ua[e].w, a);
                a = dot2bf(xb.x, ub[e].x, a); a = dot2bf(xb.y, ub[e].y, a); a = dot2bf(xb.z, ub[e].z, a); a = dot2bf(xb.w, ub[e].w, a);
                a = wave_sum(a);
                const float w = g[e] * gelu_erf(a * rs2);
                y[0] = fmaf(w, bflo(va[e].x), y[0]); y[1] = fmaf(w, bfhi(va[e].x), y[1]); y[2] = fmaf(w, bflo(va[e].y), y[2]); y[3] = fmaf(w, bfhi(va[e].y), y[3]);
                y[4] = fmaf(w, bflo(va[e].z), y[4]); y[5] = fmaf(w, bfhi(va[e].z), y[5]); y[6] = fmaf(w, bflo(va[e].w), y[6]); y[7] = fmaf(w, bfhi(va[e].w), y[7]);
                y[8] = fmaf(w, bflo(vb[e].x), y[8]); y[9] = fmaf(w, bfhi(vb[e].x), y[9]); y[10] = fmaf(w, bflo(vb[e].y), y[10]); y[11] = fmaf(w, bfhi(vb[e].y), y[11]);
                y[12] = fmaf(w, bflo(vb[e].z), y[12]); y[13] = fmaf(w, bfhi(vb[e].z), y[13]); y[14] = fmaf(w, bflo(vb[e].w), y[14]); y[15] = fmaf(w, bfhi(vb[e].w), y[15]);
            }
        }
        float* hp = H + (size_t)t * DM + 8 * lane;
        f32x4 h0 = *(const f32x4*)hp, h1 = *(const f32x4*)(hp + 4), h2 = *(const f32x4*)(hp + 512), h3 = *(const f32x4*)(hp + 516);
        h0 += (f32x4){y[0], y[1], y[2], y[3]}; h1 += (f32x4){y[4], y[5], y[6], y[7]}; h2 += (f32x4){y[8], y[9], y[10], y[11]}; h3 += (f32x4){y[12], y[13], y[14], y[15]};
        float ss = (h0[0] * h0[0] + h0[1] * h0[1]) + (h0[2] * h0[2] + h0[3] * h0[3]) + (h1[0] * h1[0] + h1[1] * h1[1]) + (h1[2] * h1[2] + h1[3] * h1[3])
                 + (h2[0] * h2[0] + h2[1] * h2[1]) + (h2[2] * h2[2] + h2[3] * h2[3]) + (h3[0] * h3[0] + h3[1] * h3[1]) + (h3[2] * h3[2] + h3[3] * h3[3]);
        ss = wave_sum(ss);
        if (dry && ss >= 0.f) continue;
        if (last) {
            const float rs = rsqrtf(ss * (1.0f / 1024.0f) + RMS_EPS);
            const f32x4 g0 = *(const f32x4*)(final_g + 8 * lane), g1 = *(const f32x4*)(final_g + 8 * lane + 4), g2 = *(const f32x4*)(final_g + 512 + 8 * lane), g3 = *(const f32x4*)(final_g + 516 + 8 * lane);
            h0 = h0 * rs * g0; h1 = h1 * rs * g1; h2 = h2 * rs * g2; h3 = h3 * rs * g3;
            *(f32x4*)hp = h0; *(f32x4*)(hp + 4) = h1; *(f32x4*)(hp + 512) = h2; *(f32x4*)(hp + 516) = h3;
        } else {
            *(f32x4*)hp = h0; *(f32x4*)(hp + 4) = h1; *(f32x4*)(hp + 512) = h2; *(f32x4*)(hp + 516) = h3;
            bf16_t* bp = HB + (size_t)t * DM + 8 * lane;
            u32x4 w; w.x = cvtpk(h0[0], h0[1]); w.y = cvtpk(h0[2], h0[3]); w.z = cvtpk(h1[0], h1[1]); w.w = cvtpk(h1[2], h1[3]);
            *(u32x4*)bp = w;
            w.x = cvtpk(h2[0], h2[1]); w.y = cvtpk(h2[2], h2[3]); w.z = cvtpk(h3[0], h3[1]); w.w = cvtpk(h3[2], h3[3]);
            *(u32x4*)(bp + 512) = w;
            if (lane == 0) ssq1[t] = ss;
        }
    }
}

#define XB_TMO      128
#define XB_XCNT(j)  (256  + 64 * (j))
#define XB_XSUB(j)  (1280 + 64 * (j))
#define XB_XGEN(j)  (2304 + 64 * (j))
#define XB_TOP      3328
#define XB_TOPGEN   3392
#define XCD_BAR_WORDS 3456
#define XB_SPIN_CAP (1u << 18)

__device__ __forceinline__ unsigned xb_ld(unsigned* p)              { return __hip_atomic_load(p, __ATOMIC_RELAXED, __HIP_MEMORY_SCOPE_AGENT); }
__device__ __forceinline__ unsigned xb_add(unsigned* p, unsigned v) { return __hip_atomic_fetch_add(p, v, __ATOMIC_RELAXED, __HIP_MEMORY_SCOPE_AGENT); }
__device__ __forceinline__ unsigned xb_xcc_id() { return (unsigned)__builtin_amdgcn_s_getreg((3 << 11) | 20) & 0xFu; }
#define XB_SPIN(cond, bar) do { unsigned _sp = 0; while (cond) { __builtin_amdgcn_s_sleep(1); \
    if ((++_sp & 255u) == 0u) { if (xb_ld(&(bar)[XB_TMO])) break; if (_sp > XB_SPIN_CAP) { atomicAdd(&(bar)[XB_TMO], 1u); break; } } } } while (0)

struct XcdBarrier {
    unsigned* bar; unsigned x;
    volatile LAS unsigned* st;
};

__device__ __forceinline__ XcdBarrier xcd_barrier_post(unsigned* bar, volatile LAS unsigned* st, int tid) {
    XcdBarrier b; b.bar = bar; b.x = xb_xcc_id(); b.st = st;
    if (tid == 0) (void)xb_add(&bar[XB_XCNT(b.x)], 1u);
    return b;
}
__device__ __forceinline__ void xcd_barrier_complete(unsigned* bar, unsigned x, unsigned& nloc, unsigned& nx) {
    const unsigned G = gridDim.x * gridDim.y * gridDim.z;
    unsigned sum, cnt, mine, sp = 0u;
    for (;;) {
        sum = 0u; cnt = 0u; mine = 0u;
#pragma unroll
        for (unsigned j = 0; j < 16; ++j) { const unsigned c = xb_ld(&bar[XB_XCNT(j)]); sum += c; cnt += (c > 0u) ? 1u : 0u; mine = (j == x) ? c : mine; }
        if (sum == G) break;
        __builtin_amdgcn_s_sleep(1);
        if ((++sp & 255u) == 0u) { if (xb_ld(&bar[XB_TMO])) break; if (sp > XB_SPIN_CAP) { atomicAdd(&bar[XB_TMO], 1u); break; } }
    }
    nloc = mine > 0u ? mine : 1u; nx = cnt > 0u ? cnt : 1u;
}

__device__ __forceinline__ void xcd_barrier(const XcdBarrier& b, int tid) {
    asm volatile("s_waitcnt vmcnt(0)" ::: "memory");
    __syncthreads();
    if (tid == 0) {
        unsigned* bar = b.bar;
        __builtin_amdgcn_s_waitcnt(0);
        unsigned nloc = b.st[0], nx = b.st[1];
        if (nloc == 0u) { xcd_barrier_complete(bar, b.x, nloc, nx); b.st[0] = nloc; b.st[1] = nx; }
        const unsigned old = xb_add(&bar[XB_XSUB(b.x)], 1u);
        const unsigned gen = old / nloc;
        if (old + 1u == (gen + 1u) * nloc) {
            __builtin_amdgcn_fence(__ATOMIC_RELEASE, "agent");
            asm volatile("s_waitcnt vmcnt(0)" ::: "memory");
            const unsigned og = xb_add(&bar[XB_TOP], 1u);
            const unsigned tg = og / nx;
            if (og + 1u == (tg + 1u) * nx) xb_add(&bar[XB_TOPGEN], 1u);
            else XB_SPIN(xb_ld(&bar[XB_TOPGEN]) == tg, bar);
            __builtin_amdgcn_fence(__ATOMIC_ACQUIRE, "agent");
            xb_add(&bar[XB_XGEN(b.x)], 1u);
            asm volatile("s_waitcnt vmcnt(0)" ::: "memory");
        } else {
            XB_SPIN(xb_ld(&bar[XB_XGEN(b.x)]) == gen, bar);
            __builtin_amdgcn_fence(__ATOMIC_ACQUIRE, "agent");
            asm volatile("s_waitcnt vmcnt(0)" ::: "memory");
        }
    }
    __syncthreads();
}
struct Params { const float* in[18]; float* out; unsigned char* ws; int ph_lo, ph_hi; };

typedef const __attribute__((address_space(4))) Params* KP;
#define KARGS() KP pp = (KP)__builtin_amdgcn_kernarg_segment_ptr(); asm volatile("" : "+s"(pp))
#ifndef PEER_FP8
#define PEER_FP8 1
#endif
#ifndef PEER_I8
#define PEER_I8 1
#endif
#ifndef G4P
#define G4P 0
#endif
#ifndef STAGGER_TICKS
#define STAGGER_TICKS 0
#endif
#ifndef PROBE_DUP
#define PROBE_DUP 0
#endif
#define PH_ON(k, bit) ((PH_MASK & (bit)) && ph_lo <= (k) && (k) < ph_hi)
constexpr int CW_BAR = 4096;
constexpr int MISC_OFF = 131072 + 320;
__device__ __forceinline__ int lane_id_opaque() { int l; asm volatile("v_mbcnt_lo_u32_b32 %0, -1, 0\n\tv_mbcnt_hi_u32_b32 %0, -1, %0" : "=v"(l)); return l; }
#define PH_SYNC(k) do { if ((k) > ph_lo) { { KP pq = (KP)__builtin_amdgcn_kernarg_segment_ptr(); \
    XcdBarrier xb_; xb_.bar = (unsigned*)(pq->ws + WS_CTL) + CW_BAR; xb_.x = xb_xcc_id(); xb_.st = (volatile LAS unsigned*)(lds + MISC_OFF) + 8; xcd_barrier(xb_, tid); if (PROBE_DUP == 15) { xcd_barrier(xb_, tid); xcd_barrier(xb_, tid); } } } } while (0)
#define PH_IDS() const int lane = lane_id_opaque(); const int tid = wave * 64 + lane

__device__ __forceinline__ void weight_prep(KP pp, int l, LAS float* scr, int gw0, int ngw, int lane) {
    unsigned char* wl = pp->ws + WS_W + (size_t)l * WL_STRIDE;
    const float* g1 = pp->in[2] + (size_t)l * DM; const float* g2 = pp->in[11] + (size_t)l * DM;
    constexpr int N_BR = 3 * 192, N_OUT = 512, N_INQ = N_IN / 8, N_QQ = 2048 / 8;
    static_assert(IN_I8 && Q_I8 && IN_I8_LAYERS == 3, "the flat weight-preparation list is written for the int8 in-projection and query projection");
    for (int it = gw0; it < N_BR + N_OUT + N_INQ + N_QQ; it += ngw) {
        if (it < N_BR) { const int i = it / 192, j = it - 192 * i;
            transpose_item<0>(pp->in[7 + i] + (size_t)l * 384 * DM, 384, DM, (bf16_t*)(wl + WL_BR) + (size_t)i * DM * 384, nullptr, scr, j, 32, lane); }
        else if (it < N_BR + N_OUT) transpose_item<0>(pp->in[10] + (size_t)l * DM * DM, DM, DM, (bf16_t*)(wl + WL_OUT), nullptr, scr, it - N_BR, 32, lane);
        else if (it < N_BR + N_OUT + N_INQ) quant_win_item(pp->in[3] + (size_t)l * DM * IN_COLS, g1, wl + WL_IN, (float*)(wl + WL_INSC), it - N_BR - N_OUT, lane);
        else quant_win_item<0, 2048>(pp->in[12] + (size_t)l * DM * 2048, g2, wl + WL_Q, (float*)(wl + WL_Q + WL_QSC), it - N_BR - N_OUT - N_INQ, lane);
    }
}

#ifndef HALF_PRIO
#define HALF_PRIO 0
#endif
template <int l>
__device__ __forceinline__ void layer_phases(const int ph_lo, const int ph_hi, LAS unsigned char* lds, const int wave) {
    constexpr int pb = 1 + 8 * l;
        if (PH_ON(pb + 0, 2)) {
            PH_IDS(); PH_SYNC(pb + 0); KARGS();
            unsigned char* ws = pp->ws; unsigned char* wl = ws + WS_W + (size_t)l * WL_STRIDE;
            const int G = gridDim.x;
            constexpr bool I8L = IN_I8 && ((IN_I8_LAYERS >> l) & 1);
            pg8::Gemm g{(const bf16_t*)(ws + (I8L ? WS_A8 : WS_HB)), (const bf16_t*)(wl + WL_IN), T, N_IN, I8L ? DM / 2 : DM, I8L ? DM / 2 : DM};
            pg8::StaticOrder S; S.init(T, N_IN, G, (int)blockIdx.x);
            EpiInT<I8L> E{(bf16_t*)(ws + WS_P), (bf16_t*)(ws + WS_G), (const float*)(ws + WS_SSQ1), (const float*)(ws + WS_ROPE), pp->in[6] + (size_t)l * 3 * DM, pp->in[4] + (size_t)l * 6, (float*)(ws + WS_LOGF), 0,
                    (const float*)(ws + WS_SA), (const float*)(wl + WL_INSC)};
            if (STAGGER_TICKS > 0 && (blockIdx.x & 1)) { const unsigned long long t0_ = __builtin_amdgcn_s_memrealtime(); while (__builtin_amdgcn_s_memrealtime() - t0_ < (unsigned long long)STAGGER_TICKS) __builtin_amdgcn_s_sleep(20); }
            pg8::gemm_phase<EpiInT<I8L>, pg8::StaticOrder, true, true, I8L>(lds, g, S, E, tid);
            if (PROBE_DUP == 1) { __syncthreads(); pg8::gemm_phase<EpiInT<I8L>, pg8::StaticOrder, true, true, I8L>(lds, g, S, E, tid); }
            if (PROBE_DUP == 13) { __syncthreads(); EpiInT<I8L> En = E; En.nostore = 1; pg8::gemm_phase<EpiInT<I8L>, pg8::StaticOrder, true, true, I8L>(lds, g, S, En, tid); }
            if (PROBE_DUP == 12) { __syncthreads(); EpiDry Ed{(float*)(ws + WS_CTL) + 8192}; pg8::gemm_phase<EpiDry, pg8::StaticOrder, true, true>(lds, g, S, Ed, tid); }
        }
        if (PH_ON(pb + 1, 4)) {
            PH_IDS(); PH_SYNC(pb + 1); KARGS();
            float* logf = (float*)(pp->ws + WS_LOGF); float* cumT = (float*)(pp->ws + WS_CUMT);
            LAS float* wt = (LAS float*)lds;
            for (int r = (int)blockIdx.x * 512 + tid; r < BATCH * 6 * SEQ; r += (int)gridDim.x * 512) {
                const int sq = r >> 13, sp_ = r & (SEQ - 1), b = sq / 6, h = sq % 6;
                const bf16_t* kr = (const bf16_t*)(pp->ws + WS_P) + ((size_t)b * SEQ + sp_) * NP + PC_KB + 64 * h;
                float n2 = 0.f;
#pragma unroll
                for (int c = 0; c < 8; ++c) { const u32x4 kk = *(const u32x4*)(kr + 8 * c);
                    n2 += (bflo(kk.x) * bflo(kk.x) + bfhi(kk.x) * bfhi(kk.x)) + (bflo(kk.y) * bflo(kk.y) + bfhi(kk.y) * bfhi(kk.y)) + (bflo(kk.z) * bflo(kk.z) + bfhi(kk.z) * bfhi(kk.z)) + (bflo(kk.w) * bflo(kk.w) + bfhi(kk.w) * bfhi(kk.w)); }
#pragma unroll
                for (int o = 1; o < 64; o <<= 1) n2 = fmaxf(n2, __shfl_xor(n2, o));
                if (lane == 0) atomicMax((unsigned*)(pp->ws + WS_KMAX_BASE + 256 * l) + sq, __float_as_uint(n2));
            }
            if (l + 1 < DEPTH && (int)blockIdx.x >= BATCH * 6 && (int)gridDim.x > BATCH * 6)
                weight_prep(pp, l + 1, (LAS float*)(lds + wave * 8448), ((int)blockIdx.x - BATCH * 6) * 8 + wave, ((int)gridDim.x - BATCH * 6) * 8, lane);
            for (int sq = blockIdx.x; sq < BATCH * 6; sq += gridDim.x) {
                const int b = sq / 6, h = sq % 6;
                float* base = logf + (size_t)b * SEQ * 8 + h;
                float v[16]; float run = 0.f;
#pragma unroll
                for (int i = 0; i < 16; ++i) { run += base[(size_t)(tid * 16 + i) * 8]; v[i] = run; }
                float inc = run;
#pragma unroll
                for (int o = 1; o < 64; o <<= 1) { const float n = __shfl_up(inc, o); if (lane >= o) inc += n; }
                __syncthreads();
                if (lane == 63) wt[wave] = inc;
                __syncthreads();
                float off = inc - run;
                for (int w = 0; w < wave; ++w) off += wt[w];
#pragma unroll
                for (int i = 0; i < 16; ++i) cumT[(size_t)sq * SEQ + tid * 16 + i] = (v[i] + off) * LOG2E;
            }
        }
        if (PH_ON(pb + 2, 8)) {
            PH_IDS(); PH_SYNC(pb + 2); KARGS();
            if (HALF_PRIO && __builtin_amdgcn_readfirstlane(wave) >= 4) __builtin_amdgcn_s_setprio(1);
            if (ATT_XCD && MIXA_3PASS == 0) attention_phase_x(pp->ws, pp->in[5] + (size_t)l * 6, CW_ATT + 64 * l, (int)(WS_KMAX_BASE / 4) + 64 * l, lds, wave, lane, (int)xb_xcc_id());
            else if (MIXA_3PASS == 4) {
                attention_phase_v2(pp->ws, pp->in[5] + (size_t)l * 6, CW_ATT + 64 * l, (int)(WS_KMAX_BASE / 4) + 64 * l, lds, wave, lane, 0);
                { KP pq = (KP)__builtin_amdgcn_kernarg_segment_ptr(); XcdBarrier xb_; xb_.bar = (unsigned*)(pq->ws + WS_CTL) + CW_BAR; xb_.x = xb_xcc_id(); xb_.st = (volatile LAS unsigned*)(lds + MISC_OFF) + 8; xcd_barrier(xb_, tid); }
                KP pq2 = (KP)__builtin_amdgcn_kernarg_segment_ptr();
                attention_phase_v2(pq2->ws, pq2->in[5] + (size_t)l * 6, CW_ATT + 64 * l, (int)(WS_KMAX_BASE / 4) + 64 * l, lds, wave, lane, 1);
            }
            else attention_phase(pp->ws, pp->in[5] + (size_t)l * 6, CW_ATT + 64 * l, CW_GRP + 512 * l, (int)(WS_KMAX_BASE / 4) + 64 * l, lds, wave, lane, 0);
            if (HALF_PRIO) __builtin_amdgcn_s_setprio(0);
            if (PROBE_DUP == 21) { __syncthreads(); KP pq3 = (KP)__builtin_amdgcn_kernarg_segment_ptr(); attention_phase(pq3->ws, pq3->in[5] + (size_t)l * 6, CW_ATT + 64 * l + 16, CW_GRP + 512 * l, (int)(WS_KMAX_BASE / 4) + 64 * l, lds, wave, lane, 1); }
        }
        if (PH_ON(pb + 3, 16)) {
            PH_IDS(); PH_SYNC(pb + 3); KARGS();
            unsigned char* ws = pp->ws; unsigned char* wl = ws + WS_W + (size_t)l * WL_STRIDE;
            bf16_t* P = (bf16_t*)(ws + WS_P);
            for (int rep = 0; rep < (PROBE_DUP == 6 ? 2 : 1); ++rep) {
                pg8::Gemm g{P, (const bf16_t*)(wl + WL_BR), T, DM, 384, NP};
                BranchOrder S; S.init(T, DM, (int)gridDim.x, (int)blockIdx.x);
                EpiBrChain E{(const unsigned char*)(ws + WS_G), P + PC_MERGED};
                pg8::gemm_phase<EpiBrChain, BranchOrder, true, true>(lds, g, S, E, tid);
                __syncthreads();
            }
        }
        if (PH_ON(pb + 4, 32)) {
            PH_IDS(); PH_SYNC(pb + 4); KARGS();
            unsigned char* ws = pp->ws; unsigned char* wl = ws + WS_W + (size_t)l * WL_STRIDE;
            pg8::Gemm g{(const bf16_t*)(ws + WS_P) + PC_MERGED, (const bf16_t*)(wl + WL_OUT), T, DM, DM, NP};
            pg8::StaticOrder S; S.init(T, DM, (int)gridDim.x, (int)blockIdx.x);
            EpiOut E{l == 0 ? pp->in[0] : pp->out, pp->out, (bf16_t*)(ws + WS_HB), (float*)(ws + WS_SSQ2P)};
            pg8::gemm_phase<EpiOut, pg8::StaticOrder, true, true>(lds, g, S, E, tid);
            if (PROBE_DUP == 22) { __syncthreads(); EpiDry Ed{(float*)(ws + WS_CTL) + 8192}; pg8::gemm_phase<EpiDry, pg8::StaticOrder, true, true>(lds, g, S, Ed, tid); }
        }
        if (PH_ON(pb + 5, 64)) {
            PH_IDS(); PH_SYNC(pb + 5); KARGS();
            unsigned char* ws = pp->ws; unsigned char* wl = ws + WS_W + (size_t)l * WL_STRIDE;
            for (int rep = 0; rep < (PROBE_DUP == 7 ? 2 : 1); ++rep) {
            {
                if (Q_I8) {
                    const int t0_ = ((int)blockIdx.x * 8 + wave) * 16;
                    for (int hb_ = 0; hb_ < (PROBE_DUP == 18 ? 8 : 2); ++hb_) {
                        u32x4 xa[8], xb[8];
#pragma unroll
                        for (int tt = 0; tt < 8; ++tt) { const bf16_t* xr = (const bf16_t*)(ws + WS_HB) + (size_t)(t0_ + 8 * (hb_ & 1) + tt) * DM + 8 * lane; xa[tt] = *(const u32x4*)xr; xb[tt] = *(const u32x4*)(xr + 512); }
#pragma unroll
                        for (int tt = 0; tt < 8; ++tt) {
                            const float f[16] = {bflo(xa[tt].x), bfhi(xa[tt].x), bflo(xa[tt].y), bfhi(xa[tt].y), bflo(xa[tt].z), bfhi(xa[tt].z), bflo(xa[tt].w), bfhi(xa[tt].w),
                                                 bflo(xb[tt].x), bfhi(xb[tt].x), bflo(xb[tt].y), bfhi(xb[tt].y), bflo(xb[tt].z), bfhi(xb[tt].z), bflo(xb[tt].w), bfhi(xb[tt].w)};
                            quant_arow_i8(f, ws + WS_XQ + (size_t)(t0_ + 8 * (hb_ & 1) + tt) * DM, (float*)(ws + WS_SX) + t0_ + 8 * (hb_ & 1) + tt, lane);
                        }
                    }
                    { KP pq = (KP)__builtin_amdgcn_kernarg_segment_ptr(); XcdBarrier xb_; xb_.bar = (unsigned*)(pq->ws + WS_CTL) + CW_BAR; xb_.x = xb_xcc_id(); xb_.st = (volatile LAS unsigned*)(lds + MISC_OFF) + 8; xcd_barrier(xb_, tid); }
                }
                pg8::Gemm g{(const bf16_t*)(ws + (Q_I8 ? WS_XQ : WS_HB)), (const bf16_t*)(wl + WL_Q), T, 2048, Q_I8 ? DM / 2 : DM, Q_I8 ? DM / 2 : DM};
                pg8::StaticOrder S; S.init(T, 2048, (int)gridDim.x, (int)blockIdx.x);
                EpiQT<Q_I8 != 0> E{(bf16_t*)(ws + WS_Q2), (const float*)(ws + WS_SSQ2P), (const float*)(ws + WS_SX), (const float*)(wl + WL_Q + WL_QSC)};
                pg8::gemm_phase<EpiQT<Q_I8 != 0>, pg8::StaticOrder, true, true, Q_I8 != 0>(lds, g, S, E, tid);
                if (PROBE_DUP == 17) { __syncthreads(); pg8::gemm_phase<EpiQT<Q_I8 != 0>, pg8::StaticOrder, true, true, Q_I8 != 0>(lds, g, S, E, tid); }
            }
            __syncthreads();
            }
        }
        if (PH_ON(pb + 6, 128)) {
            PH_IDS(); PH_SYNC(pb + 6); KARGS();
            unsigned char* ws = pp->ws;
            if (PROBE_DUP == 3) { routing_phase((const bf16_t*)(ws + WS_Q2), pp->in[13] + (size_t)l * 128 * 128, pp->in[14] + (size_t)l * 128 * 128, (int*)(ws + WS_IDS), (float*)(ws + WS_GW), lds, tid); __syncthreads(); }
            routing2_setup(pp->in[13] + (size_t)l * 128 * 128, pp->in[14] + (size_t)l * 128 * 128, lds, tid);
            if (wave < 4) routing2_units((const bf16_t*)(ws + WS_Q2), (int*)(ws + WS_IDS), (float*)(ws + WS_GW), lds, wave, lane, (int)blockIdx.x * 8 + wave, (int)gridDim.x * 8);
            if (PEER_I8) {
                const float* u = pp->in[15] + (size_t)l * N_EXP * DM; const float* v = pp->in[16] + (size_t)l * N_EXP * DM;
                const float* g2 = pp->in[11] + (size_t)l * DM;
                {
                    const int rstep = (int)gridDim.x * 8;
                    int r = (int)blockIdx.x * 8 + wave;
                    f32x4 cu[4], cv[4], nu[4], nv[4];
                    if (r < N_EXP) { quant_row_load(cu, u + (size_t)r * DM, lane); quant_row_load(cv, v + (size_t)r * DM, lane); }
                    for (; r < N_EXP; r += rstep) {
                        const int rn = r + rstep;
                        if (rn < N_EXP) { quant_row_load(nu, u + (size_t)rn * DM, lane); quant_row_load(nv, v + (size_t)rn * DM, lane); }
                        quant_row_finish(cu, g2, ws + WS_U8 + (size_t)r * DM, (float*)(ws + WS_SU) + r, 0, lane);
                        quant_row_finish(cv, nullptr, ws + WS_V8 + (size_t)r * DM, (float*)(ws + WS_SV) + r, G5_VDOT4 ? 0 : 128, lane);
#pragma unroll
                        for (int j = 0; j < 4; ++j) { cu[j] = nu[j]; cv[j] = nv[j]; }
                    }
                }
            } else if (PEER_FP8) {
                const float* u = pp->in[15] + (size_t)l * N_EXP * DM; const float* v = pp->in[16] + (size_t)l * N_EXP * DM;
                const float* g2 = pp->in[11] + (size_t)l * DM;
                for (int r = (int)blockIdx.x * 8 + wave; r < N_EXP; r += (int)gridDim.x * 8) {
                    quant_row_fp8(u + (size_t)r * DM, g2, ws + WS_U8 + (size_t)r * DM, (float*)(ws + WS_SU) + r, lane);
                    quant_row_fp8(v + (size_t)r * DM, nullptr, ws + WS_V8 + (size_t)r * DM, (float*)(ws + WS_SV) + r, lane);
                }
            } else {
                const float* u = pp->in[15] + (size_t)l * N_EXP * DM; const float* v = pp->in[16] + (size_t)l * N_EXP * DM;
                const float* g2 = pp->in[11] + (size_t)l * DM;
                bf16_t* U16 = (bf16_t*)(ws + WS_U16); bf16_t* V16 = (bf16_t*)(ws + WS_V16);
                for (unsigned e = blockIdx.x * 512 + tid; e < (unsigned)(N_EXP * DM / 8); e += gridDim.x * 512) {
                    const unsigned o = e * 8; const int c = (int)(o & (DM - 1));
                    const f32x4 a0 = *(const f32x4*)(u + o), a1 = *(const f32x4*)(u + o + 4), s0 = *(const f32x4*)(g2 + c), s1 = *(const f32x4*)(g2 + c + 4);
                    u32x4 w; w.x = cvtpk(a0[0] * s0[0], a0[1] * s0[1]); w.y = cvtpk(a0[2] * s0[2], a0[3] * s0[3]); w.z = cvtpk(a1[0] * s1[0], a1[1] * s1[1]); w.w = cvtpk(a1[2] * s1[2], a1[3] * s1[3]);
                    *(u32x4*)(U16 + o) = w;
                    const f32x4 b0 = *(const f32x4*)(v + o), b1 = *(const f32x4*)(v + o + 4);
                    if (G3_VF16) { w.x = cvtpk_h(b0[0], b0[1]); w.y = cvtpk_h(b0[2], b0[3]); w.z = cvtpk_h(b1[0], b1[1]); w.w = cvtpk_h(b1[2], b1[3]); }
                    else { w.x = cvtpk(b0[0], b0[1]); w.y = cvtpk(b0[2], b0[3]); w.z = cvtpk(b1[0], b1[1]); w.w = cvtpk(b1[2], b1[3]); }
                    *(u32x4*)(V16 + o) = w;
                }
            }
            if (wave >= 4) routing2_units((const bf16_t*)(ws + WS_Q2), (int*)(ws + WS_IDS), (float*)(ws + WS_GW), lds, wave, lane, (int)blockIdx.x * 8 + wave, (int)gridDim.x * 8);
            if (PROBE_DUP == 19) routing2_units((const bf16_t*)(ws + WS_Q2), (int*)(ws + WS_IDS), (float*)(ws + WS_GW), lds, wave, lane, (int)blockIdx.x * 8 + wave, (int)gridDim.x * 8);
        }
        if (PH_ON(pb + 7, 256)) {
            PH_IDS(); PH_SYNC(pb + 7); KARGS();
            unsigned char* ws = pp->ws;
            if (PROBE_DUP == 4) gather_phase(pp->out, (bf16_t*)(ws + WS_HB), (const float*)(ws + WS_SSQ2P), (float*)(ws + WS_SSQ1), (const bf16_t*)(ws + WS_U16), (const bf16_t*)(ws + WS_V16),
                         (const int*)(ws + WS_IDS), (const float*)(ws + WS_GW), pp->in[17], l == DEPTH - 1 ? 1 : 0, (int)blockIdx.x * 8 + wave, (int)gridDim.x * 8, lane, 1);
            if (PROBE_DUP == 5) gather_phase(pp->out, (bf16_t*)(ws + WS_HB), (const float*)(ws + WS_SSQ2P), (float*)(ws + WS_SSQ1), (const bf16_t*)(ws + WS_U16), (const bf16_t*)(ws + WS_V16),
                         (const int*)(ws + WS_IDS), (const float*)(ws + WS_GW), pp->in[17], l == DEPTH - 1 ? 1 : 0, (int)blockIdx.x * 8 + wave, (int)gridDim.x * 8, lane, 1, 511);
            if (PROBE_DUP == 10 || PROBE_DUP == 11) gather5_phase(pp->out, (bf16_t*)(ws + WS_HB), (const float*)(ws + WS_SSQ2P), (float*)(ws + WS_SSQ1), ws + WS_U8, ws + WS_V8, (const float*)(ws + WS_SU), (const float*)(ws + WS_SV),
                         ws + WS_XQ, (const int*)(ws + WS_IDS), (const float*)(ws + WS_GW), pp->in[17], l == DEPTH - 1 ? 1 : 0, lds, wave, (int)blockIdx.x * 8 + wave, lane, 1 | G4P, PROBE_DUP == 10 ? 7 : 0xffff);
            if (HALF_PRIO && __builtin_amdgcn_readfirstlane(wave) >= 4) __builtin_amdgcn_s_setprio(1);
            if (PROBE_DUP == 20) { gather5_phase(pp->out, (bf16_t*)(ws + WS_HB), (const float*)(ws + WS_SSQ2P), (float*)(ws + WS_SSQ1), ws + WS_U8, ws + WS_V8, (const float*)(ws + WS_SU), (const float*)(ws + WS_SV),
                         ws + WS_XQ, (const int*)(ws + WS_IDS), (const float*)(ws + WS_GW), pp->in[17], l == DEPTH - 1 ? 1 : 0, lds, wave, (int)blockIdx.x * 8 + wave, lane, 4, 0xffff, ws + WS_A8, (float*)(ws + WS_SA), Q_I8 ? (const float*)(ws + WS_SX) : nullptr); __syncthreads(); }
            if (PEER_I8) gather5_phase(pp->out, (bf16_t*)(ws + WS_HB), (const float*)(ws + WS_SSQ2P), (float*)(ws + WS_SSQ1), ws + WS_U8, ws + WS_V8, (const float*)(ws + WS_SU), (const float*)(ws + WS_SV),
                         ws + WS_XQ, (const int*)(ws + WS_IDS), (const float*)(ws + WS_GW), pp->in[17], l == DEPTH - 1 ? 1 : 0, lds, wave, (int)blockIdx.x * 8 + wave, lane, 0, 0xffff, ws + WS_A8, (float*)(ws + WS_SA), Q_I8 ? (const float*)(ws + WS_SX) : nullptr);
            else if (PEER_FP8) gather4_phase(pp->out, (bf16_t*)(ws + WS_HB), (const float*)(ws + WS_SSQ2P), (float*)(ws + WS_SSQ1), ws + WS_U8, ws + WS_V8, (const float*)(ws + WS_SU), (const float*)(ws + WS_SV),
                         (const int*)(ws + WS_IDS), (const float*)(ws + WS_GW), pp->in[17], l == DEPTH - 1 ? 1 : 0, lds, wave, (int)blockIdx.x * 8 + wave, lane);
            else gather3_phase(pp->out, (bf16_t*)(ws + WS_HB), (const float*)(ws + WS_SSQ2P), (float*)(ws + WS_SSQ1), (const bf16_t*)(ws + WS_U16), (const unsigned short*)(ws + WS_V16),
                         (const int*)(ws + WS_IDS), (const float*)(ws + WS_GW), pp->in[17], l == DEPTH - 1 ? 1 : 0, lds, wave, (int)blockIdx.x * 8 + wave, lane);
            if (HALF_PRIO) __builtin_amdgcn_s_setprio(0);
        }
}

__global__ void __launch_bounds__(512, 2) mega(Params p) {
    extern __shared__ __attribute__((aligned(16))) unsigned char lds_raw[];
    LAS unsigned char* lds = (LAS unsigned char*)lds_raw;
    const int ph_lo = p.ph_lo, ph_hi = p.ph_hi;
    const int wave = __builtin_amdgcn_readfirstlane(threadIdx.x >> 6);
    if (ph_lo < -1000) cg::this_grid().sync();
    {
        const int tid0 = threadIdx.x;
        for (int u = tid0; u < (LDS_BYTES - 131072) / 4; u += 512) ((LAS unsigned*)(lds + 131072))[u] = 0u;
        __syncthreads();
        if (ph_hi - ph_lo > 1) { KP pq = (KP)__builtin_amdgcn_kernarg_segment_ptr(); (void)xcd_barrier_post((unsigned*)(pq->ws + WS_CTL) + CW_BAR, (volatile LAS unsigned*)(lds + MISC_OFF) + 8, tid0); }
    }

    if (PH_ON(0, 1)) { KARGS();
        const int tid = threadIdx.x, lane = tid & 63;
        unsigned char* ws = pp->ws;
        const int G = gridDim.x, gwave = blockIdx.x * 8 + wave, ngw = G * 8;
        LAS float* scr = (LAS float*)(lds + wave * 8448);
        for (int rep = 0; rep < (PROBE_DUP == 8 ? 2 : 1); ++rep) {
        if (wave < 4) weight_prep(pp, 0, scr, gwave, ngw, lane);
        {
            const int* pos = (const int*)pp->in[1];
            float* rope = (float*)(ws + WS_ROPE);
            const float inv_freq = (float)exp2(-(double)(tid & 31) * (13.287712379549449 / 32.0));
            for (int e = blockIdx.x * 512 + tid; e < T * 32; e += G * 512) {
                const int t = e >> 5;
                const float ang = (float)pos[t] * inv_freq;
                double rv = (double)ang * 0.15915494309189535; rv -= floor(rv);
                const float rf = (float)rv;
                rope[2 * e] = __builtin_amdgcn_cosf(rf); rope[2 * e + 1] = __builtin_amdgcn_sinf(rf);
            }
        }
        {
            bf16_t* HB = (bf16_t*)(ws + WS_HB); float* ssq1 = (float*)(ws + WS_SSQ1);
            f32x4 vn[4];
            { const f32x4* xr0 = (const f32x4*)(pp->in[0] + (size_t)gwave * DM) + lane;
#pragma unroll
              for (int j = 0; j < 4; ++j) vn[j] = xr0[64 * j]; }
            for (int t = gwave; t < T; t += ngw) {
                f32x4 v[4]; float ss = 0.f;
#pragma unroll
                for (int j = 0; j < 4; ++j) v[j] = vn[j];
                if (t + ngw < T) { const f32x4* xr1 = (const f32x4*)(pp->in[0] + (size_t)(t + ngw) * DM) + lane;
#pragma unroll
                    for (int j = 0; j < 4; ++j) vn[j] = xr1[64 * j]; }
#pragma unroll
                for (int j = 0; j < 4; ++j) ss += (v[j][0] * v[j][0] + v[j][1] * v[j][1]) + (v[j][2] * v[j][2] + v[j][3] * v[j][3]);
                ss = wave_sum(ss);
                u32x2* br = (u32x2*)(HB + (size_t)t * DM) + lane;
#pragma unroll
                for (int j = 0; j < 4; ++j) { u32x2 w; w.x = cvtpk(v[j][0], v[j][1]); w.y = cvtpk(v[j][2], v[j][3]); br[64 * j] = w; }
                if (lane == 0) ssq1[t] = ss;
                if (IN_I8) {
                    float am = 0.f;
#pragma unroll
                    for (int j = 0; j < 4; ++j) am = fmaxf(am, fmaxf(fmaxf(fabsf(v[j][0]), fabsf(v[j][1])), fmaxf(fabsf(v[j][2]), fabsf(v[j][3]))));
#pragma unroll
                    for (int o = 1; o < 64; o <<= 1) am = fmaxf(am, __shfl_xor(am, o));
                    const float inv = am > 0.f ? 127.0f / am : 0.f;
                    unsigned* ar = (unsigned*)(ws + WS_A8 + (size_t)t * DM) + lane;
#pragma unroll
                    for (int j = 0; j < 4; ++j) {
                        int q0 = (int)rintf(v[j][0] * inv), q1 = (int)rintf(v[j][1] * inv), q2 = (int)rintf(v[j][2] * inv), q3 = (int)rintf(v[j][3] * inv);
                        ar[64 * j] = (unsigned)(q0 & 255) | ((unsigned)(q1 & 255) << 8) | ((unsigned)(q2 & 255) << 16) | ((unsigned)(q3 & 255) << 24);
                    }
                    if (lane == 0) ((float*)(ws + WS_SA))[t] = am > 0.f ? am / 127.0f : 0.f;
                }
            }
        }
        if (wave >= 4) weight_prep(pp, 0, scr, gwave, ngw, lane);
        }
    }

    layer_phases<0>(ph_lo, ph_hi, lds, wave);
    layer_phases<1>(ph_lo, ph_hi, lds, wave);
    static_assert(DEPTH == 2, "two layers");
}

#ifndef MK_PER_PHASE
#define MK_PER_PHASE 0
#endif
extern "C" void kernel_launch(void* const* d_in, const int* in_sizes, int n_in, void* d_out, int out_size, void* d_ws, size_t ws_size, hipStream_t stream) {
    static int grid = 0;
    if (grid == 0) {
        if (n_in != 18 || in_sizes[0] != T * DM || out_size != T * DM || ws_size < WS_END) {
            fprintf(stderr, "kernel_launch: unexpected shapes (n_in %d, in0 %d, out %d, ws %zu); nothing launched\n", n_in, n_in > 0 ? in_sizes[0] : -1, out_size, ws_size); grid = -1; return; }
        int dev = 0, cus = 0, per_cu = 0;
        (void)hipGetDevice(&dev);
        (void)hipDeviceGetAttribute(&cus, hipDeviceAttributeMultiprocessorCount, dev);
        (void)hipFuncSetAttribute((const void*)mega, hipFuncAttributeMaxDynamicSharedMemorySize, LDS_BYTES);
        (void)hipOccupancyMaxActiveBlocksPerMultiprocessor(&per_cu, (const void*)mega, 512, LDS_BYTES);
        if (per_cu < 1) { fprintf(stderr, "kernel_launch: occupancy query says %d blocks per CU\n", per_cu); per_cu = 1; }
        (void)hipGetLastError();
        if (cus < 256) { fprintf(stderr, "kernel_launch: built for a 256-CU device (found %d); nothing launched\n", cus); grid = -1; return; }
        grid = 256;
    }
    if (grid < 0) return;
    (void)hipMemsetAsync((char*)d_ws + WS_CTL, 0, CTL_ZERO_BYTES, stream);
    Params p{};
    for (int i = 0; i < 18; ++i) p.in[i] = (const float*)d_in[i];
    p.out = (float*)d_out; p.ws = (unsigned char*)d_ws;
#if MK_PER_PHASE
    for (int ph = 0; ph < NPH; ++ph) {
        p.ph_lo = ph; p.ph_hi = ph + 1;
        void* args[] = {&p};
        hipError_t e = hipLaunchCooperativeKernel((const void*)mega, dim3(grid), dim3(512), args, LDS_BYTES, stream);
        if (e != hipSuccess) { fprintf(stderr, "cooperative launch %d failed: %s\n", ph, hipGetErrorString(e)); break; }
    }
#else
    p.ph_lo = 0; p.ph_hi = NPH;
    void* args[] = {&p};
    hipError_t e = hipLaunchCooperativeKernel((const void*)mega, dim3(grid), dim3(512), args, LDS_BYTES, stream);
    if (e != hipSuccess) fprintf(stderr, "cooperative launch failed: %s (grid %d)\n", hipGetErrorString(e), grid);
#endif
}
```

```cpp
#include <hip/hip_runtime.h>
#include <hip/hip_cooperative_groups.h>
#include <cstdio>
#include <cstdint>
#include <cmath>
namespace cg = cooperative_groups;
namespace pg8 {
#define PG8_LAS __attribute__((address_space(3)))
typedef unsigned short bf16_t;
typedef short bf16x8 __attribute__((ext_vector_type(8)));
typedef float f32x4 __attribute__((ext_vector_type(4)));
typedef unsigned u32x4 __attribute__((ext_vector_type(4)));
typedef int i32x4 __attribute__((ext_vector_type(4)));
typedef long i64x2 __attribute__((ext_vector_type(2)));
#ifndef PG8_I8_SPLIT
#define PG8_I8_SPLIT 0
#endif
#ifndef PG8_I8_ASM
#define PG8_I8_ASM 0
#endif
constexpr int BM = 256, BK = 64, HALF = 128, HTB = HALF * BK * 2  , STAGE_BYTES = 8 * HTB, NXCD = 8, WGM = 8;

__host__ __device__ __forceinline__ int lds_byte(int r, int c) { const int st = (r >> 4) * 2 + (c >> 5), rr = r & 15, cc = c & 31, ob = rr * 64 + cc * 2; return st * 1024 + (ob ^ (((ob >> 9) & 1) << 5)); }
__host__ __device__ __forceinline__ void stage_rc(int b, int& R, int& C) { const int st = b / 1024, sb = b % 1024, swz = sb ^ (((sb >> 9) & 1) << 5); R = (st >> 1) * 16 + swz / 64; C = (st & 1) * 32 + (swz % 64) / 2; }
__host__ __device__ __forceinline__ int perm32(int rho) { const int n = rho >> 4, i = rho & 15; return 8 * (i >> 2) + 4 * n + (i & 3); }

struct Unit { int pm, pn, br; };
struct Gemm { const bf16_t* A; const bf16_t* Bt; int M, N, K, lda; };

struct StaticOrder {
    int nM, nN, nwg, G, c;
    __host__ __device__ void init(int M, int N, int G_, int c_) { nM = M / BM; nN = N / BM; nwg = nM * nN; G = G_; c = c_; }
    __host__ __device__ bool next(int i, Unit& u) const {
        const long L = (long)i * G + c; if (L >= nwg) return false;
        int wgid = (int)L; { const int q = nwg / NXCD, r = nwg % NXCD, xcd = wgid % NXCD, off = wgid / NXCD; wgid = (xcd < r ? xcd * (q + 1) : r * (q + 1) + (xcd - r) * q) + off; }
        const int nig = WGM * nN, gid = wgid / nig, fm = gid * WGM, gsz = (nM - fm) < WGM ? (nM - fm) : WGM;
        u.pm = fm + ((wgid % nig) % gsz); u.pn = (wgid % nig) / gsz; u.br = 0; return true;
    }
    __device__ __forceinline__ size_t a_off(const Unit&) const { return 0; }
    __device__ __forceinline__ size_t b_off(const Unit&) const { return 0; }
    __device__ __forceinline__ void a_ready(const Unit&) const {}
    __device__ __forceinline__ void done(const Unit&) const {}
};

__device__ __forceinline__ unsigned cvt_pk_bf16(float lo, float hi) { unsigned r; asm volatile("v_cvt_pk_bf16_f32 %0, %1, %2" : "=v"(r) : "v"(lo), "v"(hi)); return r; }
typedef float f32x2 __attribute__((ext_vector_type(2)));
__device__ __forceinline__ f32x2 gelu_pk(f32x2 v) {
    const f32x2 av = __builtin_elementwise_abs(v), d = av * 0.2316418882f + 1.0f;
    f32x2 t; t.x = __builtin_amdgcn_rcpf(d.x); t.y = __builtin_amdgcn_rcpf(d.y);
    f32x2 q = t * 0.5307027145f + (-0.7265760135f); q = q * t + 0.7107068705f; q = q * t + (-0.142248368f); q = q * t + 0.127414796f; q = q * t;
    const f32x2 s = (v * v) * (-0.72134752044f);
    f32x2 e; e.x = __builtin_amdgcn_exp2f(s.x); e.y = __builtin_amdgcn_exp2f(s.y);
    const f32x2 m = v * (q * e), r = v - m;
    f32x2 o; o.x = v.x < 0.f ? m.x : r.x; o.y = v.y < 0.f ? m.y : r.y; return o;
}

template <int ACT  > struct EpiBf16 {
    static constexpr bool PERM = true, AFTER_DRAIN = false; static_assert(ACT == 0 || ACT == 1, "EpiBf16: ACT is 0 (none) or 1 (gelu_pk)");
    bf16_t* O; int ldc; const float* bias; int split_cols; size_t split_stride; float scale0;
    __device__ __forceinline__ void operator()(const f32x4 (&acc)[2][2][4][2], const Unit& u, int wr, int wc, int fr, int fq) const {
        const int row0 = u.pm * BM + wr * 64 + fr; int colt = u.pn * BM; bf16_t* base = O;
        float sc = 1.f; if (split_cols) { const int t = colt / split_cols; base += (size_t)t * split_stride; colt -= t * split_cols; if (t == 0) sc = scale0; }
        const int col0 = colt + wc * 32 + 8 * fq, bcol0 = u.pn * BM + wc * 32 + 8 * fq;
        f32x4 bv[2][2];
#pragma unroll
        for (int bj = 0; bj < 2; ++bj)
#pragma unroll
            for (int n = 0; n < 2; ++n) bv[bj][n] = bias ? *(const f32x4*)(bias + bcol0 + bj * HALF + 4 * n) : (f32x4){0.f, 0.f, 0.f, 0.f};
#pragma unroll
        for (int ai = 0; ai < 2; ++ai)
#pragma unroll
            for (int m = 0; m < 4; ++m) { bf16_t* rowp = base + (size_t)(row0 + ai * HALF + m * 16) * ldc + col0;
#pragma unroll
                for (int bj = 0; bj < 2; ++bj) { f32x4 v0 = acc[ai][bj][m][0] + bv[bj][0], v1 = acc[ai][bj][m][1] + bv[bj][1];
                    if (ACT == 1) { f32x2 a = gelu_pk((f32x2){v0[0], v0[1]}), b = gelu_pk((f32x2){v0[2], v0[3]}), c = gelu_pk((f32x2){v1[0], v1[1]}), d = gelu_pk((f32x2){v1[2], v1[3]});
                        v0 = (f32x4){a.x, a.y, b.x, b.y}; v1 = (f32x4){c.x, c.y, d.x, d.y}; }
                    v0 = v0 * sc; v1 = v1 * sc; u32x4 w; w.x = cvt_pk_bf16(v0[0], v0[1]); w.y = cvt_pk_bf16(v0[2], v0[3]); w.z = cvt_pk_bf16(v1[0], v1[1]); w.w = cvt_pk_bf16(v1[2], v1[3]);
                    *(u32x4*)(rowp + bj * HALF) = w; } }
    }
};
template <class Epi, class Sched, bool ALIGN_EPI = false, bool SP2 = false, bool I8 = false>
__device__ __forceinline__ void gemm_phase(PG8_LAS unsigned char* lds, const Gemm g, const Sched& S, const Epi& E, const int tid) {
    const int wid = __builtin_amdgcn_readfirstlane(tid >> 6), lane = tid & 63, wr = wid >> 2, wc = wid & 3, fr = lane & 15, fq = lane >> 4;
    const int K = g.K, nt = K / BK;
    unsigned voffA[2], voffB[2];
#pragma unroll
    for (int i = 0; i < 2; ++i) { int R, C; stage_rc(tid * 16 + i * 8192, R, C); const int Rb = Epi::PERM ? ((R & ~31) + perm32(R & 31)) : R;
        voffA[i] = (unsigned)(R * g.lda + C) * 2u; voffB[i] = (unsigned)(Rb * K + C) * 2u; }
    const size_t kstep = (size_t)(BK * 2);
    const size_t hstep = (size_t)HALF * K * 2;
    const size_t tstep = 2 * hstep; const size_t hstepA = (size_t)HALF * g.lda * 2, tstepA = 2 * hstepA;
    const unsigned ldsw = (unsigned)wid * 1024u;
    const int aoff = lds_byte(wr * 64 + fr, fq * 8), boff = lds_byte(wc * 32 + fr, fq * 8);
#define PG8_SA(b, h) (((b) * 2 + (h)) * HTB)
#define PG8_SB(b, h) ((4 + (b) * 2 + (h)) * HTB)
#define PG8_STAGE(bufoff, gbase, voff) do { _Pragma("unroll") for (int _i = 0; _i < 2; ++_i) \
        __builtin_amdgcn_global_load_lds((const unsigned*)((const char*)(gbase) + (voff)[_i]), (PG8_LAS unsigned*)(lds + (bufoff) + ldsw + _i * 8192), 16, 0, 0); } while (0)
#define PG8_LDA(dst, b, h) do { _Pragma("unroll") for (int m = 0; m < 4; ++m) _Pragma("unroll") for (int k = 0; k < 2; ++k) dst[m][k] = *(const PG8_LAS bf16x8*)(lds + PG8_SA(b, h) + aoff + m * 2048 + k * 1024); } while (0)
#define PG8_LDB(dst, b, h) do { _Pragma("unroll") for (int n = 0; n < 2; ++n) _Pragma("unroll") for (int k = 0; k < 2; ++k) dst[n][k] = *(const PG8_LAS bf16x8*)(lds + PG8_SB(b, h) + boff + n * 2048 + k * 1024); } while (0)
#define PG8_MMA(ai, bj, At, Bt) do { __builtin_amdgcn_s_setprio(1); \
        if constexpr (I8) {   \
            _Pragma("unroll") for (int k = 0; k < 2; ++k) _Pragma("unroll") for (int m = 0; m < 4; ++m) _Pragma("unroll") for (int n = 0; n < 2; ++n) \
                { if (PG8_I8_ASM) asm volatile("v_mfma_i32_16x16x64_i8 %0, %1, %2, %0" : "+v"(acc[ai][bj][m][n]) : "v"(Bt[n][k]), "v"(At[m][k])); \
                  else acc[ai][bj][m][n] = __builtin_bit_cast(f32x4, __builtin_amdgcn_mfma_i32_16x16x64_i8(__builtin_bit_cast(i32x4, Bt[n][k]), __builtin_bit_cast(i32x4, At[m][k]), __builtin_bit_cast(i32x4, acc[ai][bj][m][n]), 0, 0, 0)); } \
        } else { \
            _Pragma("unroll") for (int m = 0; m < 4; ++m) _Pragma("unroll") for (int n = 0; n < 2; ++n) _Pragma("unroll") for (int k = 0; k < 2; ++k) \
                acc[ai][bj][m][n] = __builtin_amdgcn_mfma_f32_16x16x32_bf16(Bt[n][k], At[m][k], acc[ai][bj][m][n], 0, 0, 0); \
        } __builtin_amdgcn_s_setprio(0); } while (0)
#define PG8_WAIT_V(n) asm volatile("s_waitcnt vmcnt(" #n ")" ::: "memory")
#define PG8_WAIT_L(n) asm volatile("s_waitcnt lgkmcnt(" #n ")" ::: "memory")
#define PG8_BAR __builtin_amdgcn_s_barrier()
#define PG8_SCHED __builtin_amdgcn_sched_barrier(0)
    Unit cur, nxt; int ui = 0;
    if (!S.next(0, cur)) return;
    f32x4 acc[2][2][4][2];
#pragma unroll
    for (int a = 0; a < 2; ++a)
#pragma unroll
        for (int b = 0; b < 2; ++b)
#pragma unroll
            for (int m = 0; m < 4; ++m)
#pragma unroll
                for (int n = 0; n < 2; ++n) acc[a][b][m][n] = (f32x4){0.f, 0.f, 0.f, 0.f};
    bf16x8 At[4][2], B0[2][2], B1[2][2];
    const char* cA = (const char*)g.A + S.a_off(cur) + (size_t)cur.pm * tstepA; const char* cB = (const char*)g.Bt + S.b_off(cur) + (size_t)cur.pn * tstep;
    S.a_ready(cur);
    if constexpr (SP2) {
        PG8_STAGE(PG8_SB(0, 0), cB, voffB); PG8_STAGE(PG8_SB(0, 1), cB + hstep, voffB); PG8_STAGE(PG8_SA(0, 0), cA, voffA); PG8_STAGE(PG8_SA(0, 1), cA + hstepA, voffA);
        if (wr == 1) PG8_BAR;
        PG8_WAIT_V(2); PG8_BAR;
        PG8_STAGE(PG8_SB(1, 0), cB + kstep, voffB); PG8_STAGE(PG8_SA(1, 0), cA + kstep, voffA); PG8_STAGE(PG8_SB(1, 1), cB + hstep + kstep, voffB);
        PG8_WAIT_V(6); PG8_BAR;
    } else {
        PG8_STAGE(PG8_SB(0, 0), cB, voffB); PG8_STAGE(PG8_SA(0, 0), cA, voffA); PG8_STAGE(PG8_SB(0, 1), cB + hstep, voffB); PG8_STAGE(PG8_SA(0, 1), cA + hstepA, voffA);
        if (wr == 1) PG8_BAR;
        PG8_WAIT_V(4); PG8_BAR;
        PG8_STAGE(PG8_SB(1, 0), cB + kstep, voffB); PG8_STAGE(PG8_SA(1, 0), cA + kstep, voffA); PG8_STAGE(PG8_SB(1, 1), cB + hstep + kstep, voffB);
        PG8_WAIT_V(6); PG8_BAR;
    }
    for (;;) {
        const bool has_next = S.next(ui + 1, nxt);
        const char* nA = has_next ? (const char*)g.A + S.a_off(nxt) + (size_t)nxt.pm * tstepA : cA; const char* nB = has_next ? (const char*)g.Bt + S.b_off(nxt) + (size_t)nxt.pn * tstep : cB;
        for (int t = 0; t < nt; t += 2) {
            const bool last = (t == nt - 2);
            const char* a1 = cA + (size_t)(t + 1) * kstep;
            const char* a2 = last ? nA : cA + (size_t)(t + 2) * kstep; const char* b2 = last ? nB : cB + (size_t)(t + 2) * kstep;
            const char* a3 = a2 + kstep; const char* b3 = b2 + kstep;
            if (last && has_next) S.a_ready(nxt);
            if constexpr (SP2) {
            PG8_LDB(B0, 0, 0); PG8_LDB(B1, 0, 1); PG8_SCHED; PG8_LDA(At, 0, 0); PG8_STAGE(PG8_SA(1, 1), a1 + hstepA, voffA);
            PG8_WAIT_V(8); PG8_WAIT_L(0); PG8_BAR; PG8_MMA(0, 0, At, B0); PG8_MMA(0, 1, At, B1); PG8_BAR; PG8_SCHED;
            PG8_LDA(At, 0, 1); PG8_STAGE(PG8_SB(0, 0), b2, voffB); PG8_STAGE(PG8_SB(0, 1), b2 + hstep, voffB); PG8_STAGE(PG8_SA(0, 0), a2, voffA);
            PG8_WAIT_V(8); PG8_WAIT_L(0); PG8_BAR; PG8_MMA(1, 0, At, B0); PG8_MMA(1, 1, At, B1); PG8_BAR; PG8_SCHED;
            PG8_LDB(B0, 1, 0); PG8_LDB(B1, 1, 1); PG8_SCHED; PG8_LDA(At, 1, 0); PG8_STAGE(PG8_SA(0, 1), a2 + hstepA, voffA);
            PG8_WAIT_V(8); PG8_WAIT_L(0); PG8_BAR; PG8_MMA(0, 0, At, B0); PG8_MMA(0, 1, At, B1); PG8_BAR; PG8_SCHED;
            PG8_LDA(At, 1, 1); PG8_STAGE(PG8_SB(1, 0), b3, voffB); PG8_STAGE(PG8_SB(1, 1), b3 + hstep, voffB); PG8_STAGE(PG8_SA(1, 0), a3, voffA);
            PG8_WAIT_V(8); PG8_WAIT_L(0); PG8_BAR; PG8_MMA(1, 0, At, B0); PG8_MMA(1, 1, At, B1); PG8_BAR; PG8_SCHED;
            } else {
            PG8_LDB(B0, 0, 0); PG8_SCHED; PG8_LDA(At, 0, 0); PG8_STAGE(PG8_SA(1, 1), a1 + hstepA, voffA);
            PG8_WAIT_L(8); PG8_BAR; PG8_WAIT_L(0); PG8_MMA(0, 0, At, B0); PG8_BAR; PG8_SCHED;
            PG8_LDB(B1, 0, 1); PG8_STAGE(PG8_SB(0, 0), b2, voffB);
            PG8_BAR; PG8_WAIT_L(0); PG8_MMA(0, 1, At, B1); PG8_BAR;
            PG8_LDA(At, 0, 1); PG8_STAGE(PG8_SA(0, 0), a2, voffA);
            PG8_BAR; PG8_WAIT_L(0); PG8_MMA(1, 0, At, B0); PG8_BAR; PG8_SCHED;
            PG8_STAGE(PG8_SB(0, 1), b2 + hstep, voffB);
            PG8_WAIT_V(6); PG8_BAR; PG8_MMA(1, 1, At, B1); PG8_BAR;
            PG8_LDB(B0, 1, 0); PG8_SCHED; PG8_LDA(At, 1, 0); PG8_STAGE(PG8_SA(0, 1), a2 + hstepA, voffA);
            PG8_WAIT_L(8); PG8_BAR; PG8_WAIT_L(0); PG8_MMA(0, 0, At, B0); PG8_BAR; PG8_SCHED;
            PG8_LDB(B1, 1, 1); PG8_STAGE(PG8_SB(1, 0), b3, voffB);
            PG8_BAR; PG8_WAIT_L(0); PG8_MMA(0, 1, At, B1); PG8_BAR;
            PG8_LDA(At, 1, 1); PG8_STAGE(PG8_SA(1, 0), a3, voffA);
            PG8_BAR; PG8_WAIT_L(0); PG8_MMA(1, 0, At, B0); PG8_BAR; PG8_SCHED;
            PG8_STAGE(PG8_SB(1, 1), b3 + hstep, voffB);
            PG8_WAIT_V(6); PG8_BAR; PG8_MMA(1, 1, At, B1); PG8_BAR;
            }
        }
        if constexpr (I8) { if (PG8_I8_ASM) asm volatile("s_nop 15\n\ts_nop 15" ::: "memory"); }
        if constexpr (ALIGN_EPI) { if (wr == 0) PG8_BAR; }
        if constexpr (!Epi::AFTER_DRAIN) { E(acc, cur, wr, wc, fr, fq); S.done(cur); }
        if (!has_next) break;
        if (!E.keep(cur)) {
#pragma unroll
        for (int a = 0; a < 2; ++a)
#pragma unroll
            for (int b = 0; b < 2; ++b)
#pragma unroll
                for (int m = 0; m < 4; ++m)
#pragma unroll
                    for (int n = 0; n < 2; ++n) acc[a][b][m][n] = (f32x4){0.f, 0.f, 0.f, 0.f};
        }
        cur = nxt; cA = nA; cB = nB; ++ui;
        if constexpr (ALIGN_EPI) { if (wr == 1) PG8_BAR; }
    }
    PG8_WAIT_V(0);
    if constexpr (!ALIGN_EPI) { if (wr == 0) PG8_BAR; }
    PG8_BAR;
    if constexpr (Epi::AFTER_DRAIN) { E.fused(acc, cur, wr, wc, fr, fq, lds, wid, lane); S.done(cur); }
#undef PG8_SA
#undef PG8_SB
#undef PG8_STAGE
#undef PG8_LDA
#undef PG8_LDB
#undef PG8_MMA
#undef PG8_WAIT_V
#undef PG8_WAIT_L
#undef PG8_BAR
#undef PG8_SCHED
}
}

constexpr int BATCH = 4, SEQ = 8192, T = BATCH * SEQ, DM = 1024, DEPTH = 2;
constexpr int IN_COLS = 6022, NP = 3072, N_IN = 6144;
constexpr int N_EXP = 16384;
constexpr int PC_QA = 0, PC_QB = 384, PC_QC = 768, PC_KA = 1152, PC_VA = 1536, PC_KB = 1920, PC_VB = 2304, PC_KC = 2688, PC_VC = 2816, PC_FB = 2944;
constexpr int PC_MERGED = 1152;
constexpr float RMS_EPS = 1e-6f;
constexpr float LOG2E = 1.4426950408889634f;
constexpr float QK_SCALE2 = 0.125f * LOG2E;

constexpr size_t MiB = 1u << 20;
constexpr size_t WS_CTL = 0, CTL_ZERO_BYTES = 65536;
constexpr size_t WS_SSQ1 = 1 * MiB;
constexpr size_t WS_CUMT = 1 * MiB + 256 * 1024;
constexpr size_t WS_LOGF = 2 * MiB;
constexpr size_t WS_KMAX_BASE = 32768;
constexpr size_t WS_ROPE = 3 * MiB;
constexpr size_t WS_W = 12 * MiB, WL_STRIDE = 21 * MiB;
constexpr size_t WL_IN = 0, WL_BR = 12 * MiB, WL_OUT = WL_BR + 2304 * 1024, WL_Q = WL_OUT + 2 * MiB, WL_K12 = WL_Q + 4 * MiB;
static_assert(WL_K12 + 65536 <= WL_STRIDE, "weights");
constexpr size_t WS_HB = 56 * MiB;
constexpr size_t WS_P = 120 * MiB;
constexpr size_t WS_G = 312 * MiB;
constexpr size_t WS_SSQ2P = 504 * MiB;
constexpr size_t WS_END = 506 * MiB;
constexpr size_t WS_Q2 = WS_P;
constexpr size_t WS_IDS = WS_P + 128 * MiB;
constexpr size_t WS_GW = WS_P + 144 * MiB;
constexpr size_t WS_AO = WS_G + 96 * MiB;
constexpr size_t WS_ALSE = WS_G + 96 * MiB + 80 * MiB;
constexpr size_t WS_A8 = WS_G + 128 * MiB;
constexpr size_t WS_SA = WS_G + 160 * MiB;
constexpr size_t WS_SX = WS_G + 161 * MiB;
constexpr size_t WL_QSC = 3 * MiB;
constexpr size_t WL_INSC = 8 * MiB;
constexpr size_t WS_XQ = WS_P + 160 * MiB;
constexpr size_t WS_U16 = WS_G, WS_V16 = WS_G + 32 * MiB;
constexpr size_t WS_U8 = WS_G + 64 * MiB, WS_V8 = WS_G + 80 * MiB, WS_SU = WS_G + 96 * MiB, WS_SV = WS_G + 96 * MiB + 65536;
constexpr int CW_GRP = 10240;
constexpr int CW_ATT = 64;

constexpr int LDS_BYTES = 147456;
constexpr int NPH = 1 + 8 * DEPTH;
#ifndef PH_MASK
#define PH_MASK 511
#endif

#define LAS __attribute__((address_space(3)))
typedef unsigned short bf16_t;
typedef short bf16x8 __attribute__((ext_vector_type(8)));
typedef float f32x4 __attribute__((ext_vector_type(4)));
typedef float f32x16 __attribute__((ext_vector_type(16)));
typedef unsigned u32x4 __attribute__((ext_vector_type(4)));
typedef unsigned u32x2 __attribute__((ext_vector_type(2)));
typedef short v4i16_t __attribute__((ext_vector_type(4)));
typedef float f32x2_t __attribute__((ext_vector_type(2)));
typedef __bf16 bf16x2_t __attribute__((ext_vector_type(2)));

__device__ __forceinline__ unsigned cvtpk(float lo, float hi) { f32x2_t v = {lo, hi}; bf16x2_t b = __builtin_convertvector(v, bf16x2_t); return __builtin_bit_cast(unsigned, b); }
__device__ __forceinline__ float bflo(unsigned u) { return __uint_as_float(u << 16); }
__device__ __forceinline__ float bfhi(unsigned u) { return __uint_as_float(u & 0xffff0000u); }
__device__ __forceinline__ float wave_sum(float v) {
#pragma unroll
    for (int o = 1; o < 64; o <<= 1) v += __shfl_xor(v, o);
    return v;
}
__device__ __forceinline__ float dot2bf(unsigned a, unsigned b, float acc) {
    return fmaf(bfhi(a), bfhi(b), fmaf(bflo(a), bflo(b), acc));
}

__host__ __device__ __forceinline__ int src_col_in(int n) {
    if (n >= 3072) return 2950 + (n - 3072);
    if (n >= 2950) return -1;
    if (n >= 2944) return 2304 + (n - 2944);
    int seg, src; bool rope;
    if (n < 384)       { seg = 0;    src = 0;    rope = true;  }
    else if (n < 768)  { seg = 384;  src = 1152; rope = false; }
    else if (n < 1152) { seg = 768;  src = 2310; rope = true;  }
    else if (n < 1536) { seg = 1152; src = 384;  rope = true;  }
    else if (n < 1920) { seg = 1536; src = 768;  rope = false; }
    else if (n < 2304) { seg = 1920; src = 1536; rope = false; }
    else if (n < 2688) { seg = 2304; src = 1920; rope = false; }
    else if (n < 2816) { seg = 2688; src = 2694; rope = true;  }
    else               { seg = 2816; src = 2822; rope = false; }
    int off = n - seg;
    if (rope) { const int blk = off >> 6, w = off & 63; off = blk * 64 + (w >> 1) + 32 * (w & 1); }
    return src + off;
}

__device__ __forceinline__ float ssq16(const float* __restrict__ pz, int row) {
    const f32x4* q = (const f32x4*)(pz + (size_t)row * 16);
    const f32x4 a = q[0], b = q[1], c = q[2], d = q[3];
    return (((a[0] + a[1]) + (a[2] + a[3])) + ((b[0] + b[1]) + (b[2] + b[3]))) + (((c[0] + c[1]) + (c[2] + c[3])) + ((d[0] + d[1]) + (d[2] + d[3])));
}

template <int MODE>
__device__ __forceinline__ void transpose_item(const float* __restrict__ W, int K, int Nsrc, bf16_t* __restrict__ WT, const float* __restrict__ kscale,
                                               LAS float* scr, int item, int nblk, int lane) {
    const int kb = item / nblk, nb = item % nblk, k0 = 64 * kb, n0 = 32 * nb;
    const int nn = n0 + (lane & 31);
    const int c = (MODE == 1) ? src_col_in(nn) : nn;
#pragma unroll 8
    for (int i = 0; i < 32; ++i) {
        const int kk = 2 * i + (lane >> 5);
        float v = 0.f;
        if (c >= 0) v = W[(size_t)(k0 + kk) * Nsrc + c];
        if (kscale) v *= kscale[k0 + kk];
        if (MODE == 1 && nn >= 3072) v *= -LOG2E;
        scr[kk * 33 + (lane & 31)] = v;
    }
    asm volatile("s_waitcnt lgkmcnt(0)" ::: "memory");
    const int c8 = lane & 7;
#pragma unroll
    for (int j = 0; j < 4; ++j) {
        const int n = (lane >> 3) + 8 * j; const LAS float* s = scr + (8 * c8) * 33 + n;
        u32x4 o; o.x = cvtpk(s[0 * 33], s[1 * 33]); o.y = cvtpk(s[2 * 33], s[3 * 33]); o.z = cvtpk(s[4 * 33], s[5 * 33]); o.w = cvtpk(s[6 * 33], s[7 * 33]);
        *(u32x4*)(WT + (size_t)(n0 + n) * K + k0 + 8 * c8) = o;
    }
    asm volatile("s_waitcnt lgkmcnt(0)" ::: "memory");
}

#ifndef G5_SLICE_SYNC
#define G5_SLICE_SYNC 0
#endif
#ifndef TAIL_FENCE_LIGHT
#define TAIL_FENCE_LIGHT 1
#endif
#ifndef Q2_HEADMAJOR
#define Q2_HEADMAJOR 1
#endif
#ifndef GATE_TILED
#define GATE_TILED 1
#endif
constexpr size_t GROWB = GATE_TILED ? 256 : 3072;
#ifndef IN_I8_LAYERS
#define IN_I8_LAYERS 3
#endif
#ifndef IN_I8
#define IN_I8 1
#endif
template <int MODE = 1, int NSRC = IN_COLS>
__device__ __forceinline__ void quant_win_item(const float* __restrict__ W, const float* __restrict__ kscale, unsigned char* __restrict__ WT8, float* __restrict__ colscale, int item, int lane, bf16_t* deq = nullptr) {
    const int c = lane & 7, rs = lane >> 3, n = 8 * item + c, src = MODE == 1 ? src_col_in(n) : n, k0 = 128 * rs;
    const float post = (MODE == 1 && n >= 3072) ? -LOG2E : 1.0f;
    const float* wp = W + (size_t)k0 * NSRC + (src >= 0 ? src : 0);
    const float* kp = kscale + k0;
    float am = 0.f;
    for (int j = 0; j < 4; ++j) {
        float x[32];
#pragma unroll
        for (int i = 0; i < 32; ++i) x[i] = wp[(size_t)(32 * j + i) * NSRC];
#pragma unroll
        for (int i = 0; i < 32; ++i) am = fmaxf(am, fabsf(x[i] * kp[32 * j + i]));
    }
    if (src < 0) am = 0.f;
    am = fmaxf(am, __shfl_xor(am, 8)); am = fmaxf(am, __shfl_xor(am, 16)); am = fmaxf(am, __shfl_xor(am, 32));
    const float inv = am > 0.f ? 127.0f / am : 0.f;
    unsigned char* dst = WT8 + (size_t)n * DM + k0;
    for (int j = 0; j < 4; ++j) {
        float x[32];
#pragma unroll
        for (int i = 0; i < 32; ++i) x[i] = wp[(size_t)(32 * j + i) * NSRC];
        unsigned w[8];
#pragma unroll
        for (int q = 0; q < 8; ++q) {
            const int b = 4 * q;
            const int q0 = (int)rintf(x[b] * kp[32 * j + b] * inv), q1 = (int)rintf(x[b + 1] * kp[32 * j + b + 1] * inv), q2 = (int)rintf(x[b + 2] * kp[32 * j + b + 2] * inv), q3 = (int)rintf(x[b + 3] * kp[32 * j + b + 3] * inv);
            w[q] = (unsigned)(q0 & 255) | ((unsigned)(q1 & 255) << 8) | ((unsigned)(q2 & 255) << 16) | ((unsigned)(q3 & 255) << 24);
        }
        *(u32x4*)(dst + 32 * j) = (u32x4){w[0], w[1], w[2], w[3]}; *(u32x4*)(dst + 32 * j + 16) = (u32x4){w[4], w[5], w[6], w[7]};
    }
    if (rs == 0) colscale[n] = (am > 0.f ? am / 127.0f : 0.f) * post;
}
__device__ __forceinline__ void quant_arow_i8(const float (&f)[16], unsigned char* __restrict__ dst_row, float* __restrict__ scale_out, int lane) {
    float am = 0.f;
#pragma unroll
    for (int j = 0; j < 16; ++j) am = fmaxf(am, fabsf(f[j]));
#pragma unroll
    for (int o = 1; o < 64; o <<= 1) am = fmaxf(am, __shfl_xor(am, o));
    const float inv = am > 0.f ? 127.0f / am : 0.f;
    unsigned wq[4];
#pragma unroll
    for (int j = 0; j < 4; ++j) {
        const int q0 = (int)rintf(f[4 * j] * inv), q1 = (int)rintf(f[4 * j + 1] * inv), q2 = (int)rintf(f[4 * j + 2] * inv), q3 = (int)rintf(f[4 * j + 3] * inv);
        wq[j] = (unsigned)(q0 & 255) | ((unsigned)(q1 & 255) << 8) | ((unsigned)(q2 & 255) << 16) | ((unsigned)(q3 & 255) << 24);
    }
    *(u32x2*)(dst_row + 8 * lane) = (u32x2){wq[0], wq[1]}; *(u32x2*)(dst_row + 512 + 8 * lane) = (u32x2){wq[2], wq[3]};
    if (lane == 0) *scale_out = am > 0.f ? am / 127.0f : 0.f;
}

#ifndef EPI_NT
#define EPI_NT 1
#endif
template <bool I8> struct EpiInT {
    static constexpr bool PERM = true, AFTER_DRAIN = false;
    __device__ __forceinline__ bool keep(const pg8::Unit&) const { return false; }
    bf16_t* P; bf16_t* G; const float* ssq; const float* rope; const float* bgate; const float* bfg; float* logf; int nostore; const float* sa; const float* swc;
    __device__ __forceinline__ void operator()(const pg8::f32x4 (&acc)[2][2][4][2], const pg8::Unit& u, int wr, int wc, int fr, int fq) const {
        const int colw = u.pn * 256 + wc * 32 + 8 * fq;
        const int row0 = u.pm * 256 + wr * 64 + fr;
        float rsv[8];
#pragma unroll
        for (int i = 0; i < 8; ++i) rsv[i] = ssq[row0 + (i >> 2) * 128 + (i & 3) * 16];
#pragma unroll
        for (int i = 0; i < 8; ++i) rsv[i] = rsqrtf(rsv[i] * (1.0f / 1024.0f) + RMS_EPS);
        f32x4 swv[2][2];
        if constexpr (I8) {
            float sav[8];
#pragma unroll
            for (int i = 0; i < 8; ++i) sav[i] = sa[row0 + (i >> 2) * 128 + (i & 3) * 16];
#pragma unroll
            for (int i = 0; i < 8; ++i) rsv[i] *= sav[i];
#pragma unroll
            for (int bj = 0; bj < 2; ++bj) { swv[bj][0] = *(const f32x4*)(swc + colw + bj * 128); swv[bj][1] = *(const f32x4*)(swc + colw + bj * 128 + 4); }
        }
#define EPIIN_ACC(ai, bj, m, n, e) (I8 ? (float)__float_as_int(acc[ai][bj][m][n][e]) * swv[bj][n][e] : acc[ai][bj][m][n][e])
        if (colw >= 3072) {
            const int g0 = colw - 3072;
            f32x4 bg[2][2];
#pragma unroll
            for (int bj = 0; bj < 2; ++bj) { bg[bj][0] = *(const f32x4*)(bgate + g0 + bj * 128) * -LOG2E; bg[bj][1] = *(const f32x4*)(bgate + g0 + bj * 128 + 4) * -LOG2E; }
            unsigned char* G8 = (unsigned char*)G;
            const size_t gbyte = GATE_TILED ? (size_t)(u.pn - 12) * ((size_t)T * 256) + wc * 64 + fq * 16 : (size_t)((u.pn - 12) * 256 + wc * 64 + fq * 16);
#pragma unroll
            for (int i = 0; i < 8; ++i) {
                const int ai = i >> 2, m = i & 3;
                const int row = row0 + ai * 128 + m * 16;
                const float rs = rsv[i];
                u32x4 w;
#pragma unroll
                for (int bj = 0; bj < 2; ++bj) {
                    float v[8];
#pragma unroll
                    for (int e = 0; e < 4; ++e) {
                        v[e] = 255.0f * __builtin_amdgcn_rcpf(1.0f + __builtin_amdgcn_exp2f(fmaf(EPIIN_ACC(ai, bj, m, 0, e), rs, bg[bj][0][e])));
                        v[4 + e] = 255.0f * __builtin_amdgcn_rcpf(1.0f + __builtin_amdgcn_exp2f(fmaf(EPIIN_ACC(ai, bj, m, 1, e), rs, bg[bj][1][e])));
                    }
                    unsigned lo = 0, hi_ = 0;
                    lo = __builtin_amdgcn_cvt_pk_u8_f32(v[0], 0, lo); lo = __builtin_amdgcn_cvt_pk_u8_f32(v[1], 1, lo); lo = __builtin_amdgcn_cvt_pk_u8_f32(v[2], 2, lo); lo = __builtin_amdgcn_cvt_pk_u8_f32(v[3], 3, lo);
                    hi_ = __builtin_amdgcn_cvt_pk_u8_f32(v[4], 0, hi_); hi_ = __builtin_amdgcn_cvt_pk_u8_f32(v[5], 1, hi_); hi_ = __builtin_amdgcn_cvt_pk_u8_f32(v[6], 2, hi_); hi_ = __builtin_amdgcn_cvt_pk_u8_f32(v[7], 3, hi_);
                    if (bj == 0) { w.x = lo; w.y = hi_; } else { w.z = lo; w.w = hi_; }
                }
                if (!(nostore && w.x != 0x12345678u)) { if (EPI_NT & 1) __builtin_nontemporal_store(w, (u32x4*)(G8 + (size_t)row * GROWB + gbyte)); else *(u32x4*)(G8 + (size_t)row * GROWB + gbyte) = w; }
            }
        } else {
            bool rp[2];
#pragma unroll
            for (int bj = 0; bj < 2; ++bj) { const int cb = colw + bj * 128; rp[bj] = (cb < 384) || (cb >= 768 && cb < 1536) || (cb >= 2688 && cb < 2816); }
            f32x4 rn[2][2];
#pragma unroll
            for (int bj = 0; bj < 2; ++bj) if (rp[bj]) { const float* r = rope + ((size_t)row0 * 32 + (((colw + bj * 128) & 63) >> 1)) * 2; rn[bj][0] = *(const f32x4*)r; rn[bj][1] = *(const f32x4*)(r + 4); }
#pragma unroll
            for (int i = 0; i < 8; ++i) {
                const int ai = i >> 2, m = i & 3;
                const int row = row0 + ai * 128 + m * 16;
                const float rs = rsv[i];
                f32x4 rc[2][2];
#pragma unroll
                for (int bj = 0; bj < 2; ++bj) { rc[bj][0] = rn[bj][0]; rc[bj][1] = rn[bj][1]; }
                if (i < 7) {
                    const int rown = row0 + ((i + 1) >> 2) * 128 + ((i + 1) & 3) * 16;
#pragma unroll
                    for (int bj = 0; bj < 2; ++bj) if (rp[bj]) { const float* r = rope + ((size_t)rown * 32 + (((colw + bj * 128) & 63) >> 1)) * 2; rn[bj][0] = *(const f32x4*)r; rn[bj][1] = *(const f32x4*)(r + 4); }
                }
#pragma unroll
                for (int bj = 0; bj < 2; ++bj) {
                    const int cb = colw + bj * 128;
                    float v[8];
#pragma unroll
                    for (int e = 0; e < 4; ++e) { v[e] = EPIIN_ACC(ai, bj, m, 0, e) * rs; v[4 + e] = EPIIN_ACC(ai, bj, m, 1, e) * rs; }
                    if (rp[bj]) {
                        const f32x4 r0 = rc[bj][0], r1 = rc[bj][1];
                        float a, b;
                        a = v[0]; b = v[1]; v[0] = a * r0[0] - b * r0[1]; v[1] = b * r0[0] + a * r0[1];
                        a = v[2]; b = v[3]; v[2] = a * r0[2] - b * r0[3]; v[3] = b * r0[2] + a * r0[3];
                        a = v[4]; b = v[5]; v[4] = a * r1[0] - b * r1[1]; v[5] = b * r1[0] + a * r1[1];
                        a = v[6]; b = v[7]; v[6] = a * r1[2] - b * r1[3]; v[7] = b * r1[2] + a * r1[3];
                    }
                    if (cb == PC_FB) {
#pragma unroll
                        for (int e = 0; e < 6; ++e) { const float z = v[e] + bfg[e]; logf[(size_t)row * 8 + e] = fminf(z, 0.f) - log1pf(__expf(-fabsf(z))); }
                    }
                    u32x4 w; w.x = cvtpk(v[0], v[1]); w.y = cvtpk(v[2], v[3]); w.z = cvtpk(v[4], v[5]); w.w = cvtpk(v[6], v[7]);
                    if (!(nostore && w.x != 0x12345678u)) { if (EPI_NT & 1) __builtin_nontemporal_store(w, (u32x4*)(P + (size_t)row * NP + cb)); else *(u32x4*)(P + (size_t)row * NP + cb) = w; }
                }
            }
        }
    }
};
struct EpiDry {
    static constexpr bool PERM = true, AFTER_DRAIN = false;
    __device__ __forceinline__ bool keep(const pg8::Unit&) const { return false; }
    float* sink;
    __device__ __forceinline__ void operator()(const pg8::f32x4 (&acc)[2][2][4][2], const pg8::Unit& u, int wr, int wc, int fr, int fq) const {
        float t = 0.f;
#pragma unroll
        for (int ai = 0; ai < 2; ++ai)
#pragma unroll
            for (int bj = 0; bj < 2; ++bj)
#pragma unroll
                for (int m = 0; m < 4; ++m)
#pragma unroll
                    for (int n = 0; n < 2; ++n) t += acc[ai][bj][m][n][0] + acc[ai][bj][m][n][1] + acc[ai][bj][m][n][2] + acc[ai][bj][m][n][3];
        if (t == 1.2345e33f) sink[u.pm] = t;
    }
};
struct EpiBr {
    static constexpr bool PERM = true, AFTER_DRAIN = false;
    __device__ __forceinline__ bool keep(const pg8::Unit&) const { return false; }
    const bf16_t* Gi; bf16_t* Mg; int first;
    __device__ __forceinline__ void operator()(const pg8::f32x4 (&acc)[2][2][4][2], const pg8::Unit& u, int wr, int wc, int fr, int fq) const {
        const int colw = u.pn * 256 + wc * 32 + 8 * fq;
#pragma unroll
        for (int ai = 0; ai < 2; ++ai)
#pragma unroll
            for (int m = 0; m < 4; ++m) {
                const int row = u.pm * 256 + ai * 128 + wr * 64 + m * 16 + fr;
#pragma unroll
                for (int bj = 0; bj < 2; ++bj) {
                    const int cb = colw + bj * 128;
                    const u32x4 g = *(const u32x4*)(Gi + (size_t)row * NP + cb);
                    float v[8];
                    v[0] = bflo(g.x) * acc[ai][bj][m][0][0]; v[1] = bfhi(g.x) * acc[ai][bj][m][0][1]; v[2] = bflo(g.y) * acc[ai][bj][m][0][2]; v[3] = bfhi(g.y) * acc[ai][bj][m][0][3];
                    v[4] = bflo(g.z) * acc[ai][bj][m][1][0]; v[5] = bfhi(g.z) * acc[ai][bj][m][1][1]; v[6] = bflo(g.w) * acc[ai][bj][m][1][2]; v[7] = bfhi(g.w) * acc[ai][bj][m][1][3];
                    bf16_t* mp = Mg + (size_t)row * NP + cb;
                    if (!first) { const u32x4 o = *(const u32x4*)mp;
                        v[0] += bflo(o.x); v[1] += bfhi(o.x); v[2] += bflo(o.y); v[3] += bfhi(o.y); v[4] += bflo(o.z); v[5] += bfhi(o.z); v[6] += bflo(o.w); v[7] += bfhi(o.w); }
                    u32x4 w; w.x = cvtpk(v[0], v[1]); w.y = cvtpk(v[2], v[3]); w.z = cvtpk(v[4], v[5]); w.w = cvtpk(v[6], v[7]);
                    *(u32x4*)mp = w;
                }
                if (m & 1) asm volatile("" ::: "memory");
            }
    }
};
struct BranchOrder {
    pg8::StaticOrder so;
    __device__ __forceinline__ void init(int M, int N, int G_, int c_) { so.init(M, N, G_, c_); }
    __device__ __forceinline__ bool next(int i, pg8::Unit& u) const { const int ti = i / 3; if (!so.next(ti, u)) return false; u.br = i - 3 * ti; return true; }
    __device__ __forceinline__ size_t a_off(const pg8::Unit& u) const { return (size_t)u.br * 384 * 2; }
    __device__ __forceinline__ size_t b_off(const pg8::Unit& u) const { return (size_t)u.br * DM * 384 * 2; }
    __device__ __forceinline__ void a_ready(const pg8::Unit&) const {}
    __device__ __forceinline__ void done(const pg8::Unit&) const {}
};
#ifndef BR_PRELOAD
#define BR_PRELOAD 0
#endif
struct EpiBrChain {
    static constexpr bool PERM = true, AFTER_DRAIN = false;
    const unsigned char* G8; bf16_t* Mg;
    __device__ __forceinline__ bool keep(const pg8::Unit& u) const { return u.br < 2; }
    __device__ __forceinline__ void operator()(pg8::f32x4 (&acc)[2][2][4][2], const pg8::Unit& u, int wr, int wc, int fr, int fq) const {
        const int colw = u.pn * 256 + wc * 32 + 8 * fq, br = u.br;
        const int row0 = u.pm * 256 + wr * 64 + fr;
        const size_t gbyte = GATE_TILED ? (size_t)(br * 4 + u.pn) * ((size_t)T * 256) + wc * 64 + fq * 16 : (size_t)(br * 1024 + u.pn * 256 + wc * 64 + fq * 16);
        constexpr size_t GNEXT = GATE_TILED ? (size_t)4 * T * 256 : 1024;
        constexpr float GEPS = 1e-6f, I255 = 1.0f / 255.0f;
#if BR_PRELOAD
        u32x4 gca[8], gna[8];
#pragma unroll
        for (int i = 0; i < 8; ++i) gca[i] = *(const u32x4*)(G8 + (size_t)(row0 + (i >> 2) * 128 + (i & 3) * 16) * GROWB + gbyte);
        if (br < 2) {
#pragma unroll
            for (int i = 0; i < 8; ++i) gna[i] = *(const u32x4*)(G8 + (size_t)(row0 + (i >> 2) * 128 + (i & 3) * 16) * GROWB + gbyte + GNEXT);
        }
#else
        u32x4 gcn, gnn;
        gcn = *(const u32x4*)(G8 + (size_t)row0 * GROWB + gbyte);
        if (br < 2) gnn = *(const u32x4*)(G8 + (size_t)row0 * GROWB + gbyte + GNEXT);
#endif
#pragma unroll
        for (int i = 0; i < 8; ++i) {
            const int ai = i >> 2, m = i & 3;
            const int row = row0 + ai * 128 + m * 16;
#if BR_PRELOAD
            const u32x4 gc = gca[i], gn = gna[i];
#else
            const u32x4 gc = gcn, gn = gnn;
            if (i < 7) {
                const int rown = row0 + ((i + 1) >> 2) * 128 + ((i + 1) & 3) * 16;
                gcn = *(const u32x4*)(G8 + (size_t)rown * GROWB + gbyte);
                if (br < 2) gnn = *(const u32x4*)(G8 + (size_t)rown * GROWB + gbyte + GNEXT);
            }
#endif
#pragma unroll
            for (int bj = 0; bj < 2; ++bj) {
                const unsigned c0 = bj == 0 ? gc.x : gc.z, c1 = bj == 0 ? gc.y : gc.w;
                float f[8] = {(float)(c0 & 255u), (float)((c0 >> 8) & 255u), (float)((c0 >> 16) & 255u), (float)(c0 >> 24), (float)(c1 & 255u), (float)((c1 >> 8) & 255u), (float)((c1 >> 16) & 255u), (float)(c1 >> 24)};
#pragma unroll
                for (int e = 0; e < 8; ++e) f[e] *= I255;
                if (br > 0) {
#pragma unroll
                    for (int e = 0; e < 8; ++e) f[e] = fmaxf(f[e], GEPS);
                }
                if (br < 2) {
                    const unsigned n0 = bj == 0 ? gn.x : gn.z, n1 = bj == 0 ? gn.y : gn.w;
                    const float d[8] = {(float)(n0 & 255u), (float)((n0 >> 8) & 255u), (float)((n0 >> 16) & 255u), (float)(n0 >> 24), (float)(n1 & 255u), (float)((n1 >> 8) & 255u), (float)((n1 >> 16) & 255u), (float)(n1 >> 24)};
#pragma unroll
                    for (int e = 0; e < 8; ++e) f[e] *= __builtin_amdgcn_rcpf(fmaxf(d[e] * I255, GEPS));
#pragma unroll
                    for (int e = 0; e < 4; ++e) { acc[ai][bj][m][0][e] *= f[e]; acc[ai][bj][m][1][e] *= f[4 + e]; }
                } else {
                    float v[8];
#pragma unroll
                    for (int e = 0; e < 4; ++e) { v[e] = acc[ai][bj][m][0][e] * f[e]; v[4 + e] = acc[ai][bj][m][1][e] * f[4 + e]; }
                    u32x4 w; w.x = cvtpk(v[0], v[1]); w.y = cvtpk(v[2], v[3]); w.z = cvtpk(v[4], v[5]); w.w = cvtpk(v[6], v[7]);
                    if (EPI_NT & 8) __builtin_nontemporal_store(w, (u32x4*)(Mg + (size_t)row * NP + colw + bj * 128)); else *(u32x4*)(Mg + (size_t)row * NP + colw + bj * 128) = w;
                }
            }
        }
    }
};
#ifndef RES16
#define RES16 1
#endif
struct EpiOut {
    static constexpr bool PERM = true, AFTER_DRAIN = false;
    __device__ __forceinline__ bool keep(const pg8::Unit&) const { return false; }
    const float* Hin; float* H; bf16_t* HB; float* ssq;
    __device__ __forceinline__ void operator()(const pg8::f32x4 (&acc)[2][2][4][2], const pg8::Unit& u, int wr, int wc, int fr, int fq) const {
        const int colw = u.pn * 256 + wc * 32 + 8 * fq;
        const int row0 = u.pm * 256 + wr * 64 + fr;
#if RES16
        u32x4 hn[2];
#pragma unroll
        for (int bj = 0; bj < 2; ++bj) hn[bj] = *(const u32x4*)(HB + (size_t)row0 * DM + colw + bj * 128);
#else
        f32x4 hn[2][2];
#pragma unroll
        for (int bj = 0; bj < 2; ++bj) { const float* hi_ = Hin + (size_t)row0 * DM + colw + bj * 128; hn[bj][0] = *(const f32x4*)hi_; hn[bj][1] = *(const f32x4*)(hi_ + 4); }
#endif
#pragma unroll
        for (int i = 0; i < 8; ++i) {
            const int ai = i >> 2, m = i & 3;
            const int row = row0 + ai * 128 + m * 16;
            f32x4 hc[2][2];
#if RES16
#pragma unroll
            for (int bj = 0; bj < 2; ++bj) { hc[bj][0] = (f32x4){bflo(hn[bj].x), bfhi(hn[bj].x), bflo(hn[bj].y), bfhi(hn[bj].y)}; hc[bj][1] = (f32x4){bflo(hn[bj].z), bfhi(hn[bj].z), bflo(hn[bj].w), bfhi(hn[bj].w)}; }
            if (i < 7) {
                const int rown = row0 + ((i + 1) >> 2) * 128 + ((i + 1) & 3) * 16;
#pragma unroll
                for (int bj = 0; bj < 2; ++bj) hn[bj] = *(const u32x4*)(HB + (size_t)rown * DM + colw + bj * 128);
            }
#else
#pragma unroll
            for (int bj = 0; bj < 2; ++bj) { hc[bj][0] = hn[bj][0]; hc[bj][1] = hn[bj][1]; }
            if (i < 7) {
                const int rown = row0 + ((i + 1) >> 2) * 128 + ((i + 1) & 3) * 16;
#pragma unroll
                for (int bj = 0; bj < 2; ++bj) { const float* hi_ = Hin + (size_t)rown * DM + colw + bj * 128; hn[bj][0] = *(const f32x4*)hi_; hn[bj][1] = *(const f32x4*)(hi_ + 4); }
            }
#endif
            float ss = 0.f;
#pragma unroll
            for (int bj = 0; bj < 2; ++bj) {
                const int cb = colw + bj * 128;
                f32x4 h0 = hc[bj][0] + acc[ai][bj][m][0], h1 = hc[bj][1] + acc[ai][bj][m][1];
#if !RES16
                float* hp = H + (size_t)row * DM + cb;
                if (EPI_NT & 2) { __builtin_nontemporal_store(h0, (f32x4*)hp); __builtin_nontemporal_store(h1, (f32x4*)(hp + 4)); } else { *(f32x4*)hp = h0; *(f32x4*)(hp + 4) = h1; }
#endif
                u32x4 w; w.x = cvtpk(h0[0], h0[1]); w.y = cvtpk(h0[2], h0[3]); w.z = cvtpk(h1[0], h1[1]); w.w = cvtpk(h1[2], h1[3]);
                *(u32x4*)(HB + (size_t)row * DM + cb) = w;
                ss += (h0[0] * h0[0] + h0[1] * h0[1]) + (h0[2] * h0[2] + h0[3] * h0[3]) + (h1[0] * h1[0] + h1[1] * h1[1]) + (h1[2] * h1[2] + h1[3] * h1[3]);
            }
            ss += __shfl_xor(ss, 16); ss += __shfl_xor(ss, 32);
            if (fq == 0) ssq[(size_t)row * 16 + u.pn * 4 + wc] = ss;
        }
    }
};
#ifndef Q_I8
#define Q_I8 1
#endif
template <bool I8> struct EpiQT {
    static constexpr bool PERM = true, AFTER_DRAIN = false;
    __device__ __forceinline__ bool keep(const pg8::Unit&) const { return false; }
    bf16_t* Q; const float* ssq; const float* sx; const float* swq;
    __device__ __forceinline__ void operator()(const pg8::f32x4 (&acc)[2][2][4][2], const pg8::Unit& u, int wr, int wc, int fr, int fq) const {
        const int colw = u.pn * 256 + wc * 32 + 8 * fq;
        const int row0 = u.pm * 256 + wr * 64 + fr;
        float rsv[8];
#pragma unroll
        for (int i = 0; i < 4; ++i) rsv[i] = ssq16(ssq, row0 + (i & 3) * 16);
        asm volatile("" ::: "memory");
#pragma unroll
        for (int i = 4; i < 8; ++i) rsv[i] = ssq16(ssq, row0 + 128 + (i & 3) * 16);
#pragma unroll
        for (int i = 0; i < 8; ++i) rsv[i] = rsqrtf(rsv[i] * (1.0f / 1024.0f) + RMS_EPS);
        f32x4 swv[2][2];
        if constexpr (I8) {
#pragma unroll
            for (int i = 0; i < 8; ++i) rsv[i] *= sx[row0 + (i >> 2) * 128 + (i & 3) * 16];
#pragma unroll
            for (int bj = 0; bj < 2; ++bj) { swv[bj][0] = *(const f32x4*)(swq + colw + bj * 128); swv[bj][1] = *(const f32x4*)(swq + colw + bj * 128 + 4); }
        }
#pragma unroll
        for (int i = 0; i < 8; ++i) {
            const int ai = i >> 2, m = i & 3;
            const int row = row0 + ai * 128 + m * 16;
            const float rs = rsv[i];
#pragma unroll
            for (int bj = 0; bj < 2; ++bj) {
                const int cb = colw + bj * 128;
                f32x4 a, b;
                if constexpr (I8) {
#pragma unroll
                    for (int e = 0; e < 4; ++e) { a[e] = (float)__float_as_int(acc[ai][bj][m][0][e]) * swv[bj][0][e] * rs; b[e] = (float)__float_as_int(acc[ai][bj][m][1][e]) * swv[bj][1][e] * rs; }
                } else { a = acc[ai][bj][m][0] * rs; b = acc[ai][bj][m][1] * rs; }
                u32x4 w; w.x = cvtpk(a[0], a[1]); w.y = cvtpk(a[2], a[3]); w.z = cvtpk(b[0], b[1]); w.w = cvtpk(b[2], b[3]);
                bf16_t* qd = Q2_HEADMAJOR ? Q + (size_t)u.pn * ((size_t)T * 256) + (size_t)row * 256 + (cb - u.pn * 256) : Q + (size_t)row * 2048 + cb;
                if (EPI_NT & 4) __builtin_nontemporal_store(w, (u32x4*)qd); else *(u32x4*)qd = w;
            }
        }
    }
};

constexpr int VRP = 144;
constexpr int ATT_WAVE_LDS = 32 * VRP + 256 + 8192;
__device__ __forceinline__ int crow(int r, int hi) { return (r & 3) + 8 * (r >> 2) + 4 * hi; }

struct AttState { float m, l; f32x16 o0, o1; };
struct KTile { u32x4 k0, k1, k2, k3; float ck; };
struct VTile { u32x4 v0, v1, v2, v3; };
struct KFrag { bf16x8 k0, k1, k2, k3; };

#ifndef PROBE_HOT
#define PROBE_HOT 0
#endif
#ifndef ATT_WIDE_ST
#define ATT_WIDE_ST 1
#endif
#ifndef ATT_NT
#define ATT_NT 0
#endif
#ifndef ATT_KVSTAGE
#define ATT_KVSTAGE 0
#endif
#ifndef PROBE_NOATOM
#define PROBE_NOATOM 0
#endif
#ifndef PROBE_SHORT
#define PROBE_SHORT 0
#endif
#ifndef ATT_PIPE
#define ATT_PIPE 0
#endif
template <bool BIAS>
__device__ __forceinline__ void k_load(KTile& t, const bf16_t* __restrict__ Pb, int kcol, int r, int ktile, const float* __restrict__ cumT, int lane, int hot = 0) {
    const int row = lane >> 3, ch = lane & 7;
    const bf16_t* base = Pb + kcol + 8 * ch;
    int t0 = ktile + row * r, t1 = t0 + 8 * r, t2 = t0 + 16 * r, t3 = t0 + 24 * r;
    t0 = t0 < 0 ? 0 : (t0 > SEQ - 1 ? SEQ - 1 : t0); t1 = t1 < 0 ? 0 : (t1 > SEQ - 1 ? SEQ - 1 : t1);
    t2 = t2 < 0 ? 0 : (t2 > SEQ - 1 ? SEQ - 1 : t2); t3 = t3 < 0 ? 0 : (t3 > SEQ - 1 ? SEQ - 1 : t3);
    if (PROBE_HOT && hot) { t0 &= 255; t1 &= 255; t2 &= 255; t3 &= 255; }
    t.k0 = *(const u32x4*)(base + (size_t)t0 * NP); t.k1 = *(const u32x4*)(base + (size_t)t1 * NP); t.k2 = *(const u32x4*)(base + (size_t)t2 * NP); t.k3 = *(const u32x4*)(base + (size_t)t3 * NP);
    t.ck = 0.f;
    if (BIAS) { int tk_l = ktile + (lane & 31) * r; tk_l = tk_l < 0 ? 0 : (tk_l > SEQ - 1 ? SEQ - 1 : tk_l); t.ck = cumT[tk_l]; }
}
__device__ __forceinline__ void v_load(VTile& t, const bf16_t* __restrict__ Pb, int vcol, int r, int ktile, int lane, int hot = 0) {
    const int row = lane >> 3, ch = lane & 7;
    const bf16_t* base = Pb + vcol + 8 * ch;
    int t0 = ktile + row * r, t1 = t0 + 8 * r, t2 = t0 + 16 * r, t3 = t0 + 24 * r;
    t0 = t0 < 0 ? 0 : (t0 > SEQ - 1 ? SEQ - 1 : t0); t1 = t1 < 0 ? 0 : (t1 > SEQ - 1 ? SEQ - 1 : t1);
    t2 = t2 < 0 ? 0 : (t2 > SEQ - 1 ? SEQ - 1 : t2); t3 = t3 < 0 ? 0 : (t3 > SEQ - 1 ? SEQ - 1 : t3);
    if (PROBE_HOT && hot) { t0 &= 255; t1 &= 255; t2 &= 255; t3 &= 255; }
    t.v0 = *(const u32x4*)(base + (size_t)t0 * NP); t.v1 = *(const u32x4*)(base + (size_t)t1 * NP); t.v2 = *(const u32x4*)(base + (size_t)t2 * NP); t.v3 = *(const u32x4*)(base + (size_t)t3 * NP);
}
__device__ __forceinline__ void k_stage(const KTile& t, LAS unsigned char* vl, KFrag& f, int lane) {
    asm volatile("" ::: "memory");
    {
        LAS unsigned char* wp = vl + (lane >> 3) * VRP + (lane & 7) * 16;
        *(LAS u32x4*)(wp) = t.k0; *(LAS u32x4*)(wp + 8 * VRP) = t.k1; *(LAS u32x4*)(wp + 16 * VRP) = t.k2; *(LAS u32x4*)(wp + 24 * VRP) = t.k3;
    }
    asm volatile("s_waitcnt lgkmcnt(0)" ::: "memory");
    const LAS unsigned char* rp = vl + (lane & 31) * VRP + (lane >> 5) * 16;
    f.k0 = *(const LAS bf16x8*)(rp); f.k1 = *(const LAS bf16x8*)(rp + 32); f.k2 = *(const LAS bf16x8*)(rp + 64); f.k3 = *(const LAS bf16x8*)(rp + 96);
    asm volatile("s_waitcnt lgkmcnt(0)" ::: "memory");
}
template <bool BIAS>
__device__ __forceinline__ void v_stage(const VTile& t, float ck, LAS unsigned char* vl, bf16x8 (&vf)[2][2], int lane) {
    const int hi = lane >> 5, l31 = lane & 31, q4 = (lane & 15) >> 2, p4 = lane & 3, g1 = (lane >> 4) & 1;
    asm volatile("" ::: "memory");
    {
        LAS unsigned char* wp = vl + (lane >> 3) * VRP + (lane & 7) * 16;
        *(LAS u32x4*)(wp) = t.v0; *(LAS u32x4*)(wp + 8 * VRP) = t.v1; *(LAS u32x4*)(wp + 16 * VRP) = t.v2; *(LAS u32x4*)(wp + 24 * VRP) = t.v3;
        if (BIAS) { if (hi == 0) ((LAS float*)(vl + 32 * VRP))[l31] = ck; }
    }
    asm volatile("s_waitcnt lgkmcnt(0)" ::: "memory");
    const LAS unsigned char* vb = vl + (4 * hi + q4) * VRP + (16 * g1 + 4 * p4) * 2;
#pragma unroll
    for (int dblk = 0; dblk < 2; ++dblk)
#pragma unroll
        for (int s2 = 0; s2 < 2; ++s2) {
            const LAS unsigned char* a = vb + (16 * s2) * VRP + dblk * 64;
            const v4i16_t lo = __builtin_amdgcn_ds_read_tr16_b64_v4i16((LAS v4i16_t*)a);
            const v4i16_t hh = __builtin_amdgcn_ds_read_tr16_b64_v4i16((LAS v4i16_t*)(a + 8 * VRP));
            vf[dblk][s2] = (bf16x8){lo[0], lo[1], lo[2], lo[3], hh[0], hh[1], hh[2], hh[3]};
        }
}
__device__ __forceinline__ float max_halves(float v) {
    const auto rr = __builtin_amdgcn_permlane32_swap(__float_as_uint(v), __float_as_uint(v), false, false);
    return fmaxf(__uint_as_float(rr[0]), __uint_as_float(rr[1]));
}
__device__ __forceinline__ void softmax_pv(f32x16& s, float scale, AttState& st, const bf16x8 (&vf)[2][2]) {
    const float m0 = fmaxf(fmaxf(s[0], s[1]), s[2]), m1 = fmaxf(fmaxf(s[3], s[4]), s[5]), m2 = fmaxf(fmaxf(s[6], s[7]), s[8]);
    const float m3 = fmaxf(fmaxf(s[9], s[10]), s[11]), m4 = fmaxf(fmaxf(s[12], s[13]), s[14]);
    float mx = fmaxf(fmaxf(fmaxf(m0, m1), m2), fmaxf(fmaxf(m3, m4), s[15]));
    mx = max_halves(mx) * scale;
    float m_use = (st.m == -INFINITY) ? 0.f : st.m;
    if (!__all(mx <= st.m + 8.0f)) {
        const float m_new = fmaxf(st.m, mx);
        m_use = (m_new == -INFINITY) ? 0.f : m_new;
        const float alpha = __builtin_amdgcn_exp2f(st.m - m_use);
        st.l *= alpha; st.m = m_new;
#pragma unroll
        for (int i = 0; i < 16; ++i) { st.o0[i] *= alpha; st.o1[i] *= alpha; }
    }
    float rsum = 0.f;
#pragma unroll
    for (int i = 0; i < 16; ++i) { s[i] = __builtin_amdgcn_exp2f(fmaf(s[i], scale, -m_use)); rsum += s[i]; }
    st.l += rsum;
    u32x4 pw0, pw1;
    pw0.x = cvtpk(s[0], s[1]); pw0.y = cvtpk(s[2], s[3]); pw0.z = cvtpk(s[4], s[5]); pw0.w = cvtpk(s[6], s[7]);
    pw1.x = cvtpk(s[8], s[9]); pw1.y = cvtpk(s[10], s[11]); pw1.z = cvtpk(s[12], s[13]); pw1.w = cvtpk(s[14], s[15]);
    const bf16x8 pb0 = __builtin_bit_cast(bf16x8, pw0), pb1 = __builtin_bit_cast(bf16x8, pw1);
    st.o0 = __builtin_amdgcn_mfma_f32_32x32x16_bf16(vf[0][0], pb0, st.o0, 0, 0, 0);
    st.o0 = __builtin_amdgcn_mfma_f32_32x32x16_bf16(vf[0][1], pb1, st.o0, 0, 0, 0);
    st.o1 = __builtin_amdgcn_mfma_f32_32x32x16_bf16(vf[1][0], pb0, st.o1, 0, 0, 0);
    st.o1 = __builtin_amdgcn_mfma_f32_32x32x16_bf16(vf[1][1], pb1, st.o1, 0, 0, 0);
}
__device__ __forceinline__ f32x16 qk_tile(const KFrag& t, const bf16x8 (&qf)[4]) {
    f32x16 s;
#pragma unroll
    for (int i = 0; i < 16; ++i) s[i] = 0.f;
    s = __builtin_amdgcn_mfma_f32_32x32x16_bf16(t.k0, qf[0], s, 0, 0, 0);
    s = __builtin_amdgcn_mfma_f32_32x32x16_bf16(t.k1, qf[1], s, 0, 0, 0);
    s = __builtin_amdgcn_mfma_f32_32x32x16_bf16(t.k2, qf[2], s, 0, 0, 0);
    s = __builtin_amdgcn_mfma_f32_32x32x16_bf16(t.k3, qf[3], s, 0, 0, 0);
    return s;
}

__device__ __forceinline__ f32x16 qk_tile_lds(const KFrag& t, const LAS unsigned char* qb) {
    f32x16 s;
#pragma unroll
    for (int i = 0; i < 16; ++i) s[i] = 0.f;
    s = __builtin_amdgcn_mfma_f32_32x32x16_bf16(t.k0, *(const LAS bf16x8*)(qb), s, 0, 0, 0);
    s = __builtin_amdgcn_mfma_f32_32x32x16_bf16(t.k1, *(const LAS bf16x8*)(qb + 1024), s, 0, 0, 0);
    s = __builtin_amdgcn_mfma_f32_32x32x16_bf16(t.k2, *(const LAS bf16x8*)(qb + 2048), s, 0, 0, 0);
    s = __builtin_amdgcn_mfma_f32_32x32x16_bf16(t.k3, *(const LAS bf16x8*)(qb + 3072), s, 0, 0, 0);
    return s;
}

constexpr int KV_KOFF = 32 * VRP + 256;
__device__ __forceinline__ void kv_stage(const KTile& kt, const VTile& vt, LAS unsigned char* vl, KFrag& f, bf16x8 (&vf)[2][2], int lane) {
    const int hi = lane >> 5, q4 = (lane & 15) >> 2, p4 = lane & 3, g1 = (lane >> 4) & 1;
    asm volatile("" ::: "memory");
    {
        LAS unsigned char* wk = vl + KV_KOFF + (lane >> 3) * VRP + (lane & 7) * 16;
        *(LAS u32x4*)(wk) = kt.k0; *(LAS u32x4*)(wk + 8 * VRP) = kt.k1; *(LAS u32x4*)(wk + 16 * VRP) = kt.k2; *(LAS u32x4*)(wk + 24 * VRP) = kt.k3;
        LAS unsigned char* wp = vl + (lane >> 3) * VRP + (lane & 7) * 16;
        *(LAS u32x4*)(wp) = vt.v0; *(LAS u32x4*)(wp + 8 * VRP) = vt.v1; *(LAS u32x4*)(wp + 16 * VRP) = vt.v2; *(LAS u32x4*)(wp + 24 * VRP) = vt.v3;
    }
    asm volatile("s_waitcnt lgkmcnt(0)" ::: "memory");
    const LAS unsigned char* rp = vl + KV_KOFF + (lane & 31) * VRP + (lane >> 5) * 16;
    f.k0 = *(const LAS bf16x8*)(rp); f.k1 = *(const LAS bf16x8*)(rp + 32); f.k2 = *(const LAS bf16x8*)(rp + 64); f.k3 = *(const LAS bf16x8*)(rp + 96);
    const LAS unsigned char* vb = vl + (4 * hi + q4) * VRP + (16 * g1 + 4 * p4) * 2;
#pragma unroll
    for (int dblk = 0; dblk < 2; ++dblk)
#pragma unroll
        for (int s2 = 0; s2 < 2; ++s2) {
            const LAS unsigned char* a = vb + (16 * s2) * VRP + dblk * 64;
            const v4i16_t lo = __builtin_amdgcn_ds_read_tr16_b64_v4i16((LAS v4i16_t*)a);
            const v4i16_t hh = __builtin_amdgcn_ds_read_tr16_b64_v4i16((LAS v4i16_t*)(a + 8 * VRP));
            vf[dblk][s2] = (bf16x8){lo[0], lo[1], lo[2], lo[3], hh[0], hh[1], hh[2], hh[3]};
        }
}
template <int r>
__device__ __forceinline__ void attn_segment(const bf16_t* __restrict__ Pb, int kcol, int vcol, int maxd_tok, int kt0, int ntiles, int tq,
                                             const bf16x8 (&qf)[4], AttState& st, LAS unsigned char* vl, int lane, int hot = 0) {
    const int hi = lane >> 5;
    const int lim = maxd_tok < tq ? maxd_tok : tq;
#if ATT_PIPE
    {
        KTile k1; VTile vcur;
        f32x16 s_cur;
        {
            KTile k0; k_load<false>(k0, Pb, kcol, r, kt0, nullptr, lane, hot); v_load(vcur, Pb, vcol, r, kt0, lane, hot);
            if (ntiles > 1) k_load<false>(k1, Pb, kcol, r, kt0 + 32 * r, nullptr, lane, hot);
            KFrag kf; k_stage(k0, vl, kf, lane);
            s_cur = qk_tile(kf, qf);
        }
        for (int j = 0; j < ntiles; ++j) {
            const int ktile = kt0 + j * 32 * r;
            VTile vnext; KTile k2;
            if (j + 1 < ntiles) v_load(vnext, Pb, vcol, r, ktile + 32 * r, lane, hot);
            if (j + 2 < ntiles) k_load<false>(k2, Pb, kcol, r, ktile + 64 * r, nullptr, lane, hot);
            f32x16 s_next;
            if (j + 1 < ntiles) { KFrag kf1; k_stage(k1, vl, kf1, lane); s_next = qk_tile(kf1, qf); }
            bf16x8 vf[2][2];
            v_stage<false>(vcur, 0.f, vl, vf, lane);
            const int dbase = tq - ktile - 4 * hi * r;
#pragma unroll
            for (int i = 0; i < 16; ++i) {
                const int d = dbase - crow(i, 0) * r;
                s_cur[i] = ((unsigned)d <= (unsigned)lim) ? s_cur[i] : -INFINITY;
            }
            softmax_pv(s_cur, QK_SCALE2, st, vf);
            asm volatile("s_waitcnt lgkmcnt(0)" ::: "memory");
            if (j + 1 < ntiles) { s_cur = s_next; vcur = vnext; }
            if (j + 2 < ntiles) k1 = k2;
        }
        return;
    }
#endif
    KTile nx; VTile vnx;
    k_load<false>(nx, Pb, kcol, r, kt0, nullptr, lane, hot); v_load(vnx, Pb, vcol, r, kt0, lane, hot);
    for (int j = 0; j < ntiles; ++j) {
        const int ktile = kt0 + j * 32 * r;
        const VTile vt = vnx;
        const KTile cur = nx;
        if (j + 1 < ntiles) { k_load<false>(nx, Pb, kcol, r, ktile + 32 * r, nullptr, lane, hot); v_load(vnx, Pb, vcol, r, ktile + 32 * r, lane, hot); }
        KFrag kf; bf16x8 vf[2][2];
#if ATT_KVSTAGE
        kv_stage(cur, vt, vl, kf, vf, lane);
        f32x16 s = qk_tile(kf, qf);
#else
        k_stage(cur, vl, kf, lane);
        f32x16 s = qk_tile(kf, qf);
        v_stage<false>(vt, 0.f, vl, vf, lane);
#endif
        const int dbase = tq - ktile - 4 * hi * r;
#pragma unroll
        for (int i = 0; i < 16; ++i) {
            const int d = dbase - crow(i, 0) * r;
            s[i] = ((unsigned)d <= (unsigned)lim) ? s[i] : -INFINITY;
        }
        softmax_pv(s, QK_SCALE2, st, vf);
        asm volatile("s_waitcnt lgkmcnt(0)" ::: "memory");
    }
}

template <int r>
__device__ __forceinline__ void attn_segment_pre(const bf16_t* __restrict__ Pb, int kcol, int vcol, int maxd_tok, int kt0, int ntiles, int tq,
                                                 const bf16x8 (&qf)[4], AttState& st, LAS unsigned char* vl, int lane, KTile& nx, VTile& vnx) {
    const int hi = lane >> 5;
    const int lim = maxd_tok < tq ? maxd_tok : tq;
    for (int j = 0; j < ntiles; ++j) {
        const int ktile = kt0 + j * 32 * r;
        const VTile vt = vnx;
        const KTile cur = nx;
        if (j + 1 < ntiles) { k_load<false>(nx, Pb, kcol, r, ktile + 32 * r, nullptr, lane); v_load(vnx, Pb, vcol, r, ktile + 32 * r, lane); }
        KFrag kf; bf16x8 vf[2][2];
        k_stage(cur, vl, kf, lane);
        f32x16 s = qk_tile(kf, qf);
        v_stage<false>(vt, 0.f, vl, vf, lane);
        const int dbase = tq - ktile - 4 * hi * r;
#pragma unroll
        for (int i = 0; i < 16; ++i) {
            const int d = dbase - crow(i, 0) * r;
            s[i] = ((unsigned)d <= (unsigned)lim) ? s[i] : -INFINITY;
        }
        softmax_pv(s, QK_SCALE2, st, vf);
        asm volatile("s_waitcnt lgkmcnt(0)" ::: "memory");
    }
}
__device__ __forceinline__ void attn_load_q(const bf16_t* __restrict__ Pb, int tq, int qcol, int hi, bf16x8 (&qf)[4]) {
    const bf16_t* qp = Pb + (size_t)tq * NP + qcol + 8 * hi;
    qf[0] = *(const bf16x8*)(qp); qf[1] = *(const bf16x8*)(qp + 16); qf[2] = *(const bf16x8*)(qp + 32); qf[3] = *(const bf16x8*)(qp + 48);
}
__device__ __forceinline__ void attn_store_o(bf16_t* __restrict__ Pb, int tq, int ocol, int hi, AttState& st, int dry) {
    float l = st.l + __shfl_xor(st.l, 32);
    if (dry && l >= 0.f) return;
    const float inv = 1.0f / l;
#if ATT_WIDE_ST
    bf16_t* op = Pb + (size_t)tq * NP + ocol + 8 * hi;
#pragma unroll
    for (int k = 0; k < 2; ++k) {
        u32x2 a0, b0, a1, b1;
        a0.x = cvtpk(st.o0[8 * k] * inv, st.o0[8 * k + 1] * inv); a0.y = cvtpk(st.o0[8 * k + 2] * inv, st.o0[8 * k + 3] * inv);
        b0.x = cvtpk(st.o0[8 * k + 4] * inv, st.o0[8 * k + 5] * inv); b0.y = cvtpk(st.o0[8 * k + 6] * inv, st.o0[8 * k + 7] * inv);
        a1.x = cvtpk(st.o1[8 * k] * inv, st.o1[8 * k + 1] * inv); a1.y = cvtpk(st.o1[8 * k + 2] * inv, st.o1[8 * k + 3] * inv);
        b1.x = cvtpk(st.o1[8 * k + 4] * inv, st.o1[8 * k + 5] * inv); b1.y = cvtpk(st.o1[8 * k + 6] * inv, st.o1[8 * k + 7] * inv);
        const auto s0x = __builtin_amdgcn_permlane32_swap(a0.x, b0.x, false, false), s0y = __builtin_amdgcn_permlane32_swap(a0.y, b0.y, false, false);
        const auto s1x = __builtin_amdgcn_permlane32_swap(a1.x, b1.x, false, false), s1y = __builtin_amdgcn_permlane32_swap(a1.y, b1.y, false, false);
        *(u32x4*)(op + 16 * k) = (u32x4){s0x[0], s0y[0], s0x[1], s0y[1]};
        *(u32x4*)(op + 32 + 16 * k) = (u32x4){s1x[0], s1y[0], s1x[1], s1y[1]};
    }
#else
    bf16_t* op = Pb + (size_t)tq * NP + ocol + 4 * hi;
#pragma unroll
    for (int g = 0; g < 4; ++g) {
        u32x2 w0, w1;
        w0.x = cvtpk(st.o0[4 * g] * inv, st.o0[4 * g + 1] * inv); w0.y = cvtpk(st.o0[4 * g + 2] * inv, st.o0[4 * g + 3] * inv);
        w1.x = cvtpk(st.o1[4 * g] * inv, st.o1[4 * g + 1] * inv); w1.y = cvtpk(st.o1[4 * g + 2] * inv, st.o1[4 * g + 3] * inv);
        if (ATT_NT) { __builtin_nontemporal_store(w0, (u32x2*)(op + 8 * g)); __builtin_nontemporal_store(w1, (u32x2*)(op + 32 + 8 * g)); }
        else { *(u32x2*)(op + 8 * g) = w0; *(u32x2*)(op + 32 + 8 * g) = w1; }
    }
#endif
}
__device__ __forceinline__ void att_init(AttState& st) {
#pragma unroll
    for (int i = 0; i < 16; ++i) { st.o0[i] = 0.f; st.o1[i] = 0.f; }
    st.m = -INFINITY; st.l = 0.f;
}

__device__ __forceinline__ void attn_fox_pair(bf16_t* __restrict__ Pb, const float* __restrict__ cumT, float kmax2, int h, int qp, LAS unsigned char* vl, int lane, int dry) {
    const int hi = lane >> 5, l31 = lane & 31;
    const int kcol = PC_KB + 64 * h, vcol = PC_VB + 64 * h, qcol = PC_QB + 64 * h;
    const LAS float* ckl = (const LAS float*)(vl + 32 * VRP);
    AttState st0, st1; att_init(st0); att_init(st1);
    const int tq0 = 64 * qp + l31, tq1 = tq0 + 32;
    LAS unsigned char* qb0 = vl + 32 * VRP + 256 + hi * 512 + l31 * 16;
    LAS unsigned char* qb1 = qb0 + 4096;
    {
        bf16x8 qf[4];
        attn_load_q(Pb, tq0, qcol, hi, qf);
#pragma unroll
        for (int s_ = 0; s_ < 4; ++s_) *(LAS bf16x8*)(qb0 + 1024 * s_) = qf[s_];
        attn_load_q(Pb, tq1, qcol, hi, qf);
#pragma unroll
        for (int s_ = 0; s_ < 4; ++s_) *(LAS bf16x8*)(qb1 + 1024 * s_) = qf[s_];
        asm volatile("s_waitcnt lgkmcnt(0)" ::: "memory");
    }
    const float cq0 = cumT[tq0], cq1 = cumT[tq1];
    float bound0, bound1;
    {
        float n0 = 0.f, n1 = 0.f;
#pragma unroll
        for (int s_ = 0; s_ < 4; ++s_) {
            const bf16x8 a = *(const LAS bf16x8*)(qb0 + 1024 * s_), b = *(const LAS bf16x8*)(qb1 + 1024 * s_);
#pragma unroll
            for (int e = 0; e < 8; ++e) { const float fa = bflo((unsigned)(unsigned short)a[e]), fb = bflo((unsigned)(unsigned short)b[e]); n0 = fmaf(fa, fa, n0); n1 = fmaf(fb, fb, n1); }
        }
        n0 += __shfl_xor(n0, 32); n1 += __shfl_xor(n1, 32);
        bound0 = sqrtf(n0 * kmax2) * QK_SCALE2 * 1.01f + 0.5f; bound1 = sqrtf(n1 * kmax2) * QK_SCALE2 * 1.01f + 0.5f;
    }
    constexpr float FOX_SKIP = 48.0f;
    const int ntiles = 2 * qp + 2;
    KTile nx;
    k_load<true>(nx, Pb, kcol, 1, 32 * (ntiles - 1), cumT, lane);
    for (int j = ntiles - 1; j >= 0; --j) {
        VTile vt; v_load(vt, Pb, vcol, 1, 32 * j, lane);
        const KTile cur = nx;
        if (j > 0) k_load<true>(nx, Pb, kcol, 1, 32 * (j - 1), cumT, lane);
        KFrag kf; k_stage(cur, vl, kf, lane);
        f32x16 s1 = qk_tile_lds(kf, qb1);
        f32x16 s0;
        const bool on0 = (j <= 2 * qp);
        if (on0) s0 = qk_tile_lds(kf, qb0);
        bf16x8 vf[2][2];
        v_stage<true>(vt, cur.ck, vl, vf, lane);
        if (on0) {
            const bool diag = (j == 2 * qp);
#pragma unroll
            for (int g = 0; g < 4; ++g) { const f32x4 c4 = *(const LAS f32x4*)(ckl + 8 * g + 4 * hi);
#pragma unroll
                for (int e = 0; e < 4; ++e) { const int i = 4 * g + e; const float v = fmaf(s0[i], QK_SCALE2, cq0 - c4[e]); s0[i] = (diag && crow(i, hi) > l31) ? -INFINITY : v; } }
            softmax_pv(s0, 1.0f, st0, vf);
        }
        {
            const bool diag = (j == 2 * qp + 1);
#pragma unroll
            for (int g = 0; g < 4; ++g) { const f32x4 c4 = *(const LAS f32x4*)(ckl + 8 * g + 4 * hi);
#pragma unroll
                for (int e = 0; e < 4; ++e) { const int i = 4 * g + e; const float v = fmaf(s1[i], QK_SCALE2, cq1 - c4[e]); s1[i] = (diag && crow(i, hi) > l31) ? -INFINITY : v; } }
            softmax_pv(s1, 1.0f, st1, vf);
        }
        asm volatile("s_waitcnt lgkmcnt(0)" ::: "memory");
        if (j > 0) {
            const float ckn = __int_as_float(__builtin_amdgcn_readlane(__float_as_int(nx.ck), 31));
            const bool dead0 = (cq0 - ckn + bound0) < (st0.m - FOX_SKIP), dead1 = (cq1 - ckn + bound1) < (st1.m - FOX_SKIP);
            if (__all(dead0 && dead1)) break;
        }
    }
    attn_store_o(Pb, tq0, qcol, hi, st0, dry);
    attn_store_o(Pb, tq1, qcol, hi, st1, dry);
}

#ifndef APT
#define APT 4
#endif
#ifndef NQC
#define NQC 4
#endif
#ifndef BQP
#define BQP 1
#endif
#ifndef CQT
#define CQT 2
#endif
#ifndef ATT_POP_G
#define ATT_POP_G 1
#endif
#ifndef MIXA_3PASS
#define MIXA_3PASS 4
#endif
#ifndef MIXA_ACQ
#define MIXA_ACQ 1
#endif
#ifndef MIXA_REL
#define MIXA_REL 0
#endif
typedef unsigned long long u64_t;
#ifndef MIXA_ONLY
#define MIXA_ONLY -1
#endif
#ifndef MIXA_PLAIN
#define MIXA_PLAIN 0
#endif
__device__ __forceinline__ void st_wt8(void* p, u32x2 v) { if (MIXA_PLAIN) *(u32x2*)p = v; else __hip_atomic_store((u64_t*)p, ((u64_t)v.y << 32) | v.x, __ATOMIC_RELAXED, __HIP_MEMORY_SCOPE_AGENT); }
__device__ __forceinline__ u32x2 ld_wt8(const void* p) { if (MIXA_PLAIN) return *(const u32x2*)p; const u64_t x = __hip_atomic_load((const u64_t*)p, __ATOMIC_RELAXED, __HIP_MEMORY_SCOPE_AGENT); return (u32x2){(unsigned)x, (unsigned)(x >> 32)}; }
__device__ __forceinline__ void st_wt4(float* p, float v) { if (MIXA_PLAIN) *p = v; else __hip_atomic_store(p, v, __ATOMIC_RELAXED, __HIP_MEMORY_SCOPE_AGENT); }
__device__ __forceinline__ float ld_wt4(const float* p) { if (MIXA_PLAIN) return *p; return __hip_atomic_load(p, __ATOMIC_RELAXED, __HIP_MEMORY_SCOPE_AGENT); }
__device__ __forceinline__ void mixa_store_partial(bf16_t* __restrict__ AO, float* __restrict__ ALSE, int pat, size_t tok  , int bh, int t, int h, int hi, AttState& st) {
    const float l = st.l + __shfl_xor(st.l, 32);
    const float inv = 1.0f / l;
    bf16_t* op = AO + ((size_t)pat * T + tok) * 384 + h * 64 + 4 * hi;
#pragma unroll
    for (int g = 0; g < 4; ++g) {
        u32x2 w0, w1;
        w0.x = cvtpk(st.o0[4 * g] * inv, st.o0[4 * g + 1] * inv); w0.y = cvtpk(st.o0[4 * g + 2] * inv, st.o0[4 * g + 3] * inv);
        w1.x = cvtpk(st.o1[4 * g] * inv, st.o1[4 * g + 1] * inv); w1.y = cvtpk(st.o1[4 * g + 2] * inv, st.o1[4 * g + 3] * inv);
        st_wt8(op + 8 * g, w0); st_wt8(op + 32 + 8 * g, w1);
    }
    if (hi == 0) st_wt4(ALSE + ((size_t)pat * (BATCH * 6) + bh) * SEQ + t, st.m + __builtin_amdgcn_logf(l));
}
__device__ __forceinline__ void mixa_combine(bf16_t* __restrict__ Pb, const bf16_t* __restrict__ AO, const float* __restrict__ ALSE, size_t tok, int bh, int t, int h, int hi) {
    float ls[3], mx;
#pragma unroll
    for (int p = 0; p < 3; ++p) ls[p] = ld_wt4(ALSE + ((size_t)p * (BATCH * 6) + bh) * SEQ + t);
    mx = fmaxf(ls[0], fmaxf(ls[1], ls[2]));
    float w[3], ws = 0.f;
#pragma unroll
    for (int p = 0; p < 3; ++p) { w[p] = __builtin_amdgcn_exp2f(ls[p] - mx); if (MIXA_ONLY >= 0) w[p] = (p == MIXA_ONLY) ? 1.f : 0.f; ws += w[p]; }
    const float iw = 1.0f / ws;
    float acc[32];
#pragma unroll
    for (int i = 0; i < 32; ++i) acc[i] = 0.f;
#pragma unroll
    for (int p = 0; p < 3; ++p) {
        const bf16_t* ip = AO + ((size_t)p * T + tok) * 384 + h * 64 + 32 * hi;
        const float wp = w[p] * iw;
#pragma unroll
        for (int c = 0; c < 8; ++c) { const u32x2 v = ld_wt8(ip + 4 * c);
            acc[4 * c] = fmaf(wp, bflo(v.x), acc[4 * c]); acc[4 * c + 1] = fmaf(wp, bfhi(v.x), acc[4 * c + 1]); acc[4 * c + 2] = fmaf(wp, bflo(v.y), acc[4 * c + 2]); acc[4 * c + 3] = fmaf(wp, bfhi(v.y), acc[4 * c + 3]); }
    }
    bf16_t* op = Pb + (size_t)t * NP + PC_QA + 64 * h + 32 * hi;
#pragma unroll
    for (int c = 0; c < 4; ++c) { u32x4 w4; w4.x = cvtpk(acc[8 * c], acc[8 * c + 1]); w4.y = cvtpk(acc[8 * c + 2], acc[8 * c + 3]); w4.z = cvtpk(acc[8 * c + 4], acc[8 * c + 5]); w4.w = cvtpk(acc[8 * c + 6], acc[8 * c + 7]);
        *(u32x4*)(op + 8 * c) = w4; }
}

__device__ __forceinline__ void attention_phase(unsigned char* __restrict__ ws, const float* __restrict__ sinks, int ctr_word, int grp_word, int kmax_word, LAS unsigned char* lds, int wave, int lane, int dry) {
#define ATT_P ((bf16_t*)(ws + WS_P))
#define ATT_CUMT ((const float*)(ws + WS_CUMT))
#define ATT_AO ((bf16_t*)(ws + WS_AO))
#define ATT_ALSE ((float*)(ws + WS_ALSE))
    LAS unsigned char* vl = lds + wave * ATT_WAVE_LDS;
    const int hi = lane >> 5, l31 = lane & 31;
    constexpr int NUB = 3072 / BQP, NU = 6144;
    constexpr int NUA = MIXA_3PASS ? 3 * NU : NU;
    constexpr int NUTOT = NUB + NUA + NU / CQT + (MIXA_3PASS == 1 ? NU : 0) ;
    int pend = -1;
    unsigned ucur = 0, uend = 0;
    for (;;) {
        if (ucur == uend) {
            unsigned u0 = 0;
            if (lane == 0) {
                if (MIXA_3PASS && pend >= 0) __hip_atomic_fetch_add((unsigned*)ws + grp_word + pend, 1u, __ATOMIC_RELAXED, __HIP_MEMORY_SCOPE_AGENT);
                u0 = atomicAdd((unsigned*)ws + ctr_word, (unsigned)ATT_POP_G);
            }
            pend = -1;
            ucur = (unsigned)__builtin_amdgcn_readfirstlane((int)u0); uend = ucur + ATT_POP_G;
        }
        const unsigned u = ucur++;
        if (u >= (unsigned)NUTOT) break;
        if (PROBE_SHORT == 3 && dry) continue;
        if (u < (unsigned)NUB) {
            const int bh = (int)(u % 24), b = bh / 6, h = bh % 6;
            for (int sub = 0; sub < BQP; ++sub) {
                const int qp = 127 - (int)(u / 24) * BQP - sub;
                if (!(PROBE_SHORT == 2 && dry)) attn_fox_pair(ATT_P + (size_t)b * SEQ * NP, ATT_CUMT + (size_t)bh * SEQ, ((const float*)ws)[kmax_word + 32 * bh], h, qp, vl, lane, dry);
            }
        } else if (MIXA_3PASS && u < (unsigned)(NUB + NUA)) {
            const int v = (int)u - NUB;
            const int pat = v / NU, w_ = v - pat * NU, bh = w_ >> 8, x_ = w_ & 255, b = bh / 6, h = bh % 6;
            const int r = pat == 0 ? 1 : (pat == 1 ? 4 : 16);
            const int rho = pat == 0 ? 0 : (pat == 1 ? (x_ & 3) : (x_ & 15)), cb = pat == 0 ? x_ : (pat == 1 ? (x_ >> 2) : (x_ >> 4));
            bf16_t* Pb = ATT_P + (size_t)b * SEQ * NP;
            const int tq0 = rho + r * 32 * cb, tq = tq0 + r * l31;
            AttState st; att_init(st); bf16x8 qf[4];
            attn_load_q(Pb, tq, PC_QA + 64 * h, hi, qf);
            if (pat == 0)      attn_segment<1>(Pb, PC_KA + 64 * h, PC_VA + 64 * h, 128, tq0 - 128, 5, tq, qf, st, vl, lane);
            else if (pat == 1) attn_segment<4>(Pb, PC_KA + 64 * h, PC_VA + 64 * h, 512, tq0 - 512, 5, tq, qf, st, vl, lane);
            else               attn_segment<16>(Pb, PC_KA + 64 * h, PC_VA + 64 * h, 2048, tq0 - 2048, 5, tq, qf, st, vl, lane);
            if (!dry) {
                mixa_store_partial(ATT_AO, ATT_ALSE, pat, (size_t)b * SEQ + tq, bh, tq, h, hi, st);
                asm volatile("s_waitcnt vmcnt(0)" ::: "memory");
                if (MIXA_REL) { __builtin_amdgcn_fence(__ATOMIC_RELEASE, "agent"); asm volatile("s_waitcnt vmcnt(0)" ::: "memory"); }
                pend = bh * 16 + (tq0 >> 9);
            }
        } else if (MIXA_3PASS == 1 && u >= (unsigned)(NUB + NUA + NU)) {
            const int v = (int)u - (NUB + NUA + NU);
            const int qt = v & 255, bh = v >> 8, b = bh / 6, h = bh % 6;
            if (!dry) {
                unsigned* cw = (unsigned*)ws + grp_word + bh * 16 + (qt >> 4);
                unsigned spins = 0;
                while ((unsigned)__builtin_amdgcn_readfirstlane((int)__hip_atomic_load(cw, __ATOMIC_RELAXED, __HIP_MEMORY_SCOPE_AGENT)) < 48u) {
                    __builtin_amdgcn_s_sleep(8);
                    if (++spins > (1u << 22)) break;
                }
                if (MIXA_ACQ) { __builtin_amdgcn_fence(__ATOMIC_ACQUIRE, "agent"); asm volatile("s_waitcnt vmcnt(0)" ::: "memory"); }
                mixa_combine(ATT_P + (size_t)b * SEQ * NP, ATT_AO, ATT_ALSE, (size_t)b * SEQ + qt * 32 + l31, bh, qt * 32 + l31, h, hi);
            }
        } else if (!MIXA_3PASS && u < (unsigned)(NUB + NU)) {
            const int v = (int)u - NUB;
            const int cb = v & 15, rho = (v >> 4) & 15, bh = v >> 8, b = bh / 6, h = bh % 6;
            bf16_t* Pb = ATT_P + (size_t)b * SEQ * NP;
            const int tq0 = rho + 512 * cb, tq = tq0 + 16 * l31;
            AttState st; att_init(st); bf16x8 qf[4];
            attn_load_q(Pb, tq, PC_QA + 64 * h, hi, qf);
            attn_segment<16>(Pb, PC_KA + 64 * h, PC_VA + 64 * h, 2048, tq0 - 2048, (PROBE_SHORT && dry) ? 1 : 5, tq, qf, st, vl, lane, dry);
            attn_segment<4>(Pb, PC_KA + 64 * h, PC_VA + 64 * h, 512, tq0 - 512, (PROBE_SHORT && dry) ? 1 : 8, tq, qf, st, vl, lane, dry);
            attn_segment<1>(Pb, PC_KA + 64 * h, PC_VA + 64 * h, 128, tq0 - 128, (PROBE_SHORT && dry) ? 1 : 20, tq, qf, st, vl, lane, dry);
            attn_store_o(Pb, tq, PC_QA + 64 * h, hi, st, dry);
        } else {
            const int v = (int)u - NUB - NUA;
            const int bh = v / (256 / CQT), qg = v - bh * (256 / CQT), b = bh / 6, h = bh % 6, hk = h / 3;
            bf16_t* Pb = ATT_P + (size_t)b * SEQ * NP;
            const float sink = sinks[h] * LOG2E;
            for (int sub = 0; sub < CQT; ++sub) {
                const int qt = qg * CQT + sub;
                const int tq = qt * 32 + l31;
                AttState st; att_init(st); bf16x8 qf[4];
                attn_load_q(Pb, tq, PC_QC + 64 * h, hi, qf);
                st.m = sink; st.l = (hi == 0) ? 1.f : 0.f;
                attn_segment<1>(Pb, PC_KC + 64 * hk, PC_VC + 64 * hk, 127, qt * 32 - 128, 5, tq, qf, st, vl, lane);
                attn_store_o(Pb, tq, PC_QC + 64 * h, hi, st, dry);
            }
        }
    }
}

__device__ __forceinline__ void st_sc1_16(void* p, u32x4 v) { if (ATT_NT) __builtin_nontemporal_store(v, (u32x4*)p); else *(u32x4*)p = v; }
__device__ __forceinline__ void mixa2_store_partial(unsigned char* __restrict__ AO2, float* __restrict__ ALSE, int pat2, size_t tok, int bh, int t, int h, int hi, AttState& st) {
    const float l = st.l + __shfl_xor(st.l, 32);
    const float inv = 1.0f / l;
    unsigned char* op = AO2 + (((size_t)pat2 * T + tok) * 6 + h) * 128 + hi * 64;
    u32x4 a, b;
    a.x = cvtpk(st.o0[0] * inv, st.o0[1] * inv); a.y = cvtpk(st.o0[2] * inv, st.o0[3] * inv); a.z = cvtpk(st.o0[4] * inv, st.o0[5] * inv); a.w = cvtpk(st.o0[6] * inv, st.o0[7] * inv);
    b.x = cvtpk(st.o0[8] * inv, st.o0[9] * inv); b.y = cvtpk(st.o0[10] * inv, st.o0[11] * inv); b.z = cvtpk(st.o0[12] * inv, st.o0[13] * inv); b.w = cvtpk(st.o0[14] * inv, st.o0[15] * inv);
    st_sc1_16(op, a); st_sc1_16(op + 16, b);
    a.x = cvtpk(st.o1[0] * inv, st.o1[1] * inv); a.y = cvtpk(st.o1[2] * inv, st.o1[3] * inv); a.z = cvtpk(st.o1[4] * inv, st.o1[5] * inv); a.w = cvtpk(st.o1[6] * inv, st.o1[7] * inv);
    b.x = cvtpk(st.o1[8] * inv, st.o1[9] * inv); b.y = cvtpk(st.o1[10] * inv, st.o1[11] * inv); b.z = cvtpk(st.o1[12] * inv, st.o1[13] * inv); b.w = cvtpk(st.o1[14] * inv, st.o1[15] * inv);
    st_sc1_16(op + 32, a); st_sc1_16(op + 48, b);
    if (hi == 0) ALSE[((size_t)pat2 * (BATCH * 6) + bh) * SEQ + t] = st.m + __builtin_amdgcn_logf(l);
}
struct MixaPart { u32x4 a1, b1, c1v, d1, a2, b2, c2v, d2; float lse1, lse2; };
__device__ __forceinline__ void mixa2_load_partials(MixaPart& mp, const unsigned char* __restrict__ AO2, const float* __restrict__ ALSE, size_t tok, int bh, int t, int h, int hi) {
    const unsigned char* p1 = AO2 + (((size_t)0 * T + tok) * 6 + h) * 128 + hi * 64;
    const unsigned char* p2 = AO2 + (((size_t)1 * T + tok) * 6 + h) * 128 + hi * 64;
    mp.a1 = *(const u32x4*)p1; mp.b1 = *(const u32x4*)(p1 + 16); mp.c1v = *(const u32x4*)(p1 + 32); mp.d1 = *(const u32x4*)(p1 + 48);
    mp.a2 = *(const u32x4*)p2; mp.b2 = *(const u32x4*)(p2 + 16); mp.c2v = *(const u32x4*)(p2 + 32); mp.d2 = *(const u32x4*)(p2 + 48);
    mp.lse1 = ALSE[((size_t)0 * (BATCH * 6) + bh) * SEQ + t]; mp.lse2 = ALSE[((size_t)1 * (BATCH * 6) + bh) * SEQ + t];
}
__device__ __forceinline__ void mixa2_combine_store(bf16_t* __restrict__ Pb, const unsigned char* __restrict__ AO2, const float* __restrict__ ALSE, size_t tok, int bh, int t, int h, int hi, AttState& st, const MixaPart* pre = nullptr) {
    const float l0 = st.l + __shfl_xor(st.l, 32);
    const float lse0 = st.m + __builtin_amdgcn_logf(l0);
    MixaPart mp_; if (!pre) mixa2_load_partials(mp_, AO2, ALSE, tok, bh, t, h, hi);
    const MixaPart& mp = pre ? *pre : mp_;
    const float lse1 = mp.lse1, lse2 = mp.lse2;
    const float mx = fmaxf(lse0, fmaxf(lse1, lse2));
    const float w0 = __builtin_amdgcn_exp2f(lse0 - mx), w1 = __builtin_amdgcn_exp2f(lse1 - mx), w2 = __builtin_amdgcn_exp2f(lse2 - mx);
    const float iw = 1.0f / (w0 + w1 + w2);
    const float c0 = w0 * iw / l0, c1 = w1 * iw, c2 = w2 * iw;
    const u32x4 a1 = mp.a1, b1 = mp.b1, c1v = mp.c1v, d1 = mp.d1, a2 = mp.a2, b2 = mp.b2, c2v = mp.c2v, d2 = mp.d2;
    const unsigned q1[16] = {a1.x, a1.y, a1.z, a1.w, b1.x, b1.y, b1.z, b1.w, c1v.x, c1v.y, c1v.z, c1v.w, d1.x, d1.y, d1.z, d1.w};
    const unsigned q2[16] = {a2.x, a2.y, a2.z, a2.w, b2.x, b2.y, b2.z, b2.w, c2v.x, c2v.y, c2v.z, c2v.w, d2.x, d2.y, d2.z, d2.w};
    float r0[16], r1[16];
#pragma unroll
    for (int j = 0; j < 8; ++j) {
        r0[2 * j] = fmaf(c0, st.o0[2 * j], fmaf(c1, bflo(q1[j]), c2 * bflo(q2[j]))); r0[2 * j + 1] = fmaf(c0, st.o0[2 * j + 1], fmaf(c1, bfhi(q1[j]), c2 * bfhi(q2[j])));
        r1[2 * j] = fmaf(c0, st.o1[2 * j], fmaf(c1, bflo(q1[8 + j]), c2 * bflo(q2[8 + j]))); r1[2 * j + 1] = fmaf(c0, st.o1[2 * j + 1], fmaf(c1, bfhi(q1[8 + j]), c2 * bfhi(q2[8 + j])));
    }
#if ATT_WIDE_ST
    bf16_t* op = Pb + (size_t)t * NP + PC_QA + 64 * h + 8 * hi;
#pragma unroll
    for (int k = 0; k < 2; ++k) {
        const unsigned a0x = cvtpk(r0[8 * k], r0[8 * k + 1]), a0y = cvtpk(r0[8 * k + 2], r0[8 * k + 3]), b0x = cvtpk(r0[8 * k + 4], r0[8 * k + 5]), b0y = cvtpk(r0[8 * k + 6], r0[8 * k + 7]);
        const unsigned a1x = cvtpk(r1[8 * k], r1[8 * k + 1]), a1y = cvtpk(r1[8 * k + 2], r1[8 * k + 3]), b1x = cvtpk(r1[8 * k + 4], r1[8 * k + 5]), b1y = cvtpk(r1[8 * k + 6], r1[8 * k + 7]);
        const auto s0x = __builtin_amdgcn_permlane32_swap(a0x, b0x, false, false), s0y = __builtin_amdgcn_permlane32_swap(a0y, b0y, false, false);
        const auto s1x = __builtin_amdgcn_permlane32_swap(a1x, b1x, false, false), s1y = __builtin_amdgcn_permlane32_swap(a1y, b1y, false, false);
        *(u32x4*)(op + 16 * k) = (u32x4){s0x[0], s0y[0], s0x[1], s0y[1]};
        *(u32x4*)(op + 32 + 16 * k) = (u32x4){s1x[0], s1y[0], s1x[1], s1y[1]};
    }
#else
    bf16_t* op = Pb + (size_t)t * NP + PC_QA + 64 * h + 4 * hi;
#pragma unroll
    for (int g = 0; g < 4; ++g) {
        u32x2 x0, x1;
        x0.x = cvtpk(r0[4 * g], r0[4 * g + 1]); x0.y = cvtpk(r0[4 * g + 2], r0[4 * g + 3]);
        x1.x = cvtpk(r1[4 * g], r1[4 * g + 1]); x1.y = cvtpk(r1[4 * g + 2], r1[4 * g + 3]);
        if (ATT_NT) { __builtin_nontemporal_store(x0, (u32x2*)(op + 8 * g)); __builtin_nontemporal_store(x1, (u32x2*)(op + 32 + 8 * g)); }
        else { *(u32x2*)(op + 8 * g) = x0; *(u32x2*)(op + 32 + 8 * g) = x1; }
    }
#endif
}
__device__ __forceinline__ void attention_phase_v2(unsigned char* __restrict__ ws, const float* __restrict__ sinks, int ctr_word, int kmax_word, LAS unsigned char* lds, int wave, int lane, int half) {
    LAS unsigned char* vl = lds + wave * ATT_WAVE_LDS;
    const int hi = lane >> 5, l31 = lane & 31;
    constexpr int NUB = 3072 / BQP, NUP = 6144 / APT, NUC = 6144 / CQT, NU1 = 6144 / APT, AGB = 256 / APT;
    const unsigned ntot = half == 0 ? (unsigned)(NUB + 2 * NUP) : (unsigned)(NUC + NU1);
    int cq = wave & (NQC - 1), tried = 0;
    for (;;) {
        unsigned j = 0;
        if (lane == 0) j = atomicAdd((unsigned*)ws + 2048 + (ctr_word - CW_ATT) * 4 + 32 * cq + half, 1u);
        j = __builtin_amdgcn_readfirstlane(j);
        const unsigned u = (unsigned)NQC * j + (unsigned)cq;
        if (u >= ntot) { if (++tried == NQC) break; cq = (cq + 1) & (NQC - 1); continue; }
        if (half == 0 && u < (unsigned)NUB) {
            const int bh = (int)(u % 24), b = bh / 6, h = bh % 6;
            for (int sub = 0; sub < BQP; ++sub) {
                const int qp = 127 - (int)(u / 24) * BQP - sub;
                attn_fox_pair(ATT_P + (size_t)b * SEQ * NP, ATT_CUMT + (size_t)bh * SEQ, ((const float*)ws)[kmax_word + 32 * bh], h, qp, vl, lane, 0);
            }
        } else if (half == 0) {
            const int v = (int)u - NUB;
            const int pat2 = v / NUP, w_ = v - pat2 * NUP, bh = w_ / AGB, xg = w_ - bh * AGB, b = bh / 6, h = bh % 6;
            const int r = pat2 == 0 ? 16 : 4;
            bf16_t* Pb = ATT_P + (size_t)b * SEQ * NP;
#define PTILE_TQ0(x_) ((pat2 == 0 ? ((x_) & 15) : ((x_) & 3)) + r * 32 * (pat2 == 0 ? ((x_) >> 4) : ((x_) >> 2)))
            KTile kn; VTile vn;
            { const int tq0 = PTILE_TQ0(APT * xg);
              k_load<false>(kn, Pb, PC_KA + 64 * h, r, tq0 - 128 * r, nullptr, lane); v_load(vn, Pb, PC_VA + 64 * h, r, tq0 - 128 * r, lane); }
            for (int sub = 0; sub < APT; ++sub) {
                const int tq0 = PTILE_TQ0(APT * xg + sub), tq = tq0 + r * l31;
                AttState st; att_init(st); bf16x8 qf[4]; KTile kc = kn; VTile vc = vn;
                attn_load_q(Pb, tq, PC_QA + 64 * h, hi, qf);
                if (sub + 1 < APT) { const int tq0n = PTILE_TQ0(APT * xg + sub + 1);
                    k_load<false>(kn, Pb, PC_KA + 64 * h, r, tq0n - 128 * r, nullptr, lane); v_load(vn, Pb, PC_VA + 64 * h, r, tq0n - 128 * r, lane); }
                if (pat2 == 0) attn_segment_pre<16>(Pb, PC_KA + 64 * h, PC_VA + 64 * h, 2048, tq0 - 2048, 5, tq, qf, st, vl, lane, kc, vc);
                else           attn_segment_pre<4>(Pb, PC_KA + 64 * h, PC_VA + 64 * h, 512, tq0 - 512, 5, tq, qf, st, vl, lane, kc, vc);
                mixa2_store_partial(ws + WS_AO, ATT_ALSE, pat2, (size_t)b * SEQ + tq, bh, tq, h, hi, st);
            }
#undef PTILE_TQ0
        } else if (u < (unsigned)NUC) {
            const int v = (int)u;
            const int bh = v / (256 / CQT), qg = v - bh * (256 / CQT), b = bh / 6, h = bh % 6, hk = h / 3;
            bf16_t* Pb = ATT_P + (size_t)b * SEQ * NP;
            const float sink = sinks[h] * LOG2E;
            bf16x8 qn[4]; KTile kn; VTile vn;
            { const int qt0 = qg * CQT; attn_load_q(Pb, qt0 * 32 + l31, PC_QC + 64 * h, hi, qn);
              k_load<false>(kn, Pb, PC_KC + 64 * hk, 1, qt0 * 32 - 128, nullptr, lane); v_load(vn, Pb, PC_VC + 64 * hk, 1, qt0 * 32 - 128, lane); }
            for (int sub = 0; sub < CQT; ++sub) {
                const int qt = qg * CQT + sub;
                const int tq = qt * 32 + l31;
                AttState st; att_init(st); bf16x8 qf[4]; KTile kc = kn; VTile vc = vn;
#pragma unroll
                for (int i_ = 0; i_ < 4; ++i_) qf[i_] = qn[i_];
                if (sub + 1 < CQT) { attn_load_q(Pb, (qt + 1) * 32 + l31, PC_QC + 64 * h, hi, qn);
                    k_load<false>(kn, Pb, PC_KC + 64 * hk, 1, (qt + 1) * 32 - 128, nullptr, lane); v_load(vn, Pb, PC_VC + 64 * hk, 1, (qt + 1) * 32 - 128, lane); }
                st.m = sink; st.l = (hi == 0) ? 1.f : 0.f;
                attn_segment_pre<1>(Pb, PC_KC + 64 * hk, PC_VC + 64 * hk, 127, qt * 32 - 128, 5, tq, qf, st, vl, lane, kc, vc);
                attn_store_o(Pb, tq, PC_QC + 64 * h, hi, st, 0);
            }
        } else {
            const int v = (int)u - NUC;
            const int bh = v / AGB, qg = v - bh * AGB, b = bh / 6, h = bh % 6;
            bf16_t* Pb = ATT_P + (size_t)b * SEQ * NP;
            bf16x8 qn[4]; KTile kn; VTile vn;
            { const int qt0 = APT * qg; attn_load_q(Pb, qt0 * 32 + l31, PC_QA + 64 * h, hi, qn);
              k_load<false>(kn, Pb, PC_KA + 64 * h, 1, qt0 * 32 - 128, nullptr, lane); v_load(vn, Pb, PC_VA + 64 * h, 1, qt0 * 32 - 128, lane); }
            for (int sub = 0; sub < APT; ++sub) {
                const int qt = APT * qg + sub;
                const int tq = qt * 32 + l31;
                AttState st; att_init(st); bf16x8 qf[4]; KTile kc = kn; VTile vc = vn;
#pragma unroll
                for (int i_ = 0; i_ < 4; ++i_) qf[i_] = qn[i_];
                if (sub + 1 < APT) { attn_load_q(Pb, (qt + 1) * 32 + l31, PC_QA + 64 * h, hi, qn);
                    k_load<false>(kn, Pb, PC_KA + 64 * h, 1, (qt + 1) * 32 - 128, nullptr, lane); v_load(vn, Pb, PC_VA + 64 * h, 1, (qt + 1) * 32 - 128, lane); }
                attn_segment_pre<1>(Pb, PC_KA + 64 * h, PC_VA + 64 * h, 128, qt * 32 - 128, 5, tq, qf, st, vl, lane, kc, vc);
                mixa2_combine_store(Pb, ws + WS_AO, ATT_ALSE, (size_t)b * SEQ + tq, bh, tq, h, hi, st);
            }
        }
    }
}

#ifndef ATT_XCD
#define ATT_XCD 0
#endif
__device__ __forceinline__ void attention_phase_x(unsigned char* __restrict__ ws, const float* __restrict__ sinks, int ctr_word  , int kmax_word, LAS unsigned char* lds, int wave, int lane, int xcc) {
    LAS unsigned char* vl = lds + wave * ATT_WAVE_LDS;
    const int hi = lane >> 5, l31 = lane & 31;
    constexpr int QB = 3 * 128, QA = 3 * 256, QC = 3 * 256, QN = QB + QA + QC;
    int q = xcc & 7;
    int tried = 0;
    for (;;) {
        unsigned j = 0;
        if (lane == 0) j = atomicAdd((unsigned*)ws + ctr_word + q, 1u);
        j = __builtin_amdgcn_readfirstlane(j);
        if (j >= (unsigned)QN) {
            tried |= 1 << q;
            if (tried == 0xff) break;
            const unsigned cv = ((volatile const unsigned*)ws)[ctr_word + (lane & 7)];
            int nq = -1;
#pragma unroll
            for (int k = 1; k < 8; ++k) { const int qq = (q + k) & 7; const unsigned c_ = (unsigned)__builtin_amdgcn_readlane((int)cv, qq); if (nq < 0 && !((tried >> qq) & 1)) { if (c_ < (unsigned)QN) nq = qq; else tried |= 1 << qq; } }
            if (nq < 0) break;
            q = nq; continue;
        }
        if (j < (unsigned)QB) {
            const int bh = q + 8 * (int)(j >> 7), qp = 127 - (int)(j & 127), b = bh / 6, h = bh % 6;
            attn_fox_pair(ATT_P + (size_t)b * SEQ * NP, ATT_CUMT + (size_t)bh * SEQ, ((const float*)ws)[kmax_word + 32 * bh], h, qp, vl, lane, 0);
        } else if (j < (unsigned)(QB + QA)) {
            const int jj = (int)j - QB, bh = q + 8 * (jj >> 8), v = jj & 255, b = bh / 6, h = bh % 6;
            const int cb = v & 15, rho = v >> 4;
            bf16_t* Pb = ATT_P + (size_t)b * SEQ * NP;
            const int tq0 = rho + 512 * cb, tq = tq0 + 16 * l31;
            AttState st; att_init(st); bf16x8 qf[4];
            attn_load_q(Pb, tq, PC_QA + 64 * h, hi, qf);
            attn_segment<16>(Pb, PC_KA + 64 * h, PC_VA + 64 * h, 2048, tq0 - 2048, 5, tq, qf, st, vl, lane);
            attn_segment<4>(Pb, PC_KA + 64 * h, PC_VA + 64 * h, 512, tq0 - 512, 8, tq, qf, st, vl, lane);
            attn_segment<1>(Pb, PC_KA + 64 * h, PC_VA + 64 * h, 128, tq0 - 128, 20, tq, qf, st, vl, lane);
            attn_store_o(Pb, tq, PC_QA + 64 * h, hi, st, 0);
        } else {
            const int jj = (int)j - QB - QA, bh = q + 8 * (jj >> 8), qt = jj & 255, b = bh / 6, h = bh % 6, hk = h / 3;
            bf16_t* Pb = ATT_P + (size_t)b * SEQ * NP;
            const int tq = qt * 32 + l31;
            AttState st; att_init(st); bf16x8 qf[4];
            attn_load_q(Pb, tq, PC_QC + 64 * h, hi, qf);
            st.m = sinks[h] * LOG2E; st.l = (hi == 0) ? 1.f : 0.f;
            attn_segment<1>(Pb, PC_KC + 64 * hk, PC_VC + 64 * hk, 127, qt * 32 - 128, 5, tq, qf, st, vl, lane);
            attn_store_o(Pb, tq, PC_QC + 64 * h, hi, st, 0);
        }
    }
}

__device__ __forceinline__ int f2key(float f) { const int b = __float_as_int(f); return b ^ ((b >> 31) & 0x7fffffff); }
__device__ __forceinline__ float key2f(int k) { return __int_as_float(k ^ ((k >> 31) & 0x7fffffff)); }
#define CE_DESC(a, x) do { const int hi_ = max((a), (x)); (x) = min((a), (x)); (a) = hi_; } while (0)

__device__ __forceinline__ void route_half(const bf16_t* __restrict__ qrow, const LAS unsigned char* kl, int (&list)[16]) {
    unsigned qh[64];
#pragma unroll
    for (int c = 0; c < 16; ++c) { const u32x4 t = *(const u32x4*)(qrow + 8 * c); qh[4 * c] = t.x; qh[4 * c + 1] = t.y; qh[4 * c + 2] = t.z; qh[4 * c + 3] = t.w; }
#pragma unroll
    for (int i = 0; i < 16; ++i) list[i] = (int)0x80000000;
    for (int key = 0; key < 128; ++key) {
        float a0 = 0.f, a1 = 0.f;
        const LAS unsigned char* kp = kl + key * 256;
#pragma unroll
        for (int c = 0; c < 16; ++c) {
            const u32x4 kk = *(const LAS u32x4*)(kp + 16 * c);
            a0 = dot2bf(qh[4 * c], kk.x, a0); a1 = dot2bf(qh[4 * c + 1], kk.y, a1);
            a0 = dot2bf(qh[4 * c + 2], kk.z, a0); a1 = dot2bf(qh[4 * c + 3], kk.w, a1);
        }
        int x = (f2key(a0 + a1) & ~127) | key;
#pragma unroll
        for (int i = 0; i < 16; ++i) CE_DESC(list[i], x);
    }
}

__device__ __forceinline__ void routing_phase(const bf16_t* __restrict__ Q2, const float* __restrict__ k1, const float* __restrict__ k2, int* __restrict__ ids, float* __restrict__ gw,
                                              LAS unsigned char* lds, int tid) {
    for (int e = tid; e < 2 * 8192; e += 512) {
        const int hf = e >> 13, o = (e & 8191) * 2;
        const float* src = (hf ? k2 : k1) + o;
        *(LAS unsigned*)(lds + hf * 32768 + o * 2) = cvtpk(src[0], src[1]);
    }
    __syncthreads();
    const int nthreads = gridDim.x * 512;
    for (int it = blockIdx.x * 512 + tid; it < T * 8; it += nthreads) {
        const int t = it >> 3, h = it & 7;
        const bf16_t* qrow = Q2 + (size_t)t * 2048 + h * 256;
        int l1[16], l2[16];
        route_half(qrow, lds, l1);
        route_half(qrow + 128, lds + 32768, l2);
        float f1[16], f2[16];
#pragma unroll
        for (int i = 0; i < 16; ++i) { f1[i] = key2f(l1[i] & ~127); f2[i] = key2f(l2[i] & ~127); }
        int cl[16];
#pragma unroll
        for (int j = 0; j < 16; ++j) cl[j] = (f2key(f1[0] + f2[j]) & ~255) | j;
#pragma unroll
        for (int i = 1; i < 16; ++i) {
#pragma unroll
            for (int j = 0; j < 16; ++j) {
                if ((i + 1) * (j + 1) <= 16) {
                    int x = (f2key(f1[i] + f2[j]) & ~255) | (i * 16 + j);
#pragma unroll
                    for (int k = 0; k < 16; ++k) CE_DESC(cl[k], x);
                }
            }
        }
        float sc[16]; int idv[16];
#pragma unroll
        for (int k = 0; k < 16; ++k) {
            sc[k] = key2f(cl[k] & ~255);
            const int pi = (cl[k] >> 4) & 15, pj = cl[k] & 15;
            int a = 0, b = 0;
#pragma unroll
            for (int i = 0; i < 16; ++i) { a = (pi == i) ? (l1[i] & 127) : a; b = (pj == i) ? (l2[i] & 127) : b; }
            idv[k] = a * 128 + b;
        }
        float e[16], sum = 0.f;
#pragma unroll
        for (int k = 0; k < 16; ++k) { e[k] = __expf(sc[k] - sc[0]); sum += e[k]; }
        const float inv = 1.0f / sum;
        int* ip = ids + (size_t)it * 16; float* gp = gw + (size_t)it * 16;
#pragma unroll
        for (int k = 0; k < 16; k += 4) {
            *(int4*)(ip + k) = make_int4(idv[k], idv[k + 1], idv[k + 2], idv[k + 3]);
            *(float4*)(gp + k) = make_float4(e[k] * inv, e[k + 1] * inv, e[k + 2] * inv, e[k + 3] * inv);
        }
    }
}

__device__ __forceinline__ float gelu_erf(float x);
constexpr int KPITCH = 272;
constexpr int R2_K_BYTES = 2 * 128 * KPITCH;
#define CE_MAXMIN(a, b) do { const int hi_ = max((a), (b)); const int lo_ = min((a), (b)); (a) = hi_; (b) = lo_; } while (0)
__device__ __forceinline__ void bitonic_merge16_desc(int (&a)[16]) {
#pragma unroll
    for (int js = 3; js >= 0; --js) {
#pragma unroll
        for (int i = 0; i < 16; ++i) { const int l = i ^ (1 << js); if (l > i) CE_MAXMIN(a[i], a[l]); }
    }
}
__device__ __forceinline__ void bitonic_sort16_desc(int (&a)[16]) {
#pragma unroll
    for (int ks = 1; ks <= 4; ++ks) {
#pragma unroll
        for (int js = ks - 1; js >= 0; --js) {
#pragma unroll
            for (int i = 0; i < 16; ++i) { const int l = i ^ (1 << js);
                if (l > i) { if ((i & (1 << ks)) == 0) CE_MAXMIN(a[i], a[l]); else CE_MAXMIN(a[l], a[i]); } }
        }
    }
}
__device__ __forceinline__ void merge_top16(int (&a)[16], const int (&b)[16]) {
#pragma unroll
    for (int i = 0; i < 16; ++i) a[i] = max(a[i], b[15 - i]);
    bitonic_merge16_desc(a);
}
__device__ __forceinline__ void route2_half(const bf16_t* __restrict__ qrow  , const LAS unsigned char* kl  , int hi, int (&L)[16]) {
    f32x16 acc[4];
#pragma unroll
    for (int kt = 0; kt < 4; ++kt)
#pragma unroll
        for (int r = 0; r < 16; ++r) acc[kt][r] = 0.f;
    bf16x8 qf[8];
#pragma unroll
    for (int s = 0; s < 8; ++s) qf[s] = *(const bf16x8*)(qrow + 16 * s);
#pragma unroll
    for (int s = 0; s < 8; ++s) {
#pragma unroll
        for (int kt = 0; kt < 4; ++kt) {
            const bf16x8 kf = *(const LAS bf16x8*)(kl + kt * 32 * KPITCH + 32 * s);
            acc[kt] = __builtin_amdgcn_mfma_f32_32x32x16_bf16(kf, qf[s], acc[kt], 0, 0, 0);
        }
    }
    int kk[4][16];
    const int hi4 = 4 * hi;
#pragma unroll
    for (int kt = 0; kt < 4; ++kt)
#pragma unroll
        for (int r = 0; r < 16; ++r) kk[kt][r] = (f2key(acc[kt][r]) & ~127) | ((32 * kt + (r & 3) + 8 * (r >> 2)) | hi4);
#pragma unroll
    for (int kt = 0; kt < 4; ++kt) bitonic_sort16_desc(kk[kt]);
    merge_top16(kk[0], kk[1]); merge_top16(kk[2], kk[3]); merge_top16(kk[0], kk[2]);
#pragma unroll
    for (int i = 0; i < 16; ++i) L[i] = max(kk[0][i], __shfl_xor(kk[0][15 - i], 32));
    bitonic_merge16_desc(L);
}

__device__ __forceinline__ void routing2_setup(const float* __restrict__ k1, const float* __restrict__ k2, LAS unsigned char* lds, int tid) {
    for (int e = tid; e < 2 * 8192; e += 512) {
        const int hf = e >> 13, o = (e & 8191) * 2, key = o >> 7, d = o & 127;
        const float* src = (hf ? k2 : k1) + o;
        *(LAS unsigned*)(lds + hf * 128 * KPITCH + key * KPITCH + d * 2) = cvtpk(src[0], src[1]);
    }
    __syncthreads();
}
__device__ __forceinline__ void routing2_units(const bf16_t* __restrict__ Q2, int* __restrict__ ids, float* __restrict__ gw,
                                               LAS unsigned char* lds, int wave, int lane, int gwave, int ngw) {
    LAS unsigned char* scr = lds + R2_K_BYTES + wave * 2048 + lane * 32;
    const int hi = lane >> 5, l31 = lane & 31;
    for (int u = (gwave < 0 ? wave : gwave); u < (gwave < 0 ? 32 : (T / 32) * 8); u += (gwave < 0 ? 8 : ngw)) {
        const int tb = gwave < 0 ? (int)blockIdx.x * 4 + (u >> 3) : (u >> 3), h = u & 7;
        const int t = tb * 32 + l31;
        const bf16_t* qrow = Q2_HEADMAJOR ? Q2 + (size_t)h * ((size_t)T * 256) + (size_t)t * 256 + 8 * hi : Q2 + (size_t)t * 2048 + h * 256 + 8 * hi;
        int l1[16], l2[16];
        route2_half(qrow, lds + l31 * KPITCH + 16 * hi, hi, l1);
        route2_half(qrow + 128, lds + 128 * KPITCH + l31 * KPITCH + 16 * hi, hi, l2);
#pragma unroll
        for (int i = 0; i < 16; i += 4) {
            *(LAS unsigned*)(scr + i) = (unsigned)(l1[i] & 127) | ((unsigned)(l1[i + 1] & 127) << 8) | ((unsigned)(l1[i + 2] & 127) << 16) | ((unsigned)(l1[i + 3] & 127) << 24);
            *(LAS unsigned*)(scr + 16 + i) = (unsigned)(l2[i] & 127) | ((unsigned)(l2[i + 1] & 127) << 8) | ((unsigned)(l2[i + 2] & 127) << 16) | ((unsigned)(l2[i + 3] & 127) << 24);
        }
        float f1[16], f2[16];
#pragma unroll
        for (int i = 0; i < 16; ++i) { f1[i] = key2f(l1[i] & ~127); f2[i] = key2f(l2[i] & ~127); }
        int cl[16];
#pragma unroll
        for (int j = 0; j < 16; ++j) cl[j] = (f2key(f1[0] + f2[j]) & ~255) | (255 - j);
#pragma unroll
        for (int i = 1; i < 16; ++i) {
#pragma unroll
            for (int j = 0; j < 16; ++j) {
                if ((i + 1) * (j + 1) <= 16) {
                    int x = (f2key(f1[i] + f2[j]) & ~255) | (255 - (i * 16 + j));
#pragma unroll
                    for (int k = (i + 1) * (j + 1) - 1; k < 16; ++k) CE_DESC(cl[k], x);
                }
            }
        }
        float e[16], sum = 0.f;
        const float mx = key2f(cl[0] & ~255);
#pragma unroll
        for (int k = 0; k < 16; ++k) { e[k] = __expf(key2f(cl[k] & ~255) - mx); sum += e[k]; }
        const float inv = 1.0f / sum;
        asm volatile("s_waitcnt lgkmcnt(0)" ::: "memory");
        int idv[8]; float gv[8];
#pragma unroll
        for (int k = 0; k < 8; ++k) {
            const int c = 255 - ((hi ? cl[8 + k] : cl[k]) & 255);
            gv[k] = (hi ? e[8 + k] : e[k]) * inv;
            const int pi = (c >> 4) & 15, pj = c & 15;
            const int a = *(const LAS unsigned char*)(scr + pi), b = *(const LAS unsigned char*)(scr + 16 + pj);
            idv[k] = a * 128 + b;
        }
        int* ip = ids + ((size_t)t * 8 + h) * 16 + 8 * hi; float* gp = gw + ((size_t)t * 8 + h) * 16 + 8 * hi;
        *(int4*)(ip) = make_int4(idv[0], idv[1], idv[2], idv[3]); *(int4*)(ip + 4) = make_int4(idv[4], idv[5], idv[6], idv[7]);
        *(float4*)(gp) = make_float4(gv[0], gv[1], gv[2], gv[3]); *(float4*)(gp + 4) = make_float4(gv[4], gv[5], gv[6], gv[7]);
        asm volatile("s_waitcnt lgkmcnt(0)" ::: "memory");
    }
}

typedef __bf16 bf16x2v_t __attribute__((ext_vector_type(2)));
__device__ __forceinline__ float dot2(unsigned a, unsigned b, float acc) { return __builtin_amdgcn_fdot2_f32_bf16(__builtin_bit_cast(bf16x2v_t, a), __builtin_bit_cast(bf16x2v_t, b), acc, false); }
template <int CTRL> __device__ __forceinline__ float dpp_add(float v) { return v + __builtin_bit_cast(float, __builtin_amdgcn_update_dpp(0, __builtin_bit_cast(int, v), CTRL, 0xF, 0xF, true)); }
__device__ __forceinline__ float xor16_add(float v) { return v + __builtin_bit_cast(float, __builtin_amdgcn_ds_swizzle(__builtin_bit_cast(int, v), 0x401F)); }
__device__ __forceinline__ float xor32_add(float v) { return v + __shfl_xor(v, 32); }
constexpr int G2_WAVE_LDS = 4096 + 8192 + 128;

__device__ __forceinline__ void gather2_phase(float* __restrict__ H, bf16_t* __restrict__ HB, const float* __restrict__ ssq2p, float* __restrict__ ssq1,
                                              const bf16_t* __restrict__ U16, const bf16_t* __restrict__ V16, const int* __restrict__ ids, const float* __restrict__ gw,
                                              const float* __restrict__ final_g, int last, LAS unsigned char* lds, int wave, int gwave, int lane) {
    LAS unsigned char* wl = lds + wave * G2_WAVE_LDS;
    LAS unsigned short* idl = (LAS unsigned short*)wl;
    LAS float* al = (LAS float*)(wl + 4096);
    const int t0 = __builtin_amdgcn_readfirstlane(gwave * 16);
    const int g = lane >> 3, p = lane & 7;
    for (int tt = 0; tt < 16; ++tt) {
#pragma unroll
        for (int hf = 0; hf < 2; ++hf) { const int k = lane + 64 * hf; idl[tt * 128 + (k & 7) * 16 + (k >> 3)] = (unsigned short)ids[(size_t)(t0 + tt) * 128 + k]; }
    }
    for (int e = lane; e < 2048; e += 64) al[e] = 0.f;
    asm volatile("s_waitcnt lgkmcnt(0)" ::: "memory");
    const unsigned char* Ub = (const unsigned char*)U16; const unsigned char* Vb = (const unsigned char*)V16;
    for (int c = 0; c < 16; ++c) {
        for (int tt = 0; tt < 16; ++tt) {
            const u32x4 x4 = *(const u32x4*)(HB + (size_t)(t0 + tt) * DM + 64 * c + 8 * p);
            const u32x4 i0 = *(const LAS u32x4*)(idl + tt * 128 + g * 16), i1 = *(const LAS u32x4*)(idl + tt * 128 + g * 16 + 8);
            const unsigned idw[8] = {i0.x, i0.y, i0.z, i0.w, i1.x, i1.y, i1.z, i1.w};
            u32x4 u[16];
#pragma unroll
            for (int i = 0; i < 16; ++i) { const unsigned id = (i & 1) ? (idw[i >> 1] >> 16) : (idw[i >> 1] & 0xffffu);
                u[i] = *(const u32x4*)(Ub + (size_t)(id * 2048u + (unsigned)(c * 128 + p * 16))); }
            float a[16];
#pragma unroll
            for (int i = 0; i < 16; ++i) {
                float s = dot2(x4.x, u[i].x, 0.f); s = dot2(x4.y, u[i].y, s); s = dot2(x4.z, u[i].z, s); s = dot2(x4.w, u[i].w, s);
                s = dpp_add<0xB1>(s); s = dpp_add<0x4E>(s); s = dpp_add<0x141>(s);
                a[i] = s;
            }
            if (p == 0) {
                LAS float* ap = al + tt * 128 + g * 16;
#pragma unroll
                for (int i = 0; i < 16; ++i) (void)__hip_atomic_fetch_add(ap + i, a[i], __ATOMIC_RELAXED, __HIP_MEMORY_SCOPE_WORKGROUP);
            }
        }
    }
    asm volatile("s_waitcnt lgkmcnt(0)" ::: "memory");
    for (int n = 0; n < 32; ++n) {
        const int tt = n >> 1, pos = lane + 64 * (n & 1), k = 8 * (pos & 15) + (pos >> 4);
        const float rs2 = rsqrtf(ssq16(ssq2p, t0 + tt) * (1.0f / 1024.0f) + RMS_EPS);
        const float a = al[tt * 128 + pos] * rs2;
        al[tt * 128 + pos] = gw[(size_t)(t0 + tt) * 128 + k] * gelu_erf(a);
    }
    asm volatile("s_waitcnt lgkmcnt(0)" ::: "memory");
    for (int c = 0; c < 16; ++c) {
        for (int tt = 0; tt < 16; ++tt) {
            const LAS f32x4* wp = (const LAS f32x4*)(al + tt * 128 + g * 16);
            const f32x4 w0 = wp[0], w1 = wp[1], w2 = wp[2], w3 = wp[3];
            const float w[16] = {w0[0], w0[1], w0[2], w0[3], w1[0], w1[1], w1[2], w1[3], w2[0], w2[1], w2[2], w2[3], w3[0], w3[1], w3[2], w3[3]};
            const u32x4 i0 = *(const LAS u32x4*)(idl + tt * 128 + g * 16), i1 = *(const LAS u32x4*)(idl + tt * 128 + g * 16 + 8);
            const unsigned idw[8] = {i0.x, i0.y, i0.z, i0.w, i1.x, i1.y, i1.z, i1.w};
            u32x4 v[16];
#pragma unroll
            for (int i = 0; i < 16; ++i) { const unsigned id = (i & 1) ? (idw[i >> 1] >> 16) : (idw[i >> 1] & 0xffffu);
                v[i] = *(const u32x4*)(Vb + (size_t)(id * 2048u + (unsigned)(c * 128 + p * 16))); }
            float y[8];
#pragma unroll
            for (int j = 0; j < 8; ++j) y[j] = 0.f;
#pragma unroll
            for (int i = 0; i < 16; ++i) {
                y[0] = fmaf(w[i], bflo(v[i].x), y[0]); y[1] = fmaf(w[i], bfhi(v[i].x), y[1]); y[2] = fmaf(w[i], bflo(v[i].y), y[2]); y[3] = fmaf(w[i], bfhi(v[i].y), y[3]);
                y[4] = fmaf(w[i], bflo(v[i].z), y[4]); y[5] = fmaf(w[i], bfhi(v[i].z), y[5]); y[6] = fmaf(w[i], bflo(v[i].w), y[6]); y[7] = fmaf(w[i], bfhi(v[i].w), y[7]);
            }
#pragma unroll
            for (int j = 0; j < 8; ++j) { y[j] = dpp_add<0x128>(y[j]); y[j] = xor16_add(y[j]); y[j] = xor32_add(y[j]); }
            if (g == 0) {
                float* hp = H + (size_t)(t0 + tt) * DM + 64 * c + 8 * p;
                f32x4 h0 = *(const f32x4*)hp, h1 = *(const f32x4*)(hp + 4);
                h0 += (f32x4){y[0], y[1], y[2], y[3]}; h1 += (f32x4){y[4], y[5], y[6], y[7]};
                *(f32x4*)hp = h0; *(f32x4*)(hp + 4) = h1;
            }
        }
    }
    __builtin_amdgcn_fence(__ATOMIC_SEQ_CST, "agent");
    asm volatile("s_waitcnt vmcnt(0)" ::: "memory");
    for (int tt = 0; tt < 16; ++tt) {
        const int t = t0 + tt;
        float* hp = H + (size_t)t * DM + 8 * lane;
        f32x4 h0 = *(const f32x4*)hp, h1 = *(const f32x4*)(hp + 4), h2 = *(const f32x4*)(hp + 512), h3 = *(const f32x4*)(hp + 516);
        float ss = (h0[0] * h0[0] + h0[1] * h0[1]) + (h0[2] * h0[2] + h0[3] * h0[3]) + (h1[0] * h1[0] + h1[1] * h1[1]) + (h1[2] * h1[2] + h1[3] * h1[3])
                 + (h2[0] * h2[0] + h2[1] * h2[1]) + (h2[2] * h2[2] + h2[3] * h2[3]) + (h3[0] * h3[0] + h3[1] * h3[1]) + (h3[2] * h3[2] + h3[3] * h3[3]);
        ss = wave_sum(ss);
        if (last) {
            const float rs = rsqrtf(ss * (1.0f / 1024.0f) + RMS_EPS);
            const f32x4 g0 = *(const f32x4*)(final_g + 8 * lane), g1 = *(const f32x4*)(final_g + 8 * lane + 4), g2 = *(const f32x4*)(final_g + 512 + 8 * lane), g3 = *(const f32x4*)(final_g + 516 + 8 * lane);
            h0 = h0 * rs * g0; h1 = h1 * rs * g1; h2 = h2 * rs * g2; h3 = h3 * rs * g3;
            *(f32x4*)hp = h0; *(f32x4*)(hp + 4) = h1; *(f32x4*)(hp + 512) = h2; *(f32x4*)(hp + 516) = h3;
        } else {
            bf16_t* bp = HB + (size_t)t * DM + 8 * lane;
            u32x4 w; w.x = cvtpk(h0[0], h0[1]); w.y = cvtpk(h0[2], h0[3]); w.z = cvtpk(h1[0], h1[1]); w.w = cvtpk(h1[2], h1[3]);
            *(u32x4*)bp = w;
            w.x = cvtpk(h2[0], h2[1]); w.y = cvtpk(h2[2], h2[3]); w.z = cvtpk(h3[0], h3[1]); w.w = cvtpk(h3[2], h3[3]);
            *(u32x4*)(bp + 512) = w;
            if (lane == 0) ssq1[t] = ss;
        }
    }
}

#ifndef G3_UMFMA
#define G3_UMFMA 0
#endif
#ifndef G3_VF16
#define G3_VF16 1
#endif
typedef _Float16 f16x2_t __attribute__((ext_vector_type(2)));
__device__ __forceinline__ unsigned cvtpk_h(float lo, float hi) { f16x2_t v = {(_Float16)lo, (_Float16)hi}; return __builtin_bit_cast(unsigned, v); }
__device__ __forceinline__ void fma_mix_lo(float& y, float w, unsigned pk) { asm("v_fma_mix_f32 %0, %1, %2, %0 op_sel_hi:[0,1,0]" : "+v"(y) : "v"(w), "v"(pk)); }
__device__ __forceinline__ void fma_mix_hi(float& y, float w, unsigned pk) { asm("v_fma_mix_f32 %0, %1, %2, %0 op_sel:[0,1,0] op_sel_hi:[0,1,0]" : "+v"(y) : "v"(w), "v"(pk)); }
__device__ __forceinline__ float swap32_add(float a, float b) {
    const auto r = __builtin_amdgcn_permlane32_swap(__float_as_uint(a), __float_as_uint(b), false, false);
    return __uint_as_float(r[0]) + __uint_as_float(r[1]);
}

__device__ __forceinline__ void gather3_phase(float* __restrict__ H, bf16_t* __restrict__ HB, const float* __restrict__ ssq2p, float* __restrict__ ssq1,
                                              const bf16_t* __restrict__ U16, const unsigned short* __restrict__ V16h, const int* __restrict__ ids, const float* __restrict__ gw,
                                              const float* __restrict__ final_g, int last, LAS unsigned char* lds, int wave, int gwave, int lane) {
    LAS unsigned char* wl = lds + wave * G2_WAVE_LDS;
    LAS unsigned short* idl = (LAS unsigned short*)wl;
    LAS float* al = (LAS float*)(wl + 4096);
    const int t0 = __builtin_amdgcn_readfirstlane(gwave * 16);
    for (int tt = 0; tt < 16; ++tt) {
        idl[tt * 128 + lane] = (unsigned short)ids[(size_t)(t0 + tt) * 128 + lane];
        idl[tt * 128 + 64 + lane] = (unsigned short)ids[(size_t)(t0 + tt) * 128 + 64 + lane];
    }
    for (int e = lane; e < 2048; e += 64) al[e] = 0.f;
    asm volatile("s_waitcnt lgkmcnt(0)" ::: "memory");
    const unsigned char* Ub = (const unsigned char*)U16; const unsigned char* Vb = (const unsigned char*)V16h;
#if G3_UMFMA
    {
        const int e = lane & 15, q = lane >> 4;
        for (int c = 0; c < 16; ++c) {
            for (int tt = 0; tt < 16; ++tt) {
                const bf16_t* xp = HB + (size_t)(t0 + tt) * DM + 64 * c + 8 * q;
                const bf16x8 xa = *(const bf16x8*)xp, xb = *(const bf16x8*)(xp + 32);
                const u32x4 iv = *(const LAS u32x4*)(idl + tt * 128 + 8 * e);
                const unsigned idw[4] = {iv.x, iv.y, iv.z, iv.w};
                bf16x8 ua[8], ub[8];
#pragma unroll
                for (int gi = 0; gi < 8; ++gi) { const unsigned id = (gi & 1) ? (idw[gi >> 1] >> 16) : (idw[gi >> 1] & 0xffffu);
                    const unsigned char* up = Ub + (size_t)(id * 2048u + (unsigned)(c * 128 + q * 16));
                    ua[gi] = *(const bf16x8*)up; ub[gi] = *(const bf16x8*)(up + 64); }
                float r[8];
#pragma unroll
                for (int gi = 0; gi < 8; ++gi) {
                    f32x4 acc = {0.f, 0.f, 0.f, 0.f};
                    acc = __builtin_amdgcn_mfma_f32_16x16x32_bf16(xa, ua[gi], acc, 0, 0, 0);
                    acc = __builtin_amdgcn_mfma_f32_16x16x32_bf16(xb, ub[gi], acc, 0, 0, 0);
                    r[gi] = acc[0];
                }
                if (q == 0) {
                    LAS float* ap = al + tt * 128 + 8 * e;
#pragma unroll
                    for (int gi = 0; gi < 8; ++gi) (void)__hip_atomic_fetch_add(ap + gi, r[gi], __ATOMIC_RELAXED, __HIP_MEMORY_SCOPE_WORKGROUP);
                }
            }
        }
    }
#else
    {
        const int g = lane >> 3, p = lane & 7;
        for (int c = 0; c < 16; ++c) {
            for (int tt = 0; tt < 16; ++tt) {
                const u32x4 x4 = *(const u32x4*)(HB + (size_t)(t0 + tt) * DM + 64 * c + 8 * p);
                const u32x4 i0 = *(const LAS u32x4*)(idl + tt * 128 + g * 16), i1 = *(const LAS u32x4*)(idl + tt * 128 + g * 16 + 8);
                const unsigned idw[8] = {i0.x, i0.y, i0.z, i0.w, i1.x, i1.y, i1.z, i1.w};
                u32x4 u[16];
#pragma unroll
                for (int i = 0; i < 16; ++i) { const unsigned id = (i & 1) ? (idw[i >> 1] >> 16) : (idw[i >> 1] & 0xffffu);
                    u[i] = *(const u32x4*)(Ub + (size_t)(id * 2048u + (unsigned)(c * 128 + p * 16))); }
                float a[16];
#pragma unroll
                for (int i = 0; i < 16; ++i) {
                    float s_ = dot2(x4.x, u[i].x, 0.f); s_ = dot2(x4.y, u[i].y, s_); s_ = dot2(x4.z, u[i].z, s_); s_ = dot2(x4.w, u[i].w, s_);
                    s_ = dpp_add<0xB1>(s_); s_ = dpp_add<0x4E>(s_); s_ = dpp_add<0x141>(s_);
                    a[i] = s_;
                }
                if (p == 0) {
                    LAS float* ap = al + tt * 128 + g * 16;
#pragma unroll
                    for (int i = 0; i < 16; ++i) (void)__hip_atomic_fetch_add(ap + i, a[i], __ATOMIC_RELAXED, __HIP_MEMORY_SCOPE_WORKGROUP);
                }
            }
        }
    }
#endif
    asm volatile("s_waitcnt lgkmcnt(0)" ::: "memory");
    for (int n = 0; n < 32; ++n) {
        const int tt = n >> 1, k = lane + 64 * (n & 1);
        const float rs2 = rsqrtf(ssq16(ssq2p, t0 + tt) * (1.0f / 1024.0f) + RMS_EPS);
        const float a = al[tt * 128 + k] * rs2;
        al[tt * 128 + k] = gw[(size_t)(t0 + tt) * 128 + k] * gelu_erf(a);
    }
    asm volatile("s_waitcnt lgkmcnt(0)" ::: "memory");
    {
        const int g = lane >> 3, p = lane & 7;
        for (int c = 0; c < 16; ++c) {
            for (int tt = 0; tt < 16; ++tt) {
                const LAS f32x4* wp = (const LAS f32x4*)(al + tt * 128 + g * 16);
                const f32x4 w0 = wp[0], w1 = wp[1], w2 = wp[2], w3 = wp[3];
                const float w[16] = {w0[0], w0[1], w0[2], w0[3], w1[0], w1[1], w1[2], w1[3], w2[0], w2[1], w2[2], w2[3], w3[0], w3[1], w3[2], w3[3]};
                const u32x4 i0 = *(const LAS u32x4*)(idl + tt * 128 + g * 16), i1 = *(const LAS u32x4*)(idl + tt * 128 + g * 16 + 8);
                const unsigned idw[8] = {i0.x, i0.y, i0.z, i0.w, i1.x, i1.y, i1.z, i1.w};
                u32x4 v[16];
#pragma unroll
                for (int i = 0; i < 16; ++i) { const unsigned id = (i & 1) ? (idw[i >> 1] >> 16) : (idw[i >> 1] & 0xffffu);
                    v[i] = *(const u32x4*)(Vb + (size_t)(id * 2048u + (unsigned)(c * 128 + p * 16))); }
                float y[8];
#pragma unroll
                for (int j = 0; j < 8; ++j) y[j] = 0.f;
#pragma unroll
                for (int i = 0; i < 16; ++i) {
#if G3_VF16
                    fma_mix_lo(y[0], w[i], v[i].x); fma_mix_hi(y[1], w[i], v[i].x); fma_mix_lo(y[2], w[i], v[i].y); fma_mix_hi(y[3], w[i], v[i].y);
                    fma_mix_lo(y[4], w[i], v[i].z); fma_mix_hi(y[5], w[i], v[i].z); fma_mix_lo(y[6], w[i], v[i].w); fma_mix_hi(y[7], w[i], v[i].w);
#else
                    y[0] = fmaf(w[i], bflo(v[i].x), y[0]); y[1] = fmaf(w[i], bfhi(v[i].x), y[1]); y[2] = fmaf(w[i], bflo(v[i].y), y[2]); y[3] = fmaf(w[i], bfhi(v[i].y), y[3]);
                    y[4] = fmaf(w[i], bflo(v[i].z), y[4]); y[5] = fmaf(w[i], bfhi(v[i].z), y[5]); y[6] = fmaf(w[i], bflo(v[i].w), y[6]); y[7] = fmaf(w[i], bfhi(v[i].w), y[7]);
#endif
                }
                float z[4];
#pragma unroll
                for (int j = 0; j < 4; ++j) { z[j] = swap32_add(y[j], y[j + 4]); z[j] = xor16_add(z[j]); z[j] = dpp_add<0x128>(z[j]); }
                if ((lane & 0x18) == 0) {
                    float* hp = H + (size_t)(t0 + tt) * DM + 64 * c + 8 * p + 4 * (lane >> 5);
                    f32x4 h0 = *(const f32x4*)hp;
                    h0 += (f32x4){z[0], z[1], z[2], z[3]};
                    *(f32x4*)hp = h0;
                }
            }
        }
    }
    __builtin_amdgcn_fence(__ATOMIC_SEQ_CST, "agent");
    asm volatile("s_waitcnt vmcnt(0)" ::: "memory");
    for (int tt = 0; tt < 16; ++tt) {
        const int t = t0 + tt;
        float* hp = H + (size_t)t * DM + 8 * lane;
        f32x4 h0 = *(const f32x4*)hp, h1 = *(const f32x4*)(hp + 4), h2 = *(const f32x4*)(hp + 512), h3 = *(const f32x4*)(hp + 516);
        float ss = (h0[0] * h0[0] + h0[1] * h0[1]) + (h0[2] * h0[2] + h0[3] * h0[3]) + (h1[0] * h1[0] + h1[1] * h1[1]) + (h1[2] * h1[2] + h1[3] * h1[3])
                 + (h2[0] * h2[0] + h2[1] * h2[1]) + (h2[2] * h2[2] + h2[3] * h2[3]) + (h3[0] * h3[0] + h3[1] * h3[1]) + (h3[2] * h3[2] + h3[3] * h3[3]);
        ss = wave_sum(ss);
        if (last) {
            const float rs = rsqrtf(ss * (1.0f / 1024.0f) + RMS_EPS);
            const f32x4 g0 = *(const f32x4*)(final_g + 8 * lane), g1 = *(const f32x4*)(final_g + 8 * lane + 4), g2 = *(const f32x4*)(final_g + 512 + 8 * lane), g3 = *(const f32x4*)(final_g + 516 + 8 * lane);
            h0 = h0 * rs * g0; h1 = h1 * rs * g1; h2 = h2 * rs * g2; h3 = h3 * rs * g3;
            *(f32x4*)hp = h0; *(f32x4*)(hp + 4) = h1; *(f32x4*)(hp + 512) = h2; *(f32x4*)(hp + 516) = h3;
        } else {
            bf16_t* bp = HB + (size_t)t * DM + 8 * lane;
            u32x4 w; w.x = cvtpk(h0[0], h0[1]); w.y = cvtpk(h0[2], h0[3]); w.z = cvtpk(h1[0], h1[1]); w.w = cvtpk(h1[2], h1[3]);
            *(u32x4*)bp = w;
            w.x = cvtpk(h2[0], h2[1]); w.y = cvtpk(h2[2], h2[3]); w.z = cvtpk(h3[0], h3[1]); w.w = cvtpk(h3[2], h3[3]);
            *(u32x4*)(bp + 512) = w;
            if (lane == 0) ssq1[t] = ss;
        }
    }
}

typedef float f32x2v __attribute__((ext_vector_type(2)));
constexpr float FP8_MAX = 448.0f;

__device__ __forceinline__ void quant_row_fp8(const float* __restrict__ src, const float* __restrict__ colscale, unsigned char* __restrict__ dst, float* __restrict__ scale_out, int lane) {
    f32x4 v[4]; float am = 0.f;
#pragma unroll
    for (int j = 0; j < 4; ++j) {
        v[j] = *(const f32x4*)(src + 4 * (lane + 64 * j));
        if (colscale) v[j] = v[j] * *(const f32x4*)(colscale + 4 * (lane + 64 * j));
        am = fmaxf(am, fmaxf(fmaxf(fabsf(v[j][0]), fabsf(v[j][1])), fmaxf(fabsf(v[j][2]), fabsf(v[j][3]))));
    }
#pragma unroll
    for (int o = 1; o < 64; o <<= 1) am = fmaxf(am, __shfl_xor(am, o));
    const float inv = am > 0.f ? FP8_MAX / am : 1.0f;
#pragma unroll
    for (int j = 0; j < 4; ++j) {
        int w = 0;
        w = __builtin_amdgcn_cvt_pk_fp8_f32(v[j][0] * inv, v[j][1] * inv, w, false);
        w = __builtin_amdgcn_cvt_pk_fp8_f32(v[j][2] * inv, v[j][3] * inv, w, true);
        *(int*)(dst + 4 * (lane + 64 * j)) = w;
    }
    if (lane == 0) *scale_out = am > 0.f ? am / FP8_MAX : 1.0f;
}

__device__ __forceinline__ float dot2v(bf16x2v_t a, unsigned b, float acc) { return __builtin_amdgcn_fdot2_f32_bf16(a, __builtin_bit_cast(bf16x2v_t, b), acc, false); }
__device__ __forceinline__ void g4_issue(u32x4 (&buf)[16], const unsigned char* __restrict__ tab, const LAS unsigned short* idl, int it, int g, int p) {
    const int tt = it & 15, c = it >> 4;
    const u32x4 i0 = *(const LAS u32x4*)(idl + tt * 128 + g * 16), i1 = *(const LAS u32x4*)(idl + tt * 128 + g * 16 + 8);
    const unsigned idw[8] = {i0.x, i0.y, i0.z, i0.w, i1.x, i1.y, i1.z, i1.w};
    const unsigned char* base = tab + (c * 128 + p * 16);
#pragma unroll
    for (int i = 0; i < 16; ++i) { const unsigned id = (i & 1) ? (idw[i >> 1] >> 16) : (idw[i >> 1] & 0xffffu);
        buf[i] = *(const u32x4*)(base + (size_t)(id * 1024u)); }
}
#ifndef TAB_SLICED
#define TAB_SLICED 1
#endif
#ifndef G4_NT
#define G4_NT 0
#endif
#ifndef G5_STREAM_NT
#define G5_STREAM_NT 0
#endif
struct G4Ids { u32x4 i0, i1; };
__device__ __forceinline__ void g4_ids(G4Ids& d, const LAS unsigned short* idl, int it, int g) {
    const int tt = it & 15;
    d.i0 = *(const LAS u32x4*)(idl + tt * 128 + g * 16); d.i1 = *(const LAS u32x4*)(idl + tt * 128 + g * 16 + 8);
}
__device__ __forceinline__ void g4_rows(u32x4 (&buf)[16], const unsigned char* __restrict__ tab, const G4Ids& d, int it, int p) {
    const int c = it >> 4;
    const unsigned idw[8] = {d.i0.x, d.i0.y, d.i0.z, d.i0.w, d.i1.x, d.i1.y, d.i1.z, d.i1.w};
    const unsigned char* base = TAB_SLICED ? tab + ((size_t)c * (N_EXP * 128) + p * 16) : tab + (c * 128 + p * 16);
#pragma unroll
    for (int i = 0; i < 16; ++i) { const unsigned id = (i & 1) ? (idw[i >> 1] >> 16) : (idw[i >> 1] & 0xffffu);
        buf[i] = *(const u32x4*)(base + (size_t)(id * (TAB_SLICED ? 128u : 1024u))); }
}
__device__ __forceinline__ void g4_xload(u32x4 (&x)[2], const bf16_t* __restrict__ HB, int t0, int it, int p) {
    const bf16_t* xp = HB + (size_t)(t0 + (it & 15)) * DM + 128 * (it >> 4) + 16 * p;
    x[0] = *(const u32x4*)xp; x[1] = *(const u32x4*)(xp + 8);
}
#define G4_CVT(wd, hi_) __builtin_amdgcn_cvt_scalef32_pk_bf16_fp8((wd), 1.0f, (hi_))
__device__ __forceinline__ void g4_ucompute(const u32x4 (&u)[16], const u32x4 (&x)[2], LAS float* ap, int p) {
    const unsigned xw[8] = {x[0].x, x[0].y, x[0].z, x[0].w, x[1].x, x[1].y, x[1].z, x[1].w};
    float a[16];
#pragma unroll
    for (int i0 = 0; i0 < 16; i0 += 8) {
        float s_[8];
#pragma unroll
        for (int e = 0; e < 8; ++e) s_[e] = 0.f;
#pragma unroll
        for (int q = 0; q < 4; ++q) {
#pragma unroll
            for (int e = 0; e < 8; ++e) { const unsigned wd = (q == 0) ? u[i0 + e].x : (q == 1) ? u[i0 + e].y : (q == 2) ? u[i0 + e].z : u[i0 + e].w;
                s_[e] = dot2v(G4_CVT(wd, false), xw[2 * q], s_[e]); }
#pragma unroll
            for (int e = 0; e < 8; ++e) { const unsigned wd = (q == 0) ? u[i0 + e].x : (q == 1) ? u[i0 + e].y : (q == 2) ? u[i0 + e].z : u[i0 + e].w;
                s_[e] = dot2v(G4_CVT(wd, true), xw[2 * q + 1], s_[e]); }
        }
#pragma unroll
        for (int e = 0; e < 8; ++e) s_[e] = dpp_add<0xB1>(s_[e]);
#pragma unroll
        for (int e = 0; e < 8; ++e) s_[e] = dpp_add<0x4E>(s_[e]);
#pragma unroll
        for (int e = 0; e < 8; ++e) a[i0 + e] = dpp_add<0x141>(s_[e]);
    }
    if (p == 0) {
#pragma unroll
        for (int i = 0; i < 16; ++i) (void)__hip_atomic_fetch_add(ap + i, a[i], __ATOMIC_RELAXED, __HIP_MEMORY_SCOPE_WORKGROUP);
    }
}
__device__ __forceinline__ void g4_vcompute(const u32x4 (&v)[16], const LAS float* wsrc, float* __restrict__ hp, int lane, int dry) {
    const LAS f32x4* wp = (const LAS f32x4*)wsrc;
    const f32x4 w0 = wp[0], w1 = wp[1], w2 = wp[2], w3 = wp[3];
    const float w[16] = {w0[0], w0[1], w0[2], w0[3], w1[0], w1[1], w1[2], w1[3], w2[0], w2[1], w2[2], w2[3], w3[0], w3[1], w3[2], w3[3]};
    float yy[16];
#pragma unroll
    for (int j = 0; j < 16; ++j) yy[j] = 0.f;
#pragma unroll
    for (int i = 0; i < 16; ++i) {
        const unsigned vw[4] = {v[i].x, v[i].y, v[i].z, v[i].w};
#pragma unroll
        for (int q = 0; q < 4; ++q) {
            const f32x2v lo = __builtin_amdgcn_cvt_pk_f32_fp8((int)vw[q], false), hi = __builtin_amdgcn_cvt_pk_f32_fp8((int)vw[q], true);
            yy[4 * q] = fmaf(w[i], lo.x, yy[4 * q]); yy[4 * q + 1] = fmaf(w[i], lo.y, yy[4 * q + 1]); yy[4 * q + 2] = fmaf(w[i], hi.x, yy[4 * q + 2]); yy[4 * q + 3] = fmaf(w[i], hi.y, yy[4 * q + 3]);
        }
    }
    f32x2v y[8];
#pragma unroll
    for (int j = 0; j < 8; ++j) y[j] = (f32x2v){yy[2 * j], yy[2 * j + 1]};
    float z[8];
#pragma unroll
    for (int j = 0; j < 4; ++j) { z[2 * j] = swap32_add(y[j].x, y[j + 4].x); z[2 * j + 1] = swap32_add(y[j].y, y[j + 4].y); }
#pragma unroll
    for (int j = 0; j < 8; ++j) { z[j] = xor16_add(z[j]); z[j] = dpp_add<0x128>(z[j]); }
    if ((lane & 0x18) == 0 && !(dry && z[0] * z[0] >= 0.f)) {
        f32x4 h0 = *(const f32x4*)hp, h1 = *(const f32x4*)(hp + 4);
        h0 += (f32x4){z[0], z[1], z[2], z[3]}; h1 += (f32x4){z[4], z[5], z[6], z[7]};
        *(f32x4*)hp = h0; *(f32x4*)(hp + 4) = h1;
    }
}

__device__ __forceinline__ void gather4_phase(float* __restrict__ H, bf16_t* __restrict__ HB, const float* __restrict__ ssq2p, float* __restrict__ ssq1,
                                              const unsigned char* __restrict__ U8, const unsigned char* __restrict__ V8, const float* __restrict__ su, const float* __restrict__ sv,
                                              const int* __restrict__ ids, const float* __restrict__ gw,
                                              const float* __restrict__ final_g, int last, LAS unsigned char* lds, int wave, int gwave, int lane, int dry = 0, int idmask = 0xffff) {
    LAS unsigned char* wl = lds + wave * G2_WAVE_LDS;
    LAS unsigned short* idl = (LAS unsigned short*)wl;
    LAS float* al = (LAS float*)(wl + 4096);
    const int t0 = __builtin_amdgcn_readfirstlane(gwave * 16);
    for (int tt = 0; tt < 16; ++tt) {
        idl[tt * 128 + lane] = (unsigned short)(ids[(size_t)(t0 + tt) * 128 + lane] & idmask);
        idl[tt * 128 + 64 + lane] = (unsigned short)(ids[(size_t)(t0 + tt) * 128 + 64 + lane] & idmask);
    }
    for (int e = lane; e < 2048; e += 64) al[e] = 0.f;
    asm volatile("s_waitcnt lgkmcnt(0)" ::: "memory");
    const int g = lane >> 3, p = lane & 7;
    if (!(dry & 2)) {
        u32x4 uA[16], uB[16], xA[2], xB[2];
        g4_issue(uA, U8, idl, 0, g, p);
        g4_xload(xA, HB, t0, 0, p);
        for (int it = 0; it < 128; it += 2) {
            g4_issue(uB, U8, idl, it + 1, g, p); g4_xload(xB, HB, t0, it + 1, p);
            g4_ucompute(uA, xA, al + (it & 15) * 128 + g * 16, p);
            if (it + 2 < 128) { g4_issue(uA, U8, idl, it + 2, g, p); g4_xload(xA, HB, t0, it + 2, p); }
            g4_ucompute(uB, xB, al + ((it + 1) & 15) * 128 + g * 16, p);
        }
    }
    asm volatile("s_waitcnt lgkmcnt(0)" ::: "memory");
    for (int n = 0; n < 32; ++n) {
        const int tt = n >> 1, k = lane + 64 * (n & 1);
        const float rs2 = rsqrtf(ssq16(ssq2p, t0 + tt) * (1.0f / 1024.0f) + RMS_EPS);
        const int id = idl[tt * 128 + k];
        const float a = al[tt * 128 + k] * rs2 * su[id];
        al[tt * 128 + k] = gw[(size_t)(t0 + tt) * 128 + k] * gelu_erf(a) * sv[id];
    }
    asm volatile("s_waitcnt lgkmcnt(0)" ::: "memory");
    if (!(dry & 4)) {
        u32x4 vA[16], vB[16];
        g4_issue(vA, V8, idl, 0, g, p);
        for (int it = 0; it < 128; it += 2) {
            g4_issue(vB, V8, idl, it + 1, g, p);
            g4_vcompute(vA, al + (it & 15) * 128 + g * 16, H + (size_t)(t0 + (it & 15)) * DM + 128 * (it >> 4) + 16 * p + 8 * (lane >> 5), lane, dry);
            if (it + 2 < 128) g4_issue(vA, V8, idl, it + 2, g, p);
            g4_vcompute(vB, al + ((it + 1) & 15) * 128 + g * 16, H + (size_t)(t0 + ((it + 1) & 15)) * DM + 128 * ((it + 1) >> 4) + 16 * p + 8 * (lane >> 5), lane, dry);
        }
    }
    if (dry) return;
    __builtin_amdgcn_fence(__ATOMIC_SEQ_CST, "agent");
    asm volatile("s_waitcnt vmcnt(0)" ::: "memory");
    for (int tt = 0; tt < 16; ++tt) {
        const int t = t0 + tt;
        float* hp = H + (size_t)t * DM + 8 * lane;
        f32x4 h0 = *(const f32x4*)hp, h1 = *(const f32x4*)(hp + 4), h2 = *(const f32x4*)(hp + 512), h3 = *(const f32x4*)(hp + 516);
        float ss = (h0[0] * h0[0] + h0[1] * h0[1]) + (h0[2] * h0[2] + h0[3] * h0[3]) + (h1[0] * h1[0] + h1[1] * h1[1]) + (h1[2] * h1[2] + h1[3] * h1[3])
                 + (h2[0] * h2[0] + h2[1] * h2[1]) + (h2[2] * h2[2] + h2[3] * h2[3]) + (h3[0] * h3[0] + h3[1] * h3[1]) + (h3[2] * h3[2] + h3[3] * h3[3]);
        ss = wave_sum(ss);
        if (last) {
            const float rs = rsqrtf(ss * (1.0f / 1024.0f) + RMS_EPS);
            const f32x4 g0 = *(const f32x4*)(final_g + 8 * lane), g1 = *(const f32x4*)(final_g + 8 * lane + 4), g2 = *(const f32x4*)(final_g + 512 + 8 * lane), g3 = *(const f32x4*)(final_g + 516 + 8 * lane);
            h0 = h0 * rs * g0; h1 = h1 * rs * g1; h2 = h2 * rs * g2; h3 = h3 * rs * g3;
            *(f32x4*)hp = h0; *(f32x4*)(hp + 4) = h1; *(f32x4*)(hp + 512) = h2; *(f32x4*)(hp + 516) = h3;
        } else {
            bf16_t* bp = HB + (size_t)t * DM + 8 * lane;
            u32x4 w; w.x = cvtpk(h0[0], h0[1]); w.y = cvtpk(h0[2], h0[3]); w.z = cvtpk(h1[0], h1[1]); w.w = cvtpk(h1[2], h1[3]);
            *(u32x4*)bp = w;
            w.x = cvtpk(h2[0], h2[1]); w.y = cvtpk(h2[2], h2[3]); w.z = cvtpk(h3[0], h3[1]); w.w = cvtpk(h3[2], h3[3]);
            *(u32x4*)(bp + 512) = w;
            if (lane == 0) ssq1[t] = ss;
        }
    }
}

__device__ __forceinline__ void quant_row_i8(const float* __restrict__ src, const float* __restrict__ colscale, unsigned char* __restrict__ dst, float* __restrict__ scale_out, int bias, int lane) {
    f32x4 v[4]; float am = 0.f;
#pragma unroll
    for (int j = 0; j < 4; ++j) {
        v[j] = *(const f32x4*)(src + 4 * (lane + 64 * j));
        if (colscale) v[j] = v[j] * *(const f32x4*)(colscale + 4 * (lane + 64 * j));
        am = fmaxf(am, fmaxf(fmaxf(fabsf(v[j][0]), fabsf(v[j][1])), fmaxf(fabsf(v[j][2]), fabsf(v[j][3]))));
    }
#pragma unroll
    for (int o = 1; o < 64; o <<= 1) am = fmaxf(am, __shfl_xor(am, o));
    const float inv = am > 0.f ? 127.0f / am : 0.f;
#pragma unroll
    for (int j = 0; j < 4; ++j) {
        const int q0 = (int)rintf(v[j][0] * inv) + bias, q1 = (int)rintf(v[j][1] * inv) + bias, q2 = (int)rintf(v[j][2] * inv) + bias, q3 = (int)rintf(v[j][3] * inv) + bias;
        *(unsigned*)(dst + 4 * (lane + 64 * j)) = (unsigned)(q0 & 255) | ((unsigned)(q1 & 255) << 8) | ((unsigned)(q2 & 255) << 16) | ((unsigned)(q3 & 255) << 24);
    }
    if (lane == 0) *scale_out = am > 0.f ? am / 127.0f : 0.f;
}
__device__ __forceinline__ void quant_row_load(f32x4 (&v)[4], const float* __restrict__ src, int lane) {
#pragma unroll
    for (int j = 0; j < 4; ++j) v[j] = *(const f32x4*)(src + 4 * (lane + 64 * j));
}
__device__ __forceinline__ void quant_row_finish(f32x4 (&v)[4], const float* __restrict__ colscale, unsigned char* __restrict__ dst, float* __restrict__ scale_out, int bias, int lane) {
    float am = 0.f;
#pragma unroll
    for (int j = 0; j < 4; ++j) {
        if (colscale) v[j] = v[j] * *(const f32x4*)(colscale + 4 * (lane + 64 * j));
        am = fmaxf(am, fmaxf(fmaxf(fabsf(v[j][0]), fabsf(v[j][1])), fmaxf(fabsf(v[j][2]), fabsf(v[j][3]))));
    }
#pragma unroll
    for (int o = 1; o < 64; o <<= 1) am = fmaxf(am, __shfl_xor(am, o));
    const float inv = am > 0.f ? 127.0f / am : 0.f;
#pragma unroll
    for (int j = 0; j < 4; ++j) {
        const int q0 = (int)rintf(v[j][0] * inv) + bias, q1 = (int)rintf(v[j][1] * inv) + bias, q2 = (int)rintf(v[j][2] * inv) + bias, q3 = (int)rintf(v[j][3] * inv) + bias;
        const int col = 4 * (lane + 64 * j);
        unsigned char* d_ = TAB_SLICED ? dst + (size_t)(col >> 7) * (N_EXP * 128) + (col & 127) : dst + col;
        *(unsigned*)d_ = (unsigned)(q0 & 255) | ((unsigned)(q1 & 255) << 8) | ((unsigned)(q2 & 255) << 16) | ((unsigned)(q3 & 255) << 24);
    }
    if (lane == 0) *scale_out = am > 0.f ? am / 127.0f : 0.f;
}
template <int CTRL> __device__ __forceinline__ int dpp_addi(int v) { return v + __builtin_amdgcn_update_dpp(0, v, CTRL, 0xF, 0xF, true); }
__device__ __forceinline__ void g5_ucompute(const u32x4 (&u)[16], const u32x4& x, LAS int* ap, int p, int noatom = 0) {
    int a[16];
#pragma unroll
    for (int i = 0; i < 16; ++i) {
        int s_ = __builtin_amdgcn_sdot4((int)u[i].x, (int)x.x, 0, false);
        s_ = __builtin_amdgcn_sdot4((int)u[i].y, (int)x.y, s_, false);
        s_ = __builtin_amdgcn_sdot4((int)u[i].z, (int)x.z, s_, false);
        s_ = __builtin_amdgcn_sdot4((int)u[i].w, (int)x.w, s_, false);
        a[i] = s_;
    }
#pragma unroll
    for (int i = 0; i < 16; ++i) a[i] = dpp_addi<0xB1>(a[i]);
#pragma unroll
    for (int i = 0; i < 16; ++i) a[i] = dpp_addi<0x4E>(a[i]);
    if (PROBE_NOATOM && noatom) { int t_ = 0;
#pragma unroll
        for (int i = 0; i < 16; ++i) t_ ^= a[i];
        if (t_ == 0x7fffffff) ap[0] = t_; return; }
    if ((p & 3) == 0) {
#pragma unroll
        for (int i = 0; i < 16; ++i) (void)__hip_atomic_fetch_add(ap + i, a[i], __ATOMIC_RELAXED, __HIP_MEMORY_SCOPE_WORKGROUP);
    }
}
__device__ __forceinline__ void g5_vcompute(const u32x4 (&v)[16], const LAS float* wsrc, float* __restrict__ hp, int lane, int dry) {
    const LAS f32x4* wp = (const LAS f32x4*)wsrc;
    const f32x4 w0 = wp[0], w1 = wp[1], w2 = wp[2], w3 = wp[3];
    const float w[16] = {w0[0], w0[1], w0[2], w0[3], w1[0], w1[1], w1[2], w1[3], w2[0], w2[1], w2[2], w2[3], w3[0], w3[1], w3[2], w3[3]};
    float wsum = ((w[0] + w[1]) + (w[2] + w[3])) + ((w[4] + w[5]) + (w[6] + w[7])) + (((w[8] + w[9]) + (w[10] + w[11])) + ((w[12] + w[13]) + (w[14] + w[15])));
    float yy[16];
    const float y0 = -1152.0f * wsum;
#pragma unroll
    for (int j = 0; j < 16; ++j) yy[j] = y0;
#pragma unroll
    for (int i = 0; i < 16; ++i) {
        const unsigned vw[4] = {v[i].x, v[i].y, v[i].z, v[i].w};
#pragma unroll
        for (int q = 0; q < 4; ++q) {
            const unsigned lo = __builtin_amdgcn_perm(vw[q], 0x64646464u, 0x00050004u), hi = __builtin_amdgcn_perm(vw[q], 0x64646464u, 0x00070006u);
            fma_mix_lo(yy[4 * q], w[i], lo); fma_mix_hi(yy[4 * q + 1], w[i], lo); fma_mix_lo(yy[4 * q + 2], w[i], hi); fma_mix_hi(yy[4 * q + 3], w[i], hi);
        }
    }
    float z[8];
#pragma unroll
    for (int j = 0; j < 8; ++j) z[j] = swap32_add(yy[j], yy[j + 8]);
#pragma unroll
    for (int j = 0; j < 8; ++j) { z[j] = xor16_add(z[j]); z[j] = dpp_add<0x128>(z[j]); }
    if ((lane & 0x18) == 0 && !(dry && z[0] * z[0] >= 0.f)) {
        f32x4 h0 = *(const f32x4*)hp, h1 = *(const f32x4*)(hp + 4);
        h0 += (f32x4){z[0], z[1], z[2], z[3]}; h1 += (f32x4){z[4], z[5], z[6], z[7]};
        *(f32x4*)hp = h0; *(f32x4*)(hp + 4) = h1;
    }
}
#ifndef G5_VDOT4
#define G5_VDOT4 1
#endif
__device__ __forceinline__ void g6_vcompute(const u32x4 (&v)[16], const LAS unsigned char* w8src, float sw, float* __restrict__ hp, int lane, int dry, bf16_t* hbp, LAS float* sspart, const u32x4 hb_pre) {
    const u32x4 w4 = *(const LAS u32x4*)w8src;
    const unsigned ww[4] = {w4.x, w4.y, w4.z, w4.w};
    int yy[16];
#pragma unroll
    for (int j = 0; j < 16; ++j) yy[j] = 0;
#pragma unroll
    for (int a = 0; a < 4; ++a) {
#pragma unroll
        for (int q = 0; q < 4; ++q) {
            const unsigned r0 = (q == 0) ? v[4 * a].x : (q == 1) ? v[4 * a].y : (q == 2) ? v[4 * a].z : v[4 * a].w;
            const unsigned r1 = (q == 0) ? v[4 * a + 1].x : (q == 1) ? v[4 * a + 1].y : (q == 2) ? v[4 * a + 1].z : v[4 * a + 1].w;
            const unsigned r2 = (q == 0) ? v[4 * a + 2].x : (q == 1) ? v[4 * a + 2].y : (q == 2) ? v[4 * a + 2].z : v[4 * a + 2].w;
            const unsigned r3 = (q == 0) ? v[4 * a + 3].x : (q == 1) ? v[4 * a + 3].y : (q == 2) ? v[4 * a + 3].z : v[4 * a + 3].w;
            const unsigned lo01 = __builtin_amdgcn_perm(r1, r0, 0x05010400u), hi01 = __builtin_amdgcn_perm(r1, r0, 0x07030602u);
            const unsigned lo23 = __builtin_amdgcn_perm(r3, r2, 0x05010400u), hi23 = __builtin_amdgcn_perm(r3, r2, 0x07030602u);
            const unsigned c0 = __builtin_amdgcn_perm(lo23, lo01, 0x05040100u), c1 = __builtin_amdgcn_perm(lo23, lo01, 0x07060302u);
            const unsigned c2 = __builtin_amdgcn_perm(hi23, hi01, 0x05040100u), c3 = __builtin_amdgcn_perm(hi23, hi01, 0x07060302u);
            yy[4 * q] = __builtin_amdgcn_sdot4((int)c0, (int)ww[a], yy[4 * q], false); yy[4 * q + 1] = __builtin_amdgcn_sdot4((int)c1, (int)ww[a], yy[4 * q + 1], false);
            yy[4 * q + 2] = __builtin_amdgcn_sdot4((int)c2, (int)ww[a], yy[4 * q + 2], false); yy[4 * q + 3] = __builtin_amdgcn_sdot4((int)c3, (int)ww[a], yy[4 * q + 3], false);
        }
    }
    int z[8];
#pragma unroll
    for (int j = 0; j < 8; ++j) { const auto r = __builtin_amdgcn_permlane32_swap((unsigned)yy[j], (unsigned)yy[j + 8], false, false); z[j] = (int)(r[0] + r[1]); }
#pragma unroll
    for (int j = 0; j < 8; ++j) { z[j] += __builtin_amdgcn_ds_swizzle(z[j], 0x401F); z[j] = dpp_addi<0x128>(z[j]); }
    float ss = 0.f;
    if ((lane & 0x18) == 0 && !(dry && z[0] == 0x7fffffff)) {
#if RES16
        const u32x4 hb_ = hb_pre;
        f32x4 h0 = (f32x4){bflo(hb_.x), bfhi(hb_.x), bflo(hb_.y), bfhi(hb_.y)}, h1 = (f32x4){bflo(hb_.z), bfhi(hb_.z), bflo(hb_.w), bfhi(hb_.w)};
#else
        f32x4 h0 = *(const f32x4*)hp, h1 = *(const f32x4*)(hp + 4);
#endif
        h0 += (f32x4){(float)z[0] * sw, (float)z[1] * sw, (float)z[2] * sw, (float)z[3] * sw}; h1 += (f32x4){(float)z[4] * sw, (float)z[5] * sw, (float)z[6] * sw, (float)z[7] * sw};
        if (!RES16 || !hbp) { *(f32x4*)hp = h0; *(f32x4*)(hp + 4) = h1; }
        if (hbp) {
            u32x4 w; w.x = cvtpk(h0[0], h0[1]); w.y = cvtpk(h0[2], h0[3]); w.z = cvtpk(h1[0], h1[1]); w.w = cvtpk(h1[2], h1[3]);
            if (G5_STREAM_NT) __builtin_nontemporal_store(w, (u32x4*)hbp); else *(u32x4*)hbp = w;
            ss = (h0[0] * h0[0] + h0[1] * h0[1]) + (h0[2] * h0[2] + h0[3] * h0[3]) + (h1[0] * h1[0] + h1[1] * h1[1]) + (h1[2] * h1[2] + h1[3] * h1[3]);
        }
    }
    if (hbp) {
        ss = dpp_add<0xB1>(ss); ss = dpp_add<0x4E>(ss); ss = dpp_add<0x141>(ss);
        if ((lane & 31) == 0) sspart[lane >> 5] = ss;
    }
}
__device__ __forceinline__ void g5_xload(u32x4& x, const unsigned char* __restrict__ XQ, int t0, int it, int p) {
    x = G5_STREAM_NT ? __builtin_nontemporal_load((const u32x4*)(XQ + (size_t)(t0 + (it & 15)) * DM + 128 * (it >> 4) + 16 * p)) : *(const u32x4*)(XQ + (size_t)(t0 + (it & 15)) * DM + 128 * (it >> 4) + 16 * p);
}

__device__ __forceinline__ void gather5_phase(float* __restrict__ H, bf16_t* __restrict__ HB, const float* __restrict__ ssq2p, float* __restrict__ ssq1,
                                              const unsigned char* __restrict__ U8, const unsigned char* __restrict__ V8, const float* __restrict__ su, const float* __restrict__ sv,
                                              unsigned char* __restrict__ XQ, const int* __restrict__ ids, const float* __restrict__ gw,
                                              const float* __restrict__ final_g, int last, LAS unsigned char* lds, int wave, int gwave, int lane, int dry = 0, int idmask = 0xffff, unsigned char* A8 = nullptr, float* SA = nullptr, const float* SXg = nullptr) {
    LAS unsigned char* wl = lds + wave * G2_WAVE_LDS;
    LAS unsigned short* idl = (LAS unsigned short*)wl;
    LAS float* al = (LAS float*)(wl + 4096);
    LAS float* sxl = (LAS float*)(wl + 4096 + 8192);
    const int t0 = __builtin_amdgcn_readfirstlane(gwave * 16);
    for (int tt = 0; tt < 16; ++tt) {
        idl[tt * 128 + lane] = (unsigned short)(ids[(size_t)(t0 + tt) * 128 + lane] & idmask);
        idl[tt * 128 + 64 + lane] = (unsigned short)(ids[(size_t)(t0 + tt) * 128 + 64 + lane] & idmask);
    }
    for (int e = lane; e < 512; e += 64) ((LAS u32x4*)al)[e] = (u32x4){0u, 0u, 0u, 0u};
    if (SXg) {
        if (lane < 16) sxl[lane] = SXg[t0 + lane];
#pragma unroll
        for (int i = 0; i < 16; ++i) { const u32x4 t_ = *(const u32x4*)(XQ + (size_t)(t0 + i) * DM + 16 * lane); asm volatile("" :: "v"(t_)); }
    }
    else for (int tt = 0; tt < 16; ++tt) {
        const bf16_t* xr = HB + (size_t)(t0 + tt) * DM + 8 * lane;
        const u32x4 xa = *(const u32x4*)xr, xb = *(const u32x4*)(xr + 512);
        const float f[16] = {bflo(xa.x), bfhi(xa.x), bflo(xa.y), bfhi(xa.y), bflo(xa.z), bfhi(xa.z), bflo(xa.w), bfhi(xa.w),
                             bflo(xb.x), bfhi(xb.x), bflo(xb.y), bfhi(xb.y), bflo(xb.z), bfhi(xb.z), bflo(xb.w), bfhi(xb.w)};
        float am = 0.f;
#pragma unroll
        for (int j = 0; j < 16; ++j) am = fmaxf(am, fabsf(f[j]));
#pragma unroll
        for (int o = 1; o < 64; o <<= 1) am = fmaxf(am, __shfl_xor(am, o));
        const float inv = am > 0.f ? 127.0f / am : 0.f;
        unsigned wq[4];
#pragma unroll
        for (int j = 0; j < 4; ++j) {
            const int q0 = (int)rintf(f[4 * j] * inv), q1 = (int)rintf(f[4 * j + 1] * inv), q2 = (int)rintf(f[4 * j + 2] * inv), q3 = (int)rintf(f[4 * j + 3] * inv);
            wq[j] = (unsigned)(q0 & 255) | ((unsigned)(q1 & 255) << 8) | ((unsigned)(q2 & 255) << 16) | ((unsigned)(q3 & 255) << 24);
        }
        unsigned char* xq = XQ + (size_t)(t0 + tt) * DM + 8 * lane;
        *(u32x2*)xq = (u32x2){wq[0], wq[1]}; *(u32x2*)(xq + 512) = (u32x2){wq[2], wq[3]};
        if (lane == 0) sxl[tt] = am > 0.f ? am / 127.0f : 0.f;
    }
    asm volatile("s_waitcnt vmcnt(0) lgkmcnt(0)" ::: "memory");
    const int g = lane >> 3, p = lane & 7;
    if (!(dry & 2)) {
        u32x4 uA[16], uB[16], xA, xB;
        G4Ids dA, dB;
        g4_ids(dA, idl, 0, g); g4_ids(dB, idl, 1, g);
        g4_rows(uA, U8, dA, 0, p); g5_xload(xA, XQ, t0, 0, p);
        for (int it = 0; it < 128; it += 2) {
            g4_rows(uB, U8, dB, it + 1, p); g5_xload(xB, XQ, t0, it + 1, p);
            g4_ids(dA, idl, (it + 2) & 127, g);
            g5_ucompute(uA, xA, (LAS int*)al + (it & 15) * 128 + g * 16, p, dry);
            if (it + 2 < 128) { g4_rows(uA, U8, dA, it + 2, p); g5_xload(xA, XQ, t0, it + 2, p); }
            g4_ids(dB, idl, (it + 3) & 127, g);
            g5_ucompute(uB, xB, (LAS int*)al + ((it + 1) & 15) * 128 + g * 16, p, dry);
        }
    }
    asm volatile("s_waitcnt lgkmcnt(0)" ::: "memory");
#if G5_VDOT4
    LAS unsigned char* w8l = (LAS unsigned char*)al;
    LAS float* swl = sxl + 16;
    for (int tt = 0; tt < 16; ++tt) {
        const float rs2 = rsqrtf(ssq16(ssq2p, t0 + tt) * (1.0f / 1024.0f) + RMS_EPS) * sxl[tt];
        const int id0 = idl[tt * 128 + lane], id1 = idl[tt * 128 + 64 + lane];
        const float a0 = (float)((LAS int*)al)[tt * 128 + lane] * rs2 * su[id0], a1 = (float)((LAS int*)al)[tt * 128 + 64 + lane] * rs2 * su[id1];
        const float w0 = gw[(size_t)(t0 + tt) * 128 + lane] * gelu_erf(a0) * sv[id0], w1 = gw[(size_t)(t0 + tt) * 128 + 64 + lane] * gelu_erf(a1) * sv[id1];
        float am = fmaxf(fabsf(w0), fabsf(w1));
#pragma unroll
        for (int o = 1; o < 64; o <<= 1) am = fmaxf(am, __shfl_xor(am, o));
        const float inv = am > 0.f ? 127.0f / am : 0.f;
        asm volatile("s_waitcnt lgkmcnt(0)" ::: "memory");
        w8l[tt * 128 + lane] = (unsigned char)((int)rintf(w0 * inv) & 255); w8l[tt * 128 + 64 + lane] = (unsigned char)((int)rintf(w1 * inv) & 255);
        if (lane == 0) swl[tt] = am > 0.f ? am / 127.0f : 0.f;
    }
    asm volatile("s_waitcnt lgkmcnt(0)" ::: "memory");
    const bool fold = (RES16 || !last) && !dry;
    LAS float* ssp = al + 1024;
    if (!(dry & 4)) {
        u32x4 vA[16], vB[16];
        u32x4 hA = {0u, 0u, 0u, 0u}, hB = {0u, 0u, 0u, 0u};
        const bool wlane = (lane & 0x18) == 0;
#define G6_OFF(i_) ((size_t)(t0 + ((i_) & 15)) * DM + 128 * ((i_) >> 4) + 16 * p + 8 * (lane >> 5))
        G4Ids eA, eB;
        g4_ids(eA, idl, 0, g); g4_ids(eB, idl, 1, g);
        g4_rows(vA, V8, eA, 0, p); if (wlane) hA = G5_STREAM_NT ? __builtin_nontemporal_load((const u32x4*)(HB + G6_OFF(0))) : *(const u32x4*)(HB + G6_OFF(0));
        for (int it = 0; it < 128; it += 2) {
            g4_rows(vB, V8, eB, it + 1, p); if (wlane) hB = G5_STREAM_NT ? __builtin_nontemporal_load((const u32x4*)(HB + G6_OFF(it + 1))) : *(const u32x4*)(HB + G6_OFF(it + 1));
            g4_ids(eA, idl, (it + 2) & 127, g);
            { const size_t o_ = G6_OFF(it);
              g6_vcompute(vA, w8l + (it & 15) * 128 + g * 16, swl[it & 15], H + o_, lane, dry, fold ? HB + o_ : nullptr, ssp + (it & 15) * 16 + (it >> 4) * 2, hA); }
            if (it + 2 < 128) { g4_rows(vA, V8, eA, it + 2, p); if (wlane) hA = G5_STREAM_NT ? __builtin_nontemporal_load((const u32x4*)(HB + G6_OFF(it + 2))) : *(const u32x4*)(HB + G6_OFF(it + 2)); }
            g4_ids(eB, idl, (it + 3) & 127, g);
            { const size_t o_ = G6_OFF(it + 1);
              g6_vcompute(vB, w8l + ((it + 1) & 15) * 128 + g * 16, swl[(it + 1) & 15], H + o_, lane, dry, fold ? HB + o_ : nullptr, ssp + ((it + 1) & 15) * 16 + ((it + 1) >> 4) * 2, hB); }
        }
#undef G6_OFF
    }
#else
    for (int n = 0; n < 32; ++n) {
        const int tt = n >> 1, k = lane + 64 * (n & 1);
        const float rs2 = rsqrtf(ssq16(ssq2p, t0 + tt) * (1.0f / 1024.0f) + RMS_EPS);
        const int id = idl[tt * 128 + k];
        const float a = (float)((LAS int*)al)[tt * 128 + k] * (rs2 * sxl[tt]) * su[id];
        al[tt * 128 + k] = gw[(size_t)(t0 + tt) * 128 + k] * gelu_erf(a) * sv[id];
    }
    asm volatile("s_waitcnt lgkmcnt(0)" ::: "memory");
    if (!(dry & 4)) {
        u32x4 vA[16], vB[16];
        g4_issue(vA, V8, idl, 0, g, p);
        for (int it = 0; it < 128; it += 2) {
            g4_issue(vB, V8, idl, it + 1, g, p);
            g5_vcompute(vA, al + (it & 15) * 128 + g * 16, H + (size_t)(t0 + (it & 15)) * DM + 128 * (it >> 4) + 16 * p + 8 * (lane >> 5), lane, dry);
            if (it + 2 < 128) g4_issue(vA, V8, idl, it + 2, g, p);
            g5_vcompute(vB, al + ((it + 1) & 15) * 128 + g * 16, H + (size_t)(t0 + ((it + 1) & 15)) * DM + 128 * ((it + 1) >> 4) + 16 * p + 8 * (lane >> 5), lane, dry);
        }
    }
#endif
    if (dry) return;
#if G5_VDOT4
    if (fold) {
        asm volatile("s_waitcnt lgkmcnt(0)" ::: "memory");
        if (!last) {
            if (lane < 16) { float a_ = 0.f;
#pragma unroll
                for (int q_ = 0; q_ < 16; ++q_) a_ += ssp[lane * 16 + q_];
                ssq1[t0 + lane] = a_; }
#if IN_I8
            asm volatile("s_waitcnt vmcnt(0)" ::: "memory");
            if (TAIL_FENCE_LIGHT) __builtin_amdgcn_fence(__ATOMIC_ACQUIRE, "agent"); else __builtin_amdgcn_fence(__ATOMIC_SEQ_CST, "agent");
            asm volatile("s_waitcnt vmcnt(0)" ::: "memory");
            for (int hb_ = 0; hb_ < 2; ++hb_) {
                u32x4 xa[8], xb[8];
#pragma unroll
                for (int tt = 0; tt < 8; ++tt) { const bf16_t* xr = HB + (size_t)(t0 + 8 * hb_ + tt) * DM + 8 * lane; xa[tt] = *(const u32x4*)xr; xb[tt] = *(const u32x4*)(xr + 512); }
#pragma unroll
                for (int tt = 0; tt < 8; ++tt) {
                    const float f[16] = {bflo(xa[tt].x), bfhi(xa[tt].x), bflo(xa[tt].y), bfhi(xa[tt].y), bflo(xa[tt].z), bfhi(xa[tt].z), bflo(xa[tt].w), bfhi(xa[tt].w),
                                         bflo(xb[tt].x), bfhi(xb[tt].x), bflo(xb[tt].y), bfhi(xb[tt].y), bflo(xb[tt].z), bfhi(xb[tt].z), bflo(xb[tt].w), bfhi(xb[tt].w)};
                    quant_arow_i8(f, A8 + (size_t)(t0 + 8 * hb_ + tt) * DM, SA + t0 + 8 * hb_ + tt, lane);
                }
            }
#endif
            return;
        }
        asm volatile("s_waitcnt vmcnt(0)" ::: "memory");
        if (TAIL_FENCE_LIGHT) __builtin_amdgcn_fence(__ATOMIC_ACQUIRE, "agent"); else __builtin_amdgcn_fence(__ATOMIC_SEQ_CST, "agent");
        asm volatile("s_waitcnt vmcnt(0)" ::: "memory");
        const f32x4 g0 = *(const f32x4*)(final_g + 8 * lane), g1 = *(const f32x4*)(final_g + 8 * lane + 4), g2 = *(const f32x4*)(final_g + 512 + 8 * lane), g3 = *(const f32x4*)(final_g + 516 + 8 * lane);
        for (int tt = 0; tt < 16; ++tt) {
            const int t = t0 + tt;
            float ss = 0.f;
#pragma unroll
            for (int q_ = 0; q_ < 16; ++q_) ss += ssp[tt * 16 + q_];
            float rs = rsqrtf(ss * (1.0f / 1024.0f) + RMS_EPS);
            const bf16_t* bp = HB + (size_t)t * DM + 8 * lane;
            const u32x4 a_ = *(const u32x4*)bp, b_ = *(const u32x4*)(bp + 512);
            float* hp = H + (size_t)t * DM + 8 * lane;
            const f32x4 h0 = (f32x4){bflo(a_.x), bfhi(a_.x), bflo(a_.y), bfhi(a_.y)} * rs * g0, h1 = (f32x4){bflo(a_.z), bfhi(a_.z), bflo(a_.w), bfhi(a_.w)} * rs * g1;
            const f32x4 h2 = (f32x4){bflo(b_.x), bfhi(b_.x), bflo(b_.y), bfhi(b_.y)} * rs * g2, h3 = (f32x4){bflo(b_.z), bfhi(b_.z), bflo(b_.w), bfhi(b_.w)} * rs * g3;
            __builtin_nontemporal_store(h0, (f32x4*)hp); __builtin_nontemporal_store(h1, (f32x4*)(hp + 4)); __builtin_nontemporal_store(h2, (f32x4*)(hp + 512)); __builtin_nontemporal_store(h3, (f32x4*)(hp + 516));
        }
        return;
    }
#endif
    __builtin_amdgcn_fence(__ATOMIC_SEQ_CST, "agent");
    asm volatile("s_waitcnt vmcnt(0)" ::: "memory");
    for (int tt = 0; tt < 16; ++tt) {
        const int t = t0 + tt;
        float* hp = H + (size_t)t * DM + 8 * lane;
        f32x4 h0 = *(const f32x4*)hp, h1 = *(const f32x4*)(hp + 4), h2 = *(const f32x4*)(hp + 512), h3 = *(const f32x4*)(hp + 516);
        float ss = (h0[0] * h0[0] + h0[1] * h0[1]) + (h0[2] * h0[2] + h0[3] * h0[3]) + (h1[0] * h1[0] + h1[1] * h1[1]) + (h1[2] * h1[2] + h1[3] * h1[3])
                 + (h2[0] * h2[0] + h2[1] * h2[1]) + (h2[2] * h2[2] + h2[3] * h2[3]) + (h3[0] * h3[0] + h3[1] * h3[1]) + (h3[2] * h3[2] + h3[3] * h3[3]);
        ss = wave_sum(ss);
        if (last) {
            const float rs = rsqrtf(ss * (1.0f / 1024.0f) + RMS_EPS);
            const f32x4 g0 = *(const f32x4*)(final_g + 8 * lane), g1 = *(const f32x4*)(final_g + 8 * lane + 4), g2 = *(const f32x4*)(final_g + 512 + 8 * lane), g3 = *(const f32x4*)(final_g + 516 + 8 * lane);
            h0 = h0 * rs * g0; h1 = h1 * rs * g1; h2 = h2 * rs * g2; h3 = h3 * rs * g3;
            *(f32x4*)hp = h0; *(f32x4*)(hp + 4) = h1; *(f32x4*)(hp + 512) = h2; *(f32x4*)(hp + 516) = h3;
        } else {
            bf16_t* bp = HB + (size_t)t * DM + 8 * lane;
            u32x4 w; w.x = cvtpk(h0[0], h0[1]); w.y = cvtpk(h0[2], h0[3]); w.z = cvtpk(h1[0], h1[1]); w.w = cvtpk(h1[2], h1[3]);
            *(u32x4*)bp = w;
            w.x = cvtpk(h2[0], h2[1]); w.y = cvtpk(h2[2], h2[3]); w.z = cvtpk(h3[0], h3[1]); w.w = cvtpk(h3[2], h3[3]);
            *(u32x4*)(bp + 512) = w;
            if (lane == 0) ssq1[t] = ss;
        }
    }
}

__device__ __forceinline__ float gelu_erf(float x) { return 0.5f * x * (1.0f + erff(x * 0.70710678118654752f)); }

__device__ __forceinline__ void gather_phase(float* __restrict__ H, bf16_t* __restrict__ HB, const float* __restrict__ ssq2, float* __restrict__ ssq1,
                                             const bf16_t* __restrict__ U16, const bf16_t* __restrict__ V16, const int* __restrict__ ids, const float* __restrict__ gw,
                                             const float* __restrict__ final_g, int last, int gwave, int ngw, int lane, int dry = 0, int idmask = 0xffff) {
    for (int t0 = gwave; t0 < T; t0 += ngw) {
        const int t = __builtin_amdgcn_readfirstlane(t0);
        const u32x4 xa = *(const u32x4*)(HB + (size_t)t * DM + 8 * lane), xb = *(const u32x4*)(HB + (size_t)t * DM + 512 + 8 * lane);
        const float rs2 = rsqrtf(ssq16(ssq2, t) * (1.0f / 1024.0f) + RMS_EPS);
        float y[16];
#pragma unroll
        for (int i = 0; i < 16; ++i) y[i] = 0.f;
        const int* idp = ids + (size_t)t * 128; const float* gp = gw + (size_t)t * 128;
        for (int c = 0; c < 16; ++c) {
            u32x4 ua[8], ub[8], va[8], vb[8]; float g[8];
#pragma unroll
            for (int e = 0; e < 8; ++e) {
                const int id = __builtin_amdgcn_readfirstlane(idp[c * 8 + e]) & idmask;
                g[e] = gp[c * 8 + e];
                const bf16_t* ur = U16 + (size_t)id * DM + 8 * lane; const bf16_t* vr = V16 + (size_t)id * DM + 8 * lane;
                ua[e] = *(const u32x4*)ur; ub[e] = *(const u32x4*)(ur + 512); va[e] = *(const u32x4*)vr; vb[e] = *(const u32x4*)(vr + 512);
            }
#pragma unroll
            for (int e = 0; e < 8; ++e) {
                float a = 0.f;
                a = dot2bf(xa.x, ua[e].x, a); a = dot2bf(xa.y, ua[e].y, a); a = dot2bf(xa.z, ua[e].z, a); a = dot2bf(xa.w, ua[e].w, a);
                a = dot2bf(xb.x, ub[e].x, a); a = dot2bf(xb.y, ub[e].y, a); a = dot2bf(xb.z, ub[e].z, a); a = dot2bf(xb.w, ub[e].w, a);
                a = wave_sum(a);
                const float w = g[e] * gelu_erf(a * rs2);
                y[0] = fmaf(w, bflo(va[e].x), y[0]); y[1] = fmaf(w, bfhi(va[e].x), y[1]); y[2] = fmaf(w, bflo(va[e].y), y[2]); y[3] = fmaf(w, bfhi(va[e].y), y[3]);
                y[4] = fmaf(w, bflo(va[e].z), y[4]); y[5] = fmaf(w, bfhi(va[e].z), y[5]); y[6] = fmaf(w, bflo(va[e].w), y[6]); y[7] = fmaf(w, bfhi(va[e].w), y[7]);
                y[8] = fmaf(w, bflo(vb[e].x), y[8]); y[9] = fmaf(w, bfhi(vb[e].x), y[9]); y[10] = fmaf(w, bflo(vb[e].y), y[10]); y[11] = fmaf(w, bfhi(vb[e].y), y[11]);
                y[12] = fmaf(w, bflo(vb[e].z), y[12]); y[13] = fmaf(w, bfhi(vb[e].z), y[13]); y[14] = fmaf(w, bflo(vb[e].w), y[14]); y[15] = fmaf(w, bfhi(vb[e].w), y[15]);
            }
        }
        float* hp = H + (size_t)t * DM + 8 * lane;
        f32x4 h0 = *(const f32x4*)hp, h1 = *(const f32x4*)(hp + 4), h2 = *(const f32x4*)(hp + 512), h3 = *(const f32x4*)(hp + 516);
        h0 += (f32x4){y[0], y[1], y[2], y[3]}; h1 += (f32x4){y[4], y[5], y[6], y[7]}; h2 += (f32x4){y[8], y[9], y[10], y[11]}; h3 += (f32x4){y[12], y[13], y[14], y[15]};
        float ss = (h0[0] * h0[0] + h0[1] * h0[1]) + (h0[2] * h0[2] + h0[3] * h0[3]) + (h1[0] * h1[0] + h1[1] * h1[1]) + (h1[2] * h1[2] + h1[3] * h1[3])
                 + (h2[0] * h2[0] + h2[1] * h2[1]) + (h2[2] * h2[2] + h2[3] * h2[3]) + (h3[0] * h3[0] + h3[1] * h3[1]) + (h3[2] * h3[2] + h3[3] * h3[3]);
        ss = wave_sum(ss);
        if (dry && ss >= 0.f) continue;
        if (last) {
            const float rs = rsqrtf(ss * (1.0f / 1024.0f) + RMS_EPS);
            const f32x4 g0 = *(const f32x4*)(final_g + 8 * lane), g1 = *(const f32x4*)(final_g + 8 * lane + 4), g2 = *(const f32x4*)(final_g + 512 + 8 * lane), g3 = *(const f32x4*)(final_g + 516 + 8 * lane);
            h0 = h0 * rs * g0; h1 = h1 * rs * g1; h2 = h2 * rs * g2; h3 = h3 * rs * g3;
            *(f32x4*)hp = h0; *(f32x4*)(hp + 4) = h1; *(f32x4*)(hp + 512) = h2; *(f32x4*)(hp + 516) = h3;
        } else {
            *(f32x4*)hp = h0; *(f32x4*)(hp + 4) = h1; *(f32x4*)(hp + 512) = h2; *(f32x4*)(hp + 516) = h3;
            bf16_t* bp = HB + (size_t)t * DM + 8 * lane;
            u32x4 w; w.x = cvtpk(h0[0], h0[1]); w.y = cvtpk(h0[2], h0[3]); w.z = cvtpk(h1[0], h1[1]); w.w = cvtpk(h1[2], h1[3]);
            *(u32x4*)bp = w;
            w.x = cvtpk(h2[0], h2[1]); w.y = cvtpk(h2[2], h2[3]); w.z = cvtpk(h3[0], h3[1]); w.w = cvtpk(h3[2], h3[3]);
            *(u32x4*)(bp + 512) = w;
            if (lane == 0) ssq1[t] = ss;
        }
    }
}

#define XB_TMO      128
#define XB_XCNT(j)  (256  + 64 * (j))
#define XB_XSUB(j)  (1280 + 64 * (j))
#define XB_XGEN(j)  (2304 + 64 * (j))
#define XB_TOP      3328
#define XB_TOPGEN   3392
#define XCD_BAR_WORDS 3456
#define XB_SPIN_CAP (1u << 18)

__device__ __forceinline__ unsigned xb_ld(unsigned* p)              { return __hip_atomic_load(p, __ATOMIC_RELAXED, __HIP_MEMORY_SCOPE_AGENT); }
__device__ __forceinline__ unsigned xb_add(unsigned* p, unsigned v) { return __hip_atomic_fetch_add(p, v, __ATOMIC_RELAXED, __HIP_MEMORY_SCOPE_AGENT); }
__device__ __forceinline__ unsigned xb_xcc_id() { return (unsigned)__builtin_amdgcn_s_getreg((3 << 11) | 20) & 0xFu; }
#define XB_SPIN(cond, bar) do { unsigned _sp = 0; while (cond) { __builtin_amdgcn_s_sleep(1); \
    if ((++_sp & 255u) == 0u) { if (xb_ld(&(bar)[XB_TMO])) break; if (_sp > XB_SPIN_CAP) { atomicAdd(&(bar)[XB_TMO], 1u); break; } } } } while (0)

struct XcdBarrier {
    unsigned* bar; unsigned x;
    volatile LAS unsigned* st;
};

__device__ __forceinline__ XcdBarrier xcd_barrier_post(unsigned* bar, volatile LAS unsigned* st, int tid) {
    XcdBarrier b; b.bar = bar; b.x = xb_xcc_id(); b.st = st;
    if (tid == 0) (void)xb_add(&bar[XB_XCNT(b.x)], 1u);
    return b;
}
__device__ __forceinline__ void xcd_barrier_complete(unsigned* bar, unsigned x, unsigned& nloc, unsigned& nx) {
    const unsigned G = gridDim.x * gridDim.y * gridDim.z;
    unsigned sum, cnt, mine, sp = 0u;
    for (;;) {
        sum = 0u; cnt = 0u; mine = 0u;
#pragma unroll
        for (unsigned j = 0; j < 16; ++j) { const unsigned c = xb_ld(&bar[XB_XCNT(j)]); sum += c; cnt += (c > 0u) ? 1u : 0u; mine = (j == x) ? c : mine; }
        if (sum == G) break;
        __builtin_amdgcn_s_sleep(1);
        if ((++sp & 255u) == 0u) { if (xb_ld(&bar[XB_TMO])) break; if (sp > XB_SPIN_CAP) { atomicAdd(&bar[XB_TMO], 1u); break; } }
    }
    nloc = mine > 0u ? mine : 1u; nx = cnt > 0u ? cnt : 1u;
}

__device__ __forceinline__ void xcd_barrier(const XcdBarrier& b, int tid) {
    asm volatile("s_waitcnt vmcnt(0)" ::: "memory");
    __syncthreads();
    if (tid == 0) {
        unsigned* bar = b.bar;
        __builtin_amdgcn_s_waitcnt(0);
        unsigned nloc = b.st[0], nx = b.st[1];
        if (nloc == 0u) { xcd_barrier_complete(bar, b.x, nloc, nx); b.st[0] = nloc; b.st[1] = nx; }
        const unsigned old = xb_add(&bar[XB_XSUB(b.x)], 1u);
        const unsigned gen = old / nloc;
        if (old + 1u == (gen + 1u) * nloc) {
            __builtin_amdgcn_fence(__ATOMIC_RELEASE, "agent");
            asm volatile("s_waitcnt vmcnt(0)" ::: "memory");
            const unsigned og = xb_add(&bar[XB_TOP], 1u);
            const unsigned tg = og / nx;
            if (og + 1u == (tg + 1u) * nx) xb_add(&bar[XB_TOPGEN], 1u);
            else XB_SPIN(xb_ld(&bar[XB_TOPGEN]) == tg, bar);
            __builtin_amdgcn_fence(__ATOMIC_ACQUIRE, "agent");
            xb_add(&bar[XB_XGEN(b.x)], 1u);
            asm volatile("s_waitcnt vmcnt(0)" ::: "memory");
        } else {
            XB_SPIN(xb_ld(&bar[XB_XGEN(b.x)]) == gen, bar);
            __builtin_amdgcn_fence(__ATOMIC_ACQUIRE, "agent");
            asm volatile("s_waitcnt vmcnt(0)" ::: "memory");
        }
    }
    __syncthreads();
}
struct Params { const float* in[18]; float* out; unsigned char* ws; int ph_lo, ph_hi; };

typedef const __attribute__((address_space(4))) Params* KP;
#define KARGS() KP pp = (KP)__builtin_amdgcn_kernarg_segment_ptr(); asm volatile("" : "+s"(pp))
#ifndef PEER_FP8
#define PEER_FP8 1
#endif
#ifndef PEER_I8
#define PEER_I8 1
#endif
#ifndef G4P
#define G4P 0
#endif
#ifndef STAGGER_TICKS
#define STAGGER_TICKS 0
#endif
#ifndef PROBE_DUP
#define PROBE_DUP 0
#endif
#define PH_ON(k, bit) ((PH_MASK & (bit)) && ph_lo <= (k) && (k) < ph_hi)
constexpr int CW_BAR = 4096;
constexpr int MISC_OFF = 131072 + 320;
__device__ __forceinline__ int lane_id_opaque() { int l; asm volatile("v_mbcnt_lo_u32_b32 %0, -1, 0\n\tv_mbcnt_hi_u32_b32 %0, -1, %0" : "=v"(l)); return l; }
#define PH_SYNC(k) do { if ((k) > ph_lo) { { KP pq = (KP)__builtin_amdgcn_kernarg_segment_ptr(); \
    XcdBarrier xb_; xb_.bar = (unsigned*)(pq->ws + WS_CTL) + CW_BAR; xb_.x = xb_xcc_id(); xb_.st = (volatile LAS unsigned*)(lds + MISC_OFF) + 8; xcd_barrier(xb_, tid); if (PROBE_DUP == 15) { xcd_barrier(xb_, tid); xcd_barrier(xb_, tid); } } } } while (0)
#define PH_IDS() const int lane = lane_id_opaque(); const int tid = wave * 64 + lane

__device__ __forceinline__ void weight_prep(KP pp, int l, LAS float* scr, int gw0, int ngw, int lane) {
    unsigned char* wl = pp->ws + WS_W + (size_t)l * WL_STRIDE;
    const float* g1 = pp->in[2] + (size_t)l * DM; const float* g2 = pp->in[11] + (size_t)l * DM;
    constexpr int N_BR = 3 * 192, N_OUT = 512, N_INQ = N_IN / 8, N_QQ = 2048 / 8;
    static_assert(IN_I8 && Q_I8 && IN_I8_LAYERS == 3, "the flat weight-preparation list is written for the int8 in-projection and query projection");
    for (int it = gw0; it < N_BR + N_OUT + N_INQ + N_QQ; it += ngw) {
        if (it < N_BR) { const int i = it / 192, j = it - 192 * i;
            transpose_item<0>(pp->in[7 + i] + (size_t)l * 384 * DM, 384, DM, (bf16_t*)(wl + WL_BR) + (size_t)i * DM * 384, nullptr, scr, j, 32, lane); }
        else if (it < N_BR + N_OUT) transpose_item<0>(pp->in[10] + (size_t)l * DM * DM, DM, DM, (bf16_t*)(wl + WL_OUT), nullptr, scr, it - N_BR, 32, lane);
        else if (it < N_BR + N_OUT + N_INQ) quant_win_item(pp->in[3] + (size_t)l * DM * IN_COLS, g1, wl + WL_IN, (float*)(wl + WL_INSC), it - N_BR - N_OUT, lane);
        else quant_win_item<0, 2048>(pp->in[12] + (size_t)l * DM * 2048, g2, wl + WL_Q, (float*)(wl + WL_Q + WL_QSC), it - N_BR - N_OUT - N_INQ, lane);
    }
}

#ifndef HALF_PRIO
#define HALF_PRIO 0
#endif
template <int l>
__device__ __forceinline__ void layer_phases(const int ph_lo, const int ph_hi, LAS unsigned char* lds, const int wave) {
    constexpr int pb = 1 + 8 * l;
        if (PH_ON(pb + 0, 2)) {
            PH_IDS(); PH_SYNC(pb + 0); KARGS();
            unsigned char* ws = pp->ws; unsigned char* wl = ws + WS_W + (size_t)l * WL_STRIDE;
            const int G = gridDim.x;
            constexpr bool I8L = IN_I8 && ((IN_I8_LAYERS >> l) & 1);
            pg8::Gemm g{(const bf16_t*)(ws + (I8L ? WS_A8 : WS_HB)), (const bf16_t*)(wl + WL_IN), T, N_IN, I8L ? DM / 2 : DM, I8L ? DM / 2 : DM};
            pg8::StaticOrder S; S.init(T, N_IN, G, (int)blockIdx.x);
            EpiInT<I8L> E{(bf16_t*)(ws + WS_P), (bf16_t*)(ws + WS_G), (const float*)(ws + WS_SSQ1), (const float*)(ws + WS_ROPE), pp->in[6] + (size_t)l * 3 * DM, pp->in[4] + (size_t)l * 6, (float*)(ws + WS_LOGF), 0,
                    (const float*)(ws + WS_SA), (const float*)(wl + WL_INSC)};
            if (STAGGER_TICKS > 0 && (blockIdx.x & 1)) { const unsigned long long t0_ = __builtin_amdgcn_s_memrealtime(); while (__builtin_amdgcn_s_memrealtime() - t0_ < (unsigned long long)STAGGER_TICKS) __builtin_amdgcn_s_sleep(20); }
            pg8::gemm_phase<EpiInT<I8L>, pg8::StaticOrder, true, true, I8L>(lds, g, S, E, tid);
            if (PROBE_DUP == 1) { __syncthreads(); pg8::gemm_phase<EpiInT<I8L>, pg8::StaticOrder, true, true, I8L>(lds, g, S, E, tid); }
            if (PROBE_DUP == 13) { __syncthreads(); EpiInT<I8L> En = E; En.nostore = 1; pg8::gemm_phase<EpiInT<I8L>, pg8::StaticOrder, true, true, I8L>(lds, g, S, En, tid); }
            if (PROBE_DUP == 12) { __syncthreads(); EpiDry Ed{(float*)(ws + WS_CTL) + 8192}; pg8::gemm_phase<EpiDry, pg8::StaticOrder, true, true>(lds, g, S, Ed, tid); }
        }
        if (PH_ON(pb + 1, 4)) {
            PH_IDS(); PH_SYNC(pb + 1); KARGS();
            float* logf = (float*)(pp->ws + WS_LOGF); float* cumT = (float*)(pp->ws + WS_CUMT);
            LAS float* wt = (LAS float*)lds;
            for (int r = (int)blockIdx.x * 512 + tid; r < BATCH * 6 * SEQ; r += (int)gridDim.x * 512) {
                const int sq = r >> 13, sp_ = r & (SEQ - 1), b = sq / 6, h = sq % 6;
                const bf16_t* kr = (const bf16_t*)(pp->ws + WS_P) + ((size_t)b * SEQ + sp_) * NP + PC_KB + 64 * h;
                float n2 = 0.f;
#pragma unroll
                for (int c = 0; c < 8; ++c) { const u32x4 kk = *(const u32x4*)(kr + 8 * c);
                    n2 += (bflo(kk.x) * bflo(kk.x) + bfhi(kk.x) * bfhi(kk.x)) + (bflo(kk.y) * bflo(kk.y) + bfhi(kk.y) * bfhi(kk.y)) + (bflo(kk.z) * bflo(kk.z) + bfhi(kk.z) * bfhi(kk.z)) + (bflo(kk.w) * bflo(kk.w) + bfhi(kk.w) * bfhi(kk.w)); }
#pragma unroll
                for (int o = 1; o < 64; o <<= 1) n2 = fmaxf(n2, __shfl_xor(n2, o));
                if (lane == 0) atomicMax((unsigned*)(pp->ws + WS_KMAX_BASE + 4096 * l) + 32 * sq, __float_as_uint(n2));
            }
            if (l + 1 < DEPTH && (int)blockIdx.x >= BATCH * 6 && (int)gridDim.x > BATCH * 6)
                weight_prep(pp, l + 1, (LAS float*)(lds + wave * 8448), ((int)blockIdx.x - BATCH * 6) * 8 + wave, ((int)gridDim.x - BATCH * 6) * 8, lane);
            for (int sq = blockIdx.x; sq < BATCH * 6; sq += gridDim.x) {
                const int b = sq / 6, h = sq % 6;
                float* base = logf + (size_t)b * SEQ * 8 + h;
                float v[16]; float run = 0.f;
#pragma unroll
                for (int i = 0; i < 16; ++i) { run += base[(size_t)(tid * 16 + i) * 8]; v[i] = run; }
                float inc = run;
#pragma unroll
                for (int o = 1; o < 64; o <<= 1) { const float n = __shfl_up(inc, o); if (lane >= o) inc += n; }
                __syncthreads();
                if (lane == 63) wt[wave] = inc;
                __syncthreads();
                float off = inc - run;
                for (int w = 0; w < wave; ++w) off += wt[w];
#pragma unroll
                for (int i = 0; i < 16; ++i) cumT[(size_t)sq * SEQ + tid * 16 + i] = (v[i] + off) * LOG2E;
            }
        }
        if (PH_ON(pb + 2, 8)) {
            PH_IDS(); PH_SYNC(pb + 2); KARGS();
            if (HALF_PRIO && __builtin_amdgcn_readfirstlane(wave) >= 4) __builtin_amdgcn_s_setprio(1);
            if (ATT_XCD && MIXA_3PASS == 0) attention_phase_x(pp->ws, pp->in[5] + (size_t)l * 6, CW_ATT + 64 * l, (int)(WS_KMAX_BASE / 4) + 1024 * l, lds, wave, lane, (int)xb_xcc_id());
            else if (MIXA_3PASS == 4) {
                attention_phase_v2(pp->ws, pp->in[5] + (size_t)l * 6, CW_ATT + 64 * l, (int)(WS_KMAX_BASE / 4) + 1024 * l, lds, wave, lane, 0);
                { KP pq = (KP)__builtin_amdgcn_kernarg_segment_ptr(); XcdBarrier xb_; xb_.bar = (unsigned*)(pq->ws + WS_CTL) + CW_BAR; xb_.x = xb_xcc_id(); xb_.st = (volatile LAS unsigned*)(lds + MISC_OFF) + 8; xcd_barrier(xb_, tid); }
                KP pq2 = (KP)__builtin_amdgcn_kernarg_segment_ptr();
                attention_phase_v2(pq2->ws, pq2->in[5] + (size_t)l * 6, CW_ATT + 64 * l, (int)(WS_KMAX_BASE / 4) + 1024 * l, lds, wave, lane, 1);
            }
            else attention_phase(pp->ws, pp->in[5] + (size_t)l * 6, CW_ATT + 64 * l, CW_GRP + 512 * l, (int)(WS_KMAX_BASE / 4) + 1024 * l, lds, wave, lane, 0);
            if (HALF_PRIO) __builtin_amdgcn_s_setprio(0);
            if (PROBE_DUP == 21) { __syncthreads(); KP pq3 = (KP)__builtin_amdgcn_kernarg_segment_ptr(); attention_phase(pq3->ws, pq3->in[5] + (size_t)l * 6, CW_ATT + 64 * l + 16, CW_GRP + 512 * l, (int)(WS_KMAX_BASE / 4) + 1024 * l, lds, wave, lane, 1); }
        }
        if (PH_ON(pb + 3, 16)) {
            PH_IDS(); PH_SYNC(pb + 3); KARGS();
            unsigned char* ws = pp->ws; unsigned char* wl = ws + WS_W + (size_t)l * WL_STRIDE;
            bf16_t* P = (bf16_t*)(ws + WS_P);
            for (int rep = 0; rep < (PROBE_DUP == 6 ? 2 : 1); ++rep) {
                pg8::Gemm g{P, (const bf16_t*)(wl + WL_BR), T, DM, 384, NP};
                BranchOrder S; S.init(T, DM, (int)gridDim.x, (int)blockIdx.x);
                EpiBrChain E{(const unsigned char*)(ws + WS_G), P + PC_MERGED};
                pg8::gemm_phase<EpiBrChain, BranchOrder, true, true>(lds, g, S, E, tid);
                __syncthreads();
            }
        }
        if (PH_ON(pb + 4, 32)) {
            PH_IDS(); PH_SYNC(pb + 4); KARGS();
            unsigned char* ws = pp->ws; unsigned char* wl = ws + WS_W + (size_t)l * WL_STRIDE;
            pg8::Gemm g{(const bf16_t*)(ws + WS_P) + PC_MERGED, (const bf16_t*)(wl + WL_OUT), T, DM, DM, NP};
            pg8::StaticOrder S; S.init(T, DM, (int)gridDim.x, (int)blockIdx.x);
            EpiOut E{l == 0 ? pp->in[0] : pp->out, pp->out, (bf16_t*)(ws + WS_HB), (float*)(ws + WS_SSQ2P)};
            pg8::gemm_phase<EpiOut, pg8::StaticOrder, true, true>(lds, g, S, E, tid);
            if (PROBE_DUP == 22) { __syncthreads(); EpiDry Ed{(float*)(ws + WS_CTL) + 8192}; pg8::gemm_phase<EpiDry, pg8::StaticOrder, true, true>(lds, g, S, Ed, tid); }
        }
        if (PH_ON(pb + 5, 64)) {
            PH_IDS(); PH_SYNC(pb + 5); KARGS();
            unsigned char* ws = pp->ws; unsigned char* wl = ws + WS_W + (size_t)l * WL_STRIDE;
            for (int rep = 0; rep < (PROBE_DUP == 7 ? 2 : 1); ++rep) {
            {
                if (Q_I8) {
                    const int t0_ = ((int)blockIdx.x * 8 + wave) * 16;
                    for (int hb_ = 0; hb_ < (PROBE_DUP == 18 ? 8 : 2); ++hb_) {
                        u32x4 xa[8], xb[8];
#pragma unroll
                        for (int tt = 0; tt < 8; ++tt) { const bf16_t* xr = (const bf16_t*)(ws + WS_HB) + (size_t)(t0_ + 8 * (hb_ & 1) + tt) * DM + 8 * lane; xa[tt] = *(const u32x4*)xr; xb[tt] = *(const u32x4*)(xr + 512); }
#pragma unroll
                        for (int tt = 0; tt < 8; ++tt) {
                            const float f[16] = {bflo(xa[tt].x), bfhi(xa[tt].x), bflo(xa[tt].y), bfhi(xa[tt].y), bflo(xa[tt].z), bfhi(xa[tt].z), bflo(xa[tt].w), bfhi(xa[tt].w),
                                                 bflo(xb[tt].x), bfhi(xb[tt].x), bflo(xb[tt].y), bfhi(xb[tt].y), bflo(xb[tt].z), bfhi(xb[tt].z), bflo(xb[tt].w), bfhi(xb[tt].w)};
                            quant_arow_i8(f, ws + WS_XQ + (size_t)(t0_ + 8 * (hb_ & 1) + tt) * DM, (float*)(ws + WS_SX) + t0_ + 8 * (hb_ & 1) + tt, lane);
                        }
                    }
                    { KP pq = (KP)__builtin_amdgcn_kernarg_segment_ptr(); XcdBarrier xb_; xb_.bar = (unsigned*)(pq->ws + WS_CTL) + CW_BAR; xb_.x = xb_xcc_id(); xb_.st = (volatile LAS unsigned*)(lds + MISC_OFF) + 8; xcd_barrier(xb_, tid); }
                }
                pg8::Gemm g{(const bf16_t*)(ws + (Q_I8 ? WS_XQ : WS_HB)), (const bf16_t*)(wl + WL_Q), T, 2048, Q_I8 ? DM / 2 : DM, Q_I8 ? DM / 2 : DM};
                pg8::StaticOrder S; S.init(T, 2048, (int)gridDim.x, (int)blockIdx.x);
                EpiQT<Q_I8 != 0> E{(bf16_t*)(ws + WS_Q2), (const float*)(ws + WS_SSQ2P), (const float*)(ws + WS_SX), (const float*)(wl + WL_Q + WL_QSC)};
                pg8::gemm_phase<EpiQT<Q_I8 != 0>, pg8::StaticOrder, true, true, Q_I8 != 0>(lds, g, S, E, tid);
                if (PROBE_DUP == 17) { __syncthreads(); pg8::gemm_phase<EpiQT<Q_I8 != 0>, pg8::StaticOrder, true, true, Q_I8 != 0>(lds, g, S, E, tid); }
            }
            __syncthreads();
            }
        }
        if (PH_ON(pb + 6, 128)) {
            PH_IDS(); PH_SYNC(pb + 6); KARGS();
            unsigned char* ws = pp->ws;
            if (PROBE_DUP == 3) { routing_phase((const bf16_t*)(ws + WS_Q2), pp->in[13] + (size_t)l * 128 * 128, pp->in[14] + (size_t)l * 128 * 128, (int*)(ws + WS_IDS), (float*)(ws + WS_GW), lds, tid); __syncthreads(); }
            routing2_setup(pp->in[13] + (size_t)l * 128 * 128, pp->in[14] + (size_t)l * 128 * 128, lds, tid);
            if (wave < 4) routing2_units((const bf16_t*)(ws + WS_Q2), (int*)(ws + WS_IDS), (float*)(ws + WS_GW), lds, wave, lane, (int)blockIdx.x * 8 + wave, (int)gridDim.x * 8);
            if (PEER_I8) {
                const float* u = pp->in[15] + (size_t)l * N_EXP * DM; const float* v = pp->in[16] + (size_t)l * N_EXP * DM;
                const float* g2 = pp->in[11] + (size_t)l * DM;
                {
                    const int rstep = (int)gridDim.x * 8;
                    int r = (int)blockIdx.x * 8 + wave;
                    f32x4 cu[4], cv[4], nu[4], nv[4];
                    if (r < N_EXP) { quant_row_load(cu, u + (size_t)r * DM, lane); quant_row_load(cv, v + (size_t)r * DM, lane); }
                    for (; r < N_EXP; r += rstep) {
                        const int rn = r + rstep;
                        if (rn < N_EXP) { quant_row_load(nu, u + (size_t)rn * DM, lane); quant_row_load(nv, v + (size_t)rn * DM, lane); }
                        quant_row_finish(cu, g2, ws + WS_U8 + (size_t)r * (TAB_SLICED ? 128 : DM), (float*)(ws + WS_SU) + r, 0, lane);
                        quant_row_finish(cv, nullptr, ws + WS_V8 + (size_t)r * (TAB_SLICED ? 128 : DM), (float*)(ws + WS_SV) + r, G5_VDOT4 ? 0 : 128, lane);
#pragma unroll
                        for (int j = 0; j < 4; ++j) { cu[j] = nu[j]; cv[j] = nv[j]; }
                    }
                }
            } else if (PEER_FP8) {
                const float* u = pp->in[15] + (size_t)l * N_EXP * DM; const float* v = pp->in[16] + (size_t)l * N_EXP * DM;
                const float* g2 = pp->in[11] + (size_t)l * DM;
                for (int r = (int)blockIdx.x * 8 + wave; r < N_EXP; r += (int)gridDim.x * 8) {
                    quant_row_fp8(u + (size_t)r * DM, g2, ws + WS_U8 + (size_t)r * DM, (float*)(ws + WS_SU) + r, lane);
                    quant_row_fp8(v + (size_t)r * DM, nullptr, ws + WS_V8 + (size_t)r * DM, (float*)(ws + WS_SV) + r, lane);
                }
            } else {
                const float* u = pp->in[15] + (size_t)l * N_EXP * DM; const float* v = pp->in[16] + (size_t)l * N_EXP * DM;
                const float* g2 = pp->in[11] + (size_t)l * DM;
                bf16_t* U16 = (bf16_t*)(ws + WS_U16); bf16_t* V16 = (bf16_t*)(ws + WS_V16);
                for (unsigned e = blockIdx.x * 512 + tid; e < (unsigned)(N_EXP * DM / 8); e += gridDim.x * 512) {
                    const unsigned o = e * 8; const int c = (int)(o & (DM - 1));
                    const f32x4 a0 = *(const f32x4*)(u + o), a1 = *(const f32x4*)(u + o + 4), s0 = *(const f32x4*)(g2 + c), s1 = *(const f32x4*)(g2 + c + 4);
                    u32x4 w; w.x = cvtpk(a0[0] * s0[0], a0[1] * s0[1]); w.y = cvtpk(a0[2] * s0[2], a0[3] * s0[3]); w.z = cvtpk(a1[0] * s1[0], a1[1] * s1[1]); w.w = cvtpk(a1[2] * s1[2], a1[3] * s1[3]);
                    *(u32x4*)(U16 + o) = w;
                    const f32x4 b0 = *(const f32x4*)(v + o), b1 = *(const f32x4*)(v + o + 4);
                    if (G3_VF16) { w.x = cvtpk_h(b0[0], b0[1]); w.y = cvtpk_h(b0[2], b0[3]); w.z = cvtpk_h(b1[0], b1[1]); w.w = cvtpk_h(b1[2], b1[3]); }
                    else { w.x = cvtpk(b0[0], b0[1]); w.y = cvtpk(b0[2], b0[3]); w.z = cvtpk(b1[0], b1[1]); w.w = cvtpk(b1[2], b1[3]); }
                    *(u32x4*)(V16 + o) = w;
                }
            }
            if (wave >= 4) routing2_units((const bf16_t*)(ws + WS_Q2), (int*)(ws + WS_IDS), (float*)(ws + WS_GW), lds, wave, lane, (int)blockIdx.x * 8 + wave, (int)gridDim.x * 8);
            if (PROBE_DUP == 19) routing2_units((const bf16_t*)(ws + WS_Q2), (int*)(ws + WS_IDS), (float*)(ws + WS_GW), lds, wave, lane, (int)blockIdx.x * 8 + wave, (int)gridDim.x * 8);
        }
        if (PH_ON(pb + 7, 256)) {
            PH_IDS(); PH_SYNC(pb + 7); KARGS();
            unsigned char* ws = pp->ws;
            if (PROBE_DUP == 4) gather_phase(pp->out, (bf16_t*)(ws + WS_HB), (const float*)(ws + WS_SSQ2P), (float*)(ws + WS_SSQ1), (const bf16_t*)(ws + WS_U16), (const bf16_t*)(ws + WS_V16),
                         (const int*)(ws + WS_IDS), (const float*)(ws + WS_GW), pp->in[17], l == DEPTH - 1 ? 1 : 0, (int)blockIdx.x * 8 + wave, (int)gridDim.x * 8, lane, 1);
            if (PROBE_DUP == 5) gather_phase(pp->out, (bf16_t*)(ws + WS_HB), (const float*)(ws + WS_SSQ2P), (float*)(ws + WS_SSQ1), (const bf16_t*)(ws + WS_U16), (const bf16_t*)(ws + WS_V16),
                         (const int*)(ws + WS_IDS), (const float*)(ws + WS_GW), pp->in[17], l == DEPTH - 1 ? 1 : 0, (int)blockIdx.x * 8 + wave, (int)gridDim.x * 8, lane, 1, 511);
            if (PROBE_DUP == 10 || PROBE_DUP == 11) gather5_phase(pp->out, (bf16_t*)(ws + WS_HB), (const float*)(ws + WS_SSQ2P), (float*)(ws + WS_SSQ1), ws + WS_U8, ws + WS_V8, (const float*)(ws + WS_SU), (const float*)(ws + WS_SV),
                         ws + WS_XQ, (const int*)(ws + WS_IDS), (const float*)(ws + WS_GW), pp->in[17], l == DEPTH - 1 ? 1 : 0, lds, wave, (int)blockIdx.x * 8 + wave, lane, 1 | G4P, PROBE_DUP == 10 ? 7 : 0xffff);
            if (HALF_PRIO && __builtin_amdgcn_readfirstlane(wave) >= 4) __builtin_amdgcn_s_setprio(1);
            if (PROBE_DUP == 20) { gather5_phase(pp->out, (bf16_t*)(ws + WS_HB), (const float*)(ws + WS_SSQ2P), (float*)(ws + WS_SSQ1), ws + WS_U8, ws + WS_V8, (const float*)(ws + WS_SU), (const float*)(ws + WS_SV),
                         ws + WS_XQ, (const int*)(ws + WS_IDS), (const float*)(ws + WS_GW), pp->in[17], l == DEPTH - 1 ? 1 : 0, lds, wave, (int)blockIdx.x * 8 + wave, lane, 4, 0xffff, ws + WS_A8, (float*)(ws + WS_SA), Q_I8 ? (const float*)(ws + WS_SX) : nullptr); __syncthreads(); }
            if (PEER_I8) gather5_phase(pp->out, (bf16_t*)(ws + WS_HB), (const float*)(ws + WS_SSQ2P), (float*)(ws + WS_SSQ1), ws + WS_U8, ws + WS_V8, (const float*)(ws + WS_SU), (const float*)(ws + WS_SV),
                         ws + WS_XQ, (const int*)(ws + WS_IDS), (const float*)(ws + WS_GW), pp->in[17], l == DEPTH - 1 ? 1 : 0, lds, wave, (int)blockIdx.x * 8 + wave, lane, 0, 0xffff, ws + WS_A8, (float*)(ws + WS_SA), Q_I8 ? (const float*)(ws + WS_SX) : nullptr);
            else if (PEER_FP8) gather4_phase(pp->out, (bf16_t*)(ws + WS_HB), (const float*)(ws + WS_SSQ2P), (float*)(ws + WS_SSQ1), ws + WS_U8, ws + WS_V8, (const float*)(ws + WS_SU), (const float*)(ws + WS_SV),
                         (const int*)(ws + WS_IDS), (const float*)(ws + WS_GW), pp->in[17], l == DEPTH - 1 ? 1 : 0, lds, wave, (int)blockIdx.x * 8 + wave, lane);
            else gather3_phase(pp->out, (bf16_t*)(ws + WS_HB), (const float*)(ws + WS_SSQ2P), (float*)(ws + WS_SSQ1), (const bf16_t*)(ws + WS_U16), (const unsigned short*)(ws + WS_V16),
                         (const int*)(ws + WS_IDS), (const float*)(ws + WS_GW), pp->in[17], l == DEPTH - 1 ? 1 : 0, lds, wave, (int)blockIdx.x * 8 + wave, lane);
            if (HALF_PRIO) __builtin_amdgcn_s_setprio(0);
        }
}

__global__ void __launch_bounds__(512, 2) mega(Params p) {
    extern __shared__ __attribute__((aligned(16))) unsigned char lds_raw[];
    LAS unsigned char* lds = (LAS unsigned char*)lds_raw;
    const int ph_lo = p.ph_lo, ph_hi = p.ph_hi;
    const int wave = __builtin_amdgcn_readfirstlane(threadIdx.x >> 6);
    if (ph_lo < -1000) cg::this_grid().sync();
    {
        const int tid0 = threadIdx.x;
        for (int u = tid0; u < (LDS_BYTES - 131072) / 4; u += 512) ((LAS unsigned*)(lds + 131072))[u] = 0u;
        __syncthreads();
        if (ph_hi - ph_lo > 1) { KP pq = (KP)__builtin_amdgcn_kernarg_segment_ptr(); (void)xcd_barrier_post((unsigned*)(pq->ws + WS_CTL) + CW_BAR, (volatile LAS unsigned*)(lds + MISC_OFF) + 8, tid0); }
    }

    if (PH_ON(0, 1)) { KARGS();
        const int tid = threadIdx.x, lane = tid & 63;
        unsigned char* ws = pp->ws;
        const int G = gridDim.x, gwave = blockIdx.x * 8 + wave, ngw = G * 8;
        LAS float* scr = (LAS float*)(lds + wave * 8448);
        for (int rep = 0; rep < (PROBE_DUP == 8 ? 2 : 1); ++rep) {
        if (wave < 4) weight_prep(pp, 0, scr, gwave, ngw, lane);
        {
            const int* pos = (const int*)pp->in[1];
            float* rope = (float*)(ws + WS_ROPE);
            const float inv_freq = (float)exp2(-(double)(tid & 31) * (13.287712379549449 / 32.0));
            for (int e = blockIdx.x * 512 + tid; e < T * 32; e += G * 512) {
                const int t = e >> 5;
                const float ang = (float)pos[t] * inv_freq;
                double rv = (double)ang * 0.15915494309189535; rv -= floor(rv);
                const float rf = (float)rv;
                rope[2 * e] = __builtin_amdgcn_cosf(rf); rope[2 * e + 1] = __builtin_amdgcn_sinf(rf);
            }
        }
        {
            bf16_t* HB = (bf16_t*)(ws + WS_HB); float* ssq1 = (float*)(ws + WS_SSQ1);
            f32x4 vn[4];
            { const f32x4* xr0 = (const f32x4*)(pp->in[0] + (size_t)gwave * DM) + lane;
#pragma unroll
              for (int j = 0; j < 4; ++j) vn[j] = xr0[64 * j]; }
            for (int t = gwave; t < T; t += ngw) {
                f32x4 v[4]; float ss = 0.f;
#pragma unroll
                for (int j = 0; j < 4; ++j) v[j] = vn[j];
                if (t + ngw < T) { const f32x4* xr1 = (const f32x4*)(pp->in[0] + (size_t)(t + ngw) * DM) + lane;
#pragma unroll
                    for (int j = 0; j < 4; ++j) vn[j] = xr1[64 * j]; }
#pragma unroll
                for (int j = 0; j < 4; ++j) ss += (v[j][0] * v[j][0] + v[j][1] * v[j][1]) + (v[j][2] * v[j][2] + v[j][3] * v[j][3]);
                ss = wave_sum(ss);
                u32x2* br = (u32x2*)(HB + (size_t)t * DM) + lane;
#pragma unroll
                for (int j = 0; j < 4; ++j) { u32x2 w; w.x = cvtpk(v[j][0], v[j][1]); w.y = cvtpk(v[j][2], v[j][3]); br[64 * j] = w; }
                if (lane == 0) ssq1[t] = ss;
                if (IN_I8) {
                    float am = 0.f;
#pragma unroll
                    for (int j = 0; j < 4; ++j) am = fmaxf(am, fmaxf(fmaxf(fabsf(v[j][0]), fabsf(v[j][1])), fmaxf(fabsf(v[j][2]), fabsf(v[j][3]))));
#pragma unroll
                    for (int o = 1; o < 64; o <<= 1) am = fmaxf(am, __shfl_xor(am, o));
                    const float inv = am > 0.f ? 127.0f / am : 0.f;
                    unsigned* ar = (unsigned*)(ws + WS_A8 + (size_t)t * DM) + lane;
#pragma unroll
                    for (int j = 0; j < 4; ++j) {
                        int q0 = (int)rintf(v[j][0] * inv), q1 = (int)rintf(v[j][1] * inv), q2 = (int)rintf(v[j][2] * inv), q3 = (int)rintf(v[j][3] * inv);
                        ar[64 * j] = (unsigned)(q0 & 255) | ((unsigned)(q1 & 255) << 8) | ((unsigned)(q2 & 255) << 16) | ((unsigned)(q3 & 255) << 24);
                    }
                    if (lane == 0) ((float*)(ws + WS_SA))[t] = am > 0.f ? am / 127.0f : 0.f;
                }
            }
        }
        if (wave >= 4) weight_prep(pp, 0, scr, gwave, ngw, lane);
        }
    }

    layer_phases<0>(ph_lo, ph_hi, lds, wave);
    layer_phases<1>(ph_lo, ph_hi, lds, wave);
    static_assert(DEPTH == 2, "two layers");
}

#ifndef MK_PER_PHASE
#define MK_PER_PHASE 0
#endif
extern "C" void kernel_launch(void* const* d_in, const int* in_sizes, int n_in, void* d_out, int out_size, void* d_ws, size_t ws_size, hipStream_t stream) {
    static int grid = 0;
    if (grid == 0) {
        if (n_in != 18 || in_sizes[0] != T * DM || out_size != T * DM || ws_size < WS_END) {
            fprintf(stderr, "kernel_launch: unexpected shapes (n_in %d, in0 %d, out %d, ws %zu); nothing launched\n", n_in, n_in > 0 ? in_sizes[0] : -1, out_size, ws_size); grid = -1; return; }
        int dev = 0, cus = 0, per_cu = 0;
        (void)hipGetDevice(&dev);
        (void)hipDeviceGetAttribute(&cus, hipDeviceAttributeMultiprocessorCount, dev);
        (void)hipFuncSetAttribute((const void*)mega, hipFuncAttributeMaxDynamicSharedMemorySize, LDS_BYTES);
        (void)hipOccupancyMaxActiveBlocksPerMultiprocessor(&per_cu, (const void*)mega, 512, LDS_BYTES);
        if (per_cu < 1) { fprintf(stderr, "kernel_launch: occupancy query says %d blocks per CU\n", per_cu); per_cu = 1; }
        (void)hipGetLastError();
        if (cus < 256) { fprintf(stderr, "kernel_launch: built for a 256-CU device (found %d); nothing launched\n", cus); grid = -1; return; }
        grid = 256;
    }
    if (grid < 0) return;
    (void)hipMemsetAsync((char*)d_ws + WS_CTL, 0, CTL_ZERO_BYTES, stream);
    Params p{};
    for (int i = 0; i < 18; ++i) p.in[i] = (const float*)d_in[i];
    p.out = (float*)d_out; p.ws = (unsigned char*)d_ws;
#if MK_PER_PHASE
    for (int ph = 0; ph < NPH; ++ph) {
        p.ph_lo = ph; p.ph_hi = ph + 1;
        void* args[] = {&p};
        hipError_t e = hipLaunchCooperativeKernel((const void*)mega, dim3(grid), dim3(512), args, LDS_BYTES, stream);
        if (e != hipSuccess) { fprintf(stderr, "cooperative launch %d failed: %s\n", ph, hipGetErrorString(e)); break; }
    }
#else
    p.ph_lo = 0; p.ph_hi = NPH;
    void* args[] = {&p};
    hipError_t e = hipLaunchCooperativeKernel((const void*)mega, dim3(grid), dim3(512), args, LDS_BYTES, stream);
    if (e != hipSuccess) fprintf(stderr, "cooperative launch failed: %s (grid %d)\n", hipGetErrorString(e), grid);
#endif
}
```
